# Optimizing an MI355X kernel written in HIP

```python
import math
import jax, jax.numpy as jnp
from jax import lax
import numpy as np

D_MODEL = 2048
BATCH = 4
SEQ = 8192
DEPTH = 1

EPS = 1e-6
GM_HEADS = 8
GM_HEAD_DIM = 128
GM_W = GM_HEADS * GM_HEAD_DIM
GM_CHUNK = 128
ML_HEADS = 4
ML_QK_DIM = 128
ML_V_DIM = 256
ML_QK_W = ML_HEADS * ML_QK_DIM
ML_W = ML_HEADS * ML_V_DIM
ML_CHUNK = 128
ML_CONV = 4
MIX_W = GM_W + ML_W
SPLITS = [GM_W, GM_W, ML_QK_W, ML_QK_W, ML_W, ML_W, ML_HEADS, ML_HEADS]
PROJ_W = sum(SPLITS)
PEER_HEADS = 8
PEER_QDIM = 128
PEER_HALF = PEER_QDIM // 2
N_KEYS = 128
N_EXPERTS = N_KEYS * N_KEYS
PEER_TOPK = 16
PEER_TOKENS = 128

kernel_name = "hymba_gmlp_mlstm_peer_layer"


def rmsnorm(x, g):
    xf = x.astype(jnp.float32)
    y = xf * lax.rsqrt(jnp.mean(xf * xf, axis=-1, keepdims=True) + EPS)
    return (y * g.astype(jnp.float32)).astype(x.dtype)


def head_rmsnorm(y, g, n_heads):
    shp = y.shape
    yh = y.reshape(shp[:-1] + (n_heads, shp[-1] // n_heads))
    return rmsnorm(yh, g.reshape(n_heads, -1)).reshape(shp)


def causal_depthwise_conv(x, w, b):
    c = x.shape[-1]
    y = lax.conv_general_dilated(x, w[:, None, :].astype(x.dtype), window_strides=(1,),
                                 padding=[(w.shape[0] - 1, 0)],
                                 dimension_numbers=("NWC", "WIO", "NWC"),
                                 feature_group_count=c)
    return y + b.astype(x.dtype)


def mlstm_chunk_step(carry, inp):
    C, n, m = carry
    q, k, v, ig, lf = inp
    L = q.shape[2]
    causal = jnp.tril(jnp.ones((L, L), dtype=bool))
    b = jnp.cumsum(lf, axis=-1)
    dmat = b[..., :, None] - b[..., None, :] + ig[..., None, :]
    dmat = jnp.where(causal, dmat, -jnp.inf)
    inter = b + m[..., None]
    m_t = jnp.maximum(inter, jnp.max(dmat, axis=-1))
    w_intra = jnp.exp(dmat - m_t[..., None])
    a_inter = jnp.exp(inter - m_t)
    s = jnp.einsum("bhtd,bhsd->bhts", q, k) * w_intra
    num = jnp.einsum("bhts,bhsv->bhtv", s, v) + a_inter[..., None] * jnp.einsum("bhtd,bhdv->bhtv", q, C)
    den = jnp.sum(s, axis=-1) + a_inter * jnp.einsum("bhtd,bhd->bht", q, n)
    h = num / jnp.maximum(jnp.abs(den), jnp.exp(-m_t))[..., None]
    b_end = b[..., -1]
    g = b_end[..., None] - b + ig
    m_new = jnp.maximum(b_end + m, jnp.max(g, axis=-1))
    ws = jnp.exp(g - m_new[..., None])
    ac = jnp.exp(b_end + m - m_new)
    C_new = ac[..., None, None] * C + jnp.einsum("bhs,bhsd,bhsv->bhdv", ws, k, v)
    n_new = ac[..., None] * n + jnp.einsum("bhs,bhsd->bhd", ws, k)
    return (C_new, n_new, m_new), h


def setup_inputs(seed: int = 0) -> dict:
    key = jax.random.key(seed)
    ks = jax.random.split(key, 24)
    f32 = jnp.float32
    nrm = lambda k, shp, s: jax.random.normal(k, shp, f32) * s
    gain = lambda k, n: 1.0 + 0.02 * jax.random.normal(k, (n,), f32)
    tri = jnp.tril(jnp.ones((GM_CHUNK, GM_CHUNK), f32))
    return {
        "x": jax.random.normal(ks[0], (BATCH, SEQ, D_MODEL), f32),
        "norm1_g": gain(ks[1], D_MODEL),
        "w_in": nrm(ks[2], (D_MODEL, PROJ_W), D_MODEL ** -0.5),
        "gm_vnorm_g": gain(ks[3], GM_W),
        "w_spatial": nrm(ks[4], (GM_HEADS, GM_CHUNK, GM_CHUNK), 0.5 * GM_CHUNK ** -0.5) * tri,
        "b_spatial": 1.0 + 0.01 * jax.random.normal(ks[5], (GM_HEADS, GM_CHUNK), f32),
        "ml_conv_w": nrm(ks[6], (ML_CONV, 2 * ML_QK_W), ML_CONV ** -0.5),
        "ml_conv_b": nrm(ks[7], (2 * ML_QK_W,), 0.01),
        "ml_b_i": nrm(ks[8], (ML_HEADS,), 0.1),
        "ml_b_f": jnp.linspace(3.0, 6.0, ML_HEADS, dtype=f32) + nrm(ks[9], (ML_HEADS,), 0.1),
        "gm_out_g": gain(ks[10], GM_W),
        "ml_out_g": gain(ks[11], ML_W),
        "w_out": nrm(ks[12], (MIX_W, D_MODEL), MIX_W ** -0.5),
        "norm2_g": gain(ks[13], D_MODEL),
        "peer_wq": nrm(ks[14], (D_MODEL, PEER_HEADS * PEER_QDIM), D_MODEL ** -0.5),
        "peer_k1": nrm(ks[15], (PEER_HEADS, N_KEYS, PEER_HALF), PEER_HALF ** -0.5),
        "peer_k2": nrm(ks[16], (PEER_HEADS, N_KEYS, PEER_HALF), PEER_HALF ** -0.5),
        "peer_u": nrm(ks[17], (N_EXPERTS, D_MODEL), D_MODEL ** -0.5),
        "peer_v": nrm(ks[18], (N_EXPERTS, D_MODEL), (PEER_HEADS * PEER_TOPK) ** -0.5),
        "final_g": gain(ks[19], D_MODEL),
    }


def reference(x, norm1_g, w_in, gm_vnorm_g, w_spatial, b_spatial, ml_conv_w, ml_conv_b,
              ml_b_i, ml_b_f, gm_out_g, ml_out_g, w_out, norm2_g, peer_wq, peer_k1,
              peer_k2, peer_u, peer_v, final_g):
    B, S, D = x.shape
    f32 = jnp.float32
    for _layer in range(DEPTH):
        h = rmsnorm(x, norm1_g)
        proj = h @ w_in.astype(h.dtype)
        idx = np.cumsum(SPLITS)[:-1].tolist()
        p_u, p_v, p_q, p_k, p_mv, p_o, p_i, p_f = jnp.split(proj, idx, axis=-1)

        nc_g = S // GM_CHUNK
        u = jax.nn.gelu(p_u)
        vg = rmsnorm(jax.nn.gelu(p_v), gm_vnorm_g)
        vc = vg.reshape(B, nc_g, GM_CHUNK, GM_HEADS, GM_HEAD_DIM)
        causal = jnp.tril(jnp.ones((GM_CHUNK, GM_CHUNK), dtype=bool))
        ws_m = jnp.where(causal, w_spatial, 0.0).astype(vc.dtype)
        mixed = jnp.einsum("hts,bcshd->bcthd", ws_m, vc) + b_spatial.T.astype(vc.dtype)[None, None, :, :, None]
        y_gm = u * mixed.reshape(B, S, GM_W)

        qk = jax.nn.silu(causal_depthwise_conv(jnp.concatenate([p_q, p_k], axis=-1), ml_conv_w, ml_conv_b))
        q, k = jnp.split(qk.astype(f32), 2, axis=-1)
        q = q.reshape(B, S, ML_HEADS, ML_QK_DIM)
        k = k.reshape(B, S, ML_HEADS, ML_QK_DIM) * (ML_QK_DIM ** -0.5)
        v = p_mv.astype(f32).reshape(B, S, ML_HEADS, ML_V_DIM)
        ig = p_i.astype(f32) + ml_b_i.astype(f32)
        lf = jax.nn.log_sigmoid(p_f.astype(f32) + ml_b_f.astype(f32))
        nc_m = S // ML_CHUNK
        to_c = lambda a: jnp.transpose(a.reshape(B, nc_m, ML_CHUNK, ML_HEADS, a.shape[-1]), (1, 0, 3, 2, 4))
        to_cg = lambda a: jnp.transpose(a.reshape(B, nc_m, ML_CHUNK, ML_HEADS), (1, 0, 3, 2))
        init = (jnp.zeros((B, ML_HEADS, ML_QK_DIM, ML_V_DIM), f32),
                jnp.zeros((B, ML_HEADS, ML_QK_DIM), f32),
                jnp.zeros((B, ML_HEADS), f32))
        _, hs = lax.scan(mlstm_chunk_step, init, (to_c(q), to_c(k), to_c(v), to_cg(ig), to_cg(lf)))
        h_ml = jnp.transpose(hs, (1, 0, 3, 2, 4)).reshape(B, S, ML_W).astype(x.dtype)
        y_ml = jax.nn.sigmoid(p_o) * h_ml

        y_mix = jnp.concatenate([head_rmsnorm(y_gm, gm_out_g, GM_HEADS),
                                 head_rmsnorm(y_ml, ml_out_g, ML_HEADS)], axis=-1)
        x = x + y_mix @ w_out.astype(y_mix.dtype)

        h2 = rmsnorm(x, norm2_g)
        T = B * S
        hb = h2.reshape(T // PEER_TOKENS, PEER_TOKENS, D)

        def peer_block(xc):
            qp = (xc @ peer_wq.astype(xc.dtype)).reshape(PEER_TOKENS, PEER_HEADS, PEER_QDIM)
            q1, q2 = qp[..., :PEER_HALF], qp[..., PEER_HALF:]
            s1 = jnp.einsum("thd,hnd->thn", q1, peer_k1.astype(xc.dtype)).astype(f32)
            s2 = jnp.einsum("thd,hnd->thn", q2, peer_k2.astype(xc.dtype)).astype(f32)
            v1, i1 = lax.top_k(s1, PEER_TOPK)
            v2, i2 = lax.top_k(s2, PEER_TOPK)
            cand_s = (v1[..., :, None] + v2[..., None, :]).reshape(PEER_TOKENS, PEER_HEADS, PEER_TOPK * PEER_TOPK)
            cand_i = (i1[..., :, None] * N_KEYS + i2[..., None, :]).reshape(PEER_TOKENS, PEER_HEADS, PEER_TOPK * PEER_TOPK)
            sv, pos = lax.top_k(cand_s, PEER_TOPK)
            eidx = jnp.take_along_axis(cand_i, pos, axis=-1)
            gate = jax.nn.softmax(sv, axis=-1).astype(xc.dtype)
            u_sel = peer_u.astype(xc.dtype)[eidx]
            v_sel = peer_v.astype(xc.dtype)[eidx]
            act = jax.nn.gelu(jnp.einsum("td,thkd->thk", xc, u_sel))
            return jnp.einsum("thk,thkd->td", gate * act, v_sel)

        y_peer = lax.map(peer_block, hb).reshape(B, S, D)
        x = x + y_peer
    return rmsnorm(x, final_g)
```

```cpp
#include <hip/hip_runtime.h>
#include <hip/hip_cooperative_groups.h>
#include <cstdio>
#include <cstdint>
namespace cg = cooperative_groups;
namespace pg8 {
#define PG8_LAS __attribute__((address_space(3)))
typedef unsigned short bf16_t;
typedef short bf16x8 __attribute__((ext_vector_type(8)));
typedef float f32x4 __attribute__((ext_vector_type(4)));
typedef unsigned u32x4 __attribute__((ext_vector_type(4)));
constexpr int BM = 256, BK = 64, HALF = 128, HTB = HALF * BK * 2  , STAGE_BYTES = 8 * HTB, NXCD = 8, WGM = 8;

__host__ __device__ __forceinline__ int lds_byte(int r, int c) { const int st = (r >> 4) * 2 + (c >> 5), rr = r & 15, cc = c & 31, ob = rr * 64 + cc * 2; return st * 1024 + (ob ^ (((ob >> 9) & 1) << 5)); }
__host__ __device__ __forceinline__ void stage_rc(int b, int& R, int& C) { const int st = b / 1024, sb = b % 1024, swz = sb ^ (((sb >> 9) & 1) << 5); R = (st >> 1) * 16 + swz / 64; C = (st & 1) * 32 + (swz % 64) / 2; }
__host__ __device__ __forceinline__ int perm32(int rho) { const int n = rho >> 4, i = rho & 15; return 8 * (i >> 2) + 4 * n + (i & 3); }

struct Unit { int pm, pn; };
struct Gemm { const bf16_t* A; const bf16_t* Bt; int M, N, K; };

struct StaticOrder {
    int nM, nN, nwg, G, c;
    __host__ __device__ void init(int M, int N, int G_, int c_) { nM = M / BM; nN = N / BM; nwg = nM * nN; G = G_; c = c_; }
    __host__ __device__ bool next(int i, Unit& u) const {
        const long L = (long)i * G + c; if (L >= nwg) return false;
        int wgid = (int)L; { const int q = nwg / NXCD, r = nwg % NXCD, xcd = wgid % NXCD, off = wgid / NXCD; wgid = (xcd < r ? xcd * (q + 1) : r * (q + 1) + (xcd - r) * q) + off; }
        const int nig = WGM * nN, gid = wgid / nig, fm = gid * WGM, gsz = (nM - fm) < WGM ? (nM - fm) : WGM;
        u.pm = fm + ((wgid % nig) % gsz); u.pn = (wgid % nig) / gsz; return true;
    }
    __device__ __forceinline__ void a_ready(const Unit&) const {}
    __device__ __forceinline__ void done(const Unit&) const {}
};
__device__ __forceinline__ unsigned cvt_pk_bf16(float lo, float hi) { unsigned r; asm volatile("v_cvt_pk_bf16_f32 %0, %1, %2" : "=v"(r) : "v"(lo), "v"(hi)); return r; }
template <class Epi, class Sched, bool ALIGN_EPI = false, bool SP2 = false>
__device__ __forceinline__ void gemm_phase(PG8_LAS unsigned char* lds, const Gemm g, const Sched& S, const Epi& E) {
    const int tid = threadIdx.x, wid = __builtin_amdgcn_readfirstlane(tid >> 6), lane = tid & 63, wr = wid >> 2, wc = wid & 3, fr = lane & 15, fq = lane >> 4;
    const int K = g.K, nt = K / BK;
    unsigned voffA[2], voffB[2];
#pragma unroll
    for (int i = 0; i < 2; ++i) { int R, C; stage_rc(tid * 16 + i * 8192, R, C); const int Rb = Epi::PERM ? ((R & ~31) + perm32(R & 31)) : R;
        voffA[i] = (unsigned)(R * K + C) * 2u; voffB[i] = (unsigned)(Rb * K + C) * 2u; }
    const size_t kstep = (size_t)(BK * 2);
    const size_t hstep = (size_t)HALF * K * 2;
    const size_t tstep = 2 * hstep;
    const unsigned ldsw = (unsigned)wid * 1024u;
    const int aoff = lds_byte(wr * 64 + fr, fq * 8), boff = lds_byte(wc * 32 + fr, fq * 8);
#define PG8_SA(b, h) (((b) * 2 + (h)) * HTB)
#define PG8_SB(b, h) ((4 + (b) * 2 + (h)) * HTB)
#define PG8_STAGE(bufoff, gbase, voff) do { _Pragma("unroll") for (int _i = 0; _i < 2; ++_i) \
        __builtin_amdgcn_global_load_lds((const unsigned*)((const char*)(gbase) + (voff)[_i]), (PG8_LAS unsigned*)(lds + (bufoff) + ldsw + _i * 8192), 16, 0, 0); } while (0)
#define PG8_LDA(dst, b, h) do { _Pragma("unroll") for (int m = 0; m < 4; ++m) _Pragma("unroll") for (int k = 0; k < 2; ++k) dst[m][k] = *(const PG8_LAS bf16x8*)(lds + PG8_SA(b, h) + aoff + m * 2048 + k * 1024); } while (0)
#define PG8_LDB(dst, b, h) do { _Pragma("unroll") for (int n = 0; n < 2; ++n) _Pragma("unroll") for (int k = 0; k < 2; ++k) dst[n][k] = *(const PG8_LAS bf16x8*)(lds + PG8_SB(b, h) + boff + n * 2048 + k * 1024); } while (0)
#define PG8_MMA(ai, bj, At, Bt) do { __builtin_amdgcn_s_setprio(1); _Pragma("unroll") for (int m = 0; m < 4; ++m) _Pragma("unroll") for (int n = 0; n < 2; ++n) _Pragma("unroll") for (int k = 0; k < 2; ++k) \
        acc[ai][bj][m][n] = __builtin_amdgcn_mfma_f32_16x16x32_bf16(Bt[n][k], At[m][k], acc[ai][bj][m][n], 0, 0, 0); __builtin_amdgcn_s_setprio(0); } while (0)
#define PG8_WAIT_V(n) asm volatile("s_waitcnt vmcnt(" #n ")" ::: "memory")
#define PG8_WAIT_L(n) asm volatile("s_waitcnt lgkmcnt(" #n ")" ::: "memory")
#define PG8_BAR __builtin_amdgcn_s_barrier()
#define PG8_SCHED __builtin_amdgcn_sched_barrier(0)
    Unit cur, nxt; int ui = 0;
    if (!S.next(0, cur)) return;
    f32x4 acc[2][2][4][2];
#pragma unroll
    for (int a = 0; a < 2; ++a)
#pragma unroll
        for (int b = 0; b < 2; ++b)
#pragma unroll
            for (int m = 0; m < 4; ++m)
#pragma unroll
                for (int n = 0; n < 2; ++n) acc[a][b][m][n] = (f32x4){0.f, 0.f, 0.f, 0.f};
    bf16x8 At[4][2], B0[2][2], B1[2][2];
    const char* cA = (const char*)g.A + (size_t)cur.pm * tstep; const char* cB = (const char*)g.Bt + (size_t)cur.pn * tstep;
    S.a_ready(cur);
    if constexpr (SP2) {
        PG8_STAGE(PG8_SB(0, 0), cB, voffB); PG8_STAGE(PG8_SB(0, 1), cB + hstep, voffB); PG8_STAGE(PG8_SA(0, 0), cA, voffA); PG8_STAGE(PG8_SA(0, 1), cA + hstep, voffA);
        if (wr == 1) PG8_BAR;
        PG8_WAIT_V(2); PG8_BAR;
        PG8_STAGE(PG8_SB(1, 0), cB + kstep, voffB); PG8_STAGE(PG8_SA(1, 0), cA + kstep, voffA); PG8_STAGE(PG8_SB(1, 1), cB + hstep + kstep, voffB);
        PG8_WAIT_V(6); PG8_BAR;
    } else {
        PG8_STAGE(PG8_SB(0, 0), cB, voffB); PG8_STAGE(PG8_SA(0, 0), cA, voffA); PG8_STAGE(PG8_SB(0, 1), cB + hstep, voffB); PG8_STAGE(PG8_SA(0, 1), cA + hstep, voffA);
        if (wr == 1) PG8_BAR;
        PG8_WAIT_V(4); PG8_BAR;
        PG8_STAGE(PG8_SB(1, 0), cB + kstep, voffB); PG8_STAGE(PG8_SA(1, 0), cA + kstep, voffA); PG8_STAGE(PG8_SB(1, 1), cB + hstep + kstep, voffB);
        PG8_WAIT_V(6); PG8_BAR;
    }
    for (;;) {
        const bool has_next = S.next(ui + 1, nxt);
        const char* nA = has_next ? (const char*)g.A + (size_t)nxt.pm * tstep : cA; const char* nB = has_next ? (const char*)g.Bt + (size_t)nxt.pn * tstep : cB;
        for (int t = 0; t < nt; t += 2) {
            const bool last = (t == nt - 2);
            const char* a1 = cA + (size_t)(t + 1) * kstep;
            const char* a2 = last ? nA : cA + (size_t)(t + 2) * kstep; const char* b2 = last ? nB : cB + (size_t)(t + 2) * kstep;
            const char* a3 = a2 + kstep; const char* b3 = b2 + kstep;
            if (last && has_next) S.a_ready(nxt);
            if constexpr (SP2) {
            PG8_LDB(B0, 0, 0); PG8_LDB(B1, 0, 1); PG8_SCHED; PG8_LDA(At, 0, 0); PG8_STAGE(PG8_SA(1, 1), a1 + hstep, voffA);
            PG8_WAIT_V(8); PG8_WAIT_L(0); PG8_BAR; PG8_MMA(0, 0, At, B0); PG8_MMA(0, 1, At, B1); PG8_BAR; PG8_SCHED;
            PG8_LDA(At, 0, 1); PG8_STAGE(PG8_SB(0, 0), b2, voffB); PG8_STAGE(PG8_SB(0, 1), b2 + hstep, voffB); PG8_STAGE(PG8_SA(0, 0), a2, voffA);
            PG8_WAIT_V(8); PG8_WAIT_L(0); PG8_BAR; PG8_MMA(1, 0, At, B0); PG8_MMA(1, 1, At, B1); PG8_BAR; PG8_SCHED;
            PG8_LDB(B0, 1, 0); PG8_LDB(B1, 1, 1); PG8_SCHED; PG8_LDA(At, 1, 0); PG8_STAGE(PG8_SA(0, 1), a2 + hstep, voffA);
            PG8_WAIT_V(8); PG8_WAIT_L(0); PG8_BAR; PG8_MMA(0, 0, At, B0); PG8_MMA(0, 1, At, B1); PG8_BAR; PG8_SCHED;
            PG8_LDA(At, 1, 1); PG8_STAGE(PG8_SB(1, 0), b3, voffB); PG8_STAGE(PG8_SB(1, 1), b3 + hstep, voffB); PG8_STAGE(PG8_SA(1, 0), a3, voffA);
            PG8_WAIT_V(8); PG8_WAIT_L(0); PG8_BAR; PG8_MMA(1, 0, At, B0); PG8_MMA(1, 1, At, B1); PG8_BAR; PG8_SCHED;
            } else {
            PG8_LDB(B0, 0, 0); PG8_SCHED; PG8_LDA(At, 0, 0); PG8_STAGE(PG8_SA(1, 1), a1 + hstep, voffA);
            PG8_WAIT_L(8); PG8_BAR; PG8_WAIT_L(0); PG8_MMA(0, 0, At, B0); PG8_BAR; PG8_SCHED;
            PG8_LDB(B1, 0, 1); PG8_STAGE(PG8_SB(0, 0), b2, voffB);
            PG8_BAR; PG8_WAIT_L(0); PG8_MMA(0, 1, At, B1); PG8_BAR;
            PG8_LDA(At, 0, 1); PG8_STAGE(PG8_SA(0, 0), a2, voffA);
            PG8_BAR; PG8_WAIT_L(0); PG8_MMA(1, 0, At, B0); PG8_BAR; PG8_SCHED;
            PG8_STAGE(PG8_SB(0, 1), b2 + hstep, voffB);
            PG8_WAIT_V(6); PG8_BAR; PG8_MMA(1, 1, At, B1); PG8_BAR;
            PG8_LDB(B0, 1, 0); PG8_SCHED; PG8_LDA(At, 1, 0); PG8_STAGE(PG8_SA(0, 1), a2 + hstep, voffA);
            PG8_WAIT_L(8); PG8_BAR; PG8_WAIT_L(0); PG8_MMA(0, 0, At, B0); PG8_BAR; PG8_SCHED;
            PG8_LDB(B1, 1, 1); PG8_STAGE(PG8_SB(1, 0), b3, voffB);
            PG8_BAR; PG8_WAIT_L(0); PG8_MMA(0, 1, At, B1); PG8_BAR;
            PG8_LDA(At, 1, 1); PG8_STAGE(PG8_SA(1, 0), a3, voffA);
            PG8_BAR; PG8_WAIT_L(0); PG8_MMA(1, 0, At, B0); PG8_BAR; PG8_SCHED;
            PG8_STAGE(PG8_SB(1, 1), b3 + hstep, voffB);
            PG8_WAIT_V(6); PG8_BAR; PG8_MMA(1, 1, At, B1); PG8_BAR;
            }
        }
        if constexpr (ALIGN_EPI) { if (wr == 0) PG8_BAR; }
        if constexpr (!Epi::AFTER_DRAIN) { E(acc, cur, wr, wc, fr, fq); S.done(cur); }
        if (!has_next) break;
#pragma unroll
        for (int a = 0; a < 2; ++a)
#pragma unroll
            for (int b = 0; b < 2; ++b)
#pragma unroll
                for (int m = 0; m < 4; ++m)
#pragma unroll
                    for (int n = 0; n < 2; ++n) acc[a][b][m][n] = (f32x4){0.f, 0.f, 0.f, 0.f};
        cur = nxt; cA = nA; cB = nB; ++ui;
        if constexpr (ALIGN_EPI) { if (wr == 1) PG8_BAR; }
    }
    PG8_WAIT_V(0);
    if constexpr (!ALIGN_EPI) { if (wr == 0) PG8_BAR; }
    PG8_BAR;
    if constexpr (Epi::AFTER_DRAIN) { E.fused(acc, cur, wr, wc, fr, fq, lds, wid, lane); S.done(cur); }
#undef PG8_SA
#undef PG8_SB
#undef PG8_STAGE
#undef PG8_LDA
#undef PG8_LDB
#undef PG8_MMA
#undef PG8_WAIT_V
#undef PG8_WAIT_L
#undef PG8_BAR
#undef PG8_SCHED
}
}

#define LAS __attribute__((address_space(3)))
#define DI __device__ __forceinline__
using pg8::bf16_t; using pg8::bf16x8; using pg8::f32x4; using pg8::u32x4; using pg8::cvt_pk_bf16;
typedef unsigned u32x2 __attribute__((ext_vector_type(2)));
typedef float f32x2 __attribute__((ext_vector_type(2)));

constexpr int T_TOK = 32768, DM = 2048, NPROJ = 5120, PROJW = 5128;
constexpr int NTHREADS = 512;
constexpr int LDS_BYTES = 147456;
constexpr float EPS = 1e-6f;

constexpr size_t WS_XN = 0;
constexpr size_t WS_P = 134217728;
constexpr size_t WS_X1G = WS_P;
constexpr size_t WS_Q = WS_P + 134217728;
constexpr size_t WS_WINT = WS_P + 335544320;
constexpr size_t WS_WOUTT = WS_WINT + 20971520;
constexpr size_t WS_WQT = WS_WOUTT + 8388608;
constexpr size_t WS_UB = WS_WQT + 4194304;
constexpr size_t WS_VB = WS_UB + 67108864;
constexpr size_t WS_ST = WS_VB + 67108864;
constexpr size_t WS_CPT = WS_ST + 142606336;
constexpr size_t WS_QC = WS_CPT + 71303168;
constexpr size_t WS_KC = WS_QC + 33554432;
constexpr size_t WS_IG = WS_KC + 33554432;
constexpr size_t WS_LF = WS_IG + 524288;
constexpr size_t WS_PSSV = WS_LF + 524288;
constexpr size_t WS_PSS2 = WS_PSSV + 2097152;
constexpr size_t WS_BEND = WS_PSS2 + 4194304;
constexpr size_t WS_GMAX = WS_BEND + 4096;
constexpr size_t WS_MPREV = WS_GMAX + 4096;
constexpr size_t WS_END = WS_MPREV + 4096;

struct Params {
    const float *x, *norm1_g, *w_in, *gm_vnorm_g, *w_spatial, *b_spatial, *ml_conv_w, *ml_conv_b, *ml_b_i, *ml_b_f, *gm_out_g, *ml_out_g, *w_out, *norm2_g,
        *peer_wq, *peer_k1, *peer_k2, *peer_u, *peer_v, *final_g;
    float* out;
    unsigned char* ws;
};

DI float bf2f(unsigned short h) { return __uint_as_float(((unsigned)h) << 16); }
DI float bflo(unsigned w) { return __uint_as_float(w << 16); }
DI float bfhi(unsigned w) { return __uint_as_float(w & 0xffff0000u); }
DI float rcpf_(float x) { return __builtin_amdgcn_rcpf(x); }
DI float sigmoid_(float x) { return rcpf_(1.f + __expf(-x)); }
DI float gelu_t(float x) { const float z = 1.5957691216057308f * (x + 0.044715f * x * x * x); return x * rcpf_(1.f + __expf(-z)); }
DI float wave_sum(float v) {
#pragma unroll
    for (int o = 32; o; o >>= 1) v += __shfl_xor(v, o);
    return v;
}
DI float wave_max(float v) {
#pragma unroll
    for (int o = 32; o; o >>= 1) v = fmaxf(v, __shfl_xor(v, o));
    return v;
}
DI bf16x8 ld_frag_lds(const LAS unsigned char* p) { return *(const LAS bf16x8*)p; }
#define MFMA16(a, b, c) __builtin_amdgcn_mfma_f32_16x16x32_bf16((a), (b), (c), 0, 0, 0)

struct Epi1 {
    static constexpr bool PERM = true, AFTER_DRAIN = false;
    bf16_t* P; float* pssv;
    DI void operator()(const f32x4 (&acc)[2][2][4][2], const pg8::Unit& u, int wr, int wc, int fr, int fq) const {
        const int row0 = u.pm * 256 + wr * 64 + fr, col0 = u.pn * 256 + wc * 32 + 8 * fq;
        const int mode = u.pn < 8 ? 1 : (u.pn >= 16 ? 2 : 0);
        const bool want_ss = (u.pn >= 4 && u.pn < 8);
#pragma unroll
        for (int ai = 0; ai < 2; ++ai)
#pragma unroll
            for (int m = 0; m < 4; ++m) {
                const int row = row0 + ai * 128 + m * 16;
                bf16_t* rowp = P + (size_t)row * NPROJ + col0;
                float ss = 0.f;
#pragma unroll
                for (int bj = 0; bj < 2; ++bj) {
                    f32x4 v0 = acc[ai][bj][m][0], v1 = acc[ai][bj][m][1];
                    if (mode == 1) {
#pragma unroll
                        for (int j = 0; j < 4; ++j) { v0[j] = gelu_t(v0[j]); v1[j] = gelu_t(v1[j]); ss += v0[j] * v0[j] + v1[j] * v1[j]; }
                    } else if (mode == 2) {
#pragma unroll
                        for (int j = 0; j < 4; ++j) { v0[j] = sigmoid_(v0[j]); v1[j] = sigmoid_(v1[j]); }
                    }
                    u32x4 w; w.x = cvt_pk_bf16(v0[0], v0[1]); w.y = cvt_pk_bf16(v0[2], v0[3]); w.z = cvt_pk_bf16(v1[0], v1[1]); w.w = cvt_pk_bf16(v1[2], v1[3]);
                    *(u32x4*)(rowp + bj * 128) = w;
                }
                if (want_ss) {
                    ss += __shfl_xor(ss, 16); ss += __shfl_xor(ss, 32);
                    if (fq == 0) pssv[(size_t)row * 16 + (u.pn - 4) * 4 + wc] = ss;
                }
            }
    }
};

struct Epi2 {
    static constexpr bool PERM = true, AFTER_DRAIN = false;
    const float* x; float* x1; bf16_t* x1g; const float* g2; float* pss2;
    DI void operator()(const f32x4 (&acc)[2][2][4][2], const pg8::Unit& u, int wr, int wc, int fr, int fq) const {
        const int row0 = u.pm * 256 + wr * 64 + fr, col0 = u.pn * 256 + wc * 32 + 8 * fq;
#pragma unroll
        for (int ai = 0; ai < 2; ++ai)
#pragma unroll
            for (int m = 0; m < 4; ++m) {
                const int row = row0 + ai * 128 + m * 16;
                float ss = 0.f;
#pragma unroll
                for (int bj = 0; bj < 2; ++bj) {
                    const size_t o = (size_t)row * DM + col0 + bj * 128;
                    f32x4 v0 = acc[ai][bj][m][0] + *(const f32x4*)(x + o), v1 = acc[ai][bj][m][1] + *(const f32x4*)(x + o + 4);
                    *(f32x4*)(x1 + o) = v0; *(f32x4*)(x1 + o + 4) = v1;
                    const f32x4 ga = *(const f32x4*)(g2 + col0 + bj * 128), gb = *(const f32x4*)(g2 + col0 + bj * 128 + 4);
#pragma unroll
                    for (int j = 0; j < 4; ++j) ss += v0[j] * v0[j] + v1[j] * v1[j];
                    v0 = v0 * ga; v1 = v1 * gb;
                    u32x4 w; w.x = cvt_pk_bf16(v0[0], v0[1]); w.y = cvt_pk_bf16(v0[2], v0[3]); w.z = cvt_pk_bf16(v1[0], v1[1]); w.w = cvt_pk_bf16(v1[2], v1[3]);
                    *(u32x4*)(x1g + o) = w;
                }
                ss += __shfl_xor(ss, 16); ss += __shfl_xor(ss, 32);
                if (fq == 0) pss2[(size_t)row * 32 + u.pn * 4 + wc] = ss;
            }
    }
};

struct Epi3 {
    static constexpr bool PERM = true, AFTER_DRAIN = false;
    bf16_t* Q; const float* pss2;
    DI void operator()(const f32x4 (&acc)[2][2][4][2], const pg8::Unit& u, int wr, int wc, int fr, int fq) const {
        const int row0 = u.pm * 256 + wr * 64 + fr, col0 = u.pn * 256 + wc * 32 + 8 * fq;
#pragma unroll
        for (int ai = 0; ai < 2; ++ai)
#pragma unroll
            for (int m = 0; m < 4; ++m) {
                const int row = row0 + ai * 128 + m * 16;
                float ss = 0.f;
#pragma unroll
                for (int i = 0; i < 8; ++i) { const f32x4 t = *(const f32x4*)(pss2 + (size_t)row * 32 + i * 4); ss += (t[0] + t[1]) + (t[2] + t[3]); }
                const float rstd = rsqrtf(ss * (1.f / 2048.f) + EPS);
#pragma unroll
                for (int bj = 0; bj < 2; ++bj) {
                    const f32x4 v0 = acc[ai][bj][m][0] * rstd, v1 = acc[ai][bj][m][1] * rstd;
                    u32x4 w; w.x = cvt_pk_bf16(v0[0], v0[1]); w.y = cvt_pk_bf16(v0[2], v0[3]); w.z = cvt_pk_bf16(v1[0], v1[1]); w.w = cvt_pk_bf16(v1[2], v1[3]);
                    *(u32x4*)(Q + (size_t)row * 1024 + col0 + bj * 128) = w;
                }
            }
    }
};

DI void phase0(const Params& p, LAS unsigned char* lds) {
    const int tid = threadIdx.x, lane = tid & 63, wave = tid >> 6;
    bf16_t* XN = (bf16_t*)(p.ws + WS_XN);
    {
        LAS float* scr = (LAS float*)lds + wave * (64 * 65);
        const int gw = blockIdx.x * 8 + wave, nw = gridDim.x * 8;
        for (int it = gw; it < 4096; it += nw) {
            const float* W; bf16_t* WT; int ldw, kt, nt;
            if (it < 2560) { W = p.w_in; WT = (bf16_t*)(p.ws + WS_WINT); ldw = PROJW; kt = it / 80; nt = it % 80; }
            else if (it < 3584) { const int j = it - 2560; W = p.w_out; WT = (bf16_t*)(p.ws + WS_WOUTT); ldw = 2048; kt = j >> 5; nt = j & 31; }
            else { const int j = it - 3584; W = p.peer_wq; WT = (bf16_t*)(p.ws + WS_WQT); ldw = 1024; kt = j >> 4; nt = j & 15; }
            const int k0 = kt * 64, n0 = nt * 64;
#pragma unroll 8
            for (int r = 0; r < 64; ++r) scr[r * 65 + lane] = W[(size_t)(k0 + r) * ldw + n0 + lane];
            __builtin_amdgcn_fence(__ATOMIC_RELEASE, "wavefront"); __builtin_amdgcn_wave_barrier(); __builtin_amdgcn_fence(__ATOMIC_ACQUIRE, "wavefront");
            const int half = lane >> 5, kk = (lane & 31) * 2;
#pragma unroll 8
            for (int nn = 0; nn < 32; ++nn) {
                const int n = 2 * nn + half; const float a = scr[kk * 65 + n], b = scr[(kk + 1) * 65 + n];
                *(unsigned*)(WT + (size_t)(n0 + n) * 2048 + k0 + kk) = cvt_pk_bf16(a, b);
            }
            __builtin_amdgcn_fence(__ATOMIC_RELEASE, "wavefront"); __builtin_amdgcn_wave_barrier(); __builtin_amdgcn_fence(__ATOMIC_ACQUIRE, "wavefront");
        }
    }
    __syncthreads();
    {
        LAS float* wg = (LAS float*)lds;
        for (int idx = tid; idx < 4096; idx += NTHREADS) {
            const int k = idx >> 1, hf = idx & 1;
            const f32x4 v = *(const f32x4*)(p.w_in + (size_t)k * PROJW + 5120 + hf * 4);
            *(LAS f32x4*)(wg + k * 8 + (k >> 3) * 4 + hf * 4) = v;
        }
        __syncthreads();
        float* IG = (float*)(p.ws + WS_IG); float* LF = (float*)(p.ws + WS_LF);
        for (int row = blockIdx.x * 8 + wave; row < T_TOK; row += gridDim.x * 8) {
            const float* xr = p.x + (size_t)row * DM;
            f32x4 xv[8]; float ss = 0.f;
#pragma unroll
            for (int i = 0; i < 4; ++i) { xv[2 * i] = *(const f32x4*)(xr + i * 512 + lane * 8); xv[2 * i + 1] = *(const f32x4*)(xr + i * 512 + lane * 8 + 4); }
#pragma unroll
            for (int i = 0; i < 8; ++i) ss += (xv[i][0] * xv[i][0] + xv[i][1] * xv[i][1]) + (xv[i][2] * xv[i][2] + xv[i][3] * xv[i][3]);
            ss = wave_sum(ss);
            const float rstd = rsqrtf(ss * (1.f / 2048.f) + EPS);
            f32x4 ga = {0.f, 0.f, 0.f, 0.f}, gb = {0.f, 0.f, 0.f, 0.f};
#pragma unroll
            for (int i = 0; i < 4; ++i) {
                const f32x4 g0 = *(const f32x4*)(p.norm1_g + i * 512 + lane * 8), g1 = *(const f32x4*)(p.norm1_g + i * 512 + lane * 8 + 4);
                const f32x4 h0 = xv[2 * i] * rstd * g0, h1 = xv[2 * i + 1] * rstd * g1;
                u32x4 w; w.x = cvt_pk_bf16(h0[0], h0[1]); w.y = cvt_pk_bf16(h0[2], h0[3]); w.z = cvt_pk_bf16(h1[0], h1[1]); w.w = cvt_pk_bf16(h1[2], h1[3]);
                *(u32x4*)(XN + (size_t)row * DM + i * 512 + lane * 8) = w;
                const LAS float* wb = wg + (i * 512 + lane * 8) * 8 + (i * 64 + lane) * 4;
#pragma unroll
                for (int e = 0; e < 8; ++e) {
                    const float hv = e < 4 ? h0[e & 3] : h1[e & 3];
                    const f32x4 w0 = *(const LAS f32x4*)(wb + e * 8), w1 = *(const LAS f32x4*)(wb + e * 8 + 4);
                    ga = ga + w0 * hv; gb = gb + w1 * hv;
                }
            }
            float zi = 0.f;
#pragma unroll
            for (int j = 0; j < 4; ++j) { const float a = wave_sum(ga[j]), b = wave_sum(gb[j]); zi = (lane == j) ? a : zi; zi = (lane == 4 + j) ? b : zi; }
            if (lane < 4) IG[(size_t)row * 4 + lane] = zi + p.ml_b_i[lane];
            else if (lane < 8) { const float z = zi + p.ml_b_f[lane - 4]; LF[(size_t)row * 4 + lane - 4] = fminf(z, 0.f) - log1pf(__expf(-fabsf(z))); }
        }
    }
    {
        bf16_t* Ub = (bf16_t*)(p.ws + WS_UB); bf16_t* Vb = (bf16_t*)(p.ws + WS_VB);
        const size_t n8 = (size_t)16384 * 2048 / 8;
        for (size_t i = (size_t)blockIdx.x * NTHREADS + tid; i < n8; i += (size_t)gridDim.x * NTHREADS) {
            const f32x4 a0 = *(const f32x4*)(p.peer_u + i * 8), a1 = *(const f32x4*)(p.peer_u + i * 8 + 4);
            const f32x4 b0 = *(const f32x4*)(p.peer_v + i * 8), b1 = *(const f32x4*)(p.peer_v + i * 8 + 4);
            u32x4 w; w.x = cvt_pk_bf16(a0[0], a0[1]); w.y = cvt_pk_bf16(a0[2], a0[3]); w.z = cvt_pk_bf16(a1[0], a1[1]); w.w = cvt_pk_bf16(a1[2], a1[3]);
            *(u32x4*)(Ub + i * 8) = w;
            w.x = cvt_pk_bf16(b0[0], b0[1]); w.y = cvt_pk_bf16(b0[2], b0[3]); w.z = cvt_pk_bf16(b1[0], b1[1]); w.w = cvt_pk_bf16(b1[2], b1[3]);
            *(u32x4*)(Vb + i * 8) = w;
        }
    }
}

#define WAVE_LDS_SYNC() do { __builtin_amdgcn_fence(__ATOMIC_RELEASE, "wavefront"); __builtin_amdgcn_wave_barrier(); __builtin_amdgcn_fence(__ATOMIC_ACQUIRE, "wavefront"); } while (0)

DI void stage_T(const bf16_t* src, int ld, int ngroups, LAS unsigned char* dst, int wave, int lane) {
    for (int g = wave; g < ngroups; g += 8) {
        const u32x4 r0 = *(const u32x4*)(src + (size_t)(2 * lane) * ld + g * 8);
        const u32x4 r1 = *(const u32x4*)(src + (size_t)(2 * lane + 1) * ld + g * 8);
#pragma unroll
        for (int w = 0; w < 4; ++w) {
            const unsigned a = r0[w], b = r1[w];
            *(LAS unsigned*)(dst + (g * 8 + 2 * w) * 272 + lane * 4) = (a & 0xffffu) | (b << 16);
            *(LAS unsigned*)(dst + (g * 8 + 2 * w + 1) * 272 + lane * 4) = (a >> 16) | (b & 0xffff0000u);
        }
    }
}

DI void gmlp_bc(const Params& p, LAS unsigned char* lds, int b, int c) {
    const int tid = threadIdx.x, lane = tid & 63, wave = __builtin_amdgcn_readfirstlane(tid >> 6), fr = lane & 15, fq = lane >> 4;
    const int t0 = b * 8192 + c * 128;
    LAS unsigned char* Wl = lds; LAS unsigned char* GvT = lds + 34816; LAS float* rstdv = (LAS float*)(lds + 69632);
    const bf16_t* P = (const bf16_t*)(p.ws + WS_P); bf16_t* YM = (bf16_t*)(p.ws + WS_XN);
    const float* PSSV = (const float*)(p.ws + WS_PSSV);
    __syncthreads();
    if (tid < 128) {
        float ss = 0.f;
#pragma unroll
        for (int i = 0; i < 4; ++i) { const f32x4 v = *(const f32x4*)(PSSV + (size_t)(t0 + tid) * 16 + i * 4); ss += (v[0] + v[1]) + (v[2] + v[3]); }
        rstdv[tid] = rsqrtf(ss * (1.f / 1024.f) + EPS);
    }
    for (int h = 0; h < 8; ++h) {
        __syncthreads();
#pragma unroll
        for (int it = 0; it < 4; ++it) {
            const int e = (it * NTHREADS + tid) * 8, t = e >> 7, s0 = e & 127;
            const float* wp = p.w_spatial + ((size_t)(h * 128 + t)) * 128 + s0;
            const f32x4 a0 = *(const f32x4*)wp, a1 = *(const f32x4*)(wp + 4);
            float v[8];
#pragma unroll
            for (int j = 0; j < 8; ++j) { const float a = j < 4 ? a0[j & 3] : a1[j & 3]; v[j] = (s0 + j <= t) ? a * rstdv[s0 + j] : 0.f; }
            u32x4 w; w.x = cvt_pk_bf16(v[0], v[1]); w.y = cvt_pk_bf16(v[2], v[3]); w.z = cvt_pk_bf16(v[4], v[5]); w.w = cvt_pk_bf16(v[6], v[7]);
            *(LAS u32x4*)(Wl + t * 272 + s0 * 2) = w;
        }
        stage_T(P + (size_t)t0 * NPROJ + 1024 + h * 128, NPROJ, 16, GvT, wave, lane);
        __syncthreads();
        f32x4 acc[8];
#pragma unroll
        for (int n = 0; n < 8; ++n) acc[n] = (f32x4){0.f, 0.f, 0.f, 0.f};
        const int kmax = (16 * wave + 15) >> 5;
#pragma unroll
        for (int kk = 0; kk < 4; ++kk) {
            if (kk <= kmax) {
                const bf16x8 bfrag = ld_frag_lds(Wl + (16 * wave + fr) * 272 + (32 * kk + 8 * fq) * 2);
#pragma unroll
                for (int n = 0; n < 8; ++n) { const bf16x8 afrag = ld_frag_lds(GvT + (16 * n + fr) * 272 + (32 * kk + 8 * fq) * 2); acc[n] = MFMA16(afrag, bfrag, acc[n]); }
            }
        }
        const int t = 16 * wave + fr; const size_t grow = (size_t)(t0 + t);
        const float bsp = p.b_spatial[h * 128 + t];
        float ss = 0.f;
#pragma unroll
        for (int n = 0; n < 8; ++n) {
            const int d0 = 16 * n + 4 * fq;
            const u32x2 uw = *(const u32x2*)(P + grow * NPROJ + h * 128 + d0);
            const f32x4 gv = *(const f32x4*)(p.gm_vnorm_g + h * 128 + d0);
            f32x4 y;
            y[0] = bflo(uw.x) * (gv[0] * acc[n][0] + bsp); y[1] = bfhi(uw.x) * (gv[1] * acc[n][1] + bsp);
            y[2] = bflo(uw.y) * (gv[2] * acc[n][2] + bsp); y[3] = bfhi(uw.y) * (gv[3] * acc[n][3] + bsp);
            ss += (y[0] * y[0] + y[1] * y[1]) + (y[2] * y[2] + y[3] * y[3]);
            acc[n] = y;
        }
        ss += __shfl_xor(ss, 16); ss += __shfl_xor(ss, 32);
        const float rstd = rsqrtf(ss * (1.f / 128.f) + EPS);
#pragma unroll
        for (int n = 0; n < 8; ++n) {
            const int d0 = 16 * n + 4 * fq;
            const f32x4 g = *(const f32x4*)(p.gm_out_g + h * 128 + d0);
            const f32x4 o = acc[n] * rstd * g;
            u32x2 w; w.x = cvt_pk_bf16(o[0], o[1]); w.y = cvt_pk_bf16(o[2], o[3]);
            *(u32x2*)(YM + grow * DM + h * 128 + d0) = w;
        }
    }
}

DI void mlstm_local(const Params& p, LAS unsigned char* lds, int b, int c, int h) {
    const int tid = threadIdx.x, lane = tid & 63, wave = __builtin_amdgcn_readfirstlane(tid >> 6), fr = lane & 15, fq = lane >> 4;
    const int bh = b * 4 + h, t0 = b * 8192 + c * 128;
    LAS unsigned char* KT = lds; LAS unsigned char* VT = lds + 34816; LAS float* wsv = (LAS float*)(lds + 108800);
    const bf16_t* P = (const bf16_t*)(p.ws + WS_P);
    bf16_t* QC = (bf16_t*)(p.ws + WS_QC); bf16_t* KC = (bf16_t*)(p.ws + WS_KC);
    const float* IG = (const float*)(p.ws + WS_IG); const float* LF = (const float*)(p.ws + WS_LF);
    __syncthreads();
    if (wave == 0) {
        const float l0 = LF[(size_t)(t0 + 2 * lane) * 4 + h], l1 = LF[(size_t)(t0 + 2 * lane + 1) * 4 + h];
        const float i0 = IG[(size_t)(t0 + 2 * lane) * 4 + h], i1 = IG[(size_t)(t0 + 2 * lane + 1) * 4 + h];
        float s = l0 + l1;
#pragma unroll
        for (int off = 1; off < 64; off <<= 1) { const float tt = __shfl_up(s, off); if (lane >= off) s += tt; }
        const float b1 = s, b0 = s - l1, bend = __shfl(s, 63);
        const float g0 = bend - b0 + i0, g1 = bend - b1 + i1;
        const float gmax = wave_max(fmaxf(g0, g1));
        wsv[2 * lane] = __expf(g0 - gmax); wsv[2 * lane + 1] = __expf(g1 - gmax);
        if (lane == 0) { ((float*)(p.ws + WS_BEND))[bh * 64 + c] = bend; ((float*)(p.ws + WS_GMAX))[bh * 64 + c] = gmax; }
    }
    __syncthreads();
    for (int g = wave; g < 32; g += 8) {
        const bool isk = g >= 16; const int cgp = (g & 15) * 8;
        const int ch = (isk ? 512 : 0) + h * 128 + cgp;
        const bf16_t* src = P + (isk ? 2560 : 2048) + h * 128 + cgp;
        const int s = 2 * lane;
        float xr[5][8];
#pragma unroll
        for (int dj = 0; dj < 5; ++dj) {
            const int srow = s - 3 + dj;
            u32x4 w = {0u, 0u, 0u, 0u};
            if (c > 0 || srow >= 0) w = *(const u32x4*)(src + (size_t)((long)t0 + srow) * NPROJ);
#pragma unroll
            for (int q = 0; q < 4; ++q) { xr[dj][2 * q] = bflo(w[q]); xr[dj][2 * q + 1] = bfhi(w[q]); }
        }
        float y0[8], y1[8];
        {
            const f32x4 cb0 = *(const f32x4*)(p.ml_conv_b + ch), cb1 = *(const f32x4*)(p.ml_conv_b + ch + 4);
#pragma unroll
            for (int e = 0; e < 8; ++e) { y0[e] = e < 4 ? cb0[e & 3] : cb1[e & 3]; y1[e] = y0[e]; }
#pragma unroll
            for (int j = 0; j < 4; ++j) {
                const f32x4 w0 = *(const f32x4*)(p.ml_conv_w + j * 1024 + ch), w1 = *(const f32x4*)(p.ml_conv_w + j * 1024 + ch + 4);
#pragma unroll
                for (int e = 0; e < 8; ++e) { const float wv = e < 4 ? w0[e & 3] : w1[e & 3]; y0[e] += wv * xr[j][e]; y1[e] += wv * xr[j + 1][e]; }
            }
        }
        const float sc = isk ? 0.08838834764831845f : 1.f;
#pragma unroll
        for (int e = 0; e < 8; ++e) { y0[e] = y0[e] * sigmoid_(y0[e]) * sc; y1[e] = y1[e] * sigmoid_(y1[e]) * sc; }
        bf16_t* dst = (isk ? KC : QC) + (size_t)(t0 + s) * 512 + h * 128 + cgp;
        u32x4 w; w.x = cvt_pk_bf16(y0[0], y0[1]); w.y = cvt_pk_bf16(y0[2], y0[3]); w.z = cvt_pk_bf16(y0[4], y0[5]); w.w = cvt_pk_bf16(y0[6], y0[7]);
        *(u32x4*)dst = w;
        w.x = cvt_pk_bf16(y1[0], y1[1]); w.y = cvt_pk_bf16(y1[2], y1[3]); w.z = cvt_pk_bf16(y1[4], y1[5]); w.w = cvt_pk_bf16(y1[6], y1[7]);
        *(u32x4*)(dst + 512) = w;
        if (isk) {
            const float w0 = wsv[s], w1 = wsv[s + 1];
#pragma unroll
            for (int e = 0; e < 8; ++e) *(LAS unsigned*)(KT + (cgp + e) * 272 + lane * 4) = cvt_pk_bf16(y0[e] * w0, y1[e] * w1);
        }
    }
    stage_T(P + (size_t)t0 * NPROJ + 3072 + h * 256, NPROJ, 32, VT, wave, lane);
    for (int i = tid; i < 1024; i += NTHREADS) { const int r = i >> 6, w = i & 63; *(LAS unsigned*)(VT + (256 + r) * 272 + w * 4) = 0x3F803F80u; }
    __syncthreads();
    bf16x8 af[4];
#pragma unroll
    for (int kk = 0; kk < 4; ++kk) af[kk] = ld_frag_lds(KT + (16 * wave + fr) * 272 + (32 * kk + 8 * fq) * 2);
    float* ST = (float*)(p.ws + WS_ST) + ((size_t)(bh * 64 + c) * 272) * 128;
#pragma unroll
    for (int n = 0; n < 17; ++n) {
        f32x4 acc = {0.f, 0.f, 0.f, 0.f};
#pragma unroll
        for (int kk = 0; kk < 4; ++kk) { const bf16x8 bfr = ld_frag_lds(VT + (16 * n + fr) * 272 + (32 * kk + 8 * fq) * 2); acc = MFMA16(af[kk], bfr, acc); }
        if (n < 16 || fr == 0) *(f32x4*)(ST + (size_t)(16 * n + fr) * 128 + 16 * wave + 4 * fq) = acc;
    }
}

DI void phase_scan(const Params& p) {
    const float* ST = (const float*)(p.ws + WS_ST); bf16_t* CPT = (bf16_t*)(p.ws + WS_CPT);
    const float* BEND = (const float*)(p.ws + WS_BEND); const float* GMAX = (const float*)(p.ws + WS_GMAX); float* MPREV = (float*)(p.ws + WS_MPREV);
    const int gtid = blockIdx.x * NTHREADS + threadIdx.x, nthr = gridDim.x * NTHREADS;
    constexpr int PER = 8224;
    constexpr size_t CST = 272 * 128;
    for (int item = gtid; item < 16 * PER; item += nthr) {
        const int bh = item / PER, e4 = item - bh * PER;
        const float* src = ST + (size_t)bh * 64 * CST + (size_t)e4 * 4;
        bf16_t* dst = CPT + (size_t)bh * 64 * CST + (size_t)e4 * 4;
        f32x4 st = {0.f, 0.f, 0.f, 0.f}; float m = 0.f;
        for (int c0 = 0; c0 < 64; c0 += 8) {
            f32x4 d[8];
#pragma unroll
            for (int j = 0; j < 8; ++j) d[j] = *(const f32x4*)(src + (size_t)(c0 + j) * CST);
#pragma unroll
            for (int j = 0; j < 8; ++j) {
                const int c = c0 + j;
                const float be = BEND[bh * 64 + c], gm = GMAX[bh * 64 + c];
                const float mn = fmaxf(be + m, gm), a = __expf(be + m - mn), sc = __expf(gm - mn);
                u32x2 w; w.x = cvt_pk_bf16(st[0], st[1]); w.y = cvt_pk_bf16(st[2], st[3]);
                *(u32x2*)(dst + (size_t)c * CST) = w;
                if (e4 == 0) MPREV[bh * 64 + c] = m;
                st = st * a + d[j] * sc; m = mn;
            }
        }
    }
}

DI void mlstm_out(const Params& p, LAS unsigned char* lds, int b, int c, int h) {
    const int tid = threadIdx.x, lane = tid & 63, wave = __builtin_amdgcn_readfirstlane(tid >> 6), fr = lane & 15, fq = lane >> 4;
    const int bh = b * 4 + h, t0 = b * 8192 + c * 128;
    LAS unsigned char* Kl = lds; LAS unsigned char* Sl = lds + 34816; LAS unsigned char* VTe = lds + 69632;
    LAS float* av = (LAS float*)(lds + 143616); LAS float* Mv = (LAS float*)(lds + 144128); LAS float* bv = (LAS float*)(lds + 144640);
    const bf16_t* P = (const bf16_t*)(p.ws + WS_P); bf16_t* YM = (bf16_t*)(p.ws + WS_XN);
    const bf16_t* QC = (const bf16_t*)(p.ws + WS_QC); const bf16_t* KC = (const bf16_t*)(p.ws + WS_KC);
    const float* IG = (const float*)(p.ws + WS_IG); const float* LF = (const float*)(p.ws + WS_LF);
    const float mprev = ((const float*)(p.ws + WS_MPREV))[bh * 64 + c];
    __syncthreads();
    if (wave == 0) {
        const float l0 = LF[(size_t)(t0 + 2 * lane) * 4 + h], l1 = LF[(size_t)(t0 + 2 * lane + 1) * 4 + h];
        const float i0 = IG[(size_t)(t0 + 2 * lane) * 4 + h], i1 = IG[(size_t)(t0 + 2 * lane + 1) * 4 + h];
        float s = l0 + l1;
#pragma unroll
        for (int off = 1; off < 64; off <<= 1) { const float tt = __shfl_up(s, off); if (lane >= off) s += tt; }
        const float b1 = s, b0 = s - l1;
        const float a0 = i0 - b0, a1 = i1 - b1;
        float pm = fmaxf(a0, a1);
#pragma unroll
        for (int off = 1; off < 64; off <<= 1) { const float tt = __shfl_up(pm, off); if (lane >= off) pm = fmaxf(pm, tt); }
        float ex = __shfl_up(pm, 1); if (lane == 0) ex = -3.0e38f;
        Mv[2 * lane] = fmaxf(mprev, fmaxf(ex, a0)); Mv[2 * lane + 1] = fmaxf(mprev, pm);
        av[2 * lane] = a0; av[2 * lane + 1] = a1; bv[2 * lane] = b0; bv[2 * lane + 1] = b1;
    }
#pragma unroll
    for (int it = 0; it < 4; ++it) {
        const int e = (it * NTHREADS + tid) * 8, s = e >> 7, d0 = e & 127;
        *(LAS u32x4*)(Kl + s * 272 + d0 * 2) = *(const u32x4*)(KC + (size_t)(t0 + s) * 512 + h * 128 + d0);
    }
    stage_T(P + (size_t)t0 * NPROJ + 3072 + h * 256, NPROJ, 32, VTe, wave, lane);
    for (int i = tid; i < 1024; i += NTHREADS) { const int r = i >> 6, w = i & 63; *(LAS unsigned*)(VTe + (256 + r) * 272 + w * 4) = 0x3F803F80u; }
    bf16x8 qf[4];
#pragma unroll
    for (int kk = 0; kk < 4; ++kk) qf[kk] = *(const bf16x8*)(QC + (size_t)(t0 + 16 * wave + fr) * 512 + h * 128 + 32 * kk + 8 * fq);
    __syncthreads();
    const int t = 16 * wave + fr; const float Mt = Mv[t];
    const int stmax = wave | 1;
    for (int st = 0; st <= stmax; ++st) {
        f32x4 s4 = {0.f, 0.f, 0.f, 0.f};
#pragma unroll
        for (int kk = 0; kk < 4; ++kk) { const bf16x8 kf = ld_frag_lds(Kl + (16 * st + fr) * 272 + (32 * kk + 8 * fq) * 2); s4 = MFMA16(kf, qf[kk], s4); }
#pragma unroll
        for (int r = 0; r < 4; ++r) { const int s = 16 * st + 4 * fq + r; const float w = (s <= t) ? __expf(av[s] - Mt) : 0.f; s4[r] *= w; }
        u32x2 w; w.x = cvt_pk_bf16(s4[0], s4[1]); w.y = cvt_pk_bf16(s4[2], s4[3]);
        *(LAS u32x2*)(Sl + t * 272 + (16 * st + 4 * fq) * 2) = w;
    }
    __syncthreads();
    const bf16_t* cpt = (const bf16_t*)(p.ws + WS_CPT) + ((size_t)(bh * 64 + c) * 272) * 128;
    f32x4 acc[17];
#pragma unroll
    for (int n = 0; n < 17; ++n) {
        acc[n] = (f32x4){0.f, 0.f, 0.f, 0.f};
#pragma unroll
        for (int kk = 0; kk < 4; ++kk) { const bf16x8 cf = *(const bf16x8*)(cpt + (size_t)(16 * n + fr) * 128 + 32 * kk + 8 * fq); acc[n] = MFMA16(cf, qf[kk], acc[n]); }
    }
    const float ai = __expf(mprev - Mt);
#pragma unroll
    for (int n = 0; n < 17; ++n) acc[n] = acc[n] * ai;
    const int k2max = (16 * wave + 15) >> 5;
#pragma unroll
    for (int kk = 0; kk < 4; ++kk) {
        if (kk <= k2max) {
            const bf16x8 sf = ld_frag_lds(Sl + t * 272 + (32 * kk + 8 * fq) * 2);
#pragma unroll
            for (int n = 0; n < 17; ++n) { const bf16x8 vf = ld_frag_lds(VTe + (16 * n + fr) * 272 + (32 * kk + 8 * fq) * 2); acc[n] = MFMA16(vf, sf, acc[n]); }
        }
    }
    const float den = __shfl(acc[16][0], fr);
    const float mt = bv[t] + Mt;
    const float inv = rcpf_(fmaxf(fabsf(den), __expf(-mt)));
    const size_t grow = (size_t)(t0 + t);
    float ss = 0.f;
#pragma unroll
    for (int n = 0; n < 16; ++n) {
        const int v0 = 16 * n + 4 * fq;
        const u32x2 ow = *(const u32x2*)(P + grow * NPROJ + 4096 + h * 256 + v0);
        f32x4 y;
        y[0] = bflo(ow.x) * acc[n][0] * inv; y[1] = bfhi(ow.x) * acc[n][1] * inv; y[2] = bflo(ow.y) * acc[n][2] * inv; y[3] = bfhi(ow.y) * acc[n][3] * inv;
        ss += (y[0] * y[0] + y[1] * y[1]) + (y[2] * y[2] + y[3] * y[3]);
        acc[n] = y;
    }
    ss += __shfl_xor(ss, 16); ss += __shfl_xor(ss, 32);
    const float rstd = rsqrtf(ss * (1.f / 256.f) + EPS);
#pragma unroll
    for (int n = 0; n < 16; ++n) {
        const int v0 = 16 * n + 4 * fq;
        const f32x4 g = *(const f32x4*)(p.ml_out_g + h * 256 + v0);
        const f32x4 o = acc[n] * rstd * g;
        u32x2 w; w.x = cvt_pk_bf16(o[0], o[1]); w.y = cvt_pk_bf16(o[2], o[3]);
        *(u32x2*)(YM + grow * DM + 1024 + h * 256 + v0) = w;
    }
}

DI unsigned ord_key(float f) { const unsigned u = __float_as_uint(f); return (u & 0x80000000u) ? ~u : (u | 0x80000000u); }
DI float key_val(unsigned k) { return (k & 0x80000000u) ? __uint_as_float(k & 0x7fffffffu) : __uint_as_float(~k); }
DI unsigned umax_(unsigned a, unsigned b) { return a > b ? a : b; }
DI unsigned wave_max_u32(unsigned v) {
    v = umax_(v, (unsigned)__builtin_amdgcn_update_dpp(0, (int)v, 0xB1, 0xF, 0xF, true));
    v = umax_(v, (unsigned)__builtin_amdgcn_update_dpp(0, (int)v, 0x4E, 0xF, 0xF, true));
    v = umax_(v, (unsigned)__builtin_amdgcn_update_dpp(0, (int)v, 0x141, 0xF, 0xF, true));
    v = umax_(v, (unsigned)__builtin_amdgcn_update_dpp(0, (int)v, 0x140, 0xF, 0xF, true));
    const unsigned a = (unsigned)__builtin_amdgcn_readlane((int)v, 0), b = (unsigned)__builtin_amdgcn_readlane((int)v, 16);
    const unsigned c = (unsigned)__builtin_amdgcn_readlane((int)v, 32), d = (unsigned)__builtin_amdgcn_readlane((int)v, 48);
    return umax_(umax_(a, b), umax_(c, d));
}

DI void phase_peer(const Params& p, LAS unsigned char* lds) {
    const int tid = threadIdx.x, lane = tid & 63, wave = __builtin_amdgcn_readfirstlane(tid >> 6);
    LAS float* K1 = (LAS float*)lds; LAS float* K2 = (LAS float*)(lds + 32768);
    LAS int* sel_id = (LAS int*)(lds + 65536); LAS float* sel_cf = (LAS float*)(lds + 81920);
    LAS float* scr = (LAS float*)(lds + 98304) + wave * (16 * 68);
    const bf16_t* Q = (const bf16_t*)(p.ws + WS_Q); const bf16_t* Ub = (const bf16_t*)(p.ws + WS_UB); const bf16_t* Vb = (const bf16_t*)(p.ws + WS_VB);
    const float* PSS2 = (const float*)(p.ws + WS_PSS2);
    int ci = 0, cj = 0; bool cvalid = false;
    {
        int cnt = 0;
#pragma unroll
        for (int i = 0; i < 16; ++i) { const int nj = 16 / (i + 1); if (lane >= cnt && lane < cnt + nj) { ci = i; cj = lane - cnt; cvalid = true; } cnt += nj; }
    }
    for (int tile = blockIdx.x; tile < T_TOK / 32; tile += gridDim.x) {
        const int tok0 = tile * 32;
        for (int h = 0; h < 8; ++h) {
            __syncthreads();
            for (int idx = tid; idx < 4096; idx += NTHREADS) {
                const int which = idx >> 11, r = idx & 2047, n = r & 127, d0 = (r >> 7) * 4;
                const f32x4 v = *(const f32x4*)((which ? p.peer_k2 : p.peer_k1) + ((size_t)(h * 128 + n)) * 64 + d0);
                LAS float* K = which ? K2 : K1;
                K[(d0 + 0) * 128 + n] = v[0]; K[(d0 + 1) * 128 + n] = v[1]; K[(d0 + 2) * 128 + n] = v[2]; K[(d0 + 3) * 128 + n] = v[3];
            }
            __syncthreads();
            unsigned qv[4];
#pragma unroll
            for (int j = 0; j < 4; ++j) qv[j] = *(const unsigned*)(Q + (size_t)(tok0 + wave * 4 + j) * 1024 + h * 128 + 2 * lane);
            float s1a[4], s1b[4], s2a[4], s2b[4];
#pragma unroll
            for (int j = 0; j < 4; ++j) { s1a[j] = 0.f; s1b[j] = 0.f; s2a[j] = 0.f; s2b[j] = 0.f; }
#pragma unroll 4
            for (int dp = 0; dp < 32; ++dp) {
                const float k1a0 = K1[(2 * dp) * 128 + lane], k1b0 = K1[(2 * dp) * 128 + lane + 64], k1a1 = K1[(2 * dp + 1) * 128 + lane], k1b1 = K1[(2 * dp + 1) * 128 + lane + 64];
                const float k2a0 = K2[(2 * dp) * 128 + lane], k2b0 = K2[(2 * dp) * 128 + lane + 64], k2a1 = K2[(2 * dp + 1) * 128 + lane], k2b1 = K2[(2 * dp + 1) * 128 + lane + 64];
#pragma unroll
                for (int j = 0; j < 4; ++j) {
                    const unsigned q1 = (unsigned)__builtin_amdgcn_readlane((int)qv[j], dp), q2 = (unsigned)__builtin_amdgcn_readlane((int)qv[j], 32 + dp);
                    const float q1l = bflo(q1), q1h = bfhi(q1), q2l = bflo(q2), q2h = bfhi(q2);
                    s1a[j] += q1l * k1a0 + q1h * k1a1; s1b[j] += q1l * k1b0 + q1h * k1b1;
                    s2a[j] += q2l * k2a0 + q2h * k2a1; s2b[j] += q2l * k2b0 + q2h * k2b1;
                }
            }
#pragma unroll
            for (int j = 0; j < 4; ++j) {
                unsigned list1 = 0u, list2 = 0u;
                {
                    unsigned ka = (ord_key(s1a[j]) & ~0x7Fu) | (unsigned)(127 - lane), kb = (ord_key(s1b[j]) & ~0x7Fu) | (unsigned)(63 - lane);
                    for (int it = 0; it < 16; ++it) { const unsigned wm = wave_max_u32(umax_(ka, kb)); if (ka == wm) ka = 0u; if (kb == wm) kb = 0u; if (lane == it) list1 = wm; }
                }
                {
                    unsigned ka = (ord_key(s2a[j]) & ~0x7Fu) | (unsigned)(127 - lane), kb = (ord_key(s2b[j]) & ~0x7Fu) | (unsigned)(63 - lane);
                    for (int it = 0; it < 16; ++it) { const unsigned wm = wave_max_u32(umax_(ka, kb)); if (ka == wm) ka = 0u; if (kb == wm) kb = 0u; if (lane == it) list2 = wm; }
                }
                const unsigned k1c = (unsigned)__shfl((int)list1, ci), k2c = (unsigned)__shfl((int)list2, cj);
                const float cand = key_val(k1c & ~0x7Fu) + key_val(k2c & ~0x7Fu);
                unsigned ckey = cvalid ? ((ord_key(cand) & ~0x3Fu) | (unsigned)(63 - lane)) : 0u;
                unsigned sel = 0u;
                for (int it = 0; it < 16; ++it) { const unsigned wm = wave_max_u32(ckey); if (ckey == wm) ckey = 0u; if (lane == it) sel = wm; }
                const int pos = 63 - (int)(sel & 63u);
                const float sv = key_val(sel & ~0x3Fu);
                const unsigned e1 = (unsigned)__shfl((int)k1c, pos), e2 = (unsigned)__shfl((int)k2c, pos);
                const int eid = (127 - (int)(e1 & 127u)) * 128 + (127 - (int)(e2 & 127u));
                const float mx = __shfl(sv, 0);
                float ev = lane < 16 ? __expf(sv - mx) : 0.f;
                float sum = ev;
                sum += __shfl_xor(sum, 1); sum += __shfl_xor(sum, 2); sum += __shfl_xor(sum, 4); sum += __shfl_xor(sum, 8);
                if (lane < 16) { sel_id[(wave * 4 + j) * 128 + h * 16 + lane] = eid; sel_cf[(wave * 4 + j) * 128 + h * 16 + lane] = ev * rcpf_(sum); }
            }
        }
        WAVE_LDS_SYNC();
        for (int j = 0; j < 4; ++j) {
            const int tk = wave * 4 + j, t = tok0 + tk;
            float* xrow = p.out + (size_t)t * DM;
            const float pv = lane < 32 ? PSS2[(size_t)t * 32 + lane] : 0.f;
            const float rstd2 = rsqrtf(wave_sum(pv) * (1.f / 2048.f) + EPS);
            float h2[32];
#pragma unroll
            for (int i = 0; i < 4; ++i) {
                const f32x4 x0 = *(const f32x4*)(xrow + i * 512 + lane * 8), x1 = *(const f32x4*)(xrow + i * 512 + lane * 8 + 4);
                const f32x4 g0 = *(const f32x4*)(p.norm2_g + i * 512 + lane * 8), g1 = *(const f32x4*)(p.norm2_g + i * 512 + lane * 8 + 4);
#pragma unroll
                for (int e = 0; e < 4; ++e) { h2[i * 8 + e] = x0[e] * rstd2 * g0[e]; h2[i * 8 + 4 + e] = x1[e] * rstd2 * g1[e]; }
            }
            for (int batch = 0; batch < 8; ++batch) {
#pragma unroll 4
                for (int e = 0; e < 16; ++e) {
                    const int id = __builtin_amdgcn_readfirstlane(sel_id[tk * 128 + batch * 16 + e]);
                    const bf16_t* ur = Ub + (size_t)id * DM + lane * 8;
                    float part = 0.f;
#pragma unroll
                    for (int i = 0; i < 4; ++i) {
                        const u32x4 w = *(const u32x4*)(ur + i * 512);
                        part += h2[i * 8 + 0] * bflo(w.x) + h2[i * 8 + 1] * bfhi(w.x) + h2[i * 8 + 2] * bflo(w.y) + h2[i * 8 + 3] * bfhi(w.y)
                              + h2[i * 8 + 4] * bflo(w.z) + h2[i * 8 + 5] * bfhi(w.z) + h2[i * 8 + 6] * bflo(w.w) + h2[i * 8 + 7] * bfhi(w.w);
                    }
                    scr[e * 68 + lane] = part;
                }
                WAVE_LDS_SYNC();
                float sum = 0.f;
#pragma unroll
                for (int i = 0; i < 4; ++i) { const f32x4 r = *(const LAS f32x4*)(scr + (lane >> 2) * 68 + (lane & 3) * 16 + 4 * i); sum += (r[0] + r[1]) + (r[2] + r[3]); }
                sum += __shfl_xor(sum, 1); sum += __shfl_xor(sum, 2);
                const float act = gelu_t(sum);
                if ((lane & 3) == 0) { const int ix = tk * 128 + batch * 16 + (lane >> 2); sel_cf[ix] = sel_cf[ix] * act; }
                WAVE_LDS_SYNC();
            }
            float acc[32];
#pragma unroll
            for (int i = 0; i < 32; ++i) acc[i] = 0.f;
#pragma unroll 4
            for (int e = 0; e < 128; ++e) {
                const int id = __builtin_amdgcn_readfirstlane(sel_id[tk * 128 + e]);
                const float cf = sel_cf[tk * 128 + e];
                const bf16_t* vr = Vb + (size_t)id * DM + lane * 8;
#pragma unroll
                for (int i = 0; i < 4; ++i) {
                    const u32x4 w = *(const u32x4*)(vr + i * 512);
                    acc[i * 8 + 0] += cf * bflo(w.x); acc[i * 8 + 1] += cf * bfhi(w.x); acc[i * 8 + 2] += cf * bflo(w.y); acc[i * 8 + 3] += cf * bfhi(w.y);
                    acc[i * 8 + 4] += cf * bflo(w.z); acc[i * 8 + 5] += cf * bfhi(w.z); acc[i * 8 + 6] += cf * bflo(w.w); acc[i * 8 + 7] += cf * bfhi(w.w);
                }
            }
            float ss = 0.f;
#pragma unroll
            for (int i = 0; i < 4; ++i) {
                const f32x4 x0 = *(const f32x4*)(xrow + i * 512 + lane * 8), x1 = *(const f32x4*)(xrow + i * 512 + lane * 8 + 4);
#pragma unroll
                for (int e = 0; e < 4; ++e) { acc[i * 8 + e] += x0[e]; acc[i * 8 + 4 + e] += x1[e]; ss += acc[i * 8 + e] * acc[i * 8 + e] + acc[i * 8 + 4 + e] * acc[i * 8 + 4 + e]; }
            }
            const float rstd = rsqrtf(wave_sum(ss) * (1.f / 2048.f) + EPS);
#pragma unroll
            for (int i = 0; i < 4; ++i) {
                const f32x4 g0 = *(const f32x4*)(p.final_g + i * 512 + lane * 8), g1 = *(const f32x4*)(p.final_g + i * 512 + lane * 8 + 4);
                f32x4 o0, o1;
#pragma unroll
                for (int e = 0; e < 4; ++e) { o0[e] = acc[i * 8 + e] * rstd * g0[e]; o1[e] = acc[i * 8 + 4 + e] * rstd * g1[e]; }
                *(f32x4*)(xrow + i * 512 + lane * 8) = o0; *(f32x4*)(xrow + i * 512 + lane * 8 + 4) = o1;
            }
        }
    }
}

__global__ void __launch_bounds__(NTHREADS, 2) hymba_fwd(Params p) {
    extern __shared__ __attribute__((aligned(16))) unsigned char smem[];
    LAS unsigned char* lds = (LAS unsigned char*)smem;
    cg::grid_group grid = cg::this_grid();
    const int G = gridDim.x, bx = blockIdx.x;
    phase0(p, lds);
    grid.sync();
    {
        pg8::Gemm g{(const bf16_t*)(p.ws + WS_XN), (const bf16_t*)(p.ws + WS_WINT), T_TOK, NPROJ, DM};
        pg8::StaticOrder S; S.init(T_TOK, NPROJ, G, bx);
        Epi1 E{(bf16_t*)(p.ws + WS_P), (float*)(p.ws + WS_PSSV)};
        pg8::gemm_phase<Epi1, pg8::StaticOrder, true, true>(lds, g, S, E);
    }
    grid.sync();
    for (int si = bx; si < 256; si += G) {
        const int b = si >> 6, c = si & 63;
        gmlp_bc(p, lds, b, c);
        for (int h = 0; h < 4; ++h) mlstm_local(p, lds, b, c, h);
    }
    grid.sync();
    phase_scan(p);
    grid.sync();
    for (int it = bx; it < 1024; it += G) mlstm_out(p, lds, it >> 8, (it >> 2) & 63, it & 3);
    grid.sync();
    {
        pg8::Gemm g{(const bf16_t*)(p.ws + WS_XN), (const bf16_t*)(p.ws + WS_WOUTT), T_TOK, DM, DM};
        pg8::StaticOrder S; S.init(T_TOK, DM, G, bx);
        Epi2 E{p.x, p.out, (bf16_t*)(p.ws + WS_X1G), p.norm2_g, (float*)(p.ws + WS_PSS2)};
        pg8::gemm_phase<Epi2, pg8::StaticOrder, true, true>(lds, g, S, E);
    }
    grid.sync();
    {
        pg8::Gemm g{(const bf16_t*)(p.ws + WS_X1G), (const bf16_t*)(p.ws + WS_WQT), T_TOK, 1024, DM};
        pg8::StaticOrder S; S.init(T_TOK, 1024, G, bx);
        Epi3 E{(bf16_t*)(p.ws + WS_Q), (const float*)(p.ws + WS_PSS2)};
        pg8::gemm_phase<Epi3, pg8::StaticOrder, true, true>(lds, g, S, E);
    }
    grid.sync();
    phase_peer(p, lds);
}

extern "C" void kernel_launch(void* const* d_in, const int* in_sizes, int n_in, void* d_out, int out_size, void* d_ws, size_t ws_size, hipStream_t stream) {
    static int grid_blocks = 0;
    if (grid_blocks == 0) {
        if (n_in != 20 || ws_size < WS_END) { fprintf(stderr, "kernel_launch: unexpected n_in %d or ws_size %zu (need %zu)\n", n_in, ws_size, (size_t)WS_END); grid_blocks = -1; return; }
        int dev = 0, cus = 0, per_cu = 0;
        hipGetDevice(&dev);
        hipDeviceGetAttribute(&cus, hipDeviceAttributeMultiprocessorCount, dev);
        hipFuncSetAttribute((const void*)hymba_fwd, hipFuncAttributeMaxDynamicSharedMemorySize, LDS_BYTES);
        hipOccupancyMaxActiveBlocksPerMultiprocessor(&per_cu, (const void*)hymba_fwd, NTHREADS, LDS_BYTES);
        if (per_cu < 1) { fprintf(stderr, "kernel_launch: occupancy query says %d blocks per CU\n", per_cu); per_cu = 1; }
        if (per_cu > 1) per_cu = 1;
        grid_blocks = cus * per_cu;
        (void)hipGetLastError();
    }
    if (grid_blocks < 0) return;
    Params p{};
    p.x = (const float*)d_in[0]; p.norm1_g = (const float*)d_in[1]; p.w_in = (const float*)d_in[2]; p.gm_vnorm_g = (const float*)d_in[3];
    p.w_spatial = (const float*)d_in[4]; p.b_spatial = (const float*)d_in[5]; p.ml_conv_w = (const float*)d_in[6]; p.ml_conv_b = (const float*)d_in[7];
    p.ml_b_i = (const float*)d_in[8]; p.ml_b_f = (const float*)d_in[9]; p.gm_out_g = (const float*)d_in[10]; p.ml_out_g = (const float*)d_in[11];
    p.w_out = (const float*)d_in[12]; p.norm2_g = (const float*)d_in[13]; p.peer_wq = (const float*)d_in[14]; p.peer_k1 = (const float*)d_in[15];
    p.peer_k2 = (const float*)d_in[16]; p.peer_u = (const float*)d_in[17]; p.peer_v = (const float*)d_in[18]; p.final_g = (const float*)d_in[19];
    p.out = (float*)d_out; p.ws = (unsigned char*)d_ws;
    void* args[] = {&p};
    hipError_t e = hipLaunchCooperativeKernel((const void*)hymba_fwd, dim3(grid_blocks), dim3(NTHREADS), args, LDS_BYTES, stream);
    if (e != hipSuccess) fprintf(stderr, "cooperative launch failed: %s (grid %d)\n", hipGetErrorString(e), grid_blocks);
}
```

```cpp
#include <hip/hip_runtime.h>
#include <hip/hip_cooperative_groups.h>
#include <cstdio>
#include <cstdint>
namespace cg = cooperative_groups;
namespace pg8 {
#define PG8_LAS __attribute__((address_space(3)))
typedef unsigned short bf16_t;
typedef short bf16x8 __attribute__((ext_vector_type(8)));
typedef float f32x4 __attribute__((ext_vector_type(4)));
typedef unsigned u32x4 __attribute__((ext_vector_type(4)));
constexpr int BM = 256, BK = 64, HALF = 128, HTB = HALF * BK * 2  , STAGE_BYTES = 8 * HTB, NXCD = 8, WGM = 8;

__host__ __device__ __forceinline__ int lds_byte(int r, int c) { const int st = (r >> 4) * 2 + (c >> 5), rr = r & 15, cc = c & 31, ob = rr * 64 + cc * 2; return st * 1024 + (ob ^ (((ob >> 9) & 1) << 5)); }
__host__ __device__ __forceinline__ void stage_rc(int b, int& R, int& C) { const int st = b / 1024, sb = b % 1024, swz = sb ^ (((sb >> 9) & 1) << 5); R = (st >> 1) * 16 + swz / 64; C = (st & 1) * 32 + (swz % 64) / 2; }
__host__ __device__ __forceinline__ int perm32(int rho) { const int n = rho >> 4, i = rho & 15; return 8 * (i >> 2) + 4 * n + (i & 3); }

struct Unit { int pm, pn; };
struct Gemm { const bf16_t* A; const bf16_t* Bt; int M, N, K; };

struct StaticOrder {
    int nM, nN, nwg, G, c;
    __host__ __device__ void init(int M, int N, int G_, int c_) { nM = M / BM; nN = N / BM; nwg = nM * nN; G = G_; c = c_; }
    __host__ __device__ bool next(int i, Unit& u) const {
        const long L = (long)i * G + c; if (L >= nwg) return false;
        int wgid = (int)L; { const int q = nwg / NXCD, r = nwg % NXCD, xcd = wgid % NXCD, off = wgid / NXCD; wgid = (xcd < r ? xcd * (q + 1) : r * (q + 1) + (xcd - r) * q) + off; }
        const int nig = WGM * nN, gid = wgid / nig, fm = gid * WGM, gsz = (nM - fm) < WGM ? (nM - fm) : WGM;
        u.pm = fm + ((wgid % nig) % gsz); u.pn = (wgid % nig) / gsz; return true;
    }
    __device__ __forceinline__ void a_ready(const Unit&) const {}
    __device__ __forceinline__ void done(const Unit&) const {}
};
__device__ __forceinline__ unsigned cvt_pk_bf16(float lo, float hi) { unsigned r; asm volatile("v_cvt_pk_bf16_f32 %0, %1, %2" : "=v"(r) : "v"(lo), "v"(hi)); return r; }
template <class Epi, class Sched, bool ALIGN_EPI = false, bool SP2 = false>
__device__ __forceinline__ void gemm_phase(PG8_LAS unsigned char* lds, const Gemm g, const Sched& S, const Epi& E) {
    const int tid = threadIdx.x, wid = __builtin_amdgcn_readfirstlane(tid >> 6), lane = tid & 63, wr = wid >> 2, wc = wid & 3, fr = lane & 15, fq = lane >> 4;
    const int K = g.K, nt = K / BK;
    unsigned voffA[2], voffB[2];
#pragma unroll
    for (int i = 0; i < 2; ++i) { int R, C; stage_rc(tid * 16 + i * 8192, R, C); const int Rb = Epi::PERM ? ((R & ~31) + perm32(R & 31)) : R;
        voffA[i] = (unsigned)(R * K + C) * 2u; voffB[i] = (unsigned)(Rb * K + C) * 2u; }
    const size_t kstep = (size_t)(BK * 2);
    const size_t hstep = (size_t)HALF * K * 2;
    const size_t tstep = 2 * hstep;
    const unsigned ldsw = (unsigned)wid * 1024u;
    const int aoff = lds_byte(wr * 64 + fr, fq * 8), boff = lds_byte(wc * 32 + fr, fq * 8);
#define PG8_SA(b, h) (((b) * 2 + (h)) * HTB)
#define PG8_SB(b, h) ((4 + (b) * 2 + (h)) * HTB)
#define PG8_STAGE(bufoff, gbase, voff) do { _Pragma("unroll") for (int _i = 0; _i < 2; ++_i) \
        __builtin_amdgcn_global_load_lds((const unsigned*)((const char*)(gbase) + (voff)[_i]), (PG8_LAS unsigned*)(lds + (bufoff) + ldsw + _i * 8192), 16, 0, 0); } while (0)
#define PG8_LDA(dst, b, h) do { _Pragma("unroll") for (int m = 0; m < 4; ++m) _Pragma("unroll") for (int k = 0; k < 2; ++k) dst[m][k] = *(const PG8_LAS bf16x8*)(lds + PG8_SA(b, h) + aoff + m * 2048 + k * 1024); } while (0)
#define PG8_LDB(dst, b, h) do { _Pragma("unroll") for (int n = 0; n < 2; ++n) _Pragma("unroll") for (int k = 0; k < 2; ++k) dst[n][k] = *(const PG8_LAS bf16x8*)(lds + PG8_SB(b, h) + boff + n * 2048 + k * 1024); } while (0)
#define PG8_MMA(ai, bj, At, Bt) do { __builtin_amdgcn_s_setprio(1); _Pragma("unroll") for (int m = 0; m < 4; ++m) _Pragma("unroll") for (int n = 0; n < 2; ++n) _Pragma("unroll") for (int k = 0; k < 2; ++k) \
        acc[ai][bj][m][n] = __builtin_amdgcn_mfma_f32_16x16x32_bf16(Bt[n][k], At[m][k], acc[ai][bj][m][n], 0, 0, 0); __builtin_amdgcn_s_setprio(0); } while (0)
#define PG8_WAIT_V(n) asm volatile("s_waitcnt vmcnt(" #n ")" ::: "memory")
#define PG8_WAIT_L(n) asm volatile("s_waitcnt lgkmcnt(" #n ")" ::: "memory")
#define PG8_BAR __builtin_amdgcn_s_barrier()
#define PG8_SCHED __builtin_amdgcn_sched_barrier(0)
    Unit cur, nxt; int ui = 0;
    if (!S.next(0, cur)) return;
    f32x4 acc[2][2][4][2];
#pragma unroll
    for (int a = 0; a < 2; ++a)
#pragma unroll
        for (int b = 0; b < 2; ++b)
#pragma unroll
            for (int m = 0; m < 4; ++m)
#pragma unroll
                for (int n = 0; n < 2; ++n) acc[a][b][m][n] = (f32x4){0.f, 0.f, 0.f, 0.f};
    bf16x8 At[4][2], B0[2][2], B1[2][2];
    const char* cA = (const char*)g.A + (size_t)cur.pm * tstep; const char* cB = (const char*)g.Bt + (size_t)cur.pn * tstep;
    S.a_ready(cur);
    if constexpr (SP2) {
        PG8_STAGE(PG8_SB(0, 0), cB, voffB); PG8_STAGE(PG8_SB(0, 1), cB + hstep, voffB); PG8_STAGE(PG8_SA(0, 0), cA, voffA); PG8_STAGE(PG8_SA(0, 1), cA + hstep, voffA);
        if (wr == 1) PG8_BAR;
        PG8_WAIT_V(2); PG8_BAR;
        PG8_STAGE(PG8_SB(1, 0), cB + kstep, voffB); PG8_STAGE(PG8_SA(1, 0), cA + kstep, voffA); PG8_STAGE(PG8_SB(1, 1), cB + hstep + kstep, voffB);
        PG8_WAIT_V(6); PG8_BAR;
    } else {
        PG8_STAGE(PG8_SB(0, 0), cB, voffB); PG8_STAGE(PG8_SA(0, 0), cA, voffA); PG8_STAGE(PG8_SB(0, 1), cB + hstep, voffB); PG8_STAGE(PG8_SA(0, 1), cA + hstep, voffA);
        if (wr == 1) PG8_BAR;
        PG8_WAIT_V(4); PG8_BAR;
        PG8_STAGE(PG8_SB(1, 0), cB + kstep, voffB); PG8_STAGE(PG8_SA(1, 0), cA + kstep, voffA); PG8_STAGE(PG8_SB(1, 1), cB + hstep + kstep, voffB);
        PG8_WAIT_V(6); PG8_BAR;
    }
    for (;;) {
        const bool has_next = S.next(ui + 1, nxt);
        const char* nA = has_next ? (const char*)g.A + (size_t)nxt.pm * tstep : cA; const char* nB = has_next ? (const char*)g.Bt + (size_t)nxt.pn * tstep : cB;
        for (int t = 0; t < nt; t += 2) {
            const bool last = (t == nt - 2);
            const char* a1 = cA + (size_t)(t + 1) * kstep;
            const char* a2 = last ? nA : cA + (size_t)(t + 2) * kstep; const char* b2 = last ? nB : cB + (size_t)(t + 2) * kstep;
            const char* a3 = a2 + kstep; const char* b3 = b2 + kstep;
            if (last && has_next) S.a_ready(nxt);
            if constexpr (SP2) {
            PG8_LDB(B0, 0, 0); PG8_LDB(B1, 0, 1); PG8_SCHED; PG8_LDA(At, 0, 0); PG8_STAGE(PG8_SA(1, 1), a1 + hstep, voffA);
            PG8_WAIT_V(8); PG8_WAIT_L(0); PG8_BAR; PG8_MMA(0, 0, At, B0); PG8_MMA(0, 1, At, B1); PG8_BAR; PG8_SCHED;
            PG8_LDA(At, 0, 1); PG8_STAGE(PG8_SB(0, 0), b2, voffB); PG8_STAGE(PG8_SB(0, 1), b2 + hstep, voffB); PG8_STAGE(PG8_SA(0, 0), a2, voffA);
            PG8_WAIT_V(8); PG8_WAIT_L(0); PG8_BAR; PG8_MMA(1, 0, At, B0); PG8_MMA(1, 1, At, B1); PG8_BAR; PG8_SCHED;
            PG8_LDB(B0, 1, 0); PG8_LDB(B1, 1, 1); PG8_SCHED; PG8_LDA(At, 1, 0); PG8_STAGE(PG8_SA(0, 1), a2 + hstep, voffA);
            PG8_WAIT_V(8); PG8_WAIT_L(0); PG8_BAR; PG8_MMA(0, 0, At, B0); PG8_MMA(0, 1, At, B1); PG8_BAR; PG8_SCHED;
            PG8_LDA(At, 1, 1); PG8_STAGE(PG8_SB(1, 0), b3, voffB); PG8_STAGE(PG8_SB(1, 1), b3 + hstep, voffB); PG8_STAGE(PG8_SA(1, 0), a3, voffA);
            PG8_WAIT_V(8); PG8_WAIT_L(0); PG8_BAR; PG8_MMA(1, 0, At, B0); PG8_MMA(1, 1, At, B1); PG8_BAR; PG8_SCHED;
            } else {
            PG8_LDB(B0, 0, 0); PG8_SCHED; PG8_LDA(At, 0, 0); PG8_STAGE(PG8_SA(1, 1), a1 + hstep, voffA);
            PG8_WAIT_L(8); PG8_BAR; PG8_WAIT_L(0); PG8_MMA(0, 0, At, B0); PG8_BAR; PG8_SCHED;
            PG8_LDB(B1, 0, 1); PG8_STAGE(PG8_SB(0, 0), b2, voffB);
            PG8_BAR; PG8_WAIT_L(0); PG8_MMA(0, 1, At, B1); PG8_BAR;
            PG8_LDA(At, 0, 1); PG8_STAGE(PG8_SA(0, 0), a2, voffA);
            PG8_BAR; PG8_WAIT_L(0); PG8_MMA(1, 0, At, B0); PG8_BAR; PG8_SCHED;
            PG8_STAGE(PG8_SB(0, 1), b2 + hstep, voffB);
            PG8_WAIT_V(6); PG8_BAR; PG8_MMA(1, 1, At, B1); PG8_BAR;
            PG8_LDB(B0, 1, 0); PG8_SCHED; PG8_LDA(At, 1, 0); PG8_STAGE(PG8_SA(0, 1), a2 + hstep, voffA);
            PG8_WAIT_L(8); PG8_BAR; PG8_WAIT_L(0); PG8_MMA(0, 0, At, B0); PG8_BAR; PG8_SCHED;
            PG8_LDB(B1, 1, 1); PG8_STAGE(PG8_SB(1, 0), b3, voffB);
            PG8_BAR; PG8_WAIT_L(0); PG8_MMA(0, 1, At, B1); PG8_BAR;
            PG8_LDA(At, 1, 1); PG8_STAGE(PG8_SA(1, 0), a3, voffA);
            PG8_BAR; PG8_WAIT_L(0); PG8_MMA(1, 0, At, B0); PG8_BAR; PG8_SCHED;
            PG8_STAGE(PG8_SB(1, 1), b3 + hstep, voffB);
            PG8_WAIT_V(6); PG8_BAR; PG8_MMA(1, 1, At, B1); PG8_BAR;
            }
        }
        if constexpr (ALIGN_EPI) { if (wr == 0) PG8_BAR; }
        if constexpr (!Epi::AFTER_DRAIN) { E(acc, cur, wr, wc, fr, fq); S.done(cur); }
        if (!has_next) break;
#pragma unroll
        for (int a = 0; a < 2; ++a)
#pragma unroll
            for (int b = 0; b < 2; ++b)
#pragma unroll
                for (int m = 0; m < 4; ++m)
#pragma unroll
                    for (int n = 0; n < 2; ++n) acc[a][b][m][n] = (f32x4){0.f, 0.f, 0.f, 0.f};
        cur = nxt; cA = nA; cB = nB; ++ui;
        if constexpr (ALIGN_EPI) { if (wr == 1) PG8_BAR; }
    }
    PG8_WAIT_V(0);
    if constexpr (!ALIGN_EPI) { if (wr == 0) PG8_BAR; }
    PG8_BAR;
    if constexpr (Epi::AFTER_DRAIN) { E.fused(acc, cur, wr, wc, fr, fq, lds, wid, lane); S.done(cur); }
#undef PG8_SA
#undef PG8_SB
#undef PG8_STAGE
#undef PG8_LDA
#undef PG8_LDB
#undef PG8_MMA
#undef PG8_WAIT_V
#undef PG8_WAIT_L
#undef PG8_BAR
#undef PG8_SCHED
}
}

#define LAS __attribute__((address_space(3)))
#define DI __device__ __forceinline__
using pg8::bf16_t; using pg8::bf16x8; using pg8::f32x4; using pg8::u32x4; using pg8::cvt_pk_bf16;
typedef unsigned u32x2 __attribute__((ext_vector_type(2)));
typedef float f32x2 __attribute__((ext_vector_type(2)));

constexpr int T_TOK = 32768, DM = 2048, NPROJ = 5120, PROJW = 5128;
constexpr int NTHREADS = 512;
constexpr int LDS_BYTES = 147456;
constexpr float EPS = 1e-6f;

constexpr size_t WS_XN = 0;
constexpr size_t WS_P = 134217728;
constexpr size_t WS_X1G = WS_P;
constexpr size_t WS_Q = WS_P + 134217728;
constexpr size_t WS_WINT = WS_P + 335544320;
constexpr size_t WS_WOUTT = WS_WINT + 20971520;
constexpr size_t WS_WQT = WS_WOUTT + 8388608;
constexpr size_t WS_UB = WS_WQT + 4194304;
constexpr size_t WS_VB = WS_UB + 67108864;
constexpr size_t WS_ST = WS_VB + 67108864;
constexpr size_t WS_CPT = WS_ST + 142606336;
constexpr size_t WS_QC = WS_CPT + 71303168;
constexpr size_t WS_KC = WS_QC + 33554432;
constexpr size_t WS_IG = WS_KC + 33554432;
constexpr size_t WS_LF = WS_IG + 524288;
constexpr size_t WS_PSSV = WS_LF + 524288;
constexpr size_t WS_PSS2 = WS_PSSV + 2097152;
constexpr size_t WS_BEND = WS_PSS2 + 4194304;
constexpr size_t WS_GMAX = WS_BEND + 4096;
constexpr size_t WS_MPREV = WS_GMAX + 4096;
constexpr size_t WS_END = WS_MPREV + 4096;

struct Params {
    const float *x, *norm1_g, *w_in, *gm_vnorm_g, *w_spatial, *b_spatial, *ml_conv_w, *ml_conv_b, *ml_b_i, *ml_b_f, *gm_out_g, *ml_out_g, *w_out, *norm2_g,
        *peer_wq, *peer_k1, *peer_k2, *peer_u, *peer_v, *final_g;
    float* out;
    unsigned char* ws;
};

DI float bf2f(unsigned short h) { return __uint_as_float(((unsigned)h) << 16); }
DI float bflo(unsigned w) { return __uint_as_float(w << 16); }
DI float bfhi(unsigned w) { return __uint_as_float(w & 0xffff0000u); }
DI float rcpf_(float x) { return __builtin_amdgcn_rcpf(x); }
DI float sigmoid_(float x) { return rcpf_(1.f + __expf(-x)); }
DI float gelu_t(float x) { const float z = 1.5957691216057308f * (x + 0.044715f * x * x * x); return x * rcpf_(1.f + __expf(-z)); }
DI float wave_sum(float v) {
#pragma unroll
    for (int o = 32; o; o >>= 1) v += __shfl_xor(v, o);
    return v;
}
DI float wave_max(float v) {
#pragma unroll
    for (int o = 32; o; o >>= 1) v = fmaxf(v, __shfl_xor(v, o));
    return v;
}
DI bf16x8 ld_frag_lds(const LAS unsigned char* p) { return *(const LAS bf16x8*)p; }
#define MFMA16(a, b, c) __builtin_amdgcn_mfma_f32_16x16x32_bf16((a), (b), (c), 0, 0, 0)

struct Epi1 {
    static constexpr bool PERM = true, AFTER_DRAIN = false;
    bf16_t* P; float* pssv;
    DI void operator()(const f32x4 (&acc)[2][2][4][2], const pg8::Unit& u, int wr, int wc, int fr, int fq) const {
        const int row0 = u.pm * 256 + wr * 64 + fr, col0 = u.pn * 256 + wc * 32 + 8 * fq;
        const int mode = u.pn < 8 ? 1 : (u.pn >= 16 ? 2 : 0);
        const bool want_ss = (u.pn >= 4 && u.pn < 8);
#pragma unroll
        for (int ai = 0; ai < 2; ++ai)
#pragma unroll
            for (int m = 0; m < 4; ++m) {
                const int row = row0 + ai * 128 + m * 16;
                bf16_t* rowp = P + (size_t)row * NPROJ + col0;
                float ss = 0.f;
#pragma unroll
                for (int bj = 0; bj < 2; ++bj) {
                    f32x4 v0 = acc[ai][bj][m][0], v1 = acc[ai][bj][m][1];
                    if (mode == 1) {
#pragma unroll
                        for (int j = 0; j < 4; ++j) { v0[j] = gelu_t(v0[j]); v1[j] = gelu_t(v1[j]); ss += v0[j] * v0[j] + v1[j] * v1[j]; }
                    } else if (mode == 2) {
#pragma unroll
                        for (int j = 0; j < 4; ++j) { v0[j] = sigmoid_(v0[j]); v1[j] = sigmoid_(v1[j]); }
                    }
                    u32x4 w; w.x = cvt_pk_bf16(v0[0], v0[1]); w.y = cvt_pk_bf16(v0[2], v0[3]); w.z = cvt_pk_bf16(v1[0], v1[1]); w.w = cvt_pk_bf16(v1[2], v1[3]);
                    *(u32x4*)(rowp + bj * 128) = w;
                }
                if (want_ss) {
                    ss += __shfl_xor(ss, 16); ss += __shfl_xor(ss, 32);
                    if (fq == 0) pssv[(size_t)row * 16 + (u.pn - 4) * 4 + wc] = ss;
                }
            }
    }
};

struct Epi2 {
    static constexpr bool PERM = true, AFTER_DRAIN = false;
    const float* x; float* x1; bf16_t* x1g; const float* g2; float* pss2;
    DI void operator()(const f32x4 (&acc)[2][2][4][2], const pg8::Unit& u, int wr, int wc, int fr, int fq) const {
        const int row0 = u.pm * 256 + wr * 64 + fr, col0 = u.pn * 256 + wc * 32 + 8 * fq;
#pragma unroll
        for (int ai = 0; ai < 2; ++ai)
#pragma unroll
            for (int m = 0; m < 4; ++m) {
                const int row = row0 + ai * 128 + m * 16;
                float ss = 0.f;
#pragma unroll
                for (int bj = 0; bj < 2; ++bj) {
                    const size_t o = (size_t)row * DM + col0 + bj * 128;
                    f32x4 v0 = acc[ai][bj][m][0] + *(const f32x4*)(x + o), v1 = acc[ai][bj][m][1] + *(const f32x4*)(x + o + 4);
                    *(f32x4*)(x1 + o) = v0; *(f32x4*)(x1 + o + 4) = v1;
                    const f32x4 ga = *(const f32x4*)(g2 + col0 + bj * 128), gb = *(const f32x4*)(g2 + col0 + bj * 128 + 4);
#pragma unroll
                    for (int j = 0; j < 4; ++j) ss += v0[j] * v0[j] + v1[j] * v1[j];
                    v0 = v0 * ga; v1 = v1 * gb;
                    u32x4 w; w.x = cvt_pk_bf16(v0[0], v0[1]); w.y = cvt_pk_bf16(v0[2], v0[3]); w.z = cvt_pk_bf16(v1[0], v1[1]); w.w = cvt_pk_bf16(v1[2], v1[3]);
                    *(u32x4*)(x1g + o) = w;
                }
                ss += __shfl_xor(ss, 16); ss += __shfl_xor(ss, 32);
                if (fq == 0) pss2[(size_t)row * 32 + u.pn * 4 + wc] = ss;
            }
    }
};

struct Epi3 {
    static constexpr bool PERM = true, AFTER_DRAIN = false;
    bf16_t* Q; const float* pss2;
    DI void operator()(const f32x4 (&acc)[2][2][4][2], const pg8::Unit& u, int wr, int wc, int fr, int fq) const {
        const int row0 = u.pm * 256 + wr * 64 + fr, col0 = u.pn * 256 + wc * 32 + 8 * fq;
#pragma unroll
        for (int ai = 0; ai < 2; ++ai)
#pragma unroll
            for (int m = 0; m < 4; ++m) {
                const int row = row0 + ai * 128 + m * 16;
                float ss = 0.f;
#pragma unroll
                for (int i = 0; i < 8; ++i) { const f32x4 t = *(const f32x4*)(pss2 + (size_t)row * 32 + i * 4); ss += (t[0] + t[1]) + (t[2] + t[3]); }
                const float rstd = rsqrtf(ss * (1.f / 2048.f) + EPS);
#pragma unroll
                for (int bj = 0; bj < 2; ++bj) {
                    const f32x4 v0 = acc[ai][bj][m][0] * rstd, v1 = acc[ai][bj][m][1] * rstd;
                    u32x4 w; w.x = cvt_pk_bf16(v0[0], v0[1]); w.y = cvt_pk_bf16(v0[2], v0[3]); w.z = cvt_pk_bf16(v1[0], v1[1]); w.w = cvt_pk_bf16(v1[2], v1[3]);
                    *(u32x4*)(Q + (size_t)row * 1024 + col0 + bj * 128) = w;
                }
            }
    }
};

DI void phase0(const Params& p, LAS unsigned char* lds) {
    const int tid = threadIdx.x, lane = tid & 63, wave = tid >> 6;
    bf16_t* XN = (bf16_t*)(p.ws + WS_XN);
    {
        LAS float* scr = (LAS float*)lds + wave * (64 * 65);
        const int gw = blockIdx.x * 8 + wave, nw = gridDim.x * 8;
        for (int it = gw; it < 4096; it += nw) {
            const float* W; bf16_t* WT; int ldw, kt, nt;
            if (it < 2560) { W = p.w_in; WT = (bf16_t*)(p.ws + WS_WINT); ldw = PROJW; kt = it / 80; nt = it % 80; }
            else if (it < 3584) { const int j = it - 2560; W = p.w_out; WT = (bf16_t*)(p.ws + WS_WOUTT); ldw = 2048; kt = j >> 5; nt = j & 31; }
            else { const int j = it - 3584; W = p.peer_wq; WT = (bf16_t*)(p.ws + WS_WQT); ldw = 1024; kt = j >> 4; nt = j & 15; }
            const int k0 = kt * 64, n0 = nt * 64;
#pragma unroll 8
            for (int r = 0; r < 64; ++r) scr[r * 65 + lane] = W[(size_t)(k0 + r) * ldw + n0 + lane];
            __builtin_amdgcn_fence(__ATOMIC_RELEASE, "wavefront"); __builtin_amdgcn_wave_barrier(); __builtin_amdgcn_fence(__ATOMIC_ACQUIRE, "wavefront");
            const int half = lane >> 5, kk = (lane & 31) * 2;
#pragma unroll 8
            for (int nn = 0; nn < 32; ++nn) {
                const int n = 2 * nn + half; const float a = scr[kk * 65 + n], b = scr[(kk + 1) * 65 + n];
                *(unsigned*)(WT + (size_t)(n0 + n) * 2048 + k0 + kk) = cvt_pk_bf16(a, b);
            }
            __builtin_amdgcn_fence(__ATOMIC_RELEASE, "wavefront"); __builtin_amdgcn_wave_barrier(); __builtin_amdgcn_fence(__ATOMIC_ACQUIRE, "wavefront");
        }
    }
    __syncthreads();
    {
        LAS float* wg = (LAS float*)lds;
        for (int idx = tid; idx < 4096; idx += NTHREADS) {
            const int k = idx >> 1, hf = idx & 1;
            const f32x4 v = *(const f32x4*)(p.w_in + (size_t)k * PROJW + 5120 + hf * 4);
            *(LAS f32x4*)(wg + k * 8 + (k >> 3) * 4 + hf * 4) = v;
        }
        __syncthreads();
        float* IG = (float*)(p.ws + WS_IG); float* LF = (float*)(p.ws + WS_LF);
        for (int row = blockIdx.x * 8 + wave; row < T_TOK; row += gridDim.x * 8) {
            const float* xr = p.x + (size_t)row * DM;
            f32x4 xv[8]; float ss = 0.f;
#pragma unroll
            for (int i = 0; i < 4; ++i) { xv[2 * i] = *(const f32x4*)(xr + i * 512 + lane * 8); xv[2 * i + 1] = *(const f32x4*)(xr + i * 512 + lane * 8 + 4); }
#pragma unroll
            for (int i = 0; i < 8; ++i) ss += (xv[i][0] * xv[i][0] + xv[i][1] * xv[i][1]) + (xv[i][2] * xv[i][2] + xv[i][3] * xv[i][3]);
            ss = wave_sum(ss);
            const float rstd = rsqrtf(ss * (1.f / 2048.f) + EPS);
            f32x4 ga = {0.f, 0.f, 0.f, 0.f}, gb = {0.f, 0.f, 0.f, 0.f};
#pragma unroll
            for (int i = 0; i < 4; ++i) {
                const f32x4 g0 = *(const f32x4*)(p.norm1_g + i * 512 + lane * 8), g1 = *(const f32x4*)(p.norm1_g + i * 512 + lane * 8 + 4);
                const f32x4 h0 = xv[2 * i] * rstd * g0, h1 = xv[2 * i + 1] * rstd * g1;
                u32x4 w; w.x = cvt_pk_bf16(h0[0], h0[1]); w.y = cvt_pk_bf16(h0[2], h0[3]); w.z = cvt_pk_bf16(h1[0], h1[1]); w.w = cvt_pk_bf16(h1[2], h1[3]);
                *(u32x4*)(XN + (size_t)row * DM + i * 512 + lane * 8) = w;
                const LAS float* wb = wg + (i * 512 + lane * 8) * 8 + (i * 64 + lane) * 4;
#pragma unroll
                for (int e = 0; e < 8; ++e) {
                    const float hv = e < 4 ? h0[e & 3] : h1[e & 3];
                    const f32x4 w0 = *(const LAS f32x4*)(wb + e * 8), w1 = *(const LAS f32x4*)(wb + e * 8 + 4);
                    ga = ga + w0 * hv; gb = gb + w1 * hv;
                }
            }
            float zi = 0.f;
#pragma unroll
            for (int j = 0; j < 4; ++j) { const float a = wave_sum(ga[j]), b = wave_sum(gb[j]); zi = (lane == j) ? a : zi; zi = (lane == 4 + j) ? b : zi; }
            if (lane < 4) IG[(size_t)row * 4 + lane] = zi + p.ml_b_i[lane];
            else if (lane < 8) { const float z = zi + p.ml_b_f[lane - 4]; LF[(size_t)row * 4 + lane - 4] = fminf(z, 0.f) - log1pf(__expf(-fabsf(z))); }
        }
    }
    {
        unsigned char* Ub = p.ws + WS_UB; unsigned char* Vb = p.ws + WS_VB;
        const size_t n16 = (size_t)16384 * 2048 / 16;
        for (size_t i = (size_t)blockIdx.x * NTHREADS + tid; i < n16; i += (size_t)gridDim.x * NTHREADS) {
            u32x4 wu, wv;
#pragma unroll
            for (int q = 0; q < 4; ++q) {
                const f32x4 a = *(const f32x4*)(p.peer_u + i * 16 + q * 4) * 64.f, b = *(const f32x4*)(p.peer_v + i * 16 + q * 4) * 16.f;
                int r = 0; r = __builtin_amdgcn_cvt_pk_fp8_f32(a[0], a[1], r, false); r = __builtin_amdgcn_cvt_pk_fp8_f32(a[2], a[3], r, true); wu[q] = (unsigned)r;
                int s = 0; s = __builtin_amdgcn_cvt_pk_fp8_f32(b[0], b[1], s, false); s = __builtin_amdgcn_cvt_pk_fp8_f32(b[2], b[3], s, true); wv[q] = (unsigned)s;
            }
            *(u32x4*)(Ub + i * 16) = wu; *(u32x4*)(Vb + i * 16) = wv;
        }
    }
}

#define WAVE_LDS_SYNC() do { __builtin_amdgcn_fence(__ATOMIC_RELEASE, "wavefront"); __builtin_amdgcn_wave_barrier(); __builtin_amdgcn_fence(__ATOMIC_ACQUIRE, "wavefront"); } while (0)

DI void stage_T(const bf16_t* src, int ld, int ngroups, LAS unsigned char* dst, int wave, int lane) {
    for (int g = wave; g < ngroups; g += 8) {
        const u32x4 r0 = *(const u32x4*)(src + (size_t)(2 * lane) * ld + g * 8);
        const u32x4 r1 = *(const u32x4*)(src + (size_t)(2 * lane + 1) * ld + g * 8);
#pragma unroll
        for (int w = 0; w < 4; ++w) {
            const unsigned a = r0[w], b = r1[w];
            *(LAS unsigned*)(dst + (g * 8 + 2 * w) * 272 + lane * 4) = (a & 0xffffu) | (b << 16);
            *(LAS unsigned*)(dst + (g * 8 + 2 * w + 1) * 272 + lane * 4) = (a >> 16) | (b & 0xffff0000u);
        }
    }
}

DI void gmlp_bc(const Params& p, LAS unsigned char* lds, int b, int c) {
    const int tid = threadIdx.x, lane = tid & 63, wave = __builtin_amdgcn_readfirstlane(tid >> 6), fr = lane & 15, fq = lane >> 4;
    const int t0 = b * 8192 + c * 128;
    LAS unsigned char* Wl = lds; LAS unsigned char* GvT = lds + 34816; LAS float* rstdv = (LAS float*)(lds + 69632);
    const bf16_t* P = (const bf16_t*)(p.ws + WS_P); bf16_t* YM = (bf16_t*)(p.ws + WS_XN);
    const float* PSSV = (const float*)(p.ws + WS_PSSV);
    __syncthreads();
    if (tid < 128) {
        float ss = 0.f;
#pragma unroll
        for (int i = 0; i < 4; ++i) { const f32x4 v = *(const f32x4*)(PSSV + (size_t)(t0 + tid) * 16 + i * 4); ss += (v[0] + v[1]) + (v[2] + v[3]); }
        rstdv[tid] = rsqrtf(ss * (1.f / 1024.f) + EPS);
    }
    for (int h = 0; h < 8; ++h) {
        __syncthreads();
#pragma unroll
        for (int it = 0; it < 4; ++it) {
            const int e = (it * NTHREADS + tid) * 8, t = e >> 7, s0 = e & 127;
            const float* wp = p.w_spatial + ((size_t)(h * 128 + t)) * 128 + s0;
            const f32x4 a0 = *(const f32x4*)wp, a1 = *(const f32x4*)(wp + 4);
            float v[8];
#pragma unroll
            for (int j = 0; j < 8; ++j) { const float a = j < 4 ? a0[j & 3] : a1[j & 3]; v[j] = (s0 + j <= t) ? a * rstdv[s0 + j] : 0.f; }
            u32x4 w; w.x = cvt_pk_bf16(v[0], v[1]); w.y = cvt_pk_bf16(v[2], v[3]); w.z = cvt_pk_bf16(v[4], v[5]); w.w = cvt_pk_bf16(v[6], v[7]);
            *(LAS u32x4*)(Wl + t * 272 + s0 * 2) = w;
        }
        stage_T(P + (size_t)t0 * NPROJ + 1024 + h * 128, NPROJ, 16, GvT, wave, lane);
        __syncthreads();
        f32x4 acc[8];
#pragma unroll
        for (int n = 0; n < 8; ++n) acc[n] = (f32x4){0.f, 0.f, 0.f, 0.f};
        const int kmax = (16 * wave + 15) >> 5;
#pragma unroll
        for (int kk = 0; kk < 4; ++kk) {
            if (kk <= kmax) {
                const bf16x8 bfrag = ld_frag_lds(Wl + (16 * wave + fr) * 272 + (32 * kk + 8 * fq) * 2);
#pragma unroll
                for (int n = 0; n < 8; ++n) { const bf16x8 afrag = ld_frag_lds(GvT + (16 * n + fr) * 272 + (32 * kk + 8 * fq) * 2); acc[n] = MFMA16(afrag, bfrag, acc[n]); }
            }
        }
        const int t = 16 * wave + fr; const size_t grow = (size_t)(t0 + t);
        const float bsp = p.b_spatial[h * 128 + t];
        float ss = 0.f;
#pragma unroll
        for (int n = 0; n < 8; ++n) {
            const int d0 = 16 * n + 4 * fq;
            const u32x2 uw = *(const u32x2*)(P + grow * NPROJ + h * 128 + d0);
            const f32x4 gv = *(const f32x4*)(p.gm_vnorm_g + h * 128 + d0);
            f32x4 y;
            y[0] = bflo(uw.x) * (gv[0] * acc[n][0] + bsp); y[1] = bfhi(uw.x) * (gv[1] * acc[n][1] + bsp);
            y[2] = bflo(uw.y) * (gv[2] * acc[n][2] + bsp); y[3] = bfhi(uw.y) * (gv[3] * acc[n][3] + bsp);
            ss += (y[0] * y[0] + y[1] * y[1]) + (y[2] * y[2] + y[3] * y[3]);
            acc[n] = y;
        }
        ss += __shfl_xor(ss, 16); ss += __shfl_xor(ss, 32);
        const float rstd = rsqrtf(ss * (1.f / 128.f) + EPS);
#pragma unroll
        for (int n = 0; n < 8; ++n) {
            const int d0 = 16 * n + 4 * fq;
            const f32x4 g = *(const f32x4*)(p.gm_out_g + h * 128 + d0);
            const f32x4 o = acc[n] * rstd * g;
            u32x2 w; w.x = cvt_pk_bf16(o[0], o[1]); w.y = cvt_pk_bf16(o[2], o[3]);
            *(u32x2*)(YM + grow * DM + h * 128 + d0) = w;
        }
    }
}

DI void mlstm_local(const Params& p, LAS unsigned char* lds, int b, int c, int h) {
    const int tid = threadIdx.x, lane = tid & 63, wave = __builtin_amdgcn_readfirstlane(tid >> 6), fr = lane & 15, fq = lane >> 4;
    const int bh = b * 4 + h, t0 = b * 8192 + c * 128;
    LAS unsigned char* KT = lds; LAS unsigned char* VT = lds + 34816; LAS float* wsv = (LAS float*)(lds + 108800);
    const bf16_t* P = (const bf16_t*)(p.ws + WS_P);
    bf16_t* QC = (bf16_t*)(p.ws + WS_QC); bf16_t* KC = (bf16_t*)(p.ws + WS_KC);
    const float* IG = (const float*)(p.ws + WS_IG); const float* LF = (const float*)(p.ws + WS_LF);
    __syncthreads();
    if (wave == 0) {
        const float l0 = LF[(size_t)(t0 + 2 * lane) * 4 + h], l1 = LF[(size_t)(t0 + 2 * lane + 1) * 4 + h];
        const float i0 = IG[(size_t)(t0 + 2 * lane) * 4 + h], i1 = IG[(size_t)(t0 + 2 * lane + 1) * 4 + h];
        float s = l0 + l1;
#pragma unroll
        for (int off = 1; off < 64; off <<= 1) { const float tt = __shfl_up(s, off); if (lane >= off) s += tt; }
        const float b1 = s, b0 = s - l1, bend = __shfl(s, 63);
        const float g0 = bend - b0 + i0, g1 = bend - b1 + i1;
        const float gmax = wave_max(fmaxf(g0, g1));
        wsv[2 * lane] = __expf(g0 - gmax); wsv[2 * lane + 1] = __expf(g1 - gmax);
        if (lane == 0) { ((float*)(p.ws + WS_BEND))[bh * 64 + c] = bend; ((float*)(p.ws + WS_GMAX))[bh * 64 + c] = gmax; }
    }
    __syncthreads();
    for (int g = wave; g < 32; g += 8) {
        const bool isk = g >= 16; const int cgp = (g & 15) * 8;
        const int ch = (isk ? 512 : 0) + h * 128 + cgp;
        const bf16_t* src = P + (isk ? 2560 : 2048) + h * 128 + cgp;
        const int s = 2 * lane;
        float xr[5][8];
#pragma unroll
        for (int dj = 0; dj < 5; ++dj) {
            const int srow = s - 3 + dj;
            u32x4 w = {0u, 0u, 0u, 0u};
            if (c > 0 || srow >= 0) w = *(const u32x4*)(src + (size_t)((long)t0 + srow) * NPROJ);
#pragma unroll
            for (int q = 0; q < 4; ++q) { xr[dj][2 * q] = bflo(w[q]); xr[dj][2 * q + 1] = bfhi(w[q]); }
        }
        float y0[8], y1[8];
        {
            const f32x4 cb0 = *(const f32x4*)(p.ml_conv_b + ch), cb1 = *(const f32x4*)(p.ml_conv_b + ch + 4);
#pragma unroll
            for (int e = 0; e < 8; ++e) { y0[e] = e < 4 ? cb0[e & 3] : cb1[e & 3]; y1[e] = y0[e]; }
#pragma unroll
            for (int j = 0; j < 4; ++j) {
                const f32x4 w0 = *(const f32x4*)(p.ml_conv_w + j * 1024 + ch), w1 = *(const f32x4*)(p.ml_conv_w + j * 1024 + ch + 4);
#pragma unroll
                for (int e = 0; e < 8; ++e) { const float wv = e < 4 ? w0[e & 3] : w1[e & 3]; y0[e] += wv * xr[j][e]; y1[e] += wv * xr[j + 1][e]; }
            }
        }
        const float sc = isk ? 0.08838834764831845f : 1.f;
#pragma unroll
        for (int e = 0; e < 8; ++e) { y0[e] = y0[e] * sigmoid_(y0[e]) * sc; y1[e] = y1[e] * sigmoid_(y1[e]) * sc; }
        bf16_t* dst = (isk ? KC : QC) + (size_t)(t0 + s) * 512 + h * 128 + cgp;
        u32x4 w; w.x = cvt_pk_bf16(y0[0], y0[1]); w.y = cvt_pk_bf16(y0[2], y0[3]); w.z = cvt_pk_bf16(y0[4], y0[5]); w.w = cvt_pk_bf16(y0[6], y0[7]);
        *(u32x4*)dst = w;
        w.x = cvt_pk_bf16(y1[0], y1[1]); w.y = cvt_pk_bf16(y1[2], y1[3]); w.z = cvt_pk_bf16(y1[4], y1[5]); w.w = cvt_pk_bf16(y1[6], y1[7]);
        *(u32x4*)(dst + 512) = w;
        if (isk) {
            const float w0 = wsv[s], w1 = wsv[s + 1];
#pragma unroll
            for (int e = 0; e < 8; ++e) *(LAS unsigned*)(KT + (cgp + e) * 272 + lane * 4) = cvt_pk_bf16(y0[e] * w0, y1[e] * w1);
        }
    }
    stage_T(P + (size_t)t0 * NPROJ + 3072 + h * 256, NPROJ, 32, VT, wave, lane);
    for (int i = tid; i < 1024; i += NTHREADS) { const int r = i >> 6, w = i & 63; *(LAS unsigned*)(VT + (256 + r) * 272 + w * 4) = 0x3F803F80u; }
    __syncthreads();
    bf16x8 af[4];
#pragma unroll
    for (int kk = 0; kk < 4; ++kk) af[kk] = ld_frag_lds(KT + (16 * wave + fr) * 272 + (32 * kk + 8 * fq) * 2);
    float* ST = (float*)(p.ws + WS_ST) + ((size_t)(bh * 64 + c) * 272) * 128;
#pragma unroll
    for (int n = 0; n < 17; ++n) {
        f32x4 acc = {0.f, 0.f, 0.f, 0.f};
#pragma unroll
        for (int kk = 0; kk < 4; ++kk) { const bf16x8 bfr = ld_frag_lds(VT + (16 * n + fr) * 272 + (32 * kk + 8 * fq) * 2); acc = MFMA16(af[kk], bfr, acc); }
        if (n < 16 || fr == 0) *(f32x4*)(ST + (size_t)(16 * n + fr) * 128 + 16 * wave + 4 * fq) = acc;
    }
}

DI void phase_scan(const Params& p) {
    const float* ST = (const float*)(p.ws + WS_ST); bf16_t* CPT = (bf16_t*)(p.ws + WS_CPT);
    const float* BEND = (const float*)(p.ws + WS_BEND); const float* GMAX = (const float*)(p.ws + WS_GMAX); float* MPREV = (float*)(p.ws + WS_MPREV);
    const int gtid = blockIdx.x * NTHREADS + threadIdx.x, nthr = gridDim.x * NTHREADS;
    constexpr int PER = 8224;
    constexpr size_t CST = 272 * 128;
    for (int item = gtid; item < 16 * PER; item += nthr) {
        const int bh = item / PER, e4 = item - bh * PER;
        const float* src = ST + (size_t)bh * 64 * CST + (size_t)e4 * 4;
        bf16_t* dst = CPT + (size_t)bh * 64 * CST + (size_t)e4 * 4;
        f32x4 st = {0.f, 0.f, 0.f, 0.f}; float m = 0.f;
        for (int c0 = 0; c0 < 64; c0 += 8) {
            f32x4 d[8];
#pragma unroll
            for (int j = 0; j < 8; ++j) d[j] = *(const f32x4*)(src + (size_t)(c0 + j) * CST);
#pragma unroll
            for (int j = 0; j < 8; ++j) {
                const int c = c0 + j;
                const float be = BEND[bh * 64 + c], gm = GMAX[bh * 64 + c];
                const float mn = fmaxf(be + m, gm), a = __expf(be + m - mn), sc = __expf(gm - mn);
                u32x2 w; w.x = cvt_pk_bf16(st[0], st[1]); w.y = cvt_pk_bf16(st[2], st[3]);
                *(u32x2*)(dst + (size_t)c * CST) = w;
                if (e4 == 0) MPREV[bh * 64 + c] = m;
                st = st * a + d[j] * sc; m = mn;
            }
        }
    }
}

DI void mlstm_out(const Params& p, LAS unsigned char* lds, int b, int c, int h) {
    const int tid = threadIdx.x, lane = tid & 63, wave = __builtin_amdgcn_readfirstlane(tid >> 6), fr = lane & 15, fq = lane >> 4;
    const int bh = b * 4 + h, t0 = b * 8192 + c * 128;
    LAS unsigned char* Kl = lds; LAS unsigned char* Sl = lds + 34816; LAS unsigned char* VTe = lds + 69632;
    LAS float* av = (LAS float*)(lds + 143616); LAS float* Mv = (LAS float*)(lds + 144128); LAS float* bv = (LAS float*)(lds + 144640);
    const bf16_t* P = (const bf16_t*)(p.ws + WS_P); bf16_t* YM = (bf16_t*)(p.ws + WS_XN);
    const bf16_t* QC = (const bf16_t*)(p.ws + WS_QC); const bf16_t* KC = (const bf16_t*)(p.ws + WS_KC);
    const float* IG = (const float*)(p.ws + WS_IG); const float* LF = (const float*)(p.ws + WS_LF);
    const float mprev = ((const float*)(p.ws + WS_MPREV))[bh * 64 + c];
    __syncthreads();
    if (wave == 0) {
        const float l0 = LF[(size_t)(t0 + 2 * lane) * 4 + h], l1 = LF[(size_t)(t0 + 2 * lane + 1) * 4 + h];
        const float i0 = IG[(size_t)(t0 + 2 * lane) * 4 + h], i1 = IG[(size_t)(t0 + 2 * lane + 1) * 4 + h];
        float s = l0 + l1;
#pragma unroll
        for (int off = 1; off < 64; off <<= 1) { const float tt = __shfl_up(s, off); if (lane >= off) s += tt; }
        const float b1 = s, b0 = s - l1;
        const float a0 = i0 - b0, a1 = i1 - b1;
        float pm = fmaxf(a0, a1);
#pragma unroll
        for (int off = 1; off < 64; off <<= 1) { const float tt = __shfl_up(pm, off); if (lane >= off) pm = fmaxf(pm, tt); }
        float ex = __shfl_up(pm, 1); if (lane == 0) ex = -3.0e38f;
        Mv[2 * lane] = fmaxf(mprev, fmaxf(ex, a0)); Mv[2 * lane + 1] = fmaxf(mprev, pm);
        av[2 * lane] = a0; av[2 * lane + 1] = a1; bv[2 * lane] = b0; bv[2 * lane + 1] = b1;
    }
#pragma unroll
    for (int it = 0; it < 4; ++it) {
        const int e = (it * NTHREADS + tid) * 8, s = e >> 7, d0 = e & 127;
        *(LAS u32x4*)(Kl + s * 272 + d0 * 2) = *(const u32x4*)(KC + (size_t)(t0 + s) * 512 + h * 128 + d0);
    }
    stage_T(P + (size_t)t0 * NPROJ + 3072 + h * 256, NPROJ, 32, VTe, wave, lane);
    for (int i = tid; i < 1024; i += NTHREADS) { const int r = i >> 6, w = i & 63; *(LAS unsigned*)(VTe + (256 + r) * 272 + w * 4) = 0x3F803F80u; }
    bf16x8 qf[4];
#pragma unroll
    for (int kk = 0; kk < 4; ++kk) qf[kk] = *(const bf16x8*)(QC + (size_t)(t0 + 16 * wave + fr) * 512 + h * 128 + 32 * kk + 8 * fq);
    __syncthreads();
    const int t = 16 * wave + fr; const float Mt = Mv[t];
    const int stmax = wave | 1;
    for (int st = 0; st <= stmax; ++st) {
        f32x4 s4 = {0.f, 0.f, 0.f, 0.f};
#pragma unroll
        for (int kk = 0; kk < 4; ++kk) { const bf16x8 kf = ld_frag_lds(Kl + (16 * st + fr) * 272 + (32 * kk + 8 * fq) * 2); s4 = MFMA16(kf, qf[kk], s4); }
#pragma unroll
        for (int r = 0; r < 4; ++r) { const int s = 16 * st + 4 * fq + r; const float w = (s <= t) ? __expf(av[s] - Mt) : 0.f; s4[r] *= w; }
        u32x2 w; w.x = cvt_pk_bf16(s4[0], s4[1]); w.y = cvt_pk_bf16(s4[2], s4[3]);
        *(LAS u32x2*)(Sl + t * 272 + (16 * st + 4 * fq) * 2) = w;
    }
    __syncthreads();
    const bf16_t* cpt = (const bf16_t*)(p.ws + WS_CPT) + ((size_t)(bh * 64 + c) * 272) * 128;
    f32x4 acc[17];
#pragma unroll
    for (int n = 0; n < 17; ++n) {
        acc[n] = (f32x4){0.f, 0.f, 0.f, 0.f};
#pragma unroll
        for (int kk = 0; kk < 4; ++kk) { const bf16x8 cf = *(const bf16x8*)(cpt + (size_t)(16 * n + fr) * 128 + 32 * kk + 8 * fq); acc[n] = MFMA16(cf, qf[kk], acc[n]); }
    }
    const float ai = __expf(mprev - Mt);
#pragma unroll
    for (int n = 0; n < 17; ++n) acc[n] = acc[n] * ai;
    const int k2max = (16 * wave + 15) >> 5;
#pragma unroll
    for (int kk = 0; kk < 4; ++kk) {
        if (kk <= k2max) {
            const bf16x8 sf = ld_frag_lds(Sl + t * 272 + (32 * kk + 8 * fq) * 2);
#pragma unroll
            for (int n = 0; n < 17; ++n) { const bf16x8 vf = ld_frag_lds(VTe + (16 * n + fr) * 272 + (32 * kk + 8 * fq) * 2); acc[n] = MFMA16(vf, sf, acc[n]); }
        }
    }
    const float den = __shfl(acc[16][0], fr);
    const float mt = bv[t] + Mt;
    const float inv = rcpf_(fmaxf(fabsf(den), __expf(-mt)));
    const size_t grow = (size_t)(t0 + t);
    float ss = 0.f;
#pragma unroll
    for (int n = 0; n < 16; ++n) {
        const int v0 = 16 * n + 4 * fq;
        const u32x2 ow = *(const u32x2*)(P + grow * NPROJ + 4096 + h * 256 + v0);
        f32x4 y;
        y[0] = bflo(ow.x) * acc[n][0] * inv; y[1] = bfhi(ow.x) * acc[n][1] * inv; y[2] = bflo(ow.y) * acc[n][2] * inv; y[3] = bfhi(ow.y) * acc[n][3] * inv;
        ss += (y[0] * y[0] + y[1] * y[1]) + (y[2] * y[2] + y[3] * y[3]);
        acc[n] = y;
    }
    ss += __shfl_xor(ss, 16); ss += __shfl_xor(ss, 32);
    const float rstd = rsqrtf(ss * (1.f / 256.f) + EPS);
#pragma unroll
    for (int n = 0; n < 16; ++n) {
        const int v0 = 16 * n + 4 * fq;
        const f32x4 g = *(const f32x4*)(p.ml_out_g + h * 256 + v0);
        const f32x4 o = acc[n] * rstd * g;
        u32x2 w; w.x = cvt_pk_bf16(o[0], o[1]); w.y = cvt_pk_bf16(o[2], o[3]);
        *(u32x2*)(YM + grow * DM + 1024 + h * 256 + v0) = w;
    }
}

DI unsigned ord_key(float f) { const unsigned u = __float_as_uint(f); return (u & 0x80000000u) ? ~u : (u | 0x80000000u); }
DI float key_val(unsigned k) { return (k & 0x80000000u) ? __uint_as_float(k & 0x7fffffffu) : __uint_as_float(~k); }
DI unsigned umax_(unsigned a, unsigned b) { return a > b ? a : b; }
DI unsigned wave_max_u32(unsigned v) {
    v = umax_(v, (unsigned)__builtin_amdgcn_update_dpp(0, (int)v, 0xB1, 0xF, 0xF, true));
    v = umax_(v, (unsigned)__builtin_amdgcn_update_dpp(0, (int)v, 0x4E, 0xF, 0xF, true));
    v = umax_(v, (unsigned)__builtin_amdgcn_update_dpp(0, (int)v, 0x141, 0xF, 0xF, true));
    v = umax_(v, (unsigned)__builtin_amdgcn_update_dpp(0, (int)v, 0x140, 0xF, 0xF, true));
    const unsigned a = (unsigned)__builtin_amdgcn_readlane((int)v, 0), b = (unsigned)__builtin_amdgcn_readlane((int)v, 16);
    const unsigned c = (unsigned)__builtin_amdgcn_readlane((int)v, 32), d = (unsigned)__builtin_amdgcn_readlane((int)v, 48);
    return umax_(umax_(a, b), umax_(c, d));
}

DI void phase_peer(const Params& p, LAS unsigned char* lds) {
    const int tid = threadIdx.x, lane = tid & 63, wave = __builtin_amdgcn_readfirstlane(tid >> 6);
    LAS float* K1 = (LAS float*)lds; LAS float* K2 = (LAS float*)(lds + 32768);
    LAS int* sel_id = (LAS int*)(lds + 65536); LAS float* sel_cf = (LAS float*)(lds + 81920);
    LAS float* scr = (LAS float*)(lds + 98304) + wave * (16 * 68);
    const bf16_t* Q = (const bf16_t*)(p.ws + WS_Q); const unsigned char* Ub = p.ws + WS_UB; const unsigned char* Vb = p.ws + WS_VB;
    const float* PSS2 = (const float*)(p.ws + WS_PSS2);
    int ci = 0, cj = 0; bool cvalid = false;
    {
        int cnt = 0;
#pragma unroll
        for (int i = 0; i < 16; ++i) { const int nj = 16 / (i + 1); if (lane >= cnt && lane < cnt + nj) { ci = i; cj = lane - cnt; cvalid = true; } cnt += nj; }
    }
    for (int tile = blockIdx.x; tile < T_TOK / 32; tile += gridDim.x) {
        const int tok0 = tile * 32;
        for (int h = 0; h < 8; ++h) {
            __syncthreads();
            for (int idx = tid; idx < 4096; idx += NTHREADS) {
                const int which = idx >> 11, r = idx & 2047, n = r & 127, d0 = (r >> 7) * 4;
                const f32x4 v = *(const f32x4*)((which ? p.peer_k2 : p.peer_k1) + ((size_t)(h * 128 + n)) * 64 + d0);
                LAS float* K = which ? K2 : K1;
                K[(d0 + 0) * 128 + n] = v[0]; K[(d0 + 1) * 128 + n] = v[1]; K[(d0 + 2) * 128 + n] = v[2]; K[(d0 + 3) * 128 + n] = v[3];
            }
            __syncthreads();
            unsigned qv[4];
#pragma unroll
            for (int j = 0; j < 4; ++j) qv[j] = *(const unsigned*)(Q + (size_t)(tok0 + wave * 4 + j) * 1024 + h * 128 + 2 * lane);
            float s1a[4], s1b[4], s2a[4], s2b[4];
#pragma unroll
            for (int j = 0; j < 4; ++j) { s1a[j] = 0.f; s1b[j] = 0.f; s2a[j] = 0.f; s2b[j] = 0.f; }
#pragma unroll 4
            for (int dp = 0; dp < 32; ++dp) {
                const float k1a0 = K1[(2 * dp) * 128 + lane], k1b0 = K1[(2 * dp) * 128 + lane + 64], k1a1 = K1[(2 * dp + 1) * 128 + lane], k1b1 = K1[(2 * dp + 1) * 128 + lane + 64];
                const float k2a0 = K2[(2 * dp) * 128 + lane], k2b0 = K2[(2 * dp) * 128 + lane + 64], k2a1 = K2[(2 * dp + 1) * 128 + lane], k2b1 = K2[(2 * dp + 1) * 128 + lane + 64];
#pragma unroll
                for (int j = 0; j < 4; ++j) {
                    const unsigned q1 = (unsigned)__builtin_amdgcn_readlane((int)qv[j], dp), q2 = (unsigned)__builtin_amdgcn_readlane((int)qv[j], 32 + dp);
                    const float q1l = bflo(q1), q1h = bfhi(q1), q2l = bflo(q2), q2h = bfhi(q2);
                    s1a[j] += q1l * k1a0 + q1h * k1a1; s1b[j] += q1l * k1b0 + q1h * k1b1;
                    s2a[j] += q2l * k2a0 + q2h * k2a1; s2b[j] += q2l * k2b0 + q2h * k2b1;
                }
            }
#pragma unroll
            for (int j = 0; j < 4; ++j) {
                unsigned list1 = 0u, list2 = 0u;
                {
                    unsigned ka = (ord_key(s1a[j]) & ~0x7Fu) | (unsigned)(127 - lane), kb = (ord_key(s1b[j]) & ~0x7Fu) | (unsigned)(63 - lane);
                    for (int it = 0; it < 16; ++it) { const unsigned wm = wave_max_u32(umax_(ka, kb)); if (ka == wm) ka = 0u; if (kb == wm) kb = 0u; if (lane == it) list1 = wm; }
                }
                {
                    unsigned ka = (ord_key(s2a[j]) & ~0x7Fu) | (unsigned)(127 - lane), kb = (ord_key(s2b[j]) & ~0x7Fu) | (unsigned)(63 - lane);
                    for (int it = 0; it < 16; ++it) { const unsigned wm = wave_max_u32(umax_(ka, kb)); if (ka == wm) ka = 0u; if (kb == wm) kb = 0u; if (lane == it) list2 = wm; }
                }
                const unsigned k1c = (unsigned)__shfl((int)list1, ci), k2c = (unsigned)__shfl((int)list2, cj);
                const float cand = key_val(k1c & ~0x7Fu) + key_val(k2c & ~0x7Fu);
                unsigned ckey = cvalid ? ((ord_key(cand) & ~0x3Fu) | (unsigned)(63 - lane)) : 0u;
                unsigned sel = 0u;
                for (int it = 0; it < 16; ++it) { const unsigned wm = wave_max_u32(ckey); if (ckey == wm) ckey = 0u; if (lane == it) sel = wm; }
                const int pos = 63 - (int)(sel & 63u);
                const float sv = key_val(sel & ~0x3Fu);
                const unsigned e1 = (unsigned)__shfl((int)k1c, pos), e2 = (unsigned)__shfl((int)k2c, pos);
                const int eid = (127 - (int)(e1 & 127u)) * 128 + (127 - (int)(e2 & 127u));
                const float mx = __shfl(sv, 0);
                float ev = lane < 16 ? __expf(sv - mx) : 0.f;
                float sum = ev;
                sum += __shfl_xor(sum, 1); sum += __shfl_xor(sum, 2); sum += __shfl_xor(sum, 4); sum += __shfl_xor(sum, 8);
                if (lane < 16) { sel_id[(wave * 4 + j) * 128 + h * 16 + lane] = eid; sel_cf[(wave * 4 + j) * 128 + h * 16 + lane] = ev * rcpf_(sum); }
            }
        }
        WAVE_LDS_SYNC();
        for (int j = 0; j < 4; ++j) {
            const int tk = wave * 4 + j, t = tok0 + tk;
            float* xrow = p.out + (size_t)t * DM;
            const float pv = lane < 32 ? PSS2[(size_t)t * 32 + lane] : 0.f;
            const float rstd2 = rsqrtf(wave_sum(pv) * (1.f / 2048.f) + EPS);
            float h2[32];
#pragma unroll
            for (int i = 0; i < 2; ++i)
#pragma unroll
                for (int q = 0; q < 4; ++q) {
                    const f32x4 x0 = *(const f32x4*)(xrow + i * 1024 + lane * 16 + q * 4), g0 = *(const f32x4*)(p.norm2_g + i * 1024 + lane * 16 + q * 4);
#pragma unroll
                    for (int e = 0; e < 4; ++e) h2[i * 16 + q * 4 + e] = x0[e] * rstd2 * g0[e];
                }
            for (int batch = 0; batch < 8; ++batch) {
#pragma unroll 8
                for (int e = 0; e < 16; ++e) {
                    const int id = __builtin_amdgcn_readfirstlane(sel_id[tk * 128 + batch * 16 + e]);
                    const unsigned char* ur = Ub + (size_t)id * DM + lane * 16;
                    float part = 0.f;
#pragma unroll
                    for (int i = 0; i < 2; ++i) {
                        const u32x4 w = *(const u32x4*)(ur + i * 1024);
#pragma unroll
                        for (int q = 0; q < 4; ++q) {
                            const f32x2 lo = __builtin_amdgcn_cvt_pk_f32_fp8((int)w[q], false), hi = __builtin_amdgcn_cvt_pk_f32_fp8((int)w[q], true);
                            part += (h2[i * 16 + q * 4 + 0] * lo[0] + h2[i * 16 + q * 4 + 1] * lo[1]) + (h2[i * 16 + q * 4 + 2] * hi[0] + h2[i * 16 + q * 4 + 3] * hi[1]);
                        }
                    }
                    scr[e * 68 + lane] = part;
                }
                WAVE_LDS_SYNC();
                float sum = 0.f;
#pragma unroll
                for (int i = 0; i < 4; ++i) { const f32x4 r = *(const LAS f32x4*)(scr + (lane >> 2) * 68 + (lane & 3) * 16 + 4 * i); sum += (r[0] + r[1]) + (r[2] + r[3]); }
                sum += __shfl_xor(sum, 1); sum += __shfl_xor(sum, 2);
                const float act = gelu_t(sum * (1.f / 64.f));
                if ((lane & 3) == 0) { const int ix = tk * 128 + batch * 16 + (lane >> 2); sel_cf[ix] = sel_cf[ix] * act * (1.f / 16.f); }
                WAVE_LDS_SYNC();
            }
            float acc[32];
#pragma unroll
            for (int i = 0; i < 32; ++i) acc[i] = 0.f;
#pragma unroll 8
            for (int e = 0; e < 128; ++e) {
                const int id = __builtin_amdgcn_readfirstlane(sel_id[tk * 128 + e]);
                const float cf = sel_cf[tk * 128 + e];
                const unsigned char* vr = Vb + (size_t)id * DM + lane * 16;
#pragma unroll
                for (int i = 0; i < 2; ++i) {
                    const u32x4 w = *(const u32x4*)(vr + i * 1024);
#pragma unroll
                    for (int q = 0; q < 4; ++q) {
                        const f32x2 lo = __builtin_amdgcn_cvt_pk_f32_fp8((int)w[q], false), hi = __builtin_amdgcn_cvt_pk_f32_fp8((int)w[q], true);
                        acc[i * 16 + q * 4 + 0] += cf * lo[0]; acc[i * 16 + q * 4 + 1] += cf * lo[1]; acc[i * 16 + q * 4 + 2] += cf * hi[0]; acc[i * 16 + q * 4 + 3] += cf * hi[1];
                    }
                }
            }
            float ss = 0.f;
#pragma unroll
            for (int i = 0; i < 2; ++i)
#pragma unroll
                for (int q = 0; q < 4; ++q) {
                    const f32x4 x0 = *(const f32x4*)(xrow + i * 1024 + lane * 16 + q * 4);
#pragma unroll
                    for (int e = 0; e < 4; ++e) { acc[i * 16 + q * 4 + e] += x0[e]; ss += acc[i * 16 + q * 4 + e] * acc[i * 16 + q * 4 + e]; }
                }
            const float rstd = rsqrtf(wave_sum(ss) * (1.f / 2048.f) + EPS);
#pragma unroll
            for (int i = 0; i < 2; ++i)
#pragma unroll
                for (int q = 0; q < 4; ++q) {
                    const f32x4 g0 = *(const f32x4*)(p.final_g + i * 1024 + lane * 16 + q * 4);
                    f32x4 o0;
#pragma unroll
                    for (int e = 0; e < 4; ++e) o0[e] = acc[i * 16 + q * 4 + e] * rstd * g0[e];
                    *(f32x4*)(xrow + i * 1024 + lane * 16 + q * 4) = o0;
                }
        }
    }
}

__global__ void __launch_bounds__(NTHREADS, 2) hymba_fwd(Params p) {
    extern __shared__ __attribute__((aligned(16))) unsigned char smem[];
    LAS unsigned char* lds = (LAS unsigned char*)smem;
    cg::grid_group grid = cg::this_grid();
    const int G = gridDim.x, bx = blockIdx.x;
    phase0(p, lds);
    grid.sync();
    {
        pg8::Gemm g{(const bf16_t*)(p.ws + WS_XN), (const bf16_t*)(p.ws + WS_WINT), T_TOK, NPROJ, DM};
        pg8::StaticOrder S; S.init(T_TOK, NPROJ, G, bx);
        Epi1 E{(bf16_t*)(p.ws + WS_P), (float*)(p.ws + WS_PSSV)};
        pg8::gemm_phase<Epi1, pg8::StaticOrder, true, true>(lds, g, S, E);
    }
    grid.sync();
    for (int si = bx; si < 256; si += G) {
        const int b = si >> 6, c = si & 63;
        gmlp_bc(p, lds, b, c);
        for (int h = 0; h < 4; ++h) mlstm_local(p, lds, b, c, h);
    }
    grid.sync();
    phase_scan(p);
    grid.sync();
    for (int it = bx; it < 1024; it += G) mlstm_out(p, lds, it >> 8, (it >> 2) & 63, it & 3);
    grid.sync();
    {
        pg8::Gemm g{(const bf16_t*)(p.ws + WS_XN), (const bf16_t*)(p.ws + WS_WOUTT), T_TOK, DM, DM};
        pg8::StaticOrder S; S.init(T_TOK, DM, G, bx);
        Epi2 E{p.x, p.out, (bf16_t*)(p.ws + WS_X1G), p.norm2_g, (float*)(p.ws + WS_PSS2)};
        pg8::gemm_phase<Epi2, pg8::StaticOrder, true, true>(lds, g, S, E);
    }
    grid.sync();
    {
        pg8::Gemm g{(const bf16_t*)(p.ws + WS_X1G), (const bf16_t*)(p.ws + WS_WQT), T_TOK, 1024, DM};
        pg8::StaticOrder S; S.init(T_TOK, 1024, G, bx);
        Epi3 E{(bf16_t*)(p.ws + WS_Q), (const float*)(p.ws + WS_PSS2)};
        pg8::gemm_phase<Epi3, pg8::StaticOrder, true, true>(lds, g, S, E);
    }
    grid.sync();
    phase_peer(p, lds);
}

extern "C" void kernel_launch(void* const* d_in, const int* in_sizes, int n_in, void* d_out, int out_size, void* d_ws, size_t ws_size, hipStream_t stream) {
    static int grid_blocks = 0;
    if (grid_blocks == 0) {
        if (n_in != 20 || ws_size < WS_END) { fprintf(stderr, "kernel_launch: unexpected n_in %d or ws_size %zu (need %zu)\n", n_in, ws_size, (size_t)WS_END); grid_blocks = -1; return; }
        int dev = 0, cus = 0, per_cu = 0;
        hipGetDevice(&dev);
        hipDeviceGetAttribute(&cus, hipDeviceAttributeMultiprocessorCount, dev);
        hipFuncSetAttribute((const void*)hymba_fwd, hipFuncAttributeMaxDynamicSharedMemorySize, LDS_BYTES);
        hipOccupancyMaxActiveBlocksPerMultiprocessor(&per_cu, (const void*)hymba_fwd, NTHREADS, LDS_BYTES);
        if (per_cu < 1) { fprintf(stderr, "kernel_launch: occupancy query says %d blocks per CU\n", per_cu); per_cu = 1; }
        if (per_cu > 1) per_cu = 1;
        grid_blocks = cus * per_cu;
        (void)hipGetLastError();
    }
    if (grid_blocks < 0) return;
    Params p{};
    p.x = (const float*)d_in[0]; p.norm1_g = (const float*)d_in[1]; p.w_in = (const float*)d_in[2]; p.gm_vnorm_g = (const float*)d_in[3];
    p.w_spatial = (const float*)d_in[4]; p.b_spatial = (const float*)d_in[5]; p.ml_conv_w = (const float*)d_in[6]; p.ml_conv_b = (const float*)d_in[7];
    p.ml_b_i = (const float*)d_in[8]; p.ml_b_f = (const float*)d_in[9]; p.gm_out_g = (const float*)d_in[10]; p.ml_out_g = (const float*)d_in[11];
    p.w_out = (const float*)d_in[12]; p.norm2_g = (const float*)d_in[13]; p.peer_wq = (const float*)d_in[14]; p.peer_k1 = (const float*)d_in[15];
    p.peer_k2 = (const float*)d_in[16]; p.peer_u = (const float*)d_in[17]; p.peer_v = (const float*)d_in[18]; p.final_g = (const float*)d_in[19];
    p.out = (float*)d_out; p.ws = (unsigned char*)d_ws;
    void* args[] = {&p};
    hipError_t e = hipLaunchCooperativeKernel((const void*)hymba_fwd, dim3(grid_blocks), dim3(NTHREADS), args, LDS_BYTES, stream);
    if (e != hipSuccess) fprintf(stderr, "cooperative launch failed: %s (grid %d)\n", hipGetErrorString(e), grid_blocks);
}
```

```cpp
#include <hip/hip_runtime.h>
#include <hip/hip_cooperative_groups.h>
#include <cstdio>
#include <cstdint>
namespace cg = cooperative_groups;
namespace pg8 {
#define PG8_LAS __attribute__((address_space(3)))
typedef unsigned short bf16_t;
typedef short bf16x8 __attribute__((ext_vector_type(8)));
typedef float f32x4 __attribute__((ext_vector_type(4)));
typedef unsigned u32x4 __attribute__((ext_vector_type(4)));
constexpr int BM = 256, BK = 64, HALF = 128, HTB = HALF * BK * 2  , STAGE_BYTES = 8 * HTB, NXCD = 8, WGM = 8;

__host__ __device__ __forceinline__ int lds_byte(int r, int c) { const int st = (r >> 4) * 2 + (c >> 5), rr = r & 15, cc = c & 31, ob = rr * 64 + cc * 2; return st * 1024 + (ob ^ (((ob >> 9) & 1) << 5)); }
__host__ __device__ __forceinline__ void stage_rc(int b, int& R, int& C) { const int st = b / 1024, sb = b % 1024, swz = sb ^ (((sb >> 9) & 1) << 5); R = (st >> 1) * 16 + swz / 64; C = (st & 1) * 32 + (swz % 64) / 2; }
__host__ __device__ __forceinline__ int perm32(int rho) { const int n = rho >> 4, i = rho & 15; return 8 * (i >> 2) + 4 * n + (i & 3); }

struct Unit { int pm, pn; };
struct Gemm { const bf16_t* A; const bf16_t* Bt; int M, N, K; };

struct StaticOrder {
    int nM, nN, nwg, G, c;
    __host__ __device__ void init(int M, int N, int G_, int c_) { nM = M / BM; nN = N / BM; nwg = nM * nN; G = G_; c = c_; }
    __host__ __device__ bool next(int i, Unit& u) const {
        const long L = (long)i * G + c; if (L >= nwg) return false;
        int wgid = (int)L; { const int q = nwg / NXCD, r = nwg % NXCD, xcd = wgid % NXCD, off = wgid / NXCD; wgid = (xcd < r ? xcd * (q + 1) : r * (q + 1) + (xcd - r) * q) + off; }
        const int nig = WGM * nN, gid = wgid / nig, fm = gid * WGM, gsz = (nM - fm) < WGM ? (nM - fm) : WGM;
        u.pm = fm + ((wgid % nig) % gsz); u.pn = (wgid % nig) / gsz; return true;
    }
    __device__ __forceinline__ void a_ready(const Unit&) const {}
    __device__ __forceinline__ void done(const Unit&) const {}
};
__device__ __forceinline__ unsigned cvt_pk_bf16(float lo, float hi) { unsigned r; asm volatile("v_cvt_pk_bf16_f32 %0, %1, %2" : "=v"(r) : "v"(lo), "v"(hi)); return r; }
template <class Epi, class Sched, bool ALIGN_EPI = false, bool SP2 = false>
__device__ __forceinline__ void gemm_phase(PG8_LAS unsigned char* lds, const Gemm g, const Sched& S, const Epi& E) {
    const int tid = threadIdx.x, wid = __builtin_amdgcn_readfirstlane(tid >> 6), lane = tid & 63, wr = wid >> 2, wc = wid & 3, fr = lane & 15, fq = lane >> 4;
    const int K = g.K, nt = K / BK;
    unsigned voffA[2], voffB[2];
#pragma unroll
    for (int i = 0; i < 2; ++i) { int R, C; stage_rc(tid * 16 + i * 8192, R, C); const int Rb = Epi::PERM ? ((R & ~31) + perm32(R & 31)) : R;
        voffA[i] = (unsigned)(R * K + C) * 2u; voffB[i] = (unsigned)(Rb * K + C) * 2u; }
    const size_t kstep = (size_t)(BK * 2);
    const size_t hstep = (size_t)HALF * K * 2;
    const size_t tstep = 2 * hstep;
    const unsigned ldsw = (unsigned)wid * 1024u;
    const int aoff = lds_byte(wr * 64 + fr, fq * 8), boff = lds_byte(wc * 32 + fr, fq * 8);
#define PG8_SA(b, h) (((b) * 2 + (h)) * HTB)
#define PG8_SB(b, h) ((4 + (b) * 2 + (h)) * HTB)
#define PG8_STAGE(bufoff, gbase, voff) do { _Pragma("unroll") for (int _i = 0; _i < 2; ++_i) \
        __builtin_amdgcn_global_load_lds((const unsigned*)((const char*)(gbase) + (voff)[_i]), (PG8_LAS unsigned*)(lds + (bufoff) + ldsw + _i * 8192), 16, 0, 0); } while (0)
#define PG8_LDA(dst, b, h) do { _Pragma("unroll") for (int m = 0; m < 4; ++m) _Pragma("unroll") for (int k = 0; k < 2; ++k) dst[m][k] = *(const PG8_LAS bf16x8*)(lds + PG8_SA(b, h) + aoff + m * 2048 + k * 1024); } while (0)
#define PG8_LDB(dst, b, h) do { _Pragma("unroll") for (int n = 0; n < 2; ++n) _Pragma("unroll") for (int k = 0; k < 2; ++k) dst[n][k] = *(const PG8_LAS bf16x8*)(lds + PG8_SB(b, h) + boff + n * 2048 + k * 1024); } while (0)
#define PG8_MMA(ai, bj, At, Bt) do { __builtin_amdgcn_s_setprio(1); _Pragma("unroll") for (int m = 0; m < 4; ++m) _Pragma("unroll") for (int n = 0; n < 2; ++n) _Pragma("unroll") for (int k = 0; k < 2; ++k) \
        acc[ai][bj][m][n] = __builtin_amdgcn_mfma_f32_16x16x32_bf16(Bt[n][k], At[m][k], acc[ai][bj][m][n], 0, 0, 0); __builtin_amdgcn_s_setprio(0); } while (0)
#define PG8_WAIT_V(n) asm volatile("s_waitcnt vmcnt(" #n ")" ::: "memory")
#define PG8_WAIT_L(n) asm volatile("s_waitcnt lgkmcnt(" #n ")" ::: "memory")
#define PG8_BAR __builtin_amdgcn_s_barrier()
#define PG8_SCHED __builtin_amdgcn_sched_barrier(0)
    Unit cur, nxt; int ui = 0;
    if (!S.next(0, cur)) return;
    f32x4 acc[2][2][4][2];
#pragma unroll
    for (int a = 0; a < 2; ++a)
#pragma unroll
        for (int b = 0; b < 2; ++b)
#pragma unroll
            for (int m = 0; m < 4; ++m)
#pragma unroll
                for (int n = 0; n < 2; ++n) acc[a][b][m][n] = (f32x4){0.f, 0.f, 0.f, 0.f};
    bf16x8 At[4][2], B0[2][2], B1[2][2];
    const char* cA = (const char*)g.A + (size_t)cur.pm * tstep; const char* cB = (const char*)g.Bt + (size_t)cur.pn * tstep;
    S.a_ready(cur);
    if constexpr (SP2) {
        PG8_STAGE(PG8_SB(0, 0), cB, voffB); PG8_STAGE(PG8_SB(0, 1), cB + hstep, voffB); PG8_STAGE(PG8_SA(0, 0), cA, voffA); PG8_STAGE(PG8_SA(0, 1), cA + hstep, voffA);
        if (wr == 1) PG8_BAR;
        PG8_WAIT_V(2); PG8_BAR;
        PG8_STAGE(PG8_SB(1, 0), cB + kstep, voffB); PG8_STAGE(PG8_SA(1, 0), cA + kstep, voffA); PG8_STAGE(PG8_SB(1, 1), cB + hstep + kstep, voffB);
        PG8_WAIT_V(6); PG8_BAR;
    } else {
        PG8_STAGE(PG8_SB(0, 0), cB, voffB); PG8_STAGE(PG8_SA(0, 0), cA, voffA); PG8_STAGE(PG8_SB(0, 1), cB + hstep, voffB); PG8_STAGE(PG8_SA(0, 1), cA + hstep, voffA);
        if (wr == 1) PG8_BAR;
        PG8_WAIT_V(4); PG8_BAR;
        PG8_STAGE(PG8_SB(1, 0), cB + kstep, voffB); PG8_STAGE(PG8_SA(1, 0), cA + kstep, voffA); PG8_STAGE(PG8_SB(1, 1), cB + hstep + kstep, voffB);
        PG8_WAIT_V(6); PG8_BAR;
    }
    for (;;) {
        const bool has_next = S.next(ui + 1, nxt);
        const char* nA = has_next ? (const char*)g.A + (size_t)nxt.pm * tstep : cA; const char* nB = has_next ? (const char*)g.Bt + (size_t)nxt.pn * tstep : cB;
        for (int t = 0; t < nt; t += 2) {
            const bool last = (t == nt - 2);
            const char* a1 = cA + (size_t)(t + 1) * kstep;
            const char* a2 = last ? nA : cA + (size_t)(t + 2) * kstep; const char* b2 = last ? nB : cB + (size_t)(t + 2) * kstep;
            const char* a3 = a2 + kstep; const char* b3 = b2 + kstep;
            if (last && has_next) S.a_ready(nxt);
            if constexpr (SP2) {
            PG8_LDB(B0, 0, 0); PG8_LDB(B1, 0, 1); PG8_SCHED; PG8_LDA(At, 0, 0); PG8_STAGE(PG8_SA(1, 1), a1 + hstep, voffA);
            PG8_WAIT_V(8); PG8_WAIT_L(0); PG8_BAR; PG8_MMA(0, 0, At, B0); PG8_MMA(0, 1, At, B1); PG8_BAR; PG8_SCHED;
            PG8_LDA(At, 0, 1); PG8_STAGE(PG8_SB(0, 0), b2, voffB); PG8_STAGE(PG8_SB(0, 1), b2 + hstep, voffB); PG8_STAGE(PG8_SA(0, 0), a2, voffA);
            PG8_WAIT_V(8); PG8_WAIT_L(0); PG8_BAR; PG8_MMA(1, 0, At, B0); PG8_MMA(1, 1, At, B1); PG8_BAR; PG8_SCHED;
            PG8_LDB(B0, 1, 0); PG8_LDB(B1, 1, 1); PG8_SCHED; PG8_LDA(At, 1, 0); PG8_STAGE(PG8_SA(0, 1), a2 + hstep, voffA);
            PG8_WAIT_V(8); PG8_WAIT_L(0); PG8_BAR; PG8_MMA(0, 0, At, B0); PG8_MMA(0, 1, At, B1); PG8_BAR; PG8_SCHED;
            PG8_LDA(At, 1, 1); PG8_STAGE(PG8_SB(1, 0), b3, voffB); PG8_STAGE(PG8_SB(1, 1), b3 + hstep, voffB); PG8_STAGE(PG8_SA(1, 0), a3, voffA);
            PG8_WAIT_V(8); PG8_WAIT_L(0); PG8_BAR; PG8_MMA(1, 0, At, B0); PG8_MMA(1, 1, At, B1); PG8_BAR; PG8_SCHED;
            } else {
            PG8_LDB(B0, 0, 0); PG8_SCHED; PG8_LDA(At, 0, 0); PG8_STAGE(PG8_SA(1, 1), a1 + hstep, voffA);
            PG8_WAIT_L(8); PG8_BAR; PG8_WAIT_L(0); PG8_MMA(0, 0, At, B0); PG8_BAR; PG8_SCHED;
            PG8_LDB(B1, 0, 1); PG8_STAGE(PG8_SB(0, 0), b2, voffB);
            PG8_BAR; PG8_WAIT_L(0); PG8_MMA(0, 1, At, B1); PG8_BAR;
            PG8_LDA(At, 0, 1); PG8_STAGE(PG8_SA(0, 0), a2, voffA);
            PG8_BAR; PG8_WAIT_L(0); PG8_MMA(1, 0, At, B0); PG8_BAR; PG8_SCHED;
            PG8_STAGE(PG8_SB(0, 1), b2 + hstep, voffB);
            PG8_WAIT_V(6); PG8_BAR; PG8_MMA(1, 1, At, B1); PG8_BAR;
            PG8_LDB(B0, 1, 0); PG8_SCHED; PG8_LDA(At, 1, 0); PG8_STAGE(PG8_SA(0, 1), a2 + hstep, voffA);
            PG8_WAIT_L(8); PG8_BAR; PG8_WAIT_L(0); PG8_MMA(0, 0, At, B0); PG8_BAR; PG8_SCHED;
            PG8_LDB(B1, 1, 1); PG8_STAGE(PG8_SB(1, 0), b3, voffB);
            PG8_BAR; PG8_WAIT_L(0); PG8_MMA(0, 1, At, B1); PG8_BAR;
            PG8_LDA(At, 1, 1); PG8_STAGE(PG8_SA(1, 0), a3, voffA);
            PG8_BAR; PG8_WAIT_L(0); PG8_MMA(1, 0, At, B0); PG8_BAR; PG8_SCHED;
            PG8_STAGE(PG8_SB(1, 1), b3 + hstep, voffB);
            PG8_WAIT_V(6); PG8_BAR; PG8_MMA(1, 1, At, B1); PG8_BAR;
            }
        }
        if constexpr (ALIGN_EPI) { if (wr == 0) PG8_BAR; }
        if constexpr (!Epi::AFTER_DRAIN) { E(acc, cur, wr, wc, fr, fq); S.done(cur); }
        if (!has_next) break;
#pragma unroll
        for (int a = 0; a < 2; ++a)
#pragma unroll
            for (int b = 0; b < 2; ++b)
#pragma unroll
                for (int m = 0; m < 4; ++m)
#pragma unroll
                    for (int n = 0; n < 2; ++n) acc[a][b][m][n] = (f32x4){0.f, 0.f, 0.f, 0.f};
        cur = nxt; cA = nA; cB = nB; ++ui;
        if constexpr (ALIGN_EPI) { if (wr == 1) PG8_BAR; }
    }
    PG8_WAIT_V(0);
    if constexpr (!ALIGN_EPI) { if (wr == 0) PG8_BAR; }
    PG8_BAR;
    if constexpr (Epi::AFTER_DRAIN) { E.fused(acc, cur, wr, wc, fr, fq, lds, wid, lane); S.done(cur); }
#undef PG8_SA
#undef PG8_SB
#undef PG8_STAGE
#undef PG8_LDA
#undef PG8_LDB
#undef PG8_MMA
#undef PG8_WAIT_V
#undef PG8_WAIT_L
#undef PG8_BAR
#undef PG8_SCHED
}
}

#define LAS __attribute__((address_space(3)))
#define DI __device__ __forceinline__
using pg8::bf16_t; using pg8::bf16x8; using pg8::f32x4; using pg8::u32x4; using pg8::cvt_pk_bf16;
typedef unsigned u32x2 __attribute__((ext_vector_type(2)));
typedef float f32x2 __attribute__((ext_vector_type(2)));

constexpr int T_TOK = 32768, DM = 2048, NPROJ = 5120, PROJW = 5128;
constexpr int NTHREADS = 512;
constexpr int LDS_BYTES = 147456;
constexpr float EPS = 1e-6f;

constexpr size_t WS_XN = 0;
constexpr size_t WS_P = 134217728;
constexpr size_t WS_X1G = WS_P;
constexpr size_t WS_Q = WS_P + 134217728;
constexpr size_t WS_WINT = WS_P + 335544320;
constexpr size_t WS_WOUTT = WS_WINT + 20971520;
constexpr size_t WS_WQT = WS_WOUTT + 8388608;
constexpr size_t WS_UB = WS_WQT + 4194304;
constexpr size_t WS_VB = WS_UB + 67108864;
constexpr size_t WS_ST = WS_VB + 67108864;
constexpr size_t WS_CPT = WS_ST + 142606336;
constexpr size_t WS_QC = WS_CPT + 71303168;
constexpr size_t WS_KC = WS_QC + 33554432;
constexpr size_t WS_IG = WS_KC + 33554432;
constexpr size_t WS_LF = WS_IG + 524288;
constexpr size_t WS_PSSV = WS_LF + 524288;
constexpr size_t WS_PSS2 = WS_PSSV + 2097152;
constexpr size_t WS_BEND = WS_PSS2 + 4194304;
constexpr size_t WS_GMAX = WS_BEND + 4096;
constexpr size_t WS_MPREV = WS_GMAX + 4096;
constexpr size_t WS_SELID = WS_MPREV + 4096;
constexpr size_t WS_SELG = WS_SELID + 16777216;
constexpr size_t WS_END = WS_SELG + 16777216;

struct Params {
    const float *x, *norm1_g, *w_in, *gm_vnorm_g, *w_spatial, *b_spatial, *ml_conv_w, *ml_conv_b, *ml_b_i, *ml_b_f, *gm_out_g, *ml_out_g, *w_out, *norm2_g,
        *peer_wq, *peer_k1, *peer_k2, *peer_u, *peer_v, *final_g;
    float* out;
    unsigned char* ws;
};

DI float bf2f(unsigned short h) { return __uint_as_float(((unsigned)h) << 16); }
DI float bflo(unsigned w) { return __uint_as_float(w << 16); }
DI float bfhi(unsigned w) { return __uint_as_float(w & 0xffff0000u); }
DI float rcpf_(float x) { return __builtin_amdgcn_rcpf(x); }
DI float sigmoid_(float x) { return rcpf_(1.f + __expf(-x)); }
DI float gelu_t(float x) { const float z = 1.5957691216057308f * (x + 0.044715f * x * x * x); return x * rcpf_(1.f + __expf(-z)); }
DI float wave_sum(float v) {
#pragma unroll
    for (int o = 32; o; o >>= 1) v += __shfl_xor(v, o);
    return v;
}
DI float wave_max(float v) {
#pragma unroll
    for (int o = 32; o; o >>= 1) v = fmaxf(v, __shfl_xor(v, o));
    return v;
}
DI bf16x8 ld_frag_lds(const LAS unsigned char* p) { return *(const LAS bf16x8*)p; }
#define MFMA16(a, b, c) __builtin_amdgcn_mfma_f32_16x16x32_bf16((a), (b), (c), 0, 0, 0)

struct Epi1 {
    static constexpr bool PERM = true, AFTER_DRAIN = false;
    bf16_t* P; float* pssv;
    DI void operator()(const f32x4 (&acc)[2][2][4][2], const pg8::Unit& u, int wr, int wc, int fr, int fq) const {
        const int row0 = u.pm * 256 + wr * 64 + fr, col0 = u.pn * 256 + wc * 32 + 8 * fq;
        const int mode = u.pn < 8 ? 1 : (u.pn >= 16 ? 2 : 0);
        const bool want_ss = (u.pn >= 4 && u.pn < 8);
#pragma unroll
        for (int ai = 0; ai < 2; ++ai)
#pragma unroll
            for (int m = 0; m < 4; ++m) {
                const int row = row0 + ai * 128 + m * 16;
                bf16_t* rowp = P + (size_t)row * NPROJ + col0;
                float ss = 0.f;
#pragma unroll
                for (int bj = 0; bj < 2; ++bj) {
                    f32x4 v0 = acc[ai][bj][m][0], v1 = acc[ai][bj][m][1];
                    if (mode == 1) {
#pragma unroll
                        for (int j = 0; j < 4; ++j) { v0[j] = gelu_t(v0[j]); v1[j] = gelu_t(v1[j]); ss += v0[j] * v0[j] + v1[j] * v1[j]; }
                    } else if (mode == 2) {
#pragma unroll
                        for (int j = 0; j < 4; ++j) { v0[j] = sigmoid_(v0[j]); v1[j] = sigmoid_(v1[j]); }
                    }
                    u32x4 w; w.x = cvt_pk_bf16(v0[0], v0[1]); w.y = cvt_pk_bf16(v0[2], v0[3]); w.z = cvt_pk_bf16(v1[0], v1[1]); w.w = cvt_pk_bf16(v1[2], v1[3]);
                    *(u32x4*)(rowp + bj * 128) = w;
                }
                if (want_ss) {
                    ss += __shfl_xor(ss, 16); ss += __shfl_xor(ss, 32);
                    if (fq == 0) pssv[(size_t)row * 16 + (u.pn - 4) * 4 + wc] = ss;
                }
            }
    }
};

struct Epi2 {
    static constexpr bool PERM = true, AFTER_DRAIN = false;
    const float* x; float* x1; bf16_t* x1g; const float* g2; float* pss2;
    DI void operator()(const f32x4 (&acc)[2][2][4][2], const pg8::Unit& u, int wr, int wc, int fr, int fq) const {
        const int row0 = u.pm * 256 + wr * 64 + fr, col0 = u.pn * 256 + wc * 32 + 8 * fq;
#pragma unroll
        for (int ai = 0; ai < 2; ++ai)
#pragma unroll
            for (int m = 0; m < 4; ++m) {
                const int row = row0 + ai * 128 + m * 16;
                float ss = 0.f;
#pragma unroll
                for (int bj = 0; bj < 2; ++bj) {
                    const size_t o = (size_t)row * DM + col0 + bj * 128;
                    f32x4 v0 = acc[ai][bj][m][0] + *(const f32x4*)(x + o), v1 = acc[ai][bj][m][1] + *(const f32x4*)(x + o + 4);
                    *(f32x4*)(x1 + o) = v0; *(f32x4*)(x1 + o + 4) = v1;
                    const f32x4 ga = *(const f32x4*)(g2 + col0 + bj * 128), gb = *(const f32x4*)(g2 + col0 + bj * 128 + 4);
#pragma unroll
                    for (int j = 0; j < 4; ++j) ss += v0[j] * v0[j] + v1[j] * v1[j];
                    v0 = v0 * ga; v1 = v1 * gb;
                    u32x4 w; w.x = cvt_pk_bf16(v0[0], v0[1]); w.y = cvt_pk_bf16(v0[2], v0[3]); w.z = cvt_pk_bf16(v1[0], v1[1]); w.w = cvt_pk_bf16(v1[2], v1[3]);
                    *(u32x4*)(x1g + o) = w;
                }
                ss += __shfl_xor(ss, 16); ss += __shfl_xor(ss, 32);
                if (fq == 0) pss2[(size_t)row * 32 + u.pn * 4 + wc] = ss;
            }
    }
};

struct Epi3 {
    static constexpr bool PERM = true, AFTER_DRAIN = false;
    bf16_t* Q; const float* pss2;
    DI void operator()(const f32x4 (&acc)[2][2][4][2], const pg8::Unit& u, int wr, int wc, int fr, int fq) const {
        const int row0 = u.pm * 256 + wr * 64 + fr, col0 = u.pn * 256 + wc * 32 + 8 * fq;
#pragma unroll
        for (int ai = 0; ai < 2; ++ai)
#pragma unroll
            for (int m = 0; m < 4; ++m) {
                const int row = row0 + ai * 128 + m * 16;
                float ss = 0.f;
#pragma unroll
                for (int i = 0; i < 8; ++i) { const f32x4 t = *(const f32x4*)(pss2 + (size_t)row * 32 + i * 4); ss += (t[0] + t[1]) + (t[2] + t[3]); }
                const float rstd = rsqrtf(ss * (1.f / 2048.f) + EPS);
#pragma unroll
                for (int bj = 0; bj < 2; ++bj) {
                    const f32x4 v0 = acc[ai][bj][m][0] * rstd, v1 = acc[ai][bj][m][1] * rstd;
                    u32x4 w; w.x = cvt_pk_bf16(v0[0], v0[1]); w.y = cvt_pk_bf16(v0[2], v0[3]); w.z = cvt_pk_bf16(v1[0], v1[1]); w.w = cvt_pk_bf16(v1[2], v1[3]);
                    *(u32x4*)(Q + (size_t)row * 1024 + col0 + bj * 128) = w;
                }
            }
    }
};

DI void phase0(const Params& p, LAS unsigned char* lds) {
    const int tid = threadIdx.x, lane = tid & 63, wave = tid >> 6;
    bf16_t* XN = (bf16_t*)(p.ws + WS_XN);
    {
        LAS float* scr = (LAS float*)lds + wave * (64 * 65);
        const int gw = blockIdx.x * 8 + wave, nw = gridDim.x * 8;
        for (int it = gw; it < 4096; it += nw) {
            const float* W; bf16_t* WT; int ldw, kt, nt;
            if (it < 2560) { W = p.w_in; WT = (bf16_t*)(p.ws + WS_WINT); ldw = PROJW; kt = it / 80; nt = it % 80; }
            else if (it < 3584) { const int j = it - 2560; W = p.w_out; WT = (bf16_t*)(p.ws + WS_WOUTT); ldw = 2048; kt = j >> 5; nt = j & 31; }
            else { const int j = it - 3584; W = p.peer_wq; WT = (bf16_t*)(p.ws + WS_WQT); ldw = 1024; kt = j >> 4; nt = j & 15; }
            const int k0 = kt * 64, n0 = nt * 64;
#pragma unroll 8
            for (int r = 0; r < 64; ++r) scr[r * 65 + lane] = W[(size_t)(k0 + r) * ldw + n0 + lane];
            __builtin_amdgcn_fence(__ATOMIC_RELEASE, "wavefront"); __builtin_amdgcn_wave_barrier(); __builtin_amdgcn_fence(__ATOMIC_ACQUIRE, "wavefront");
            const int half = lane >> 5, kk = (lane & 31) * 2;
#pragma unroll 8
            for (int nn = 0; nn < 32; ++nn) {
                const int n = 2 * nn + half; const float a = scr[kk * 65 + n], b = scr[(kk + 1) * 65 + n];
                *(unsigned*)(WT + (size_t)(n0 + n) * 2048 + k0 + kk) = cvt_pk_bf16(a, b);
            }
            __builtin_amdgcn_fence(__ATOMIC_RELEASE, "wavefront"); __builtin_amdgcn_wave_barrier(); __builtin_amdgcn_fence(__ATOMIC_ACQUIRE, "wavefront");
        }
    }
    __syncthreads();
    {
        LAS float* wg = (LAS float*)lds;
        for (int idx = tid; idx < 4096; idx += NTHREADS) {
            const int k = idx >> 1, hf = idx & 1;
            const f32x4 v = *(const f32x4*)(p.w_in + (size_t)k * PROJW + 5120 + hf * 4);
            *(LAS f32x4*)(wg + k * 8 + (k >> 3) * 4 + hf * 4) = v;
        }
        __syncthreads();
        float* IG = (float*)(p.ws + WS_IG); float* LF = (float*)(p.ws + WS_LF);
        for (int row = blockIdx.x * 8 + wave; row < T_TOK; row += gridDim.x * 8) {
            const float* xr = p.x + (size_t)row * DM;
            f32x4 xv[8]; float ss = 0.f;
#pragma unroll
            for (int i = 0; i < 4; ++i) { xv[2 * i] = *(const f32x4*)(xr + i * 512 + lane * 8); xv[2 * i + 1] = *(const f32x4*)(xr + i * 512 + lane * 8 + 4); }
#pragma unroll
            for (int i = 0; i < 8; ++i) ss += (xv[i][0] * xv[i][0] + xv[i][1] * xv[i][1]) + (xv[i][2] * xv[i][2] + xv[i][3] * xv[i][3]);
            ss = wave_sum(ss);
            const float rstd = rsqrtf(ss * (1.f / 2048.f) + EPS);
            f32x4 ga = {0.f, 0.f, 0.f, 0.f}, gb = {0.f, 0.f, 0.f, 0.f};
#pragma unroll
            for (int i = 0; i < 4; ++i) {
                const f32x4 g0 = *(const f32x4*)(p.norm1_g + i * 512 + lane * 8), g1 = *(const f32x4*)(p.norm1_g + i * 512 + lane * 8 + 4);
                const f32x4 h0 = xv[2 * i] * rstd * g0, h1 = xv[2 * i + 1] * rstd * g1;
                u32x4 w; w.x = cvt_pk_bf16(h0[0], h0[1]); w.y = cvt_pk_bf16(h0[2], h0[3]); w.z = cvt_pk_bf16(h1[0], h1[1]); w.w = cvt_pk_bf16(h1[2], h1[3]);
                *(u32x4*)(XN + (size_t)row * DM + i * 512 + lane * 8) = w;
                const LAS float* wb = wg + (i * 512 + lane * 8) * 8 + (i * 64 + lane) * 4;
#pragma unroll
                for (int e = 0; e < 8; ++e) {
                    const float hv = e < 4 ? h0[e & 3] : h1[e & 3];
                    const f32x4 w0 = *(const LAS f32x4*)(wb + e * 8), w1 = *(const LAS f32x4*)(wb + e * 8 + 4);
                    ga = ga + w0 * hv; gb = gb + w1 * hv;
                }
            }
            float zi = 0.f;
#pragma unroll
            for (int j = 0; j < 4; ++j) { const float a = wave_sum(ga[j]), b = wave_sum(gb[j]); zi = (lane == j) ? a : zi; zi = (lane == 4 + j) ? b : zi; }
            if (lane < 4) IG[(size_t)row * 4 + lane] = zi + p.ml_b_i[lane];
            else if (lane < 8) { const float z = zi + p.ml_b_f[lane - 4]; LF[(size_t)row * 4 + lane - 4] = fminf(z, 0.f) - log1pf(__expf(-fabsf(z))); }
        }
    }
    {
        unsigned char* Ub = p.ws + WS_UB; unsigned char* Vb = p.ws + WS_VB;
        const size_t n16 = (size_t)16384 * 2048 / 16;
        for (size_t i = (size_t)blockIdx.x * NTHREADS + tid; i < n16; i += (size_t)gridDim.x * NTHREADS) {
            u32x4 wu, wv;
#pragma unroll
            for (int q = 0; q < 4; ++q) {
                const f32x4 a = *(const f32x4*)(p.peer_u + i * 16 + q * 4) * 64.f, b = *(const f32x4*)(p.peer_v + i * 16 + q * 4) * 16.f;
                int r = 0; r = __builtin_amdgcn_cvt_pk_fp8_f32(a[0], a[1], r, false); r = __builtin_amdgcn_cvt_pk_fp8_f32(a[2], a[3], r, true); wu[q] = (unsigned)r;
                int s = 0; s = __builtin_amdgcn_cvt_pk_fp8_f32(b[0], b[1], s, false); s = __builtin_amdgcn_cvt_pk_fp8_f32(b[2], b[3], s, true); wv[q] = (unsigned)s;
            }
            *(u32x4*)(Ub + i * 16) = wu; *(u32x4*)(Vb + i * 16) = wv;
        }
    }
}

#define WAVE_LDS_SYNC() do { __builtin_amdgcn_fence(__ATOMIC_RELEASE, "wavefront"); __builtin_amdgcn_wave_barrier(); __builtin_amdgcn_fence(__ATOMIC_ACQUIRE, "wavefront"); } while (0)

DI void stage_T(const bf16_t* src, int ld, int ngroups, LAS unsigned char* dst, int wave, int lane) {
    for (int g = wave; g < ngroups; g += 8) {
        const u32x4 r0 = *(const u32x4*)(src + (size_t)(2 * lane) * ld + g * 8);
        const u32x4 r1 = *(const u32x4*)(src + (size_t)(2 * lane + 1) * ld + g * 8);
#pragma unroll
        for (int w = 0; w < 4; ++w) {
            const unsigned a = r0[w], b = r1[w];
            *(LAS unsigned*)(dst + (g * 8 + 2 * w) * 272 + lane * 4) = (a & 0xffffu) | (b << 16);
            *(LAS unsigned*)(dst + (g * 8 + 2 * w + 1) * 272 + lane * 4) = (a >> 16) | (b & 0xffff0000u);
        }
    }
}

DI void gmlp_bc(const Params& p, LAS unsigned char* lds, int b, int c) {
    const int tid = threadIdx.x, lane = tid & 63, wave = __builtin_amdgcn_readfirstlane(tid >> 6), fr = lane & 15, fq = lane >> 4;
    const int t0 = b * 8192 + c * 128;
    LAS unsigned char* Wl = lds; LAS unsigned char* GvT = lds + 34816; LAS float* rstdv = (LAS float*)(lds + 69632);
    const bf16_t* P = (const bf16_t*)(p.ws + WS_P); bf16_t* YM = (bf16_t*)(p.ws + WS_XN);
    const float* PSSV = (const float*)(p.ws + WS_PSSV);
    __syncthreads();
    if (tid < 128) {
        float ss = 0.f;
#pragma unroll
        for (int i = 0; i < 4; ++i) { const f32x4 v = *(const f32x4*)(PSSV + (size_t)(t0 + tid) * 16 + i * 4); ss += (v[0] + v[1]) + (v[2] + v[3]); }
        rstdv[tid] = rsqrtf(ss * (1.f / 1024.f) + EPS);
    }
    for (int h = 0; h < 8; ++h) {
        __syncthreads();
#pragma unroll
        for (int it = 0; it < 4; ++it) {
            const int e = (it * NTHREADS + tid) * 8, t = e >> 7, s0 = e & 127;
            const float* wp = p.w_spatial + ((size_t)(h * 128 + t)) * 128 + s0;
            const f32x4 a0 = *(const f32x4*)wp, a1 = *(const f32x4*)(wp + 4);
            float v[8];
#pragma unroll
            for (int j = 0; j < 8; ++j) { const float a = j < 4 ? a0[j & 3] : a1[j & 3]; v[j] = (s0 + j <= t) ? a * rstdv[s0 + j] : 0.f; }
            u32x4 w; w.x = cvt_pk_bf16(v[0], v[1]); w.y = cvt_pk_bf16(v[2], v[3]); w.z = cvt_pk_bf16(v[4], v[5]); w.w = cvt_pk_bf16(v[6], v[7]);
            *(LAS u32x4*)(Wl + t * 272 + s0 * 2) = w;
        }
        stage_T(P + (size_t)t0 * NPROJ + 1024 + h * 128, NPROJ, 16, GvT, wave, lane);
        __syncthreads();
        f32x4 acc[8];
#pragma unroll
        for (int n = 0; n < 8; ++n) acc[n] = (f32x4){0.f, 0.f, 0.f, 0.f};
        const int kmax = (16 * wave + 15) >> 5;
#pragma unroll
        for (int kk = 0; kk < 4; ++kk) {
            if (kk <= kmax) {
                const bf16x8 bfrag = ld_frag_lds(Wl + (16 * wave + fr) * 272 + (32 * kk + 8 * fq) * 2);
#pragma unroll
                for (int n = 0; n < 8; ++n) { const bf16x8 afrag = ld_frag_lds(GvT + (16 * n + fr) * 272 + (32 * kk + 8 * fq) * 2); acc[n] = MFMA16(afrag, bfrag, acc[n]); }
            }
        }
        const int t = 16 * wave + fr; const size_t grow = (size_t)(t0 + t);
        const float bsp = p.b_spatial[h * 128 + t];
        float ss = 0.f;
#pragma unroll
        for (int n = 0; n < 8; ++n) {
            const int d0 = 16 * n + 4 * fq;
            const u32x2 uw = *(const u32x2*)(P + grow * NPROJ + h * 128 + d0);
            const f32x4 gv = *(const f32x4*)(p.gm_vnorm_g + h * 128 + d0);
            f32x4 y;
            y[0] = bflo(uw.x) * (gv[0] * acc[n][0] + bsp); y[1] = bfhi(uw.x) * (gv[1] * acc[n][1] + bsp);
            y[2] = bflo(uw.y) * (gv[2] * acc[n][2] + bsp); y[3] = bfhi(uw.y) * (gv[3] * acc[n][3] + bsp);
            ss += (y[0] * y[0] + y[1] * y[1]) + (y[2] * y[2] + y[3] * y[3]);
            acc[n] = y;
        }
        ss += __shfl_xor(ss, 16); ss += __shfl_xor(ss, 32);
        const float rstd = rsqrtf(ss * (1.f / 128.f) + EPS);
#pragma unroll
        for (int n = 0; n < 8; ++n) {
            const int d0 = 16 * n + 4 * fq;
            const f32x4 g = *(const f32x4*)(p.gm_out_g + h * 128 + d0);
            const f32x4 o = acc[n] * rstd * g;
            u32x2 w; w.x = cvt_pk_bf16(o[0], o[1]); w.y = cvt_pk_bf16(o[2], o[3]);
            *(u32x2*)(YM + grow * DM + h * 128 + d0) = w;
        }
    }
}

DI void mlstm_local(const Params& p, LAS unsigned char* lds, int b, int c, int h) {
    const int tid = threadIdx.x, lane = tid & 63, wave = __builtin_amdgcn_readfirstlane(tid >> 6), fr = lane & 15, fq = lane >> 4;
    const int bh = b * 4 + h, t0 = b * 8192 + c * 128;
    LAS unsigned char* KT = lds; LAS unsigned char* VT = lds + 34816; LAS float* wsv = (LAS float*)(lds + 108800);
    const bf16_t* P = (const bf16_t*)(p.ws + WS_P);
    bf16_t* QC = (bf16_t*)(p.ws + WS_QC); bf16_t* KC = (bf16_t*)(p.ws + WS_KC);
    const float* IG = (const float*)(p.ws + WS_IG); const float* LF = (const float*)(p.ws + WS_LF);
    __syncthreads();
    if (wave == 0) {
        const float l0 = LF[(size_t)(t0 + 2 * lane) * 4 + h], l1 = LF[(size_t)(t0 + 2 * lane + 1) * 4 + h];
        const float i0 = IG[(size_t)(t0 + 2 * lane) * 4 + h], i1 = IG[(size_t)(t0 + 2 * lane + 1) * 4 + h];
        float s = l0 + l1;
#pragma unroll
        for (int off = 1; off < 64; off <<= 1) { const float tt = __shfl_up(s, off); if (lane >= off) s += tt; }
        const float b1 = s, b0 = s - l1, bend = __shfl(s, 63);
        const float g0 = bend - b0 + i0, g1 = bend - b1 + i1;
        const float gmax = wave_max(fmaxf(g0, g1));
        wsv[2 * lane] = __expf(g0 - gmax); wsv[2 * lane + 1] = __expf(g1 - gmax);
        if (lane == 0) { ((float*)(p.ws + WS_BEND))[bh * 64 + c] = bend; ((float*)(p.ws + WS_GMAX))[bh * 64 + c] = gmax; }
    }
    __syncthreads();
    for (int g = wave; g < 32; g += 8) {
        const bool isk = g >= 16; const int cgp = (g & 15) * 8;
        const int ch = (isk ? 512 : 0) + h * 128 + cgp;
        const bf16_t* src = P + (isk ? 2560 : 2048) + h * 128 + cgp;
        const int s = 2 * lane;
        float xr[5][8];
#pragma unroll
        for (int dj = 0; dj < 5; ++dj) {
            const int srow = s - 3 + dj;
            u32x4 w = {0u, 0u, 0u, 0u};
            if (c > 0 || srow >= 0) w = *(const u32x4*)(src + (size_t)((long)t0 + srow) * NPROJ);
#pragma unroll
            for (int q = 0; q < 4; ++q) { xr[dj][2 * q] = bflo(w[q]); xr[dj][2 * q + 1] = bfhi(w[q]); }
        }
        float y0[8], y1[8];
        {
            const f32x4 cb0 = *(const f32x4*)(p.ml_conv_b + ch), cb1 = *(const f32x4*)(p.ml_conv_b + ch + 4);
#pragma unroll
            for (int e = 0; e < 8; ++e) { y0[e] = e < 4 ? cb0[e & 3] : cb1[e & 3]; y1[e] = y0[e]; }
#pragma unroll
            for (int j = 0; j < 4; ++j) {
                const f32x4 w0 = *(const f32x4*)(p.ml_conv_w + j * 1024 + ch), w1 = *(const f32x4*)(p.ml_conv_w + j * 1024 + ch + 4);
#pragma unroll
                for (int e = 0; e < 8; ++e) { const float wv = e < 4 ? w0[e & 3] : w1[e & 3]; y0[e] += wv * xr[j][e]; y1[e] += wv * xr[j + 1][e]; }
            }
        }
        const float sc = isk ? 0.08838834764831845f : 1.f;
#pragma unroll
        for (int e = 0; e < 8; ++e) { y0[e] = y0[e] * sigmoid_(y0[e]) * sc; y1[e] = y1[e] * sigmoid_(y1[e]) * sc; }
        bf16_t* dst = (isk ? KC : QC) + (size_t)(t0 + s) * 512 + h * 128 + cgp;
        u32x4 w; w.x = cvt_pk_bf16(y0[0], y0[1]); w.y = cvt_pk_bf16(y0[2], y0[3]); w.z = cvt_pk_bf16(y0[4], y0[5]); w.w = cvt_pk_bf16(y0[6], y0[7]);
        *(u32x4*)dst = w;
        w.x = cvt_pk_bf16(y1[0], y1[1]); w.y = cvt_pk_bf16(y1[2], y1[3]); w.z = cvt_pk_bf16(y1[4], y1[5]); w.w = cvt_pk_bf16(y1[6], y1[7]);
        *(u32x4*)(dst + 512) = w;
        if (isk) {
            const float w0 = wsv[s], w1 = wsv[s + 1];
#pragma unroll
            for (int e = 0; e < 8; ++e) *(LAS unsigned*)(KT + (cgp + e) * 272 + lane * 4) = cvt_pk_bf16(y0[e] * w0, y1[e] * w1);
        }
    }
    stage_T(P + (size_t)t0 * NPROJ + 3072 + h * 256, NPROJ, 32, VT, wave, lane);
    for (int i = tid; i < 1024; i += NTHREADS) { const int r = i >> 6, w = i & 63; *(LAS unsigned*)(VT + (256 + r) * 272 + w * 4) = 0x3F803F80u; }
    __syncthreads();
    bf16x8 af[4];
#pragma unroll
    for (int kk = 0; kk < 4; ++kk) af[kk] = ld_frag_lds(KT + (16 * wave + fr) * 272 + (32 * kk + 8 * fq) * 2);
    float* ST = (float*)(p.ws + WS_ST) + ((size_t)(bh * 64 + c) * 272) * 128;
#pragma unroll
    for (int n = 0; n < 17; ++n) {
        f32x4 acc = {0.f, 0.f, 0.f, 0.f};
#pragma unroll
        for (int kk = 0; kk < 4; ++kk) { const bf16x8 bfr = ld_frag_lds(VT + (16 * n + fr) * 272 + (32 * kk + 8 * fq) * 2); acc = MFMA16(af[kk], bfr, acc); }
        if (n < 16 || fr == 0) *(f32x4*)(ST + (size_t)(16 * n + fr) * 128 + 16 * wave + 4 * fq) = acc;
    }
}

DI void phase_scan(const Params& p) {
    const float* ST = (const float*)(p.ws + WS_ST); bf16_t* CPT = (bf16_t*)(p.ws + WS_CPT);
    const float* BEND = (const float*)(p.ws + WS_BEND); const float* GMAX = (const float*)(p.ws + WS_GMAX); float* MPREV = (float*)(p.ws + WS_MPREV);
    const int gtid = blockIdx.x * NTHREADS + threadIdx.x, nthr = gridDim.x * NTHREADS;
    constexpr int PER = 8224;
    constexpr size_t CST = 272 * 128;
    for (int item = gtid; item < 16 * PER; item += nthr) {
        const int bh = item / PER, e4 = item - bh * PER;
        const float* src = ST + (size_t)bh * 64 * CST + (size_t)e4 * 4;
        bf16_t* dst = CPT + (size_t)bh * 64 * CST + (size_t)e4 * 4;
        f32x4 st = {0.f, 0.f, 0.f, 0.f}; float m = 0.f;
        for (int c0 = 0; c0 < 64; c0 += 8) {
            f32x4 d[8];
#pragma unroll
            for (int j = 0; j < 8; ++j) d[j] = *(const f32x4*)(src + (size_t)(c0 + j) * CST);
#pragma unroll
            for (int j = 0; j < 8; ++j) {
                const int c = c0 + j;
                const float be = BEND[bh * 64 + c], gm = GMAX[bh * 64 + c];
                const float mn = fmaxf(be + m, gm), a = __expf(be + m - mn), sc = __expf(gm - mn);
                u32x2 w; w.x = cvt_pk_bf16(st[0], st[1]); w.y = cvt_pk_bf16(st[2], st[3]);
                *(u32x2*)(dst + (size_t)c * CST) = w;
                if (e4 == 0) MPREV[bh * 64 + c] = m;
                st = st * a + d[j] * sc; m = mn;
            }
        }
    }
}

DI void mlstm_out(const Params& p, LAS unsigned char* lds, int b, int c, int h) {
    const int tid = threadIdx.x, lane = tid & 63, wave = __builtin_amdgcn_readfirstlane(tid >> 6), fr = lane & 15, fq = lane >> 4;
    const int bh = b * 4 + h, t0 = b * 8192 + c * 128;
    LAS unsigned char* Kl = lds; LAS unsigned char* Sl = lds + 34816; LAS unsigned char* VTe = lds + 69632;
    LAS float* av = (LAS float*)(lds + 143616); LAS float* Mv = (LAS float*)(lds + 144128); LAS float* bv = (LAS float*)(lds + 144640);
    const bf16_t* P = (const bf16_t*)(p.ws + WS_P); bf16_t* YM = (bf16_t*)(p.ws + WS_XN);
    const bf16_t* QC = (const bf16_t*)(p.ws + WS_QC); const bf16_t* KC = (const bf16_t*)(p.ws + WS_KC);
    const float* IG = (const float*)(p.ws + WS_IG); const float* LF = (const float*)(p.ws + WS_LF);
    const float mprev = ((const float*)(p.ws + WS_MPREV))[bh * 64 + c];
    __syncthreads();
    if (wave == 0) {
        const float l0 = LF[(size_t)(t0 + 2 * lane) * 4 + h], l1 = LF[(size_t)(t0 + 2 * lane + 1) * 4 + h];
        const float i0 = IG[(size_t)(t0 + 2 * lane) * 4 + h], i1 = IG[(size_t)(t0 + 2 * lane + 1) * 4 + h];
        float s = l0 + l1;
#pragma unroll
        for (int off = 1; off < 64; off <<= 1) { const float tt = __shfl_up(s, off); if (lane >= off) s += tt; }
        const float b1 = s, b0 = s - l1;
        const float a0 = i0 - b0, a1 = i1 - b1;
        float pm = fmaxf(a0, a1);
#pragma unroll
        for (int off = 1; off < 64; off <<= 1) { const float tt = __shfl_up(pm, off); if (lane >= off) pm = fmaxf(pm, tt); }
        float ex = __shfl_up(pm, 1); if (lane == 0) ex = -3.0e38f;
        Mv[2 * lane] = fmaxf(mprev, fmaxf(ex, a0)); Mv[2 * lane + 1] = fmaxf(mprev, pm);
        av[2 * lane] = a0; av[2 * lane + 1] = a1; bv[2 * lane] = b0; bv[2 * lane + 1] = b1;
    }
#pragma unroll
    for (int it = 0; it < 4; ++it) {
        const int e = (it * NTHREADS + tid) * 8, s = e >> 7, d0 = e & 127;
        *(LAS u32x4*)(Kl + s * 272 + d0 * 2) = *(const u32x4*)(KC + (size_t)(t0 + s) * 512 + h * 128 + d0);
    }
    stage_T(P + (size_t)t0 * NPROJ + 3072 + h * 256, NPROJ, 32, VTe, wave, lane);
    for (int i = tid; i < 1024; i += NTHREADS) { const int r = i >> 6, w = i & 63; *(LAS unsigned*)(VTe + (256 + r) * 272 + w * 4) = 0x3F803F80u; }
    bf16x8 qf[4];
#pragma unroll
    for (int kk = 0; kk < 4; ++kk) qf[kk] = *(const bf16x8*)(QC + (size_t)(t0 + 16 * wave + fr) * 512 + h * 128 + 32 * kk + 8 * fq);
    __syncthreads();
    const int t = 16 * wave + fr; const float Mt = Mv[t];
    const int stmax = wave | 1;
    for (int st = 0; st <= stmax; ++st) {
        f32x4 s4 = {0.f, 0.f, 0.f, 0.f};
#pragma unroll
        for (int kk = 0; kk < 4; ++kk) { const bf16x8 kf = ld_frag_lds(Kl + (16 * st + fr) * 272 + (32 * kk + 8 * fq) * 2); s4 = MFMA16(kf, qf[kk], s4); }
#pragma unroll
        for (int r = 0; r < 4; ++r) { const int s = 16 * st + 4 * fq + r; const float w = (s <= t) ? __expf(av[s] - Mt) : 0.f; s4[r] *= w; }
        u32x2 w; w.x = cvt_pk_bf16(s4[0], s4[1]); w.y = cvt_pk_bf16(s4[2], s4[3]);
        *(LAS u32x2*)(Sl + t * 272 + (16 * st + 4 * fq) * 2) = w;
    }
    __syncthreads();
    const bf16_t* cpt = (const bf16_t*)(p.ws + WS_CPT) + ((size_t)(bh * 64 + c) * 272) * 128;
    f32x4 acc[17];
#pragma unroll
    for (int n = 0; n < 17; ++n) {
        acc[n] = (f32x4){0.f, 0.f, 0.f, 0.f};
#pragma unroll
        for (int kk = 0; kk < 4; ++kk) { const bf16x8 cf = *(const bf16x8*)(cpt + (size_t)(16 * n + fr) * 128 + 32 * kk + 8 * fq); acc[n] = MFMA16(cf, qf[kk], acc[n]); }
    }
    const float ai = __expf(mprev - Mt);
#pragma unroll
    for (int n = 0; n < 17; ++n) acc[n] = acc[n] * ai;
    const int k2max = (16 * wave + 15) >> 5;
#pragma unroll
    for (int kk = 0; kk < 4; ++kk) {
        if (kk <= k2max) {
            const bf16x8 sf = ld_frag_lds(Sl + t * 272 + (32 * kk + 8 * fq) * 2);
#pragma unroll
            for (int n = 0; n < 17; ++n) { const bf16x8 vf = ld_frag_lds(VTe + (16 * n + fr) * 272 + (32 * kk + 8 * fq) * 2); acc[n] = MFMA16(vf, sf, acc[n]); }
        }
    }
    const float den = __shfl(acc[16][0], fr);
    const float mt = bv[t] + Mt;
    const float inv = rcpf_(fmaxf(fabsf(den), __expf(-mt)));
    const size_t grow = (size_t)(t0 + t);
    float ss = 0.f;
#pragma unroll
    for (int n = 0; n < 16; ++n) {
        const int v0 = 16 * n + 4 * fq;
        const u32x2 ow = *(const u32x2*)(P + grow * NPROJ + 4096 + h * 256 + v0);
        f32x4 y;
        y[0] = bflo(ow.x) * acc[n][0] * inv; y[1] = bfhi(ow.x) * acc[n][1] * inv; y[2] = bflo(ow.y) * acc[n][2] * inv; y[3] = bfhi(ow.y) * acc[n][3] * inv;
        ss += (y[0] * y[0] + y[1] * y[1]) + (y[2] * y[2] + y[3] * y[3]);
        acc[n] = y;
    }
    ss += __shfl_xor(ss, 16); ss += __shfl_xor(ss, 32);
    const float rstd = rsqrtf(ss * (1.f / 256.f) + EPS);
#pragma unroll
    for (int n = 0; n < 16; ++n) {
        const int v0 = 16 * n + 4 * fq;
        const f32x4 g = *(const f32x4*)(p.ml_out_g + h * 256 + v0);
        const f32x4 o = acc[n] * rstd * g;
        u32x2 w; w.x = cvt_pk_bf16(o[0], o[1]); w.y = cvt_pk_bf16(o[2], o[3]);
        *(u32x2*)(YM + grow * DM + 1024 + h * 256 + v0) = w;
    }
}

DI unsigned ord_key(float f) { const unsigned u = __float_as_uint(f); return (u & 0x80000000u) ? ~u : (u | 0x80000000u); }
DI float key_val(unsigned k) { return (k & 0x80000000u) ? __uint_as_float(k & 0x7fffffffu) : __uint_as_float(~k); }
DI unsigned umax_(unsigned a, unsigned b) { return a > b ? a : b; }
DI unsigned wave_max_u32(unsigned v) {
    v = umax_(v, (unsigned)__builtin_amdgcn_update_dpp(0, (int)v, 0xB1, 0xF, 0xF, true));
    v = umax_(v, (unsigned)__builtin_amdgcn_update_dpp(0, (int)v, 0x4E, 0xF, 0xF, true));
    v = umax_(v, (unsigned)__builtin_amdgcn_update_dpp(0, (int)v, 0x141, 0xF, 0xF, true));
    v = umax_(v, (unsigned)__builtin_amdgcn_update_dpp(0, (int)v, 0x140, 0xF, 0xF, true));
    const unsigned a = (unsigned)__builtin_amdgcn_readlane((int)v, 0), b = (unsigned)__builtin_amdgcn_readlane((int)v, 16);
    const unsigned c = (unsigned)__builtin_amdgcn_readlane((int)v, 32), d = (unsigned)__builtin_amdgcn_readlane((int)v, 48);
    return umax_(umax_(a, b), umax_(c, d));
}

DI void peer_select(const Params& p, LAS unsigned char* lds) {
    const int tid = threadIdx.x, lane = tid & 63, wave = __builtin_amdgcn_readfirstlane(tid >> 6);
    LAS float* K1 = (LAS float*)lds; LAS float* K2 = (LAS float*)(lds + 32768);
    int* SELID = (int*)(p.ws + WS_SELID); float* SELG = (float*)(p.ws + WS_SELG);
    const bf16_t* Q = (const bf16_t*)(p.ws + WS_Q);
    int ci = 0, cj = 0; bool cvalid = false;
    {
        int cnt = 0;
#pragma unroll
        for (int i = 0; i < 16; ++i) { const int nj = 16 / (i + 1); if (lane >= cnt && lane < cnt + nj) { ci = i; cj = lane - cnt; cvalid = true; } cnt += nj; }
    }
    for (int tile = blockIdx.x; tile < T_TOK / 32; tile += gridDim.x) {
        const int tok0 = tile * 32;
        for (int h = 0; h < 8; ++h) {
            __syncthreads();
            for (int idx = tid; idx < 4096; idx += NTHREADS) {
                const int which = idx >> 11, r = idx & 2047, n = r & 127, d0 = (r >> 7) * 4;
                const f32x4 v = *(const f32x4*)((which ? p.peer_k2 : p.peer_k1) + ((size_t)(h * 128 + n)) * 64 + d0);
                LAS float* K = which ? K2 : K1;
                K[(d0 + 0) * 128 + n] = v[0]; K[(d0 + 1) * 128 + n] = v[1]; K[(d0 + 2) * 128 + n] = v[2]; K[(d0 + 3) * 128 + n] = v[3];
            }
            __syncthreads();
            unsigned qv[4];
#pragma unroll
            for (int j = 0; j < 4; ++j) qv[j] = *(const unsigned*)(Q + (size_t)(tok0 + wave * 4 + j) * 1024 + h * 128 + 2 * lane);
            float s1a[4], s1b[4], s2a[4], s2b[4];
#pragma unroll
            for (int j = 0; j < 4; ++j) { s1a[j] = 0.f; s1b[j] = 0.f; s2a[j] = 0.f; s2b[j] = 0.f; }
#pragma unroll 4
            for (int dp = 0; dp < 32; ++dp) {
                const float k1a0 = K1[(2 * dp) * 128 + lane], k1b0 = K1[(2 * dp) * 128 + lane + 64], k1a1 = K1[(2 * dp + 1) * 128 + lane], k1b1 = K1[(2 * dp + 1) * 128 + lane + 64];
                const float k2a0 = K2[(2 * dp) * 128 + lane], k2b0 = K2[(2 * dp) * 128 + lane + 64], k2a1 = K2[(2 * dp + 1) * 128 + lane], k2b1 = K2[(2 * dp + 1) * 128 + lane + 64];
#pragma unroll
                for (int j = 0; j < 4; ++j) {
                    const unsigned q1 = (unsigned)__builtin_amdgcn_readlane((int)qv[j], dp), q2 = (unsigned)__builtin_amdgcn_readlane((int)qv[j], 32 + dp);
                    const float q1l = bflo(q1), q1h = bfhi(q1), q2l = bflo(q2), q2h = bfhi(q2);
                    s1a[j] += q1l * k1a0 + q1h * k1a1; s1b[j] += q1l * k1b0 + q1h * k1b1;
                    s2a[j] += q2l * k2a0 + q2h * k2a1; s2b[j] += q2l * k2b0 + q2h * k2b1;
                }
            }
#pragma unroll
            for (int j = 0; j < 4; ++j) {
                unsigned list1 = 0u, list2 = 0u;
                {
                    unsigned ka = (ord_key(s1a[j]) & ~0x7Fu) | (unsigned)(127 - lane), kb = (ord_key(s1b[j]) & ~0x7Fu) | (unsigned)(63 - lane);
                    for (int it = 0; it < 16; ++it) { const unsigned wm = wave_max_u32(umax_(ka, kb)); if (ka == wm) ka = 0u; if (kb == wm) kb = 0u; if (lane == it) list1 = wm; }
                }
                {
                    unsigned ka = (ord_key(s2a[j]) & ~0x7Fu) | (unsigned)(127 - lane), kb = (ord_key(s2b[j]) & ~0x7Fu) | (unsigned)(63 - lane);
                    for (int it = 0; it < 16; ++it) { const unsigned wm = wave_max_u32(umax_(ka, kb)); if (ka == wm) ka = 0u; if (kb == wm) kb = 0u; if (lane == it) list2 = wm; }
                }
                const unsigned k1c = (unsigned)__shfl((int)list1, ci), k2c = (unsigned)__shfl((int)list2, cj);
                const float cand = key_val(k1c & ~0x7Fu) + key_val(k2c & ~0x7Fu);
                unsigned ckey = cvalid ? ((ord_key(cand) & ~0x3Fu) | (unsigned)(63 - lane)) : 0u;
                unsigned sel = 0u;
                for (int it = 0; it < 16; ++it) { const unsigned wm = wave_max_u32(ckey); if (ckey == wm) ckey = 0u; if (lane == it) sel = wm; }
                const int pos = 63 - (int)(sel & 63u);
                const float sv = key_val(sel & ~0x3Fu);
                const unsigned e1 = (unsigned)__shfl((int)k1c, pos), e2 = (unsigned)__shfl((int)k2c, pos);
                const int eid = (127 - (int)(e1 & 127u)) * 128 + (127 - (int)(e2 & 127u));
                const float mx = __shfl(sv, 0);
                float ev = lane < 16 ? __expf(sv - mx) : 0.f;
                float sum = ev;
                sum += __shfl_xor(sum, 1); sum += __shfl_xor(sum, 2); sum += __shfl_xor(sum, 4); sum += __shfl_xor(sum, 8);
                if (lane < 16) { const size_t o = (size_t)(tok0 + wave * 4 + j) * 128 + h * 16 + lane; SELID[o] = eid; SELG[o] = ev * rcpf_(sum); }
            }
        }
    }
}

DI f32x2 pkfma(f32x2 a, f32x2 b, f32x2 c) { return __builtin_elementwise_fma(a, b, c); }
DI void peer_gather(const Params& p, LAS unsigned char* lds) {
    const int tid = threadIdx.x, lane = tid & 63, wave = __builtin_amdgcn_readfirstlane(tid >> 6);
    LAS float* scr = (LAS float*)lds + wave * (16 * 68);
    LAS float* cfl = (LAS float*)(lds + 8 * 16 * 68 * 4) + wave * 128;
    const unsigned char* Ub = p.ws + WS_UB; const unsigned char* Vb = p.ws + WS_VB;
    const float* PSS2 = (const float*)(p.ws + WS_PSS2);
    const int* SELID = (const int*)(p.ws + WS_SELID); const float* SELG = (const float*)(p.ws + WS_SELG);
    const int gw = blockIdx.x * 8 + wave, nw = gridDim.x * 8;
    for (int t = gw; t < T_TOK; t += nw) {
        const int idA = SELID[(size_t)t * 128 + lane], idB = SELID[(size_t)t * 128 + 64 + lane];
        const float gA = SELG[(size_t)t * 128 + lane], gB = SELG[(size_t)t * 128 + 64 + lane];
        float* xrow = p.out + (size_t)t * DM;
        const float pv = lane < 32 ? PSS2[(size_t)t * 32 + lane] : 0.f;
        const float rstd2 = rsqrtf(wave_sum(pv) * (1.f / 2048.f) + EPS);
        f32x2 h2[16];
#pragma unroll
        for (int hf = 0; hf < 2; ++hf)
#pragma unroll
            for (int q = 0; q < 4; ++q) {
                const f32x4 x0 = *(const f32x4*)(xrow + hf * 1024 + lane * 16 + q * 4), g0 = *(const f32x4*)(p.norm2_g + hf * 1024 + lane * 16 + q * 4);
                h2[hf * 8 + q * 2] = (f32x2){x0[0] * rstd2 * g0[0], x0[1] * rstd2 * g0[1]};
                h2[hf * 8 + q * 2 + 1] = (f32x2){x0[2] * rstd2 * g0[2], x0[3] * rstd2 * g0[3]};
            }
        constexpr int NPK = 4;
        u32x4 buf[2][NPK][2];
#define PEER_LOAD(TB, st, base) do { const int idv_ = ((base) < 64) ? idA : idB; _Pragma("unroll") for (int e_ = 0; e_ < NPK; ++e_) { \
            const int id_ = __builtin_amdgcn_readlane(idv_, ((base) + e_) & 63); const unsigned char* r_ = (TB) + (size_t)id_ * DM + lane * 16; \
            buf[st][e_][0] = *(const u32x4*)r_; buf[st][e_][1] = *(const u32x4*)(r_ + 1024); } } while (0)
#define PEER_DOT(st, slot0) do { _Pragma("unroll") for (int e_ = 0; e_ < NPK; ++e_) { f32x2 a2_ = {0.f, 0.f}; \
            _Pragma("unroll") for (int hf_ = 0; hf_ < 2; ++hf_) _Pragma("unroll") for (int q_ = 0; q_ < 4; ++q_) { const int w_ = (int)buf[st][e_][hf_][q_]; \
                a2_ = pkfma(h2[hf_ * 8 + q_ * 2], __builtin_amdgcn_cvt_pk_f32_fp8(w_, false), a2_); a2_ = pkfma(h2[hf_ * 8 + q_ * 2 + 1], __builtin_amdgcn_cvt_pk_f32_fp8(w_, true), a2_); } \
            scr[((slot0) + e_) * 68 + lane] = a2_[0] + a2_[1]; } } while (0)
        PEER_LOAD(Ub, 0, 0);
        for (int b = 0; b < 128 / NPK; b += 2) {
            PEER_LOAD(Ub, 1, (b + 1) * NPK);
            PEER_DOT(0, (b * NPK) & 15);
            if (b + 2 < 128 / NPK) PEER_LOAD(Ub, 0, (b + 2) * NPK);
            PEER_DOT(1, ((b + 1) * NPK) & 15);
            if ((((b + 2) * NPK) & 15) == 0) {
                WAVE_LDS_SYNC();
                float sum = 0.f;
#pragma unroll
                for (int i = 0; i < 4; ++i) { const f32x4 r = *(const LAS f32x4*)(scr + (lane >> 2) * 68 + (lane & 3) * 16 + 4 * i); sum += (r[0] + r[1]) + (r[2] + r[3]); }
                sum += __shfl_xor(sum, 1); sum += __shfl_xor(sum, 2);
                const int k0 = (b + 2) * NPK - 16;
                const int k = k0 + (lane >> 2);
                const float gate = __shfl((k0 < 64) ? gA : gB, k & 63);
                if ((lane & 3) == 0) cfl[k] = gate * gelu_t(sum * (1.f / 64.f)) * (1.f / 16.f);
                WAVE_LDS_SYNC();
            }
        }
        f32x2 acc[16];
#pragma unroll
        for (int i = 0; i < 16; ++i) acc[i] = (f32x2){0.f, 0.f};
#define PEER_AXPY(st, base) do { _Pragma("unroll") for (int e_ = 0; e_ < NPK; ++e_) { const float c_ = cfl[(base) + e_]; const f32x2 c2_ = {c_, c_}; \
            _Pragma("unroll") for (int hf_ = 0; hf_ < 2; ++hf_) _Pragma("unroll") for (int q_ = 0; q_ < 4; ++q_) { const int w_ = (int)buf[st][e_][hf_][q_]; \
                acc[hf_ * 8 + q_ * 2] = pkfma(c2_, __builtin_amdgcn_cvt_pk_f32_fp8(w_, false), acc[hf_ * 8 + q_ * 2]); \
                acc[hf_ * 8 + q_ * 2 + 1] = pkfma(c2_, __builtin_amdgcn_cvt_pk_f32_fp8(w_, true), acc[hf_ * 8 + q_ * 2 + 1]); } } } while (0)
        PEER_LOAD(Vb, 0, 0);
        for (int b = 0; b < 128 / NPK; b += 2) {
            PEER_LOAD(Vb, 1, (b + 1) * NPK);
            PEER_AXPY(0, b * NPK);
            if (b + 2 < 128 / NPK) PEER_LOAD(Vb, 0, (b + 2) * NPK);
            PEER_AXPY(1, (b + 1) * NPK);
        }
        float ss = 0.f;
#pragma unroll
        for (int hf = 0; hf < 2; ++hf)
#pragma unroll
            for (int q = 0; q < 4; ++q) {
                const f32x4 x0 = *(const f32x4*)(xrow + hf * 1024 + lane * 16 + q * 4);
                acc[hf * 8 + q * 2] += (f32x2){x0[0], x0[1]}; acc[hf * 8 + q * 2 + 1] += (f32x2){x0[2], x0[3]};
                const f32x2 a = acc[hf * 8 + q * 2], b = acc[hf * 8 + q * 2 + 1];
                ss += (a[0] * a[0] + a[1] * a[1]) + (b[0] * b[0] + b[1] * b[1]);
            }
        const float rstd = rsqrtf(wave_sum(ss) * (1.f / 2048.f) + EPS);
#pragma unroll
        for (int hf = 0; hf < 2; ++hf)
#pragma unroll
            for (int q = 0; q < 4; ++q) {
                const f32x4 g0 = *(const f32x4*)(p.final_g + hf * 1024 + lane * 16 + q * 4);
                const f32x2 a = acc[hf * 8 + q * 2], b = acc[hf * 8 + q * 2 + 1];
                const f32x4 o0 = {a[0] * rstd * g0[0], a[1] * rstd * g0[1], b[0] * rstd * g0[2], b[1] * rstd * g0[3]};
                *(f32x4*)(xrow + hf * 1024 + lane * 16 + q * 4) = o0;
            }
        WAVE_LDS_SYNC();
    }
}

#ifndef PROBE_DUP
#define PROBE_DUP 0
#endif
#define REP(bit) for (int rep_ = 0; rep_ < (((PROBE_DUP) >> (bit)) & 1) + 1; ++rep_)
#define PH1() { pg8::Gemm g{(const bf16_t*)(p.ws + WS_XN), (const bf16_t*)(p.ws + WS_WINT), T_TOK, NPROJ, DM}; pg8::StaticOrder S; S.init(T_TOK, NPROJ, G, bx); Epi1 E{(bf16_t*)(p.ws + WS_P), (float*)(p.ws + WS_PSSV)}; pg8::gemm_phase<Epi1, pg8::StaticOrder, true, true>(lds, g, S, E); grid.sync(); }
#define PH3() { pg8::Gemm g{(const bf16_t*)(p.ws + WS_XN), (const bf16_t*)(p.ws + WS_WOUTT), T_TOK, DM, DM}; pg8::StaticOrder S; S.init(T_TOK, DM, G, bx); Epi2 E{p.x, p.out, (bf16_t*)(p.ws + WS_X1G), p.norm2_g, (float*)(p.ws + WS_PSS2)}; pg8::gemm_phase<Epi2, pg8::StaticOrder, true, true>(lds, g, S, E); grid.sync(); }
#define PH4() { pg8::Gemm g{(const bf16_t*)(p.ws + WS_X1G), (const bf16_t*)(p.ws + WS_WQT), T_TOK, 1024, DM}; pg8::StaticOrder S; S.init(T_TOK, 1024, G, bx); Epi3 E{(bf16_t*)(p.ws + WS_Q), (const float*)(p.ws + WS_PSS2)}; pg8::gemm_phase<Epi3, pg8::StaticOrder, true, true>(lds, g, S, E); grid.sync(); }
__global__ void __launch_bounds__(NTHREADS, 2) hymba_fwd(Params p) {
    extern __shared__ __attribute__((aligned(16))) unsigned char smem[];
    LAS unsigned char* lds = (LAS unsigned char*)smem;
    cg::grid_group grid = cg::this_grid();
    const int G = gridDim.x, bx = blockIdx.x;
    REP(0) { phase0(p, lds); grid.sync(); }
    PH1()
#if (PROBE_DUP >> 1) & 1
    PH1()
#endif
    REP(2) {
        for (int si = bx; si < 256; si += G) {
            const int b = si >> 6, c = si & 63;
            gmlp_bc(p, lds, b, c);
            for (int h = 0; h < 4; ++h) mlstm_local(p, lds, b, c, h);
        }
        grid.sync();
    }
    REP(3) { phase_scan(p); grid.sync(); }
    REP(4) { for (int it = bx; it < 1024; it += G) mlstm_out(p, lds, it >> 8, (it >> 2) & 63, it & 3); grid.sync(); }
    PH3()
#if (PROBE_DUP >> 5) & 1
    PH3()
#endif
    PH4()
#if (PROBE_DUP >> 6) & 1
    PH4()
#endif
    peer_select(p, lds);
    grid.sync();
    peer_gather(p, lds);
}

extern "C" void kernel_launch(void* const* d_in, const int* in_sizes, int n_in, void* d_out, int out_size, void* d_ws, size_t ws_size, hipStream_t stream) {
    static int grid_blocks = 0;
    if (grid_blocks == 0) {
        if (n_in != 20 || ws_size < WS_END) { fprintf(stderr, "kernel_launch: unexpected n_in %d or ws_size %zu (need %zu)\n", n_in, ws_size, (size_t)WS_END); grid_blocks = -1; return; }
        int dev = 0, cus = 0, per_cu = 0;
        hipGetDevice(&dev);
        hipDeviceGetAttribute(&cus, hipDeviceAttributeMultiprocessorCount, dev);
        hipFuncSetAttribute((const void*)hymba_fwd, hipFuncAttributeMaxDynamicSharedMemorySize, LDS_BYTES);
        hipOccupancyMaxActiveBlocksPerMultiprocessor(&per_cu, (const void*)hymba_fwd, NTHREADS, LDS_BYTES);
        if (per_cu < 1) { fprintf(stderr, "kernel_launch: occupancy query says %d blocks per CU\n", per_cu); per_cu = 1; }
        if (per_cu > 1) per_cu = 1;
        grid_blocks = cus * per_cu;
        (void)hipGetLastError();
    }
    if (grid_blocks < 0) return;
    Params p{};
    p.x = (const float*)d_in[0]; p.norm1_g = (const float*)d_in[1]; p.w_in = (const float*)d_in[2]; p.gm_vnorm_g = (const float*)d_in[3];
    p.w_spatial = (const float*)d_in[4]; p.b_spatial = (const float*)d_in[5]; p.ml_conv_w = (const float*)d_in[6]; p.ml_conv_b = (const float*)d_in[7];
    p.ml_b_i = (const float*)d_in[8]; p.ml_b_f = (const float*)d_in[9]; p.gm_out_g = (const float*)d_in[10]; p.ml_out_g = (const float*)d_in[11];
    p.w_out = (const float*)d_in[12]; p.norm2_g = (const float*)d_in[13]; p.peer_wq = (const float*)d_in[14]; p.peer_k1 = (const float*)d_in[15];
    p.peer_k2 = (const float*)d_in[16]; p.peer_u = (const float*)d_in[17]; p.peer_v = (const float*)d_in[18]; p.final_g = (const float*)d_in[19];
    p.out = (float*)d_out; p.ws = (unsigned char*)d_ws;
    void* args[] = {&p};
    hipError_t e = hipLaunchCooperativeKernel((const void*)hymba_fwd, dim3(grid_blocks), dim3(NTHREADS), args, LDS_BYTES, stream);
    if (e != hipSuccess) fprintf(stderr, "cooperative launch failed: %s (grid %d)\n", hipGetErrorString(e), grid_blocks);
}
```

```cpp
#include <hip/hip_runtime.h>
#include <hip/hip_cooperative_groups.h>
#include <cstdio>
#include <cstdint>
namespace cg = cooperative_groups;
namespace pg8 {
#define PG8_LAS __attribute__((address_space(3)))
typedef unsigned short bf16_t;
typedef short bf16x8 __attribute__((ext_vector_type(8)));
typedef float f32x4 __attribute__((ext_vector_type(4)));
typedef unsigned u32x4 __attribute__((ext_vector_type(4)));
constexpr int BM = 256, BK = 64, HALF = 128, HTB = HALF * BK * 2  , STAGE_BYTES = 8 * HTB, NXCD = 8, WGM = 8;

__host__ __device__ __forceinline__ int lds_byte(int r, int c) { const int st = (r >> 4) * 2 + (c >> 5), rr = r & 15, cc = c & 31, ob = rr * 64 + cc * 2; return st * 1024 + (ob ^ (((ob >> 9) & 1) << 5)); }
__host__ __device__ __forceinline__ void stage_rc(int b, int& R, int& C) { const int st = b / 1024, sb = b % 1024, swz = sb ^ (((sb >> 9) & 1) << 5); R = (st >> 1) * 16 + swz / 64; C = (st & 1) * 32 + (swz % 64) / 2; }
__host__ __device__ __forceinline__ int perm32(int rho) { const int n = rho >> 4, i = rho & 15; return 8 * (i >> 2) + 4 * n + (i & 3); }

struct Unit { int pm, pn; };
struct Gemm { const bf16_t* A; const bf16_t* Bt; int M, N, K; };

struct StaticOrder {
    int nM, nN, nwg, G, c;
    __host__ __device__ void init(int M, int N, int G_, int c_) { nM = M / BM; nN = N / BM; nwg = nM * nN; G = G_; c = c_; }
    __host__ __device__ bool next(int i, Unit& u) const {
        const long L = (long)i * G + c; if (L >= nwg) return false;
        int wgid = (int)L; { const int q = nwg / NXCD, r = nwg % NXCD, xcd = wgid % NXCD, off = wgid / NXCD; wgid = (xcd < r ? xcd * (q + 1) : r * (q + 1) + (xcd - r) * q) + off; }
        const int nig = WGM * nN, gid = wgid / nig, fm = gid * WGM, gsz = (nM - fm) < WGM ? (nM - fm) : WGM;
        u.pm = fm + ((wgid % nig) % gsz); u.pn = (wgid % nig) / gsz; return true;
    }
    __device__ __forceinline__ void a_ready(const Unit&) const {}
    __device__ __forceinline__ void done(const Unit&) const {}
};
__device__ __forceinline__ unsigned cvt_pk_bf16(float lo, float hi) { unsigned r; asm volatile("v_cvt_pk_bf16_f32 %0, %1, %2" : "=v"(r) : "v"(lo), "v"(hi)); return r; }
template <class Epi, class Sched, bool ALIGN_EPI = false, bool SP2 = false>
__device__ __forceinline__ void gemm_phase(PG8_LAS unsigned char* lds, const Gemm g, const Sched& S, const Epi& E) {
    const int tid = threadIdx.x, wid = __builtin_amdgcn_readfirstlane(tid >> 6), lane = tid & 63, wr = wid >> 2, wc = wid & 3, fr = lane & 15, fq = lane >> 4;
    const int K = g.K, nt = K / BK;
    unsigned voffA[2], voffB[2];
#pragma unroll
    for (int i = 0; i < 2; ++i) { int R, C; stage_rc(tid * 16 + i * 8192, R, C); const int Rb = Epi::PERM ? ((R & ~31) + perm32(R & 31)) : R;
        voffA[i] = (unsigned)(R * K + C) * 2u; voffB[i] = (unsigned)(Rb * K + C) * 2u; }
    const size_t kstep = (size_t)(BK * 2);
    const size_t hstep = (size_t)HALF * K * 2;
    const size_t tstep = 2 * hstep;
    const unsigned ldsw = (unsigned)wid * 1024u;
    const int aoff = lds_byte(wr * 64 + fr, fq * 8), boff = lds_byte(wc * 32 + fr, fq * 8);
#define PG8_SA(b, h) (((b) * 2 + (h)) * HTB)
#define PG8_SB(b, h) ((4 + (b) * 2 + (h)) * HTB)
#define PG8_STAGE(bufoff, gbase, voff) do { _Pragma("unroll") for (int _i = 0; _i < 2; ++_i) \
        __builtin_amdgcn_global_load_lds((const unsigned*)((const char*)(gbase) + (voff)[_i]), (PG8_LAS unsigned*)(lds + (bufoff) + ldsw + _i * 8192), 16, 0, 0); } while (0)
#define PG8_LDA(dst, b, h) do { _Pragma("unroll") for (int m = 0; m < 4; ++m) _Pragma("unroll") for (int k = 0; k < 2; ++k) dst[m][k] = *(const PG8_LAS bf16x8*)(lds + PG8_SA(b, h) + aoff + m * 2048 + k * 1024); } while (0)
#define PG8_LDB(dst, b, h) do { _Pragma("unroll") for (int n = 0; n < 2; ++n) _Pragma("unroll") for (int k = 0; k < 2; ++k) dst[n][k] = *(const PG8_LAS bf16x8*)(lds + PG8_SB(b, h) + boff + n * 2048 + k * 1024); } while (0)
#define PG8_MMA(ai, bj, At, Bt) do { __builtin_amdgcn_s_setprio(1); _Pragma("unroll") for (int m = 0; m < 4; ++m) _Pragma("unroll") for (int n = 0; n < 2; ++n) _Pragma("unroll") for (int k = 0; k < 2; ++k) \
        acc[ai][bj][m][n] = __builtin_amdgcn_mfma_f32_16x16x32_bf16(Bt[n][k], At[m][k], acc[ai][bj][m][n], 0, 0, 0); __builtin_amdgcn_s_setprio(0); } while (0)
#define PG8_WAIT_V(n) asm volatile("s_waitcnt vmcnt(" #n ")" ::: "memory")
#define PG8_WAIT_L(n) asm volatile("s_waitcnt lgkmcnt(" #n ")" ::: "memory")
#define PG8_BAR __builtin_amdgcn_s_barrier()
#define PG8_SCHED __builtin_amdgcn_sched_barrier(0)
    Unit cur, nxt; int ui = 0;
    if (!S.next(0, cur)) return;
    f32x4 acc[2][2][4][2];
#pragma unroll
    for (int a = 0; a < 2; ++a)
#pragma unroll
        for (int b = 0; b < 2; ++b)
#pragma unroll
            for (int m = 0; m < 4; ++m)
#pragma unroll
                for (int n = 0; n < 2; ++n) acc[a][b][m][n] = (f32x4){0.f, 0.f, 0.f, 0.f};
    bf16x8 At[4][2], B0[2][2], B1[2][2];
    const char* cA = (const char*)g.A + (size_t)cur.pm * tstep; const char* cB = (const char*)g.Bt + (size_t)cur.pn * tstep;
    S.a_ready(cur);
    if constexpr (SP2) {
        PG8_STAGE(PG8_SB(0, 0), cB, voffB); PG8_STAGE(PG8_SB(0, 1), cB + hstep, voffB); PG8_STAGE(PG8_SA(0, 0), cA, voffA); PG8_STAGE(PG8_SA(0, 1), cA + hstep, voffA);
        if (wr == 1) PG8_BAR;
        PG8_WAIT_V(2); PG8_BAR;
        PG8_STAGE(PG8_SB(1, 0), cB + kstep, voffB); PG8_STAGE(PG8_SA(1, 0), cA + kstep, voffA); PG8_STAGE(PG8_SB(1, 1), cB + hstep + kstep, voffB);
        PG8_WAIT_V(6); PG8_BAR;
    } else {
        PG8_STAGE(PG8_SB(0, 0), cB, voffB); PG8_STAGE(PG8_SA(0, 0), cA, voffA); PG8_STAGE(PG8_SB(0, 1), cB + hstep, voffB); PG8_STAGE(PG8_SA(0, 1), cA + hstep, voffA);
        if (wr == 1) PG8_BAR;
        PG8_WAIT_V(4); PG8_BAR;
        PG8_STAGE(PG8_SB(1, 0), cB + kstep, voffB); PG8_STAGE(PG8_SA(1, 0), cA + kstep, voffA); PG8_STAGE(PG8_SB(1, 1), cB + hstep + kstep, voffB);
        PG8_WAIT_V(6); PG8_BAR;
    }
    for (;;) {
        const bool has_next = S.next(ui + 1, nxt);
        const char* nA = has_next ? (const char*)g.A + (size_t)nxt.pm * tstep : cA; const char* nB = has_next ? (const char*)g.Bt + (size_t)nxt.pn * tstep : cB;
        for (int t = 0; t < nt; t += 2) {
            const bool last = (t == nt - 2);
            const char* a1 = cA + (size_t)(t + 1) * kstep;
            const char* a2 = last ? nA : cA + (size_t)(t + 2) * kstep; const char* b2 = last ? nB : cB + (size_t)(t + 2) * kstep;
            const char* a3 = a2 + kstep; const char* b3 = b2 + kstep;
            if (last && has_next) S.a_ready(nxt);
            if constexpr (SP2) {
            PG8_LDB(B0, 0, 0); PG8_LDB(B1, 0, 1); PG8_SCHED; PG8_LDA(At, 0, 0); PG8_STAGE(PG8_SA(1, 1), a1 + hstep, voffA);
            PG8_WAIT_V(8); PG8_WAIT_L(0); PG8_BAR; PG8_MMA(0, 0, At, B0); PG8_MMA(0, 1, At, B1); PG8_BAR; PG8_SCHED;
            PG8_LDA(At, 0, 1); PG8_STAGE(PG8_SB(0, 0), b2, voffB); PG8_STAGE(PG8_SB(0, 1), b2 + hstep, voffB); PG8_STAGE(PG8_SA(0, 0), a2, voffA);
            PG8_WAIT_V(8); PG8_WAIT_L(0); PG8_BAR; PG8_MMA(1, 0, At, B0); PG8_MMA(1, 1, At, B1); PG8_BAR; PG8_SCHED;
            PG8_LDB(B0, 1, 0); PG8_LDB(B1, 1, 1); PG8_SCHED; PG8_LDA(At, 1, 0); PG8_STAGE(PG8_SA(0, 1), a2 + hstep, voffA);
            PG8_WAIT_V(8); PG8_WAIT_L(0); PG8_BAR; PG8_MMA(0, 0, At, B0); PG8_MMA(0, 1, At, B1); PG8_BAR; PG8_SCHED;
            PG8_LDA(At, 1, 1); PG8_STAGE(PG8_SB(1, 0), b3, voffB); PG8_STAGE(PG8_SB(1, 1), b3 + hstep, voffB); PG8_STAGE(PG8_SA(1, 0), a3, voffA);
            PG8_WAIT_V(8); PG8_WAIT_L(0); PG8_BAR; PG8_MMA(1, 0, At, B0); PG8_MMA(1, 1, At, B1); PG8_BAR; PG8_SCHED;
            } else {
            PG8_LDB(B0, 0, 0); PG8_SCHED; PG8_LDA(At, 0, 0); PG8_STAGE(PG8_SA(1, 1), a1 + hstep, voffA);
            PG8_WAIT_L(8); PG8_BAR; PG8_WAIT_L(0); PG8_MMA(0, 0, At, B0); PG8_BAR; PG8_SCHED;
            PG8_LDB(B1, 0, 1); PG8_STAGE(PG8_SB(0, 0), b2, voffB);
            PG8_BAR; PG8_WAIT_L(0); PG8_MMA(0, 1, At, B1); PG8_BAR;
            PG8_LDA(At, 0, 1); PG8_STAGE(PG8_SA(0, 0), a2, voffA);
            PG8_BAR; PG8_WAIT_L(0); PG8_MMA(1, 0, At, B0); PG8_BAR; PG8_SCHED;
            PG8_STAGE(PG8_SB(0, 1), b2 + hstep, voffB);
            PG8_WAIT_V(6); PG8_BAR; PG8_MMA(1, 1, At, B1); PG8_BAR;
            PG8_LDB(B0, 1, 0); PG8_SCHED; PG8_LDA(At, 1, 0); PG8_STAGE(PG8_SA(0, 1), a2 + hstep, voffA);
            PG8_WAIT_L(8); PG8_BAR; PG8_WAIT_L(0); PG8_MMA(0, 0, At, B0); PG8_BAR; PG8_SCHED;
            PG8_LDB(B1, 1, 1); PG8_STAGE(PG8_SB(1, 0), b3, voffB);
            PG8_BAR; PG8_WAIT_L(0); PG8_MMA(0, 1, At, B1); PG8_BAR;
            PG8_LDA(At, 1, 1); PG8_STAGE(PG8_SA(1, 0), a3, voffA);
            PG8_BAR; PG8_WAIT_L(0); PG8_MMA(1, 0, At, B0); PG8_BAR; PG8_SCHED;
            PG8_STAGE(PG8_SB(1, 1), b3 + hstep, voffB);
            PG8_WAIT_V(6); PG8_BAR; PG8_MMA(1, 1, At, B1); PG8_BAR;
            }
        }
        if constexpr (ALIGN_EPI) { if (wr == 0) PG8_BAR; }
        if constexpr (!Epi::AFTER_DRAIN) { E(acc, cur, wr, wc, fr, fq); S.done(cur); }
        if (!has_next) break;
#pragma unroll
        for (int a = 0; a < 2; ++a)
#pragma unroll
            for (int b = 0; b < 2; ++b)
#pragma unroll
                for (int m = 0; m < 4; ++m)
#pragma unroll
                    for (int n = 0; n < 2; ++n) acc[a][b][m][n] = (f32x4){0.f, 0.f, 0.f, 0.f};
        cur = nxt; cA = nA; cB = nB; ++ui;
        if constexpr (ALIGN_EPI) { if (wr == 1) PG8_BAR; }
    }
    PG8_WAIT_V(0);
    if constexpr (!ALIGN_EPI) { if (wr == 0) PG8_BAR; }
    PG8_BAR;
    if constexpr (Epi::AFTER_DRAIN) { E.fused(acc, cur, wr, wc, fr, fq, lds, wid, lane); S.done(cur); }
#undef PG8_SA
#undef PG8_SB
#undef PG8_STAGE
#undef PG8_LDA
#undef PG8_LDB
#undef PG8_MMA
#undef PG8_WAIT_V
#undef PG8_WAIT_L
#undef PG8_BAR
#undef PG8_SCHED
}
}

#define LAS __attribute__((address_space(3)))
#define DI __device__ __forceinline__
using pg8::bf16_t; using pg8::bf16x8; using pg8::f32x4; using pg8::u32x4; using pg8::cvt_pk_bf16;
typedef unsigned u32x2 __attribute__((ext_vector_type(2)));
typedef float f32x2 __attribute__((ext_vector_type(2)));

constexpr int T_TOK = 32768, DM = 2048, NPROJ = 5120, PROJW = 5128;
constexpr int NTHREADS = 512;
constexpr int LDS_BYTES = 147456;
constexpr float EPS = 1e-6f;

constexpr size_t WS_XN = 0;
constexpr size_t WS_P = 134217728;
constexpr size_t WS_X1G = WS_P;
constexpr size_t WS_Q = WS_P + 134217728;
constexpr size_t WS_WINT = WS_P + 335544320;
constexpr size_t WS_WOUTT = WS_WINT + 20971520;
constexpr size_t WS_WQT = WS_WOUTT + 8388608;
constexpr size_t WS_UB = WS_WQT + 4194304;
constexpr size_t WS_VB = WS_UB + 67108864;
constexpr size_t WS_ST = WS_VB + 67108864;
constexpr size_t WS_CPT = WS_ST + 142606336;
constexpr size_t WS_QC = WS_CPT + 71303168;
constexpr size_t WS_KC = WS_QC + 33554432;
constexpr size_t WS_IG = WS_KC + 33554432;
constexpr size_t WS_LF = WS_IG + 524288;
constexpr size_t WS_PSSV = WS_LF + 524288;
constexpr size_t WS_PSS2 = WS_PSSV + 2097152;
constexpr size_t WS_BEND = WS_PSS2 + 4194304;
constexpr size_t WS_GMAX = WS_BEND + 4096;
constexpr size_t WS_MPREV = WS_GMAX + 4096;
constexpr size_t WS_SELID = WS_MPREV + 4096;
constexpr size_t WS_SELG = WS_SELID + 16777216;
constexpr size_t WS_KB1 = WS_SELG + 16777216;
constexpr size_t WS_KB2 = WS_KB1 + 131072;
constexpr size_t WS_END = WS_KB2 + 131072;

struct Params {
    const float *x, *norm1_g, *w_in, *gm_vnorm_g, *w_spatial, *b_spatial, *ml_conv_w, *ml_conv_b, *ml_b_i, *ml_b_f, *gm_out_g, *ml_out_g, *w_out, *norm2_g,
        *peer_wq, *peer_k1, *peer_k2, *peer_u, *peer_v, *final_g;
    float* out;
    unsigned char* ws;
};

DI float bf2f(unsigned short h) { return __uint_as_float(((unsigned)h) << 16); }
DI float bflo(unsigned w) { return __uint_as_float(w << 16); }
DI float bfhi(unsigned w) { return __uint_as_float(w & 0xffff0000u); }
DI float rcpf_(float x) { return __builtin_amdgcn_rcpf(x); }
DI float sigmoid_(float x) { return rcpf_(1.f + __expf(-x)); }
DI float gelu_t(float x) { const float z = 1.5957691216057308f * (x + 0.044715f * x * x * x); return x * rcpf_(1.f + __expf(-z)); }
DI float wave_sum(float v) {
#pragma unroll
    for (int o = 32; o; o >>= 1) v += __shfl_xor(v, o);
    return v;
}
DI float wave_max(float v) {
#pragma unroll
    for (int o = 32; o; o >>= 1) v = fmaxf(v, __shfl_xor(v, o));
    return v;
}
DI bf16x8 ld_frag_lds(const LAS unsigned char* p) { return *(const LAS bf16x8*)p; }
#define MFMA16(a, b, c) __builtin_amdgcn_mfma_f32_16x16x32_bf16((a), (b), (c), 0, 0, 0)

struct Epi1 {
    static constexpr bool PERM = true, AFTER_DRAIN = false;
    bf16_t* P; float* pssv;
    DI void operator()(const f32x4 (&acc)[2][2][4][2], const pg8::Unit& u, int wr, int wc, int fr, int fq) const {
        const int row0 = u.pm * 256 + wr * 64 + fr, col0 = u.pn * 256 + wc * 32 + 8 * fq;
        const int mode = u.pn < 8 ? 1 : (u.pn >= 16 ? 2 : 0);
        const bool want_ss = (u.pn >= 4 && u.pn < 8);
#pragma unroll
        for (int ai = 0; ai < 2; ++ai)
#pragma unroll
            for (int m = 0; m < 4; ++m) {
                const int row = row0 + ai * 128 + m * 16;
                bf16_t* rowp = P + (size_t)row * NPROJ + col0;
                float ss = 0.f;
#pragma unroll
                for (int bj = 0; bj < 2; ++bj) {
                    f32x4 v0 = acc[ai][bj][m][0], v1 = acc[ai][bj][m][1];
                    if (mode == 1) {
#pragma unroll
                        for (int j = 0; j < 4; ++j) { v0[j] = gelu_t(v0[j]); v1[j] = gelu_t(v1[j]); ss += v0[j] * v0[j] + v1[j] * v1[j]; }
                    } else if (mode == 2) {
#pragma unroll
                        for (int j = 0; j < 4; ++j) { v0[j] = sigmoid_(v0[j]); v1[j] = sigmoid_(v1[j]); }
                    }
                    u32x4 w; w.x = cvt_pk_bf16(v0[0], v0[1]); w.y = cvt_pk_bf16(v0[2], v0[3]); w.z = cvt_pk_bf16(v1[0], v1[1]); w.w = cvt_pk_bf16(v1[2], v1[3]);
                    *(u32x4*)(rowp + bj * 128) = w;
                }
                if (want_ss) {
                    ss += __shfl_xor(ss, 16); ss += __shfl_xor(ss, 32);
                    if (fq == 0) pssv[(size_t)row * 16 + (u.pn - 4) * 4 + wc] = ss;
                }
            }
    }
};

struct Epi2 {
    static constexpr bool PERM = true, AFTER_DRAIN = false;
    const float* x; float* x1; bf16_t* x1g; const float* g2; float* pss2;
    DI void operator()(const f32x4 (&acc)[2][2][4][2], const pg8::Unit& u, int wr, int wc, int fr, int fq) const {
        const int row0 = u.pm * 256 + wr * 64 + fr, col0 = u.pn * 256 + wc * 32 + 8 * fq;
#pragma unroll
        for (int ai = 0; ai < 2; ++ai)
#pragma unroll
            for (int m = 0; m < 4; ++m) {
                const int row = row0 + ai * 128 + m * 16;
                float ss = 0.f;
#pragma unroll
                for (int bj = 0; bj < 2; ++bj) {
                    const size_t o = (size_t)row * DM + col0 + bj * 128;
                    f32x4 v0 = acc[ai][bj][m][0] + *(const f32x4*)(x + o), v1 = acc[ai][bj][m][1] + *(const f32x4*)(x + o + 4);
                    *(f32x4*)(x1 + o) = v0; *(f32x4*)(x1 + o + 4) = v1;
                    const f32x4 ga = *(const f32x4*)(g2 + col0 + bj * 128), gb = *(const f32x4*)(g2 + col0 + bj * 128 + 4);
#pragma unroll
                    for (int j = 0; j < 4; ++j) ss += v0[j] * v0[j] + v1[j] * v1[j];
                    v0 = v0 * ga; v1 = v1 * gb;
                    u32x4 w; w.x = cvt_pk_bf16(v0[0], v0[1]); w.y = cvt_pk_bf16(v0[2], v0[3]); w.z = cvt_pk_bf16(v1[0], v1[1]); w.w = cvt_pk_bf16(v1[2], v1[3]);
                    *(u32x4*)(x1g + o) = w;
                }
                ss += __shfl_xor(ss, 16); ss += __shfl_xor(ss, 32);
                if (fq == 0) pss2[(size_t)row * 32 + u.pn * 4 + wc] = ss;
            }
    }
};

struct Epi3 {
    static constexpr bool PERM = true, AFTER_DRAIN = false;
    bf16_t* Q; const float* pss2;
    DI void operator()(const f32x4 (&acc)[2][2][4][2], const pg8::Unit& u, int wr, int wc, int fr, int fq) const {
        const int row0 = u.pm * 256 + wr * 64 + fr, col0 = u.pn * 256 + wc * 32 + 8 * fq;
#pragma unroll
        for (int ai = 0; ai < 2; ++ai)
#pragma unroll
            for (int m = 0; m < 4; ++m) {
                const int row = row0 + ai * 128 + m * 16;
                float ss = 0.f;
#pragma unroll
                for (int i = 0; i < 8; ++i) { const f32x4 t = *(const f32x4*)(pss2 + (size_t)row * 32 + i * 4); ss += (t[0] + t[1]) + (t[2] + t[3]); }
                const float rstd = rsqrtf(ss * (1.f / 2048.f) + EPS);
#pragma unroll
                for (int bj = 0; bj < 2; ++bj) {
                    const f32x4 v0 = acc[ai][bj][m][0] * rstd, v1 = acc[ai][bj][m][1] * rstd;
                    u32x4 w; w.x = cvt_pk_bf16(v0[0], v0[1]); w.y = cvt_pk_bf16(v0[2], v0[3]); w.z = cvt_pk_bf16(v1[0], v1[1]); w.w = cvt_pk_bf16(v1[2], v1[3]);
                    *(u32x4*)(Q + (size_t)row * 1024 + col0 + bj * 128) = w;
                }
            }
    }
};

DI void phase0(const Params& p, LAS unsigned char* lds) {
    const int tid = threadIdx.x, lane = tid & 63, wave = tid >> 6;
    bf16_t* XN = (bf16_t*)(p.ws + WS_XN);
    {
        LAS float* scr = (LAS float*)lds + wave * (64 * 65);
        const int gw = blockIdx.x * 8 + wave, nw = gridDim.x * 8;
        for (int it = gw; it < 4096; it += nw) {
            const float* W; bf16_t* WT; int ldw, kt, nt;
            if (it < 2560) { W = p.w_in; WT = (bf16_t*)(p.ws + WS_WINT); ldw = PROJW; kt = it / 80; nt = it % 80; }
            else if (it < 3584) { const int j = it - 2560; W = p.w_out; WT = (bf16_t*)(p.ws + WS_WOUTT); ldw = 2048; kt = j >> 5; nt = j & 31; }
            else { const int j = it - 3584; W = p.peer_wq; WT = (bf16_t*)(p.ws + WS_WQT); ldw = 1024; kt = j >> 4; nt = j & 15; }
            const int k0 = kt * 64, n0 = nt * 64;
#pragma unroll 8
            for (int r = 0; r < 64; ++r) scr[r * 65 + lane] = W[(size_t)(k0 + r) * ldw + n0 + lane];
            __builtin_amdgcn_fence(__ATOMIC_RELEASE, "wavefront"); __builtin_amdgcn_wave_barrier(); __builtin_amdgcn_fence(__ATOMIC_ACQUIRE, "wavefront");
            const int half = lane >> 5, kk = (lane & 31) * 2;
#pragma unroll 8
            for (int nn = 0; nn < 32; ++nn) {
                const int n = 2 * nn + half; const float a = scr[kk * 65 + n], b = scr[(kk + 1) * 65 + n];
                *(unsigned*)(WT + (size_t)(n0 + n) * 2048 + k0 + kk) = cvt_pk_bf16(a, b);
            }
            __builtin_amdgcn_fence(__ATOMIC_RELEASE, "wavefront"); __builtin_amdgcn_wave_barrier(); __builtin_amdgcn_fence(__ATOMIC_ACQUIRE, "wavefront");
        }
    }
    __syncthreads();
    {
        LAS float* wg = (LAS float*)lds;
        for (int idx = tid; idx < 4096; idx += NTHREADS) {
            const int k = idx >> 1, hf = idx & 1;
            const f32x4 v = *(const f32x4*)(p.w_in + (size_t)k * PROJW + 5120 + hf * 4);
            *(LAS f32x4*)(wg + k * 8 + (k >> 3) * 4 + hf * 4) = v;
        }
        __syncthreads();
        float* IG = (float*)(p.ws + WS_IG); float* LF = (float*)(p.ws + WS_LF);
        for (int row = blockIdx.x * 8 + wave; row < T_TOK; row += gridDim.x * 8) {
            const float* xr = p.x + (size_t)row * DM;
            f32x4 xv[8]; float ss = 0.f;
#pragma unroll
            for (int i = 0; i < 4; ++i) { xv[2 * i] = *(const f32x4*)(xr + i * 512 + lane * 8); xv[2 * i + 1] = *(const f32x4*)(xr + i * 512 + lane * 8 + 4); }
#pragma unroll
            for (int i = 0; i < 8; ++i) ss += (xv[i][0] * xv[i][0] + xv[i][1] * xv[i][1]) + (xv[i][2] * xv[i][2] + xv[i][3] * xv[i][3]);
            ss = wave_sum(ss);
            const float rstd = rsqrtf(ss * (1.f / 2048.f) + EPS);
            f32x4 ga = {0.f, 0.f, 0.f, 0.f}, gb = {0.f, 0.f, 0.f, 0.f};
#pragma unroll
            for (int i = 0; i < 4; ++i) {
                const f32x4 g0 = *(const f32x4*)(p.norm1_g + i * 512 + lane * 8), g1 = *(const f32x4*)(p.norm1_g + i * 512 + lane * 8 + 4);
                const f32x4 h0 = xv[2 * i] * rstd * g0, h1 = xv[2 * i + 1] * rstd * g1;
                u32x4 w; w.x = cvt_pk_bf16(h0[0], h0[1]); w.y = cvt_pk_bf16(h0[2], h0[3]); w.z = cvt_pk_bf16(h1[0], h1[1]); w.w = cvt_pk_bf16(h1[2], h1[3]);
                *(u32x4*)(XN + (size_t)row * DM + i * 512 + lane * 8) = w;
                const LAS float* wb = wg + (i * 512 + lane * 8) * 8 + (i * 64 + lane) * 4;
#pragma unroll
                for (int e = 0; e < 8; ++e) {
                    const float hv = e < 4 ? h0[e & 3] : h1[e & 3];
                    const f32x4 w0 = *(const LAS f32x4*)(wb + e * 8), w1 = *(const LAS f32x4*)(wb + e * 8 + 4);
                    ga = ga + w0 * hv; gb = gb + w1 * hv;
                }
            }
            float zi = 0.f;
#pragma unroll
            for (int j = 0; j < 4; ++j) { const float a = wave_sum(ga[j]), b = wave_sum(gb[j]); zi = (lane == j) ? a : zi; zi = (lane == 4 + j) ? b : zi; }
            if (lane < 4) IG[(size_t)row * 4 + lane] = zi + p.ml_b_i[lane];
            else if (lane < 8) { const float z = zi + p.ml_b_f[lane - 4]; LF[(size_t)row * 4 + lane - 4] = fminf(z, 0.f) - log1pf(__expf(-fabsf(z))); }
        }
    }
    {
        unsigned char* Ub = p.ws + WS_UB; unsigned char* Vb = p.ws + WS_VB;
        const size_t n16 = (size_t)16384 * 2048 / 16;
        for (size_t i = (size_t)blockIdx.x * NTHREADS + tid; i < n16; i += (size_t)gridDim.x * NTHREADS) {
            u32x4 wu, wv;
#pragma unroll
            for (int q = 0; q < 4; ++q) {
                const f32x4 a = *(const f32x4*)(p.peer_u + i * 16 + q * 4) * 64.f, b = *(const f32x4*)(p.peer_v + i * 16 + q * 4) * 16.f;
                int r = 0; r = __builtin_amdgcn_cvt_pk_fp8_f32(a[0], a[1], r, false); r = __builtin_amdgcn_cvt_pk_fp8_f32(a[2], a[3], r, true); wu[q] = (unsigned)r;
                int s = 0; s = __builtin_amdgcn_cvt_pk_fp8_f32(b[0], b[1], s, false); s = __builtin_amdgcn_cvt_pk_fp8_f32(b[2], b[3], s, true); wv[q] = (unsigned)s;
            }
            *(u32x4*)(Ub + i * 16) = wu; *(u32x4*)(Vb + i * 16) = wv;
        }
    }
    {
        bf16_t* KB1 = (bf16_t*)(p.ws + WS_KB1); bf16_t* KB2 = (bf16_t*)(p.ws + WS_KB2);
        for (int i = blockIdx.x * NTHREADS + tid; i < 65536 / 4; i += gridDim.x * NTHREADS) {
            const f32x4 a = *(const f32x4*)(p.peer_k1 + i * 4), b = *(const f32x4*)(p.peer_k2 + i * 4);
            u32x2 w; w.x = cvt_pk_bf16(a[0], a[1]); w.y = cvt_pk_bf16(a[2], a[3]); *(u32x2*)(KB1 + i * 4) = w;
            w.x = cvt_pk_bf16(b[0], b[1]); w.y = cvt_pk_bf16(b[2], b[3]); *(u32x2*)(KB2 + i * 4) = w;
        }
    }
}

#define WAVE_LDS_SYNC() do { __builtin_amdgcn_fence(__ATOMIC_RELEASE, "wavefront"); __builtin_amdgcn_wave_barrier(); __builtin_amdgcn_fence(__ATOMIC_ACQUIRE, "wavefront"); } while (0)

DI void stage_T(const bf16_t* src, int ld, int ngroups, LAS unsigned char* dst, int wave, int lane) {
    for (int g = wave; g < ngroups; g += 8) {
        const u32x4 r0 = *(const u32x4*)(src + (size_t)(2 * lane) * ld + g * 8);
        const u32x4 r1 = *(const u32x4*)(src + (size_t)(2 * lane + 1) * ld + g * 8);
#pragma unroll
        for (int w = 0; w < 4; ++w) {
            const unsigned a = r0[w], b = r1[w];
            *(LAS unsigned*)(dst + (g * 8 + 2 * w) * 272 + lane * 4) = (a & 0xffffu) | (b << 16);
            *(LAS unsigned*)(dst + (g * 8 + 2 * w + 1) * 272 + lane * 4) = (a >> 16) | (b & 0xffff0000u);
        }
    }
}

DI void gmlp_bc(const Params& p, LAS unsigned char* lds, int b, int c) {
    const int tid = threadIdx.x, lane = tid & 63, wave = __builtin_amdgcn_readfirstlane(tid >> 6), fr = lane & 15, fq = lane >> 4;
    const int t0 = b * 8192 + c * 128;
    LAS unsigned char* Wl = lds; LAS unsigned char* GvT = lds + 34816; LAS float* rstdv = (LAS float*)(lds + 69632);
    const bf16_t* P = (const bf16_t*)(p.ws + WS_P); bf16_t* YM = (bf16_t*)(p.ws + WS_XN);
    const float* PSSV = (const float*)(p.ws + WS_PSSV);
    __syncthreads();
    if (tid < 128) {
        float ss = 0.f;
#pragma unroll
        for (int i = 0; i < 4; ++i) { const f32x4 v = *(const f32x4*)(PSSV + (size_t)(t0 + tid) * 16 + i * 4); ss += (v[0] + v[1]) + (v[2] + v[3]); }
        rstdv[tid] = rsqrtf(ss * (1.f / 1024.f) + EPS);
    }
    for (int h = 0; h < 8; ++h) {
        __syncthreads();
#pragma unroll
        for (int it = 0; it < 4; ++it) {
            const int e = (it * NTHREADS + tid) * 8, t = e >> 7, s0 = e & 127;
            const float* wp = p.w_spatial + ((size_t)(h * 128 + t)) * 128 + s0;
            const f32x4 a0 = *(const f32x4*)wp, a1 = *(const f32x4*)(wp + 4);
            float v[8];
#pragma unroll
            for (int j = 0; j < 8; ++j) { const float a = j < 4 ? a0[j & 3] : a1[j & 3]; v[j] = (s0 + j <= t) ? a * rstdv[s0 + j] : 0.f; }
            u32x4 w; w.x = cvt_pk_bf16(v[0], v[1]); w.y = cvt_pk_bf16(v[2], v[3]); w.z = cvt_pk_bf16(v[4], v[5]); w.w = cvt_pk_bf16(v[6], v[7]);
            *(LAS u32x4*)(Wl + t * 272 + s0 * 2) = w;
        }
        stage_T(P + (size_t)t0 * NPROJ + 1024 + h * 128, NPROJ, 16, GvT, wave, lane);
        __syncthreads();
        f32x4 acc[8];
#pragma unroll
        for (int n = 0; n < 8; ++n) acc[n] = (f32x4){0.f, 0.f, 0.f, 0.f};
        const int kmax = (16 * wave + 15) >> 5;
#pragma unroll
        for (int kk = 0; kk < 4; ++kk) {
            if (kk <= kmax) {
                const bf16x8 bfrag = ld_frag_lds(Wl + (16 * wave + fr) * 272 + (32 * kk + 8 * fq) * 2);
#pragma unroll
                for (int n = 0; n < 8; ++n) { const bf16x8 afrag = ld_frag_lds(GvT + (16 * n + fr) * 272 + (32 * kk + 8 * fq) * 2); acc[n] = MFMA16(afrag, bfrag, acc[n]); }
            }
        }
        const int t = 16 * wave + fr; const size_t grow = (size_t)(t0 + t);
        const float bsp = p.b_spatial[h * 128 + t];
        float ss = 0.f;
#pragma unroll
        for (int n = 0; n < 8; ++n) {
            const int d0 = 16 * n + 4 * fq;
            const u32x2 uw = *(const u32x2*)(P + grow * NPROJ + h * 128 + d0);
            const f32x4 gv = *(const f32x4*)(p.gm_vnorm_g + h * 128 + d0);
            f32x4 y;
            y[0] = bflo(uw.x) * (gv[0] * acc[n][0] + bsp); y[1] = bfhi(uw.x) * (gv[1] * acc[n][1] + bsp);
            y[2] = bflo(uw.y) * (gv[2] * acc[n][2] + bsp); y[3] = bfhi(uw.y) * (gv[3] * acc[n][3] + bsp);
            ss += (y[0] * y[0] + y[1] * y[1]) + (y[2] * y[2] + y[3] * y[3]);
            acc[n] = y;
        }
        ss += __shfl_xor(ss, 16); ss += __shfl_xor(ss, 32);
        const float rstd = rsqrtf(ss * (1.f / 128.f) + EPS);
#pragma unroll
        for (int n = 0; n < 8; ++n) {
            const int d0 = 16 * n + 4 * fq;
            const f32x4 g = *(const f32x4*)(p.gm_out_g + h * 128 + d0);
            const f32x4 o = acc[n] * rstd * g;
            u32x2 w; w.x = cvt_pk_bf16(o[0], o[1]); w.y = cvt_pk_bf16(o[2], o[3]);
            *(u32x2*)(YM + grow * DM + h * 128 + d0) = w;
        }
    }
}

DI void mlstm_local(const Params& p, LAS unsigned char* lds, int b, int c, int h) {
    const int tid = threadIdx.x, lane = tid & 63, wave = __builtin_amdgcn_readfirstlane(tid >> 6), fr = lane & 15, fq = lane >> 4;
    const int bh = b * 4 + h, t0 = b * 8192 + c * 128;
    LAS unsigned char* KT = lds; LAS unsigned char* VT = lds + 34816; LAS float* wsv = (LAS float*)(lds + 108800);
    const bf16_t* P = (const bf16_t*)(p.ws + WS_P);
    bf16_t* QC = (bf16_t*)(p.ws + WS_QC); bf16_t* KC = (bf16_t*)(p.ws + WS_KC);
    const float* IG = (const float*)(p.ws + WS_IG); const float* LF = (const float*)(p.ws + WS_LF);
    __syncthreads();
    if (wave == 0) {
        const float l0 = LF[(size_t)(t0 + 2 * lane) * 4 + h], l1 = LF[(size_t)(t0 + 2 * lane + 1) * 4 + h];
        const float i0 = IG[(size_t)(t0 + 2 * lane) * 4 + h], i1 = IG[(size_t)(t0 + 2 * lane + 1) * 4 + h];
        float s = l0 + l1;
#pragma unroll
        for (int off = 1; off < 64; off <<= 1) { const float tt = __shfl_up(s, off); if (lane >= off) s += tt; }
        const float b1 = s, b0 = s - l1, bend = __shfl(s, 63);
        const float g0 = bend - b0 + i0, g1 = bend - b1 + i1;
        const float gmax = wave_max(fmaxf(g0, g1));
        wsv[2 * lane] = __expf(g0 - gmax); wsv[2 * lane + 1] = __expf(g1 - gmax);
        if (lane == 0) { ((float*)(p.ws + WS_BEND))[bh * 64 + c] = bend; ((float*)(p.ws + WS_GMAX))[bh * 64 + c] = gmax; }
    }
    __syncthreads();
    for (int g = wave; g < 32; g += 8) {
        const bool isk = g >= 16; const int cgp = (g & 15) * 8;
        const int ch = (isk ? 512 : 0) + h * 128 + cgp;
        const bf16_t* src = P + (isk ? 2560 : 2048) + h * 128 + cgp;
        const int s = 2 * lane;
        float xr[5][8];
#pragma unroll
        for (int dj = 0; dj < 5; ++dj) {
            const int srow = s - 3 + dj;
            u32x4 w = {0u, 0u, 0u, 0u};
            if (c > 0 || srow >= 0) w = *(const u32x4*)(src + (size_t)((long)t0 + srow) * NPROJ);
#pragma unroll
            for (int q = 0; q < 4; ++q) { xr[dj][2 * q] = bflo(w[q]); xr[dj][2 * q + 1] = bfhi(w[q]); }
        }
        float y0[8], y1[8];
        {
            const f32x4 cb0 = *(const f32x4*)(p.ml_conv_b + ch), cb1 = *(const f32x4*)(p.ml_conv_b + ch + 4);
#pragma unroll
            for (int e = 0; e < 8; ++e) { y0[e] = e < 4 ? cb0[e & 3] : cb1[e & 3]; y1[e] = y0[e]; }
#pragma unroll
            for (int j = 0; j < 4; ++j) {
                const f32x4 w0 = *(const f32x4*)(p.ml_conv_w + j * 1024 + ch), w1 = *(const f32x4*)(p.ml_conv_w + j * 1024 + ch + 4);
#pragma unroll
                for (int e = 0; e < 8; ++e) { const float wv = e < 4 ? w0[e & 3] : w1[e & 3]; y0[e] += wv * xr[j][e]; y1[e] += wv * xr[j + 1][e]; }
            }
        }
        const float sc = isk ? 0.08838834764831845f : 1.f;
#pragma unroll
        for (int e = 0; e < 8; ++e) { y0[e] = y0[e] * sigmoid_(y0[e]) * sc; y1[e] = y1[e] * sigmoid_(y1[e]) * sc; }
        bf16_t* dst = (isk ? KC : QC) + (size_t)(t0 + s) * 512 + h * 128 + cgp;
        u32x4 w; w.x = cvt_pk_bf16(y0[0], y0[1]); w.y = cvt_pk_bf16(y0[2], y0[3]); w.z = cvt_pk_bf16(y0[4], y0[5]); w.w = cvt_pk_bf16(y0[6], y0[7]);
        *(u32x4*)dst = w;
        w.x = cvt_pk_bf16(y1[0], y1[1]); w.y = cvt_pk_bf16(y1[2], y1[3]); w.z = cvt_pk_bf16(y1[4], y1[5]); w.w = cvt_pk_bf16(y1[6], y1[7]);
        *(u32x4*)(dst + 512) = w;
        if (isk) {
            const float w0 = wsv[s], w1 = wsv[s + 1];
#pragma unroll
            for (int e = 0; e < 8; ++e) *(LAS unsigned*)(KT + (cgp + e) * 272 + lane * 4) = cvt_pk_bf16(y0[e] * w0, y1[e] * w1);
        }
    }
    stage_T(P + (size_t)t0 * NPROJ + 3072 + h * 256, NPROJ, 32, VT, wave, lane);
    for (int i = tid; i < 1024; i += NTHREADS) { const int r = i >> 6, w = i & 63; *(LAS unsigned*)(VT + (256 + r) * 272 + w * 4) = 0x3F803F80u; }
    __syncthreads();
    bf16x8 af[4];
#pragma unroll
    for (int kk = 0; kk < 4; ++kk) af[kk] = ld_frag_lds(KT + (16 * wave + fr) * 272 + (32 * kk + 8 * fq) * 2);
    float* ST = (float*)(p.ws + WS_ST) + ((size_t)(bh * 64 + c) * 272) * 128;
#pragma unroll
    for (int n = 0; n < 17; ++n) {
        f32x4 acc = {0.f, 0.f, 0.f, 0.f};
#pragma unroll
        for (int kk = 0; kk < 4; ++kk) { const bf16x8 bfr = ld_frag_lds(VT + (16 * n + fr) * 272 + (32 * kk + 8 * fq) * 2); acc = MFMA16(af[kk], bfr, acc); }
        if (n < 16 || fr == 0) *(f32x4*)(ST + (size_t)(16 * n + fr) * 128 + 16 * wave + 4 * fq) = acc;
    }
}

DI void phase_scan(const Params& p) {
    const float* ST = (const float*)(p.ws + WS_ST); bf16_t* CPT = (bf16_t*)(p.ws + WS_CPT);
    const float* BEND = (const float*)(p.ws + WS_BEND); const float* GMAX = (const float*)(p.ws + WS_GMAX); float* MPREV = (float*)(p.ws + WS_MPREV);
    const int gtid = blockIdx.x * NTHREADS + threadIdx.x, nthr = gridDim.x * NTHREADS;
    constexpr int PER = 8224;
    constexpr size_t CST = 272 * 128;
    for (int item = gtid; item < 16 * PER; item += nthr) {
        const int bh = item / PER, e4 = item - bh * PER;
        const float* src = ST + (size_t)bh * 64 * CST + (size_t)e4 * 4;
        bf16_t* dst = CPT + (size_t)bh * 64 * CST + (size_t)e4 * 4;
        f32x4 st = {0.f, 0.f, 0.f, 0.f}; float m = 0.f;
        for (int c0 = 0; c0 < 64; c0 += 8) {
            f32x4 d[8];
#pragma unroll
            for (int j = 0; j < 8; ++j) d[j] = *(const f32x4*)(src + (size_t)(c0 + j) * CST);
#pragma unroll
            for (int j = 0; j < 8; ++j) {
                const int c = c0 + j;
                const float be = BEND[bh * 64 + c], gm = GMAX[bh * 64 + c];
                const float mn = fmaxf(be + m, gm), a = __expf(be + m - mn), sc = __expf(gm - mn);
                u32x2 w; w.x = cvt_pk_bf16(st[0], st[1]); w.y = cvt_pk_bf16(st[2], st[3]);
                *(u32x2*)(dst + (size_t)c * CST) = w;
                if (e4 == 0) MPREV[bh * 64 + c] = m;
                st = st * a + d[j] * sc; m = mn;
            }
        }
    }
}

DI void mlstm_out(const Params& p, LAS unsigned char* lds, int b, int c, int h) {
    const int tid = threadIdx.x, lane = tid & 63, wave = __builtin_amdgcn_readfirstlane(tid >> 6), fr = lane & 15, fq = lane >> 4;
    const int bh = b * 4 + h, t0 = b * 8192 + c * 128;
    LAS unsigned char* Kl = lds; LAS unsigned char* Sl = lds + 34816; LAS unsigned char* VTe = lds + 69632;
    LAS float* av = (LAS float*)(lds + 143616); LAS float* Mv = (LAS float*)(lds + 144128); LAS float* bv = (LAS float*)(lds + 144640);
    const bf16_t* P = (const bf16_t*)(p.ws + WS_P); bf16_t* YM = (bf16_t*)(p.ws + WS_XN);
    const bf16_t* QC = (const bf16_t*)(p.ws + WS_QC); const bf16_t* KC = (const bf16_t*)(p.ws + WS_KC);
    const float* IG = (const float*)(p.ws + WS_IG); const float* LF = (const float*)(p.ws + WS_LF);
    const float mprev = ((const float*)(p.ws + WS_MPREV))[bh * 64 + c];
    __syncthreads();
    if (wave == 0) {
        const float l0 = LF[(size_t)(t0 + 2 * lane) * 4 + h], l1 = LF[(size_t)(t0 + 2 * lane + 1) * 4 + h];
        const float i0 = IG[(size_t)(t0 + 2 * lane) * 4 + h], i1 = IG[(size_t)(t0 + 2 * lane + 1) * 4 + h];
        float s = l0 + l1;
#pragma unroll
        for (int off = 1; off < 64; off <<= 1) { const float tt = __shfl_up(s, off); if (lane >= off) s += tt; }
        const float b1 = s, b0 = s - l1;
        const float a0 = i0 - b0, a1 = i1 - b1;
        float pm = fmaxf(a0, a1);
#pragma unroll
        for (int off = 1; off < 64; off <<= 1) { const float tt = __shfl_up(pm, off); if (lane >= off) pm = fmaxf(pm, tt); }
        float ex = __shfl_up(pm, 1); if (lane == 0) ex = -3.0e38f;
        Mv[2 * lane] = fmaxf(mprev, fmaxf(ex, a0)); Mv[2 * lane + 1] = fmaxf(mprev, pm);
        av[2 * lane] = a0; av[2 * lane + 1] = a1; bv[2 * lane] = b0; bv[2 * lane + 1] = b1;
    }
#pragma unroll
    for (int it = 0; it < 4; ++it) {
        const int e = (it * NTHREADS + tid) * 8, s = e >> 7, d0 = e & 127;
        *(LAS u32x4*)(Kl + s * 272 + d0 * 2) = *(const u32x4*)(KC + (size_t)(t0 + s) * 512 + h * 128 + d0);
    }
    stage_T(P + (size_t)t0 * NPROJ + 3072 + h * 256, NPROJ, 32, VTe, wave, lane);
    for (int i = tid; i < 1024; i += NTHREADS) { const int r = i >> 6, w = i & 63; *(LAS unsigned*)(VTe + (256 + r) * 272 + w * 4) = 0x3F803F80u; }
    bf16x8 qf[4];
#pragma unroll
    for (int kk = 0; kk < 4; ++kk) qf[kk] = *(const bf16x8*)(QC + (size_t)(t0 + 16 * wave + fr) * 512 + h * 128 + 32 * kk + 8 * fq);
    __syncthreads();
    const int t = 16 * wave + fr; const float Mt = Mv[t];
    const int stmax = wave | 1;
    for (int st = 0; st <= stmax; ++st) {
        f32x4 s4 = {0.f, 0.f, 0.f, 0.f};
#pragma unroll
        for (int kk = 0; kk < 4; ++kk) { const bf16x8 kf = ld_frag_lds(Kl + (16 * st + fr) * 272 + (32 * kk + 8 * fq) * 2); s4 = MFMA16(kf, qf[kk], s4); }
#pragma unroll
        for (int r = 0; r < 4; ++r) { const int s = 16 * st + 4 * fq + r; const float w = (s <= t) ? __expf(av[s] - Mt) : 0.f; s4[r] *= w; }
        u32x2 w; w.x = cvt_pk_bf16(s4[0], s4[1]); w.y = cvt_pk_bf16(s4[2], s4[3]);
        *(LAS u32x2*)(Sl + t * 272 + (16 * st + 4 * fq) * 2) = w;
    }
    __syncthreads();
    const bf16_t* cpt = (const bf16_t*)(p.ws + WS_CPT) + ((size_t)(bh * 64 + c) * 272) * 128;
    f32x4 acc[17];
#pragma unroll
    for (int n = 0; n < 17; ++n) {
        acc[n] = (f32x4){0.f, 0.f, 0.f, 0.f};
#pragma unroll
        for (int kk = 0; kk < 4; ++kk) { const bf16x8 cf = *(const bf16x8*)(cpt + (size_t)(16 * n + fr) * 128 + 32 * kk + 8 * fq); acc[n] = MFMA16(cf, qf[kk], acc[n]); }
    }
    const float ai = __expf(mprev - Mt);
#pragma unroll
    for (int n = 0; n < 17; ++n) acc[n] = acc[n] * ai;
    const int k2max = (16 * wave + 15) >> 5;
#pragma unroll
    for (int kk = 0; kk < 4; ++kk) {
        if (kk <= k2max) {
            const bf16x8 sf = ld_frag_lds(Sl + t * 272 + (32 * kk + 8 * fq) * 2);
#pragma unroll
            for (int n = 0; n < 17; ++n) { const bf16x8 vf = ld_frag_lds(VTe + (16 * n + fr) * 272 + (32 * kk + 8 * fq) * 2); acc[n] = MFMA16(vf, sf, acc[n]); }
        }
    }
    const float den = __shfl(acc[16][0], fr);
    const float mt = bv[t] + Mt;
    const float inv = rcpf_(fmaxf(fabsf(den), __expf(-mt)));
    const size_t grow = (size_t)(t0 + t);
    float ss = 0.f;
#pragma unroll
    for (int n = 0; n < 16; ++n) {
        const int v0 = 16 * n + 4 * fq;
        const u32x2 ow = *(const u32x2*)(P + grow * NPROJ + 4096 + h * 256 + v0);
        f32x4 y;
        y[0] = bflo(ow.x) * acc[n][0] * inv; y[1] = bfhi(ow.x) * acc[n][1] * inv; y[2] = bflo(ow.y) * acc[n][2] * inv; y[3] = bfhi(ow.y) * acc[n][3] * inv;
        ss += (y[0] * y[0] + y[1] * y[1]) + (y[2] * y[2] + y[3] * y[3]);
        acc[n] = y;
    }
    ss += __shfl_xor(ss, 16); ss += __shfl_xor(ss, 32);
    const float rstd = rsqrtf(ss * (1.f / 256.f) + EPS);
#pragma unroll
    for (int n = 0; n < 16; ++n) {
        const int v0 = 16 * n + 4 * fq;
        const f32x4 g = *(const f32x4*)(p.ml_out_g + h * 256 + v0);
        const f32x4 o = acc[n] * rstd * g;
        u32x2 w; w.x = cvt_pk_bf16(o[0], o[1]); w.y = cvt_pk_bf16(o[2], o[3]);
        *(u32x2*)(YM + grow * DM + 1024 + h * 256 + v0) = w;
    }
}

DI unsigned ord_key(float f) { const unsigned u = __float_as_uint(f); return (u & 0x80000000u) ? ~u : (u | 0x80000000u); }
DI float key_val(unsigned k) { return (k & 0x80000000u) ? __uint_as_float(k & 0x7fffffffu) : __uint_as_float(~k); }
DI unsigned umax_(unsigned a, unsigned b) { return a > b ? a : b; }
DI unsigned umin_(unsigned a, unsigned b) { return a < b ? a : b; }
#define DPPU(v, ctrl) ((unsigned)__builtin_amdgcn_update_dpp(0, (int)(v), (ctrl), 0xF, 0xF, true))
DI unsigned row_max_u32(unsigned v) {
    v = umax_(v, DPPU(v, 0xB1)); v = umax_(v, DPPU(v, 0x4E)); v = umax_(v, DPPU(v, 0x141)); v = umax_(v, DPPU(v, 0x140)); return v;
}
DI float row_sum_f32(float v) {
    v += __uint_as_float(DPPU(__float_as_uint(v), 0xB1)); v += __uint_as_float(DPPU(__float_as_uint(v), 0x4E));
    v += __uint_as_float(DPPU(__float_as_uint(v), 0x141)); v += __uint_as_float(DPPU(__float_as_uint(v), 0x140)); return v;
}
#define CEX(a, b) do { const unsigned mx_ = umax_(a, b), mn_ = umin_(a, b); a = mx_; b = mn_; } while (0)
template <int N> DI unsigned top16_row(unsigned (&s)[N], int c) {
    unsigned list = 0u;
#pragma unroll 1
    for (int it = 0; it < 16; ++it) {
        const unsigned wm = row_max_u32(s[0]);
        const bool win = (s[0] == wm);
#pragma unroll
        for (int i = 0; i < N - 1; ++i) s[i] = win ? s[i + 1] : s[i];
        s[N - 1] = win ? 0u : s[N - 1];
        list = (c == it) ? wm : list;
    }
    return list;
}

DI void peer_select(const Params& p) {
    const int tid = threadIdx.x, lane = tid & 63, wave = __builtin_amdgcn_readfirstlane(tid >> 6), c = lane & 15, g = lane >> 4, rowbase = lane & 48;
    const bf16_t* Q = (const bf16_t*)(p.ws + WS_Q); const bf16_t* KB1 = (const bf16_t*)(p.ws + WS_KB1); const bf16_t* KB2 = (const bf16_t*)(p.ws + WS_KB2);
    int* SELID = (int*)(p.ws + WS_SELID); float* SELG = (float*)(p.ws + WS_SELG);
    unsigned pk = 0u, validmask = 0u;
#pragma unroll
    for (int q = 0; q < 4; ++q) {
        const int target = 4 * c + q; int ci = 0, cj = 0, cnt = 0; bool v = false;
#pragma unroll
        for (int i = 0; i < 16; ++i) { const int nj = 16 / (i + 1); if (target >= cnt && target < cnt + nj) { ci = i; cj = target - cnt; v = true; } cnt += nj; }
        pk |= (unsigned)((ci << 4) | cj) << (8 * q); validmask |= (v ? 1u : 0u) << q;
    }
    for (int tile = blockIdx.x * 8 + wave; tile < T_TOK / 16; tile += gridDim.x * 8) {
        const int tok0 = tile * 16;
        for (int h = 0; h < 8; ++h) {
            bf16x8 a1[2], a2[2];
            {
                const bf16_t* qp = Q + (size_t)(tok0 + c) * 1024 + h * 128 + g * 8;
                a1[0] = *(const bf16x8*)qp; a1[1] = *(const bf16x8*)(qp + 32); a2[0] = *(const bf16x8*)(qp + 64); a2[1] = *(const bf16x8*)(qp + 96);
            }
            f32x4 acc1[8], acc2[8];
#pragma unroll
            for (int nt = 0; nt < 8; ++nt) {
                const size_t ko = ((size_t)(h * 128 + nt * 16 + c)) * 64 + g * 8;
                acc1[nt] = (f32x4){0.f, 0.f, 0.f, 0.f}; acc2[nt] = (f32x4){0.f, 0.f, 0.f, 0.f};
                acc1[nt] = MFMA16(a1[0], *(const bf16x8*)(KB1 + ko), acc1[nt]); acc1[nt] = MFMA16(a1[1], *(const bf16x8*)(KB1 + ko + 32), acc1[nt]);
                acc2[nt] = MFMA16(a2[0], *(const bf16x8*)(KB2 + ko), acc2[nt]); acc2[nt] = MFMA16(a2[1], *(const bf16x8*)(KB2 + ko + 32), acc2[nt]);
            }
#pragma unroll
            for (int r = 0; r < 4; ++r) {
                unsigned s[8];
#pragma unroll
                for (int nt = 0; nt < 8; ++nt) s[nt] = (ord_key(acc1[nt][r]) & ~0x7Fu) | (unsigned)(127 - (nt * 16 + c));
                CEX(s[0], s[1]); CEX(s[2], s[3]); CEX(s[4], s[5]); CEX(s[6], s[7]); CEX(s[0], s[2]); CEX(s[1], s[3]); CEX(s[4], s[6]); CEX(s[5], s[7]); CEX(s[1], s[2]); CEX(s[5], s[6]);
                CEX(s[0], s[4]); CEX(s[1], s[5]); CEX(s[2], s[6]); CEX(s[3], s[7]); CEX(s[2], s[4]); CEX(s[3], s[5]); CEX(s[1], s[2]); CEX(s[3], s[4]); CEX(s[5], s[6]);
                const unsigned list1 = top16_row<8>(s, c);
#pragma unroll
                for (int nt = 0; nt < 8; ++nt) s[nt] = (ord_key(acc2[nt][r]) & ~0x7Fu) | (unsigned)(127 - (nt * 16 + c));
                CEX(s[0], s[1]); CEX(s[2], s[3]); CEX(s[4], s[5]); CEX(s[6], s[7]); CEX(s[0], s[2]); CEX(s[1], s[3]); CEX(s[4], s[6]); CEX(s[5], s[7]); CEX(s[1], s[2]); CEX(s[5], s[6]);
                CEX(s[0], s[4]); CEX(s[1], s[5]); CEX(s[2], s[6]); CEX(s[3], s[7]); CEX(s[2], s[4]); CEX(s[3], s[5]); CEX(s[1], s[2]); CEX(s[3], s[4]); CEX(s[5], s[6]);
                const unsigned list2 = top16_row<8>(s, c);
                unsigned cs[4];
#pragma unroll
                for (int q = 0; q < 4; ++q) {
                    const int ci = (int)((pk >> (8 * q + 4)) & 15u), cj = (int)((pk >> (8 * q)) & 15u);
                    const unsigned k1 = (unsigned)__shfl((int)list1, rowbase + ci), k2 = (unsigned)__shfl((int)list2, rowbase + cj);
                    const float cand = key_val(k1 & ~0x7Fu) + key_val(k2 & ~0x7Fu);
                    cs[q] = ((validmask >> q) & 1u) ? ((ord_key(cand) & ~0x3Fu) | (unsigned)(63 - (4 * c + q))) : 0u;
                }
                CEX(cs[0], cs[1]); CEX(cs[2], cs[3]); CEX(cs[0], cs[2]); CEX(cs[1], cs[3]); CEX(cs[1], cs[2]);
                const unsigned sel = top16_row<4>(cs, c);
                const int slot = 63 - (int)(sel & 63u);
                const unsigned pkv = (unsigned)__shfl((int)pk, rowbase + (slot >> 2));
                const int cij = (int)((pkv >> (8 * (slot & 3))) & 0xFFu);
                const unsigned e1 = (unsigned)__shfl((int)list1, rowbase + (cij >> 4)), e2 = (unsigned)__shfl((int)list2, rowbase + (cij & 15));
                const int eid = (127 - (int)(e1 & 127u)) * 128 + (127 - (int)(e2 & 127u));
                const float sv = key_val(sel & ~0x3Fu), mx = key_val(row_max_u32(sel) & ~0x3Fu);
                const float ev = __expf(sv - mx);
                const float sum = row_sum_f32(ev);
                const size_t o = (size_t)(tok0 + 4 * g + r) * 128 + h * 16 + c;
                SELID[o] = eid; SELG[o] = ev * rcpf_(sum);
            }
        }
    }
}

DI f32x2 pkfma(f32x2 a, f32x2 b, f32x2 c) { return __builtin_elementwise_fma(a, b, c); }
DI void peer_gather(const Params& p, LAS unsigned char* lds) {
    const int tid = threadIdx.x, lane = tid & 63, wave = __builtin_amdgcn_readfirstlane(tid >> 6);
    LAS float* scr = (LAS float*)lds + wave * (16 * 68);
    LAS float* cfl = (LAS float*)(lds + 8 * 16 * 68 * 4) + wave * 128;
    const unsigned char* Ub = p.ws + WS_UB; const unsigned char* Vb = p.ws + WS_VB;
    const float* PSS2 = (const float*)(p.ws + WS_PSS2);
    const int* SELID = (const int*)(p.ws + WS_SELID); const float* SELG = (const float*)(p.ws + WS_SELG);
    const int gw = blockIdx.x * 8 + wave, nw = gridDim.x * 8;
    for (int t = gw; t < T_TOK; t += nw) {
        const int idA = SELID[(size_t)t * 128 + lane], idB = SELID[(size_t)t * 128 + 64 + lane];
        const float gA = SELG[(size_t)t * 128 + lane], gB = SELG[(size_t)t * 128 + 64 + lane];
        float* xrow = p.out + (size_t)t * DM;
        const float pv = lane < 32 ? PSS2[(size_t)t * 32 + lane] : 0.f;
        const float rstd2 = rsqrtf(wave_sum(pv) * (1.f / 2048.f) + EPS);
        f32x2 h2[16];
#pragma unroll
        for (int hf = 0; hf < 2; ++hf)
#pragma unroll
            for (int q = 0; q < 4; ++q) {
                const f32x4 x0 = *(const f32x4*)(xrow + hf * 1024 + lane * 16 + q * 4), g0 = *(const f32x4*)(p.norm2_g + hf * 1024 + lane * 16 + q * 4);
                h2[hf * 8 + q * 2] = (f32x2){x0[0] * rstd2 * g0[0], x0[1] * rstd2 * g0[1]};
                h2[hf * 8 + q * 2 + 1] = (f32x2){x0[2] * rstd2 * g0[2], x0[3] * rstd2 * g0[3]};
            }
        constexpr int NPK = 4;
        u32x4 buf[2][NPK][2];
#define PEER_LOAD(TB, st, base) do { const int idv_ = ((base) < 64) ? idA : idB; _Pragma("unroll") for (int e_ = 0; e_ < NPK; ++e_) { \
            const int id_ = __builtin_amdgcn_readlane(idv_, ((base) + e_) & 63); const unsigned char* r_ = (TB) + (size_t)id_ * DM + lane * 16; \
            buf[st][e_][0] = *(const u32x4*)r_; buf[st][e_][1] = *(const u32x4*)(r_ + 1024); } } while (0)
#define PEER_DOT(st, slot0) do { _Pragma("unroll") for (int e_ = 0; e_ < NPK; ++e_) { f32x2 a2_ = {0.f, 0.f}; \
            _Pragma("unroll") for (int hf_ = 0; hf_ < 2; ++hf_) _Pragma("unroll") for (int q_ = 0; q_ < 4; ++q_) { const int w_ = (int)buf[st][e_][hf_][q_]; \
                a2_ = pkfma(h2[hf_ * 8 + q_ * 2], __builtin_amdgcn_cvt_pk_f32_fp8(w_, false), a2_); a2_ = pkfma(h2[hf_ * 8 + q_ * 2 + 1], __builtin_amdgcn_cvt_pk_f32_fp8(w_, true), a2_); } \
            scr[((slot0) + e_) * 68 + lane] = a2_[0] + a2_[1]; } } while (0)
        PEER_LOAD(Ub, 0, 0);
        for (int b = 0; b < 128 / NPK; b += 2) {
            PEER_LOAD(Ub, 1, (b + 1) * NPK);
            PEER_DOT(0, (b * NPK) & 15);
            if (b + 2 < 128 / NPK) PEER_LOAD(Ub, 0, (b + 2) * NPK);
            PEER_DOT(1, ((b + 1) * NPK) & 15);
            if ((((b + 2) * NPK) & 15) == 0) {
                WAVE_LDS_SYNC();
                float sum = 0.f;
#pragma unroll
                for (int i = 0; i < 4; ++i) { const f32x4 r = *(const LAS f32x4*)(scr + (lane >> 2) * 68 + (lane & 3) * 16 + 4 * i); sum += (r[0] + r[1]) + (r[2] + r[3]); }
                sum += __shfl_xor(sum, 1); sum += __shfl_xor(sum, 2);
                const int k0 = (b + 2) * NPK - 16;
                const int k = k0 + (lane >> 2);
                const float gate = __shfl((k0 < 64) ? gA : gB, k & 63);
                if ((lane & 3) == 0) cfl[k] = gate * gelu_t(sum * (1.f / 64.f)) * (1.f / 16.f);
                WAVE_LDS_SYNC();
            }
        }
        f32x2 acc[16];
#pragma unroll
        for (int i = 0; i < 16; ++i) acc[i] = (f32x2){0.f, 0.f};
#define PEER_AXPY(st, base) do { _Pragma("unroll") for (int e_ = 0; e_ < NPK; ++e_) { const float c_ = cfl[(base) + e_]; const f32x2 c2_ = {c_, c_}; \
            _Pragma("unroll") for (int hf_ = 0; hf_ < 2; ++hf_) _Pragma("unroll") for (int q_ = 0; q_ < 4; ++q_) { const int w_ = (int)buf[st][e_][hf_][q_]; \
                acc[hf_ * 8 + q_ * 2] = pkfma(c2_, __builtin_amdgcn_cvt_pk_f32_fp8(w_, false), acc[hf_ * 8 + q_ * 2]); \
                acc[hf_ * 8 + q_ * 2 + 1] = pkfma(c2_, __builtin_amdgcn_cvt_pk_f32_fp8(w_, true), acc[hf_ * 8 + q_ * 2 + 1]); } } } while (0)
        PEER_LOAD(Vb, 0, 0);
        for (int b = 0; b < 128 / NPK; b += 2) {
            PEER_LOAD(Vb, 1, (b + 1) * NPK);
            PEER_AXPY(0, b * NPK);
            if (b + 2 < 128 / NPK) PEER_LOAD(Vb, 0, (b + 2) * NPK);
            PEER_AXPY(1, (b + 1) * NPK);
        }
        float ss = 0.f;
#pragma unroll
        for (int hf = 0; hf < 2; ++hf)
#pragma unroll
            for (int q = 0; q < 4; ++q) {
                const f32x4 x0 = *(const f32x4*)(xrow + hf * 1024 + lane * 16 + q * 4);
                acc[hf * 8 + q * 2] += (f32x2){x0[0], x0[1]}; acc[hf * 8 + q * 2 + 1] += (f32x2){x0[2], x0[3]};
                const f32x2 a = acc[hf * 8 + q * 2], b = acc[hf * 8 + q * 2 + 1];
                ss += (a[0] * a[0] + a[1] * a[1]) + (b[0] * b[0] + b[1] * b[1]);
            }
        const float rstd = rsqrtf(wave_sum(ss) * (1.f / 2048.f) + EPS);
#pragma unroll
        for (int hf = 0; hf < 2; ++hf)
#pragma unroll
            for (int q = 0; q < 4; ++q) {
                const f32x4 g0 = *(const f32x4*)(p.final_g + hf * 1024 + lane * 16 + q * 4);
                const f32x2 a = acc[hf * 8 + q * 2], b = acc[hf * 8 + q * 2 + 1];
                const f32x4 o0 = {a[0] * rstd * g0[0], a[1] * rstd * g0[1], b[0] * rstd * g0[2], b[1] * rstd * g0[3]};
                *(f32x4*)(xrow + hf * 1024 + lane * 16 + q * 4) = o0;
            }
        WAVE_LDS_SYNC();
    }
}

#ifndef PROBE_DUP
#define PROBE_DUP 0
#endif
#define REP(bit) for (int rep_ = 0; rep_ < (((PROBE_DUP) >> (bit)) & 1) + 1; ++rep_)
#define PH1() { pg8::Gemm g{(const bf16_t*)(p.ws + WS_XN), (const bf16_t*)(p.ws + WS_WINT), T_TOK, NPROJ, DM}; pg8::StaticOrder S; S.init(T_TOK, NPROJ, G, bx); Epi1 E{(bf16_t*)(p.ws + WS_P), (float*)(p.ws + WS_PSSV)}; pg8::gemm_phase<Epi1, pg8::StaticOrder, true, true>(lds, g, S, E); grid.sync(); }
#define PH3() { pg8::Gemm g{(const bf16_t*)(p.ws + WS_XN), (const bf16_t*)(p.ws + WS_WOUTT), T_TOK, DM, DM}; pg8::StaticOrder S; S.init(T_TOK, DM, G, bx); Epi2 E{p.x, p.out, (bf16_t*)(p.ws + WS_X1G), p.norm2_g, (float*)(p.ws + WS_PSS2)}; pg8::gemm_phase<Epi2, pg8::StaticOrder, true, true>(lds, g, S, E); grid.sync(); }
#define PH4() { pg8::Gemm g{(const bf16_t*)(p.ws + WS_X1G), (const bf16_t*)(p.ws + WS_WQT), T_TOK, 1024, DM}; pg8::StaticOrder S; S.init(T_TOK, 1024, G, bx); Epi3 E{(bf16_t*)(p.ws + WS_Q), (const float*)(p.ws + WS_PSS2)}; pg8::gemm_phase<Epi3, pg8::StaticOrder, true, true>(lds, g, S, E); grid.sync(); }
__global__ void __launch_bounds__(NTHREADS, 2) hymba_fwd(Params p) {
    extern __shared__ __attribute__((aligned(16))) unsigned char smem[];
    LAS unsigned char* lds = (LAS unsigned char*)smem;
    cg::grid_group grid = cg::this_grid();
    const int G = gridDim.x, bx = blockIdx.x;
    REP(0) { phase0(p, lds); grid.sync(); }
    PH1()
#if (PROBE_DUP >> 1) & 1
    PH1()
#endif
    REP(2) {
        for (int si = bx; si < 256; si += G) {
            const int b = si >> 6, c = si & 63;
            gmlp_bc(p, lds, b, c);
            for (int h = 0; h < 4; ++h) mlstm_local(p, lds, b, c, h);
        }
        grid.sync();
    }
    REP(3) { phase_scan(p); grid.sync(); }
    REP(4) { for (int it = bx; it < 1024; it += G) mlstm_out(p, lds, it >> 8, (it >> 2) & 63, it & 3); grid.sync(); }
    PH3()
#if (PROBE_DUP >> 5) & 1
    PH3()
#endif
    PH4()
#if (PROBE_DUP >> 6) & 1
    PH4()
#endif
    REP(7) { peer_select(p); grid.sync(); }
    peer_gather(p, lds);
}

extern "C" void kernel_launch(void* const* d_in, const int* in_sizes, int n_in, void* d_out, int out_size, void* d_ws, size_t ws_size, hipStream_t stream) {
    static int grid_blocks = 0;
    if (grid_blocks == 0) {
        if (n_in != 20 || ws_size < WS_END) { fprintf(stderr, "kernel_launch: unexpected n_in %d or ws_size %zu (need %zu)\n", n_in, ws_size, (size_t)WS_END); grid_blocks = -1; return; }
        int dev = 0, cus = 0, per_cu = 0;
        hipGetDevice(&dev);
        hipDeviceGetAttribute(&cus, hipDeviceAttributeMultiprocessorCount, dev);
        hipFuncSetAttribute((const void*)hymba_fwd, hipFuncAttributeMaxDynamicSharedMemorySize, LDS_BYTES);
        hipOccupancyMaxActiveBlocksPerMultiprocessor(&per_cu, (const void*)hymba_fwd, NTHREADS, LDS_BYTES);
        if (per_cu < 1) { fprintf(stderr, "kernel_launch: occupancy query says %d blocks per CU\n", per_cu); per_cu = 1; }
        if (per_cu > 1) per_cu = 1;
        grid_blocks = cus * per_cu;
        (void)hipGetLastError();
    }
    if (grid_blocks < 0) return;
    Params p{};
    p.x = (const float*)d_in[0]; p.norm1_g = (const float*)d_in[1]; p.w_in = (const float*)d_in[2]; p.gm_vnorm_g = (const float*)d_in[3];
    p.w_spatial = (const float*)d_in[4]; p.b_spatial = (const float*)d_in[5]; p.ml_conv_w = (const float*)d_in[6]; p.ml_conv_b = (const float*)d_in[7];
    p.ml_b_i = (const float*)d_in[8]; p.ml_b_f = (const float*)d_in[9]; p.gm_out_g = (const float*)d_in[10]; p.ml_out_g = (const float*)d_in[11];
    p.w_out = (const float*)d_in[12]; p.norm2_g = (const float*)d_in[13]; p.peer_wq = (const float*)d_in[14]; p.peer_k1 = (const float*)d_in[15];
    p.peer_k2 = (const float*)d_in[16]; p.peer_u = (const float*)d_in[17]; p.peer_v = (const float*)d_in[18]; p.final_g = (const float*)d_in[19];
    p.out = (float*)d_out; p.ws = (unsigned char*)d_ws;
    void* args[] = {&p};
    hipError_t e = hipLaunchCooperativeKernel((const void*)hymba_fwd, dim3(grid_blocks), dim3(NTHREADS), args, LDS_BYTES, stream);
    if (e != hipSuccess) fprintf(stderr, "cooperative launch failed: %s (grid %d)\n", hipGetErrorString(e), grid_blocks);
}
```

```cpp
#include <hip/hip_runtime.h>
#include <hip/hip_cooperative_groups.h>
#include <cstdio>
#include <cstdint>
namespace cg = cooperative_groups;
namespace pg8 {
#define PG8_LAS __attribute__((address_space(3)))
typedef unsigned short bf16_t;
typedef short bf16x8 __attribute__((ext_vector_type(8)));
typedef float f32x4 __attribute__((ext_vector_type(4)));
typedef unsigned u32x4 __attribute__((ext_vector_type(4)));
constexpr int BM = 256, BK = 64, HALF = 128, HTB = HALF * BK * 2  , STAGE_BYTES = 8 * HTB, NXCD = 8, WGM = 8;

__host__ __device__ __forceinline__ int lds_byte(int r, int c) { const int st = (r >> 4) * 2 + (c >> 5), rr = r & 15, cc = c & 31, ob = rr * 64 + cc * 2; return st * 1024 + (ob ^ (((ob >> 9) & 1) << 5)); }
__host__ __device__ __forceinline__ void stage_rc(int b, int& R, int& C) { const int st = b / 1024, sb = b % 1024, swz = sb ^ (((sb >> 9) & 1) << 5); R = (st >> 1) * 16 + swz / 64; C = (st & 1) * 32 + (swz % 64) / 2; }
__host__ __device__ __forceinline__ int perm32(int rho) { const int n = rho >> 4, i = rho & 15; return 8 * (i >> 2) + 4 * n + (i & 3); }

struct Unit { int pm, pn; };
struct Gemm { const bf16_t* A; const bf16_t* Bt; int M, N, K; };

struct StaticOrder {
    int nM, nN, nwg, G, c;
    __host__ __device__ void init(int M, int N, int G_, int c_) { nM = M / BM; nN = N / BM; nwg = nM * nN; G = G_; c = c_; }
    __host__ __device__ bool next(int i, Unit& u) const {
        const long L = (long)i * G + c; if (L >= nwg) return false;
        int wgid = (int)L; { const int q = nwg / NXCD, r = nwg % NXCD, xcd = wgid % NXCD, off = wgid / NXCD; wgid = (xcd < r ? xcd * (q + 1) : r * (q + 1) + (xcd - r) * q) + off; }
        const int nig = WGM * nN, gid = wgid / nig, fm = gid * WGM, gsz = (nM - fm) < WGM ? (nM - fm) : WGM;
        u.pm = fm + ((wgid % nig) % gsz); u.pn = (wgid % nig) / gsz; return true;
    }
    __device__ __forceinline__ void a_ready(const Unit&) const {}
    __device__ __forceinline__ void done(const Unit&) const {}
};
__device__ __forceinline__ unsigned cvt_pk_bf16(float lo, float hi) { unsigned r; asm volatile("v_cvt_pk_bf16_f32 %0, %1, %2" : "=v"(r) : "v"(lo), "v"(hi)); return r; }
template <class Epi, class Sched, bool ALIGN_EPI = false, bool SP2 = false>
__device__ __forceinline__ void gemm_phase(PG8_LAS unsigned char* lds, const Gemm g, const Sched& S, const Epi& E) {
    const int tid = threadIdx.x, wid = __builtin_amdgcn_readfirstlane(tid >> 6), lane = tid & 63, wr = wid >> 2, wc = wid & 3, fr = lane & 15, fq = lane >> 4;
    const int K = g.K, nt = K / BK;
    unsigned voffA[2], voffB[2];
#pragma unroll
    for (int i = 0; i < 2; ++i) { int R, C; stage_rc(tid * 16 + i * 8192, R, C); const int Rb = Epi::PERM ? ((R & ~31) + perm32(R & 31)) : R;
        voffA[i] = (unsigned)(R * K + C) * 2u; voffB[i] = (unsigned)(Rb * K + C) * 2u; }
    const size_t kstep = (size_t)(BK * 2);
    const size_t hstep = (size_t)HALF * K * 2;
    const size_t tstep = 2 * hstep;
    const unsigned ldsw = (unsigned)wid * 1024u;
    const int aoff = lds_byte(wr * 64 + fr, fq * 8), boff = lds_byte(wc * 32 + fr, fq * 8);
#define PG8_SA(b, h) (((b) * 2 + (h)) * HTB)
#define PG8_SB(b, h) ((4 + (b) * 2 + (h)) * HTB)
#define PG8_STAGE(bufoff, gbase, voff) do { _Pragma("unroll") for (int _i = 0; _i < 2; ++_i) \
        __builtin_amdgcn_global_load_lds((const unsigned*)((const char*)(gbase) + (voff)[_i]), (PG8_LAS unsigned*)(lds + (bufoff) + ldsw + _i * 8192), 16, 0, 0); } while (0)
#define PG8_LDA(dst, b, h) do { _Pragma("unroll") for (int m = 0; m < 4; ++m) _Pragma("unroll") for (int k = 0; k < 2; ++k) dst[m][k] = *(const PG8_LAS bf16x8*)(lds + PG8_SA(b, h) + aoff + m * 2048 + k * 1024); } while (0)
#define PG8_LDB(dst, b, h) do { _Pragma("unroll") for (int n = 0; n < 2; ++n) _Pragma("unroll") for (int k = 0; k < 2; ++k) dst[n][k] = *(const PG8_LAS bf16x8*)(lds + PG8_SB(b, h) + boff + n * 2048 + k * 1024); } while (0)
#define PG8_MMA(ai, bj, At, Bt) do { __builtin_amdgcn_s_setprio(1); _Pragma("unroll") for (int m = 0; m < 4; ++m) _Pragma("unroll") for (int n = 0; n < 2; ++n) _Pragma("unroll") for (int k = 0; k < 2; ++k) \
        acc[ai][bj][m][n] = __builtin_amdgcn_mfma_f32_16x16x32_bf16(Bt[n][k], At[m][k], acc[ai][bj][m][n], 0, 0, 0); __builtin_amdgcn_s_setprio(0); } while (0)
#define PG8_WAIT_V(n) asm volatile("s_waitcnt vmcnt(" #n ")" ::: "memory")
#define PG8_WAIT_L(n) asm volatile("s_waitcnt lgkmcnt(" #n ")" ::: "memory")
#define PG8_BAR __builtin_amdgcn_s_barrier()
#define PG8_SCHED __builtin_amdgcn_sched_barrier(0)
    Unit cur, nxt; int ui = 0;
    if (!S.next(0, cur)) return;
    f32x4 acc[2][2][4][2];
#pragma unroll
    for (int a = 0; a < 2; ++a)
#pragma unroll
        for (int b = 0; b < 2; ++b)
#pragma unroll
            for (int m = 0; m < 4; ++m)
#pragma unroll
                for (int n = 0; n < 2; ++n) acc[a][b][m][n] = (f32x4){0.f, 0.f, 0.f, 0.f};
    bf16x8 At[4][2], B0[2][2], B1[2][2];
    const char* cA = (const char*)g.A + (size_t)cur.pm * tstep; const char* cB = (const char*)g.Bt + (size_t)cur.pn * tstep;
    S.a_ready(cur);
    if constexpr (SP2) {
        PG8_STAGE(PG8_SB(0, 0), cB, voffB); PG8_STAGE(PG8_SB(0, 1), cB + hstep, voffB); PG8_STAGE(PG8_SA(0, 0), cA, voffA); PG8_STAGE(PG8_SA(0, 1), cA + hstep, voffA);
        if (wr == 1) PG8_BAR;
        PG8_WAIT_V(2); PG8_BAR;
        PG8_STAGE(PG8_SB(1, 0), cB + kstep, voffB); PG8_STAGE(PG8_SA(1, 0), cA + kstep, voffA); PG8_STAGE(PG8_SB(1, 1), cB + hstep + kstep, voffB);
        PG8_WAIT_V(6); PG8_BAR;
    } else {
        PG8_STAGE(PG8_SB(0, 0), cB, voffB); PG8_STAGE(PG8_SA(0, 0), cA, voffA); PG8_STAGE(PG8_SB(0, 1), cB + hstep, voffB); PG8_STAGE(PG8_SA(0, 1), cA + hstep, voffA);
        if (wr == 1) PG8_BAR;
        PG8_WAIT_V(4); PG8_BAR;
        PG8_STAGE(PG8_SB(1, 0), cB + kstep, voffB); PG8_STAGE(PG8_SA(1, 0), cA + kstep, voffA); PG8_STAGE(PG8_SB(1, 1), cB + hstep + kstep, voffB);
        PG8_WAIT_V(6); PG8_BAR;
    }
    for (;;) {
        const bool has_next = S.next(ui + 1, nxt);
        const char* nA = has_next ? (const char*)g.A + (size_t)nxt.pm * tstep : cA; const char* nB = has_next ? (const char*)g.Bt + (size_t)nxt.pn * tstep : cB;
        for (int t = 0; t < nt; t += 2) {
            const bool last = (t == nt - 2);
            const char* a1 = cA + (size_t)(t + 1) * kstep;
            const char* a2 = last ? nA : cA + (size_t)(t + 2) * kstep; const char* b2 = last ? nB : cB + (size_t)(t + 2) * kstep;
            const char* a3 = a2 + kstep; const char* b3 = b2 + kstep;
            if (last && has_next) S.a_ready(nxt);
            if constexpr (SP2) {
            PG8_LDB(B0, 0, 0); PG8_LDB(B1, 0, 1); PG8_SCHED; PG8_LDA(At, 0, 0); PG8_STAGE(PG8_SA(1, 1), a1 + hstep, voffA);
            PG8_WAIT_V(8); PG8_WAIT_L(0); PG8_BAR; PG8_MMA(0, 0, At, B0); PG8_MMA(0, 1, At, B1); PG8_BAR; PG8_SCHED;
            PG8_LDA(At, 0, 1); PG8_STAGE(PG8_SB(0, 0), b2, voffB); PG8_STAGE(PG8_SB(0, 1), b2 + hstep, voffB); PG8_STAGE(PG8_SA(0, 0), a2, voffA);
            PG8_WAIT_V(8); PG8_WAIT_L(0); PG8_BAR; PG8_MMA(1, 0, At, B0); PG8_MMA(1, 1, At, B1); PG8_BAR; PG8_SCHED;
            PG8_LDB(B0, 1, 0); PG8_LDB(B1, 1, 1); PG8_SCHED; PG8_LDA(At, 1, 0); PG8_STAGE(PG8_SA(0, 1), a2 + hstep, voffA);
            PG8_WAIT_V(8); PG8_WAIT_L(0); PG8_BAR; PG8_MMA(0, 0, At, B0); PG8_MMA(0, 1, At, B1); PG8_BAR; PG8_SCHED;
            PG8_LDA(At, 1, 1); PG8_STAGE(PG8_SB(1, 0), b3, voffB); PG8_STAGE(PG8_SB(1, 1), b3 + hstep, voffB); PG8_STAGE(PG8_SA(1, 0), a3, voffA);
            PG8_WAIT_V(8); PG8_WAIT_L(0); PG8_BAR; PG8_MMA(1, 0, At, B0); PG8_MMA(1, 1, At, B1); PG8_BAR; PG8_SCHED;
            } else {
            PG8_LDB(B0, 0, 0); PG8_SCHED; PG8_LDA(At, 0, 0); PG8_STAGE(PG8_SA(1, 1), a1 + hstep, voffA);
            PG8_WAIT_L(8); PG8_BAR; PG8_WAIT_L(0); PG8_MMA(0, 0, At, B0); PG8_BAR; PG8_SCHED;
            PG8_LDB(B1, 0, 1); PG8_STAGE(PG8_SB(0, 0), b2, voffB);
            PG8_BAR; PG8_WAIT_L(0); PG8_MMA(0, 1, At, B1); PG8_BAR;
            PG8_LDA(At, 0, 1); PG8_STAGE(PG8_SA(0, 0), a2, voffA);
            PG8_BAR; PG8_WAIT_L(0); PG8_MMA(1, 0, At, B0); PG8_BAR; PG8_SCHED;
            PG8_STAGE(PG8_SB(0, 1), b2 + hstep, voffB);
            PG8_WAIT_V(6); PG8_BAR; PG8_MMA(1, 1, At, B1); PG8_BAR;
            PG8_LDB(B0, 1, 0); PG8_SCHED; PG8_LDA(At, 1, 0); PG8_STAGE(PG8_SA(0, 1), a2 + hstep, voffA);
            PG8_WAIT_L(8); PG8_BAR; PG8_WAIT_L(0); PG8_MMA(0, 0, At, B0); PG8_BAR; PG8_SCHED;
            PG8_LDB(B1, 1, 1); PG8_STAGE(PG8_SB(1, 0), b3, voffB);
            PG8_BAR; PG8_WAIT_L(0); PG8_MMA(0, 1, At, B1); PG8_BAR;
            PG8_LDA(At, 1, 1); PG8_STAGE(PG8_SA(1, 0), a3, voffA);
            PG8_BAR; PG8_WAIT_L(0); PG8_MMA(1, 0, At, B0); PG8_BAR; PG8_SCHED;
            PG8_STAGE(PG8_SB(1, 1), b3 + hstep, voffB);
            PG8_WAIT_V(6); PG8_BAR; PG8_MMA(1, 1, At, B1); PG8_BAR;
            }
        }
        if constexpr (ALIGN_EPI) { if (wr == 0) PG8_BAR; }
        if constexpr (!Epi::AFTER_DRAIN) { E(acc, cur, wr, wc, fr, fq); S.done(cur); }
        if (!has_next) break;
#pragma unroll
        for (int a = 0; a < 2; ++a)
#pragma unroll
            for (int b = 0; b < 2; ++b)
#pragma unroll
                for (int m = 0; m < 4; ++m)
#pragma unroll
                    for (int n = 0; n < 2; ++n) acc[a][b][m][n] = (f32x4){0.f, 0.f, 0.f, 0.f};
        cur = nxt; cA = nA; cB = nB; ++ui;
        if constexpr (ALIGN_EPI) { if (wr == 1) PG8_BAR; }
    }
    PG8_WAIT_V(0);
    if constexpr (!ALIGN_EPI) { if (wr == 0) PG8_BAR; }
    PG8_BAR;
    if constexpr (Epi::AFTER_DRAIN) { E.fused(acc, cur, wr, wc, fr, fq, lds, wid, lane); S.done(cur); }
#undef PG8_SA
#undef PG8_SB
#undef PG8_STAGE
#undef PG8_LDA
#undef PG8_LDB
#undef PG8_MMA
#undef PG8_WAIT_V
#undef PG8_WAIT_L
#undef PG8_BAR
#undef PG8_SCHED
}
}

#define LAS __attribute__((address_space(3)))
#define DI __device__ __forceinline__
using pg8::bf16_t; using pg8::bf16x8; using pg8::f32x4; using pg8::u32x4; using pg8::cvt_pk_bf16;
typedef unsigned u32x2 __attribute__((ext_vector_type(2)));
typedef float f32x2 __attribute__((ext_vector_type(2)));

constexpr int T_TOK = 32768, DM = 2048, NPROJ = 5120, PROJW = 5128;
constexpr int NTHREADS = 512;
constexpr int LDS_BYTES = 147456;
constexpr float EPS = 1e-6f;

constexpr size_t WS_XN = 0;
constexpr size_t WS_P = 134217728;
constexpr size_t WS_X1G = WS_P;
constexpr size_t WS_Q = WS_P + 134217728;
constexpr size_t WS_WINT = WS_P + 335544320;
constexpr size_t WS_WOUTT = WS_WINT + 20971520;
constexpr size_t WS_WQT = WS_WOUTT + 8388608;
constexpr size_t WS_UB = WS_WQT + 4194304;
constexpr size_t WS_VB = WS_UB + 67108864;
constexpr size_t WS_ST = WS_VB + 67108864;
constexpr size_t WS_CPT = WS_ST + 142606336;
constexpr size_t WS_QC = WS_CPT + 71303168;
constexpr size_t WS_KC = WS_QC + 33554432;
constexpr size_t WS_IG = WS_KC + 33554432;
constexpr size_t WS_LF = WS_IG + 524288;
constexpr size_t WS_PSSV = WS_LF + 524288;
constexpr size_t WS_PSS2 = WS_PSSV + 2097152;
constexpr size_t WS_BEND = WS_PSS2 + 4194304;
constexpr size_t WS_GMAX = WS_BEND + 4096;
constexpr size_t WS_MPREV = WS_GMAX + 4096;
constexpr size_t WS_SELID = WS_MPREV + 4096;
constexpr size_t WS_SELG = WS_SELID + 16777216;
constexpr size_t WS_KB1 = WS_SELG + 16777216;
constexpr size_t WS_KB2 = WS_KB1 + 131072;
constexpr size_t WS_END = WS_KB2 + 131072;

struct Params {
    const float *x, *norm1_g, *w_in, *gm_vnorm_g, *w_spatial, *b_spatial, *ml_conv_w, *ml_conv_b, *ml_b_i, *ml_b_f, *gm_out_g, *ml_out_g, *w_out, *norm2_g,
        *peer_wq, *peer_k1, *peer_k2, *peer_u, *peer_v, *final_g;
    float* out;
    unsigned char* ws;
};

DI float bf2f(unsigned short h) { return __uint_as_float(((unsigned)h) << 16); }
DI float bflo(unsigned w) { return __uint_as_float(w << 16); }
DI float bfhi(unsigned w) { return __uint_as_float(w & 0xffff0000u); }
DI float rcpf_(float x) { return __builtin_amdgcn_rcpf(x); }
DI float sigmoid_(float x) { return rcpf_(1.f + __expf(-x)); }
DI float gelu_t(float x) { const float z = 1.5957691216057308f * (x + 0.044715f * x * x * x); return x * rcpf_(1.f + __expf(-z)); }
DI float wave_sum(float v) {
#pragma unroll
    for (int o = 32; o; o >>= 1) v += __shfl_xor(v, o);
    return v;
}
DI float wave_max(float v) {
#pragma unroll
    for (int o = 32; o; o >>= 1) v = fmaxf(v, __shfl_xor(v, o));
    return v;
}
DI bf16x8 ld_frag_lds(const LAS unsigned char* p) { return *(const LAS bf16x8*)p; }
#define MFMA16(a, b, c) __builtin_amdgcn_mfma_f32_16x16x32_bf16((a), (b), (c), 0, 0, 0)

struct Epi1 {
    static constexpr bool PERM = true, AFTER_DRAIN = false;
    bf16_t* P; float* pssv;
    DI void operator()(const f32x4 (&acc)[2][2][4][2], const pg8::Unit& u, int wr, int wc, int fr, int fq) const {
        const int row0 = u.pm * 256 + wr * 64 + fr, col0 = u.pn * 256 + wc * 32 + 8 * fq;
        const int mode = u.pn < 8 ? 1 : (u.pn >= 16 ? 2 : 0);
        const bool want_ss = (u.pn >= 4 && u.pn < 8);
#pragma unroll
        for (int ai = 0; ai < 2; ++ai)
#pragma unroll
            for (int m = 0; m < 4; ++m) {
                const int row = row0 + ai * 128 + m * 16;
                bf16_t* rowp = P + (size_t)row * NPROJ + col0;
                float ss = 0.f;
#pragma unroll
                for (int bj = 0; bj < 2; ++bj) {
                    f32x4 v0 = acc[ai][bj][m][0], v1 = acc[ai][bj][m][1];
                    if (mode == 1) {
#pragma unroll
                        for (int j = 0; j < 4; ++j) { v0[j] = gelu_t(v0[j]); v1[j] = gelu_t(v1[j]); ss += v0[j] * v0[j] + v1[j] * v1[j]; }
                    } else if (mode == 2) {
#pragma unroll
                        for (int j = 0; j < 4; ++j) { v0[j] = sigmoid_(v0[j]); v1[j] = sigmoid_(v1[j]); }
                    }
                    u32x4 w; w.x = cvt_pk_bf16(v0[0], v0[1]); w.y = cvt_pk_bf16(v0[2], v0[3]); w.z = cvt_pk_bf16(v1[0], v1[1]); w.w = cvt_pk_bf16(v1[2], v1[3]);
                    *(u32x4*)(rowp + bj * 128) = w;
                }
                if (want_ss) {
                    ss += __shfl_xor(ss, 16); ss += __shfl_xor(ss, 32);
                    if (fq == 0) pssv[(size_t)row * 16 + (u.pn - 4) * 4 + wc] = ss;
                }
            }
    }
};

struct Epi2 {
    static constexpr bool PERM = true, AFTER_DRAIN = false;
    const float* x; float* x1; bf16_t* x1g; const float* g2; float* pss2;
    DI void operator()(const f32x4 (&acc)[2][2][4][2], const pg8::Unit& u, int wr, int wc, int fr, int fq) const {
        const int row0 = u.pm * 256 + wr * 64 + fr, col0 = u.pn * 256 + wc * 32 + 8 * fq;
#pragma unroll
        for (int ai = 0; ai < 2; ++ai)
#pragma unroll
            for (int m = 0; m < 4; ++m) {
                const int row = row0 + ai * 128 + m * 16;
                float ss = 0.f;
#pragma unroll
                for (int bj = 0; bj < 2; ++bj) {
                    const size_t o = (size_t)row * DM + col0 + bj * 128;
                    f32x4 v0 = acc[ai][bj][m][0] + *(const f32x4*)(x + o), v1 = acc[ai][bj][m][1] + *(const f32x4*)(x + o + 4);
                    *(f32x4*)(x1 + o) = v0; *(f32x4*)(x1 + o + 4) = v1;
                    const f32x4 ga = *(const f32x4*)(g2 + col0 + bj * 128), gb = *(const f32x4*)(g2 + col0 + bj * 128 + 4);
#pragma unroll
                    for (int j = 0; j < 4; ++j) ss += v0[j] * v0[j] + v1[j] * v1[j];
                    v0 = v0 * ga; v1 = v1 * gb;
                    u32x4 w; w.x = cvt_pk_bf16(v0[0], v0[1]); w.y = cvt_pk_bf16(v0[2], v0[3]); w.z = cvt_pk_bf16(v1[0], v1[1]); w.w = cvt_pk_bf16(v1[2], v1[3]);
                    *(u32x4*)(x1g + o) = w;
                }
                ss += __shfl_xor(ss, 16); ss += __shfl_xor(ss, 32);
                if (fq == 0) pss2[(size_t)row * 32 + u.pn * 4 + wc] = ss;
            }
    }
};

struct Epi3 {
    static constexpr bool PERM = true, AFTER_DRAIN = false;
    bf16_t* Q; const float* pss2;
    DI void operator()(const f32x4 (&acc)[2][2][4][2], const pg8::Unit& u, int wr, int wc, int fr, int fq) const {
        const int row0 = u.pm * 256 + wr * 64 + fr, col0 = u.pn * 256 + wc * 32 + 8 * fq;
#pragma unroll
        for (int ai = 0; ai < 2; ++ai)
#pragma unroll
            for (int m = 0; m < 4; ++m) {
                const int row = row0 + ai * 128 + m * 16;
                float ss = 0.f;
#pragma unroll
                for (int i = 0; i < 8; ++i) { const f32x4 t = *(const f32x4*)(pss2 + (size_t)row * 32 + i * 4); ss += (t[0] + t[1]) + (t[2] + t[3]); }
                const float rstd = rsqrtf(ss * (1.f / 2048.f) + EPS);
#pragma unroll
                for (int bj = 0; bj < 2; ++bj) {
                    const f32x4 v0 = acc[ai][bj][m][0] * rstd, v1 = acc[ai][bj][m][1] * rstd;
                    u32x4 w; w.x = cvt_pk_bf16(v0[0], v0[1]); w.y = cvt_pk_bf16(v0[2], v0[3]); w.z = cvt_pk_bf16(v1[0], v1[1]); w.w = cvt_pk_bf16(v1[2], v1[3]);
                    *(u32x4*)(Q + (size_t)row * 1024 + col0 + bj * 128) = w;
                }
            }
    }
};

DI void phase0(const Params& p, LAS unsigned char* lds) {
    const int tid = threadIdx.x, lane = tid & 63, wave = tid >> 6;
    bf16_t* XN = (bf16_t*)(p.ws + WS_XN);
    {
        LAS float* scr = (LAS float*)lds + wave * (64 * 65);
        const int gw = blockIdx.x * 8 + wave, nw = gridDim.x * 8;
        for (int it = gw; it < 4096; it += nw) {
            const float* W; bf16_t* WT; int ldw, kt, nt;
            if (it < 2560) { W = p.w_in; WT = (bf16_t*)(p.ws + WS_WINT); ldw = PROJW; kt = it / 80; nt = it % 80; }
            else if (it < 3584) { const int j = it - 2560; W = p.w_out; WT = (bf16_t*)(p.ws + WS_WOUTT); ldw = 2048; kt = j >> 5; nt = j & 31; }
            else { const int j = it - 3584; W = p.peer_wq; WT = (bf16_t*)(p.ws + WS_WQT); ldw = 1024; kt = j >> 4; nt = j & 15; }
            const int k0 = kt * 64, n0 = nt * 64;
#pragma unroll 8
            for (int r = 0; r < 64; ++r) scr[r * 65 + lane] = W[(size_t)(k0 + r) * ldw + n0 + lane];
            __builtin_amdgcn_fence(__ATOMIC_RELEASE, "wavefront"); __builtin_amdgcn_wave_barrier(); __builtin_amdgcn_fence(__ATOMIC_ACQUIRE, "wavefront");
            const int half = lane >> 5, kk = (lane & 31) * 2;
#pragma unroll 8
            for (int nn = 0; nn < 32; ++nn) {
                const int n = 2 * nn + half; const float a = scr[kk * 65 + n], b = scr[(kk + 1) * 65 + n];
                *(unsigned*)(WT + (size_t)(n0 + n) * 2048 + k0 + kk) = cvt_pk_bf16(a, b);
            }
            __builtin_amdgcn_fence(__ATOMIC_RELEASE, "wavefront"); __builtin_amdgcn_wave_barrier(); __builtin_amdgcn_fence(__ATOMIC_ACQUIRE, "wavefront");
        }
    }
    __syncthreads();
    {
        LAS float* wg = (LAS float*)lds;
        for (int idx = tid; idx < 4096; idx += NTHREADS) {
            const int k = idx >> 1, hf = idx & 1;
            const f32x4 v = *(const f32x4*)(p.w_in + (size_t)k * PROJW + 5120 + hf * 4);
            *(LAS f32x4*)(wg + k * 8 + (k >> 3) * 4 + hf * 4) = v;
        }
        __syncthreads();
        float* IG = (float*)(p.ws + WS_IG); float* LF = (float*)(p.ws + WS_LF);
        for (int row = blockIdx.x * 8 + wave; row < T_TOK; row += gridDim.x * 8) {
            const float* xr = p.x + (size_t)row * DM;
            f32x4 xv[8]; float ss = 0.f;
#pragma unroll
            for (int i = 0; i < 4; ++i) { xv[2 * i] = *(const f32x4*)(xr + i * 512 + lane * 8); xv[2 * i + 1] = *(const f32x4*)(xr + i * 512 + lane * 8 + 4); }
#pragma unroll
            for (int i = 0; i < 8; ++i) ss += (xv[i][0] * xv[i][0] + xv[i][1] * xv[i][1]) + (xv[i][2] * xv[i][2] + xv[i][3] * xv[i][3]);
            ss = wave_sum(ss);
            const float rstd = rsqrtf(ss * (1.f / 2048.f) + EPS);
            f32x4 ga = {0.f, 0.f, 0.f, 0.f}, gb = {0.f, 0.f, 0.f, 0.f};
#pragma unroll
            for (int i = 0; i < 4; ++i) {
                const f32x4 g0 = *(const f32x4*)(p.norm1_g + i * 512 + lane * 8), g1 = *(const f32x4*)(p.norm1_g + i * 512 + lane * 8 + 4);
                const f32x4 h0 = xv[2 * i] * rstd * g0, h1 = xv[2 * i + 1] * rstd * g1;
                u32x4 w; w.x = cvt_pk_bf16(h0[0], h0[1]); w.y = cvt_pk_bf16(h0[2], h0[3]); w.z = cvt_pk_bf16(h1[0], h1[1]); w.w = cvt_pk_bf16(h1[2], h1[3]);
                *(u32x4*)(XN + (size_t)row * DM + i * 512 + lane * 8) = w;
                const LAS float* wb = wg + (i * 512 + lane * 8) * 8 + (i * 64 + lane) * 4;
#pragma unroll
                for (int e = 0; e < 8; ++e) {
                    const float hv = e < 4 ? h0[e & 3] : h1[e & 3];
                    const f32x4 w0 = *(const LAS f32x4*)(wb + e * 8), w1 = *(const LAS f32x4*)(wb + e * 8 + 4);
                    ga = ga + w0 * hv; gb = gb + w1 * hv;
                }
            }
            float zi = 0.f;
#pragma unroll
            for (int j = 0; j < 4; ++j) { const float a = wave_sum(ga[j]), b = wave_sum(gb[j]); zi = (lane == j) ? a : zi; zi = (lane == 4 + j) ? b : zi; }
            if (lane < 4) IG[(size_t)row * 4 + lane] = zi + p.ml_b_i[lane];
            else if (lane < 8) { const float z = zi + p.ml_b_f[lane - 4]; LF[(size_t)row * 4 + lane - 4] = fminf(z, 0.f) - log1pf(__expf(-fabsf(z))); }
        }
    }
    {
        const int nthr = gridDim.x * NTHREADS;
        for (int item = blockIdx.x * NTHREADS + tid; item < 2 * 16384 * 64; item += nthr) {
            const int which = item >> 20, rc = item & 1048575, row = rc >> 6, ch = rc & 63;
            const float* src = (which ? p.peer_v : p.peer_u) + (size_t)row * DM + ch * 32;
            unsigned char* dst = p.ws + (which ? WS_VB : WS_UB) + (size_t)row * 1152;
            f32x4 v[8]; float amax = 0.f;
#pragma unroll
            for (int q = 0; q < 8; ++q) { v[q] = *(const f32x4*)(src + q * 4); amax = fmaxf(amax, fmaxf(fmaxf(fabsf(v[q][0]), fabsf(v[q][1])), fmaxf(fabsf(v[q][2]), fabsf(v[q][3])))); }
            const unsigned sb = cvt_pk_bf16(amax * (1.f / 6.f), 0.f) & 0xffffu;
            float sc = bflo(sb); if (sc == 0.f) sc = 1.f;
            const float inv = 1.f / sc;
            u32x4 w;
#pragma unroll
            for (int d = 0; d < 4; ++d) {
                unsigned r = 0u;
                r = __builtin_amdgcn_cvt_scalef32_pk_fp4_f32(r, v[2 * d][0] * inv, v[2 * d][1] * inv, 1.0f, 0);
                r = __builtin_amdgcn_cvt_scalef32_pk_fp4_f32(r, v[2 * d][2] * inv, v[2 * d][3] * inv, 1.0f, 1);
                r = __builtin_amdgcn_cvt_scalef32_pk_fp4_f32(r, v[2 * d + 1][0] * inv, v[2 * d + 1][1] * inv, 1.0f, 2);
                r = __builtin_amdgcn_cvt_scalef32_pk_fp4_f32(r, v[2 * d + 1][2] * inv, v[2 * d + 1][3] * inv, 1.0f, 3);
                w[d] = r;
            }
            *(u32x4*)(dst + ch * 16) = w;
            *(unsigned short*)(dst + 1024 + ch * 2) = (unsigned short)(sc == 1.f && sb == 0u ? 0x3F80u : sb);
        }
    }
    {
        bf16_t* KB1 = (bf16_t*)(p.ws + WS_KB1); bf16_t* KB2 = (bf16_t*)(p.ws + WS_KB2);
        for (int i = blockIdx.x * NTHREADS + tid; i < 65536 / 4; i += gridDim.x * NTHREADS) {
            const f32x4 a = *(const f32x4*)(p.peer_k1 + i * 4), b = *(const f32x4*)(p.peer_k2 + i * 4);
            u32x2 w; w.x = cvt_pk_bf16(a[0], a[1]); w.y = cvt_pk_bf16(a[2], a[3]); *(u32x2*)(KB1 + i * 4) = w;
            w.x = cvt_pk_bf16(b[0], b[1]); w.y = cvt_pk_bf16(b[2], b[3]); *(u32x2*)(KB2 + i * 4) = w;
        }
    }
}

#define WAVE_LDS_SYNC() do { __builtin_amdgcn_fence(__ATOMIC_RELEASE, "wavefront"); __builtin_amdgcn_wave_barrier(); __builtin_amdgcn_fence(__ATOMIC_ACQUIRE, "wavefront"); } while (0)

DI void stage_T(const bf16_t* src, int ld, int ngroups, LAS unsigned char* dst, int wave, int lane) {
    for (int g = wave; g < ngroups; g += 8) {
        const u32x4 r0 = *(const u32x4*)(src + (size_t)(2 * lane) * ld + g * 8);
        const u32x4 r1 = *(const u32x4*)(src + (size_t)(2 * lane + 1) * ld + g * 8);
#pragma unroll
        for (int w = 0; w < 4; ++w) {
            const unsigned a = r0[w], b = r1[w];
            *(LAS unsigned*)(dst + (g * 8 + 2 * w) * 272 + lane * 4) = (a & 0xffffu) | (b << 16);
            *(LAS unsigned*)(dst + (g * 8 + 2 * w + 1) * 272 + lane * 4) = (a >> 16) | (b & 0xffff0000u);
        }
    }
}

DI void gmlp_bc(const Params& p, LAS unsigned char* lds, int b, int c) {
    const int tid = threadIdx.x, lane = tid & 63, wave = __builtin_amdgcn_readfirstlane(tid >> 6), fr = lane & 15, fq = lane >> 4;
    const int t0 = b * 8192 + c * 128;
    LAS unsigned char* Wl = lds; LAS unsigned char* GvT = lds + 34816; LAS float* rstdv = (LAS float*)(lds + 69632);
    const bf16_t* P = (const bf16_t*)(p.ws + WS_P); bf16_t* YM = (bf16_t*)(p.ws + WS_XN);
    const float* PSSV = (const float*)(p.ws + WS_PSSV);
    __syncthreads();
    if (tid < 128) {
        float ss = 0.f;
#pragma unroll
        for (int i = 0; i < 4; ++i) { const f32x4 v = *(const f32x4*)(PSSV + (size_t)(t0 + tid) * 16 + i * 4); ss += (v[0] + v[1]) + (v[2] + v[3]); }
        rstdv[tid] = rsqrtf(ss * (1.f / 1024.f) + EPS);
    }
    for (int h = 0; h < 8; ++h) {
        __syncthreads();
#pragma unroll
        for (int it = 0; it < 4; ++it) {
            const int e = (it * NTHREADS + tid) * 8, t = e >> 7, s0 = e & 127;
            const float* wp = p.w_spatial + ((size_t)(h * 128 + t)) * 128 + s0;
            const f32x4 a0 = *(const f32x4*)wp, a1 = *(const f32x4*)(wp + 4);
            float v[8];
#pragma unroll
            for (int j = 0; j < 8; ++j) { const float a = j < 4 ? a0[j & 3] : a1[j & 3]; v[j] = (s0 + j <= t) ? a * rstdv[s0 + j] : 0.f; }
            u32x4 w; w.x = cvt_pk_bf16(v[0], v[1]); w.y = cvt_pk_bf16(v[2], v[3]); w.z = cvt_pk_bf16(v[4], v[5]); w.w = cvt_pk_bf16(v[6], v[7]);
            *(LAS u32x4*)(Wl + t * 272 + s0 * 2) = w;
        }
        stage_T(P + (size_t)t0 * NPROJ + 1024 + h * 128, NPROJ, 16, GvT, wave, lane);
        __syncthreads();
        f32x4 acc[8];
#pragma unroll
        for (int n = 0; n < 8; ++n) acc[n] = (f32x4){0.f, 0.f, 0.f, 0.f};
        const int kmax = (16 * wave + 15) >> 5;
#pragma unroll
        for (int kk = 0; kk < 4; ++kk) {
            if (kk <= kmax) {
                const bf16x8 bfrag = ld_frag_lds(Wl + (16 * wave + fr) * 272 + (32 * kk + 8 * fq) * 2);
#pragma unroll
                for (int n = 0; n < 8; ++n) { const bf16x8 afrag = ld_frag_lds(GvT + (16 * n + fr) * 272 + (32 * kk + 8 * fq) * 2); acc[n] = MFMA16(afrag, bfrag, acc[n]); }
            }
        }
        const int t = 16 * wave + fr; const size_t grow = (size_t)(t0 + t);
        const float bsp = p.b_spatial[h * 128 + t];
        float ss = 0.f;
#pragma unroll
        for (int n = 0; n < 8; ++n) {
            const int d0 = 16 * n + 4 * fq;
            const u32x2 uw = *(const u32x2*)(P + grow * NPROJ + h * 128 + d0);
            const f32x4 gv = *(const f32x4*)(p.gm_vnorm_g + h * 128 + d0);
            f32x4 y;
            y[0] = bflo(uw.x) * (gv[0] * acc[n][0] + bsp); y[1] = bfhi(uw.x) * (gv[1] * acc[n][1] + bsp);
            y[2] = bflo(uw.y) * (gv[2] * acc[n][2] + bsp); y[3] = bfhi(uw.y) * (gv[3] * acc[n][3] + bsp);
            ss += (y[0] * y[0] + y[1] * y[1]) + (y[2] * y[2] + y[3] * y[3]);
            acc[n] = y;
        }
        ss += __shfl_xor(ss, 16); ss += __shfl_xor(ss, 32);
        const float rstd = rsqrtf(ss * (1.f / 128.f) + EPS);
#pragma unroll
        for (int n = 0; n < 8; ++n) {
            const int d0 = 16 * n + 4 * fq;
            const f32x4 g = *(const f32x4*)(p.gm_out_g + h * 128 + d0);
            const f32x4 o = acc[n] * rstd * g;
            u32x2 w; w.x = cvt_pk_bf16(o[0], o[1]); w.y = cvt_pk_bf16(o[2], o[3]);
            *(u32x2*)(YM + grow * DM + h * 128 + d0) = w;
        }
    }
}

DI void mlstm_local(const Params& p, LAS unsigned char* lds, int b, int c, int h) {
    const int tid = threadIdx.x, lane = tid & 63, wave = __builtin_amdgcn_readfirstlane(tid >> 6), fr = lane & 15, fq = lane >> 4;
    const int bh = b * 4 + h, t0 = b * 8192 + c * 128;
    LAS unsigned char* KT = lds; LAS unsigned char* VT = lds + 34816; LAS float* wsv = (LAS float*)(lds + 108800);
    const bf16_t* P = (const bf16_t*)(p.ws + WS_P);
    bf16_t* QC = (bf16_t*)(p.ws + WS_QC); bf16_t* KC = (bf16_t*)(p.ws + WS_KC);
    const float* IG = (const float*)(p.ws + WS_IG); const float* LF = (const float*)(p.ws + WS_LF);
    __syncthreads();
    if (wave == 0) {
        const float l0 = LF[(size_t)(t0 + 2 * lane) * 4 + h], l1 = LF[(size_t)(t0 + 2 * lane + 1) * 4 + h];
        const float i0 = IG[(size_t)(t0 + 2 * lane) * 4 + h], i1 = IG[(size_t)(t0 + 2 * lane + 1) * 4 + h];
        float s = l0 + l1;
#pragma unroll
        for (int off = 1; off < 64; off <<= 1) { const float tt = __shfl_up(s, off); if (lane >= off) s += tt; }
        const float b1 = s, b0 = s - l1, bend = __shfl(s, 63);
        const float g0 = bend - b0 + i0, g1 = bend - b1 + i1;
        const float gmax = wave_max(fmaxf(g0, g1));
        wsv[2 * lane] = __expf(g0 - gmax); wsv[2 * lane + 1] = __expf(g1 - gmax);
        if (lane == 0) { ((float*)(p.ws + WS_BEND))[bh * 64 + c] = bend; ((float*)(p.ws + WS_GMAX))[bh * 64 + c] = gmax; }
    }
    __syncthreads();
    for (int g = wave; g < 32; g += 8) {
        const bool isk = g >= 16; const int cgp = (g & 15) * 8;
        const int ch = (isk ? 512 : 0) + h * 128 + cgp;
        const bf16_t* src = P + (isk ? 2560 : 2048) + h * 128 + cgp;
        const int s = 2 * lane;
        float xr[5][8];
#pragma unroll
        for (int dj = 0; dj < 5; ++dj) {
            const int srow = s - 3 + dj;
            u32x4 w = {0u, 0u, 0u, 0u};
            if (c > 0 || srow >= 0) w = *(const u32x4*)(src + (size_t)((long)t0 + srow) * NPROJ);
#pragma unroll
            for (int q = 0; q < 4; ++q) { xr[dj][2 * q] = bflo(w[q]); xr[dj][2 * q + 1] = bfhi(w[q]); }
        }
        float y0[8], y1[8];
        {
            const f32x4 cb0 = *(const f32x4*)(p.ml_conv_b + ch), cb1 = *(const f32x4*)(p.ml_conv_b + ch + 4);
#pragma unroll
            for (int e = 0; e < 8; ++e) { y0[e] = e < 4 ? cb0[e & 3] : cb1[e & 3]; y1[e] = y0[e]; }
#pragma unroll
            for (int j = 0; j < 4; ++j) {
                const f32x4 w0 = *(const f32x4*)(p.ml_conv_w + j * 1024 + ch), w1 = *(const f32x4*)(p.ml_conv_w + j * 1024 + ch + 4);
#pragma unroll
                for (int e = 0; e < 8; ++e) { const float wv = e < 4 ? w0[e & 3] : w1[e & 3]; y0[e] += wv * xr[j][e]; y1[e] += wv * xr[j + 1][e]; }
            }
        }
        const float sc = isk ? 0.08838834764831845f : 1.f;
#pragma unroll
        for (int e = 0; e < 8; ++e) { y0[e] = y0[e] * sigmoid_(y0[e]) * sc; y1[e] = y1[e] * sigmoid_(y1[e]) * sc; }
        bf16_t* dst = (isk ? KC : QC) + (size_t)(t0 + s) * 512 + h * 128 + cgp;
        u32x4 w; w.x = cvt_pk_bf16(y0[0], y0[1]); w.y = cvt_pk_bf16(y0[2], y0[3]); w.z = cvt_pk_bf16(y0[4], y0[5]); w.w = cvt_pk_bf16(y0[6], y0[7]);
        *(u32x4*)dst = w;
        w.x = cvt_pk_bf16(y1[0], y1[1]); w.y = cvt_pk_bf16(y1[2], y1[3]); w.z = cvt_pk_bf16(y1[4], y1[5]); w.w = cvt_pk_bf16(y1[6], y1[7]);
        *(u32x4*)(dst + 512) = w;
        if (isk) {
            const float w0 = wsv[s], w1 = wsv[s + 1];
#pragma unroll
            for (int e = 0; e < 8; ++e) *(LAS unsigned*)(KT + (cgp + e) * 272 + lane * 4) = cvt_pk_bf16(y0[e] * w0, y1[e] * w1);
        }
    }
    stage_T(P + (size_t)t0 * NPROJ + 3072 + h * 256, NPROJ, 32, VT, wave, lane);
    for (int i = tid; i < 1024; i += NTHREADS) { const int r = i >> 6, w = i & 63; *(LAS unsigned*)(VT + (256 + r) * 272 + w * 4) = 0x3F803F80u; }
    __syncthreads();
    bf16x8 af[4];
#pragma unroll
    for (int kk = 0; kk < 4; ++kk) af[kk] = ld_frag_lds(KT + (16 * wave + fr) * 272 + (32 * kk + 8 * fq) * 2);
    float* ST = (float*)(p.ws + WS_ST) + ((size_t)(bh * 64 + c) * 272) * 128;
#pragma unroll
    for (int n = 0; n < 17; ++n) {
        f32x4 acc = {0.f, 0.f, 0.f, 0.f};
#pragma unroll
        for (int kk = 0; kk < 4; ++kk) { const bf16x8 bfr = ld_frag_lds(VT + (16 * n + fr) * 272 + (32 * kk + 8 * fq) * 2); acc = MFMA16(af[kk], bfr, acc); }
        if (n < 16 || fr == 0) *(f32x4*)(ST + (size_t)(16 * n + fr) * 128 + 16 * wave + 4 * fq) = acc;
    }
}

DI void phase_scan(const Params& p) {
    const float* ST = (const float*)(p.ws + WS_ST); bf16_t* CPT = (bf16_t*)(p.ws + WS_CPT);
    const float* BEND = (const float*)(p.ws + WS_BEND); const float* GMAX = (const float*)(p.ws + WS_GMAX); float* MPREV = (float*)(p.ws + WS_MPREV);
    const int gtid = blockIdx.x * NTHREADS + threadIdx.x, nthr = gridDim.x * NTHREADS;
    constexpr int PER = 8224;
    constexpr size_t CST = 272 * 128;
    for (int item = gtid; item < 16 * PER; item += nthr) {
        const int bh = item / PER, e4 = item - bh * PER;
        const float* src = ST + (size_t)bh * 64 * CST + (size_t)e4 * 4;
        bf16_t* dst = CPT + (size_t)bh * 64 * CST + (size_t)e4 * 4;
        f32x4 st = {0.f, 0.f, 0.f, 0.f}; float m = 0.f;
        for (int c0 = 0; c0 < 64; c0 += 8) {
            f32x4 d[8];
#pragma unroll
            for (int j = 0; j < 8; ++j) d[j] = *(const f32x4*)(src + (size_t)(c0 + j) * CST);
#pragma unroll
            for (int j = 0; j < 8; ++j) {
                const int c = c0 + j;
                const float be = BEND[bh * 64 + c], gm = GMAX[bh * 64 + c];
                const float mn = fmaxf(be + m, gm), a = __expf(be + m - mn), sc = __expf(gm - mn);
                u32x2 w; w.x = cvt_pk_bf16(st[0], st[1]); w.y = cvt_pk_bf16(st[2], st[3]);
                *(u32x2*)(dst + (size_t)c * CST) = w;
                if (e4 == 0) MPREV[bh * 64 + c] = m;
                st = st * a + d[j] * sc; m = mn;
            }
        }
    }
}

DI void mlstm_out(const Params& p, LAS unsigned char* lds, int b, int c, int h) {
    const int tid = threadIdx.x, lane = tid & 63, wave = __builtin_amdgcn_readfirstlane(tid >> 6), fr = lane & 15, fq = lane >> 4;
    const int bh = b * 4 + h, t0 = b * 8192 + c * 128;
    LAS unsigned char* Kl = lds; LAS unsigned char* Sl = lds + 34816; LAS unsigned char* VTe = lds + 69632;
    LAS float* av = (LAS float*)(lds + 143616); LAS float* Mv = (LAS float*)(lds + 144128); LAS float* bv = (LAS float*)(lds + 144640);
    const bf16_t* P = (const bf16_t*)(p.ws + WS_P); bf16_t* YM = (bf16_t*)(p.ws + WS_XN);
    const bf16_t* QC = (const bf16_t*)(p.ws + WS_QC); const bf16_t* KC = (const bf16_t*)(p.ws + WS_KC);
    const float* IG = (const float*)(p.ws + WS_IG); const float* LF = (const float*)(p.ws + WS_LF);
    const float mprev = ((const float*)(p.ws + WS_MPREV))[bh * 64 + c];
    __syncthreads();
    if (wave == 0) {
        const float l0 = LF[(size_t)(t0 + 2 * lane) * 4 + h], l1 = LF[(size_t)(t0 + 2 * lane + 1) * 4 + h];
        const float i0 = IG[(size_t)(t0 + 2 * lane) * 4 + h], i1 = IG[(size_t)(t0 + 2 * lane + 1) * 4 + h];
        float s = l0 + l1;
#pragma unroll
        for (int off = 1; off < 64; off <<= 1) { const float tt = __shfl_up(s, off); if (lane >= off) s += tt; }
        const float b1 = s, b0 = s - l1;
        const float a0 = i0 - b0, a1 = i1 - b1;
        float pm = fmaxf(a0, a1);
#pragma unroll
        for (int off = 1; off < 64; off <<= 1) { const float tt = __shfl_up(pm, off); if (lane >= off) pm = fmaxf(pm, tt); }
        float ex = __shfl_up(pm, 1); if (lane == 0) ex = -3.0e38f;
        Mv[2 * lane] = fmaxf(mprev, fmaxf(ex, a0)); Mv[2 * lane + 1] = fmaxf(mprev, pm);
        av[2 * lane] = a0; av[2 * lane + 1] = a1; bv[2 * lane] = b0; bv[2 * lane + 1] = b1;
    }
#pragma unroll
    for (int it = 0; it < 4; ++it) {
        const int e = (it * NTHREADS + tid) * 8, s = e >> 7, d0 = e & 127;
        *(LAS u32x4*)(Kl + s * 272 + d0 * 2) = *(const u32x4*)(KC + (size_t)(t0 + s) * 512 + h * 128 + d0);
    }
    stage_T(P + (size_t)t0 * NPROJ + 3072 + h * 256, NPROJ, 32, VTe, wave, lane);
    for (int i = tid; i < 1024; i += NTHREADS) { const int r = i >> 6, w = i & 63; *(LAS unsigned*)(VTe + (256 + r) * 272 + w * 4) = 0x3F803F80u; }
    bf16x8 qf[4];
#pragma unroll
    for (int kk = 0; kk < 4; ++kk) qf[kk] = *(const bf16x8*)(QC + (size_t)(t0 + 16 * wave + fr) * 512 + h * 128 + 32 * kk + 8 * fq);
    __syncthreads();
    const int t = 16 * wave + fr; const float Mt = Mv[t];
    const int stmax = wave | 1;
    for (int st = 0; st <= stmax; ++st) {
        f32x4 s4 = {0.f, 0.f, 0.f, 0.f};
#pragma unroll
        for (int kk = 0; kk < 4; ++kk) { const bf16x8 kf = ld_frag_lds(Kl + (16 * st + fr) * 272 + (32 * kk + 8 * fq) * 2); s4 = MFMA16(kf, qf[kk], s4); }
#pragma unroll
        for (int r = 0; r < 4; ++r) { const int s = 16 * st + 4 * fq + r; const float w = (s <= t) ? __expf(av[s] - Mt) : 0.f; s4[r] *= w; }
        u32x2 w; w.x = cvt_pk_bf16(s4[0], s4[1]); w.y = cvt_pk_bf16(s4[2], s4[3]);
        *(LAS u32x2*)(Sl + t * 272 + (16 * st + 4 * fq) * 2) = w;
    }
    __syncthreads();
    const bf16_t* cpt = (const bf16_t*)(p.ws + WS_CPT) + ((size_t)(bh * 64 + c) * 272) * 128;
    f32x4 acc[17];
#pragma unroll
    for (int n = 0; n < 17; ++n) {
        acc[n] = (f32x4){0.f, 0.f, 0.f, 0.f};
#pragma unroll
        for (int kk = 0; kk < 4; ++kk) { const bf16x8 cf = *(const bf16x8*)(cpt + (size_t)(16 * n + fr) * 128 + 32 * kk + 8 * fq); acc[n] = MFMA16(cf, qf[kk], acc[n]); }
    }
    const float ai = __expf(mprev - Mt);
#pragma unroll
    for (int n = 0; n < 17; ++n) acc[n] = acc[n] * ai;
    const int k2max = (16 * wave + 15) >> 5;
#pragma unroll
    for (int kk = 0; kk < 4; ++kk) {
        if (kk <= k2max) {
            const bf16x8 sf = ld_frag_lds(Sl + t * 272 + (32 * kk + 8 * fq) * 2);
#pragma unroll
            for (int n = 0; n < 17; ++n) { const bf16x8 vf = ld_frag_lds(VTe + (16 * n + fr) * 272 + (32 * kk + 8 * fq) * 2); acc[n] = MFMA16(vf, sf, acc[n]); }
        }
    }
    const float den = __shfl(acc[16][0], fr);
    const float mt = bv[t] + Mt;
    const float inv = rcpf_(fmaxf(fabsf(den), __expf(-mt)));
    const size_t grow = (size_t)(t0 + t);
    float ss = 0.f;
#pragma unroll
    for (int n = 0; n < 16; ++n) {
        const int v0 = 16 * n + 4 * fq;
        const u32x2 ow = *(const u32x2*)(P + grow * NPROJ + 4096 + h * 256 + v0);
        f32x4 y;
        y[0] = bflo(ow.x) * acc[n][0] * inv; y[1] = bfhi(ow.x) * acc[n][1] * inv; y[2] = bflo(ow.y) * acc[n][2] * inv; y[3] = bfhi(ow.y) * acc[n][3] * inv;
        ss += (y[0] * y[0] + y[1] * y[1]) + (y[2] * y[2] + y[3] * y[3]);
        acc[n] = y;
    }
    ss += __shfl_xor(ss, 16); ss += __shfl_xor(ss, 32);
    const float rstd = rsqrtf(ss * (1.f / 256.f) + EPS);
#pragma unroll
    for (int n = 0; n < 16; ++n) {
        const int v0 = 16 * n + 4 * fq;
        const f32x4 g = *(const f32x4*)(p.ml_out_g + h * 256 + v0);
        const f32x4 o = acc[n] * rstd * g;
        u32x2 w; w.x = cvt_pk_bf16(o[0], o[1]); w.y = cvt_pk_bf16(o[2], o[3]);
        *(u32x2*)(YM + grow * DM + 1024 + h * 256 + v0) = w;
    }
}

DI unsigned ord_key(float f) { const unsigned u = __float_as_uint(f); return (u & 0x80000000u) ? ~u : (u | 0x80000000u); }
DI float key_val(unsigned k) { return (k & 0x80000000u) ? __uint_as_float(k & 0x7fffffffu) : __uint_as_float(~k); }
DI unsigned umax_(unsigned a, unsigned b) { return a > b ? a : b; }
DI unsigned umin_(unsigned a, unsigned b) { return a < b ? a : b; }
#define DPPU(v, ctrl) ((unsigned)__builtin_amdgcn_update_dpp(0, (int)(v), (ctrl), 0xF, 0xF, true))
DI unsigned row_max_u32(unsigned v) {
    v = umax_(v, DPPU(v, 0xB1)); v = umax_(v, DPPU(v, 0x4E)); v = umax_(v, DPPU(v, 0x141)); v = umax_(v, DPPU(v, 0x140)); return v;
}
DI float row_sum_f32(float v) {
    v += __uint_as_float(DPPU(__float_as_uint(v), 0xB1)); v += __uint_as_float(DPPU(__float_as_uint(v), 0x4E));
    v += __uint_as_float(DPPU(__float_as_uint(v), 0x141)); v += __uint_as_float(DPPU(__float_as_uint(v), 0x140)); return v;
}
#define CEX(a, b) do { const unsigned mx_ = umax_(a, b), mn_ = umin_(a, b); a = mx_; b = mn_; } while (0)
template <int N> DI unsigned top16_row(unsigned (&s)[N], int c) {
    unsigned list = 0u;
#pragma unroll 1
    for (int it = 0; it < 16; ++it) {
        const unsigned wm = row_max_u32(s[0]);
        const bool win = (s[0] == wm);
#pragma unroll
        for (int i = 0; i < N - 1; ++i) s[i] = win ? s[i + 1] : s[i];
        s[N - 1] = win ? 0u : s[N - 1];
        list = (c == it) ? wm : list;
    }
    return list;
}

DI void peer_select(const Params& p) {
    const int tid = threadIdx.x, lane = tid & 63, wave = __builtin_amdgcn_readfirstlane(tid >> 6), c = lane & 15, g = lane >> 4, rowbase = lane & 48;
    const bf16_t* Q = (const bf16_t*)(p.ws + WS_Q); const bf16_t* KB1 = (const bf16_t*)(p.ws + WS_KB1); const bf16_t* KB2 = (const bf16_t*)(p.ws + WS_KB2);
    int* SELID = (int*)(p.ws + WS_SELID); float* SELG = (float*)(p.ws + WS_SELG);
    unsigned pk = 0u, validmask = 0u;
#pragma unroll
    for (int q = 0; q < 4; ++q) {
        const int target = 4 * c + q; int ci = 0, cj = 0, cnt = 0; bool v = false;
#pragma unroll
        for (int i = 0; i < 16; ++i) { const int nj = 16 / (i + 1); if (target >= cnt && target < cnt + nj) { ci = i; cj = target - cnt; v = true; } cnt += nj; }
        pk |= (unsigned)((ci << 4) | cj) << (8 * q); validmask |= (v ? 1u : 0u) << q;
    }
    for (int tile = blockIdx.x * 8 + wave; tile < T_TOK / 16; tile += gridDim.x * 8) {
        const int tok0 = tile * 16;
        for (int h = 0; h < 8; ++h) {
            bf16x8 a1[2], a2[2];
            {
                const bf16_t* qp = Q + (size_t)(tok0 + c) * 1024 + h * 128 + g * 8;
                a1[0] = *(const bf16x8*)qp; a1[1] = *(const bf16x8*)(qp + 32); a2[0] = *(const bf16x8*)(qp + 64); a2[1] = *(const bf16x8*)(qp + 96);
            }
            f32x4 acc1[8], acc2[8];
#pragma unroll
            for (int nt = 0; nt < 8; ++nt) {
                const size_t ko = ((size_t)(h * 128 + nt * 16 + c)) * 64 + g * 8;
                acc1[nt] = (f32x4){0.f, 0.f, 0.f, 0.f}; acc2[nt] = (f32x4){0.f, 0.f, 0.f, 0.f};
                acc1[nt] = MFMA16(a1[0], *(const bf16x8*)(KB1 + ko), acc1[nt]); acc1[nt] = MFMA16(a1[1], *(const bf16x8*)(KB1 + ko + 32), acc1[nt]);
                acc2[nt] = MFMA16(a2[0], *(const bf16x8*)(KB2 + ko), acc2[nt]); acc2[nt] = MFMA16(a2[1], *(const bf16x8*)(KB2 + ko + 32), acc2[nt]);
            }
#pragma unroll
            for (int r = 0; r < 4; ++r) {
                unsigned s[8];
#pragma unroll
                for (int nt = 0; nt < 8; ++nt) s[nt] = (ord_key(acc1[nt][r]) & ~0x7Fu) | (unsigned)(127 - (nt * 16 + c));
                CEX(s[0], s[1]); CEX(s[2], s[3]); CEX(s[4], s[5]); CEX(s[6], s[7]); CEX(s[0], s[2]); CEX(s[1], s[3]); CEX(s[4], s[6]); CEX(s[5], s[7]); CEX(s[1], s[2]); CEX(s[5], s[6]);
                CEX(s[0], s[4]); CEX(s[1], s[5]); CEX(s[2], s[6]); CEX(s[3], s[7]); CEX(s[2], s[4]); CEX(s[3], s[5]); CEX(s[1], s[2]); CEX(s[3], s[4]); CEX(s[5], s[6]);
                const unsigned list1 = top16_row<8>(s, c);
#pragma unroll
                for (int nt = 0; nt < 8; ++nt) s[nt] = (ord_key(acc2[nt][r]) & ~0x7Fu) | (unsigned)(127 - (nt * 16 + c));
                CEX(s[0], s[1]); CEX(s[2], s[3]); CEX(s[4], s[5]); CEX(s[6], s[7]); CEX(s[0], s[2]); CEX(s[1], s[3]); CEX(s[4], s[6]); CEX(s[5], s[7]); CEX(s[1], s[2]); CEX(s[5], s[6]);
                CEX(s[0], s[4]); CEX(s[1], s[5]); CEX(s[2], s[6]); CEX(s[3], s[7]); CEX(s[2], s[4]); CEX(s[3], s[5]); CEX(s[1], s[2]); CEX(s[3], s[4]); CEX(s[5], s[6]);
                const unsigned list2 = top16_row<8>(s, c);
                unsigned cs[4];
#pragma unroll
                for (int q = 0; q < 4; ++q) {
                    const int ci = (int)((pk >> (8 * q + 4)) & 15u), cj = (int)((pk >> (8 * q)) & 15u);
                    const unsigned k1 = (unsigned)__shfl((int)list1, rowbase + ci), k2 = (unsigned)__shfl((int)list2, rowbase + cj);
                    const float cand = key_val(k1 & ~0x7Fu) + key_val(k2 & ~0x7Fu);
                    cs[q] = ((validmask >> q) & 1u) ? ((ord_key(cand) & ~0x3Fu) | (unsigned)(63 - (4 * c + q))) : 0u;
                }
                CEX(cs[0], cs[1]); CEX(cs[2], cs[3]); CEX(cs[0], cs[2]); CEX(cs[1], cs[3]); CEX(cs[1], cs[2]);
                const unsigned sel = top16_row<4>(cs, c);
                const int slot = 63 - (int)(sel & 63u);
                const unsigned pkv = (unsigned)__shfl((int)pk, rowbase + (slot >> 2));
                const int cij = (int)((pkv >> (8 * (slot & 3))) & 0xFFu);
                const unsigned e1 = (unsigned)__shfl((int)list1, rowbase + (cij >> 4)), e2 = (unsigned)__shfl((int)list2, rowbase + (cij & 15));
                const int eid = (127 - (int)(e1 & 127u)) * 128 + (127 - (int)(e2 & 127u));
                const float sv = key_val(sel & ~0x3Fu), mx = key_val(row_max_u32(sel) & ~0x3Fu);
                const float ev = __expf(sv - mx);
                const float sum = row_sum_f32(ev);
                const size_t o = (size_t)(tok0 + 4 * g + r) * 128 + h * 16 + c;
                SELID[o] = eid; SELG[o] = ev * rcpf_(sum);
            }
        }
    }
}

DI f32x2 pkfma(f32x2 a, f32x2 b, f32x2 c) { return __builtin_elementwise_fma(a, b, c); }
DI void peer_gather(const Params& p, LAS unsigned char* lds) {
    const int tid = threadIdx.x, lane = tid & 63, wave = __builtin_amdgcn_readfirstlane(tid >> 6);
    LAS float* scr = (LAS float*)lds + wave * (16 * 68);
    LAS float* cfl = (LAS float*)(lds + 8 * 16 * 68 * 4) + wave * 128;
    const unsigned char* Ub = p.ws + WS_UB; const unsigned char* Vb = p.ws + WS_VB;
    const float* PSS2 = (const float*)(p.ws + WS_PSS2);
    const int* SELID = (const int*)(p.ws + WS_SELID); const float* SELG = (const float*)(p.ws + WS_SELG);
    const int gw = blockIdx.x * 8 + wave, nw = gridDim.x * 8;
    for (int t = gw; t < T_TOK; t += nw) {
        const int idA = SELID[(size_t)t * 128 + lane], idB = SELID[(size_t)t * 128 + 64 + lane];
        const float gA = SELG[(size_t)t * 128 + lane], gB = SELG[(size_t)t * 128 + 64 + lane];
        float* xrow = p.out + (size_t)t * DM + lane * 32;
        const float pv = lane < 32 ? PSS2[(size_t)t * 32 + lane] : 0.f;
        const float rstd2 = rsqrtf(wave_sum(pv) * (1.f / 2048.f) + EPS);
        f32x2 h2[16];
#pragma unroll
        for (int q = 0; q < 8; ++q) {
            const f32x4 x0 = *(const f32x4*)(xrow + q * 4), g0 = *(const f32x4*)(p.norm2_g + lane * 32 + q * 4);
            h2[2 * q] = (f32x2){x0[0] * rstd2 * g0[0], x0[1] * rstd2 * g0[1]};
            h2[2 * q + 1] = (f32x2){x0[2] * rstd2 * g0[2], x0[3] * rstd2 * g0[3]};
        }
        constexpr int NPK = 8;
        u32x4 buf[2][NPK]; unsigned short bsc[2][NPK];
#define PEER_LOAD(TB, st, base) do { const int idv_ = ((base) < 64) ? idA : idB; _Pragma("unroll") for (int e_ = 0; e_ < NPK; ++e_) { \
            const int id_ = __builtin_amdgcn_readlane(idv_, ((base) + e_) & 63); const unsigned char* r_ = (TB) + (size_t)id_ * 1152; \
            buf[st][e_] = *(const u32x4*)(r_ + lane * 16); bsc[st][e_] = *(const unsigned short*)(r_ + 1024 + lane * 2); } } while (0)
#define PEER_DOT(st, slot0) do { _Pragma("unroll") for (int e_ = 0; e_ < NPK; ++e_) { f32x2 a2_ = {0.f, 0.f}; \
            _Pragma("unroll") for (int d_ = 0; d_ < 4; ++d_) { const unsigned w_ = buf[st][e_][d_]; \
                a2_ = pkfma(h2[d_ * 4 + 0], __builtin_amdgcn_cvt_scalef32_pk_f32_fp4(w_, 1.0f, 0), a2_); a2_ = pkfma(h2[d_ * 4 + 1], __builtin_amdgcn_cvt_scalef32_pk_f32_fp4(w_, 1.0f, 1), a2_); \
                a2_ = pkfma(h2[d_ * 4 + 2], __builtin_amdgcn_cvt_scalef32_pk_f32_fp4(w_, 1.0f, 2), a2_); a2_ = pkfma(h2[d_ * 4 + 3], __builtin_amdgcn_cvt_scalef32_pk_f32_fp4(w_, 1.0f, 3), a2_); } \
            scr[((slot0) + e_) * 68 + lane] = (a2_[0] + a2_[1]) * bf2f(bsc[st][e_]); } } while (0)
        PEER_LOAD(Ub, 0, 0);
        for (int b = 0; b < 128 / NPK; b += 2) {
            PEER_LOAD(Ub, 1, (b + 1) * NPK);
            PEER_DOT(0, (b * NPK) & 15);
            if (b + 2 < 128 / NPK) PEER_LOAD(Ub, 0, (b + 2) * NPK);
            PEER_DOT(1, ((b + 1) * NPK) & 15);
            if ((((b + 2) * NPK) & 15) == 0) {
                WAVE_LDS_SYNC();
                float sum = 0.f;
#pragma unroll
                for (int i = 0; i < 4; ++i) { const f32x4 r = *(const LAS f32x4*)(scr + (lane >> 2) * 68 + (lane & 3) * 16 + 4 * i); sum += (r[0] + r[1]) + (r[2] + r[3]); }
                sum += __shfl_xor(sum, 1); sum += __shfl_xor(sum, 2);
                const int k0 = (b + 2) * NPK - 16;
                const int k = k0 + (lane >> 2);
                const float gate = __shfl((k0 < 64) ? gA : gB, k & 63);
                if ((lane & 3) == 0) cfl[k] = gate * gelu_t(sum);
                WAVE_LDS_SYNC();
            }
        }
        f32x2 acc[16];
#pragma unroll
        for (int i = 0; i < 16; ++i) acc[i] = (f32x2){0.f, 0.f};
#define PEER_AXPY(st, base) do { _Pragma("unroll") for (int e_ = 0; e_ < NPK; ++e_) { const float c_ = cfl[(base) + e_] * bf2f(bsc[st][e_]); const f32x2 c2_ = {c_, c_}; \
            _Pragma("unroll") for (int d_ = 0; d_ < 4; ++d_) { const unsigned w_ = buf[st][e_][d_]; \
                acc[d_ * 4 + 0] = pkfma(c2_, __builtin_amdgcn_cvt_scalef32_pk_f32_fp4(w_, 1.0f, 0), acc[d_ * 4 + 0]); acc[d_ * 4 + 1] = pkfma(c2_, __builtin_amdgcn_cvt_scalef32_pk_f32_fp4(w_, 1.0f, 1), acc[d_ * 4 + 1]); \
                acc[d_ * 4 + 2] = pkfma(c2_, __builtin_amdgcn_cvt_scalef32_pk_f32_fp4(w_, 1.0f, 2), acc[d_ * 4 + 2]); acc[d_ * 4 + 3] = pkfma(c2_, __builtin_amdgcn_cvt_scalef32_pk_f32_fp4(w_, 1.0f, 3), acc[d_ * 4 + 3]); } } } while (0)
        PEER_LOAD(Vb, 0, 0);
        for (int b = 0; b < 128 / NPK; b += 2) {
            PEER_LOAD(Vb, 1, (b + 1) * NPK);
            PEER_AXPY(0, b * NPK);
            if (b + 2 < 128 / NPK) PEER_LOAD(Vb, 0, (b + 2) * NPK);
            PEER_AXPY(1, (b + 1) * NPK);
        }
        float ss = 0.f;
#pragma unroll
        for (int q = 0; q < 8; ++q) {
            const f32x4 x0 = *(const f32x4*)(xrow + q * 4);
            acc[2 * q] += (f32x2){x0[0], x0[1]}; acc[2 * q + 1] += (f32x2){x0[2], x0[3]};
            const f32x2 a = acc[2 * q], b = acc[2 * q + 1];
            ss += (a[0] * a[0] + a[1] * a[1]) + (b[0] * b[0] + b[1] * b[1]);
        }
        const float rstd = rsqrtf(wave_sum(ss) * (1.f / 2048.f) + EPS);
#pragma unroll
        for (int q = 0; q < 8; ++q) {
            const f32x4 g0 = *(const f32x4*)(p.final_g + lane * 32 + q * 4);
            const f32x2 a = acc[2 * q], b = acc[2 * q + 1];
            const f32x4 o0 = {a[0] * rstd * g0[0], a[1] * rstd * g0[1], b[0] * rstd * g0[2], b[1] * rstd * g0[3]};
            *(f32x4*)(xrow + q * 4) = o0;
        }
        WAVE_LDS_SYNC();
    }
}

#ifndef PROBE_DUP
#define PROBE_DUP 0
#endif
#define REP(bit) for (int rep_ = 0; rep_ < (((PROBE_DUP) >> (bit)) & 1) + 1; ++rep_)
#define PH1() { pg8::Gemm g{(const bf16_t*)(p.ws + WS_XN), (const bf16_t*)(p.ws + WS_WINT), T_TOK, NPROJ, DM}; pg8::StaticOrder S; S.init(T_TOK, NPROJ, G, bx); Epi1 E{(bf16_t*)(p.ws + WS_P), (float*)(p.ws + WS_PSSV)}; pg8::gemm_phase<Epi1, pg8::StaticOrder, true, true>(lds, g, S, E); grid.sync(); }
#define PH3() { pg8::Gemm g{(const bf16_t*)(p.ws + WS_XN), (const bf16_t*)(p.ws + WS_WOUTT), T_TOK, DM, DM}; pg8::StaticOrder S; S.init(T_TOK, DM, G, bx); Epi2 E{p.x, p.out, (bf16_t*)(p.ws + WS_X1G), p.norm2_g, (float*)(p.ws + WS_PSS2)}; pg8::gemm_phase<Epi2, pg8::StaticOrder, true, true>(lds, g, S, E); grid.sync(); }
#define PH4() { pg8::Gemm g{(const bf16_t*)(p.ws + WS_X1G), (const bf16_t*)(p.ws + WS_WQT), T_TOK, 1024, DM}; pg8::StaticOrder S; S.init(T_TOK, 1024, G, bx); Epi3 E{(bf16_t*)(p.ws + WS_Q), (const float*)(p.ws + WS_PSS2)}; pg8::gemm_phase<Epi3, pg8::StaticOrder, true, true>(lds, g, S, E); grid.sync(); }
__global__ void __launch_bounds__(NTHREADS, 2) hymba_fwd(Params p) {
    extern __shared__ __attribute__((aligned(16))) unsigned char smem[];
    LAS unsigned char* lds = (LAS unsigned char*)smem;
    cg::grid_group grid = cg::this_grid();
    const int G = gridDim.x, bx = blockIdx.x;
    REP(0) { phase0(p, lds); grid.sync(); }
    PH1()
#if (PROBE_DUP >> 1) & 1
    PH1()
#endif
    REP(2) {
        for (int si = bx; si < 256; si += G) {
            const int b = si >> 6, c = si & 63;
            gmlp_bc(p, lds, b, c);
            for (int h = 0; h < 4; ++h) mlstm_local(p, lds, b, c, h);
        }
        grid.sync();
    }
    REP(3) { phase_scan(p); grid.sync(); }
    REP(4) { for (int it = bx; it < 1024; it += G) mlstm_out(p, lds, it >> 8, (it >> 2) & 63, it & 3); grid.sync(); }
    PH3()
#if (PROBE_DUP >> 5) & 1
    PH3()
#endif
    PH4()
#if (PROBE_DUP >> 6) & 1
    PH4()
#endif
    REP(7) { peer_select(p); grid.sync(); }
    peer_gather(p, lds);
}

extern "C" void kernel_launch(void* const* d_in, const int* in_sizes, int n_in, void* d_out, int out_size, void* d_ws, size_t ws_size, hipStream_t stream) {
    static int grid_blocks = 0;
    if (grid_blocks == 0) {
        if (n_in != 20 || ws_size < WS_END) { fprintf(stderr, "kernel_launch: unexpected n_in %d or ws_size %zu (need %zu)\n", n_in, ws_size, (size_t)WS_END); grid_blocks = -1; return; }
        int dev = 0, cus = 0, per_cu = 0;
        hipGetDevice(&dev);
        hipDeviceGetAttribute(&cus, hipDeviceAttributeMultiprocessorCount, dev);
        hipFuncSetAttribute((const void*)hymba_fwd, hipFuncAttributeMaxDynamicSharedMemorySize, LDS_BYTES);
        hipOccupancyMaxActiveBlocksPerMultiprocessor(&per_cu, (const void*)hymba_fwd, NTHREADS, LDS_BYTES);
        if (per_cu < 1) { fprintf(stderr, "kernel_launch: occupancy query says %d blocks per CU\n", per_cu); per_cu = 1; }
        if (per_cu > 1) per_cu = 1;
        grid_blocks = cus * per_cu;
        (void)hipGetLastError();
    }
    if (grid_blocks < 0) return;
    Params p{};
    p.x = (const float*)d_in[0]; p.norm1_g = (const float*)d_in[1]; p.w_in = (const float*)d_in[2]; p.gm_vnorm_g = (const float*)d_in[3];
    p.w_spatial = (const float*)d_in[4]; p.b_spatial = (const float*)d_in[5]; p.ml_conv_w = (const float*)d_in[6]; p.ml_conv_b = (const float*)d_in[7];
    p.ml_b_i = (const float*)d_in[8]; p.ml_b_f = (const float*)d_in[9]; p.gm_out_g = (const float*)d_in[10]; p.ml_out_g = (const float*)d_in[11];
    p.w_out = (const float*)d_in[12]; p.norm2_g = (const float*)d_in[13]; p.peer_wq = (const float*)d_in[14]; p.peer_k1 = (const float*)d_in[15];
    p.peer_k2 = (const float*)d_in[16]; p.peer_u = (const float*)d_in[17]; p.peer_v = (const float*)d_in[18]; p.final_g = (const float*)d_in[19];
    p.out = (float*)d_out; p.ws = (unsigned char*)d_ws;
    void* args[] = {&p};
    hipError_t e = hipLaunchCooperativeKernel((const void*)hymba_fwd, dim3(grid_blocks), dim3(NTHREADS), args, LDS_BYTES, stream);
    if (e != hipSuccess) fprintf(stderr, "cooperative launch failed: %s (grid %d)\n", hipGetErrorString(e), grid_blocks);
}
```

```cpp
#include <hip/hip_runtime.h>
#include <hip/hip_cooperative_groups.h>
#include <cstdio>
#include <cstdint>
namespace cg = cooperative_groups;
namespace pg8 {
#define PG8_LAS __attribute__((address_space(3)))
typedef unsigned short bf16_t;
typedef short bf16x8 __attribute__((ext_vector_type(8)));
typedef float f32x4 __attribute__((ext_vector_type(4)));
typedef unsigned u32x4 __attribute__((ext_vector_type(4)));
constexpr int BM = 256, BK = 64, HALF = 128, HTB = HALF * BK * 2  , STAGE_BYTES = 8 * HTB, NXCD = 8, WGM = 8;

__host__ __device__ __forceinline__ int lds_byte(int r, int c) { const int st = (r >> 4) * 2 + (c >> 5), rr = r & 15, cc = c & 31, ob = rr * 64 + cc * 2; return st * 1024 + (ob ^ (((ob >> 9) & 1) << 5)); }
__host__ __device__ __forceinline__ void stage_rc(int b, int& R, int& C) { const int st = b / 1024, sb = b % 1024, swz = sb ^ (((sb >> 9) & 1) << 5); R = (st >> 1) * 16 + swz / 64; C = (st & 1) * 32 + (swz % 64) / 2; }
__host__ __device__ __forceinline__ int perm32(int rho) { const int n = rho >> 4, i = rho & 15; return 8 * (i >> 2) + 4 * n + (i & 3); }

struct Unit { int pm, pn; };
struct Gemm { const bf16_t* A; const bf16_t* Bt; int M, N, K; };

struct StaticOrder {
    int nM, nN, nwg, G, c;
    __host__ __device__ void init(int M, int N, int G_, int c_) { nM = M / BM; nN = N / BM; nwg = nM * nN; G = G_; c = c_; }
    __host__ __device__ bool next(int i, Unit& u) const {
        const long L = (long)i * G + c; if (L >= nwg) return false;
        int wgid = (int)L; { const int q = nwg / NXCD, r = nwg % NXCD, xcd = wgid % NXCD, off = wgid / NXCD; wgid = (xcd < r ? xcd * (q + 1) : r * (q + 1) + (xcd - r) * q) + off; }
        const int nig = WGM * nN, gid = wgid / nig, fm = gid * WGM, gsz = (nM - fm) < WGM ? (nM - fm) : WGM;
        u.pm = fm + ((wgid % nig) % gsz); u.pn = (wgid % nig) / gsz; return true;
    }
    __device__ __forceinline__ void a_ready(const Unit&) const {}
    __device__ __forceinline__ void done(const Unit&) const {}
};
__device__ __forceinline__ unsigned cvt_pk_bf16(float lo, float hi) { unsigned r; asm volatile("v_cvt_pk_bf16_f32 %0, %1, %2" : "=v"(r) : "v"(lo), "v"(hi)); return r; }
template <class Epi, class Sched, bool ALIGN_EPI = false, bool SP2 = false>
__device__ __forceinline__ void gemm_phase(PG8_LAS unsigned char* lds, const Gemm g, const Sched& S, const Epi& E) {
    const int tid = threadIdx.x, wid = __builtin_amdgcn_readfirstlane(tid >> 6), lane = tid & 63, wr = wid >> 2, wc = wid & 3, fr = lane & 15, fq = lane >> 4;
    const int K = g.K, nt = K / BK;
    unsigned voffA[2], voffB[2];
#pragma unroll
    for (int i = 0; i < 2; ++i) { int R, C; stage_rc(tid * 16 + i * 8192, R, C); const int Rb = Epi::PERM ? ((R & ~31) + perm32(R & 31)) : R;
        voffA[i] = (unsigned)(R * K + C) * 2u; voffB[i] = (unsigned)(Rb * K + C) * 2u; }
    const size_t kstep = (size_t)(BK * 2);
    const size_t hstep = (size_t)HALF * K * 2;
    const size_t tstep = 2 * hstep;
    const unsigned ldsw = (unsigned)wid * 1024u;
    const int aoff = lds_byte(wr * 64 + fr, fq * 8), boff = lds_byte(wc * 32 + fr, fq * 8);
#define PG8_SA(b, h) (((b) * 2 + (h)) * HTB)
#define PG8_SB(b, h) ((4 + (b) * 2 + (h)) * HTB)
#define PG8_STAGE(bufoff, gbase, voff) do { _Pragma("unroll") for (int _i = 0; _i < 2; ++_i) \
        __builtin_amdgcn_global_load_lds((const unsigned*)((const char*)(gbase) + (voff)[_i]), (PG8_LAS unsigned*)(lds + (bufoff) + ldsw + _i * 8192), 16, 0, 0); } while (0)
#define PG8_LDA(dst, b, h) do { _Pragma("unroll") for (int m = 0; m < 4; ++m) _Pragma("unroll") for (int k = 0; k < 2; ++k) dst[m][k] = *(const PG8_LAS bf16x8*)(lds + PG8_SA(b, h) + aoff + m * 2048 + k * 1024); } while (0)
#define PG8_LDB(dst, b, h) do { _Pragma("unroll") for (int n = 0; n < 2; ++n) _Pragma("unroll") for (int k = 0; k < 2; ++k) dst[n][k] = *(const PG8_LAS bf16x8*)(lds + PG8_SB(b, h) + boff + n * 2048 + k * 1024); } while (0)
#define PG8_MMA(ai, bj, At, Bt) do { __builtin_amdgcn_s_setprio(1); _Pragma("unroll") for (int m = 0; m < 4; ++m) _Pragma("unroll") for (int n = 0; n < 2; ++n) _Pragma("unroll") for (int k = 0; k < 2; ++k) \
        acc[ai][bj][m][n] = __builtin_amdgcn_mfma_f32_16x16x32_bf16(Bt[n][k], At[m][k], acc[ai][bj][m][n], 0, 0, 0); __builtin_amdgcn_s_setprio(0); } while (0)
#define PG8_WAIT_V(n) asm volatile("s_waitcnt vmcnt(" #n ")" ::: "memory")
#define PG8_WAIT_L(n) asm volatile("s_waitcnt lgkmcnt(" #n ")" ::: "memory")
#define PG8_BAR __builtin_amdgcn_s_barrier()
#define PG8_SCHED __builtin_amdgcn_sched_barrier(0)
    Unit cur, nxt; int ui = 0;
    if (!S.next(0, cur)) return;
    f32x4 acc[2][2][4][2];
#pragma unroll
    for (int a = 0; a < 2; ++a)
#pragma unroll
        for (int b = 0; b < 2; ++b)
#pragma unroll
            for (int m = 0; m < 4; ++m)
#pragma unroll
                for (int n = 0; n < 2; ++n) acc[a][b][m][n] = (f32x4){0.f, 0.f, 0.f, 0.f};
    bf16x8 At[4][2], B0[2][2], B1[2][2];
    const char* cA = (const char*)g.A + (size_t)cur.pm * tstep; const char* cB = (const char*)g.Bt + (size_t)cur.pn * tstep;
    S.a_ready(cur);
    if constexpr (SP2) {
        PG8_STAGE(PG8_SB(0, 0), cB, voffB); PG8_STAGE(PG8_SB(0, 1), cB + hstep, voffB); PG8_STAGE(PG8_SA(0, 0), cA, voffA); PG8_STAGE(PG8_SA(0, 1), cA + hstep, voffA);
        if (wr == 1) PG8_BAR;
        PG8_WAIT_V(2); PG8_BAR;
        PG8_STAGE(PG8_SB(1, 0), cB + kstep, voffB); PG8_STAGE(PG8_SA(1, 0), cA + kstep, voffA); PG8_STAGE(PG8_SB(1, 1), cB + hstep + kstep, voffB);
        PG8_WAIT_V(6); PG8_BAR;
    } else {
        PG8_STAGE(PG8_SB(0, 0), cB, voffB); PG8_STAGE(PG8_SA(0, 0), cA, voffA); PG8_STAGE(PG8_SB(0, 1), cB + hstep, voffB); PG8_STAGE(PG8_SA(0, 1), cA + hstep, voffA);
        if (wr == 1) PG8_BAR;
        PG8_WAIT_V(4); PG8_BAR;
        PG8_STAGE(PG8_SB(1, 0), cB + kstep, voffB); PG8_STAGE(PG8_SA(1, 0), cA + kstep, voffA); PG8_STAGE(PG8_SB(1, 1), cB + hstep + kstep, voffB);
        PG8_WAIT_V(6); PG8_BAR;
    }
    for (;;) {
        const bool has_next = S.next(ui + 1, nxt);
        const char* nA = has_next ? (const char*)g.A + (size_t)nxt.pm * tstep : cA; const char* nB = has_next ? (const char*)g.Bt + (size_t)nxt.pn * tstep : cB;
        for (int t = 0; t < nt; t += 2) {
            const bool last = (t == nt - 2);
            const char* a1 = cA + (size_t)(t + 1) * kstep;
            const char* a2 = last ? nA : cA + (size_t)(t + 2) * kstep; const char* b2 = last ? nB : cB + (size_t)(t + 2) * kstep;
            const char* a3 = a2 + kstep; const char* b3 = b2 + kstep;
            if (last && has_next) S.a_ready(nxt);
            if constexpr (SP2) {
            PG8_LDB(B0, 0, 0); PG8_LDB(B1, 0, 1); PG8_SCHED; PG8_LDA(At, 0, 0); PG8_STAGE(PG8_SA(1, 1), a1 + hstep, voffA);
            PG8_WAIT_V(8); PG8_WAIT_L(0); PG8_BAR; PG8_MMA(0, 0, At, B0); PG8_MMA(0, 1, At, B1); PG8_BAR; PG8_SCHED;
            PG8_LDA(At, 0, 1); PG8_STAGE(PG8_SB(0, 0), b2, voffB); PG8_STAGE(PG8_SB(0, 1), b2 + hstep, voffB); PG8_STAGE(PG8_SA(0, 0), a2, voffA);
            PG8_WAIT_V(8); PG8_WAIT_L(0); PG8_BAR; PG8_MMA(1, 0, At, B0); PG8_MMA(1, 1, At, B1); PG8_BAR; PG8_SCHED;
            PG8_LDB(B0, 1, 0); PG8_LDB(B1, 1, 1); PG8_SCHED; PG8_LDA(At, 1, 0); PG8_STAGE(PG8_SA(0, 1), a2 + hstep, voffA);
            PG8_WAIT_V(8); PG8_WAIT_L(0); PG8_BAR; PG8_MMA(0, 0, At, B0); PG8_MMA(0, 1, At, B1); PG8_BAR; PG8_SCHED;
            PG8_LDA(At, 1, 1); PG8_STAGE(PG8_SB(1, 0), b3, voffB); PG8_STAGE(PG8_SB(1, 1), b3 + hstep, voffB); PG8_STAGE(PG8_SA(1, 0), a3, voffA);
            PG8_WAIT_V(8); PG8_WAIT_L(0); PG8_BAR; PG8_MMA(1, 0, At, B0); PG8_MMA(1, 1, At, B1); PG8_BAR; PG8_SCHED;
            } else {
            PG8_LDB(B0, 0, 0); PG8_SCHED; PG8_LDA(At, 0, 0); PG8_STAGE(PG8_SA(1, 1), a1 + hstep, voffA);
            PG8_WAIT_L(8); PG8_BAR; PG8_WAIT_L(0); PG8_MMA(0, 0, At, B0); PG8_BAR; PG8_SCHED;
            PG8_LDB(B1, 0, 1); PG8_STAGE(PG8_SB(0, 0), b2, voffB);
            PG8_BAR; PG8_WAIT_L(0); PG8_MMA(0, 1, At, B1); PG8_BAR;
            PG8_LDA(At, 0, 1); PG8_STAGE(PG8_SA(0, 0), a2, voffA);
            PG8_BAR; PG8_WAIT_L(0); PG8_MMA(1, 0, At, B0); PG8_BAR; PG8_SCHED;
            PG8_STAGE(PG8_SB(0, 1), b2 + hstep, voffB);
            PG8_WAIT_V(6); PG8_BAR; PG8_MMA(1, 1, At, B1); PG8_BAR;
            PG8_LDB(B0, 1, 0); PG8_SCHED; PG8_LDA(At, 1, 0); PG8_STAGE(PG8_SA(0, 1), a2 + hstep, voffA);
            PG8_WAIT_L(8); PG8_BAR; PG8_WAIT_L(0); PG8_MMA(0, 0, At, B0); PG8_BAR; PG8_SCHED;
            PG8_LDB(B1, 1, 1); PG8_STAGE(PG8_SB(1, 0), b3, voffB);
            PG8_BAR; PG8_WAIT_L(0); PG8_MMA(0, 1, At, B1); PG8_BAR;
            PG8_LDA(At, 1, 1); PG8_STAGE(PG8_SA(1, 0), a3, voffA);
            PG8_BAR; PG8_WAIT_L(0); PG8_MMA(1, 0, At, B0); PG8_BAR; PG8_SCHED;
            PG8_STAGE(PG8_SB(1, 1), b3 + hstep, voffB);
            PG8_WAIT_V(6); PG8_BAR; PG8_MMA(1, 1, At, B1); PG8_BAR;
            }
        }
        if constexpr (ALIGN_EPI) { if (wr == 0) PG8_BAR; }
        if constexpr (!Epi::AFTER_DRAIN) { E(acc, cur, wr, wc, fr, fq); S.done(cur); }
        if (!has_next) break;
#pragma unroll
        for (int a = 0; a < 2; ++a)
#pragma unroll
            for (int b = 0; b < 2; ++b)
#pragma unroll
                for (int m = 0; m < 4; ++m)
#pragma unroll
                    for (int n = 0; n < 2; ++n) acc[a][b][m][n] = (f32x4){0.f, 0.f, 0.f, 0.f};
        cur = nxt; cA = nA; cB = nB; ++ui;
        if constexpr (ALIGN_EPI) { if (wr == 1) PG8_BAR; }
    }
    PG8_WAIT_V(0);
    if constexpr (!ALIGN_EPI) { if (wr == 0) PG8_BAR; }
    PG8_BAR;
    if constexpr (Epi::AFTER_DRAIN) { E.fused(acc, cur, wr, wc, fr, fq, lds, wid, lane); S.done(cur); }
#undef PG8_SA
#undef PG8_SB
#undef PG8_STAGE
#undef PG8_LDA
#undef PG8_LDB
#undef PG8_MMA
#undef PG8_WAIT_V
#undef PG8_WAIT_L
#undef PG8_BAR
#undef PG8_SCHED
}
}

#define LAS __attribute__((address_space(3)))
#define DI __device__ __forceinline__
using pg8::bf16_t; using pg8::bf16x8; using pg8::f32x4; using pg8::u32x4; using pg8::cvt_pk_bf16;
typedef unsigned u32x2 __attribute__((ext_vector_type(2)));
typedef float f32x2 __attribute__((ext_vector_type(2)));

constexpr int T_TOK = 32768, DM = 2048, NPROJ = 5120, PROJW = 5128;
constexpr int NTHREADS = 512;
constexpr int LDS_BYTES = 147456;
constexpr float EPS = 1e-6f;

constexpr size_t WS_XN = 0;
constexpr size_t WS_P = 134217728;
constexpr size_t WS_X1G = WS_P;
constexpr size_t WS_Q = WS_P + 134217728;
constexpr size_t WS_WINT = WS_P + 335544320;
constexpr size_t WS_WOUTT = WS_WINT + 20971520;
constexpr size_t WS_WQT = WS_WOUTT + 8388608;
constexpr size_t WS_UB = WS_WQT + 4194304;
constexpr size_t WS_VB = WS_UB + 67108864;
constexpr size_t WS_ST = WS_VB + 67108864;
constexpr size_t WS_CPT = WS_ST + 142606336;
constexpr size_t WS_QC = WS_CPT + 71303168;
constexpr size_t WS_KC = WS_QC + 33554432;
constexpr size_t WS_IG = WS_KC + 33554432;
constexpr size_t WS_LF = WS_IG + 524288;
constexpr size_t WS_PSSV = WS_LF + 524288;
constexpr size_t WS_PSS2 = WS_PSSV + 2097152;
constexpr size_t WS_BEND = WS_PSS2 + 4194304;
constexpr size_t WS_GMAX = WS_BEND + 4096;
constexpr size_t WS_MPREV = WS_GMAX + 4096;
constexpr size_t WS_SELID = WS_MPREV + 4096;
constexpr size_t WS_SELG = WS_SELID + 16777216;
constexpr size_t WS_KB1 = WS_SELG + 16777216;
constexpr size_t WS_KB2 = WS_KB1 + 131072;
constexpr size_t WS_END = WS_KB2 + 131072;

struct Params {
    const float *x, *norm1_g, *w_in, *gm_vnorm_g, *w_spatial, *b_spatial, *ml_conv_w, *ml_conv_b, *ml_b_i, *ml_b_f, *gm_out_g, *ml_out_g, *w_out, *norm2_g,
        *peer_wq, *peer_k1, *peer_k2, *peer_u, *peer_v, *final_g;
    float* out;
    unsigned char* ws;
};

DI float bf2f(unsigned short h) { return __uint_as_float(((unsigned)h) << 16); }
DI float bflo(unsigned w) { return __uint_as_float(w << 16); }
DI float bfhi(unsigned w) { return __uint_as_float(w & 0xffff0000u); }
DI float rcpf_(float x) { return __builtin_amdgcn_rcpf(x); }
DI float sigmoid_(float x) { return rcpf_(1.f + __expf(-x)); }
DI float gelu_t(float x) { const float z = 1.5957691216057308f * (x + 0.044715f * x * x * x); return x * rcpf_(1.f + __expf(-z)); }
DI float wave_sum(float v) {
#pragma unroll
    for (int o = 32; o; o >>= 1) v += __shfl_xor(v, o);
    return v;
}
DI float wave_max(float v) {
#pragma unroll
    for (int o = 32; o; o >>= 1) v = fmaxf(v, __shfl_xor(v, o));
    return v;
}
DI bf16x8 ld_frag_lds(const LAS unsigned char* p) { return *(const LAS bf16x8*)p; }
#define MFMA16(a, b, c) __builtin_amdgcn_mfma_f32_16x16x32_bf16((a), (b), (c), 0, 0, 0)

struct Epi1 {
    static constexpr bool PERM = true, AFTER_DRAIN = false;
    bf16_t* P; float* pssv;
    DI void operator()(const f32x4 (&acc)[2][2][4][2], const pg8::Unit& u, int wr, int wc, int fr, int fq) const {
        const int row0 = u.pm * 256 + wr * 64 + fr, col0 = u.pn * 256 + wc * 32 + 8 * fq;
        const int mode = u.pn < 8 ? 1 : (u.pn >= 16 ? 2 : 0);
        const bool want_ss = (u.pn >= 4 && u.pn < 8);
#pragma unroll
        for (int ai = 0; ai < 2; ++ai)
#pragma unroll
            for (int m = 0; m < 4; ++m) {
                const int row = row0 + ai * 128 + m * 16;
                bf16_t* rowp = P + (size_t)row * NPROJ + col0;
                float ss = 0.f;
#pragma unroll
                for (int bj = 0; bj < 2; ++bj) {
                    f32x4 v0 = acc[ai][bj][m][0], v1 = acc[ai][bj][m][1];
                    if (mode == 1) {
#pragma unroll
                        for (int j = 0; j < 4; ++j) { v0[j] = gelu_t(v0[j]); v1[j] = gelu_t(v1[j]); ss += v0[j] * v0[j] + v1[j] * v1[j]; }
                    } else if (mode == 2) {
#pragma unroll
                        for (int j = 0; j < 4; ++j) { v0[j] = sigmoid_(v0[j]); v1[j] = sigmoid_(v1[j]); }
                    }
                    u32x4 w; w.x = cvt_pk_bf16(v0[0], v0[1]); w.y = cvt_pk_bf16(v0[2], v0[3]); w.z = cvt_pk_bf16(v1[0], v1[1]); w.w = cvt_pk_bf16(v1[2], v1[3]);
                    *(u32x4*)(rowp + bj * 128) = w;
                }
                if (want_ss) {
                    ss += __shfl_xor(ss, 16); ss += __shfl_xor(ss, 32);
                    if (fq == 0) pssv[(size_t)row * 16 + (u.pn - 4) * 4 + wc] = ss;
                }
            }
    }
};

struct Epi2 {
    static constexpr bool PERM = true, AFTER_DRAIN = false;
    const float* x; bf16_t* x1b; float* pss2;
    DI void operator()(const f32x4 (&acc)[2][2][4][2], const pg8::Unit& u, int wr, int wc, int fr, int fq) const {
        const int row0 = u.pm * 256 + wr * 64 + fr, col0 = u.pn * 256 + wc * 32 + 8 * fq;
#pragma unroll
        for (int ai = 0; ai < 2; ++ai)
#pragma unroll
            for (int m = 0; m < 4; ++m) {
                const int row = row0 + ai * 128 + m * 16;
                float ss = 0.f;
#pragma unroll
                for (int bj = 0; bj < 2; ++bj) {
                    const size_t o = (size_t)row * DM + col0 + bj * 128;
                    const f32x4 v0 = acc[ai][bj][m][0] + *(const f32x4*)(x + o), v1 = acc[ai][bj][m][1] + *(const f32x4*)(x + o + 4);
#pragma unroll
                    for (int j = 0; j < 4; ++j) ss += v0[j] * v0[j] + v1[j] * v1[j];
                    u32x4 w; w.x = cvt_pk_bf16(v0[0], v0[1]); w.y = cvt_pk_bf16(v0[2], v0[3]); w.z = cvt_pk_bf16(v1[0], v1[1]); w.w = cvt_pk_bf16(v1[2], v1[3]);
                    *(u32x4*)(x1b + o) = w;
                }
                ss += __shfl_xor(ss, 16); ss += __shfl_xor(ss, 32);
                if (fq == 0) pss2[(size_t)row * 32 + u.pn * 4 + wc] = ss;
            }
    }
};

struct Epi3 {
    static constexpr bool PERM = true, AFTER_DRAIN = false;
    bf16_t* Q; const float* pss2;
    DI void operator()(const f32x4 (&acc)[2][2][4][2], const pg8::Unit& u, int wr, int wc, int fr, int fq) const {
        const int row0 = u.pm * 256 + wr * 64 + fr, col0 = u.pn * 256 + wc * 32 + 8 * fq;
#pragma unroll
        for (int ai = 0; ai < 2; ++ai)
#pragma unroll
            for (int m = 0; m < 4; ++m) {
                const int row = row0 + ai * 128 + m * 16;
                float ss = 0.f;
#pragma unroll
                for (int i = 0; i < 8; ++i) { const f32x4 t = *(const f32x4*)(pss2 + (size_t)row * 32 + i * 4); ss += (t[0] + t[1]) + (t[2] + t[3]); }
                const float rstd = rsqrtf(ss * (1.f / 2048.f) + EPS);
#pragma unroll
                for (int bj = 0; bj < 2; ++bj) {
                    const f32x4 v0 = acc[ai][bj][m][0] * rstd, v1 = acc[ai][bj][m][1] * rstd;
                    u32x4 w; w.x = cvt_pk_bf16(v0[0], v0[1]); w.y = cvt_pk_bf16(v0[2], v0[3]); w.z = cvt_pk_bf16(v1[0], v1[1]); w.w = cvt_pk_bf16(v1[2], v1[3]);
                    *(u32x4*)(Q + (size_t)row * 1024 + col0 + bj * 128) = w;
                }
            }
    }
};

DI void phase0(const Params& p, LAS unsigned char* lds) {
    const int tid = threadIdx.x, lane = tid & 63, wave = tid >> 6;
    bf16_t* XN = (bf16_t*)(p.ws + WS_XN);
    {
        LAS float* scr = (LAS float*)lds + wave * (64 * 65);
        const int gw = blockIdx.x * 8 + wave, nw = gridDim.x * 8;
        for (int it = gw; it < 4096; it += nw) {
            const float* W; bf16_t* WT; int ldw, kt, nt;
            if (it < 2560) { W = p.w_in; WT = (bf16_t*)(p.ws + WS_WINT); ldw = PROJW; kt = it / 80; nt = it % 80; }
            else if (it < 3584) { const int j = it - 2560; W = p.w_out; WT = (bf16_t*)(p.ws + WS_WOUTT); ldw = 2048; kt = j >> 5; nt = j & 31; }
            else { const int j = it - 3584; W = p.peer_wq; WT = (bf16_t*)(p.ws + WS_WQT); ldw = 1024; kt = j >> 4; nt = j & 15; }
            const int k0 = kt * 64, n0 = nt * 64;
#pragma unroll 8
            for (int r = 0; r < 64; ++r) scr[r * 65 + lane] = W[(size_t)(k0 + r) * ldw + n0 + lane] * (it >= 3584 ? p.norm2_g[k0 + r] : 1.f);
            __builtin_amdgcn_fence(__ATOMIC_RELEASE, "wavefront"); __builtin_amdgcn_wave_barrier(); __builtin_amdgcn_fence(__ATOMIC_ACQUIRE, "wavefront");
            const int half = lane >> 5, kk = (lane & 31) * 2;
#pragma unroll 8
            for (int nn = 0; nn < 32; ++nn) {
                const int n = 2 * nn + half; const float a = scr[kk * 65 + n], b = scr[(kk + 1) * 65 + n];
                *(unsigned*)(WT + (size_t)(n0 + n) * 2048 + k0 + kk) = cvt_pk_bf16(a, b);
            }
            __builtin_amdgcn_fence(__ATOMIC_RELEASE, "wavefront"); __builtin_amdgcn_wave_barrier(); __builtin_amdgcn_fence(__ATOMIC_ACQUIRE, "wavefront");
        }
    }
    __syncthreads();
    {
        LAS float* wg = (LAS float*)lds;
        for (int idx = tid; idx < 4096; idx += NTHREADS) {
            const int k = idx >> 1, hf = idx & 1;
            const f32x4 v = *(const f32x4*)(p.w_in + (size_t)k * PROJW + 5120 + hf * 4);
            *(LAS f32x4*)(wg + k * 8 + (k >> 3) * 4 + hf * 4) = v;
        }
        __syncthreads();
        float* IG = (float*)(p.ws + WS_IG); float* LF = (float*)(p.ws + WS_LF);
        for (int row = blockIdx.x * 8 + wave; row < T_TOK; row += gridDim.x * 8) {
            const float* xr = p.x + (size_t)row * DM;
            f32x4 xv[8]; float ss = 0.f;
#pragma unroll
            for (int i = 0; i < 4; ++i) { xv[2 * i] = *(const f32x4*)(xr + i * 512 + lane * 8); xv[2 * i + 1] = *(const f32x4*)(xr + i * 512 + lane * 8 + 4); }
#pragma unroll
            for (int i = 0; i < 8; ++i) ss += (xv[i][0] * xv[i][0] + xv[i][1] * xv[i][1]) + (xv[i][2] * xv[i][2] + xv[i][3] * xv[i][3]);
            ss = wave_sum(ss);
            const float rstd = rsqrtf(ss * (1.f / 2048.f) + EPS);
            f32x4 ga = {0.f, 0.f, 0.f, 0.f}, gb = {0.f, 0.f, 0.f, 0.f};
#pragma unroll
            for (int i = 0; i < 4; ++i) {
                const f32x4 g0 = *(const f32x4*)(p.norm1_g + i * 512 + lane * 8), g1 = *(const f32x4*)(p.norm1_g + i * 512 + lane * 8 + 4);
                const f32x4 h0 = xv[2 * i] * rstd * g0, h1 = xv[2 * i + 1] * rstd * g1;
                u32x4 w; w.x = cvt_pk_bf16(h0[0], h0[1]); w.y = cvt_pk_bf16(h0[2], h0[3]); w.z = cvt_pk_bf16(h1[0], h1[1]); w.w = cvt_pk_bf16(h1[2], h1[3]);
                *(u32x4*)(XN + (size_t)row * DM + i * 512 + lane * 8) = w;
                const LAS float* wb = wg + (i * 512 + lane * 8) * 8 + (i * 64 + lane) * 4;
#pragma unroll
                for (int e = 0; e < 8; ++e) {
                    const float hv = e < 4 ? h0[e & 3] : h1[e & 3];
                    const f32x4 w0 = *(const LAS f32x4*)(wb + e * 8), w1 = *(const LAS f32x4*)(wb + e * 8 + 4);
                    ga = ga + w0 * hv; gb = gb + w1 * hv;
                }
            }
            float zi = 0.f;
#pragma unroll
            for (int j = 0; j < 4; ++j) { const float a = wave_sum(ga[j]), b = wave_sum(gb[j]); zi = (lane == j) ? a : zi; zi = (lane == 4 + j) ? b : zi; }
            if (lane < 4) IG[(size_t)row * 4 + lane] = zi + p.ml_b_i[lane];
            else if (lane < 8) { const float z = zi + p.ml_b_f[lane - 4]; LF[(size_t)row * 4 + lane - 4] = fminf(z, 0.f) - log1pf(__expf(-fabsf(z))); }
        }
    }
    {
        const int nthr = gridDim.x * NTHREADS;
        for (int item = blockIdx.x * NTHREADS + tid; item < 2 * 16384 * 64; item += nthr) {
            const int which = item >> 20, rc = item & 1048575, row = rc >> 6, ch = rc & 63;
            const float* src = (which ? p.peer_v : p.peer_u) + (size_t)row * DM + ch * 32;
            unsigned char* dst = p.ws + (which ? WS_VB : WS_UB) + (size_t)row * 1152;
            f32x4 v[8]; float amax = 0.f;
#pragma unroll
            for (int q = 0; q < 8; ++q) { v[q] = *(const f32x4*)(src + q * 4); amax = fmaxf(amax, fmaxf(fmaxf(fabsf(v[q][0]), fabsf(v[q][1])), fmaxf(fabsf(v[q][2]), fabsf(v[q][3])))); }
            const unsigned sb = cvt_pk_bf16(amax * (1.f / 6.f), 0.f) & 0xffffu;
            float sc = bflo(sb); if (sc == 0.f) sc = 1.f;
            const float inv = 1.f / sc;
            u32x4 w;
#pragma unroll
            for (int d = 0; d < 4; ++d) {
                unsigned r = 0u;
                r = __builtin_amdgcn_cvt_scalef32_pk_fp4_f32(r, v[2 * d][0] * inv, v[2 * d][1] * inv, 1.0f, 0);
                r = __builtin_amdgcn_cvt_scalef32_pk_fp4_f32(r, v[2 * d][2] * inv, v[2 * d][3] * inv, 1.0f, 1);
                r = __builtin_amdgcn_cvt_scalef32_pk_fp4_f32(r, v[2 * d + 1][0] * inv, v[2 * d + 1][1] * inv, 1.0f, 2);
                r = __builtin_amdgcn_cvt_scalef32_pk_fp4_f32(r, v[2 * d + 1][2] * inv, v[2 * d + 1][3] * inv, 1.0f, 3);
                w[d] = r;
            }
            *(u32x4*)(dst + ch * 16) = w;
            *(unsigned short*)(dst + 1024 + ch * 2) = (unsigned short)(sc == 1.f && sb == 0u ? 0x3F80u : sb);
        }
    }
    {
        bf16_t* KB1 = (bf16_t*)(p.ws + WS_KB1); bf16_t* KB2 = (bf16_t*)(p.ws + WS_KB2);
        for (int i = blockIdx.x * NTHREADS + tid; i < 65536 / 4; i += gridDim.x * NTHREADS) {
            const f32x4 a = *(const f32x4*)(p.peer_k1 + i * 4), b = *(const f32x4*)(p.peer_k2 + i * 4);
            u32x2 w; w.x = cvt_pk_bf16(a[0], a[1]); w.y = cvt_pk_bf16(a[2], a[3]); *(u32x2*)(KB1 + i * 4) = w;
            w.x = cvt_pk_bf16(b[0], b[1]); w.y = cvt_pk_bf16(b[2], b[3]); *(u32x2*)(KB2 + i * 4) = w;
        }
    }
}

#define WAVE_LDS_SYNC() do { __builtin_amdgcn_fence(__ATOMIC_RELEASE, "wavefront"); __builtin_amdgcn_wave_barrier(); __builtin_amdgcn_fence(__ATOMIC_ACQUIRE, "wavefront"); } while (0)

DI void stage_T(const bf16_t* src, int ld, int ngroups, LAS unsigned char* dst, int wave, int lane) {
    for (int g = wave; g < ngroups; g += 8) {
        const u32x4 r0 = *(const u32x4*)(src + (size_t)(2 * lane) * ld + g * 8);
        const u32x4 r1 = *(const u32x4*)(src + (size_t)(2 * lane + 1) * ld + g * 8);
#pragma unroll
        for (int w = 0; w < 4; ++w) {
            const unsigned a = r0[w], b = r1[w];
            *(LAS unsigned*)(dst + (g * 8 + 2 * w) * 272 + lane * 4) = (a & 0xffffu) | (b << 16);
            *(LAS unsigned*)(dst + (g * 8 + 2 * w + 1) * 272 + lane * 4) = (a >> 16) | (b & 0xffff0000u);
        }
    }
}

DI void gmlp_bc(const Params& p, LAS unsigned char* lds, int b, int c) {
    const int tid = threadIdx.x, lane = tid & 63, wave = __builtin_amdgcn_readfirstlane(tid >> 6), fr = lane & 15, fq = lane >> 4;
    const int t0 = b * 8192 + c * 128;
    LAS unsigned char* Wl = lds; LAS unsigned char* GvT = lds + 34816; LAS float* rstdv = (LAS float*)(lds + 69632);
    const bf16_t* P = (const bf16_t*)(p.ws + WS_P); bf16_t* YM = (bf16_t*)(p.ws + WS_XN);
    const float* PSSV = (const float*)(p.ws + WS_PSSV);
    __syncthreads();
    if (tid < 128) {
        float ss = 0.f;
#pragma unroll
        for (int i = 0; i < 4; ++i) { const f32x4 v = *(const f32x4*)(PSSV + (size_t)(t0 + tid) * 16 + i * 4); ss += (v[0] + v[1]) + (v[2] + v[3]); }
        rstdv[tid] = rsqrtf(ss * (1.f / 1024.f) + EPS);
    }
    for (int h = 0; h < 8; ++h) {
        __syncthreads();
#pragma unroll
        for (int it = 0; it < 4; ++it) {
            const int e = (it * NTHREADS + tid) * 8, t = e >> 7, s0 = e & 127;
            const float* wp = p.w_spatial + ((size_t)(h * 128 + t)) * 128 + s0;
            const f32x4 a0 = *(const f32x4*)wp, a1 = *(const f32x4*)(wp + 4);
            float v[8];
#pragma unroll
            for (int j = 0; j < 8; ++j) { const float a = j < 4 ? a0[j & 3] : a1[j & 3]; v[j] = (s0 + j <= t) ? a * rstdv[s0 + j] : 0.f; }
            u32x4 w; w.x = cvt_pk_bf16(v[0], v[1]); w.y = cvt_pk_bf16(v[2], v[3]); w.z = cvt_pk_bf16(v[4], v[5]); w.w = cvt_pk_bf16(v[6], v[7]);
            *(LAS u32x4*)(Wl + t * 272 + s0 * 2) = w;
        }
        stage_T(P + (size_t)t0 * NPROJ + 1024 + h * 128, NPROJ, 16, GvT, wave, lane);
        __syncthreads();
        f32x4 acc[8];
#pragma unroll
        for (int n = 0; n < 8; ++n) acc[n] = (f32x4){0.f, 0.f, 0.f, 0.f};
        const int kmax = (16 * wave + 15) >> 5;
#pragma unroll
        for (int kk = 0; kk < 4; ++kk) {
            if (kk <= kmax) {
                const bf16x8 bfrag = ld_frag_lds(Wl + (16 * wave + fr) * 272 + (32 * kk + 8 * fq) * 2);
#pragma unroll
                for (int n = 0; n < 8; ++n) { const bf16x8 afrag = ld_frag_lds(GvT + (16 * n + fr) * 272 + (32 * kk + 8 * fq) * 2); acc[n] = MFMA16(afrag, bfrag, acc[n]); }
            }
        }
        const int t = 16 * wave + fr; const size_t grow = (size_t)(t0 + t);
        const float bsp = p.b_spatial[h * 128 + t];
        float ss = 0.f;
#pragma unroll
        for (int n = 0; n < 8; ++n) {
            const int d0 = 16 * n + 4 * fq;
            const u32x2 uw = *(const u32x2*)(P + grow * NPROJ + h * 128 + d0);
            const f32x4 gv = *(const f32x4*)(p.gm_vnorm_g + h * 128 + d0);
            f32x4 y;
            y[0] = bflo(uw.x) * (gv[0] * acc[n][0] + bsp); y[1] = bfhi(uw.x) * (gv[1] * acc[n][1] + bsp);
            y[2] = bflo(uw.y) * (gv[2] * acc[n][2] + bsp); y[3] = bfhi(uw.y) * (gv[3] * acc[n][3] + bsp);
            ss += (y[0] * y[0] + y[1] * y[1]) + (y[2] * y[2] + y[3] * y[3]);
            acc[n] = y;
        }
        ss += __shfl_xor(ss, 16); ss += __shfl_xor(ss, 32);
        const float rstd = rsqrtf(ss * (1.f / 128.f) + EPS);
#pragma unroll
        for (int n = 0; n < 8; ++n) {
            const int d0 = 16 * n + 4 * fq;
            const f32x4 g = *(const f32x4*)(p.gm_out_g + h * 128 + d0);
            const f32x4 o = acc[n] * rstd * g;
            u32x2 w; w.x = cvt_pk_bf16(o[0], o[1]); w.y = cvt_pk_bf16(o[2], o[3]);
            *(u32x2*)(YM + grow * DM + h * 128 + d0) = w;
        }
    }
}

DI void mlstm_local(const Params& p, LAS unsigned char* lds, int b, int c, int h) {
    const int tid = threadIdx.x, lane = tid & 63, wave = __builtin_amdgcn_readfirstlane(tid >> 6), fr = lane & 15, fq = lane >> 4;
    const int bh = b * 4 + h, t0 = b * 8192 + c * 128;
    LAS unsigned char* KT = lds; LAS unsigned char* VT = lds + 34816; LAS float* wsv = (LAS float*)(lds + 108800);
    const bf16_t* P = (const bf16_t*)(p.ws + WS_P);
    bf16_t* QC = (bf16_t*)(p.ws + WS_QC); bf16_t* KC = (bf16_t*)(p.ws + WS_KC);
    const float* IG = (const float*)(p.ws + WS_IG); const float* LF = (const float*)(p.ws + WS_LF);
    __syncthreads();
    if (wave == 0) {
        const float l0 = LF[(size_t)(t0 + 2 * lane) * 4 + h], l1 = LF[(size_t)(t0 + 2 * lane + 1) * 4 + h];
        const float i0 = IG[(size_t)(t0 + 2 * lane) * 4 + h], i1 = IG[(size_t)(t0 + 2 * lane + 1) * 4 + h];
        float s = l0 + l1;
#pragma unroll
        for (int off = 1; off < 64; off <<= 1) { const float tt = __shfl_up(s, off); if (lane >= off) s += tt; }
        const float b1 = s, b0 = s - l1, bend = __shfl(s, 63);
        const float g0 = bend - b0 + i0, g1 = bend - b1 + i1;
        const float gmax = wave_max(fmaxf(g0, g1));
        wsv[2 * lane] = __expf(g0 - gmax); wsv[2 * lane + 1] = __expf(g1 - gmax);
        if (lane == 0) { ((float*)(p.ws + WS_BEND))[bh * 64 + c] = bend; ((float*)(p.ws + WS_GMAX))[bh * 64 + c] = gmax; }
    }
    __syncthreads();
    for (int g = wave; g < 32; g += 8) {
        const bool isk = g >= 16; const int cgp = (g & 15) * 8;
        const int ch = (isk ? 512 : 0) + h * 128 + cgp;
        const bf16_t* src = P + (isk ? 2560 : 2048) + h * 128 + cgp;
        const int s = 2 * lane;
        float xr[5][8];
#pragma unroll
        for (int dj = 0; dj < 5; ++dj) {
            const int srow = s - 3 + dj;
            u32x4 w = {0u, 0u, 0u, 0u};
            if (c > 0 || srow >= 0) w = *(const u32x4*)(src + (size_t)((long)t0 + srow) * NPROJ);
#pragma unroll
            for (int q = 0; q < 4; ++q) { xr[dj][2 * q] = bflo(w[q]); xr[dj][2 * q + 1] = bfhi(w[q]); }
        }
        float y0[8], y1[8];
        {
            const f32x4 cb0 = *(const f32x4*)(p.ml_conv_b + ch), cb1 = *(const f32x4*)(p.ml_conv_b + ch + 4);
#pragma unroll
            for (int e = 0; e < 8; ++e) { y0[e] = e < 4 ? cb0[e & 3] : cb1[e & 3]; y1[e] = y0[e]; }
#pragma unroll
            for (int j = 0; j < 4; ++j) {
                const f32x4 w0 = *(const f32x4*)(p.ml_conv_w + j * 1024 + ch), w1 = *(const f32x4*)(p.ml_conv_w + j * 1024 + ch + 4);
#pragma unroll
                for (int e = 0; e < 8; ++e) { const float wv = e < 4 ? w0[e & 3] : w1[e & 3]; y0[e] += wv * xr[j][e]; y1[e] += wv * xr[j + 1][e]; }
            }
        }
        const float sc = isk ? 0.08838834764831845f : 1.f;
#pragma unroll
        for (int e = 0; e < 8; ++e) { y0[e] = y0[e] * sigmoid_(y0[e]) * sc; y1[e] = y1[e] * sigmoid_(y1[e]) * sc; }
        bf16_t* dst = (isk ? KC : QC) + (size_t)(t0 + s) * 512 + h * 128 + cgp;
        u32x4 w; w.x = cvt_pk_bf16(y0[0], y0[1]); w.y = cvt_pk_bf16(y0[2], y0[3]); w.z = cvt_pk_bf16(y0[4], y0[5]); w.w = cvt_pk_bf16(y0[6], y0[7]);
        *(u32x4*)dst = w;
        w.x = cvt_pk_bf16(y1[0], y1[1]); w.y = cvt_pk_bf16(y1[2], y1[3]); w.z = cvt_pk_bf16(y1[4], y1[5]); w.w = cvt_pk_bf16(y1[6], y1[7]);
        *(u32x4*)(dst + 512) = w;
        if (isk) {
            const float w0 = wsv[s], w1 = wsv[s + 1];
#pragma unroll
            for (int e = 0; e < 8; ++e) *(LAS unsigned*)(KT + (cgp + e) * 272 + lane * 4) = cvt_pk_bf16(y0[e] * w0, y1[e] * w1);
        }
    }
    stage_T(P + (size_t)t0 * NPROJ + 3072 + h * 256, NPROJ, 32, VT, wave, lane);
    for (int i = tid; i < 1024; i += NTHREADS) { const int r = i >> 6, w = i & 63; *(LAS unsigned*)(VT + (256 + r) * 272 + w * 4) = 0x3F803F80u; }
    __syncthreads();
    bf16x8 af[4];
#pragma unroll
    for (int kk = 0; kk < 4; ++kk) af[kk] = ld_frag_lds(KT + (16 * wave + fr) * 272 + (32 * kk + 8 * fq) * 2);
    float* ST = (float*)(p.ws + WS_ST) + ((size_t)(bh * 64 + c) * 272) * 128;
#pragma unroll
    for (int n = 0; n < 17; ++n) {
        f32x4 acc = {0.f, 0.f, 0.f, 0.f};
#pragma unroll
        for (int kk = 0; kk < 4; ++kk) { const bf16x8 bfr = ld_frag_lds(VT + (16 * n + fr) * 272 + (32 * kk + 8 * fq) * 2); acc = MFMA16(af[kk], bfr, acc); }
        if (n < 16 || fr == 0) *(f32x4*)(ST + (size_t)(16 * n + fr) * 128 + 16 * wave + 4 * fq) = acc;
    }
}

DI void phase_scan(const Params& p) {
    const float* ST = (const float*)(p.ws + WS_ST); bf16_t* CPT = (bf16_t*)(p.ws + WS_CPT);
    const float* BEND = (const float*)(p.ws + WS_BEND); const float* GMAX = (const float*)(p.ws + WS_GMAX); float* MPREV = (float*)(p.ws + WS_MPREV);
    const int gtid = blockIdx.x * NTHREADS + threadIdx.x, nthr = gridDim.x * NTHREADS;
    constexpr int PER = 8224;
    constexpr size_t CST = 272 * 128;
    for (int item = gtid; item < 16 * PER; item += nthr) {
        const int bh = item / PER, e4 = item - bh * PER;
        const float* src = ST + (size_t)bh * 64 * CST + (size_t)e4 * 4;
        bf16_t* dst = CPT + (size_t)bh * 64 * CST + (size_t)e4 * 4;
        f32x4 st = {0.f, 0.f, 0.f, 0.f}; float m = 0.f;
        for (int c0 = 0; c0 < 64; c0 += 8) {
            f32x4 d[8];
#pragma unroll
            for (int j = 0; j < 8; ++j) d[j] = *(const f32x4*)(src + (size_t)(c0 + j) * CST);
#pragma unroll
            for (int j = 0; j < 8; ++j) {
                const int c = c0 + j;
                const float be = BEND[bh * 64 + c], gm = GMAX[bh * 64 + c];
                const float mn = fmaxf(be + m, gm), a = __expf(be + m - mn), sc = __expf(gm - mn);
                u32x2 w; w.x = cvt_pk_bf16(st[0], st[1]); w.y = cvt_pk_bf16(st[2], st[3]);
                *(u32x2*)(dst + (size_t)c * CST) = w;
                if (e4 == 0) MPREV[bh * 64 + c] = m;
                st = st * a + d[j] * sc; m = mn;
            }
        }
    }
}

DI void mlstm_out(const Params& p, LAS unsigned char* lds, int b, int c, int h) {
    const int tid = threadIdx.x, lane = tid & 63, wave = __builtin_amdgcn_readfirstlane(tid >> 6), fr = lane & 15, fq = lane >> 4;
    const int bh = b * 4 + h, t0 = b * 8192 + c * 128;
    LAS unsigned char* Kl = lds; LAS unsigned char* Sl = lds + 34816; LAS unsigned char* VTe = lds + 69632;
    LAS float* av = (LAS float*)(lds + 143616); LAS float* Mv = (LAS float*)(lds + 144128); LAS float* bv = (LAS float*)(lds + 144640);
    const bf16_t* P = (const bf16_t*)(p.ws + WS_P); bf16_t* YM = (bf16_t*)(p.ws + WS_XN);
    const bf16_t* QC = (const bf16_t*)(p.ws + WS_QC); const bf16_t* KC = (const bf16_t*)(p.ws + WS_KC);
    const float* IG = (const float*)(p.ws + WS_IG); const float* LF = (const float*)(p.ws + WS_LF);
    const float mprev = ((const float*)(p.ws + WS_MPREV))[bh * 64 + c];
    __syncthreads();
    if (wave == 0) {
        const float l0 = LF[(size_t)(t0 + 2 * lane) * 4 + h], l1 = LF[(size_t)(t0 + 2 * lane + 1) * 4 + h];
        const float i0 = IG[(size_t)(t0 + 2 * lane) * 4 + h], i1 = IG[(size_t)(t0 + 2 * lane + 1) * 4 + h];
        float s = l0 + l1;
#pragma unroll
        for (int off = 1; off < 64; off <<= 1) { const float tt = __shfl_up(s, off); if (lane >= off) s += tt; }
        const float b1 = s, b0 = s - l1;
        const float a0 = i0 - b0, a1 = i1 - b1;
        float pm = fmaxf(a0, a1);
#pragma unroll
        for (int off = 1; off < 64; off <<= 1) { const float tt = __shfl_up(pm, off); if (lane >= off) pm = fmaxf(pm, tt); }
        float ex = __shfl_up(pm, 1); if (lane == 0) ex = -3.0e38f;
        Mv[2 * lane] = fmaxf(mprev, fmaxf(ex, a0)); Mv[2 * lane + 1] = fmaxf(mprev, pm);
        av[2 * lane] = a0; av[2 * lane + 1] = a1; bv[2 * lane] = b0; bv[2 * lane + 1] = b1;
    }
#pragma unroll
    for (int it = 0; it < 4; ++it) {
        const int e = (it * NTHREADS + tid) * 8, s = e >> 7, d0 = e & 127;
        *(LAS u32x4*)(Kl + s * 272 + d0 * 2) = *(const u32x4*)(KC + (size_t)(t0 + s) * 512 + h * 128 + d0);
    }
    stage_T(P + (size_t)t0 * NPROJ + 3072 + h * 256, NPROJ, 32, VTe, wave, lane);
    for (int i = tid; i < 1024; i += NTHREADS) { const int r = i >> 6, w = i & 63; *(LAS unsigned*)(VTe + (256 + r) * 272 + w * 4) = 0x3F803F80u; }
    bf16x8 qf[4];
#pragma unroll
    for (int kk = 0; kk < 4; ++kk) qf[kk] = *(const bf16x8*)(QC + (size_t)(t0 + 16 * wave + fr) * 512 + h * 128 + 32 * kk + 8 * fq);
    __syncthreads();
    const int t = 16 * wave + fr; const float Mt = Mv[t];
    const int stmax = wave | 1;
    for (int st = 0; st <= stmax; ++st) {
        f32x4 s4 = {0.f, 0.f, 0.f, 0.f};
#pragma unroll
        for (int kk = 0; kk < 4; ++kk) { const bf16x8 kf = ld_frag_lds(Kl + (16 * st + fr) * 272 + (32 * kk + 8 * fq) * 2); s4 = MFMA16(kf, qf[kk], s4); }
#pragma unroll
        for (int r = 0; r < 4; ++r) { const int s = 16 * st + 4 * fq + r; const float w = (s <= t) ? __expf(av[s] - Mt) : 0.f; s4[r] *= w; }
        u32x2 w; w.x = cvt_pk_bf16(s4[0], s4[1]); w.y = cvt_pk_bf16(s4[2], s4[3]);
        *(LAS u32x2*)(Sl + t * 272 + (16 * st + 4 * fq) * 2) = w;
    }
    __syncthreads();
    const bf16_t* cpt = (const bf16_t*)(p.ws + WS_CPT) + ((size_t)(bh * 64 + c) * 272) * 128;
    f32x4 acc[17];
#pragma unroll
    for (int n = 0; n < 17; ++n) {
        acc[n] = (f32x4){0.f, 0.f, 0.f, 0.f};
#pragma unroll
        for (int kk = 0; kk < 4; ++kk) { const bf16x8 cf = *(const bf16x8*)(cpt + (size_t)(16 * n + fr) * 128 + 32 * kk + 8 * fq); acc[n] = MFMA16(cf, qf[kk], acc[n]); }
    }
    const float ai = __expf(mprev - Mt);
#pragma unroll
    for (int n = 0; n < 17; ++n) acc[n] = acc[n] * ai;
    const int k2max = (16 * wave + 15) >> 5;
#pragma unroll
    for (int kk = 0; kk < 4; ++kk) {
        if (kk <= k2max) {
            const bf16x8 sf = ld_frag_lds(Sl + t * 272 + (32 * kk + 8 * fq) * 2);
#pragma unroll
            for (int n = 0; n < 17; ++n) { const bf16x8 vf = ld_frag_lds(VTe + (16 * n + fr) * 272 + (32 * kk + 8 * fq) * 2); acc[n] = MFMA16(vf, sf, acc[n]); }
        }
    }
    const float den = __shfl(acc[16][0], fr);
    const float mt = bv[t] + Mt;
    const float inv = rcpf_(fmaxf(fabsf(den), __expf(-mt)));
    const size_t grow = (size_t)(t0 + t);
    float ss = 0.f;
#pragma unroll
    for (int n = 0; n < 16; ++n) {
        const int v0 = 16 * n + 4 * fq;
        const u32x2 ow = *(const u32x2*)(P + grow * NPROJ + 4096 + h * 256 + v0);
        f32x4 y;
        y[0] = bflo(ow.x) * acc[n][0] * inv; y[1] = bfhi(ow.x) * acc[n][1] * inv; y[2] = bflo(ow.y) * acc[n][2] * inv; y[3] = bfhi(ow.y) * acc[n][3] * inv;
        ss += (y[0] * y[0] + y[1] * y[1]) + (y[2] * y[2] + y[3] * y[3]);
        acc[n] = y;
    }
    ss += __shfl_xor(ss, 16); ss += __shfl_xor(ss, 32);
    const float rstd = rsqrtf(ss * (1.f / 256.f) + EPS);
#pragma unroll
    for (int n = 0; n < 16; ++n) {
        const int v0 = 16 * n + 4 * fq;
        const f32x4 g = *(const f32x4*)(p.ml_out_g + h * 256 + v0);
        const f32x4 o = acc[n] * rstd * g;
        u32x2 w; w.x = cvt_pk_bf16(o[0], o[1]); w.y = cvt_pk_bf16(o[2], o[3]);
        *(u32x2*)(YM + grow * DM + 1024 + h * 256 + v0) = w;
    }
}

DI unsigned ord_key(float f) { const unsigned u = __float_as_uint(f); return (u & 0x80000000u) ? ~u : (u | 0x80000000u); }
DI float key_val(unsigned k) { return (k & 0x80000000u) ? __uint_as_float(k & 0x7fffffffu) : __uint_as_float(~k); }
DI unsigned umax_(unsigned a, unsigned b) { return a > b ? a : b; }
DI unsigned umin_(unsigned a, unsigned b) { return a < b ? a : b; }
#define DPPU(v, ctrl) ((unsigned)__builtin_amdgcn_update_dpp(0, (int)(v), (ctrl), 0xF, 0xF, true))
DI unsigned row_max_u32(unsigned v) {
    v = umax_(v, DPPU(v, 0xB1)); v = umax_(v, DPPU(v, 0x4E)); v = umax_(v, DPPU(v, 0x141)); v = umax_(v, DPPU(v, 0x140)); return v;
}
DI float row_sum_f32(float v) {
    v += __uint_as_float(DPPU(__float_as_uint(v), 0xB1)); v += __uint_as_float(DPPU(__float_as_uint(v), 0x4E));
    v += __uint_as_float(DPPU(__float_as_uint(v), 0x141)); v += __uint_as_float(DPPU(__float_as_uint(v), 0x140)); return v;
}
#define CEX(a, b) do { const unsigned mx_ = umax_(a, b), mn_ = umin_(a, b); a = mx_; b = mn_; } while (0)
template <int N> DI unsigned top16_row(unsigned (&s)[N], int c) {
    unsigned list = 0u;
#pragma unroll 1
    for (int it = 0; it < 16; ++it) {
        const unsigned wm = row_max_u32(s[0]);
        const bool win = (s[0] == wm);
#pragma unroll
        for (int i = 0; i < N - 1; ++i) s[i] = win ? s[i + 1] : s[i];
        s[N - 1] = win ? 0u : s[N - 1];
        list = (c == it) ? wm : list;
    }
    return list;
}

DI void peer_select(const Params& p) {
    const int tid = threadIdx.x, lane = tid & 63, wave = __builtin_amdgcn_readfirstlane(tid >> 6), c = lane & 15, g = lane >> 4, rowbase = lane & 48;
    const bf16_t* Q = (const bf16_t*)(p.ws + WS_Q); const bf16_t* KB1 = (const bf16_t*)(p.ws + WS_KB1); const bf16_t* KB2 = (const bf16_t*)(p.ws + WS_KB2);
    int* SELID = (int*)(p.ws + WS_SELID); float* SELG = (float*)(p.ws + WS_SELG);
    unsigned pk = 0u, validmask = 0u;
#pragma unroll
    for (int q = 0; q < 4; ++q) {
        const int target = 4 * c + q; int ci = 0, cj = 0, cnt = 0; bool v = false;
#pragma unroll
        for (int i = 0; i < 16; ++i) { const int nj = 16 / (i + 1); if (target >= cnt && target < cnt + nj) { ci = i; cj = target - cnt; v = true; } cnt += nj; }
        pk |= (unsigned)((ci << 4) | cj) << (8 * q); validmask |= (v ? 1u : 0u) << q;
    }
    for (int tile = blockIdx.x * 8 + wave; tile < T_TOK / 16; tile += gridDim.x * 8) {
        const int tok0 = tile * 16;
        for (int h = 0; h < 8; ++h) {
            bf16x8 a1[2], a2[2];
            {
                const bf16_t* qp = Q + (size_t)(tok0 + c) * 1024 + h * 128 + g * 8;
                a1[0] = *(const bf16x8*)qp; a1[1] = *(const bf16x8*)(qp + 32); a2[0] = *(const bf16x8*)(qp + 64); a2[1] = *(const bf16x8*)(qp + 96);
            }
            f32x4 acc1[8], acc2[8];
#pragma unroll
            for (int nt = 0; nt < 8; ++nt) {
                const size_t ko = ((size_t)(h * 128 + nt * 16 + c)) * 64 + g * 8;
                acc1[nt] = (f32x4){0.f, 0.f, 0.f, 0.f}; acc2[nt] = (f32x4){0.f, 0.f, 0.f, 0.f};
                acc1[nt] = MFMA16(a1[0], *(const bf16x8*)(KB1 + ko), acc1[nt]); acc1[nt] = MFMA16(a1[1], *(const bf16x8*)(KB1 + ko + 32), acc1[nt]);
                acc2[nt] = MFMA16(a2[0], *(const bf16x8*)(KB2 + ko), acc2[nt]); acc2[nt] = MFMA16(a2[1], *(const bf16x8*)(KB2 + ko + 32), acc2[nt]);
            }
#pragma unroll
            for (int r = 0; r < 4; ++r) {
                unsigned s[8];
#pragma unroll
                for (int nt = 0; nt < 8; ++nt) s[nt] = (ord_key(acc1[nt][r]) & ~0x7Fu) | (unsigned)(127 - (nt * 16 + c));
                CEX(s[0], s[1]); CEX(s[2], s[3]); CEX(s[4], s[5]); CEX(s[6], s[7]); CEX(s[0], s[2]); CEX(s[1], s[3]); CEX(s[4], s[6]); CEX(s[5], s[7]); CEX(s[1], s[2]); CEX(s[5], s[6]);
                CEX(s[0], s[4]); CEX(s[1], s[5]); CEX(s[2], s[6]); CEX(s[3], s[7]); CEX(s[2], s[4]); CEX(s[3], s[5]); CEX(s[1], s[2]); CEX(s[3], s[4]); CEX(s[5], s[6]);
                const unsigned list1 = top16_row<8>(s, c);
#pragma unroll
                for (int nt = 0; nt < 8; ++nt) s[nt] = (ord_key(acc2[nt][r]) & ~0x7Fu) | (unsigned)(127 - (nt * 16 + c));
                CEX(s[0], s[1]); CEX(s[2], s[3]); CEX(s[4], s[5]); CEX(s[6], s[7]); CEX(s[0], s[2]); CEX(s[1], s[3]); CEX(s[4], s[6]); CEX(s[5], s[7]); CEX(s[1], s[2]); CEX(s[5], s[6]);
                CEX(s[0], s[4]); CEX(s[1], s[5]); CEX(s[2], s[6]); CEX(s[3], s[7]); CEX(s[2], s[4]); CEX(s[3], s[5]); CEX(s[1], s[2]); CEX(s[3], s[4]); CEX(s[5], s[6]);
                const unsigned list2 = top16_row<8>(s, c);
                unsigned cs[4];
#pragma unroll
                for (int q = 0; q < 4; ++q) {
                    const int ci = (int)((pk >> (8 * q + 4)) & 15u), cj = (int)((pk >> (8 * q)) & 15u);
                    const unsigned k1 = (unsigned)__shfl((int)list1, rowbase + ci), k2 = (unsigned)__shfl((int)list2, rowbase + cj);
                    const float cand = key_val(k1 & ~0x7Fu) + key_val(k2 & ~0x7Fu);
                    cs[q] = ((validmask >> q) & 1u) ? ((ord_key(cand) & ~0x3Fu) | (unsigned)(63 - (4 * c + q))) : 0u;
                }
                CEX(cs[0], cs[1]); CEX(cs[2], cs[3]); CEX(cs[0], cs[2]); CEX(cs[1], cs[3]); CEX(cs[1], cs[2]);
                const unsigned sel = top16_row<4>(cs, c);
                const int slot = 63 - (int)(sel & 63u);
                const unsigned pkv = (unsigned)__shfl((int)pk, rowbase + (slot >> 2));
                const int cij = (int)((pkv >> (8 * (slot & 3))) & 0xFFu);
                const unsigned e1 = (unsigned)__shfl((int)list1, rowbase + (cij >> 4)), e2 = (unsigned)__shfl((int)list2, rowbase + (cij & 15));
                const int eid = (127 - (int)(e1 & 127u)) * 128 + (127 - (int)(e2 & 127u));
                const float sv = key_val(sel & ~0x3Fu), mx = key_val(row_max_u32(sel) & ~0x3Fu);
                const float ev = __expf(sv - mx);
                const float sum = row_sum_f32(ev);
                const size_t o = (size_t)(tok0 + 4 * g + r) * 128 + h * 16 + c;
                SELID[o] = eid; SELG[o] = ev * rcpf_(sum);
            }
        }
    }
}

DI f32x2 pkfma(f32x2 a, f32x2 b, f32x2 c) { return __builtin_elementwise_fma(a, b, c); }
DI void peer_gather(const Params& p, LAS unsigned char* lds) {
    const int tid = threadIdx.x, lane = tid & 63, wave = __builtin_amdgcn_readfirstlane(tid >> 6);
    LAS float* scr = (LAS float*)lds + wave * (16 * 68);
    LAS float* cfl = (LAS float*)(lds + 8 * 16 * 68 * 4) + wave * 128;
    const unsigned char* Ub = p.ws + WS_UB; const unsigned char* Vb = p.ws + WS_VB;
    const float* PSS2 = (const float*)(p.ws + WS_PSS2);
    const int* SELID = (const int*)(p.ws + WS_SELID); const float* SELG = (const float*)(p.ws + WS_SELG);
    const int gw = blockIdx.x * 8 + wave, nw = gridDim.x * 8;
    for (int t = gw; t < T_TOK; t += nw) {
        const int idA = SELID[(size_t)t * 128 + lane], idB = SELID[(size_t)t * 128 + 64 + lane];
        const float gA = SELG[(size_t)t * 128 + lane], gB = SELG[(size_t)t * 128 + 64 + lane];
        const bf16_t* xrow = (const bf16_t*)(p.ws + WS_X1G) + (size_t)t * DM + lane * 32;
        float* orow = p.out + (size_t)t * DM + lane * 32;
        const float pv = lane < 32 ? PSS2[(size_t)t * 32 + lane] : 0.f;
        const float rstd2 = rsqrtf(wave_sum(pv) * (1.f / 2048.f) + EPS);
        f32x2 h2[16];
#pragma unroll
        for (int q = 0; q < 4; ++q) {
            const u32x4 xw = *(const u32x4*)(xrow + q * 8);
            const f32x4 g0 = *(const f32x4*)(p.norm2_g + lane * 32 + q * 8), g1 = *(const f32x4*)(p.norm2_g + lane * 32 + q * 8 + 4);
            h2[4 * q] = (f32x2){bflo(xw.x) * rstd2 * g0[0], bfhi(xw.x) * rstd2 * g0[1]};
            h2[4 * q + 1] = (f32x2){bflo(xw.y) * rstd2 * g0[2], bfhi(xw.y) * rstd2 * g0[3]};
            h2[4 * q + 2] = (f32x2){bflo(xw.z) * rstd2 * g1[0], bfhi(xw.z) * rstd2 * g1[1]};
            h2[4 * q + 3] = (f32x2){bflo(xw.w) * rstd2 * g1[2], bfhi(xw.w) * rstd2 * g1[3]};
        }
        constexpr int NPK = 8;
        u32x4 buf[2][NPK]; unsigned short bsc[2][NPK];
#define PEER_LOAD(TB, st, base) do { const int idv_ = ((base) < 64) ? idA : idB; _Pragma("unroll") for (int e_ = 0; e_ < NPK; ++e_) { \
            const int id_ = __builtin_amdgcn_readlane(idv_, ((base) + e_) & 63); const unsigned char* r_ = (TB) + (size_t)id_ * 1152; \
            buf[st][e_] = *(const u32x4*)(r_ + lane * 16); bsc[st][e_] = *(const unsigned short*)(r_ + 1024 + lane * 2); } } while (0)
#define PEER_DOT(st, slot0) do { _Pragma("unroll") for (int e_ = 0; e_ < NPK; ++e_) { f32x2 a2_ = {0.f, 0.f}; \
            _Pragma("unroll") for (int d_ = 0; d_ < 4; ++d_) { const unsigned w_ = buf[st][e_][d_]; \
                a2_ = pkfma(h2[d_ * 4 + 0], __builtin_amdgcn_cvt_scalef32_pk_f32_fp4(w_, 1.0f, 0), a2_); a2_ = pkfma(h2[d_ * 4 + 1], __builtin_amdgcn_cvt_scalef32_pk_f32_fp4(w_, 1.0f, 1), a2_); \
                a2_ = pkfma(h2[d_ * 4 + 2], __builtin_amdgcn_cvt_scalef32_pk_f32_fp4(w_, 1.0f, 2), a2_); a2_ = pkfma(h2[d_ * 4 + 3], __builtin_amdgcn_cvt_scalef32_pk_f32_fp4(w_, 1.0f, 3), a2_); } \
            scr[((slot0) + e_) * 68 + lane] = (a2_[0] + a2_[1]) * bf2f(bsc[st][e_]); } } while (0)
        PEER_LOAD(Ub, 0, 0);
        for (int b = 0; b < 128 / NPK; b += 2) {
            PEER_LOAD(Ub, 1, (b + 1) * NPK);
            PEER_DOT(0, (b * NPK) & 15);
            if (b + 2 < 128 / NPK) PEER_LOAD(Ub, 0, (b + 2) * NPK);
            PEER_DOT(1, ((b + 1) * NPK) & 15);
            if ((((b + 2) * NPK) & 15) == 0) {
                WAVE_LDS_SYNC();
                float sum = 0.f;
#pragma unroll
                for (int i = 0; i < 4; ++i) { const f32x4 r = *(const LAS f32x4*)(scr + (lane >> 2) * 68 + (lane & 3) * 16 + 4 * i); sum += (r[0] + r[1]) + (r[2] + r[3]); }
                sum += __shfl_xor(sum, 1); sum += __shfl_xor(sum, 2);
                const int k0 = (b + 2) * NPK - 16;
                const int k = k0 + (lane >> 2);
                const float gate = __shfl((k0 < 64) ? gA : gB, k & 63);
                if ((lane & 3) == 0) cfl[k] = gate * gelu_t(sum);
                WAVE_LDS_SYNC();
            }
        }
        f32x2 acc[16];
#pragma unroll
        for (int i = 0; i < 16; ++i) acc[i] = (f32x2){0.f, 0.f};
#define PEER_AXPY(st, base) do { _Pragma("unroll") for (int e_ = 0; e_ < NPK; ++e_) { const float c_ = cfl[(base) + e_] * bf2f(bsc[st][e_]); const f32x2 c2_ = {c_, c_}; \
            _Pragma("unroll") for (int d_ = 0; d_ < 4; ++d_) { const unsigned w_ = buf[st][e_][d_]; \
                acc[d_ * 4 + 0] = pkfma(c2_, __builtin_amdgcn_cvt_scalef32_pk_f32_fp4(w_, 1.0f, 0), acc[d_ * 4 + 0]); acc[d_ * 4 + 1] = pkfma(c2_, __builtin_amdgcn_cvt_scalef32_pk_f32_fp4(w_, 1.0f, 1), acc[d_ * 4 + 1]); \
                acc[d_ * 4 + 2] = pkfma(c2_, __builtin_amdgcn_cvt_scalef32_pk_f32_fp4(w_, 1.0f, 2), acc[d_ * 4 + 2]); acc[d_ * 4 + 3] = pkfma(c2_, __builtin_amdgcn_cvt_scalef32_pk_f32_fp4(w_, 1.0f, 3), acc[d_ * 4 + 3]); } } } while (0)
        PEER_LOAD(Vb, 0, 0);
        for (int b = 0; b < 128 / NPK; b += 2) {
            PEER_LOAD(Vb, 1, (b + 1) * NPK);
            PEER_AXPY(0, b * NPK);
            if (b + 2 < 128 / NPK) PEER_LOAD(Vb, 0, (b + 2) * NPK);
            PEER_AXPY(1, (b + 1) * NPK);
        }
        float ss = 0.f;
#pragma unroll
        for (int q = 0; q < 4; ++q) {
            const u32x4 xw = *(const u32x4*)(xrow + q * 8);
            acc[4 * q] += (f32x2){bflo(xw.x), bfhi(xw.x)}; acc[4 * q + 1] += (f32x2){bflo(xw.y), bfhi(xw.y)};
            acc[4 * q + 2] += (f32x2){bflo(xw.z), bfhi(xw.z)}; acc[4 * q + 3] += (f32x2){bflo(xw.w), bfhi(xw.w)};
#pragma unroll
            for (int i = 0; i < 4; ++i) { const f32x2 a = acc[4 * q + i]; ss += a[0] * a[0] + a[1] * a[1]; }
        }
        const float rstd = rsqrtf(wave_sum(ss) * (1.f / 2048.f) + EPS);
#pragma unroll
        for (int q = 0; q < 8; ++q) {
            const f32x4 g0 = *(const f32x4*)(p.final_g + lane * 32 + q * 4);
            const f32x2 a = acc[2 * q], b = acc[2 * q + 1];
            const f32x4 o0 = {a[0] * rstd * g0[0], a[1] * rstd * g0[1], b[0] * rstd * g0[2], b[1] * rstd * g0[3]};
            *(f32x4*)(orow + q * 4) = o0;
        }
        WAVE_LDS_SYNC();
    }
}

#ifndef PROBE_DUP
#define PROBE_DUP 0
#endif
#define REP(bit) for (int rep_ = 0; rep_ < (((PROBE_DUP) >> (bit)) & 1) + 1; ++rep_)
#define PH1() { pg8::Gemm g{(const bf16_t*)(p.ws + WS_XN), (const bf16_t*)(p.ws + WS_WINT), T_TOK, NPROJ, DM}; pg8::StaticOrder S; S.init(T_TOK, NPROJ, G, bx); Epi1 E{(bf16_t*)(p.ws + WS_P), (float*)(p.ws + WS_PSSV)}; pg8::gemm_phase<Epi1, pg8::StaticOrder, true, true>(lds, g, S, E); grid.sync(); }
#define PH3() { pg8::Gemm g{(const bf16_t*)(p.ws + WS_XN), (const bf16_t*)(p.ws + WS_WOUTT), T_TOK, DM, DM}; pg8::StaticOrder S; S.init(T_TOK, DM, G, bx); Epi2 E{p.x, (bf16_t*)(p.ws + WS_X1G), (float*)(p.ws + WS_PSS2)}; pg8::gemm_phase<Epi2, pg8::StaticOrder, true, true>(lds, g, S, E); grid.sync(); }
#define PH4() { pg8::Gemm g{(const bf16_t*)(p.ws + WS_X1G), (const bf16_t*)(p.ws + WS_WQT), T_TOK, 1024, DM}; pg8::StaticOrder S; S.init(T_TOK, 1024, G, bx); Epi3 E{(bf16_t*)(p.ws + WS_Q), (const float*)(p.ws + WS_PSS2)}; pg8::gemm_phase<Epi3, pg8::StaticOrder, true, true>(lds, g, S, E); grid.sync(); }
__global__ void __launch_bounds__(NTHREADS, 2) hymba_fwd(Params p) {
    extern __shared__ __attribute__((aligned(16))) unsigned char smem[];
    LAS unsigned char* lds = (LAS unsigned char*)smem;
    cg::grid_group grid = cg::this_grid();
    const int G = gridDim.x, bx = blockIdx.x;
    REP(0) { phase0(p, lds); grid.sync(); }
    PH1()
#if (PROBE_DUP >> 1) & 1
    PH1()
#endif
    REP(2) {
        for (int si = bx; si < 256; si += G) {
            const int b = si >> 6, c = si & 63;
            gmlp_bc(p, lds, b, c);
            for (int h = 0; h < 4; ++h) mlstm_local(p, lds, b, c, h);
        }
        grid.sync();
    }
    REP(3) { phase_scan(p); grid.sync(); }
    REP(4) { for (int it = bx; it < 1024; it += G) mlstm_out(p, lds, it >> 8, (it >> 2) & 63, it & 3); grid.sync(); }
    PH3()
#if (PROBE_DUP >> 5) & 1
    PH3()
#endif
    PH4()
#if (PROBE_DUP >> 6) & 1
    PH4()
#endif
    REP(7) { peer_select(p); grid.sync(); }
    peer_gather(p, lds);
}

extern "C" void kernel_launch(void* const* d_in, const int* in_sizes, int n_in, void* d_out, int out_size, void* d_ws, size_t ws_size, hipStream_t stream) {
    static int grid_blocks = 0;
    if (grid_blocks == 0) {
        if (n_in != 20 || ws_size < WS_END) { fprintf(stderr, "kernel_launch: unexpected n_in %d or ws_size %zu (need %zu)\n", n_in, ws_size, (size_t)WS_END); grid_blocks = -1; return; }
        int dev = 0, cus = 0, per_cu = 0;
        hipGetDevice(&dev);
        hipDeviceGetAttribute(&cus, hipDeviceAttributeMultiprocessorCount, dev);
        hipFuncSetAttribute((const void*)hymba_fwd, hipFuncAttributeMaxDynamicSharedMemorySize, LDS_BYTES);
        hipOccupancyMaxActiveBlocksPerMultiprocessor(&per_cu, (const void*)hymba_fwd, NTHREADS, LDS_BYTES);
        if (per_cu < 1) { fprintf(stderr, "kernel_launch: occupancy query says %d blocks per CU\n", per_cu); per_cu = 1; }
        if (per_cu > 1) per_cu = 1;
        grid_blocks = cus * per_cu;
        (void)hipGetLastError();
    }
    if (grid_blocks < 0) return;
    Params p{};
    p.x = (const float*)d_in[0]; p.norm1_g = (const float*)d_in[1]; p.w_in = (const float*)d_in[2]; p.gm_vnorm_g = (const float*)d_in[3];
    p.w_spatial = (const float*)d_in[4]; p.b_spatial = (const float*)d_in[5]; p.ml_conv_w = (const float*)d_in[6]; p.ml_conv_b = (const float*)d_in[7];
    p.ml_b_i = (const float*)d_in[8]; p.ml_b_f = (const float*)d_in[9]; p.gm_out_g = (const float*)d_in[10]; p.ml_out_g = (const float*)d_in[11];
    p.w_out = (const float*)d_in[12]; p.norm2_g = (const float*)d_in[13]; p.peer_wq = (const float*)d_in[14]; p.peer_k1 = (const float*)d_in[15];
    p.peer_k2 = (const float*)d_in[16]; p.peer_u = (const float*)d_in[17]; p.peer_v = (const float*)d_in[18]; p.final_g = (const float*)d_in[19];
    p.out = (float*)d_out; p.ws = (unsigned char*)d_ws;
    void* args[] = {&p};
    hipError_t e = hipLaunchCooperativeKernel((const void*)hymba_fwd, dim3(grid_blocks), dim3(NTHREADS), args, LDS_BYTES, stream);
    if (e != hipSuccess) fprintf(stderr, "cooperative launch failed: %s (grid %d)\n", hipGetErrorString(e), grid_blocks);
}
```

```cpp
#include <hip/hip_runtime.h>
#include <hip/hip_cooperative_groups.h>
#include <cstdio>
#include <cstdint>
namespace cg = cooperative_groups;
namespace pg8 {
#define PG8_LAS __attribute__((address_space(3)))
typedef unsigned short bf16_t;
typedef short bf16x8 __attribute__((ext_vector_type(8)));
typedef float f32x4 __attribute__((ext_vector_type(4)));
typedef unsigned u32x4 __attribute__((ext_vector_type(4)));
constexpr int BM = 256, BK = 64, HALF = 128, HTB = HALF * BK * 2  , STAGE_BYTES = 8 * HTB, NXCD = 8, WGM = 8;

__host__ __device__ __forceinline__ int lds_byte(int r, int c) { const int st = (r >> 4) * 2 + (c >> 5), rr = r & 15, cc = c & 31, ob = rr * 64 + cc * 2; return st * 1024 + (ob ^ (((ob >> 9) & 1) << 5)); }
__host__ __device__ __forceinline__ void stage_rc(int b, int& R, int& C) { const int st = b / 1024, sb = b % 1024, swz = sb ^ (((sb >> 9) & 1) << 5); R = (st >> 1) * 16 + swz / 64; C = (st & 1) * 32 + (swz % 64) / 2; }
__host__ __device__ __forceinline__ int perm32(int rho) { const int n = rho >> 4, i = rho & 15; return 8 * (i >> 2) + 4 * n + (i & 3); }

struct Unit { int pm, pn; };
struct Gemm { const bf16_t* A; const bf16_t* Bt; int M, N, K; };

struct StaticOrder {
    int nM, nN, nwg, G, c;
    __host__ __device__ void init(int M, int N, int G_, int c_) { nM = M / BM; nN = N / BM; nwg = nM * nN; G = G_; c = c_; }
    __host__ __device__ bool next(int i, Unit& u) const {
        const long L = (long)i * G + c; if (L >= nwg) return false;
        int wgid = (int)L; { const int q = nwg / NXCD, r = nwg % NXCD, xcd = wgid % NXCD, off = wgid / NXCD; wgid = (xcd < r ? xcd * (q + 1) : r * (q + 1) + (xcd - r) * q) + off; }
        const int nig = WGM * nN, gid = wgid / nig, fm = gid * WGM, gsz = (nM - fm) < WGM ? (nM - fm) : WGM;
        u.pm = fm + ((wgid % nig) % gsz); u.pn = (wgid % nig) / gsz; return true;
    }
    __device__ __forceinline__ void a_ready(const Unit&) const {}
    __device__ __forceinline__ void done(const Unit&) const {}
};
__device__ __forceinline__ unsigned cvt_pk_bf16(float lo, float hi) { unsigned r; asm volatile("v_cvt_pk_bf16_f32 %0, %1, %2" : "=v"(r) : "v"(lo), "v"(hi)); return r; }
template <class Epi, class Sched, bool ALIGN_EPI = false, bool SP2 = false>
__device__ __forceinline__ void gemm_phase(PG8_LAS unsigned char* lds, const Gemm g, const Sched& S, const Epi& E) {
    const int tid = threadIdx.x, wid = __builtin_amdgcn_readfirstlane(tid >> 6), lane = tid & 63, wr = wid >> 2, wc = wid & 3, fr = lane & 15, fq = lane >> 4;
    const int K = g.K, nt = K / BK;
    unsigned voffA[2], voffB[2];
#pragma unroll
    for (int i = 0; i < 2; ++i) { int R, C; stage_rc(tid * 16 + i * 8192, R, C); const int Rb = Epi::PERM ? ((R & ~31) + perm32(R & 31)) : R;
        voffA[i] = (unsigned)(R * K + C) * 2u; voffB[i] = (unsigned)(Rb * K + C) * 2u; }
    const size_t kstep = (size_t)(BK * 2);
    const size_t hstep = (size_t)HALF * K * 2;
    const size_t tstep = 2 * hstep;
    const unsigned ldsw = (unsigned)wid * 1024u;
    const int aoff = lds_byte(wr * 64 + fr, fq * 8), boff = lds_byte(wc * 32 + fr, fq * 8);
#define PG8_SA(b, h) (((b) * 2 + (h)) * HTB)
#define PG8_SB(b, h) ((4 + (b) * 2 + (h)) * HTB)
#define PG8_STAGE(bufoff, gbase, voff) do { _Pragma("unroll") for (int _i = 0; _i < 2; ++_i) \
        __builtin_amdgcn_global_load_lds((const unsigned*)((const char*)(gbase) + (voff)[_i]), (PG8_LAS unsigned*)(lds + (bufoff) + ldsw + _i * 8192), 16, 0, 0); } while (0)
#define PG8_LDA(dst, b, h) do { _Pragma("unroll") for (int m = 0; m < 4; ++m) _Pragma("unroll") for (int k = 0; k < 2; ++k) dst[m][k] = *(const PG8_LAS bf16x8*)(lds + PG8_SA(b, h) + aoff + m * 2048 + k * 1024); } while (0)
#define PG8_LDB(dst, b, h) do { _Pragma("unroll") for (int n = 0; n < 2; ++n) _Pragma("unroll") for (int k = 0; k < 2; ++k) dst[n][k] = *(const PG8_LAS bf16x8*)(lds + PG8_SB(b, h) + boff + n * 2048 + k * 1024); } while (0)
#define PG8_MMA(ai, bj, At, Bt) do { __builtin_amdgcn_s_setprio(1); _Pragma("unroll") for (int m = 0; m < 4; ++m) _Pragma("unroll") for (int n = 0; n < 2; ++n) _Pragma("unroll") for (int k = 0; k < 2; ++k) \
        acc[ai][bj][m][n] = __builtin_amdgcn_mfma_f32_16x16x32_bf16(Bt[n][k], At[m][k], acc[ai][bj][m][n], 0, 0, 0); __builtin_amdgcn_s_setprio(0); } while (0)
#define PG8_WAIT_V(n) asm volatile("s_waitcnt vmcnt(" #n ")" ::: "memory")
#define PG8_WAIT_L(n) asm volatile("s_waitcnt lgkmcnt(" #n ")" ::: "memory")
#define PG8_BAR __builtin_amdgcn_s_barrier()
#define PG8_SCHED __builtin_amdgcn_sched_barrier(0)
    Unit cur, nxt; int ui = 0;
    if (!S.next(0, cur)) return;
    f32x4 acc[2][2][4][2];
#pragma unroll
    for (int a = 0; a < 2; ++a)
#pragma unroll
        for (int b = 0; b < 2; ++b)
#pragma unroll
            for (int m = 0; m < 4; ++m)
#pragma unroll
                for (int n = 0; n < 2; ++n) acc[a][b][m][n] = (f32x4){0.f, 0.f, 0.f, 0.f};
    bf16x8 At[4][2], B0[2][2], B1[2][2];
    const char* cA = (const char*)g.A + (size_t)cur.pm * tstep; const char* cB = (const char*)g.Bt + (size_t)cur.pn * tstep;
    S.a_ready(cur);
    if constexpr (SP2) {
        PG8_STAGE(PG8_SB(0, 0), cB, voffB); PG8_STAGE(PG8_SB(0, 1), cB + hstep, voffB); PG8_STAGE(PG8_SA(0, 0), cA, voffA); PG8_STAGE(PG8_SA(0, 1), cA + hstep, voffA);
        if (wr == 1) PG8_BAR;
        PG8_WAIT_V(2); PG8_BAR;
        PG8_STAGE(PG8_SB(1, 0), cB + kstep, voffB); PG8_STAGE(PG8_SA(1, 0), cA + kstep, voffA); PG8_STAGE(PG8_SB(1, 1), cB + hstep + kstep, voffB);
        PG8_WAIT_V(6); PG8_BAR;
    } else {
        PG8_STAGE(PG8_SB(0, 0), cB, voffB); PG8_STAGE(PG8_SA(0, 0), cA, voffA); PG8_STAGE(PG8_SB(0, 1), cB + hstep, voffB); PG8_STAGE(PG8_SA(0, 1), cA + hstep, voffA);
        if (wr == 1) PG8_BAR;
        PG8_WAIT_V(4); PG8_BAR;
        PG8_STAGE(PG8_SB(1, 0), cB + kstep, voffB); PG8_STAGE(PG8_SA(1, 0), cA + kstep, voffA); PG8_STAGE(PG8_SB(1, 1), cB + hstep + kstep, voffB);
        PG8_WAIT_V(6); PG8_BAR;
    }
    for (;;) {
        const bool has_next = S.next(ui + 1, nxt);
        const char* nA = has_next ? (const char*)g.A + (size_t)nxt.pm * tstep : cA; const char* nB = has_next ? (const char*)g.Bt + (size_t)nxt.pn * tstep : cB;
        for (int t = 0; t < nt; t += 2) {
            const bool last = (t == nt - 2);
            const char* a1 = cA + (size_t)(t + 1) * kstep;
            const char* a2 = last ? nA : cA + (size_t)(t + 2) * kstep; const char* b2 = last ? nB : cB + (size_t)(t + 2) * kstep;
            const char* a3 = a2 + kstep; const char* b3 = b2 + kstep;
            if (last && has_next) S.a_ready(nxt);
            if constexpr (SP2) {
            PG8_LDB(B0, 0, 0); PG8_LDB(B1, 0, 1); PG8_SCHED; PG8_LDA(At, 0, 0); PG8_STAGE(PG8_SA(1, 1), a1 + hstep, voffA);
            PG8_WAIT_V(8); PG8_WAIT_L(0); PG8_BAR; PG8_MMA(0, 0, At, B0); PG8_MMA(0, 1, At, B1); PG8_BAR; PG8_SCHED;
            PG8_LDA(At, 0, 1); PG8_STAGE(PG8_SB(0, 0), b2, voffB); PG8_STAGE(PG8_SB(0, 1), b2 + hstep, voffB); PG8_STAGE(PG8_SA(0, 0), a2, voffA);
            PG8_WAIT_V(8); PG8_WAIT_L(0); PG8_BAR; PG8_MMA(1, 0, At, B0); PG8_MMA(1, 1, At, B1); PG8_BAR; PG8_SCHED;
            PG8_LDB(B0, 1, 0); PG8_LDB(B1, 1, 1); PG8_SCHED; PG8_LDA(At, 1, 0); PG8_STAGE(PG8_SA(0, 1), a2 + hstep, voffA);
            PG8_WAIT_V(8); PG8_WAIT_L(0); PG8_BAR; PG8_MMA(0, 0, At, B0); PG8_MMA(0, 1, At, B1); PG8_BAR; PG8_SCHED;
            PG8_LDA(At, 1, 1); PG8_STAGE(PG8_SB(1, 0), b3, voffB); PG8_STAGE(PG8_SB(1, 1), b3 + hstep, voffB); PG8_STAGE(PG8_SA(1, 0), a3, voffA);
            PG8_WAIT_V(8); PG8_WAIT_L(0); PG8_BAR; PG8_MMA(1, 0, At, B0); PG8_MMA(1, 1, At, B1); PG8_BAR; PG8_SCHED;
            } else {
            PG8_LDB(B0, 0, 0); PG8_SCHED; PG8_LDA(At, 0, 0); PG8_STAGE(PG8_SA(1, 1), a1 + hstep, voffA);
            PG8_WAIT_L(8); PG8_BAR; PG8_WAIT_L(0); PG8_MMA(0, 0, At, B0); PG8_BAR; PG8_SCHED;
            PG8_LDB(B1, 0, 1); PG8_STAGE(PG8_SB(0, 0), b2, voffB);
            PG8_BAR; PG8_WAIT_L(0); PG8_MMA(0, 1, At, B1); PG8_BAR;
            PG8_LDA(At, 0, 1); PG8_STAGE(PG8_SA(0, 0), a2, voffA);
            PG8_BAR; PG8_WAIT_L(0); PG8_MMA(1, 0, At, B0); PG8_BAR; PG8_SCHED;
            PG8_STAGE(PG8_SB(0, 1), b2 + hstep, voffB);
            PG8_WAIT_V(6); PG8_BAR; PG8_MMA(1, 1, At, B1); PG8_BAR;
            PG8_LDB(B0, 1, 0); PG8_SCHED; PG8_LDA(At, 1, 0); PG8_STAGE(PG8_SA(0, 1), a2 + hstep, voffA);
            PG8_WAIT_L(8); PG8_BAR; PG8_WAIT_L(0); PG8_MMA(0, 0, At, B0); PG8_BAR; PG8_SCHED;
            PG8_LDB(B1, 1, 1); PG8_STAGE(PG8_SB(1, 0), b3, voffB);
            PG8_BAR; PG8_WAIT_L(0); PG8_MMA(0, 1, At, B1); PG8_BAR;
            PG8_LDA(At, 1, 1); PG8_STAGE(PG8_SA(1, 0), a3, voffA);
            PG8_BAR; PG8_WAIT_L(0); PG8_MMA(1, 0, At, B0); PG8_BAR; PG8_SCHED;
            PG8_STAGE(PG8_SB(1, 1), b3 + hstep, voffB);
            PG8_WAIT_V(6); PG8_BAR; PG8_MMA(1, 1, At, B1); PG8_BAR;
            }
        }
        if constexpr (ALIGN_EPI) { if (wr == 0) PG8_BAR; }
        if constexpr (!Epi::AFTER_DRAIN) { E(acc, cur, wr, wc, fr, fq); S.done(cur); }
        if (!has_next) break;
#pragma unroll
        for (int a = 0; a < 2; ++a)
#pragma unroll
            for (int b = 0; b < 2; ++b)
#pragma unroll
                for (int m = 0; m < 4; ++m)
#pragma unroll
                    for (int n = 0; n < 2; ++n) acc[a][b][m][n] = (f32x4){0.f, 0.f, 0.f, 0.f};
        cur = nxt; cA = nA; cB = nB; ++ui;
        if constexpr (ALIGN_EPI) { if (wr == 1) PG8_BAR; }
    }
    PG8_WAIT_V(0);
    if constexpr (!ALIGN_EPI) { if (wr == 0) PG8_BAR; }
    PG8_BAR;
    if constexpr (Epi::AFTER_DRAIN) { E.fused(acc, cur, wr, wc, fr, fq, lds, wid, lane); S.done(cur); }
#undef PG8_SA
#undef PG8_SB
#undef PG8_STAGE
#undef PG8_LDA
#undef PG8_LDB
#undef PG8_MMA
#undef PG8_WAIT_V
#undef PG8_WAIT_L
#undef PG8_BAR
#undef PG8_SCHED
}
}

#define LAS __attribute__((address_space(3)))
#define DI __device__ __forceinline__
using pg8::bf16_t; using pg8::bf16x8; using pg8::f32x4; using pg8::u32x4; using pg8::cvt_pk_bf16;
typedef unsigned u32x2 __attribute__((ext_vector_type(2)));
typedef float f32x2 __attribute__((ext_vector_type(2)));

constexpr int T_TOK = 32768, DM = 2048, NPROJ = 5120, PROJW = 5128;
constexpr int NTHREADS = 512;
constexpr int LDS_BYTES = 147456;
constexpr float EPS = 1e-6f;

constexpr size_t WS_XN = 0;
constexpr size_t WS_P = 134217728;
constexpr size_t WS_X1G = WS_P;
constexpr size_t WS_Q = WS_P + 134217728;
constexpr size_t WS_WINT = WS_P + 335544320;
constexpr size_t WS_WOUTT = WS_WINT + 20971520;
constexpr size_t WS_WQT = WS_WOUTT + 8388608;
constexpr size_t WS_UB = WS_WQT + 4194304;
constexpr size_t WS_VB = WS_UB + 67108864;
constexpr size_t WS_ST = WS_VB + 67108864;
constexpr size_t WS_CPT = WS_ST + 142606336;
constexpr size_t WS_QC = WS_CPT + 71303168;
constexpr size_t WS_KC = WS_QC + 33554432;
constexpr size_t WS_IG = WS_KC + 33554432;
constexpr size_t WS_LF = WS_IG + 524288;
constexpr size_t WS_PSSV = WS_LF + 524288;
constexpr size_t WS_PSS2 = WS_PSSV + 2097152;
constexpr size_t WS_BEND = WS_PSS2 + 4194304;
constexpr size_t WS_GMAX = WS_BEND + 4096;
constexpr size_t WS_MPREV = WS_GMAX + 4096;
constexpr size_t WS_SELID = WS_MPREV + 4096;
constexpr size_t WS_SELG = WS_SELID + 16777216;
constexpr size_t WS_KB1 = WS_SELG + 16777216;
constexpr size_t WS_KB2 = WS_KB1 + 131072;
constexpr size_t WS_END = WS_KB2 + 131072;

struct Params {
    const float *x, *norm1_g, *w_in, *gm_vnorm_g, *w_spatial, *b_spatial, *ml_conv_w, *ml_conv_b, *ml_b_i, *ml_b_f, *gm_out_g, *ml_out_g, *w_out, *norm2_g,
        *peer_wq, *peer_k1, *peer_k2, *peer_u, *peer_v, *final_g;
    float* out;
    unsigned char* ws;
};

template <int CB, int H, int W> DI size_t p_off(int t, int h, int d) { return (size_t)T_TOK * CB + ((size_t)((t >> 7) * H + h) * 128 + (t & 127)) * W + d; }
DI float bf2f(unsigned short h) { return __uint_as_float(((unsigned)h) << 16); }
DI float bflo(unsigned w) { return __uint_as_float(w << 16); }
DI float bfhi(unsigned w) { return __uint_as_float(w & 0xffff0000u); }
DI float rcpf_(float x) { return __builtin_amdgcn_rcpf(x); }
DI float sigmoid_(float x) { return rcpf_(1.f + __expf(-x)); }
DI float gelu_t(float x) { const float z = 1.5957691216057308f * (x + 0.044715f * x * x * x); return x * rcpf_(1.f + __expf(-z)); }
DI float wave_sum(float v) {
#pragma unroll
    for (int o = 32; o; o >>= 1) v += __shfl_xor(v, o);
    return v;
}
DI float wave_max(float v) {
#pragma unroll
    for (int o = 32; o; o >>= 1) v = fmaxf(v, __shfl_xor(v, o));
    return v;
}
DI bf16x8 ld_frag_lds(const LAS unsigned char* p) { return *(const LAS bf16x8*)p; }
#define MFMA16(a, b, c) __builtin_amdgcn_mfma_f32_16x16x32_bf16((a), (b), (c), 0, 0, 0)

struct Epi1 {
    static constexpr bool PERM = true, AFTER_DRAIN = false;
    bf16_t* P; float* pssv;
    DI void operator()(const f32x4 (&acc)[2][2][4][2], const pg8::Unit& u, int wr, int wc, int fr, int fq) const {
        const int row0 = u.pm * 256 + wr * 64 + fr, col0 = u.pn * 256 + wc * 32 + 8 * fq;
        const int mode = u.pn < 8 ? 1 : (u.pn >= 16 ? 2 : 0);
        const bool want_ss = (u.pn >= 4 && u.pn < 8);
#pragma unroll
        for (int ai = 0; ai < 2; ++ai)
#pragma unroll
            for (int m = 0; m < 4; ++m) {
                const int row = row0 + ai * 128 + m * 16;
                const int CB = u.pn < 4 ? 0 : (u.pn < 8 ? 1024 : (u.pn < 10 ? 2048 : (u.pn < 12 ? 2560 : (u.pn < 16 ? 3072 : 4096))));
                const int lw = u.pn < 12 ? 7 : 8, H = u.pn < 8 ? 8 : 4;
                float ss = 0.f;
#pragma unroll
                for (int bj = 0; bj < 2; ++bj) {
                    f32x4 v0 = acc[ai][bj][m][0], v1 = acc[ai][bj][m][1];
                    if (mode == 1) {
#pragma unroll
                        for (int j = 0; j < 4; ++j) { v0[j] = gelu_t(v0[j]); v1[j] = gelu_t(v1[j]); ss += v0[j] * v0[j] + v1[j] * v1[j]; }
                    } else if (mode == 2) {
#pragma unroll
                        for (int j = 0; j < 4; ++j) { v0[j] = sigmoid_(v0[j]); v1[j] = sigmoid_(v1[j]); }
                    }
                    u32x4 w; w.x = cvt_pk_bf16(v0[0], v0[1]); w.y = cvt_pk_bf16(v0[2], v0[3]); w.z = cvt_pk_bf16(v1[0], v1[1]); w.w = cvt_pk_bf16(v1[2], v1[3]);
                    {
                        const int cr = col0 + bj * 128 - CB, hh = cr >> lw, d = cr & ((1 << lw) - 1);
                        *(u32x4*)(P + (size_t)T_TOK * CB + (((size_t)((row >> 7) * H + hh) * 128 + (row & 127)) << lw) + d) = w;
                    }
                }
                if (want_ss) {
                    ss += __shfl_xor(ss, 16); ss += __shfl_xor(ss, 32);
                    if (fq == 0) pssv[(size_t)row * 16 + (u.pn - 4) * 4 + wc] = ss;
                }
            }
    }
};

struct Epi2 {
    static constexpr bool PERM = true, AFTER_DRAIN = false;
    const float* x; bf16_t* x1b; float* pss2;
    DI void operator()(const f32x4 (&acc)[2][2][4][2], const pg8::Unit& u, int wr, int wc, int fr, int fq) const {
        const int row0 = u.pm * 256 + wr * 64 + fr, col0 = u.pn * 256 + wc * 32 + 8 * fq;
#pragma unroll
        for (int ai = 0; ai < 2; ++ai)
#pragma unroll
            for (int m = 0; m < 4; ++m) {
                const int row = row0 + ai * 128 + m * 16;
                float ss = 0.f;
#pragma unroll
                for (int bj = 0; bj < 2; ++bj) {
                    const size_t o = (size_t)row * DM + col0 + bj * 128;
                    const f32x4 v0 = acc[ai][bj][m][0] + *(const f32x4*)(x + o), v1 = acc[ai][bj][m][1] + *(const f32x4*)(x + o + 4);
#pragma unroll
                    for (int j = 0; j < 4; ++j) ss += v0[j] * v0[j] + v1[j] * v1[j];
                    u32x4 w; w.x = cvt_pk_bf16(v0[0], v0[1]); w.y = cvt_pk_bf16(v0[2], v0[3]); w.z = cvt_pk_bf16(v1[0], v1[1]); w.w = cvt_pk_bf16(v1[2], v1[3]);
                    *(u32x4*)(x1b + o) = w;
                }
                ss += __shfl_xor(ss, 16); ss += __shfl_xor(ss, 32);
                if (fq == 0) pss2[(size_t)row * 32 + u.pn * 4 + wc] = ss;
            }
    }
};

struct Epi3 {
    static constexpr bool PERM = true, AFTER_DRAIN = false;
    bf16_t* Q; const float* pss2;
    DI void operator()(const f32x4 (&acc)[2][2][4][2], const pg8::Unit& u, int wr, int wc, int fr, int fq) const {
        const int row0 = u.pm * 256 + wr * 64 + fr, col0 = u.pn * 256 + wc * 32 + 8 * fq;
#pragma unroll
        for (int ai = 0; ai < 2; ++ai)
#pragma unroll
            for (int m = 0; m < 4; ++m) {
                const int row = row0 + ai * 128 + m * 16;
                float ss = 0.f;
#pragma unroll
                for (int i = 0; i < 8; ++i) { const f32x4 t = *(const f32x4*)(pss2 + (size_t)row * 32 + i * 4); ss += (t[0] + t[1]) + (t[2] + t[3]); }
                const float rstd = rsqrtf(ss * (1.f / 2048.f) + EPS);
#pragma unroll
                for (int bj = 0; bj < 2; ++bj) {
                    const f32x4 v0 = acc[ai][bj][m][0] * rstd, v1 = acc[ai][bj][m][1] * rstd;
                    u32x4 w; w.x = cvt_pk_bf16(v0[0], v0[1]); w.y = cvt_pk_bf16(v0[2], v0[3]); w.z = cvt_pk_bf16(v1[0], v1[1]); w.w = cvt_pk_bf16(v1[2], v1[3]);
                    *(u32x4*)(Q + (size_t)row * 1024 + col0 + bj * 128) = w;
                }
            }
    }
};

DI void phase0(const Params& p, LAS unsigned char* lds) {
    const int tid = threadIdx.x, lane = tid & 63, wave = tid >> 6;
    bf16_t* XN = (bf16_t*)(p.ws + WS_XN);
    {
        LAS float* scr = (LAS float*)lds + wave * (64 * 65);
        const int gw = blockIdx.x * 8 + wave, nw = gridDim.x * 8;
        for (int it = gw; it < 4096; it += nw) {
            const float* W; bf16_t* WT; int ldw, kt, nt;
            if (it < 2560) { W = p.w_in; WT = (bf16_t*)(p.ws + WS_WINT); ldw = PROJW; kt = it / 80; nt = it % 80; }
            else if (it < 3584) { const int j = it - 2560; W = p.w_out; WT = (bf16_t*)(p.ws + WS_WOUTT); ldw = 2048; kt = j >> 5; nt = j & 31; }
            else { const int j = it - 3584; W = p.peer_wq; WT = (bf16_t*)(p.ws + WS_WQT); ldw = 1024; kt = j >> 4; nt = j & 15; }
            const int k0 = kt * 64, n0 = nt * 64;
#pragma unroll 16
            for (int r = 0; r < 64; ++r) scr[r * 65 + lane] = W[(size_t)(k0 + r) * ldw + n0 + lane] * (it >= 3584 ? p.norm2_g[k0 + r] : 1.f);
            __builtin_amdgcn_fence(__ATOMIC_RELEASE, "wavefront"); __builtin_amdgcn_wave_barrier(); __builtin_amdgcn_fence(__ATOMIC_ACQUIRE, "wavefront");
            const int half = lane >> 5, kk = (lane & 31) * 2;
#pragma unroll 8
            for (int nn = 0; nn < 32; ++nn) {
                const int n = 2 * nn + half; const float a = scr[kk * 65 + n], b = scr[(kk + 1) * 65 + n];
                *(unsigned*)(WT + (size_t)(n0 + n) * 2048 + k0 + kk) = cvt_pk_bf16(a, b);
            }
            __builtin_amdgcn_fence(__ATOMIC_RELEASE, "wavefront"); __builtin_amdgcn_wave_barrier(); __builtin_amdgcn_fence(__ATOMIC_ACQUIRE, "wavefront");
        }
    }
    __syncthreads();
    {
        LAS float* wg = (LAS float*)lds;
        for (int idx = tid; idx < 4096; idx += NTHREADS) {
            const int k = idx >> 1, hf = idx & 1;
            const f32x4 v = *(const f32x4*)(p.w_in + (size_t)k * PROJW + 5120 + hf * 4);
            *(LAS f32x4*)(wg + k * 8 + (k >> 3) * 4 + hf * 4) = v;
        }
        __syncthreads();
        float* IG = (float*)(p.ws + WS_IG); float* LF = (float*)(p.ws + WS_LF);
        for (int row0 = 2 * (blockIdx.x * 8 + wave); row0 < T_TOK; row0 += 2 * gridDim.x * 8) {
            f32x4 xv[2][8];
#pragma unroll
            for (int rr = 0; rr < 2; ++rr) {
                const float* xr = p.x + (size_t)(row0 + rr) * DM;
#pragma unroll
                for (int i = 0; i < 4; ++i) { xv[rr][2 * i] = *(const f32x4*)(xr + i * 512 + lane * 8); xv[rr][2 * i + 1] = *(const f32x4*)(xr + i * 512 + lane * 8 + 4); }
            }
#pragma unroll
            for (int rr = 0; rr < 2; ++rr) {
                const int row = row0 + rr;
                float ss = 0.f;
#pragma unroll
                for (int i = 0; i < 8; ++i) ss += (xv[rr][i][0] * xv[rr][i][0] + xv[rr][i][1] * xv[rr][i][1]) + (xv[rr][i][2] * xv[rr][i][2] + xv[rr][i][3] * xv[rr][i][3]);
                ss = wave_sum(ss);
                const float rstd = rsqrtf(ss * (1.f / 2048.f) + EPS);
                f32x4 ga = {0.f, 0.f, 0.f, 0.f}, gb = {0.f, 0.f, 0.f, 0.f};
#pragma unroll
                for (int i = 0; i < 4; ++i) {
                    const f32x4 g0 = *(const f32x4*)(p.norm1_g + i * 512 + lane * 8), g1 = *(const f32x4*)(p.norm1_g + i * 512 + lane * 8 + 4);
                    const f32x4 h0 = xv[rr][2 * i] * rstd * g0, h1 = xv[rr][2 * i + 1] * rstd * g1;
                    u32x4 w; w.x = cvt_pk_bf16(h0[0], h0[1]); w.y = cvt_pk_bf16(h0[2], h0[3]); w.z = cvt_pk_bf16(h1[0], h1[1]); w.w = cvt_pk_bf16(h1[2], h1[3]);
                    *(u32x4*)(XN + (size_t)row * DM + i * 512 + lane * 8) = w;
                    const LAS float* wb = wg + (i * 512 + lane * 8) * 8 + (i * 64 + lane) * 4;
#pragma unroll
                    for (int e = 0; e < 8; ++e) {
                        const float hv = e < 4 ? h0[e & 3] : h1[e & 3];
                        const f32x4 w0 = *(const LAS f32x4*)(wb + e * 8), w1 = *(const LAS f32x4*)(wb + e * 8 + 4);
                        ga = ga + w0 * hv; gb = gb + w1 * hv;
                    }
                }
                f32x4 m4 = lane < 32 ? ga : gb, s4 = lane < 32 ? gb : ga;
#pragma unroll
                for (int j = 0; j < 4; ++j) m4[j] += __shfl_xor(s4[j], 32);
                const bool up16 = (lane & 16) != 0;
                float m2a = up16 ? m4[2] : m4[0], m2b = up16 ? m4[3] : m4[1];
                const float s2a = up16 ? m4[0] : m4[2], s2b = up16 ? m4[1] : m4[3];
                m2a += __shfl_xor(s2a, 16); m2b += __shfl_xor(s2b, 16);
                const bool up8 = (lane & 8) != 0;
                float m1 = up8 ? m2b : m2a; const float s1 = up8 ? m2a : m2b;
                m1 += __shfl_xor(s1, 8);
                m1 += __shfl_xor(m1, 4); m1 += __shfl_xor(m1, 2); m1 += __shfl_xor(m1, 1);
                const int j = ((lane >> 5) << 2) | (((lane >> 4) & 1) << 1) | ((lane >> 3) & 1);
                if ((lane & 7) == 0) {
                    if (j < 4) IG[(size_t)row * 4 + j] = m1 + p.ml_b_i[j];
                    else { const float z = m1 + p.ml_b_f[j - 4]; LF[(size_t)row * 4 + j - 4] = fminf(z, 0.f) - log1pf(__expf(-fabsf(z))); }
                }
            }
        }
    }
    {
        const size_t nthr = (size_t)gridDim.x * NTHREADS, NQ = (size_t)16384 * 512;
        for (size_t base = (size_t)blockIdx.x * NTHREADS + tid; base < 2 * NQ; base += 4 * nthr) {
            f32x4 v[4];
#pragma unroll
            for (int u = 0; u < 4; ++u) {
                size_t i = base + u * nthr; if (i >= 2 * NQ) i = base;
                const int which = i >= NQ; const size_t j = i - (which ? NQ : 0);
                v[u] = *(const f32x4*)((which ? p.peer_v : p.peer_u) + j * 4);
            }
#pragma unroll
            for (int u = 0; u < 4; ++u) {
                size_t i = base + u * nthr; if (i >= 2 * NQ) i = base;
                const int which = i >= NQ; const size_t j = i - (which ? NQ : 0);
                const int row = (int)(j >> 9), c4 = (int)(j & 511);
                float amax = fmaxf(fmaxf(fabsf(v[u][0]), fabsf(v[u][1])), fmaxf(fabsf(v[u][2]), fabsf(v[u][3])));
                amax = fmaxf(amax, __uint_as_float((unsigned)__builtin_amdgcn_update_dpp(0, (int)__float_as_uint(amax), 0xB1, 0xF, 0xF, true)));
                amax = fmaxf(amax, __uint_as_float((unsigned)__builtin_amdgcn_update_dpp(0, (int)__float_as_uint(amax), 0x4E, 0xF, 0xF, true)));
                amax = fmaxf(amax, __uint_as_float((unsigned)__builtin_amdgcn_update_dpp(0, (int)__float_as_uint(amax), 0x141, 0xF, 0xF, true)));
                const unsigned sb = cvt_pk_bf16(amax * (1.f / 6.f), 0.f) & 0xffffu;
                float sc = bflo(sb); if (sc == 0.f) sc = 1.f;
                const float inv = 1.f / sc;
                unsigned r = 0u;
                r = __builtin_amdgcn_cvt_scalef32_pk_fp4_f32(r, v[u][0] * inv, v[u][1] * inv, 1.0f, 0);
                r = __builtin_amdgcn_cvt_scalef32_pk_fp4_f32(r, v[u][2] * inv, v[u][3] * inv, 1.0f, 1);
                unsigned char* dst = p.ws + (which ? WS_VB : WS_UB) + (size_t)row * 1152;
                *(unsigned short*)(dst + c4 * 2) = (unsigned short)(r & 0xffffu);
                if ((c4 & 7) == 0) *(unsigned short*)(dst + 1024 + (c4 >> 3) * 2) = (unsigned short)(sb == 0u ? 0x3F80u : sb);
            }
        }
    }
    {
        bf16_t* KB1 = (bf16_t*)(p.ws + WS_KB1); bf16_t* KB2 = (bf16_t*)(p.ws + WS_KB2);
        for (int i = blockIdx.x * NTHREADS + tid; i < 65536 / 4; i += gridDim.x * NTHREADS) {
            const f32x4 a = *(const f32x4*)(p.peer_k1 + i * 4), b = *(const f32x4*)(p.peer_k2 + i * 4);
            u32x2 w; w.x = cvt_pk_bf16(a[0], a[1]); w.y = cvt_pk_bf16(a[2], a[3]); *(u32x2*)(KB1 + i * 4) = w;
            w.x = cvt_pk_bf16(b[0], b[1]); w.y = cvt_pk_bf16(b[2], b[3]); *(u32x2*)(KB2 + i * 4) = w;
        }
    }
}

#define WAVE_LDS_SYNC() do { __builtin_amdgcn_fence(__ATOMIC_RELEASE, "wavefront"); __builtin_amdgcn_wave_barrier(); __builtin_amdgcn_fence(__ATOMIC_ACQUIRE, "wavefront"); } while (0)

template <int NG> DI void stage_T_load(const bf16_t* src, int ld, u32x4 (&r0)[NG], u32x4 (&r1)[NG], int wave, int lane) {
#pragma unroll
    for (int i = 0; i < NG; ++i) {
        const int g = wave + 8 * i;
        r0[i] = *(const u32x4*)(src + (size_t)(2 * lane) * ld + g * 8);
        r1[i] = *(const u32x4*)(src + (size_t)(2 * lane + 1) * ld + g * 8);
    }
}
template <int NG> DI void stage_T_store(const u32x4 (&r0)[NG], const u32x4 (&r1)[NG], LAS unsigned char* dst, int wave, int lane) {
#pragma unroll
    for (int i = 0; i < NG; ++i) {
        const int g = wave + 8 * i;
#pragma unroll
        for (int w = 0; w < 4; ++w) {
            const unsigned a = r0[i][w], b = r1[i][w];
            *(LAS unsigned*)(dst + (g * 8 + 2 * w) * 272 + lane * 4) = (a & 0xffffu) | (b << 16);
            *(LAS unsigned*)(dst + (g * 8 + 2 * w + 1) * 272 + lane * 4) = (a >> 16) | (b & 0xffff0000u);
        }
    }
}
template <int NG> DI void stage_T(const bf16_t* src, int ld, LAS unsigned char* dst, int wave, int lane) {
    u32x4 r0[NG], r1[NG];
    stage_T_load<NG>(src, ld, r0, r1, wave, lane);
    stage_T_store<NG>(r0, r1, dst, wave, lane);
}

DI void gmlp_bc(const Params& p, LAS unsigned char* lds, int b, int c) {
    const int tid = threadIdx.x, lane = tid & 63, wave = __builtin_amdgcn_readfirstlane(tid >> 6), fr = lane & 15, fq = lane >> 4;
    const int t0 = b * 8192 + c * 128;
    LAS unsigned char* Wl = lds; LAS unsigned char* GvT = lds + 34816; LAS float* rstdv = (LAS float*)(lds + 69632);
    const bf16_t* P = (const bf16_t*)(p.ws + WS_P); bf16_t* YM = (bf16_t*)(p.ws + WS_XN);
    const float* PSSV = (const float*)(p.ws + WS_PSSV);
    __syncthreads();
    if (tid < 128) {
        float ss = 0.f;
#pragma unroll
        for (int i = 0; i < 4; ++i) { const f32x4 v = *(const f32x4*)(PSSV + (size_t)(t0 + tid) * 16 + i * 4); ss += (v[0] + v[1]) + (v[2] + v[3]); }
        rstdv[tid] = rsqrtf(ss * (1.f / 1024.f) + EPS);
    }
    f32x4 wa[4][2]; u32x4 gr0[2], gr1[2];
#define GMLP_PREFETCH(hh) do { _Pragma("unroll") for (int it = 0; it < 4; ++it) { const int e = (it * NTHREADS + tid) * 8, t = e >> 7, s0 = e & 127; \
            const float* wp = p.w_spatial + ((size_t)((hh) * 128 + t)) * 128 + s0; wa[it][0] = *(const f32x4*)wp; wa[it][1] = *(const f32x4*)(wp + 4); } \
        stage_T_load<2>(P + p_off<1024, 8, 128>(t0, (hh), 0), 128, gr0, gr1, wave, lane); } while (0)
    GMLP_PREFETCH(0);
    for (int h = 0; h < 8; ++h) {
        __syncthreads();
#pragma unroll
        for (int it = 0; it < 4; ++it) {
            const int e = (it * NTHREADS + tid) * 8, t = e >> 7, s0 = e & 127;
            float v[8];
#pragma unroll
            for (int j = 0; j < 8; ++j) { const float a = j < 4 ? wa[it][0][j & 3] : wa[it][1][j & 3]; v[j] = (s0 + j <= t) ? a * rstdv[s0 + j] : 0.f; }
            u32x4 w; w.x = cvt_pk_bf16(v[0], v[1]); w.y = cvt_pk_bf16(v[2], v[3]); w.z = cvt_pk_bf16(v[4], v[5]); w.w = cvt_pk_bf16(v[6], v[7]);
            *(LAS u32x4*)(Wl + t * 272 + s0 * 2) = w;
        }
        stage_T_store<2>(gr0, gr1, GvT, wave, lane);
        __syncthreads();
        if (h + 1 < 8) GMLP_PREFETCH(h + 1);
        f32x4 acc[8];
#pragma unroll
        for (int n = 0; n < 8; ++n) acc[n] = (f32x4){0.f, 0.f, 0.f, 0.f};
        const int kmax = (16 * wave + 15) >> 5;
#pragma unroll
        for (int kk = 0; kk < 4; ++kk) {
            if (kk <= kmax) {
                const bf16x8 bfrag = ld_frag_lds(Wl + (16 * wave + fr) * 272 + (32 * kk + 8 * fq) * 2);
#pragma unroll
                for (int n = 0; n < 8; ++n) { const bf16x8 afrag = ld_frag_lds(GvT + (16 * n + fr) * 272 + (32 * kk + 8 * fq) * 2); acc[n] = MFMA16(afrag, bfrag, acc[n]); }
            }
        }
        const int t = 16 * wave + fr; const size_t grow = (size_t)(t0 + t);
        const float bsp = p.b_spatial[h * 128 + t];
        float ss = 0.f;
#pragma unroll
        for (int n = 0; n < 8; ++n) {
            const int d0 = 16 * n + 4 * fq;
            const u32x2 uw = *(const u32x2*)(P + p_off<0, 8, 128>(t0 + t, h, d0));
            const f32x4 gv = *(const f32x4*)(p.gm_vnorm_g + h * 128 + d0);
            f32x4 y;
            y[0] = bflo(uw.x) * (gv[0] * acc[n][0] + bsp); y[1] = bfhi(uw.x) * (gv[1] * acc[n][1] + bsp);
            y[2] = bflo(uw.y) * (gv[2] * acc[n][2] + bsp); y[3] = bfhi(uw.y) * (gv[3] * acc[n][3] + bsp);
            ss += (y[0] * y[0] + y[1] * y[1]) + (y[2] * y[2] + y[3] * y[3]);
            acc[n] = y;
        }
        ss += __shfl_xor(ss, 16); ss += __shfl_xor(ss, 32);
        const float rstd = rsqrtf(ss * (1.f / 128.f) + EPS);
#pragma unroll
        for (int n = 0; n < 8; ++n) {
            const int d0 = 16 * n + 4 * fq;
            const f32x4 g = *(const f32x4*)(p.gm_out_g + h * 128 + d0);
            const f32x4 o = acc[n] * rstd * g;
            u32x2 w; w.x = cvt_pk_bf16(o[0], o[1]); w.y = cvt_pk_bf16(o[2], o[3]);
            *(u32x2*)(YM + grow * DM + h * 128 + d0) = w;
        }
    }
}

DI void mlstm_local(const Params& p, LAS unsigned char* lds, int b, int c, int h) {
    const int tid = threadIdx.x, lane = tid & 63, wave = __builtin_amdgcn_readfirstlane(tid >> 6), fr = lane & 15, fq = lane >> 4;
    const int bh = b * 4 + h, t0 = b * 8192 + c * 128;
    LAS unsigned char* KT = lds; LAS unsigned char* VT = lds + 34816; LAS float* wsv = (LAS float*)(lds + 108800);
    const bf16_t* P = (const bf16_t*)(p.ws + WS_P);
    bf16_t* QC = (bf16_t*)(p.ws + WS_QC); bf16_t* KC = (bf16_t*)(p.ws + WS_KC);
    const float* IG = (const float*)(p.ws + WS_IG); const float* LF = (const float*)(p.ws + WS_LF);
    LAS float* cwl = (LAS float*)(lds + 109312);
    __syncthreads();
    u32x4 xw[2][5];
#define CONV_LOAD(half) do { _Pragma("unroll") for (int gi = 0; gi < 2; ++gi) { const int g = wave + 8 * (gi + 2 * (half)); const int cgp = (g & 15) * 8; \
        _Pragma("unroll") for (int dj = 0; dj < 5; ++dj) { const int srow = 2 * lane - 3 + dj; xw[gi][dj] = (u32x4){0u, 0u, 0u, 0u}; \
            if (c > 0 || srow >= 0) xw[gi][dj] = *(const u32x4*)(P + ((half) ? p_off<2560, 4, 128>(t0 + srow, h, cgp) : p_off<2048, 4, 128>(t0 + srow, h, cgp))); } } } while (0)
    CONV_LOAD(0);
    for (int idx = tid; idx < 1280; idx += NTHREADS) {
        const int j = idx >> 8, cc = idx & 255, ch = (cc >= 128 ? 512 : 0) + h * 128 + (cc & 127);
        cwl[idx] = j < 4 ? p.ml_conv_w[j * 1024 + ch] : p.ml_conv_b[ch];
    }
    if (wave == 0) {
        const float l0 = LF[(size_t)(t0 + 2 * lane) * 4 + h], l1 = LF[(size_t)(t0 + 2 * lane + 1) * 4 + h];
        const float i0 = IG[(size_t)(t0 + 2 * lane) * 4 + h], i1 = IG[(size_t)(t0 + 2 * lane + 1) * 4 + h];
        float s = l0 + l1;
#pragma unroll
        for (int off = 1; off < 64; off <<= 1) { const float tt = __shfl_up(s, off); if (lane >= off) s += tt; }
        const float b1 = s, b0 = s - l1, bend = __shfl(s, 63);
        const float g0 = bend - b0 + i0, g1 = bend - b1 + i1;
        const float gmax = wave_max(fmaxf(g0, g1));
        wsv[2 * lane] = __expf(g0 - gmax); wsv[2 * lane + 1] = __expf(g1 - gmax);
        if (lane == 0) { ((float*)(p.ws + WS_BEND))[bh * 64 + c] = bend; ((float*)(p.ws + WS_GMAX))[bh * 64 + c] = gmax; }
    }
    __syncthreads();
#pragma unroll
    for (int gi4 = 0; gi4 < 4; ++gi4) {
        const int gi = gi4 & 1;
        if (gi4 == 2) CONV_LOAD(1);
        const int g = wave + 8 * gi4; const bool isk = gi4 >= 2; const int cgp = (g & 15) * 8;
        const int cc0 = (isk ? 128 : 0) + cgp;
        const int s = 2 * lane;
        float y0[8], y1[8];
        {
            const f32x4 cb0 = *(const LAS f32x4*)(cwl + 1024 + cc0), cb1 = *(const LAS f32x4*)(cwl + 1024 + cc0 + 4);
#pragma unroll
            for (int e = 0; e < 8; ++e) { y0[e] = e < 4 ? cb0[e & 3] : cb1[e & 3]; y1[e] = y0[e]; }
#pragma unroll
            for (int j = 0; j < 5; ++j) {
                float xr[8];
#pragma unroll
                for (int q = 0; q < 4; ++q) { xr[2 * q] = bflo(xw[gi][j][q]); xr[2 * q + 1] = bfhi(xw[gi][j][q]); }
                if (j < 4) {
                    const f32x4 w0 = *(const LAS f32x4*)(cwl + j * 256 + cc0), w1 = *(const LAS f32x4*)(cwl + j * 256 + cc0 + 4);
#pragma unroll
                    for (int e = 0; e < 8; ++e) y0[e] += (e < 4 ? w0[e & 3] : w1[e & 3]) * xr[e];
                }
                if (j > 0) {
                    const f32x4 w0 = *(const LAS f32x4*)(cwl + (j - 1) * 256 + cc0), w1 = *(const LAS f32x4*)(cwl + (j - 1) * 256 + cc0 + 4);
#pragma unroll
                    for (int e = 0; e < 8; ++e) y1[e] += (e < 4 ? w0[e & 3] : w1[e & 3]) * xr[e];
                }
            }
        }
        const float sc = isk ? 0.08838834764831845f : 1.f;
#pragma unroll
        for (int e = 0; e < 8; ++e) { y0[e] = y0[e] * sigmoid_(y0[e]) * sc; y1[e] = y1[e] * sigmoid_(y1[e]) * sc; }
        bf16_t* dst = (isk ? KC : QC) + (size_t)(t0 + s) * 512 + h * 128 + cgp;
        u32x4 w; w.x = cvt_pk_bf16(y0[0], y0[1]); w.y = cvt_pk_bf16(y0[2], y0[3]); w.z = cvt_pk_bf16(y0[4], y0[5]); w.w = cvt_pk_bf16(y0[6], y0[7]);
        *(u32x4*)dst = w;
        w.x = cvt_pk_bf16(y1[0], y1[1]); w.y = cvt_pk_bf16(y1[2], y1[3]); w.z = cvt_pk_bf16(y1[4], y1[5]); w.w = cvt_pk_bf16(y1[6], y1[7]);
        *(u32x4*)(dst + 512) = w;
        if (isk) {
            const float w0 = wsv[s], w1 = wsv[s + 1];
#pragma unroll
            for (int e = 0; e < 8; ++e) *(LAS unsigned*)(KT + (cgp + e) * 272 + lane * 4) = cvt_pk_bf16(y0[e] * w0, y1[e] * w1);
        }
    }
    stage_T<4>(P + p_off<3072, 4, 256>(t0, h, 0), 256, VT, wave, lane);
    for (int i = tid; i < 1024; i += NTHREADS) { const int r = i >> 6, w = i & 63; *(LAS unsigned*)(VT + (256 + r) * 272 + w * 4) = 0x3F803F80u; }
    __syncthreads();
    bf16x8 af[4];
#pragma unroll
    for (int kk = 0; kk < 4; ++kk) af[kk] = ld_frag_lds(KT + (16 * wave + fr) * 272 + (32 * kk + 8 * fq) * 2);
    float* ST = (float*)(p.ws + WS_ST) + ((size_t)(bh * 64 + c) * 272) * 128;
#pragma unroll
    for (int n = 0; n < 17; ++n) {
        f32x4 acc = {0.f, 0.f, 0.f, 0.f};
#pragma unroll
        for (int kk = 0; kk < 4; ++kk) { const bf16x8 bfr = ld_frag_lds(VT + (16 * n + fr) * 272 + (32 * kk + 8 * fq) * 2); acc = MFMA16(af[kk], bfr, acc); }
        if (n < 16 || fr == 0) *(f32x4*)(ST + (size_t)(16 * n + fr) * 128 + 16 * wave + 4 * fq) = acc;
    }
}

DI void phase_scan(const Params& p) {
    const float* ST = (const float*)(p.ws + WS_ST); bf16_t* CPT = (bf16_t*)(p.ws + WS_CPT);
    const float* BEND = (const float*)(p.ws + WS_BEND); const float* GMAX = (const float*)(p.ws + WS_GMAX); float* MPREV = (float*)(p.ws + WS_MPREV);
    const int gtid = blockIdx.x * NTHREADS + threadIdx.x, nthr = gridDim.x * NTHREADS;
    constexpr int PER = 8224;
    constexpr size_t CST = 272 * 128;
    for (int item = gtid; item < 16 * PER; item += nthr) {
        const int bh = item / PER, e4 = item - bh * PER;
        const float* src = ST + (size_t)bh * 64 * CST + (size_t)e4 * 4;
        bf16_t* dst = CPT + (size_t)bh * 64 * CST + (size_t)e4 * 4;
        f32x4 st = {0.f, 0.f, 0.f, 0.f}; float m = 0.f;
        for (int c0 = 0; c0 < 64; c0 += 8) {
            f32x4 d[8];
#pragma unroll
            for (int j = 0; j < 8; ++j) d[j] = *(const f32x4*)(src + (size_t)(c0 + j) * CST);
#pragma unroll
            for (int j = 0; j < 8; ++j) {
                const int c = c0 + j;
                const float be = BEND[bh * 64 + c], gm = GMAX[bh * 64 + c];
                const float mn = fmaxf(be + m, gm), a = __expf(be + m - mn), sc = __expf(gm - mn);
                u32x2 w; w.x = cvt_pk_bf16(st[0], st[1]); w.y = cvt_pk_bf16(st[2], st[3]);
                *(u32x2*)(dst + (size_t)c * CST) = w;
                if (e4 == 0) MPREV[bh * 64 + c] = m;
                st = st * a + d[j] * sc; m = mn;
            }
        }
    }
}

DI void mlstm_out(const Params& p, LAS unsigned char* lds, int b, int c, int h) {
    const int tid = threadIdx.x, lane = tid & 63, wave = __builtin_amdgcn_readfirstlane(tid >> 6), fr = lane & 15, fq = lane >> 4;
    const int bh = b * 4 + h, t0 = b * 8192 + c * 128;
    LAS unsigned char* Kl = lds; LAS unsigned char* Sl = lds + 34816; LAS unsigned char* VTe = lds + 69632;
    LAS float* av = (LAS float*)(lds + 143616); LAS float* Mv = (LAS float*)(lds + 144128); LAS float* bv = (LAS float*)(lds + 144640);
    const bf16_t* P = (const bf16_t*)(p.ws + WS_P); bf16_t* YM = (bf16_t*)(p.ws + WS_XN);
    const bf16_t* QC = (const bf16_t*)(p.ws + WS_QC); const bf16_t* KC = (const bf16_t*)(p.ws + WS_KC);
    const float* IG = (const float*)(p.ws + WS_IG); const float* LF = (const float*)(p.ws + WS_LF);
    const float mprev = ((const float*)(p.ws + WS_MPREV))[bh * 64 + c];
    __syncthreads();
    if (wave == 0) {
        const float l0 = LF[(size_t)(t0 + 2 * lane) * 4 + h], l1 = LF[(size_t)(t0 + 2 * lane + 1) * 4 + h];
        const float i0 = IG[(size_t)(t0 + 2 * lane) * 4 + h], i1 = IG[(size_t)(t0 + 2 * lane + 1) * 4 + h];
        float s = l0 + l1;
#pragma unroll
        for (int off = 1; off < 64; off <<= 1) { const float tt = __shfl_up(s, off); if (lane >= off) s += tt; }
        const float b1 = s, b0 = s - l1;
        const float a0 = i0 - b0, a1 = i1 - b1;
        float pm = fmaxf(a0, a1);
#pragma unroll
        for (int off = 1; off < 64; off <<= 1) { const float tt = __shfl_up(pm, off); if (lane >= off) pm = fmaxf(pm, tt); }
        float ex = __shfl_up(pm, 1); if (lane == 0) ex = -3.0e38f;
        Mv[2 * lane] = fmaxf(mprev, fmaxf(ex, a0)); Mv[2 * lane + 1] = fmaxf(mprev, pm);
        av[2 * lane] = a0; av[2 * lane + 1] = a1; bv[2 * lane] = b0; bv[2 * lane + 1] = b1;
    }
#pragma unroll
    for (int it = 0; it < 4; ++it) {
        const int e = (it * NTHREADS + tid) * 8, s = e >> 7, d0 = e & 127;
        *(LAS u32x4*)(Kl + s * 272 + d0 * 2) = *(const u32x4*)(KC + (size_t)(t0 + s) * 512 + h * 128 + d0);
    }
    stage_T<4>(P + p_off<3072, 4, 256>(t0, h, 0), 256, VTe, wave, lane);
    for (int i = tid; i < 1024; i += NTHREADS) { const int r = i >> 6, w = i & 63; *(LAS unsigned*)(VTe + (256 + r) * 272 + w * 4) = 0x3F803F80u; }
    bf16x8 qf[4];
#pragma unroll
    for (int kk = 0; kk < 4; ++kk) qf[kk] = *(const bf16x8*)(QC + (size_t)(t0 + 16 * wave + fr) * 512 + h * 128 + 32 * kk + 8 * fq);
    __syncthreads();
    const int t = 16 * wave + fr; const float Mt = Mv[t];
    const int stmax = wave | 1;
    for (int st = 0; st <= stmax; ++st) {
        f32x4 s4 = {0.f, 0.f, 0.f, 0.f};
#pragma unroll
        for (int kk = 0; kk < 4; ++kk) { const bf16x8 kf = ld_frag_lds(Kl + (16 * st + fr) * 272 + (32 * kk + 8 * fq) * 2); s4 = MFMA16(kf, qf[kk], s4); }
#pragma unroll
        for (int r = 0; r < 4; ++r) { const int s = 16 * st + 4 * fq + r; const float w = (s <= t) ? __expf(av[s] - Mt) : 0.f; s4[r] *= w; }
        u32x2 w; w.x = cvt_pk_bf16(s4[0], s4[1]); w.y = cvt_pk_bf16(s4[2], s4[3]);
        *(LAS u32x2*)(Sl + t * 272 + (16 * st + 4 * fq) * 2) = w;
    }
    __syncthreads();
    const bf16_t* cpt = (const bf16_t*)(p.ws + WS_CPT) + ((size_t)(bh * 64 + c) * 272) * 128;
    f32x4 acc[17];
#pragma unroll
    for (int n = 0; n < 17; ++n) {
        acc[n] = (f32x4){0.f, 0.f, 0.f, 0.f};
#pragma unroll
        for (int kk = 0; kk < 4; ++kk) { const bf16x8 cf = *(const bf16x8*)(cpt + (size_t)(16 * n + fr) * 128 + 32 * kk + 8 * fq); acc[n] = MFMA16(cf, qf[kk], acc[n]); }
    }
    const float ai = __expf(mprev - Mt);
#pragma unroll
    for (int n = 0; n < 17; ++n) acc[n] = acc[n] * ai;
    const int k2max = (16 * wave + 15) >> 5;
#pragma unroll
    for (int kk = 0; kk < 4; ++kk) {
        if (kk <= k2max) {
            const bf16x8 sf = ld_frag_lds(Sl + t * 272 + (32 * kk + 8 * fq) * 2);
#pragma unroll
            for (int n = 0; n < 17; ++n) { const bf16x8 vf = ld_frag_lds(VTe + (16 * n + fr) * 272 + (32 * kk + 8 * fq) * 2); acc[n] = MFMA16(vf, sf, acc[n]); }
        }
    }
    const float den = __shfl(acc[16][0], fr);
    const float mt = bv[t] + Mt;
    const float inv = rcpf_(fmaxf(fabsf(den), __expf(-mt)));
    const size_t grow = (size_t)(t0 + t);
    float ss = 0.f;
#pragma unroll
    for (int n = 0; n < 16; ++n) {
        const int v0 = 16 * n + 4 * fq;
        const u32x2 ow = *(const u32x2*)(P + p_off<4096, 4, 256>(t0 + t, h, v0));
        f32x4 y;
        y[0] = bflo(ow.x) * acc[n][0] * inv; y[1] = bfhi(ow.x) * acc[n][1] * inv; y[2] = bflo(ow.y) * acc[n][2] * inv; y[3] = bfhi(ow.y) * acc[n][3] * inv;
        ss += (y[0] * y[0] + y[1] * y[1]) + (y[2] * y[2] + y[3] * y[3]);
        acc[n] = y;
    }
    ss += __shfl_xor(ss, 16); ss += __shfl_xor(ss, 32);
    const float rstd = rsqrtf(ss * (1.f / 256.f) + EPS);
#pragma unroll
    for (int n = 0; n < 16; ++n) {
        const int v0 = 16 * n + 4 * fq;
        const f32x4 g = *(const f32x4*)(p.ml_out_g + h * 256 + v0);
        const f32x4 o = acc[n] * rstd * g;
        u32x2 w; w.x = cvt_pk_bf16(o[0], o[1]); w.y = cvt_pk_bf16(o[2], o[3]);
        *(u32x2*)(YM + grow * DM + 1024 + h * 256 + v0) = w;
    }
}

DI unsigned ord_key(float f) { const unsigned u = __float_as_uint(f); return (u & 0x80000000u) ? ~u : (u | 0x80000000u); }
DI float key_val(unsigned k) { return (k & 0x80000000u) ? __uint_as_float(k & 0x7fffffffu) : __uint_as_float(~k); }
DI unsigned umax_(unsigned a, unsigned b) { return a > b ? a : b; }
DI unsigned umin_(unsigned a, unsigned b) { return a < b ? a : b; }
#define DPPU(v, ctrl) ((unsigned)__builtin_amdgcn_update_dpp(0, (int)(v), (ctrl), 0xF, 0xF, true))
DI unsigned row_max_u32(unsigned v) {
    v = umax_(v, DPPU(v, 0xB1)); v = umax_(v, DPPU(v, 0x4E)); v = umax_(v, DPPU(v, 0x141)); v = umax_(v, DPPU(v, 0x140)); return v;
}
DI float row_sum_f32(float v) {
    v += __uint_as_float(DPPU(__float_as_uint(v), 0xB1)); v += __uint_as_float(DPPU(__float_as_uint(v), 0x4E));
    v += __uint_as_float(DPPU(__float_as_uint(v), 0x141)); v += __uint_as_float(DPPU(__float_as_uint(v), 0x140)); return v;
}
#define CEX(a, b) do { const unsigned mx_ = umax_(a, b), mn_ = umin_(a, b); a = mx_; b = mn_; } while (0)
template <int N> DI unsigned top16_row(unsigned (&s)[N], int c) {
    unsigned list = 0u;
#pragma unroll 1
    for (int it = 0; it < 16; ++it) {
        const unsigned wm = row_max_u32(s[0]);
        const bool win = (s[0] == wm);
#pragma unroll
        for (int i = 0; i < N - 1; ++i) s[i] = win ? s[i + 1] : s[i];
        s[N - 1] = win ? 0u : s[N - 1];
        list = (c == it) ? wm : list;
    }
    return list;
}

DI void peer_select(const Params& p) {
    const int tid = threadIdx.x, lane = tid & 63, wave = __builtin_amdgcn_readfirstlane(tid >> 6), c = lane & 15, g = lane >> 4, rowbase = lane & 48;
    const bf16_t* Q = (const bf16_t*)(p.ws + WS_Q); const bf16_t* KB1 = (const bf16_t*)(p.ws + WS_KB1); const bf16_t* KB2 = (const bf16_t*)(p.ws + WS_KB2);
    int* SELID = (int*)(p.ws + WS_SELID); float* SELG = (float*)(p.ws + WS_SELG);
    unsigned pk = 0u, validmask = 0u;
#pragma unroll
    for (int q = 0; q < 4; ++q) {
        const int target = 4 * c + q; int ci = 0, cj = 0, cnt = 0; bool v = false;
#pragma unroll
        for (int i = 0; i < 16; ++i) { const int nj = 16 / (i + 1); if (target >= cnt && target < cnt + nj) { ci = i; cj = target - cnt; v = true; } cnt += nj; }
        pk |= (unsigned)((ci << 4) | cj) << (8 * q); validmask |= (v ? 1u : 0u) << q;
    }
    for (int tile = blockIdx.x * 8 + wave; tile < T_TOK / 16; tile += gridDim.x * 8) {
        const int tok0 = tile * 16;
        for (int h = 0; h < 8; ++h) {
            bf16x8 a1[2], a2[2];
            {
                const bf16_t* qp = Q + (size_t)(tok0 + c) * 1024 + h * 128 + g * 8;
                a1[0] = *(const bf16x8*)qp; a1[1] = *(const bf16x8*)(qp + 32); a2[0] = *(const bf16x8*)(qp + 64); a2[1] = *(const bf16x8*)(qp + 96);
            }
            f32x4 acc1[8], acc2[8];
#pragma unroll
            for (int nt = 0; nt < 8; ++nt) {
                const size_t ko = ((size_t)(h * 128 + nt * 16 + c)) * 64 + g * 8;
                acc1[nt] = (f32x4){0.f, 0.f, 0.f, 0.f}; acc2[nt] = (f32x4){0.f, 0.f, 0.f, 0.f};
                acc1[nt] = MFMA16(a1[0], *(const bf16x8*)(KB1 + ko), acc1[nt]); acc1[nt] = MFMA16(a1[1], *(const bf16x8*)(KB1 + ko + 32), acc1[nt]);
                acc2[nt] = MFMA16(a2[0], *(const bf16x8*)(KB2 + ko), acc2[nt]); acc2[nt] = MFMA16(a2[1], *(const bf16x8*)(KB2 + ko + 32), acc2[nt]);
            }
#pragma unroll
            for (int r = 0; r < 4; ++r) {
                unsigned s[8];
#pragma unroll
                for (int nt = 0; nt < 8; ++nt) s[nt] = (ord_key(acc1[nt][r]) & ~0x7Fu) | (unsigned)(127 - (nt * 16 + c));
                CEX(s[0], s[1]); CEX(s[2], s[3]); CEX(s[4], s[5]); CEX(s[6], s[7]); CEX(s[0], s[2]); CEX(s[1], s[3]); CEX(s[4], s[6]); CEX(s[5], s[7]); CEX(s[1], s[2]); CEX(s[5], s[6]);
                CEX(s[0], s[4]); CEX(s[1], s[5]); CEX(s[2], s[6]); CEX(s[3], s[7]); CEX(s[2], s[4]); CEX(s[3], s[5]); CEX(s[1], s[2]); CEX(s[3], s[4]); CEX(s[5], s[6]);
                const unsigned list1 = top16_row<8>(s, c);
#pragma unroll
                for (int nt = 0; nt < 8; ++nt) s[nt] = (ord_key(acc2[nt][r]) & ~0x7Fu) | (unsigned)(127 - (nt * 16 + c));
                CEX(s[0], s[1]); CEX(s[2], s[3]); CEX(s[4], s[5]); CEX(s[6], s[7]); CEX(s[0], s[2]); CEX(s[1], s[3]); CEX(s[4], s[6]); CEX(s[5], s[7]); CEX(s[1], s[2]); CEX(s[5], s[6]);
                CEX(s[0], s[4]); CEX(s[1], s[5]); CEX(s[2], s[6]); CEX(s[3], s[7]); CEX(s[2], s[4]); CEX(s[3], s[5]); CEX(s[1], s[2]); CEX(s[3], s[4]); CEX(s[5], s[6]);
                const unsigned list2 = top16_row<8>(s, c);
                unsigned cs[4];
#pragma unroll
                for (int q = 0; q < 4; ++q) {
                    const int ci = (int)((pk >> (8 * q + 4)) & 15u), cj = (int)((pk >> (8 * q)) & 15u);
                    const unsigned k1 = (unsigned)__shfl((int)list1, rowbase + ci), k2 = (unsigned)__shfl((int)list2, rowbase + cj);
                    const float cand = key_val(k1 & ~0x7Fu) + key_val(k2 & ~0x7Fu);
                    cs[q] = ((validmask >> q) & 1u) ? ((ord_key(cand) & ~0x3Fu) | (unsigned)(63 - (4 * c + q))) : 0u;
                }
                CEX(cs[0], cs[1]); CEX(cs[2], cs[3]); CEX(cs[0], cs[2]); CEX(cs[1], cs[3]); CEX(cs[1], cs[2]);
                const unsigned sel = top16_row<4>(cs, c);
                const int slot = 63 - (int)(sel & 63u);
                const unsigned pkv = (unsigned)__shfl((int)pk, rowbase + (slot >> 2));
                const int cij = (int)((pkv >> (8 * (slot & 3))) & 0xFFu);
                const unsigned e1 = (unsigned)__shfl((int)list1, rowbase + (cij >> 4)), e2 = (unsigned)__shfl((int)list2, rowbase + (cij & 15));
                const int eid = (127 - (int)(e1 & 127u)) * 128 + (127 - (int)(e2 & 127u));
                const float sv = key_val(sel & ~0x3Fu), mx = key_val(row_max_u32(sel) & ~0x3Fu);
                const float ev = __expf(sv - mx);
                const float sum = row_sum_f32(ev);
                const size_t o = (size_t)(tok0 + 4 * g + r) * 128 + h * 16 + c;
                SELID[o] = eid; SELG[o] = ev * rcpf_(sum);
            }
        }
    }
}

DI f32x2 pkfma(f32x2 a, f32x2 b, f32x2 c) { return __builtin_elementwise_fma(a, b, c); }
DI void peer_gather(const Params& p, LAS unsigned char* lds) {
    const int tid = threadIdx.x, lane = tid & 63, wave = __builtin_amdgcn_readfirstlane(tid >> 6);
    LAS float* scr = (LAS float*)lds + wave * (16 * 68);
    LAS float* cfl = (LAS float*)(lds + 8 * 16 * 68 * 4) + wave * 128;
    const unsigned char* Ub = p.ws + WS_UB; const unsigned char* Vb = p.ws + WS_VB;
    const float* PSS2 = (const float*)(p.ws + WS_PSS2);
    const int* SELID = (const int*)(p.ws + WS_SELID); const float* SELG = (const float*)(p.ws + WS_SELG);
    const int gw = blockIdx.x * 8 + wave, nw = gridDim.x * 8;
    for (int t = gw; t < T_TOK; t += nw) {
        const int idA = SELID[(size_t)t * 128 + lane], idB = SELID[(size_t)t * 128 + 64 + lane];
        const float gA = SELG[(size_t)t * 128 + lane], gB = SELG[(size_t)t * 128 + 64 + lane];
        const bf16_t* xrow = (const bf16_t*)(p.ws + WS_X1G) + (size_t)t * DM + lane * 32;
        float* orow = p.out + (size_t)t * DM + lane * 32;
        const float pv = lane < 32 ? PSS2[(size_t)t * 32 + lane] : 0.f;
        const float rstd2 = rsqrtf(wave_sum(pv) * (1.f / 2048.f) + EPS);
        f32x2 h2[16];
#pragma unroll
        for (int q = 0; q < 4; ++q) {
            const u32x4 xw = *(const u32x4*)(xrow + q * 8);
            const f32x4 g0 = *(const f32x4*)(p.norm2_g + lane * 32 + q * 8), g1 = *(const f32x4*)(p.norm2_g + lane * 32 + q * 8 + 4);
            h2[4 * q] = (f32x2){bflo(xw.x) * rstd2 * g0[0], bfhi(xw.x) * rstd2 * g0[1]};
            h2[4 * q + 1] = (f32x2){bflo(xw.y) * rstd2 * g0[2], bfhi(xw.y) * rstd2 * g0[3]};
            h2[4 * q + 2] = (f32x2){bflo(xw.z) * rstd2 * g1[0], bfhi(xw.z) * rstd2 * g1[1]};
            h2[4 * q + 3] = (f32x2){bflo(xw.w) * rstd2 * g1[2], bfhi(xw.w) * rstd2 * g1[3]};
        }
        constexpr int NPK = 8;
        u32x4 buf[2][NPK]; unsigned short bsc[2][NPK];
#define PEER_LOAD(TB, st, base) do { const int idv_ = ((base) < 64) ? idA : idB; _Pragma("unroll") for (int e_ = 0; e_ < NPK; ++e_) { \
            const int id_ = __builtin_amdgcn_readlane(idv_, ((base) + e_) & 63); const unsigned char* r_ = (TB) + (size_t)id_ * 1152; \
            buf[st][e_] = *(const u32x4*)(r_ + lane * 16); bsc[st][e_] = *(const unsigned short*)(r_ + 1024 + lane * 2); } } while (0)
#define PEER_DOT(st, slot0) do { _Pragma("unroll") for (int e_ = 0; e_ < NPK; ++e_) { f32x2 a2_ = {0.f, 0.f}; \
            _Pragma("unroll") for (int d_ = 0; d_ < 4; ++d_) { const unsigned w_ = buf[st][e_][d_]; \
                a2_ = pkfma(h2[d_ * 4 + 0], __builtin_amdgcn_cvt_scalef32_pk_f32_fp4(w_, 1.0f, 0), a2_); a2_ = pkfma(h2[d_ * 4 + 1], __builtin_amdgcn_cvt_scalef32_pk_f32_fp4(w_, 1.0f, 1), a2_); \
                a2_ = pkfma(h2[d_ * 4 + 2], __builtin_amdgcn_cvt_scalef32_pk_f32_fp4(w_, 1.0f, 2), a2_); a2_ = pkfma(h2[d_ * 4 + 3], __builtin_amdgcn_cvt_scalef32_pk_f32_fp4(w_, 1.0f, 3), a2_); } \
            scr[((slot0) + e_) * 68 + lane] = (a2_[0] + a2_[1]) * bf2f(bsc[st][e_]); } } while (0)
        PEER_LOAD(Ub, 0, 0);
        for (int b = 0; b < 128 / NPK; b += 2) {
            PEER_LOAD(Ub, 1, (b + 1) * NPK);
            PEER_DOT(0, (b * NPK) & 15);
            if (b + 2 < 128 / NPK) PEER_LOAD(Ub, 0, (b + 2) * NPK);
            PEER_DOT(1, ((b + 1) * NPK) & 15);
            if ((((b + 2) * NPK) & 15) == 0) {
                WAVE_LDS_SYNC();
                float sum = 0.f;
#pragma unroll
                for (int i = 0; i < 4; ++i) { const f32x4 r = *(const LAS f32x4*)(scr + (lane >> 2) * 68 + (lane & 3) * 16 + 4 * i); sum += (r[0] + r[1]) + (r[2] + r[3]); }
                sum += __shfl_xor(sum, 1); sum += __shfl_xor(sum, 2);
                const int k0 = (b + 2) * NPK - 16;
                const int k = k0 + (lane >> 2);
                const float gate = __shfl((k0 < 64) ? gA : gB, k & 63);
                if ((lane & 3) == 0) cfl[k] = gate * gelu_t(sum);
                WAVE_LDS_SYNC();
            }
        }
        f32x2 acc[16];
#pragma unroll
        for (int i = 0; i < 16; ++i) acc[i] = (f32x2){0.f, 0.f};
#define PEER_AXPY(st, base) do { _Pragma("unroll") for (int e_ = 0; e_ < NPK; ++e_) { const float c_ = cfl[(base) + e_] * bf2f(bsc[st][e_]); const f32x2 c2_ = {c_, c_}; \
            _Pragma("unroll") for (int d_ = 0; d_ < 4; ++d_) { const unsigned w_ = buf[st][e_][d_]; \
                acc[d_ * 4 + 0] = pkfma(c2_, __builtin_amdgcn_cvt_scalef32_pk_f32_fp4(w_, 1.0f, 0), acc[d_ * 4 + 0]); acc[d_ * 4 + 1] = pkfma(c2_, __builtin_amdgcn_cvt_scalef32_pk_f32_fp4(w_, 1.0f, 1), acc[d_ * 4 + 1]); \
                acc[d_ * 4 + 2] = pkfma(c2_, __builtin_amdgcn_cvt_scalef32_pk_f32_fp4(w_, 1.0f, 2), acc[d_ * 4 + 2]); acc[d_ * 4 + 3] = pkfma(c2_, __builtin_amdgcn_cvt_scalef32_pk_f32_fp4(w_, 1.0f, 3), acc[d_ * 4 + 3]); } } } while (0)
        PEER_LOAD(Vb, 0, 0);
        for (int b = 0; b < 128 / NPK; b += 2) {
            PEER_LOAD(Vb, 1, (b + 1) * NPK);
            PEER_AXPY(0, b * NPK);
            if (b + 2 < 128 / NPK) PEER_LOAD(Vb, 0, (b + 2) * NPK);
            PEER_AXPY(1, (b + 1) * NPK);
        }
        float ss = 0.f;
#pragma unroll
        for (int q = 0; q < 4; ++q) {
            const u32x4 xw = *(const u32x4*)(xrow + q * 8);
            acc[4 * q] += (f32x2){bflo(xw.x), bfhi(xw.x)}; acc[4 * q + 1] += (f32x2){bflo(xw.y), bfhi(xw.y)};
            acc[4 * q + 2] += (f32x2){bflo(xw.z), bfhi(xw.z)}; acc[4 * q + 3] += (f32x2){bflo(xw.w), bfhi(xw.w)};
#pragma unroll
            for (int i = 0; i < 4; ++i) { const f32x2 a = acc[4 * q + i]; ss += a[0] * a[0] + a[1] * a[1]; }
        }
        const float rstd = rsqrtf(wave_sum(ss) * (1.f / 2048.f) + EPS);
#pragma unroll
        for (int q = 0; q < 8; ++q) {
            const f32x4 g0 = *(const f32x4*)(p.final_g + lane * 32 + q * 4);
            const f32x2 a = acc[2 * q], b = acc[2 * q + 1];
            const f32x4 o0 = {a[0] * rstd * g0[0], a[1] * rstd * g0[1], b[0] * rstd * g0[2], b[1] * rstd * g0[3]};
            *(f32x4*)(orow + q * 4) = o0;
        }
        WAVE_LDS_SYNC();
    }
}

#ifndef PROBE_DUP
#define PROBE_DUP 0
#endif
#define REP(bit) for (int rep_ = 0; rep_ < (((PROBE_DUP) >> (bit)) & 1) + 1; ++rep_)
#define PH1() { pg8::Gemm g{(const bf16_t*)(p.ws + WS_XN), (const bf16_t*)(p.ws + WS_WINT), T_TOK, NPROJ, DM}; pg8::StaticOrder S; S.init(T_TOK, NPROJ, G, bx); Epi1 E{(bf16_t*)(p.ws + WS_P), (float*)(p.ws + WS_PSSV)}; pg8::gemm_phase<Epi1, pg8::StaticOrder, true, true>(lds, g, S, E); grid.sync(); }
#define PH3() { pg8::Gemm g{(const bf16_t*)(p.ws + WS_XN), (const bf16_t*)(p.ws + WS_WOUTT), T_TOK, DM, DM}; pg8::StaticOrder S; S.init(T_TOK, DM, G, bx); Epi2 E{p.x, (bf16_t*)(p.ws + WS_X1G), (float*)(p.ws + WS_PSS2)}; pg8::gemm_phase<Epi2, pg8::StaticOrder, true, true>(lds, g, S, E); grid.sync(); }
#define PH4() { pg8::Gemm g{(const bf16_t*)(p.ws + WS_X1G), (const bf16_t*)(p.ws + WS_WQT), T_TOK, 1024, DM}; pg8::StaticOrder S; S.init(T_TOK, 1024, G, bx); Epi3 E{(bf16_t*)(p.ws + WS_Q), (const float*)(p.ws + WS_PSS2)}; pg8::gemm_phase<Epi3, pg8::StaticOrder, true, true>(lds, g, S, E); grid.sync(); }
__global__ void __launch_bounds__(NTHREADS, 2) hymba_fwd(Params p) {
    extern __shared__ __attribute__((aligned(16))) unsigned char smem[];
    LAS unsigned char* lds = (LAS unsigned char*)smem;
    cg::grid_group grid = cg::this_grid();
    const int G = gridDim.x, bx = blockIdx.x;
    REP(0) { phase0(p, lds); grid.sync(); }
    PH1()
#if (PROBE_DUP >> 1) & 1
    PH1()
#endif
    REP(2) {
        for (int si = bx; si < 256; si += G) {
            const int b = si >> 6, c = si & 63;
            gmlp_bc(p, lds, b, c);
            for (int h = 0; h < 4; ++h) mlstm_local(p, lds, b, c, h);
        }
        grid.sync();
    }
    REP(3) { phase_scan(p); grid.sync(); }
    REP(4) { for (int it = bx; it < 1024; it += G) mlstm_out(p, lds, it >> 8, (it >> 2) & 63, it & 3); grid.sync(); }
    PH3()
#if (PROBE_DUP >> 5) & 1
    PH3()
#endif
    PH4()
#if (PROBE_DUP >> 6) & 1
    PH4()
#endif
    REP(7) { peer_select(p); grid.sync(); }
    peer_gather(p, lds);
}

extern "C" void kernel_launch(void* const* d_in, const int* in_sizes, int n_in, void* d_out, int out_size, void* d_ws, size_t ws_size, hipStream_t stream) {
    static int grid_blocks = 0;
    if (grid_blocks == 0) {
        if (n_in != 20 || ws_size < WS_END) { fprintf(stderr, "kernel_launch: unexpected n_in %d or ws_size %zu (need %zu)\n", n_in, ws_size, (size_t)WS_END); grid_blocks = -1; return; }
        int dev = 0, cus = 0, per_cu = 0;
        hipGetDevice(&dev);
        hipDeviceGetAttribute(&cus, hipDeviceAttributeMultiprocessorCount, dev);
        hipFuncSetAttribute((const void*)hymba_fwd, hipFuncAttributeMaxDynamicSharedMemorySize, LDS_BYTES);
        hipOccupancyMaxActiveBlocksPerMultiprocessor(&per_cu, (const void*)hymba_fwd, NTHREADS, LDS_BYTES);
        if (per_cu < 1) { fprintf(stderr, "kernel_launch: occupancy query says %d blocks per CU\n", per_cu); per_cu = 1; }
        if (per_cu > 1) per_cu = 1;
        grid_blocks = cus * per_cu;
        (void)hipGetLastError();
    }
    if (grid_blocks < 0) return;
    Params p{};
    p.x = (const float*)d_in[0]; p.norm1_g = (const float*)d_in[1]; p.w_in = (const float*)d_in[2]; p.gm_vnorm_g = (const float*)d_in[3];
    p.w_spatial = (const float*)d_in[4]; p.b_spatial = (const float*)d_in[5]; p.ml_conv_w = (const float*)d_in[6]; p.ml_conv_b = (const float*)d_in[7];
    p.ml_b_i = (const float*)d_in[8]; p.ml_b_f = (const float*)d_in[9]; p.gm_out_g = (const float*)d_in[10]; p.ml_out_g = (const float*)d_in[11];
    p.w_out = (const float*)d_in[12]; p.norm2_g = (const float*)d_in[13]; p.peer_wq = (const float*)d_in[14]; p.peer_k1 = (const float*)d_in[15];
    p.peer_k2 = (const float*)d_in[16]; p.peer_u = (const float*)d_in[17]; p.peer_v = (const float*)d_in[18]; p.final_g = (const float*)d_in[19];
    p.out = (float*)d_out; p.ws = (unsigned char*)d_ws;
    void* args[] = {&p};
    hipError_t e = hipLaunchCooperativeKernel((const void*)hymba_fwd, dim3(grid_blocks), dim3(NTHREADS), args, LDS_BYTES, stream);
    if (e != hipSuccess) fprintf(stderr, "cooperative launch failed: %s (grid %d)\n", hipGetErrorString(e), grid_blocks);
}
```

```cpp
#include <hip/hip_runtime.h>
#include <hip/hip_cooperative_groups.h>
#include <cstdio>
#include <cstdint>
namespace cg = cooperative_groups;
namespace pg8 {
#define PG8_LAS __attribute__((address_space(3)))
typedef unsigned short bf16_t;
typedef short bf16x8 __attribute__((ext_vector_type(8)));
typedef float f32x4 __attribute__((ext_vector_type(4)));
typedef unsigned u32x4 __attribute__((ext_vector_type(4)));
constexpr int BM = 256, BK = 64, HALF = 128, HTB = HALF * BK * 2  , STAGE_BYTES = 8 * HTB, NXCD = 8, WGM = 8;

__host__ __device__ __forceinline__ int lds_byte(int r, int c) { const int st = (r >> 4) * 2 + (c >> 5), rr = r & 15, cc = c & 31, ob = rr * 64 + cc * 2; return st * 1024 + (ob ^ (((ob >> 9) & 1) << 5)); }
__host__ __device__ __forceinline__ void stage_rc(int b, int& R, int& C) { const int st = b / 1024, sb = b % 1024, swz = sb ^ (((sb >> 9) & 1) << 5); R = (st >> 1) * 16 + swz / 64; C = (st & 1) * 32 + (swz % 64) / 2; }
__host__ __device__ __forceinline__ int perm32(int rho) { const int n = rho >> 4, i = rho & 15; return 8 * (i >> 2) + 4 * n + (i & 3); }

struct Unit { int pm, pn; };
struct Gemm { const bf16_t* A; const bf16_t* Bt; int M, N, K; };

struct StaticOrder {
    int nM, nN, nwg, G, c;
    __host__ __device__ void init(int M, int N, int G_, int c_) { nM = M / BM; nN = N / BM; nwg = nM * nN; G = G_; c = c_; }
    __host__ __device__ bool next(int i, Unit& u) const {
        const long L = (long)i * G + c; if (L >= nwg) return false;
        int wgid = (int)L; { const int q = nwg / NXCD, r = nwg % NXCD, xcd = wgid % NXCD, off = wgid / NXCD; wgid = (xcd < r ? xcd * (q + 1) : r * (q + 1) + (xcd - r) * q) + off; }
        const int nig = WGM * nN, gid = wgid / nig, fm = gid * WGM, gsz = (nM - fm) < WGM ? (nM - fm) : WGM;
        u.pm = fm + ((wgid % nig) % gsz); u.pn = (wgid % nig) / gsz; return true;
    }
    __device__ __forceinline__ void a_ready(const Unit&) const {}
    __device__ __forceinline__ void done(const Unit&) const {}
};
__device__ __forceinline__ unsigned cvt_pk_bf16(float lo, float hi) { unsigned r; asm volatile("v_cvt_pk_bf16_f32 %0, %1, %2" : "=v"(r) : "v"(lo), "v"(hi)); return r; }
template <class Epi, class Sched, bool ALIGN_EPI = false, bool SP2 = false>
__device__ __forceinline__ void gemm_phase(PG8_LAS unsigned char* lds, const Gemm g, const Sched& S, const Epi& E) {
    const int tid = threadIdx.x, wid = __builtin_amdgcn_readfirstlane(tid >> 6), lane = tid & 63, wr = wid >> 2, wc = wid & 3, fr = lane & 15, fq = lane >> 4;
    const int K = g.K, nt = K / BK;
    unsigned voffA[2], voffB[2];
#pragma unroll
    for (int i = 0; i < 2; ++i) { int R, C; stage_rc(tid * 16 + i * 8192, R, C); const int Rb = Epi::PERM ? ((R & ~31) + perm32(R & 31)) : R;
        voffA[i] = (unsigned)(R * K + C) * 2u; voffB[i] = (unsigned)(Rb * K + C) * 2u; }
    const size_t kstep = (size_t)(BK * 2);
    const size_t hstep = (size_t)HALF * K * 2;
    const size_t tstep = 2 * hstep;
    const unsigned ldsw = (unsigned)wid * 1024u;
    const int aoff = lds_byte(wr * 64 + fr, fq * 8), boff = lds_byte(wc * 32 + fr, fq * 8);
#define PG8_SA(b, h) (((b) * 2 + (h)) * HTB)
#define PG8_SB(b, h) ((4 + (b) * 2 + (h)) * HTB)
#define PG8_STAGE(bufoff, gbase, voff) do { _Pragma("unroll") for (int _i = 0; _i < 2; ++_i) \
        __builtin_amdgcn_global_load_lds((const unsigned*)((const char*)(gbase) + (voff)[_i]), (PG8_LAS unsigned*)(lds + (bufoff) + ldsw + _i * 8192), 16, 0, 0); } while (0)
#define PG8_LDA(dst, b, h) do { _Pragma("unroll") for (int m = 0; m < 4; ++m) _Pragma("unroll") for (int k = 0; k < 2; ++k) dst[m][k] = *(const PG8_LAS bf16x8*)(lds + PG8_SA(b, h) + aoff + m * 2048 + k * 1024); } while (0)
#define PG8_LDB(dst, b, h) do { _Pragma("unroll") for (int n = 0; n < 2; ++n) _Pragma("unroll") for (int k = 0; k < 2; ++k) dst[n][k] = *(const PG8_LAS bf16x8*)(lds + PG8_SB(b, h) + boff + n * 2048 + k * 1024); } while (0)
#define PG8_MMA(ai, bj, At, Bt) do { __builtin_amdgcn_s_setprio(1); _Pragma("unroll") for (int m = 0; m < 4; ++m) _Pragma("unroll") for (int n = 0; n < 2; ++n) _Pragma("unroll") for (int k = 0; k < 2; ++k) \
        acc[ai][bj][m][n] = __builtin_amdgcn_mfma_f32_16x16x32_bf16(Bt[n][k], At[m][k], acc[ai][bj][m][n], 0, 0, 0); __builtin_amdgcn_s_setprio(0); } while (0)
#define PG8_WAIT_V(n) asm volatile("s_waitcnt vmcnt(" #n ")" ::: "memory")
#define PG8_WAIT_L(n) asm volatile("s_waitcnt lgkmcnt(" #n ")" ::: "memory")
#define PG8_BAR __builtin_amdgcn_s_barrier()
#define PG8_SCHED __builtin_amdgcn_sched_barrier(0)
    Unit cur, nxt; int ui = 0;
    if (!S.next(0, cur)) return;
    f32x4 acc[2][2][4][2];
#pragma unroll
    for (int a = 0; a < 2; ++a)
#pragma unroll
        for (int b = 0; b < 2; ++b)
#pragma unroll
            for (int m = 0; m < 4; ++m)
#pragma unroll
                for (int n = 0; n < 2; ++n) acc[a][b][m][n] = (f32x4){0.f, 0.f, 0.f, 0.f};
    bf16x8 At[4][2], B0[2][2], B1[2][2];
    const char* cA = (const char*)g.A + (size_t)cur.pm * tstep; const char* cB = (const char*)g.Bt + (size_t)cur.pn * tstep;
    S.a_ready(cur);
    if constexpr (SP2) {
        PG8_STAGE(PG8_SB(0, 0), cB, voffB); PG8_STAGE(PG8_SB(0, 1), cB + hstep, voffB); PG8_STAGE(PG8_SA(0, 0), cA, voffA); PG8_STAGE(PG8_SA(0, 1), cA + hstep, voffA);
        if (wr == 1) PG8_BAR;
        PG8_WAIT_V(2); PG8_BAR;
        PG8_STAGE(PG8_SB(1, 0), cB + kstep, voffB); PG8_STAGE(PG8_SA(1, 0), cA + kstep, voffA); PG8_STAGE(PG8_SB(1, 1), cB + hstep + kstep, voffB);
        PG8_WAIT_V(6); PG8_BAR;
    } else {
        PG8_STAGE(PG8_SB(0, 0), cB, voffB); PG8_STAGE(PG8_SA(0, 0), cA, voffA); PG8_STAGE(PG8_SB(0, 1), cB + hstep, voffB); PG8_STAGE(PG8_SA(0, 1), cA + hstep, voffA);
        if (wr == 1) PG8_BAR;
        PG8_WAIT_V(4); PG8_BAR;
        PG8_STAGE(PG8_SB(1, 0), cB + kstep, voffB); PG8_STAGE(PG8_SA(1, 0), cA + kstep, voffA); PG8_STAGE(PG8_SB(1, 1), cB + hstep + kstep, voffB);
        PG8_WAIT_V(6); PG8_BAR;
    }
    for (;;) {
        const bool has_next = S.next(ui + 1, nxt);
        const char* nA = has_next ? (const char*)g.A + (size_t)nxt.pm * tstep : cA; const char* nB = has_next ? (const char*)g.Bt + (size_t)nxt.pn * tstep : cB;
        for (int t = 0; t < nt; t += 2) {
            const bool last = (t == nt - 2);
            const char* a1 = cA + (size_t)(t + 1) * kstep;
            const char* a2 = last ? nA : cA + (size_t)(t + 2) * kstep; const char* b2 = last ? nB : cB + (size_t)(t + 2) * kstep;
            const char* a3 = a2 + kstep; const char* b3 = b2 + kstep;
            if (last && has_next) S.a_ready(nxt);
            if constexpr (SP2) {
            PG8_LDB(B0, 0, 0); PG8_LDB(B1, 0, 1); PG8_SCHED; PG8_LDA(At, 0, 0); PG8_STAGE(PG8_SA(1, 1), a1 + hstep, voffA);
            PG8_WAIT_V(8); PG8_WAIT_L(0); PG8_BAR; PG8_MMA(0, 0, At, B0); PG8_MMA(0, 1, At, B1); PG8_BAR; PG8_SCHED;
            PG8_LDA(At, 0, 1); PG8_STAGE(PG8_SB(0, 0), b2, voffB); PG8_STAGE(PG8_SB(0, 1), b2 + hstep, voffB); PG8_STAGE(PG8_SA(0, 0), a2, voffA);
            PG8_WAIT_V(8); PG8_WAIT_L(0); PG8_BAR; PG8_MMA(1, 0, At, B0); PG8_MMA(1, 1, At, B1); PG8_BAR; PG8_SCHED;
            PG8_LDB(B0, 1, 0); PG8_LDB(B1, 1, 1); PG8_SCHED; PG8_LDA(At, 1, 0); PG8_STAGE(PG8_SA(0, 1), a2 + hstep, voffA);
            PG8_WAIT_V(8); PG8_WAIT_L(0); PG8_BAR; PG8_MMA(0, 0, At, B0); PG8_MMA(0, 1, At, B1); PG8_BAR; PG8_SCHED;
            PG8_LDA(At, 1, 1); PG8_STAGE(PG8_SB(1, 0), b3, voffB); PG8_STAGE(PG8_SB(1, 1), b3 + hstep, voffB); PG8_STAGE(PG8_SA(1, 0), a3, voffA);
            PG8_WAIT_V(8); PG8_WAIT_L(0); PG8_BAR; PG8_MMA(1, 0, At, B0); PG8_MMA(1, 1, At, B1); PG8_BAR; PG8_SCHED;
            } else {
            PG8_LDB(B0, 0, 0); PG8_SCHED; PG8_LDA(At, 0, 0); PG8_STAGE(PG8_SA(1, 1), a1 + hstep, voffA);
            PG8_WAIT_L(8); PG8_BAR; PG8_WAIT_L(0); PG8_MMA(0, 0, At, B0); PG8_BAR; PG8_SCHED;
            PG8_LDB(B1, 0, 1); PG8_STAGE(PG8_SB(0, 0), b2, voffB);
            PG8_BAR; PG8_WAIT_L(0); PG8_MMA(0, 1, At, B1); PG8_BAR;
            PG8_LDA(At, 0, 1); PG8_STAGE(PG8_SA(0, 0), a2, voffA);
            PG8_BAR; PG8_WAIT_L(0); PG8_MMA(1, 0, At, B0); PG8_BAR; PG8_SCHED;
            PG8_STAGE(PG8_SB(0, 1), b2 + hstep, voffB);
            PG8_WAIT_V(6); PG8_BAR; PG8_MMA(1, 1, At, B1); PG8_BAR;
            PG8_LDB(B0, 1, 0); PG8_SCHED; PG8_LDA(At, 1, 0); PG8_STAGE(PG8_SA(0, 1), a2 + hstep, voffA);
            PG8_WAIT_L(8); PG8_BAR; PG8_WAIT_L(0); PG8_MMA(0, 0, At, B0); PG8_BAR; PG8_SCHED;
            PG8_LDB(B1, 1, 1); PG8_STAGE(PG8_SB(1, 0), b3, voffB);
            PG8_BAR; PG8_WAIT_L(0); PG8_MMA(0, 1, At, B1); PG8_BAR;
            PG8_LDA(At, 1, 1); PG8_STAGE(PG8_SA(1, 0), a3, voffA);
            PG8_BAR; PG8_WAIT_L(0); PG8_MMA(1, 0, At, B0); PG8_BAR; PG8_SCHED;
            PG8_STAGE(PG8_SB(1, 1), b3 + hstep, voffB);
            PG8_WAIT_V(6); PG8_BAR; PG8_MMA(1, 1, At, B1); PG8_BAR;
            }
        }
        if constexpr (ALIGN_EPI) { if (wr == 0) PG8_BAR; }
        if constexpr (!Epi::AFTER_DRAIN) { E(acc, cur, wr, wc, fr, fq); S.done(cur); }
        if (!has_next) break;
#pragma unroll
        for (int a = 0; a < 2; ++a)
#pragma unroll
            for (int b = 0; b < 2; ++b)
#pragma unroll
                for (int m = 0; m < 4; ++m)
#pragma unroll
                    for (int n = 0; n < 2; ++n) acc[a][b][m][n] = (f32x4){0.f, 0.f, 0.f, 0.f};
        cur = nxt; cA = nA; cB = nB; ++ui;
        if constexpr (ALIGN_EPI) { if (wr == 1) PG8_BAR; }
    }
    PG8_WAIT_V(0);
    if constexpr (!ALIGN_EPI) { if (wr == 0) PG8_BAR; }
    PG8_BAR;
    if constexpr (Epi::AFTER_DRAIN) { E.fused(acc, cur, wr, wc, fr, fq, lds, wid, lane); S.done(cur); }
#undef PG8_SA
#undef PG8_SB
#undef PG8_STAGE
#undef PG8_LDA
#undef PG8_LDB
#undef PG8_MMA
#undef PG8_WAIT_V
#undef PG8_WAIT_L
#undef PG8_BAR
#undef PG8_SCHED
}
}

#define LAS __attribute__((address_space(3)))
#define DI __device__ __forceinline__
using pg8::bf16_t; using pg8::bf16x8; using pg8::f32x4; using pg8::u32x4; using pg8::cvt_pk_bf16;
typedef unsigned u32x2 __attribute__((ext_vector_type(2)));
typedef float f32x2 __attribute__((ext_vector_type(2)));

constexpr int T_TOK = 32768, DM = 2048, NPROJ = 5120, PROJW = 5128;
constexpr int NTHREADS = 512;
constexpr int LDS_BYTES = 147456;
constexpr float EPS = 1e-6f;

constexpr size_t WS_XN = 0;
constexpr size_t WS_P = 134217728;
constexpr size_t WS_X1G = WS_P;
constexpr size_t WS_Q = WS_P + 134217728;
constexpr size_t WS_WINT = WS_P + 335544320;
constexpr size_t WS_WOUTT = WS_WINT + 20971520;
constexpr size_t WS_WQT = WS_WOUTT + 8388608;
constexpr size_t WS_UB = WS_WQT + 4194304;
constexpr size_t WS_VB = WS_UB + 67108864;
constexpr size_t WS_ST = WS_VB + 67108864;
constexpr size_t WS_CPT = WS_ST + 142606336;
constexpr size_t WS_QC = WS_CPT + 71303168;
constexpr size_t WS_KC = WS_QC + 33554432;
constexpr size_t WS_IG = WS_KC + 33554432;
constexpr size_t WS_LF = WS_IG + 524288;
constexpr size_t WS_PSSV = WS_LF + 524288;
constexpr size_t WS_PSS2 = WS_PSSV + 2097152;
constexpr size_t WS_BEND = WS_PSS2 + 4194304;
constexpr size_t WS_GMAX = WS_BEND + 4096;
constexpr size_t WS_MPREV = WS_GMAX + 4096;
constexpr size_t WS_SELID = WS_MPREV + 4096;
constexpr size_t WS_SELG = WS_SELID + 16777216;
constexpr size_t WS_KB1 = WS_SELG + 16777216;
constexpr size_t WS_KB2 = WS_KB1 + 131072;
constexpr size_t WS_BAR = WS_KB2 + 131072;
constexpr size_t WS_END = WS_BAR + 16384;

struct Params {
    const float *x, *norm1_g, *w_in, *gm_vnorm_g, *w_spatial, *b_spatial, *ml_conv_w, *ml_conv_b, *ml_b_i, *ml_b_f, *gm_out_g, *ml_out_g, *w_out, *norm2_g,
        *peer_wq, *peer_k1, *peer_k2, *peer_u, *peer_v, *final_g;
    float* out;
    unsigned char* ws;
};

template <int CB, int H, int W> DI size_t p_off(int t, int h, int d) { return (size_t)T_TOK * CB + ((size_t)((t >> 7) * H + h) * 128 + (t & 127)) * W + d; }
DI float bf2f(unsigned short h) { return __uint_as_float(((unsigned)h) << 16); }
DI float bflo(unsigned w) { return __uint_as_float(w << 16); }
DI float bfhi(unsigned w) { return __uint_as_float(w & 0xffff0000u); }
DI float rcpf_(float x) { return __builtin_amdgcn_rcpf(x); }
DI float sigmoid_(float x) { return rcpf_(1.f + __expf(-x)); }
DI float gelu_t(float x) { const float z = 1.5957691216057308f * (x + 0.044715f * x * x * x); return x * rcpf_(1.f + __expf(-z)); }
DI float wave_sum(float v) {
#pragma unroll
    for (int o = 32; o; o >>= 1) v += __shfl_xor(v, o);
    return v;
}
DI float wave_max(float v) {
#pragma unroll
    for (int o = 32; o; o >>= 1) v = fmaxf(v, __shfl_xor(v, o));
    return v;
}
DI bf16x8 ld_frag_lds(const LAS unsigned char* p) { return *(const LAS bf16x8*)p; }
#define MFMA16(a, b, c) __builtin_amdgcn_mfma_f32_16x16x32_bf16((a), (b), (c), 0, 0, 0)

struct Epi1 {
    static constexpr bool PERM = true, AFTER_DRAIN = false;
    bf16_t* P; float* pssv;
    DI void operator()(const f32x4 (&acc)[2][2][4][2], const pg8::Unit& u, int wr, int wc, int fr, int fq) const {
        const int row0 = u.pm * 256 + wr * 64 + fr, col0 = u.pn * 256 + wc * 32 + 8 * fq;
        const int mode = u.pn < 8 ? 1 : (u.pn >= 16 ? 2 : 0);
        const bool want_ss = (u.pn >= 4 && u.pn < 8);
#pragma unroll
        for (int ai = 0; ai < 2; ++ai)
#pragma unroll
            for (int m = 0; m < 4; ++m) {
                const int row = row0 + ai * 128 + m * 16;
                const int CB = u.pn < 4 ? 0 : (u.pn < 8 ? 1024 : (u.pn < 10 ? 2048 : (u.pn < 12 ? 2560 : (u.pn < 16 ? 3072 : 4096))));
                const int lw = u.pn < 12 ? 7 : 8, H = u.pn < 8 ? 8 : 4;
                float ss = 0.f;
#pragma unroll
                for (int bj = 0; bj < 2; ++bj) {
                    f32x4 v0 = acc[ai][bj][m][0], v1 = acc[ai][bj][m][1];
                    if (mode == 1) {
#pragma unroll
                        for (int j = 0; j < 4; ++j) { v0[j] = gelu_t(v0[j]); v1[j] = gelu_t(v1[j]); ss += v0[j] * v0[j] + v1[j] * v1[j]; }
                    } else if (mode == 2) {
#pragma unroll
                        for (int j = 0; j < 4; ++j) { v0[j] = sigmoid_(v0[j]); v1[j] = sigmoid_(v1[j]); }
                    }
                    u32x4 w; w.x = cvt_pk_bf16(v0[0], v0[1]); w.y = cvt_pk_bf16(v0[2], v0[3]); w.z = cvt_pk_bf16(v1[0], v1[1]); w.w = cvt_pk_bf16(v1[2], v1[3]);
                    {
                        const int cr = col0 + bj * 128 - CB, hh = cr >> lw, d = cr & ((1 << lw) - 1);
                        *(u32x4*)(P + (size_t)T_TOK * CB + (((size_t)((row >> 7) * H + hh) * 128 + (row & 127)) << lw) + d) = w;
                    }
                }
                if (want_ss) {
                    ss += __shfl_xor(ss, 16); ss += __shfl_xor(ss, 32);
                    if (fq == 0) pssv[(size_t)row * 16 + (u.pn - 4) * 4 + wc] = ss;
                }
            }
    }
};

struct Epi2 {
    static constexpr bool PERM = true, AFTER_DRAIN = false;
    const float* x; bf16_t* x1b; float* pss2;
    DI void operator()(const f32x4 (&acc)[2][2][4][2], const pg8::Unit& u, int wr, int wc, int fr, int fq) const {
        const int row0 = u.pm * 256 + wr * 64 + fr, col0 = u.pn * 256 + wc * 32 + 8 * fq;
#pragma unroll
        for (int ai = 0; ai < 2; ++ai)
#pragma unroll
            for (int m = 0; m < 4; ++m) {
                const int row = row0 + ai * 128 + m * 16;
                float ss = 0.f;
#pragma unroll
                for (int bj = 0; bj < 2; ++bj) {
                    const size_t o = (size_t)row * DM + col0 + bj * 128;
                    const f32x4 v0 = acc[ai][bj][m][0] + *(const f32x4*)(x + o), v1 = acc[ai][bj][m][1] + *(const f32x4*)(x + o + 4);
#pragma unroll
                    for (int j = 0; j < 4; ++j) ss += v0[j] * v0[j] + v1[j] * v1[j];
                    u32x4 w; w.x = cvt_pk_bf16(v0[0], v0[1]); w.y = cvt_pk_bf16(v0[2], v0[3]); w.z = cvt_pk_bf16(v1[0], v1[1]); w.w = cvt_pk_bf16(v1[2], v1[3]);
                    *(u32x4*)(x1b + o) = w;
                }
                ss += __shfl_xor(ss, 16); ss += __shfl_xor(ss, 32);
                if (fq == 0) pss2[(size_t)row * 32 + u.pn * 4 + wc] = ss;
            }
    }
};

struct Epi3 {
    static constexpr bool PERM = true, AFTER_DRAIN = false;
    bf16_t* Q; const float* pss2;
    DI void operator()(const f32x4 (&acc)[2][2][4][2], const pg8::Unit& u, int wr, int wc, int fr, int fq) const {
        const int row0 = u.pm * 256 + wr * 64 + fr, col0 = u.pn * 256 + wc * 32 + 8 * fq;
#pragma unroll
        for (int ai = 0; ai < 2; ++ai)
#pragma unroll
            for (int m = 0; m < 4; ++m) {
                const int row = row0 + ai * 128 + m * 16;
                float ss = 0.f;
#pragma unroll
                for (int i = 0; i < 8; ++i) { const f32x4 t = *(const f32x4*)(pss2 + (size_t)row * 32 + i * 4); ss += (t[0] + t[1]) + (t[2] + t[3]); }
                const float rstd = rsqrtf(ss * (1.f / 2048.f) + EPS);
#pragma unroll
                for (int bj = 0; bj < 2; ++bj) {
                    const f32x4 v0 = acc[ai][bj][m][0] * rstd, v1 = acc[ai][bj][m][1] * rstd;
                    u32x4 w; w.x = cvt_pk_bf16(v0[0], v0[1]); w.y = cvt_pk_bf16(v0[2], v0[3]); w.z = cvt_pk_bf16(v1[0], v1[1]); w.w = cvt_pk_bf16(v1[2], v1[3]);
                    *(u32x4*)(Q + (size_t)row * 1024 + col0 + bj * 128) = w;
                }
            }
    }
};

DI void phase0(const Params& p, LAS unsigned char* lds) {
    const int tid = threadIdx.x, lane = tid & 63, wave = tid >> 6;
    bf16_t* XN = (bf16_t*)(p.ws + WS_XN);
    {
        LAS float* scr = (LAS float*)lds + wave * (64 * 65);
        const int gw = blockIdx.x * 8 + wave, nw = gridDim.x * 8;
        for (int it = gw; it < 4096; it += nw) {
            const float* W; bf16_t* WT; int ldw, kt, nt;
            if (it < 2560) { W = p.w_in; WT = (bf16_t*)(p.ws + WS_WINT); ldw = PROJW; kt = it / 80; nt = it % 80; }
            else if (it < 3584) { const int j = it - 2560; W = p.w_out; WT = (bf16_t*)(p.ws + WS_WOUTT); ldw = 2048; kt = j >> 5; nt = j & 31; }
            else { const int j = it - 3584; W = p.peer_wq; WT = (bf16_t*)(p.ws + WS_WQT); ldw = 1024; kt = j >> 4; nt = j & 15; }
            const int k0 = kt * 64, n0 = nt * 64;
#pragma unroll 16
            for (int r = 0; r < 64; ++r) scr[r * 65 + lane] = W[(size_t)(k0 + r) * ldw + n0 + lane] * (it >= 3584 ? p.norm2_g[k0 + r] : 1.f);
            __builtin_amdgcn_fence(__ATOMIC_RELEASE, "wavefront"); __builtin_amdgcn_wave_barrier(); __builtin_amdgcn_fence(__ATOMIC_ACQUIRE, "wavefront");
            const int half = lane >> 5, kk = (lane & 31) * 2;
#pragma unroll 8
            for (int nn = 0; nn < 32; ++nn) {
                const int n = 2 * nn + half; const float a = scr[kk * 65 + n], b = scr[(kk + 1) * 65 + n];
                *(unsigned*)(WT + (size_t)(n0 + n) * 2048 + k0 + kk) = cvt_pk_bf16(a, b);
            }
            __builtin_amdgcn_fence(__ATOMIC_RELEASE, "wavefront"); __builtin_amdgcn_wave_barrier(); __builtin_amdgcn_fence(__ATOMIC_ACQUIRE, "wavefront");
        }
    }
    __syncthreads();
    {
        LAS float* wg = (LAS float*)lds;
        for (int idx = tid; idx < 4096; idx += NTHREADS) {
            const int k = idx >> 1, hf = idx & 1;
            const f32x4 v = *(const f32x4*)(p.w_in + (size_t)k * PROJW + 5120 + hf * 4);
            *(LAS f32x4*)(wg + k * 8 + (k >> 3) * 4 + hf * 4) = v;
        }
        __syncthreads();
        float* IG = (float*)(p.ws + WS_IG); float* LF = (float*)(p.ws + WS_LF);
        for (int row0 = 2 * (blockIdx.x * 8 + wave); row0 < T_TOK; row0 += 2 * gridDim.x * 8) {
            f32x4 xv[2][8];
#pragma unroll
            for (int rr = 0; rr < 2; ++rr) {
                const float* xr = p.x + (size_t)(row0 + rr) * DM;
#pragma unroll
                for (int i = 0; i < 4; ++i) { xv[rr][2 * i] = *(const f32x4*)(xr + i * 512 + lane * 8); xv[rr][2 * i + 1] = *(const f32x4*)(xr + i * 512 + lane * 8 + 4); }
            }
#pragma unroll
            for (int rr = 0; rr < 2; ++rr) {
                const int row = row0 + rr;
                float ss = 0.f;
#pragma unroll
                for (int i = 0; i < 8; ++i) ss += (xv[rr][i][0] * xv[rr][i][0] + xv[rr][i][1] * xv[rr][i][1]) + (xv[rr][i][2] * xv[rr][i][2] + xv[rr][i][3] * xv[rr][i][3]);
                ss = wave_sum(ss);
                const float rstd = rsqrtf(ss * (1.f / 2048.f) + EPS);
                f32x4 ga = {0.f, 0.f, 0.f, 0.f}, gb = {0.f, 0.f, 0.f, 0.f};
#pragma unroll
                for (int i = 0; i < 4; ++i) {
                    const f32x4 g0 = *(const f32x4*)(p.norm1_g + i * 512 + lane * 8), g1 = *(const f32x4*)(p.norm1_g + i * 512 + lane * 8 + 4);
                    const f32x4 h0 = xv[rr][2 * i] * rstd * g0, h1 = xv[rr][2 * i + 1] * rstd * g1;
                    u32x4 w; w.x = cvt_pk_bf16(h0[0], h0[1]); w.y = cvt_pk_bf16(h0[2], h0[3]); w.z = cvt_pk_bf16(h1[0], h1[1]); w.w = cvt_pk_bf16(h1[2], h1[3]);
                    *(u32x4*)(XN + (size_t)row * DM + i * 512 + lane * 8) = w;
                    const LAS float* wb = wg + (i * 512 + lane * 8) * 8 + (i * 64 + lane) * 4;
#pragma unroll
                    for (int e = 0; e < 8; ++e) {
                        const float hv = e < 4 ? h0[e & 3] : h1[e & 3];
                        const f32x4 w0 = *(const LAS f32x4*)(wb + e * 8), w1 = *(const LAS f32x4*)(wb + e * 8 + 4);
                        ga = ga + w0 * hv; gb = gb + w1 * hv;
                    }
                }
                f32x4 m4 = lane < 32 ? ga : gb, s4 = lane < 32 ? gb : ga;
#pragma unroll
                for (int j = 0; j < 4; ++j) m4[j] += __shfl_xor(s4[j], 32);
                const bool up16 = (lane & 16) != 0;
                float m2a = up16 ? m4[2] : m4[0], m2b = up16 ? m4[3] : m4[1];
                const float s2a = up16 ? m4[0] : m4[2], s2b = up16 ? m4[1] : m4[3];
                m2a += __shfl_xor(s2a, 16); m2b += __shfl_xor(s2b, 16);
                const bool up8 = (lane & 8) != 0;
                float m1 = up8 ? m2b : m2a; const float s1 = up8 ? m2a : m2b;
                m1 += __shfl_xor(s1, 8);
                m1 += __shfl_xor(m1, 4); m1 += __shfl_xor(m1, 2); m1 += __shfl_xor(m1, 1);
                const int j = ((lane >> 5) << 2) | (((lane >> 4) & 1) << 1) | ((lane >> 3) & 1);
                if ((lane & 7) == 0) {
                    if (j < 4) IG[(size_t)row * 4 + j] = m1 + p.ml_b_i[j];
                    else { const float z = m1 + p.ml_b_f[j - 4]; LF[(size_t)row * 4 + j - 4] = fminf(z, 0.f) - log1pf(__expf(-fabsf(z))); }
                }
            }
        }
    }
    {
        const size_t nthr = (size_t)gridDim.x * NTHREADS, NQ = (size_t)16384 * 512;
        for (size_t base = (size_t)blockIdx.x * NTHREADS + tid; base < 2 * NQ; base += 4 * nthr) {
            f32x4 v[4];
#pragma unroll
            for (int u = 0; u < 4; ++u) {
                size_t i = base + u * nthr; if (i >= 2 * NQ) i = base;
                const int which = i >= NQ; const size_t j = i - (which ? NQ : 0);
                v[u] = *(const f32x4*)((which ? p.peer_v : p.peer_u) + j * 4);
            }
#pragma unroll
            for (int u = 0; u < 4; ++u) {
                size_t i = base + u * nthr; if (i >= 2 * NQ) i = base;
                const int which = i >= NQ; const size_t j = i - (which ? NQ : 0);
                const int row = (int)(j >> 9), c4 = (int)(j & 511);
                float amax = fmaxf(fmaxf(fabsf(v[u][0]), fabsf(v[u][1])), fmaxf(fabsf(v[u][2]), fabsf(v[u][3])));
                amax = fmaxf(amax, __uint_as_float((unsigned)__builtin_amdgcn_update_dpp(0, (int)__float_as_uint(amax), 0xB1, 0xF, 0xF, true)));
                amax = fmaxf(amax, __uint_as_float((unsigned)__builtin_amdgcn_update_dpp(0, (int)__float_as_uint(amax), 0x4E, 0xF, 0xF, true)));
                amax = fmaxf(amax, __uint_as_float((unsigned)__builtin_amdgcn_update_dpp(0, (int)__float_as_uint(amax), 0x141, 0xF, 0xF, true)));
                const unsigned sb = cvt_pk_bf16(amax * (1.f / 6.f), 0.f) & 0xffffu;
                float sc = bflo(sb); if (sc == 0.f) sc = 1.f;
                const float inv = 1.f / sc;
                unsigned r = 0u;
                r = __builtin_amdgcn_cvt_scalef32_pk_fp4_f32(r, v[u][0] * inv, v[u][1] * inv, 1.0f, 0);
                r = __builtin_amdgcn_cvt_scalef32_pk_fp4_f32(r, v[u][2] * inv, v[u][3] * inv, 1.0f, 1);
                unsigned char* dst = p.ws + (which ? WS_VB : WS_UB) + (size_t)row * 1152;
                *(unsigned short*)(dst + c4 * 2) = (unsigned short)(r & 0xffffu);
                if ((c4 & 7) == 0) *(unsigned short*)(dst + 1024 + (c4 >> 3) * 2) = (unsigned short)(sb == 0u ? 0x3F80u : sb);
            }
        }
    }
    {
        bf16_t* KB1 = (bf16_t*)(p.ws + WS_KB1); bf16_t* KB2 = (bf16_t*)(p.ws + WS_KB2);
        for (int i = blockIdx.x * NTHREADS + tid; i < 65536 / 4; i += gridDim.x * NTHREADS) {
            const f32x4 a = *(const f32x4*)(p.peer_k1 + i * 4), b = *(const f32x4*)(p.peer_k2 + i * 4);
            u32x2 w; w.x = cvt_pk_bf16(a[0], a[1]); w.y = cvt_pk_bf16(a[2], a[3]); *(u32x2*)(KB1 + i * 4) = w;
            w.x = cvt_pk_bf16(b[0], b[1]); w.y = cvt_pk_bf16(b[2], b[3]); *(u32x2*)(KB2 + i * 4) = w;
        }
    }
}

#define WAVE_LDS_SYNC() do { __builtin_amdgcn_fence(__ATOMIC_RELEASE, "wavefront"); __builtin_amdgcn_wave_barrier(); __builtin_amdgcn_fence(__ATOMIC_ACQUIRE, "wavefront"); } while (0)

template <int NG> DI void stage_T_load(const bf16_t* src, int ld, u32x4 (&r0)[NG], u32x4 (&r1)[NG], int wave, int lane) {
#pragma unroll
    for (int i = 0; i < NG; ++i) {
        const int g = wave + 8 * i;
        r0[i] = *(const u32x4*)(src + (size_t)(2 * lane) * ld + g * 8);
        r1[i] = *(const u32x4*)(src + (size_t)(2 * lane + 1) * ld + g * 8);
    }
}
template <int NG> DI void stage_T_store(const u32x4 (&r0)[NG], const u32x4 (&r1)[NG], LAS unsigned char* dst, int wave, int lane) {
#pragma unroll
    for (int i = 0; i < NG; ++i) {
        const int g = wave + 8 * i;
#pragma unroll
        for (int w = 0; w < 4; ++w) {
            const unsigned a = r0[i][w], b = r1[i][w];
            *(LAS unsigned*)(dst + (g * 8 + 2 * w) * 272 + lane * 4) = (a & 0xffffu) | (b << 16);
            *(LAS unsigned*)(dst + (g * 8 + 2 * w + 1) * 272 + lane * 4) = (a >> 16) | (b & 0xffff0000u);
        }
    }
}
template <int NG> DI void stage_T(const bf16_t* src, int ld, LAS unsigned char* dst, int wave, int lane) {
    u32x4 r0[NG], r1[NG];
    stage_T_load<NG>(src, ld, r0, r1, wave, lane);
    stage_T_store<NG>(r0, r1, dst, wave, lane);
}

DI void gmlp_bc(const Params& p, LAS unsigned char* lds, int b, int c) {
    const int tid = threadIdx.x, lane = tid & 63, wave = __builtin_amdgcn_readfirstlane(tid >> 6), fr = lane & 15, fq = lane >> 4;
    const int t0 = b * 8192 + c * 128;
    LAS unsigned char* Wl = lds; LAS unsigned char* GvT = lds + 34816; LAS float* rstdv = (LAS float*)(lds + 69632);
    const bf16_t* P = (const bf16_t*)(p.ws + WS_P); bf16_t* YM = (bf16_t*)(p.ws + WS_XN);
    const float* PSSV = (const float*)(p.ws + WS_PSSV);
    __syncthreads();
    if (tid < 128) {
        float ss = 0.f;
#pragma unroll
        for (int i = 0; i < 4; ++i) { const f32x4 v = *(const f32x4*)(PSSV + (size_t)(t0 + tid) * 16 + i * 4); ss += (v[0] + v[1]) + (v[2] + v[3]); }
        rstdv[tid] = rsqrtf(ss * (1.f / 1024.f) + EPS);
    }
    f32x4 wa[4][2]; u32x4 gr0[2], gr1[2];
#define GMLP_PREFETCH(hh) do { _Pragma("unroll") for (int it = 0; it < 4; ++it) { const int e = (it * NTHREADS + tid) * 8, t = e >> 7, s0 = e & 127; \
            const float* wp = p.w_spatial + ((size_t)((hh) * 128 + t)) * 128 + s0; wa[it][0] = *(const f32x4*)wp; wa[it][1] = *(const f32x4*)(wp + 4); } \
        stage_T_load<2>(P + p_off<1024, 8, 128>(t0, (hh), 0), 128, gr0, gr1, wave, lane); } while (0)
    GMLP_PREFETCH(0);
    for (int h = 0; h < 8; ++h) {
        __syncthreads();
#pragma unroll
        for (int it = 0; it < 4; ++it) {
            const int e = (it * NTHREADS + tid) * 8, t = e >> 7, s0 = e & 127;
            float v[8];
#pragma unroll
            for (int j = 0; j < 8; ++j) { const float a = j < 4 ? wa[it][0][j & 3] : wa[it][1][j & 3]; v[j] = (s0 + j <= t) ? a * rstdv[s0 + j] : 0.f; }
            u32x4 w; w.x = cvt_pk_bf16(v[0], v[1]); w.y = cvt_pk_bf16(v[2], v[3]); w.z = cvt_pk_bf16(v[4], v[5]); w.w = cvt_pk_bf16(v[6], v[7]);
            *(LAS u32x4*)(Wl + t * 272 + s0 * 2) = w;
        }
        stage_T_store<2>(gr0, gr1, GvT, wave, lane);
        __syncthreads();
        if (h + 1 < 8) GMLP_PREFETCH(h + 1);
        f32x4 acc[8];
#pragma unroll
        for (int n = 0; n < 8; ++n) acc[n] = (f32x4){0.f, 0.f, 0.f, 0.f};
        const int kmax = (16 * wave + 15) >> 5;
#pragma unroll
        for (int kk = 0; kk < 4; ++kk) {
            if (kk <= kmax) {
                const bf16x8 bfrag = ld_frag_lds(Wl + (16 * wave + fr) * 272 + (32 * kk + 8 * fq) * 2);
#pragma unroll
                for (int n = 0; n < 8; ++n) { const bf16x8 afrag = ld_frag_lds(GvT + (16 * n + fr) * 272 + (32 * kk + 8 * fq) * 2); acc[n] = MFMA16(afrag, bfrag, acc[n]); }
            }
        }
        const int t = 16 * wave + fr; const size_t grow = (size_t)(t0 + t);
        const float bsp = p.b_spatial[h * 128 + t];
        float ss = 0.f;
#pragma unroll
        for (int n = 0; n < 8; ++n) {
            const int d0 = 16 * n + 4 * fq;
            const u32x2 uw = *(const u32x2*)(P + p_off<0, 8, 128>(t0 + t, h, d0));
            const f32x4 gv = *(const f32x4*)(p.gm_vnorm_g + h * 128 + d0);
            f32x4 y;
            y[0] = bflo(uw.x) * (gv[0] * acc[n][0] + bsp); y[1] = bfhi(uw.x) * (gv[1] * acc[n][1] + bsp);
            y[2] = bflo(uw.y) * (gv[2] * acc[n][2] + bsp); y[3] = bfhi(uw.y) * (gv[3] * acc[n][3] + bsp);
            ss += (y[0] * y[0] + y[1] * y[1]) + (y[2] * y[2] + y[3] * y[3]);
            acc[n] = y;
        }
        ss += __shfl_xor(ss, 16); ss += __shfl_xor(ss, 32);
        const float rstd = rsqrtf(ss * (1.f / 128.f) + EPS);
#pragma unroll
        for (int n = 0; n < 8; ++n) {
            const int d0 = 16 * n + 4 * fq;
            const f32x4 g = *(const f32x4*)(p.gm_out_g + h * 128 + d0);
            const f32x4 o = acc[n] * rstd * g;
            u32x2 w; w.x = cvt_pk_bf16(o[0], o[1]); w.y = cvt_pk_bf16(o[2], o[3]);
            *(u32x2*)(YM + grow * DM + h * 128 + d0) = w;
        }
    }
}

DI void mlstm_local(const Params& p, LAS unsigned char* lds, int b, int c, int h) {
    const int tid = threadIdx.x, lane = tid & 63, wave = __builtin_amdgcn_readfirstlane(tid >> 6), fr = lane & 15, fq = lane >> 4;
    const int bh = b * 4 + h, t0 = b * 8192 + c * 128;
    LAS unsigned char* KT = lds; LAS unsigned char* VT = lds + 34816; LAS float* wsv = (LAS float*)(lds + 108800);
    const bf16_t* P = (const bf16_t*)(p.ws + WS_P);
    bf16_t* QC = (bf16_t*)(p.ws + WS_QC); bf16_t* KC = (bf16_t*)(p.ws + WS_KC);
    const float* IG = (const float*)(p.ws + WS_IG); const float* LF = (const float*)(p.ws + WS_LF);
    LAS float* cwl = (LAS float*)(lds + 109312);
    __syncthreads();
    u32x4 xw[2][5];
#define CONV_LOAD(half) do { _Pragma("unroll") for (int gi = 0; gi < 2; ++gi) { const int g = wave + 8 * (gi + 2 * (half)); const int cgp = (g & 15) * 8; \
        _Pragma("unroll") for (int dj = 0; dj < 5; ++dj) { const int srow = 2 * lane - 3 + dj; xw[gi][dj] = (u32x4){0u, 0u, 0u, 0u}; \
            if (c > 0 || srow >= 0) xw[gi][dj] = *(const u32x4*)(P + ((half) ? p_off<2560, 4, 128>(t0 + srow, h, cgp) : p_off<2048, 4, 128>(t0 + srow, h, cgp))); } } } while (0)
    CONV_LOAD(0);
    for (int idx = tid; idx < 1280; idx += NTHREADS) {
        const int j = idx >> 8, cc = idx & 255, ch = (cc >= 128 ? 512 : 0) + h * 128 + (cc & 127);
        cwl[idx] = j < 4 ? p.ml_conv_w[j * 1024 + ch] : p.ml_conv_b[ch];
    }
    if (wave == 0) {
        const float l0 = LF[(size_t)(t0 + 2 * lane) * 4 + h], l1 = LF[(size_t)(t0 + 2 * lane + 1) * 4 + h];
        const float i0 = IG[(size_t)(t0 + 2 * lane) * 4 + h], i1 = IG[(size_t)(t0 + 2 * lane + 1) * 4 + h];
        float s = l0 + l1;
#pragma unroll
        for (int off = 1; off < 64; off <<= 1) { const float tt = __shfl_up(s, off); if (lane >= off) s += tt; }
        const float b1 = s, b0 = s - l1, bend = __shfl(s, 63);
        const float g0 = bend - b0 + i0, g1 = bend - b1 + i1;
        const float gmax = wave_max(fmaxf(g0, g1));
        wsv[2 * lane] = __expf(g0 - gmax); wsv[2 * lane + 1] = __expf(g1 - gmax);
        if (lane == 0) { ((float*)(p.ws + WS_BEND))[bh * 64 + c] = bend; ((float*)(p.ws + WS_GMAX))[bh * 64 + c] = gmax; }
    }
    __syncthreads();
#pragma unroll
    for (int gi4 = 0; gi4 < 4; ++gi4) {
        const int gi = gi4 & 1;
        if (gi4 == 2) CONV_LOAD(1);
        const int g = wave + 8 * gi4; const bool isk = gi4 >= 2; const int cgp = (g & 15) * 8;
        const int cc0 = (isk ? 128 : 0) + cgp;
        const int s = 2 * lane;
        float y0[8], y1[8];
        {
            const f32x4 cb0 = *(const LAS f32x4*)(cwl + 1024 + cc0), cb1 = *(const LAS f32x4*)(cwl + 1024 + cc0 + 4);
#pragma unroll
            for (int e = 0; e < 8; ++e) { y0[e] = e < 4 ? cb0[e & 3] : cb1[e & 3]; y1[e] = y0[e]; }
#pragma unroll
            for (int j = 0; j < 5; ++j) {
                float xr[8];
#pragma unroll
                for (int q = 0; q < 4; ++q) { xr[2 * q] = bflo(xw[gi][j][q]); xr[2 * q + 1] = bfhi(xw[gi][j][q]); }
                if (j < 4) {
                    const f32x4 w0 = *(const LAS f32x4*)(cwl + j * 256 + cc0), w1 = *(const LAS f32x4*)(cwl + j * 256 + cc0 + 4);
#pragma unroll
                    for (int e = 0; e < 8; ++e) y0[e] += (e < 4 ? w0[e & 3] : w1[e & 3]) * xr[e];
                }
                if (j > 0) {
                    const f32x4 w0 = *(const LAS f32x4*)(cwl + (j - 1) * 256 + cc0), w1 = *(const LAS f32x4*)(cwl + (j - 1) * 256 + cc0 + 4);
#pragma unroll
                    for (int e = 0; e < 8; ++e) y1[e] += (e < 4 ? w0[e & 3] : w1[e & 3]) * xr[e];
                }
            }
        }
        const float sc = isk ? 0.08838834764831845f : 1.f;
#pragma unroll
        for (int e = 0; e < 8; ++e) { y0[e] = y0[e] * sigmoid_(y0[e]) * sc; y1[e] = y1[e] * sigmoid_(y1[e]) * sc; }
        bf16_t* dst = (isk ? KC : QC) + (size_t)(t0 + s) * 512 + h * 128 + cgp;
        u32x4 w; w.x = cvt_pk_bf16(y0[0], y0[1]); w.y = cvt_pk_bf16(y0[2], y0[3]); w.z = cvt_pk_bf16(y0[4], y0[5]); w.w = cvt_pk_bf16(y0[6], y0[7]);
        *(u32x4*)dst = w;
        w.x = cvt_pk_bf16(y1[0], y1[1]); w.y = cvt_pk_bf16(y1[2], y1[3]); w.z = cvt_pk_bf16(y1[4], y1[5]); w.w = cvt_pk_bf16(y1[6], y1[7]);
        *(u32x4*)(dst + 512) = w;
        if (isk) {
            const float w0 = wsv[s], w1 = wsv[s + 1];
#pragma unroll
            for (int e = 0; e < 8; ++e) *(LAS unsigned*)(KT + (cgp + e) * 272 + lane * 4) = cvt_pk_bf16(y0[e] * w0, y1[e] * w1);
        }
    }
    stage_T<4>(P + p_off<3072, 4, 256>(t0, h, 0), 256, VT, wave, lane);
    for (int i = tid; i < 1024; i += NTHREADS) { const int r = i >> 6, w = i & 63; *(LAS unsigned*)(VT + (256 + r) * 272 + w * 4) = 0x3F803F80u; }
    __syncthreads();
    bf16x8 af[4];
#pragma unroll
    for (int kk = 0; kk < 4; ++kk) af[kk] = ld_frag_lds(KT + (16 * wave + fr) * 272 + (32 * kk + 8 * fq) * 2);
    float* ST = (float*)(p.ws + WS_ST) + ((size_t)(bh * 64 + c) * 272) * 128;
#pragma unroll
    for (int n = 0; n < 17; ++n) {
        f32x4 acc = {0.f, 0.f, 0.f, 0.f};
#pragma unroll
        for (int kk = 0; kk < 4; ++kk) { const bf16x8 bfr = ld_frag_lds(VT + (16 * n + fr) * 272 + (32 * kk + 8 * fq) * 2); acc = MFMA16(af[kk], bfr, acc); }
        if (n < 16 || fr == 0) *(f32x4*)(ST + (size_t)(16 * n + fr) * 128 + 16 * wave + 4 * fq) = acc;
    }
}

DI void phase_scan(const Params& p) {
    const float* ST = (const float*)(p.ws + WS_ST); bf16_t* CPT = (bf16_t*)(p.ws + WS_CPT);
    const float* BEND = (const float*)(p.ws + WS_BEND); const float* GMAX = (const float*)(p.ws + WS_GMAX); float* MPREV = (float*)(p.ws + WS_MPREV);
    const int gtid = blockIdx.x * NTHREADS + threadIdx.x, nthr = gridDim.x * NTHREADS;
    constexpr int PER = 8224;
    constexpr size_t CST = 272 * 128;
    for (int item = gtid; item < 16 * PER; item += nthr) {
        const int bh = item / PER, e4 = item - bh * PER;
        const float* src = ST + (size_t)bh * 64 * CST + (size_t)e4 * 4;
        bf16_t* dst = CPT + (size_t)bh * 64 * CST + (size_t)e4 * 4;
        f32x4 st = {0.f, 0.f, 0.f, 0.f}; float m = 0.f;
        for (int c0 = 0; c0 < 64; c0 += 8) {
            f32x4 d[8];
#pragma unroll
            for (int j = 0; j < 8; ++j) d[j] = *(const f32x4*)(src + (size_t)(c0 + j) * CST);
#pragma unroll
            for (int j = 0; j < 8; ++j) {
                const int c = c0 + j;
                const float be = BEND[bh * 64 + c], gm = GMAX[bh * 64 + c];
                const float mn = fmaxf(be + m, gm), a = __expf(be + m - mn), sc = __expf(gm - mn);
                u32x2 w; w.x = cvt_pk_bf16(st[0], st[1]); w.y = cvt_pk_bf16(st[2], st[3]);
                *(u32x2*)(dst + (size_t)c * CST) = w;
                if (e4 == 0) MPREV[bh * 64 + c] = m;
                st = st * a + d[j] * sc; m = mn;
            }
        }
    }
}

DI void mlstm_out(const Params& p, LAS unsigned char* lds, int b, int c, int h) {
    const int tid = threadIdx.x, lane = tid & 63, wave = __builtin_amdgcn_readfirstlane(tid >> 6), fr = lane & 15, fq = lane >> 4;
    const int bh = b * 4 + h, t0 = b * 8192 + c * 128;
    LAS unsigned char* Kl = lds; LAS unsigned char* Sl = lds + 34816; LAS unsigned char* VTe = lds + 69632;
    LAS float* av = (LAS float*)(lds + 143616); LAS float* Mv = (LAS float*)(lds + 144128); LAS float* bv = (LAS float*)(lds + 144640);
    const bf16_t* P = (const bf16_t*)(p.ws + WS_P); bf16_t* YM = (bf16_t*)(p.ws + WS_XN);
    const bf16_t* QC = (const bf16_t*)(p.ws + WS_QC); const bf16_t* KC = (const bf16_t*)(p.ws + WS_KC);
    const float* IG = (const float*)(p.ws + WS_IG); const float* LF = (const float*)(p.ws + WS_LF);
    const float mprev = ((const float*)(p.ws + WS_MPREV))[bh * 64 + c];
    __syncthreads();
    if (wave == 0) {
        const float l0 = LF[(size_t)(t0 + 2 * lane) * 4 + h], l1 = LF[(size_t)(t0 + 2 * lane + 1) * 4 + h];
        const float i0 = IG[(size_t)(t0 + 2 * lane) * 4 + h], i1 = IG[(size_t)(t0 + 2 * lane + 1) * 4 + h];
        float s = l0 + l1;
#pragma unroll
        for (int off = 1; off < 64; off <<= 1) { const float tt = __shfl_up(s, off); if (lane >= off) s += tt; }
        const float b1 = s, b0 = s - l1;
        const float a0 = i0 - b0, a1 = i1 - b1;
        float pm = fmaxf(a0, a1);
#pragma unroll
        for (int off = 1; off < 64; off <<= 1) { const float tt = __shfl_up(pm, off); if (lane >= off) pm = fmaxf(pm, tt); }
        float ex = __shfl_up(pm, 1); if (lane == 0) ex = -3.0e38f;
        Mv[2 * lane] = fmaxf(mprev, fmaxf(ex, a0)); Mv[2 * lane + 1] = fmaxf(mprev, pm);
        av[2 * lane] = a0; av[2 * lane + 1] = a1; bv[2 * lane] = b0; bv[2 * lane + 1] = b1;
    }
#pragma unroll
    for (int it = 0; it < 4; ++it) {
        const int e = (it * NTHREADS + tid) * 8, s = e >> 7, d0 = e & 127;
        *(LAS u32x4*)(Kl + s * 272 + d0 * 2) = *(const u32x4*)(KC + (size_t)(t0 + s) * 512 + h * 128 + d0);
    }
    stage_T<4>(P + p_off<3072, 4, 256>(t0, h, 0), 256, VTe, wave, lane);
    for (int i = tid; i < 1024; i += NTHREADS) { const int r = i >> 6, w = i & 63; *(LAS unsigned*)(VTe + (256 + r) * 272 + w * 4) = 0x3F803F80u; }
    bf16x8 qf[4];
#pragma unroll
    for (int kk = 0; kk < 4; ++kk) qf[kk] = *(const bf16x8*)(QC + (size_t)(t0 + 16 * wave + fr) * 512 + h * 128 + 32 * kk + 8 * fq);
    __syncthreads();
    const int t = 16 * wave + fr; const float Mt = Mv[t];
    const int stmax = wave | 1;
    for (int st = 0; st <= stmax; ++st) {
        f32x4 s4 = {0.f, 0.f, 0.f, 0.f};
#pragma unroll
        for (int kk = 0; kk < 4; ++kk) { const bf16x8 kf = ld_frag_lds(Kl + (16 * st + fr) * 272 + (32 * kk + 8 * fq) * 2); s4 = MFMA16(kf, qf[kk], s4); }
#pragma unroll
        for (int r = 0; r < 4; ++r) { const int s = 16 * st + 4 * fq + r; const float w = (s <= t) ? __expf(av[s] - Mt) : 0.f; s4[r] *= w; }
        u32x2 w; w.x = cvt_pk_bf16(s4[0], s4[1]); w.y = cvt_pk_bf16(s4[2], s4[3]);
        *(LAS u32x2*)(Sl + t * 272 + (16 * st + 4 * fq) * 2) = w;
    }
    __syncthreads();
    const bf16_t* cpt = (const bf16_t*)(p.ws + WS_CPT) + ((size_t)(bh * 64 + c) * 272) * 128;
    f32x4 acc[17];
#pragma unroll
    for (int n = 0; n < 17; ++n) {
        acc[n] = (f32x4){0.f, 0.f, 0.f, 0.f};
#pragma unroll
        for (int kk = 0; kk < 4; ++kk) { const bf16x8 cf = *(const bf16x8*)(cpt + (size_t)(16 * n + fr) * 128 + 32 * kk + 8 * fq); acc[n] = MFMA16(cf, qf[kk], acc[n]); }
    }
    const float ai = __expf(mprev - Mt);
#pragma unroll
    for (int n = 0; n < 17; ++n) acc[n] = acc[n] * ai;
    const int k2max = (16 * wave + 15) >> 5;
#pragma unroll
    for (int kk = 0; kk < 4; ++kk) {
        if (kk <= k2max) {
            const bf16x8 sf = ld_frag_lds(Sl + t * 272 + (32 * kk + 8 * fq) * 2);
#pragma unroll
            for (int n = 0; n < 17; ++n) { const bf16x8 vf = ld_frag_lds(VTe + (16 * n + fr) * 272 + (32 * kk + 8 * fq) * 2); acc[n] = MFMA16(vf, sf, acc[n]); }
        }
    }
    const float den = __shfl(acc[16][0], fr);
    const float mt = bv[t] + Mt;
    const float inv = rcpf_(fmaxf(fabsf(den), __expf(-mt)));
    const size_t grow = (size_t)(t0 + t);
    float ss = 0.f;
#pragma unroll
    for (int n = 0; n < 16; ++n) {
        const int v0 = 16 * n + 4 * fq;
        const u32x2 ow = *(const u32x2*)(P + p_off<4096, 4, 256>(t0 + t, h, v0));
        f32x4 y;
        y[0] = bflo(ow.x) * acc[n][0] * inv; y[1] = bfhi(ow.x) * acc[n][1] * inv; y[2] = bflo(ow.y) * acc[n][2] * inv; y[3] = bfhi(ow.y) * acc[n][3] * inv;
        ss += (y[0] * y[0] + y[1] * y[1]) + (y[2] * y[2] + y[3] * y[3]);
        acc[n] = y;
    }
    ss += __shfl_xor(ss, 16); ss += __shfl_xor(ss, 32);
    const float rstd = rsqrtf(ss * (1.f / 256.f) + EPS);
#pragma unroll
    for (int n = 0; n < 16; ++n) {
        const int v0 = 16 * n + 4 * fq;
        const f32x4 g = *(const f32x4*)(p.ml_out_g + h * 256 + v0);
        const f32x4 o = acc[n] * rstd * g;
        u32x2 w; w.x = cvt_pk_bf16(o[0], o[1]); w.y = cvt_pk_bf16(o[2], o[3]);
        *(u32x2*)(YM + grow * DM + 1024 + h * 256 + v0) = w;
    }
}

DI unsigned ord_key(float f) { const unsigned u = __float_as_uint(f); return (u & 0x80000000u) ? ~u : (u | 0x80000000u); }
DI float key_val(unsigned k) { return (k & 0x80000000u) ? __uint_as_float(k & 0x7fffffffu) : __uint_as_float(~k); }
DI unsigned umax_(unsigned a, unsigned b) { return a > b ? a : b; }
DI unsigned umin_(unsigned a, unsigned b) { return a < b ? a : b; }
#define DPPU(v, ctrl) ((unsigned)__builtin_amdgcn_update_dpp(0, (int)(v), (ctrl), 0xF, 0xF, true))
DI unsigned row_max_u32(unsigned v) {
    v = umax_(v, DPPU(v, 0xB1)); v = umax_(v, DPPU(v, 0x4E)); v = umax_(v, DPPU(v, 0x141)); v = umax_(v, DPPU(v, 0x140)); return v;
}
DI float row_sum_f32(float v) {
    v += __uint_as_float(DPPU(__float_as_uint(v), 0xB1)); v += __uint_as_float(DPPU(__float_as_uint(v), 0x4E));
    v += __uint_as_float(DPPU(__float_as_uint(v), 0x141)); v += __uint_as_float(DPPU(__float_as_uint(v), 0x140)); return v;
}
#define CEX(a, b) do { const unsigned mx_ = umax_(a, b), mn_ = umin_(a, b); a = mx_; b = mn_; } while (0)
template <int N> DI unsigned top16_row(unsigned (&s)[N], int c) {
    unsigned list = 0u;
#pragma unroll 1
    for (int it = 0; it < 16; ++it) {
        const unsigned wm = row_max_u32(s[0]);
        const bool win = (s[0] == wm);
#pragma unroll
        for (int i = 0; i < N - 1; ++i) s[i] = win ? s[i + 1] : s[i];
        s[N - 1] = win ? 0u : s[N - 1];
        list = (c == it) ? wm : list;
    }
    return list;
}

DI void peer_select(const Params& p) {
    const int tid = threadIdx.x, lane = tid & 63, wave = __builtin_amdgcn_readfirstlane(tid >> 6), c = lane & 15, g = lane >> 4, rowbase = lane & 48;
    const bf16_t* Q = (const bf16_t*)(p.ws + WS_Q); const bf16_t* KB1 = (const bf16_t*)(p.ws + WS_KB1); const bf16_t* KB2 = (const bf16_t*)(p.ws + WS_KB2);
    int* SELID = (int*)(p.ws + WS_SELID); float* SELG = (float*)(p.ws + WS_SELG);
    unsigned pk = 0u, validmask = 0u;
#pragma unroll
    for (int q = 0; q < 4; ++q) {
        const int target = 4 * c + q; int ci = 0, cj = 0, cnt = 0; bool v = false;
#pragma unroll
        for (int i = 0; i < 16; ++i) { const int nj = 16 / (i + 1); if (target >= cnt && target < cnt + nj) { ci = i; cj = target - cnt; v = true; } cnt += nj; }
        pk |= (unsigned)((ci << 4) | cj) << (8 * q); validmask |= (v ? 1u : 0u) << q;
    }
    for (int tile = blockIdx.x * 8 + wave; tile < T_TOK / 16; tile += gridDim.x * 8) {
        const int tok0 = tile * 16;
        for (int h = 0; h < 8; ++h) {
            bf16x8 a1[2], a2[2];
            {
                const bf16_t* qp = Q + (size_t)(tok0 + c) * 1024 + h * 128 + g * 8;
                a1[0] = *(const bf16x8*)qp; a1[1] = *(const bf16x8*)(qp + 32); a2[0] = *(const bf16x8*)(qp + 64); a2[1] = *(const bf16x8*)(qp + 96);
            }
            f32x4 acc1[8], acc2[8];
#pragma unroll
            for (int nt = 0; nt < 8; ++nt) {
                const size_t ko = ((size_t)(h * 128 + nt * 16 + c)) * 64 + g * 8;
                acc1[nt] = (f32x4){0.f, 0.f, 0.f, 0.f}; acc2[nt] = (f32x4){0.f, 0.f, 0.f, 0.f};
                acc1[nt] = MFMA16(a1[0], *(const bf16x8*)(KB1 + ko), acc1[nt]); acc1[nt] = MFMA16(a1[1], *(const bf16x8*)(KB1 + ko + 32), acc1[nt]);
                acc2[nt] = MFMA16(a2[0], *(const bf16x8*)(KB2 + ko), acc2[nt]); acc2[nt] = MFMA16(a2[1], *(const bf16x8*)(KB2 + ko + 32), acc2[nt]);
            }
#pragma unroll
            for (int r = 0; r < 4; ++r) {
                unsigned s[8];
#pragma unroll
                for (int nt = 0; nt < 8; ++nt) s[nt] = (ord_key(acc1[nt][r]) & ~0x7Fu) | (unsigned)(127 - (nt * 16 + c));
                CEX(s[0], s[1]); CEX(s[2], s[3]); CEX(s[4], s[5]); CEX(s[6], s[7]); CEX(s[0], s[2]); CEX(s[1], s[3]); CEX(s[4], s[6]); CEX(s[5], s[7]); CEX(s[1], s[2]); CEX(s[5], s[6]);
                CEX(s[0], s[4]); CEX(s[1], s[5]); CEX(s[2], s[6]); CEX(s[3], s[7]); CEX(s[2], s[4]); CEX(s[3], s[5]); CEX(s[1], s[2]); CEX(s[3], s[4]); CEX(s[5], s[6]);
                const unsigned list1 = top16_row<8>(s, c);
#pragma unroll
                for (int nt = 0; nt < 8; ++nt) s[nt] = (ord_key(acc2[nt][r]) & ~0x7Fu) | (unsigned)(127 - (nt * 16 + c));
                CEX(s[0], s[1]); CEX(s[2], s[3]); CEX(s[4], s[5]); CEX(s[6], s[7]); CEX(s[0], s[2]); CEX(s[1], s[3]); CEX(s[4], s[6]); CEX(s[5], s[7]); CEX(s[1], s[2]); CEX(s[5], s[6]);
                CEX(s[0], s[4]); CEX(s[1], s[5]); CEX(s[2], s[6]); CEX(s[3], s[7]); CEX(s[2], s[4]); CEX(s[3], s[5]); CEX(s[1], s[2]); CEX(s[3], s[4]); CEX(s[5], s[6]);
                const unsigned list2 = top16_row<8>(s, c);
                unsigned cs[4];
#pragma unroll
                for (int q = 0; q < 4; ++q) {
                    const int ci = (int)((pk >> (8 * q + 4)) & 15u), cj = (int)((pk >> (8 * q)) & 15u);
                    const unsigned k1 = (unsigned)__shfl((int)list1, rowbase + ci), k2 = (unsigned)__shfl((int)list2, rowbase + cj);
                    const float cand = key_val(k1 & ~0x7Fu) + key_val(k2 & ~0x7Fu);
                    cs[q] = ((validmask >> q) & 1u) ? ((ord_key(cand) & ~0x3Fu) | (unsigned)(63 - (4 * c + q))) : 0u;
                }
                CEX(cs[0], cs[1]); CEX(cs[2], cs[3]); CEX(cs[0], cs[2]); CEX(cs[1], cs[3]); CEX(cs[1], cs[2]);
                const unsigned sel = top16_row<4>(cs, c);
                const int slot = 63 - (int)(sel & 63u);
                const unsigned pkv = (unsigned)__shfl((int)pk, rowbase + (slot >> 2));
                const int cij = (int)((pkv >> (8 * (slot & 3))) & 0xFFu);
                const unsigned e1 = (unsigned)__shfl((int)list1, rowbase + (cij >> 4)), e2 = (unsigned)__shfl((int)list2, rowbase + (cij & 15));
                const int eid = (127 - (int)(e1 & 127u)) * 128 + (127 - (int)(e2 & 127u));
                const float sv = key_val(sel & ~0x3Fu), mx = key_val(row_max_u32(sel) & ~0x3Fu);
                const float ev = __expf(sv - mx);
                const float sum = row_sum_f32(ev);
                const size_t o = (size_t)(tok0 + 4 * g + r) * 128 + h * 16 + c;
                SELID[o] = eid; SELG[o] = ev * rcpf_(sum);
            }
        }
    }
}

DI f32x2 pkfma(f32x2 a, f32x2 b, f32x2 c) { return __builtin_elementwise_fma(a, b, c); }
DI void peer_gather(const Params& p, LAS unsigned char* lds) {
    const int tid = threadIdx.x, lane = tid & 63, wave = __builtin_amdgcn_readfirstlane(tid >> 6);
    LAS float* scr = (LAS float*)lds + wave * (16 * 68);
    LAS float* cfl = (LAS float*)(lds + 8 * 16 * 68 * 4) + wave * 128;
    const unsigned char* Ub = p.ws + WS_UB; const unsigned char* Vb = p.ws + WS_VB;
    const float* PSS2 = (const float*)(p.ws + WS_PSS2);
    const int* SELID = (const int*)(p.ws + WS_SELID); const float* SELG = (const float*)(p.ws + WS_SELG);
    const int gw = blockIdx.x * 8 + wave, nw = gridDim.x * 8;
    for (int t = gw; t < T_TOK; t += nw) {
        const int idA = SELID[(size_t)t * 128 + lane], idB = SELID[(size_t)t * 128 + 64 + lane];
        const float gA = SELG[(size_t)t * 128 + lane], gB = SELG[(size_t)t * 128 + 64 + lane];
        const bf16_t* xrow = (const bf16_t*)(p.ws + WS_X1G) + (size_t)t * DM + lane * 32;
        float* orow = p.out + (size_t)t * DM + lane * 32;
        const float pv = lane < 32 ? PSS2[(size_t)t * 32 + lane] : 0.f;
        const float rstd2 = rsqrtf(wave_sum(pv) * (1.f / 2048.f) + EPS);
        f32x2 h2[16];
#pragma unroll
        for (int q = 0; q < 4; ++q) {
            const u32x4 xw = *(const u32x4*)(xrow + q * 8);
            const f32x4 g0 = *(const f32x4*)(p.norm2_g + lane * 32 + q * 8), g1 = *(const f32x4*)(p.norm2_g + lane * 32 + q * 8 + 4);
            h2[4 * q] = (f32x2){bflo(xw.x) * rstd2 * g0[0], bfhi(xw.x) * rstd2 * g0[1]};
            h2[4 * q + 1] = (f32x2){bflo(xw.y) * rstd2 * g0[2], bfhi(xw.y) * rstd2 * g0[3]};
            h2[4 * q + 2] = (f32x2){bflo(xw.z) * rstd2 * g1[0], bfhi(xw.z) * rstd2 * g1[1]};
            h2[4 * q + 3] = (f32x2){bflo(xw.w) * rstd2 * g1[2], bfhi(xw.w) * rstd2 * g1[3]};
        }
        constexpr int NPK = 8;
        u32x4 buf[2][NPK]; unsigned short bsc[2][NPK];
#define PEER_LOAD(TB, st, base) do { const int idv_ = ((base) < 64) ? idA : idB; _Pragma("unroll") for (int e_ = 0; e_ < NPK; ++e_) { \
            const int id_ = __builtin_amdgcn_readlane(idv_, ((base) + e_) & 63); const unsigned char* r_ = (TB) + (size_t)id_ * 1152; \
            buf[st][e_] = *(const u32x4*)(r_ + lane * 16); bsc[st][e_] = *(const unsigned short*)(r_ + 1024 + lane * 2); } } while (0)
#define PEER_DOT(st, slot0) do { _Pragma("unroll") for (int e_ = 0; e_ < NPK; ++e_) { f32x2 a2_ = {0.f, 0.f}; \
            _Pragma("unroll") for (int d_ = 0; d_ < 4; ++d_) { const unsigned w_ = buf[st][e_][d_]; \
                a2_ = pkfma(h2[d_ * 4 + 0], __builtin_amdgcn_cvt_scalef32_pk_f32_fp4(w_, 1.0f, 0), a2_); a2_ = pkfma(h2[d_ * 4 + 1], __builtin_amdgcn_cvt_scalef32_pk_f32_fp4(w_, 1.0f, 1), a2_); \
                a2_ = pkfma(h2[d_ * 4 + 2], __builtin_amdgcn_cvt_scalef32_pk_f32_fp4(w_, 1.0f, 2), a2_); a2_ = pkfma(h2[d_ * 4 + 3], __builtin_amdgcn_cvt_scalef32_pk_f32_fp4(w_, 1.0f, 3), a2_); } \
            scr[((slot0) + e_) * 68 + lane] = (a2_[0] + a2_[1]) * bf2f(bsc[st][e_]); } } while (0)
        PEER_LOAD(Ub, 0, 0);
        for (int b = 0; b < 128 / NPK; b += 2) {
            PEER_LOAD(Ub, 1, (b + 1) * NPK);
            PEER_DOT(0, (b * NPK) & 15);
            if (b + 2 < 128 / NPK) PEER_LOAD(Ub, 0, (b + 2) * NPK);
            PEER_DOT(1, ((b + 1) * NPK) & 15);
            if ((((b + 2) * NPK) & 15) == 0) {
                WAVE_LDS_SYNC();
                float sum = 0.f;
#pragma unroll
                for (int i = 0; i < 4; ++i) { const f32x4 r = *(const LAS f32x4*)(scr + (lane >> 2) * 68 + (lane & 3) * 16 + 4 * i); sum += (r[0] + r[1]) + (r[2] + r[3]); }
                sum += __shfl_xor(sum, 1); sum += __shfl_xor(sum, 2);
                const int k0 = (b + 2) * NPK - 16;
                const int k = k0 + (lane >> 2);
                const float gate = __shfl((k0 < 64) ? gA : gB, k & 63);
                if ((lane & 3) == 0) cfl[k] = gate * gelu_t(sum);
                WAVE_LDS_SYNC();
            }
        }
        f32x2 acc[16];
#pragma unroll
        for (int i = 0; i < 16; ++i) acc[i] = (f32x2){0.f, 0.f};
#define PEER_AXPY(st, base) do { _Pragma("unroll") for (int e_ = 0; e_ < NPK; ++e_) { const float c_ = cfl[(base) + e_] * bf2f(bsc[st][e_]); const f32x2 c2_ = {c_, c_}; \
            _Pragma("unroll") for (int d_ = 0; d_ < 4; ++d_) { const unsigned w_ = buf[st][e_][d_]; \
                acc[d_ * 4 + 0] = pkfma(c2_, __builtin_amdgcn_cvt_scalef32_pk_f32_fp4(w_, 1.0f, 0), acc[d_ * 4 + 0]); acc[d_ * 4 + 1] = pkfma(c2_, __builtin_amdgcn_cvt_scalef32_pk_f32_fp4(w_, 1.0f, 1), acc[d_ * 4 + 1]); \
                acc[d_ * 4 + 2] = pkfma(c2_, __builtin_amdgcn_cvt_scalef32_pk_f32_fp4(w_, 1.0f, 2), acc[d_ * 4 + 2]); acc[d_ * 4 + 3] = pkfma(c2_, __builtin_amdgcn_cvt_scalef32_pk_f32_fp4(w_, 1.0f, 3), acc[d_ * 4 + 3]); } } } while (0)
        PEER_LOAD(Vb, 0, 0);
        for (int b = 0; b < 128 / NPK; b += 2) {
            PEER_LOAD(Vb, 1, (b + 1) * NPK);
            PEER_AXPY(0, b * NPK);
            if (b + 2 < 128 / NPK) PEER_LOAD(Vb, 0, (b + 2) * NPK);
            PEER_AXPY(1, (b + 1) * NPK);
        }
        float ss = 0.f;
#pragma unroll
        for (int q = 0; q < 4; ++q) {
            const u32x4 xw = *(const u32x4*)(xrow + q * 8);
            acc[4 * q] += (f32x2){bflo(xw.x), bfhi(xw.x)}; acc[4 * q + 1] += (f32x2){bflo(xw.y), bfhi(xw.y)};
            acc[4 * q + 2] += (f32x2){bflo(xw.z), bfhi(xw.z)}; acc[4 * q + 3] += (f32x2){bflo(xw.w), bfhi(xw.w)};
#pragma unroll
            for (int i = 0; i < 4; ++i) { const f32x2 a = acc[4 * q + i]; ss += a[0] * a[0] + a[1] * a[1]; }
        }
        const float rstd = rsqrtf(wave_sum(ss) * (1.f / 2048.f) + EPS);
#pragma unroll
        for (int q = 0; q < 8; ++q) {
            const f32x4 g0 = *(const f32x4*)(p.final_g + lane * 32 + q * 4);
            const f32x2 a = acc[2 * q], b = acc[2 * q + 1];
            const f32x4 o0 = {a[0] * rstd * g0[0], a[1] * rstd * g0[1], b[0] * rstd * g0[2], b[1] * rstd * g0[3]};
            *(f32x4*)(orow + q * 4) = o0;
        }
        WAVE_LDS_SYNC();
    }
}

#define XB_TMO      128
#define XB_XCNT(j)  (256  + 64 * (j))
#define XB_XSUB(j)  (1280 + 64 * (j))
#define XB_XGEN(j)  (2304 + 64 * (j))
#define XB_TOP      3328
#define XB_TOPGEN   3392
#define XCD_BAR_WORDS 3456
#define XB_SPIN_CAP (1u << 18)

__device__ __forceinline__ unsigned xb_ld(unsigned* p)              { return __hip_atomic_load(p, __ATOMIC_RELAXED, __HIP_MEMORY_SCOPE_AGENT); }
__device__ __forceinline__ unsigned xb_add(unsigned* p, unsigned v) { return __hip_atomic_fetch_add(p, v, __ATOMIC_RELAXED, __HIP_MEMORY_SCOPE_AGENT); }
__device__ __forceinline__ unsigned xb_xcc_id() { return (unsigned)__builtin_amdgcn_s_getreg((3 << 11) | 20) & 0xFu; }
#define XB_SPIN(cond, bar) do { unsigned _sp = 0; while (cond) { __builtin_amdgcn_s_sleep(1); \
    if ((++_sp & 255u) == 0u) { if (xb_ld(&(bar)[XB_TMO])) break; if (_sp > XB_SPIN_CAP) { atomicAdd(&(bar)[XB_TMO], 1u); break; } } } } while (0)

struct XcdBarrier {
    unsigned* bar; unsigned x;
    volatile LAS unsigned* st;
};

__device__ __forceinline__ XcdBarrier xcd_barrier_post(unsigned* bar, volatile LAS unsigned* st) {
    XcdBarrier b; b.bar = bar; b.x = xb_xcc_id(); b.st = st;
    if (threadIdx.x == 0) (void)xb_add(&bar[XB_XCNT(b.x)], 1u);
    return b;
}
__device__ __forceinline__ void xcd_barrier_complete(unsigned* bar, unsigned x, unsigned& nloc, unsigned& nx) {
    const unsigned G = gridDim.x * gridDim.y * gridDim.z;
    unsigned sum, cnt, mine, sp = 0u;
    for (;;) {
        sum = 0u; cnt = 0u; mine = 0u;
#pragma unroll
        for (unsigned j = 0; j < 16; ++j) { const unsigned c = xb_ld(&bar[XB_XCNT(j)]); sum += c; cnt += (c > 0u) ? 1u : 0u; mine = (j == x) ? c : mine; }
        if (sum == G) break;
        __builtin_amdgcn_s_sleep(1);
        if ((++sp & 255u) == 0u) { if (xb_ld(&bar[XB_TMO])) break; if (sp > XB_SPIN_CAP) { atomicAdd(&bar[XB_TMO], 1u); break; } }
    }
    nloc = mine > 0u ? mine : 1u; nx = cnt > 0u ? cnt : 1u;
}

__device__ __forceinline__ void xcd_barrier(const XcdBarrier& b) {
    asm volatile("s_waitcnt vmcnt(0)" ::: "memory");
    __syncthreads();
    if (threadIdx.x == 0) {
        unsigned* bar = b.bar;
        __builtin_amdgcn_s_waitcnt(0);
        unsigned nloc = b.st[0], nx = b.st[1];
        if (nloc == 0u) { xcd_barrier_complete(bar, b.x, nloc, nx); b.st[0] = nloc; b.st[1] = nx; }
        const unsigned old = xb_add(&bar[XB_XSUB(b.x)], 1u);
        const unsigned gen = old / nloc;
        if (old + 1u == (gen + 1u) * nloc) {
            __builtin_amdgcn_fence(__ATOMIC_RELEASE, "agent");
            asm volatile("s_waitcnt vmcnt(0)" ::: "memory");
            const unsigned og = xb_add(&bar[XB_TOP], 1u);
            const unsigned tg = og / nx;
            if (og + 1u == (tg + 1u) * nx) xb_add(&bar[XB_TOPGEN], 1u);
            else XB_SPIN(xb_ld(&bar[XB_TOPGEN]) == tg, bar);
            __builtin_amdgcn_fence(__ATOMIC_ACQUIRE, "agent");
            xb_add(&bar[XB_XGEN(b.x)], 1u);
            asm volatile("s_waitcnt vmcnt(0)" ::: "memory");
        } else {
            XB_SPIN(xb_ld(&bar[XB_XGEN(b.x)]) == gen, bar);
            __builtin_amdgcn_fence(__ATOMIC_ACQUIRE, "agent");
            asm volatile("s_waitcnt vmcnt(0)" ::: "memory");
        }
    }
    __syncthreads();
}

#ifndef PROBE_DUP
#define PROBE_DUP 0
#endif
#define REP(bit) for (int rep_ = 0; rep_ < (((PROBE_DUP) >> (bit)) & 1) + 1; ++rep_)
#define PH1() { pg8::Gemm g{(const bf16_t*)(p.ws + WS_XN), (const bf16_t*)(p.ws + WS_WINT), T_TOK, NPROJ, DM}; pg8::StaticOrder S; S.init(T_TOK, NPROJ, G, bx); Epi1 E{(bf16_t*)(p.ws + WS_P), (float*)(p.ws + WS_PSSV)}; pg8::gemm_phase<Epi1, pg8::StaticOrder, true, true>(lds, g, S, E); xcd_barrier(xbar); }
#define PH3() { pg8::Gemm g{(const bf16_t*)(p.ws + WS_XN), (const bf16_t*)(p.ws + WS_WOUTT), T_TOK, DM, DM}; pg8::StaticOrder S; S.init(T_TOK, DM, G, bx); Epi2 E{p.x, (bf16_t*)(p.ws + WS_X1G), (float*)(p.ws + WS_PSS2)}; pg8::gemm_phase<Epi2, pg8::StaticOrder, true, true>(lds, g, S, E); xcd_barrier(xbar); }
#define PH4() { pg8::Gemm g{(const bf16_t*)(p.ws + WS_X1G), (const bf16_t*)(p.ws + WS_WQT), T_TOK, 1024, DM}; pg8::StaticOrder S; S.init(T_TOK, 1024, G, bx); Epi3 E{(bf16_t*)(p.ws + WS_Q), (const float*)(p.ws + WS_PSS2)}; pg8::gemm_phase<Epi3, pg8::StaticOrder, true, true>(lds, g, S, E); xcd_barrier(xbar); }
__global__ void __launch_bounds__(NTHREADS, 2) hymba_fwd(Params p) {
    extern __shared__ __attribute__((aligned(16))) unsigned char smem[];
    LAS unsigned char* lds = (LAS unsigned char*)smem;
    cg::grid_group grid = cg::this_grid();
    const int G = gridDim.x, bx = blockIdx.x;
    unsigned* barw = (unsigned*)(p.ws + WS_BAR);
    volatile LAS unsigned* xst = (volatile LAS unsigned*)(lds + LDS_BYTES - 16);
    if (threadIdx.x < 4) xst[threadIdx.x] = 0u;
    if (bx == 0) { for (int i = threadIdx.x; i < XCD_BAR_WORDS; i += NTHREADS) barw[i] = 0u; }
    __syncthreads();
    REP(0) { phase0(p, lds); grid.sync(); }
    const XcdBarrier xbar = xcd_barrier_post(barw, xst);
    PH1()
#if (PROBE_DUP >> 1) & 1
    PH1()
#endif
    REP(2) {
        for (int si = bx; si < 256; si += G) {
            const int b = si >> 6, c = si & 63;
            gmlp_bc(p, lds, b, c);
            for (int h = 0; h < 4; ++h) mlstm_local(p, lds, b, c, h);
        }
        xcd_barrier(xbar);
    }
    REP(3) { phase_scan(p); xcd_barrier(xbar); }
    REP(4) { for (int it = bx; it < 1024; it += G) mlstm_out(p, lds, it >> 8, (it >> 2) & 63, it & 3); xcd_barrier(xbar); }
    PH3()
#if (PROBE_DUP >> 5) & 1
    PH3()
#endif
    PH4()
#if (PROBE_DUP >> 6) & 1
    PH4()
#endif
    REP(7) { peer_select(p); xcd_barrier(xbar); }
    peer_gather(p, lds);
}

extern "C" void kernel_launch(void* const* d_in, const int* in_sizes, int n_in, void* d_out, int out_size, void* d_ws, size_t ws_size, hipStream_t stream) {
    static int grid_blocks = 0;
    if (grid_blocks == 0) {
        if (n_in != 20 || ws_size < WS_END) { fprintf(stderr, "kernel_launch: unexpected n_in %d or ws_size %zu (need %zu)\n", n_in, ws_size, (size_t)WS_END); grid_blocks = -1; return; }
        int dev = 0, cus = 0, per_cu = 0;
        hipGetDevice(&dev);
        hipDeviceGetAttribute(&cus, hipDeviceAttributeMultiprocessorCount, dev);
        hipFuncSetAttribute((const void*)hymba_fwd, hipFuncAttributeMaxDynamicSharedMemorySize, LDS_BYTES);
        hipOccupancyMaxActiveBlocksPerMultiprocessor(&per_cu, (const void*)hymba_fwd, NTHREADS, LDS_BYTES);
        if (per_cu < 1) { fprintf(stderr, "kernel_launch: occupancy query says %d blocks per CU\n", per_cu); per_cu = 1; }
        if (per_cu > 1) per_cu = 1;
        grid_blocks = cus * per_cu;
        (void)hipGetLastError();
    }
    if (grid_blocks < 0) return;
    Params p{};
    p.x = (const float*)d_in[0]; p.norm1_g = (const float*)d_in[1]; p.w_in = (const float*)d_in[2]; p.gm_vnorm_g = (const float*)d_in[3];
    p.w_spatial = (const float*)d_in[4]; p.b_spatial = (const float*)d_in[5]; p.ml_conv_w = (const float*)d_in[6]; p.ml_conv_b = (const float*)d_in[7];
    p.ml_b_i = (const float*)d_in[8]; p.ml_b_f = (const float*)d_in[9]; p.gm_out_g = (const float*)d_in[10]; p.ml_out_g = (const float*)d_in[11];
    p.w_out = (const float*)d_in[12]; p.norm2_g = (const float*)d_in[13]; p.peer_wq = (const float*)d_in[14]; p.peer_k1 = (const float*)d_in[15];
    p.peer_k2 = (const float*)d_in[16]; p.peer_u = (const float*)d_in[17]; p.peer_v = (const float*)d_in[18]; p.final_g = (const float*)d_in[19];
    p.out = (float*)d_out; p.ws = (unsigned char*)d_ws;
    void* args[] = {&p};
    hipError_t e = hipLaunchCooperativeKernel((const void*)hymba_fwd, dim3(grid_blocks), dim3(NTHREADS), args, LDS_BYTES, stream);
    if (e != hipSuccess) fprintf(stderr, "cooperative launch failed: %s (grid %d)\n", hipGetErrorString(e), grid_blocks);
}
```

```cpp
#include <hip/hip_runtime.h>
#include <hip/hip_cooperative_groups.h>
#include <cstdio>
#include <cstdint>
namespace cg = cooperative_groups;
namespace pg8 {
#define PG8_LAS __attribute__((address_space(3)))
typedef unsigned short bf16_t;
typedef short bf16x8 __attribute__((ext_vector_type(8)));
typedef float f32x4 __attribute__((ext_vector_type(4)));
typedef unsigned u32x4 __attribute__((ext_vector_type(4)));
constexpr int BM = 256, BK = 64, HALF = 128, HTB = HALF * BK * 2  , STAGE_BYTES = 8 * HTB, NXCD = 8, WGM = 8;

__host__ __device__ __forceinline__ int lds_byte(int r, int c) { const int st = (r >> 4) * 2 + (c >> 5), rr = r & 15, cc = c & 31, ob = rr * 64 + cc * 2; return st * 1024 + (ob ^ (((ob >> 9) & 1) << 5)); }
__host__ __device__ __forceinline__ void stage_rc(int b, int& R, int& C) { const int st = b / 1024, sb = b % 1024, swz = sb ^ (((sb >> 9) & 1) << 5); R = (st >> 1) * 16 + swz / 64; C = (st & 1) * 32 + (swz % 64) / 2; }
__host__ __device__ __forceinline__ int perm32(int rho) { const int n = rho >> 4, i = rho & 15; return 8 * (i >> 2) + 4 * n + (i & 3); }

struct Unit { int pm, pn; };
struct Gemm { const bf16_t* A; const bf16_t* Bt; int M, N, K; };

struct StaticOrder {
    int nM, nN, nwg, G, c;
    __host__ __device__ void init(int M, int N, int G_, int c_) { nM = M / BM; nN = N / BM; nwg = nM * nN; G = G_; c = c_; }
    __host__ __device__ bool next(int i, Unit& u) const {
        const long L = (long)i * G + c; if (L >= nwg) return false;
        int wgid = (int)L; { const int q = nwg / NXCD, r = nwg % NXCD, xcd = wgid % NXCD, off = wgid / NXCD; wgid = (xcd < r ? xcd * (q + 1) : r * (q + 1) + (xcd - r) * q) + off; }
        const int nig = WGM * nN, gid = wgid / nig, fm = gid * WGM, gsz = (nM - fm) < WGM ? (nM - fm) : WGM;
        u.pm = fm + ((wgid % nig) % gsz); u.pn = (wgid % nig) / gsz; return true;
    }
    __device__ __forceinline__ void a_ready(const Unit&) const {}
    __device__ __forceinline__ void done(const Unit&) const {}
};
__device__ __forceinline__ unsigned cvt_pk_bf16(float lo, float hi) { unsigned r; asm volatile("v_cvt_pk_bf16_f32 %0, %1, %2" : "=v"(r) : "v"(lo), "v"(hi)); return r; }
template <class Epi, class Sched, bool ALIGN_EPI = false, bool SP2 = false>
__device__ __forceinline__ void gemm_phase(PG8_LAS unsigned char* lds, const Gemm g, const Sched& S, const Epi& E) {
    const int tid = threadIdx.x, wid = __builtin_amdgcn_readfirstlane(tid >> 6), lane = tid & 63, wr = wid >> 2, wc = wid & 3, fr = lane & 15, fq = lane >> 4;
    const int K = g.K, nt = K / BK;
    unsigned voffA[2], voffB[2];
#pragma unroll
    for (int i = 0; i < 2; ++i) { int R, C; stage_rc(tid * 16 + i * 8192, R, C); const int Rb = Epi::PERM ? ((R & ~31) + perm32(R & 31)) : R;
        voffA[i] = (unsigned)(R * K + C) * 2u; voffB[i] = (unsigned)(Rb * K + C) * 2u; }
    const size_t kstep = (size_t)(BK * 2);
    const size_t hstep = (size_t)HALF * K * 2;
    const size_t tstep = 2 * hstep;
    const unsigned ldsw = (unsigned)wid * 1024u;
    const int aoff = lds_byte(wr * 64 + fr, fq * 8), boff = lds_byte(wc * 32 + fr, fq * 8);
#define PG8_SA(b, h) (((b) * 2 + (h)) * HTB)
#define PG8_SB(b, h) ((4 + (b) * 2 + (h)) * HTB)
#define PG8_STAGE(bufoff, gbase, voff) do { _Pragma("unroll") for (int _i = 0; _i < 2; ++_i) \
        __builtin_amdgcn_global_load_lds((const unsigned*)((const char*)(gbase) + (voff)[_i]), (PG8_LAS unsigned*)(lds + (bufoff) + ldsw + _i * 8192), 16, 0, 0); } while (0)
#define PG8_LDA(dst, b, h) do { _Pragma("unroll") for (int m = 0; m < 4; ++m) _Pragma("unroll") for (int k = 0; k < 2; ++k) dst[m][k] = *(const PG8_LAS bf16x8*)(lds + PG8_SA(b, h) + aoff + m * 2048 + k * 1024); } while (0)
#define PG8_LDB(dst, b, h) do { _Pragma("unroll") for (int n = 0; n < 2; ++n) _Pragma("unroll") for (int k = 0; k < 2; ++k) dst[n][k] = *(const PG8_LAS bf16x8*)(lds + PG8_SB(b, h) + boff + n * 2048 + k * 1024); } while (0)
#define PG8_MMA(ai, bj, At, Bt) do { __builtin_amdgcn_s_setprio(1); _Pragma("unroll") for (int m = 0; m < 4; ++m) _Pragma("unroll") for (int n = 0; n < 2; ++n) _Pragma("unroll") for (int k = 0; k < 2; ++k) \
        acc[ai][bj][m][n] = __builtin_amdgcn_mfma_f32_16x16x32_bf16(Bt[n][k], At[m][k], acc[ai][bj][m][n], 0, 0, 0); __builtin_amdgcn_s_setprio(0); } while (0)
#define PG8_WAIT_V(n) asm volatile("s_waitcnt vmcnt(" #n ")" ::: "memory")
#define PG8_WAIT_L(n) asm volatile("s_waitcnt lgkmcnt(" #n ")" ::: "memory")
#define PG8_BAR __builtin_amdgcn_s_barrier()
#define PG8_SCHED __builtin_amdgcn_sched_barrier(0)
    Unit cur, nxt; int ui = 0;
    if (!S.next(0, cur)) return;
    f32x4 acc[2][2][4][2];
#pragma unroll
    for (int a = 0; a < 2; ++a)
#pragma unroll
        for (int b = 0; b < 2; ++b)
#pragma unroll
            for (int m = 0; m < 4; ++m)
#pragma unroll
                for (int n = 0; n < 2; ++n) acc[a][b][m][n] = (f32x4){0.f, 0.f, 0.f, 0.f};
    bf16x8 At[4][2], B0[2][2], B1[2][2];
    const char* cA = (const char*)g.A + (size_t)cur.pm * tstep; const char* cB = (const char*)g.Bt + (size_t)cur.pn * tstep;
    S.a_ready(cur);
    if constexpr (SP2) {
        PG8_STAGE(PG8_SB(0, 0), cB, voffB); PG8_STAGE(PG8_SB(0, 1), cB + hstep, voffB); PG8_STAGE(PG8_SA(0, 0), cA, voffA); PG8_STAGE(PG8_SA(0, 1), cA + hstep, voffA);
        if (wr == 1) PG8_BAR;
        PG8_WAIT_V(2); PG8_BAR;
        PG8_STAGE(PG8_SB(1, 0), cB + kstep, voffB); PG8_STAGE(PG8_SA(1, 0), cA + kstep, voffA); PG8_STAGE(PG8_SB(1, 1), cB + hstep + kstep, voffB);
        PG8_WAIT_V(6); PG8_BAR;
    } else {
        PG8_STAGE(PG8_SB(0, 0), cB, voffB); PG8_STAGE(PG8_SA(0, 0), cA, voffA); PG8_STAGE(PG8_SB(0, 1), cB + hstep, voffB); PG8_STAGE(PG8_SA(0, 1), cA + hstep, voffA);
        if (wr == 1) PG8_BAR;
        PG8_WAIT_V(4); PG8_BAR;
        PG8_STAGE(PG8_SB(1, 0), cB + kstep, voffB); PG8_STAGE(PG8_SA(1, 0), cA + kstep, voffA); PG8_STAGE(PG8_SB(1, 1), cB + hstep + kstep, voffB);
        PG8_WAIT_V(6); PG8_BAR;
    }
    for (;;) {
        const bool has_next = S.next(ui + 1, nxt);
        const char* nA = has_next ? (const char*)g.A + (size_t)nxt.pm * tstep : cA; const char* nB = has_next ? (const char*)g.Bt + (size_t)nxt.pn * tstep : cB;
        for (int t = 0; t < nt; t += 2) {
            const bool last = (t == nt - 2);
            const char* a1 = cA + (size_t)(t + 1) * kstep;
            const char* a2 = last ? nA : cA + (size_t)(t + 2) * kstep; const char* b2 = last ? nB : cB + (size_t)(t + 2) * kstep;
            const char* a3 = a2 + kstep; const char* b3 = b2 + kstep;
            if (last && has_next) S.a_ready(nxt);
            if constexpr (SP2) {
            PG8_LDB(B0, 0, 0); PG8_LDB(B1, 0, 1); PG8_SCHED; PG8_LDA(At, 0, 0); PG8_STAGE(PG8_SA(1, 1), a1 + hstep, voffA);
            PG8_WAIT_V(8); PG8_WAIT_L(0); PG8_BAR; PG8_MMA(0, 0, At, B0); PG8_MMA(0, 1, At, B1); PG8_BAR; PG8_SCHED;
            PG8_LDA(At, 0, 1); PG8_STAGE(PG8_SB(0, 0), b2, voffB); PG8_STAGE(PG8_SB(0, 1), b2 + hstep, voffB); PG8_STAGE(PG8_SA(0, 0), a2, voffA);
            PG8_WAIT_V(8); PG8_WAIT_L(0); PG8_BAR; PG8_MMA(1, 0, At, B0); PG8_MMA(1, 1, At, B1); PG8_BAR; PG8_SCHED;
            PG8_LDB(B0, 1, 0); PG8_LDB(B1, 1, 1); PG8_SCHED; PG8_LDA(At, 1, 0); PG8_STAGE(PG8_SA(0, 1), a2 + hstep, voffA);
            PG8_WAIT_V(8); PG8_WAIT_L(0); PG8_BAR; PG8_MMA(0, 0, At, B0); PG8_MMA(0, 1, At, B1); PG8_BAR; PG8_SCHED;
            PG8_LDA(At, 1, 1); PG8_STAGE(PG8_SB(1, 0), b3, voffB); PG8_STAGE(PG8_SB(1, 1), b3 + hstep, voffB); PG8_STAGE(PG8_SA(1, 0), a3, voffA);
            PG8_WAIT_V(8); PG8_WAIT_L(0); PG8_BAR; PG8_MMA(1, 0, At, B0); PG8_MMA(1, 1, At, B1); PG8_BAR; PG8_SCHED;
            } else {
            PG8_LDB(B0, 0, 0); PG8_SCHED; PG8_LDA(At, 0, 0); PG8_STAGE(PG8_SA(1, 1), a1 + hstep, voffA);
            PG8_WAIT_L(8); PG8_BAR; PG8_WAIT_L(0); PG8_MMA(0, 0, At, B0); PG8_BAR; PG8_SCHED;
            PG8_LDB(B1, 0, 1); PG8_STAGE(PG8_SB(0, 0), b2, voffB);
            PG8_BAR; PG8_WAIT_L(0); PG8_MMA(0, 1, At, B1); PG8_BAR;
            PG8_LDA(At, 0, 1); PG8_STAGE(PG8_SA(0, 0), a2, voffA);
            PG8_BAR; PG8_WAIT_L(0); PG8_MMA(1, 0, At, B0); PG8_BAR; PG8_SCHED;
            PG8_STAGE(PG8_SB(0, 1), b2 + hstep, voffB);
            PG8_WAIT_V(6); PG8_BAR; PG8_MMA(1, 1, At, B1); PG8_BAR;
            PG8_LDB(B0, 1, 0); PG8_SCHED; PG8_LDA(At, 1, 0); PG8_STAGE(PG8_SA(0, 1), a2 + hstep, voffA);
            PG8_WAIT_L(8); PG8_BAR; PG8_WAIT_L(0); PG8_MMA(0, 0, At, B0); PG8_BAR; PG8_SCHED;
            PG8_LDB(B1, 1, 1); PG8_STAGE(PG8_SB(1, 0), b3, voffB);
            PG8_BAR; PG8_WAIT_L(0); PG8_MMA(0, 1, At, B1); PG8_BAR;
            PG8_LDA(At, 1, 1); PG8_STAGE(PG8_SA(1, 0), a3, voffA);
            PG8_BAR; PG8_WAIT_L(0); PG8_MMA(1, 0, At, B0); PG8_BAR; PG8_SCHED;
            PG8_STAGE(PG8_SB(1, 1), b3 + hstep, voffB);
            PG8_WAIT_V(6); PG8_BAR; PG8_MMA(1, 1, At, B1); PG8_BAR;
            }
        }
        if constexpr (ALIGN_EPI) { if (wr == 0) PG8_BAR; }
        if constexpr (!Epi::AFTER_DRAIN) { E(acc, cur, wr, wc, fr, fq); S.done(cur); }
        if (!has_next) break;
#pragma unroll
        for (int a = 0; a < 2; ++a)
#pragma unroll
            for (int b = 0; b < 2; ++b)
#pragma unroll
                for (int m = 0; m < 4; ++m)
#pragma unroll
                    for (int n = 0; n < 2; ++n) acc[a][b][m][n] = (f32x4){0.f, 0.f, 0.f, 0.f};
        cur = nxt; cA = nA; cB = nB; ++ui;
        if constexpr (ALIGN_EPI) { if (wr == 1) PG8_BAR; }
    }
    PG8_WAIT_V(0);
    if constexpr (!ALIGN_EPI) { if (wr == 0) PG8_BAR; }
    PG8_BAR;
    if constexpr (Epi::AFTER_DRAIN) { E.fused(acc, cur, wr, wc, fr, fq, lds, wid, lane); S.done(cur); }
#undef PG8_SA
#undef PG8_SB
#undef PG8_STAGE
#undef PG8_LDA
#undef PG8_LDB
#undef PG8_MMA
#undef PG8_WAIT_V
#undef PG8_WAIT_L
#undef PG8_BAR
#undef PG8_SCHED
}
}

#define LAS __attribute__((address_space(3)))
#define DI __device__ __forceinline__
using pg8::bf16_t; using pg8::bf16x8; using pg8::f32x4; using pg8::u32x4; using pg8::cvt_pk_bf16;
typedef unsigned u32x2 __attribute__((ext_vector_type(2)));
typedef float f32x2 __attribute__((ext_vector_type(2)));

constexpr int T_TOK = 32768, DM = 2048, NPROJ = 5120, PROJW = 5128;
constexpr int NTHREADS = 512;
constexpr int LDS_BYTES = 147456;
constexpr float EPS = 1e-6f;

constexpr size_t WS_XN = 0;
constexpr size_t WS_P = 134217728;
constexpr size_t WS_X1G = WS_P;
constexpr size_t WS_Q = WS_P + 134217728;
constexpr size_t WS_WINT = WS_P + 335544320;
constexpr size_t WS_WOUTT = WS_WINT + 20971520;
constexpr size_t WS_WQT = WS_WOUTT + 8388608;
constexpr size_t WS_UB = WS_WQT + 4194304;
constexpr size_t WS_VB = WS_UB + 67108864;
constexpr size_t WS_ST = WS_VB + 67108864;
constexpr size_t WS_CPT = WS_ST + 142606336;
constexpr size_t WS_QC = WS_CPT + 71303168;
constexpr size_t WS_KC = WS_QC + 33554432;
constexpr size_t WS_IG = WS_KC + 33554432;
constexpr size_t WS_LF = WS_IG + 524288;
constexpr size_t WS_PSSV = WS_LF + 524288;
constexpr size_t WS_PSS2 = WS_PSSV + 2097152;
constexpr size_t WS_BEND = WS_PSS2 + 4194304;
constexpr size_t WS_GMAX = WS_BEND + 4096;
constexpr size_t WS_MPREV = WS_GMAX + 4096;
constexpr size_t WS_SELID = WS_MPREV + 4096;
constexpr size_t WS_SELG = WS_SELID + 16777216;
constexpr size_t WS_KB1 = WS_SELG + 16777216;
constexpr size_t WS_KB2 = WS_KB1 + 131072;
constexpr size_t WS_BAR = WS_KB2 + 131072;
constexpr size_t WS_END = WS_BAR + 16384;

struct Params {
    const float *x, *norm1_g, *w_in, *gm_vnorm_g, *w_spatial, *b_spatial, *ml_conv_w, *ml_conv_b, *ml_b_i, *ml_b_f, *gm_out_g, *ml_out_g, *w_out, *norm2_g,
        *peer_wq, *peer_k1, *peer_k2, *peer_u, *peer_v, *final_g;
    float* out;
    unsigned char* ws;
};

template <int CB, int H, int W> DI size_t p_off(int t, int h, int d) { return (size_t)T_TOK * CB + ((size_t)((t >> 7) * H + h) * 128 + (t & 127)) * W + d; }
DI float bf2f(unsigned short h) { return __uint_as_float(((unsigned)h) << 16); }
DI float bflo(unsigned w) { return __uint_as_float(w << 16); }
DI float bfhi(unsigned w) { return __uint_as_float(w & 0xffff0000u); }
DI float rcpf_(float x) { return __builtin_amdgcn_rcpf(x); }
DI float sigmoid_(float x) { return rcpf_(1.f + __expf(-x)); }
DI float gelu_t(float x) { const float z = 1.5957691216057308f * (x + 0.044715f * x * x * x); return x * rcpf_(1.f + __expf(-z)); }
DI float wave_sum(float v) {
#pragma unroll
    for (int o = 32; o; o >>= 1) v += __shfl_xor(v, o);
    return v;
}
DI float wave_max(float v) {
#pragma unroll
    for (int o = 32; o; o >>= 1) v = fmaxf(v, __shfl_xor(v, o));
    return v;
}
DI bf16x8 ld_frag_lds(const LAS unsigned char* p) { return *(const LAS bf16x8*)p; }
#define MFMA16(a, b, c) __builtin_amdgcn_mfma_f32_16x16x32_bf16((a), (b), (c), 0, 0, 0)

struct Epi1 {
    static constexpr bool PERM = true, AFTER_DRAIN = false;
    bf16_t* P; float* pssv;
    DI void operator()(const f32x4 (&acc)[2][2][4][2], const pg8::Unit& u, int wr, int wc, int fr, int fq) const {
        const int row0 = u.pm * 256 + wr * 64 + fr, col0 = u.pn * 256 + wc * 32 + 8 * fq;
        const int mode = u.pn < 8 ? 1 : (u.pn >= 16 ? 2 : 0);
        const bool want_ss = (u.pn >= 4 && u.pn < 8);
#pragma unroll
        for (int ai = 0; ai < 2; ++ai)
#pragma unroll
            for (int m = 0; m < 4; ++m) {
                const int row = row0 + ai * 128 + m * 16;
                const int CB = u.pn < 4 ? 0 : (u.pn < 8 ? 1024 : (u.pn < 10 ? 2048 : (u.pn < 12 ? 2560 : (u.pn < 16 ? 3072 : 4096))));
                const int lw = u.pn < 12 ? 7 : 8, H = u.pn < 8 ? 8 : 4;
                float ss = 0.f;
#pragma unroll
                for (int bj = 0; bj < 2; ++bj) {
                    f32x4 v0 = acc[ai][bj][m][0], v1 = acc[ai][bj][m][1];
                    if (mode == 1) {
#pragma unroll
                        for (int j = 0; j < 4; ++j) { v0[j] = gelu_t(v0[j]); v1[j] = gelu_t(v1[j]); ss += v0[j] * v0[j] + v1[j] * v1[j]; }
                    } else if (mode == 2) {
#pragma unroll
                        for (int j = 0; j < 4; ++j) { v0[j] = sigmoid_(v0[j]); v1[j] = sigmoid_(v1[j]); }
                    }
                    u32x4 w; w.x = cvt_pk_bf16(v0[0], v0[1]); w.y = cvt_pk_bf16(v0[2], v0[3]); w.z = cvt_pk_bf16(v1[0], v1[1]); w.w = cvt_pk_bf16(v1[2], v1[3]);
                    {
                        const int cr = col0 + bj * 128 - CB, hh = cr >> lw, d = cr & ((1 << lw) - 1);
                        *(u32x4*)(P + (size_t)T_TOK * CB + (((size_t)((row >> 7) * H + hh) * 128 + (row & 127)) << lw) + d) = w;
                    }
                }
                if (want_ss) {
                    ss += __shfl_xor(ss, 16); ss += __shfl_xor(ss, 32);
                    if (fq == 0) pssv[(size_t)row * 16 + (u.pn - 4) * 4 + wc] = ss;
                }
            }
    }
};

struct Epi2 {
    static constexpr bool PERM = true, AFTER_DRAIN = false;
    const float* x; bf16_t* x1b; float* pss2;
    DI void operator()(const f32x4 (&acc)[2][2][4][2], const pg8::Unit& u, int wr, int wc, int fr, int fq) const {
        const int row0 = u.pm * 256 + wr * 64 + fr, col0 = u.pn * 256 + wc * 32 + 8 * fq;
#pragma unroll
        for (int ai = 0; ai < 2; ++ai)
#pragma unroll
            for (int m = 0; m < 4; ++m) {
                const int row = row0 + ai * 128 + m * 16;
                float ss = 0.f;
#pragma unroll
                for (int bj = 0; bj < 2; ++bj) {
                    const size_t o = (size_t)row * DM + col0 + bj * 128;
                    const f32x4 v0 = acc[ai][bj][m][0] + *(const f32x4*)(x + o), v1 = acc[ai][bj][m][1] + *(const f32x4*)(x + o + 4);
#pragma unroll
                    for (int j = 0; j < 4; ++j) ss += v0[j] * v0[j] + v1[j] * v1[j];
                    u32x4 w; w.x = cvt_pk_bf16(v0[0], v0[1]); w.y = cvt_pk_bf16(v0[2], v0[3]); w.z = cvt_pk_bf16(v1[0], v1[1]); w.w = cvt_pk_bf16(v1[2], v1[3]);
                    *(u32x4*)(x1b + o) = w;
                }
                ss += __shfl_xor(ss, 16); ss += __shfl_xor(ss, 32);
                if (fq == 0) pss2[(size_t)row * 32 + u.pn * 4 + wc] = ss;
            }
    }
};

struct Epi3 {
    static constexpr bool PERM = true, AFTER_DRAIN = false;
    bf16_t* Q; const float* pss2;
    DI void operator()(const f32x4 (&acc)[2][2][4][2], const pg8::Unit& u, int wr, int wc, int fr, int fq) const {
        const int row0 = u.pm * 256 + wr * 64 + fr, col0 = u.pn * 256 + wc * 32 + 8 * fq;
#pragma unroll
        for (int ai = 0; ai < 2; ++ai)
#pragma unroll
            for (int m = 0; m < 4; ++m) {
                const int row = row0 + ai * 128 + m * 16;
                float ss = 0.f;
#pragma unroll
                for (int i = 0; i < 8; ++i) { const f32x4 t = *(const f32x4*)(pss2 + (size_t)row * 32 + i * 4); ss += (t[0] + t[1]) + (t[2] + t[3]); }
                const float rstd = rsqrtf(ss * (1.f / 2048.f) + EPS);
#pragma unroll
                for (int bj = 0; bj < 2; ++bj) {
                    const f32x4 v0 = acc[ai][bj][m][0] * rstd, v1 = acc[ai][bj][m][1] * rstd;
                    u32x4 w; w.x = cvt_pk_bf16(v0[0], v0[1]); w.y = cvt_pk_bf16(v0[2], v0[3]); w.z = cvt_pk_bf16(v1[0], v1[1]); w.w = cvt_pk_bf16(v1[2], v1[3]);
                    *(u32x4*)(Q + (size_t)row * 1024 + col0 + bj * 128) = w;
                }
            }
    }
};

DI void phase0(const Params& p, LAS unsigned char* lds) {
    const int tid = threadIdx.x, lane = tid & 63, wave = tid >> 6;
    bf16_t* XN = (bf16_t*)(p.ws + WS_XN);
    {
        LAS float* scr = (LAS float*)lds + wave * (64 * 65);
        const int gw = blockIdx.x * 8 + wave, nw = gridDim.x * 8;
        for (int it = gw; it < 4096; it += nw) {
            const float* W; bf16_t* WT; int ldw, kt, nt;
            if (it < 2560) { W = p.w_in; WT = (bf16_t*)(p.ws + WS_WINT); ldw = PROJW; kt = it / 80; nt = it % 80; }
            else if (it < 3584) { const int j = it - 2560; W = p.w_out; WT = (bf16_t*)(p.ws + WS_WOUTT); ldw = 2048; kt = j >> 5; nt = j & 31; }
            else { const int j = it - 3584; W = p.peer_wq; WT = (bf16_t*)(p.ws + WS_WQT); ldw = 1024; kt = j >> 4; nt = j & 15; }
            const int k0 = kt * 64, n0 = nt * 64;
#pragma unroll 16
            for (int r = 0; r < 64; ++r) scr[r * 65 + lane] = W[(size_t)(k0 + r) * ldw + n0 + lane] * (it >= 3584 ? p.norm2_g[k0 + r] : 1.f);
            __builtin_amdgcn_fence(__ATOMIC_RELEASE, "wavefront"); __builtin_amdgcn_wave_barrier(); __builtin_amdgcn_fence(__ATOMIC_ACQUIRE, "wavefront");
            const int half = lane >> 5, kk = (lane & 31) * 2;
#pragma unroll 8
            for (int nn = 0; nn < 32; ++nn) {
                const int n = 2 * nn + half; const float a = scr[kk * 65 + n], b = scr[(kk + 1) * 65 + n];
                *(unsigned*)(WT + (size_t)(n0 + n) * 2048 + k0 + kk) = cvt_pk_bf16(a, b);
            }
            __builtin_amdgcn_fence(__ATOMIC_RELEASE, "wavefront"); __builtin_amdgcn_wave_barrier(); __builtin_amdgcn_fence(__ATOMIC_ACQUIRE, "wavefront");
        }
    }
    __syncthreads();
    {
        LAS float* wg = (LAS float*)lds;
        for (int idx = tid; idx < 4096; idx += NTHREADS) {
            const int k = idx >> 1, hf = idx & 1;
            const f32x4 v = *(const f32x4*)(p.w_in + (size_t)k * PROJW + 5120 + hf * 4);
            *(LAS f32x4*)(wg + k * 8 + (k >> 3) * 4 + hf * 4) = v;
        }
        __syncthreads();
        float* IG = (float*)(p.ws + WS_IG); float* LF = (float*)(p.ws + WS_LF);
        for (int row0 = 2 * (blockIdx.x * 8 + wave); row0 < T_TOK; row0 += 2 * gridDim.x * 8) {
            f32x4 xv[2][8];
#pragma unroll
            for (int rr = 0; rr < 2; ++rr) {
                const float* xr = p.x + (size_t)(row0 + rr) * DM;
#pragma unroll
                for (int i = 0; i < 4; ++i) { xv[rr][2 * i] = *(const f32x4*)(xr + i * 512 + lane * 8); xv[rr][2 * i + 1] = *(const f32x4*)(xr + i * 512 + lane * 8 + 4); }
            }
#pragma unroll
            for (int rr = 0; rr < 2; ++rr) {
                const int row = row0 + rr;
                float ss = 0.f;
#pragma unroll
                for (int i = 0; i < 8; ++i) ss += (xv[rr][i][0] * xv[rr][i][0] + xv[rr][i][1] * xv[rr][i][1]) + (xv[rr][i][2] * xv[rr][i][2] + xv[rr][i][3] * xv[rr][i][3]);
                ss = wave_sum(ss);
                const float rstd = rsqrtf(ss * (1.f / 2048.f) + EPS);
                f32x4 ga = {0.f, 0.f, 0.f, 0.f}, gb = {0.f, 0.f, 0.f, 0.f};
#pragma unroll
                for (int i = 0; i < 4; ++i) {
                    const f32x4 g0 = *(const f32x4*)(p.norm1_g + i * 512 + lane * 8), g1 = *(const f32x4*)(p.norm1_g + i * 512 + lane * 8 + 4);
                    const f32x4 h0 = xv[rr][2 * i] * rstd * g0, h1 = xv[rr][2 * i + 1] * rstd * g1;
                    u32x4 w; w.x = cvt_pk_bf16(h0[0], h0[1]); w.y = cvt_pk_bf16(h0[2], h0[3]); w.z = cvt_pk_bf16(h1[0], h1[1]); w.w = cvt_pk_bf16(h1[2], h1[3]);
                    *(u32x4*)(XN + (size_t)row * DM + i * 512 + lane * 8) = w;
                    const LAS float* wb = wg + (i * 512 + lane * 8) * 8 + (i * 64 + lane) * 4;
#pragma unroll
                    for (int e = 0; e < 8; ++e) {
                        const float hv = e < 4 ? h0[e & 3] : h1[e & 3];
                        const f32x4 w0 = *(const LAS f32x4*)(wb + e * 8), w1 = *(const LAS f32x4*)(wb + e * 8 + 4);
                        ga = ga + w0 * hv; gb = gb + w1 * hv;
                    }
                }
                f32x4 m4 = lane < 32 ? ga : gb, s4 = lane < 32 ? gb : ga;
#pragma unroll
                for (int j = 0; j < 4; ++j) m4[j] += __shfl_xor(s4[j], 32);
                const bool up16 = (lane & 16) != 0;
                float m2a = up16 ? m4[2] : m4[0], m2b = up16 ? m4[3] : m4[1];
                const float s2a = up16 ? m4[0] : m4[2], s2b = up16 ? m4[1] : m4[3];
                m2a += __shfl_xor(s2a, 16); m2b += __shfl_xor(s2b, 16);
                const bool up8 = (lane & 8) != 0;
                float m1 = up8 ? m2b : m2a; const float s1 = up8 ? m2a : m2b;
                m1 += __shfl_xor(s1, 8);
                m1 += __shfl_xor(m1, 4); m1 += __shfl_xor(m1, 2); m1 += __shfl_xor(m1, 1);
                const int j = ((lane >> 5) << 2) | (((lane >> 4) & 1) << 1) | ((lane >> 3) & 1);
                if ((lane & 7) == 0) {
                    if (j < 4) IG[(size_t)row * 4 + j] = m1 + p.ml_b_i[j];
                    else { const float z = m1 + p.ml_b_f[j - 4]; LF[(size_t)row * 4 + j - 4] = fminf(z, 0.f) - log1pf(__expf(-fabsf(z))); }
                }
            }
        }
    }
    {
        const size_t nthr = (size_t)gridDim.x * NTHREADS, NQ = (size_t)16384 * 512;
        for (size_t base = (size_t)blockIdx.x * NTHREADS + tid; base < 2 * NQ; base += 4 * nthr) {
            f32x4 v[4];
#pragma unroll
            for (int u = 0; u < 4; ++u) {
                size_t i = base + u * nthr; if (i >= 2 * NQ) i = base;
                const int which = i >= NQ; const size_t j = i - (which ? NQ : 0);
                v[u] = *(const f32x4*)((which ? p.peer_v : p.peer_u) + j * 4);
            }
#pragma unroll
            for (int u = 0; u < 4; ++u) {
                size_t i = base + u * nthr; if (i >= 2 * NQ) i = base;
                const int which = i >= NQ; const size_t j = i - (which ? NQ : 0);
                const int row = (int)(j >> 9), c4 = (int)(j & 511);
                float amax = fmaxf(fmaxf(fabsf(v[u][0]), fabsf(v[u][1])), fmaxf(fabsf(v[u][2]), fabsf(v[u][3])));
                amax = fmaxf(amax, __uint_as_float((unsigned)__builtin_amdgcn_update_dpp(0, (int)__float_as_uint(amax), 0xB1, 0xF, 0xF, true)));
                amax = fmaxf(amax, __uint_as_float((unsigned)__builtin_amdgcn_update_dpp(0, (int)__float_as_uint(amax), 0x4E, 0xF, 0xF, true)));
                amax = fmaxf(amax, __uint_as_float((unsigned)__builtin_amdgcn_update_dpp(0, (int)__float_as_uint(amax), 0x141, 0xF, 0xF, true)));
                const unsigned sb = cvt_pk_bf16(amax * (1.f / 6.f), 0.f) & 0xffffu;
                float sc = bflo(sb); if (sc == 0.f) sc = 1.f;
                const float inv = 1.f / sc;
                unsigned r = 0u;
                r = __builtin_amdgcn_cvt_scalef32_pk_fp4_f32(r, v[u][0] * inv, v[u][1] * inv, 1.0f, 0);
                r = __builtin_amdgcn_cvt_scalef32_pk_fp4_f32(r, v[u][2] * inv, v[u][3] * inv, 1.0f, 1);
                unsigned char* dst = p.ws + (which ? WS_VB : WS_UB) + (size_t)row * 1152;
                *(unsigned short*)(dst + c4 * 2) = (unsigned short)(r & 0xffffu);
                if ((c4 & 7) == 0) *(unsigned short*)(dst + 1024 + (c4 >> 3) * 2) = (unsigned short)(sb == 0u ? 0x3F80u : sb);
            }
        }
    }
    {
        bf16_t* KB1 = (bf16_t*)(p.ws + WS_KB1); bf16_t* KB2 = (bf16_t*)(p.ws + WS_KB2);
        for (int i = blockIdx.x * NTHREADS + tid; i < 65536 / 4; i += gridDim.x * NTHREADS) {
            const f32x4 a = *(const f32x4*)(p.peer_k1 + i * 4), b = *(const f32x4*)(p.peer_k2 + i * 4);
            u32x2 w; w.x = cvt_pk_bf16(a[0], a[1]); w.y = cvt_pk_bf16(a[2], a[3]); *(u32x2*)(KB1 + i * 4) = w;
            w.x = cvt_pk_bf16(b[0], b[1]); w.y = cvt_pk_bf16(b[2], b[3]); *(u32x2*)(KB2 + i * 4) = w;
        }
    }
}

#define WAVE_LDS_SYNC() do { __builtin_amdgcn_fence(__ATOMIC_RELEASE, "wavefront"); __builtin_amdgcn_wave_barrier(); __builtin_amdgcn_fence(__ATOMIC_ACQUIRE, "wavefront"); } while (0)

template <int NG> DI void stage_T_load(const bf16_t* src, int ld, u32x4 (&r0)[NG], u32x4 (&r1)[NG], int wave, int lane) {
#pragma unroll
    for (int i = 0; i < NG; ++i) {
        const int g = wave + 8 * i;
        r0[i] = *(const u32x4*)(src + (size_t)(2 * lane) * ld + g * 8);
        r1[i] = *(const u32x4*)(src + (size_t)(2 * lane + 1) * ld + g * 8);
    }
}
template <int NG> DI void stage_T_store(const u32x4 (&r0)[NG], const u32x4 (&r1)[NG], LAS unsigned char* dst, int wave, int lane) {
#pragma unroll
    for (int i = 0; i < NG; ++i) {
        const int g = wave + 8 * i;
#pragma unroll
        for (int w = 0; w < 4; ++w) {
            const unsigned a = r0[i][w], b = r1[i][w];
            *(LAS unsigned*)(dst + (g * 8 + 2 * w) * 272 + lane * 4) = (a & 0xffffu) | (b << 16);
            *(LAS unsigned*)(dst + (g * 8 + 2 * w + 1) * 272 + lane * 4) = (a >> 16) | (b & 0xffff0000u);
        }
    }
}
template <int NG> DI void stage_T(const bf16_t* src, int ld, LAS unsigned char* dst, int wave, int lane) {
    u32x4 r0[NG], r1[NG];
    stage_T_load<NG>(src, ld, r0, r1, wave, lane);
    stage_T_store<NG>(r0, r1, dst, wave, lane);
}

DI void gmlp_bc(const Params& p, LAS unsigned char* lds, int b, int c) {
    const int tid = threadIdx.x, lane = tid & 63, wave = __builtin_amdgcn_readfirstlane(tid >> 6), fr = lane & 15, fq = lane >> 4;
    const int t0 = b * 8192 + c * 128;
    LAS unsigned char* Wl = lds; LAS unsigned char* GvT = lds + 34816; LAS float* rstdv = (LAS float*)(lds + 69632);
    const bf16_t* P = (const bf16_t*)(p.ws + WS_P); bf16_t* YM = (bf16_t*)(p.ws + WS_XN);
    const float* PSSV = (const float*)(p.ws + WS_PSSV);
    __syncthreads();
    if (tid < 128) {
        float ss = 0.f;
#pragma unroll
        for (int i = 0; i < 4; ++i) { const f32x4 v = *(const f32x4*)(PSSV + (size_t)(t0 + tid) * 16 + i * 4); ss += (v[0] + v[1]) + (v[2] + v[3]); }
        rstdv[tid] = rsqrtf(ss * (1.f / 1024.f) + EPS);
    }
    f32x4 wa[4][2]; u32x4 gr0[2], gr1[2];
#define GMLP_PREFETCH(hh) do { _Pragma("unroll") for (int it = 0; it < 4; ++it) { const int e = (it * NTHREADS + tid) * 8, t = e >> 7, s0 = e & 127; \
            const float* wp = p.w_spatial + ((size_t)((hh) * 128 + t)) * 128 + s0; wa[it][0] = *(const f32x4*)wp; wa[it][1] = *(const f32x4*)(wp + 4); } \
        stage_T_load<2>(P + p_off<1024, 8, 128>(t0, (hh), 0), 128, gr0, gr1, wave, lane); } while (0)
    GMLP_PREFETCH(0);
    for (int h = 0; h < 8; ++h) {
        __syncthreads();
#pragma unroll
        for (int it = 0; it < 4; ++it) {
            const int e = (it * NTHREADS + tid) * 8, t = e >> 7, s0 = e & 127;
            float v[8];
#pragma unroll
            for (int j = 0; j < 8; ++j) { const float a = j < 4 ? wa[it][0][j & 3] : wa[it][1][j & 3]; v[j] = (s0 + j <= t) ? a * rstdv[s0 + j] : 0.f; }
            u32x4 w; w.x = cvt_pk_bf16(v[0], v[1]); w.y = cvt_pk_bf16(v[2], v[3]); w.z = cvt_pk_bf16(v[4], v[5]); w.w = cvt_pk_bf16(v[6], v[7]);
            *(LAS u32x4*)(Wl + t * 272 + s0 * 2) = w;
        }
        stage_T_store<2>(gr0, gr1, GvT, wave, lane);
        __syncthreads();
        if (h + 1 < 8) GMLP_PREFETCH(h + 1);
        f32x4 acc[8];
#pragma unroll
        for (int n = 0; n < 8; ++n) acc[n] = (f32x4){0.f, 0.f, 0.f, 0.f};
        const int kmax = (16 * wave + 15) >> 5;
#pragma unroll
        for (int kk = 0; kk < 4; ++kk) {
            if (kk <= kmax) {
                const bf16x8 bfrag = ld_frag_lds(Wl + (16 * wave + fr) * 272 + (32 * kk + 8 * fq) * 2);
#pragma unroll
                for (int n = 0; n < 8; ++n) { const bf16x8 afrag = ld_frag_lds(GvT + (16 * n + fr) * 272 + (32 * kk + 8 * fq) * 2); acc[n] = MFMA16(afrag, bfrag, acc[n]); }
            }
        }
        const int t = 16 * wave + fr; const size_t grow = (size_t)(t0 + t);
        const float bsp = p.b_spatial[h * 128 + t];
        float ss = 0.f;
#pragma unroll
        for (int n = 0; n < 8; ++n) {
            const int d0 = 16 * n + 4 * fq;
            const u32x2 uw = *(const u32x2*)(P + p_off<0, 8, 128>(t0 + t, h, d0));
            const f32x4 gv = *(const f32x4*)(p.gm_vnorm_g + h * 128 + d0);
            f32x4 y;
            y[0] = bflo(uw.x) * (gv[0] * acc[n][0] + bsp); y[1] = bfhi(uw.x) * (gv[1] * acc[n][1] + bsp);
            y[2] = bflo(uw.y) * (gv[2] * acc[n][2] + bsp); y[3] = bfhi(uw.y) * (gv[3] * acc[n][3] + bsp);
            ss += (y[0] * y[0] + y[1] * y[1]) + (y[2] * y[2] + y[3] * y[3]);
            acc[n] = y;
        }
        ss += __shfl_xor(ss, 16); ss += __shfl_xor(ss, 32);
        const float rstd = rsqrtf(ss * (1.f / 128.f) + EPS);
#pragma unroll
        for (int n = 0; n < 8; ++n) {
            const int d0 = 16 * n + 4 * fq;
            const f32x4 g = *(const f32x4*)(p.gm_out_g + h * 128 + d0);
            const f32x4 o = acc[n] * rstd * g;
            u32x2 w; w.x = cvt_pk_bf16(o[0], o[1]); w.y = cvt_pk_bf16(o[2], o[3]);
            *(u32x2*)(YM + grow * DM + h * 128 + d0) = w;
        }
    }
}

DI void mlstm_local(const Params& p, LAS unsigned char* lds, int b, int c, int h) {
    const int tid = threadIdx.x, lane = tid & 63, wave = __builtin_amdgcn_readfirstlane(tid >> 6), fr = lane & 15, fq = lane >> 4;
    const int bh = b * 4 + h, t0 = b * 8192 + c * 128;
    LAS unsigned char* KT = lds; LAS unsigned char* VT = lds + 34816; LAS float* wsv = (LAS float*)(lds + 108800);
    const bf16_t* P = (const bf16_t*)(p.ws + WS_P);
    bf16_t* QC = (bf16_t*)(p.ws + WS_QC); bf16_t* KC = (bf16_t*)(p.ws + WS_KC);
    const float* IG = (const float*)(p.ws + WS_IG); const float* LF = (const float*)(p.ws + WS_LF);
    LAS float* cwl = (LAS float*)(lds + 109312);
    __syncthreads();
    u32x4 xw[2][5];
#define CONV_LOAD(half) do { _Pragma("unroll") for (int gi = 0; gi < 2; ++gi) { const int g = wave + 8 * (gi + 2 * (half)); const int cgp = (g & 15) * 8; \
        _Pragma("unroll") for (int dj = 0; dj < 5; ++dj) { const int srow = 2 * lane - 3 + dj; xw[gi][dj] = (u32x4){0u, 0u, 0u, 0u}; \
            if (c > 0 || srow >= 0) xw[gi][dj] = *(const u32x4*)(P + ((half) ? p_off<2560, 4, 128>(t0 + srow, h, cgp) : p_off<2048, 4, 128>(t0 + srow, h, cgp))); } } } while (0)
    CONV_LOAD(0);
    for (int idx = tid; idx < 1280; idx += NTHREADS) {
        const int j = idx >> 8, cc = idx & 255, ch = (cc >= 128 ? 512 : 0) + h * 128 + (cc & 127);
        cwl[idx] = j < 4 ? p.ml_conv_w[j * 1024 + ch] : p.ml_conv_b[ch];
    }
    if (wave == 0) {
        const float l0 = LF[(size_t)(t0 + 2 * lane) * 4 + h], l1 = LF[(size_t)(t0 + 2 * lane + 1) * 4 + h];
        const float i0 = IG[(size_t)(t0 + 2 * lane) * 4 + h], i1 = IG[(size_t)(t0 + 2 * lane + 1) * 4 + h];
        float s = l0 + l1;
#pragma unroll
        for (int off = 1; off < 64; off <<= 1) { const float tt = __shfl_up(s, off); if (lane >= off) s += tt; }
        const float b1 = s, b0 = s - l1, bend = __shfl(s, 63);
        const float g0 = bend - b0 + i0, g1 = bend - b1 + i1;
        const float gmax = wave_max(fmaxf(g0, g1));
        wsv[2 * lane] = __expf(g0 - gmax); wsv[2 * lane + 1] = __expf(g1 - gmax);
        if (lane == 0) { ((float*)(p.ws + WS_BEND))[bh * 64 + c] = bend; ((float*)(p.ws + WS_GMAX))[bh * 64 + c] = gmax; }
    }
    __syncthreads();
#pragma unroll
    for (int gi4 = 0; gi4 < 4; ++gi4) {
        const int gi = gi4 & 1;
        if (gi4 == 2) CONV_LOAD(1);
        const int g = wave + 8 * gi4; const bool isk = gi4 >= 2; const int cgp = (g & 15) * 8;
        const int cc0 = (isk ? 128 : 0) + cgp;
        const int s = 2 * lane;
        float y0[8], y1[8];
        {
            const f32x4 cb0 = *(const LAS f32x4*)(cwl + 1024 + cc0), cb1 = *(const LAS f32x4*)(cwl + 1024 + cc0 + 4);
#pragma unroll
            for (int e = 0; e < 8; ++e) { y0[e] = e < 4 ? cb0[e & 3] : cb1[e & 3]; y1[e] = y0[e]; }
#pragma unroll
            for (int j = 0; j < 5; ++j) {
                float xr[8];
#pragma unroll
                for (int q = 0; q < 4; ++q) { xr[2 * q] = bflo(xw[gi][j][q]); xr[2 * q + 1] = bfhi(xw[gi][j][q]); }
                if (j < 4) {
                    const f32x4 w0 = *(const LAS f32x4*)(cwl + j * 256 + cc0), w1 = *(const LAS f32x4*)(cwl + j * 256 + cc0 + 4);
#pragma unroll
                    for (int e = 0; e < 8; ++e) y0[e] += (e < 4 ? w0[e & 3] : w1[e & 3]) * xr[e];
                }
                if (j > 0) {
                    const f32x4 w0 = *(const LAS f32x4*)(cwl + (j - 1) * 256 + cc0), w1 = *(const LAS f32x4*)(cwl + (j - 1) * 256 + cc0 + 4);
#pragma unroll
                    for (int e = 0; e < 8; ++e) y1[e] += (e < 4 ? w0[e & 3] : w1[e & 3]) * xr[e];
                }
            }
        }
        const float sc = isk ? 0.08838834764831845f : 1.f;
#pragma unroll
        for (int e = 0; e < 8; ++e) { y0[e] = y0[e] * sigmoid_(y0[e]) * sc; y1[e] = y1[e] * sigmoid_(y1[e]) * sc; }
        bf16_t* dst = (isk ? KC : QC) + (size_t)(t0 + s) * 512 + h * 128 + cgp;
        u32x4 w; w.x = cvt_pk_bf16(y0[0], y0[1]); w.y = cvt_pk_bf16(y0[2], y0[3]); w.z = cvt_pk_bf16(y0[4], y0[5]); w.w = cvt_pk_bf16(y0[6], y0[7]);
        *(u32x4*)dst = w;
        w.x = cvt_pk_bf16(y1[0], y1[1]); w.y = cvt_pk_bf16(y1[2], y1[3]); w.z = cvt_pk_bf16(y1[4], y1[5]); w.w = cvt_pk_bf16(y1[6], y1[7]);
        *(u32x4*)(dst + 512) = w;
        if (isk) {
            const float w0 = wsv[s], w1 = wsv[s + 1];
#pragma unroll
            for (int e = 0; e < 8; ++e) *(LAS unsigned*)(KT + (cgp + e) * 272 + lane * 4) = cvt_pk_bf16(y0[e] * w0, y1[e] * w1);
        }
    }
    stage_T<4>(P + p_off<3072, 4, 256>(t0, h, 0), 256, VT, wave, lane);
    for (int i = tid; i < 1024; i += NTHREADS) { const int r = i >> 6, w = i & 63; *(LAS unsigned*)(VT + (256 + r) * 272 + w * 4) = 0x3F803F80u; }
    __syncthreads();
    bf16x8 af[4];
#pragma unroll
    for (int kk = 0; kk < 4; ++kk) af[kk] = ld_frag_lds(KT + (16 * wave + fr) * 272 + (32 * kk + 8 * fq) * 2);
    float* ST = (float*)(p.ws + WS_ST) + ((size_t)(bh * 64 + c) * 272) * 128;
#pragma unroll
    for (int n = 0; n < 17; ++n) {
        f32x4 acc = {0.f, 0.f, 0.f, 0.f};
#pragma unroll
        for (int kk = 0; kk < 4; ++kk) { const bf16x8 bfr = ld_frag_lds(VT + (16 * n + fr) * 272 + (32 * kk + 8 * fq) * 2); acc = MFMA16(af[kk], bfr, acc); }
        if (n < 16 || fr == 0) *(f32x4*)(ST + (size_t)(16 * n + fr) * 128 + 16 * wave + 4 * fq) = acc;
    }
}

DI void phase_scan(const Params& p) {
    const float* ST = (const float*)(p.ws + WS_ST); bf16_t* CPT = (bf16_t*)(p.ws + WS_CPT);
    const float* BEND = (const float*)(p.ws + WS_BEND); const float* GMAX = (const float*)(p.ws + WS_GMAX); float* MPREV = (float*)(p.ws + WS_MPREV);
    const int gtid = blockIdx.x * NTHREADS + threadIdx.x, nthr = gridDim.x * NTHREADS;
    constexpr int PER = 8224;
    constexpr size_t CST = 272 * 128;
    for (int item = gtid; item < 16 * PER; item += nthr) {
        const int bh = item / PER, e4 = item - bh * PER;
        const float* src = ST + (size_t)bh * 64 * CST + (size_t)e4 * 4;
        bf16_t* dst = CPT + (size_t)bh * 64 * CST + (size_t)e4 * 4;
        f32x4 st = {0.f, 0.f, 0.f, 0.f}; float m = 0.f;
        for (int c0 = 0; c0 < 64; c0 += 8) {
            f32x4 d[8];
#pragma unroll
            for (int j = 0; j < 8; ++j) d[j] = *(const f32x4*)(src + (size_t)(c0 + j) * CST);
#pragma unroll
            for (int j = 0; j < 8; ++j) {
                const int c = c0 + j;
                const float be = BEND[bh * 64 + c], gm = GMAX[bh * 64 + c];
                const float mn = fmaxf(be + m, gm), a = __expf(be + m - mn), sc = __expf(gm - mn);
                u32x2 w; w.x = cvt_pk_bf16(st[0], st[1]); w.y = cvt_pk_bf16(st[2], st[3]);
                *(u32x2*)(dst + (size_t)c * CST) = w;
                if (e4 == 0) MPREV[bh * 64 + c] = m;
                st = st * a + d[j] * sc; m = mn;
            }
        }
    }
}

DI void mlstm_out(const Params& p, LAS unsigned char* lds, int b, int c, int h) {
    const int tid = threadIdx.x, lane = tid & 63, wave = __builtin_amdgcn_readfirstlane(tid >> 6), fr = lane & 15, fq = lane >> 4;
    const int bh = b * 4 + h, t0 = b * 8192 + c * 128;
    LAS unsigned char* Kl = lds; LAS unsigned char* Sl = lds + 34816; LAS unsigned char* VTe = lds + 69632;
    LAS float* av = (LAS float*)(lds + 143616); LAS float* Mv = (LAS float*)(lds + 144128); LAS float* bv = (LAS float*)(lds + 144640);
    const bf16_t* P = (const bf16_t*)(p.ws + WS_P); bf16_t* YM = (bf16_t*)(p.ws + WS_XN);
    const bf16_t* QC = (const bf16_t*)(p.ws + WS_QC); const bf16_t* KC = (const bf16_t*)(p.ws + WS_KC);
    const float* IG = (const float*)(p.ws + WS_IG); const float* LF = (const float*)(p.ws + WS_LF);
    const float mprev = ((const float*)(p.ws + WS_MPREV))[bh * 64 + c];
    __syncthreads();
    if (wave == 0) {
        const float l0 = LF[(size_t)(t0 + 2 * lane) * 4 + h], l1 = LF[(size_t)(t0 + 2 * lane + 1) * 4 + h];
        const float i0 = IG[(size_t)(t0 + 2 * lane) * 4 + h], i1 = IG[(size_t)(t0 + 2 * lane + 1) * 4 + h];
        float s = l0 + l1;
#pragma unroll
        for (int off = 1; off < 64; off <<= 1) { const float tt = __shfl_up(s, off); if (lane >= off) s += tt; }
        const float b1 = s, b0 = s - l1;
        const float a0 = i0 - b0, a1 = i1 - b1;
        float pm = fmaxf(a0, a1);
#pragma unroll
        for (int off = 1; off < 64; off <<= 1) { const float tt = __shfl_up(pm, off); if (lane >= off) pm = fmaxf(pm, tt); }
        float ex = __shfl_up(pm, 1); if (lane == 0) ex = -3.0e38f;
        Mv[2 * lane] = fmaxf(mprev, fmaxf(ex, a0)); Mv[2 * lane + 1] = fmaxf(mprev, pm);
        av[2 * lane] = a0; av[2 * lane + 1] = a1; bv[2 * lane] = b0; bv[2 * lane + 1] = b1;
    }
#pragma unroll
    for (int it = 0; it < 4; ++it) {
        const int e = (it * NTHREADS + tid) * 8, s = e >> 7, d0 = e & 127;
        *(LAS u32x4*)(Kl + s * 272 + d0 * 2) = *(const u32x4*)(KC + (size_t)(t0 + s) * 512 + h * 128 + d0);
    }
    stage_T<4>(P + p_off<3072, 4, 256>(t0, h, 0), 256, VTe, wave, lane);
    for (int i = tid; i < 1024; i += NTHREADS) { const int r = i >> 6, w = i & 63; *(LAS unsigned*)(VTe + (256 + r) * 272 + w * 4) = 0x3F803F80u; }
    bf16x8 qf[4];
#pragma unroll
    for (int kk = 0; kk < 4; ++kk) qf[kk] = *(const bf16x8*)(QC + (size_t)(t0 + 16 * wave + fr) * 512 + h * 128 + 32 * kk + 8 * fq);
    __syncthreads();
    const int t = 16 * wave + fr; const float Mt = Mv[t];
    const int stmax = wave | 1;
    for (int st = 0; st <= stmax; ++st) {
        f32x4 s4 = {0.f, 0.f, 0.f, 0.f};
#pragma unroll
        for (int kk = 0; kk < 4; ++kk) { const bf16x8 kf = ld_frag_lds(Kl + (16 * st + fr) * 272 + (32 * kk + 8 * fq) * 2); s4 = MFMA16(kf, qf[kk], s4); }
#pragma unroll
        for (int r = 0; r < 4; ++r) { const int s = 16 * st + 4 * fq + r; const float w = (s <= t) ? __expf(av[s] - Mt) : 0.f; s4[r] *= w; }
        u32x2 w; w.x = cvt_pk_bf16(s4[0], s4[1]); w.y = cvt_pk_bf16(s4[2], s4[3]);
        *(LAS u32x2*)(Sl + t * 272 + (16 * st + 4 * fq) * 2) = w;
    }
    __syncthreads();
    const bf16_t* cpt = (const bf16_t*)(p.ws + WS_CPT) + ((size_t)(bh * 64 + c) * 272) * 128;
    f32x4 acc[17];
#pragma unroll
    for (int n = 0; n < 17; ++n) {
        acc[n] = (f32x4){0.f, 0.f, 0.f, 0.f};
#pragma unroll
        for (int kk = 0; kk < 4; ++kk) { const bf16x8 cf = *(const bf16x8*)(cpt + (size_t)(16 * n + fr) * 128 + 32 * kk + 8 * fq); acc[n] = MFMA16(cf, qf[kk], acc[n]); }
    }
    const float ai = __expf(mprev - Mt);
#pragma unroll
    for (int n = 0; n < 17; ++n) acc[n] = acc[n] * ai;
    const int k2max = (16 * wave + 15) >> 5;
#pragma unroll
    for (int kk = 0; kk < 4; ++kk) {
        if (kk <= k2max) {
            const bf16x8 sf = ld_frag_lds(Sl + t * 272 + (32 * kk + 8 * fq) * 2);
#pragma unroll
            for (int n = 0; n < 17; ++n) { const bf16x8 vf = ld_frag_lds(VTe + (16 * n + fr) * 272 + (32 * kk + 8 * fq) * 2); acc[n] = MFMA16(vf, sf, acc[n]); }
        }
    }
    const float den = __shfl(acc[16][0], fr);
    const float mt = bv[t] + Mt;
    const float inv = rcpf_(fmaxf(fabsf(den), __expf(-mt)));
    const size_t grow = (size_t)(t0 + t);
    float ss = 0.f;
#pragma unroll
    for (int n = 0; n < 16; ++n) {
        const int v0 = 16 * n + 4 * fq;
        const u32x2 ow = *(const u32x2*)(P + p_off<4096, 4, 256>(t0 + t, h, v0));
        f32x4 y;
        y[0] = bflo(ow.x) * acc[n][0] * inv; y[1] = bfhi(ow.x) * acc[n][1] * inv; y[2] = bflo(ow.y) * acc[n][2] * inv; y[3] = bfhi(ow.y) * acc[n][3] * inv;
        ss += (y[0] * y[0] + y[1] * y[1]) + (y[2] * y[2] + y[3] * y[3]);
        acc[n] = y;
    }
    ss += __shfl_xor(ss, 16); ss += __shfl_xor(ss, 32);
    const float rstd = rsqrtf(ss * (1.f / 256.f) + EPS);
#pragma unroll
    for (int n = 0; n < 16; ++n) {
        const int v0 = 16 * n + 4 * fq;
        const f32x4 g = *(const f32x4*)(p.ml_out_g + h * 256 + v0);
        const f32x4 o = acc[n] * rstd * g;
        u32x2 w; w.x = cvt_pk_bf16(o[0], o[1]); w.y = cvt_pk_bf16(o[2], o[3]);
        *(u32x2*)(YM + grow * DM + 1024 + h * 256 + v0) = w;
    }
}

DI unsigned ord_key(float f) { const unsigned u = __float_as_uint(f); return (u & 0x80000000u) ? ~u : (u | 0x80000000u); }
DI float key_val(unsigned k) { return (k & 0x80000000u) ? __uint_as_float(k & 0x7fffffffu) : __uint_as_float(~k); }
DI unsigned umax_(unsigned a, unsigned b) { return a > b ? a : b; }
DI unsigned umin_(unsigned a, unsigned b) { return a < b ? a : b; }
#define DPPU(v, ctrl) ((unsigned)__builtin_amdgcn_update_dpp(0, (int)(v), (ctrl), 0xF, 0xF, true))
DI unsigned row_max_u32(unsigned v) {
    v = umax_(v, DPPU(v, 0xB1)); v = umax_(v, DPPU(v, 0x4E)); v = umax_(v, DPPU(v, 0x141)); v = umax_(v, DPPU(v, 0x140)); return v;
}
DI float row_sum_f32(float v) {
    v += __uint_as_float(DPPU(__float_as_uint(v), 0xB1)); v += __uint_as_float(DPPU(__float_as_uint(v), 0x4E));
    v += __uint_as_float(DPPU(__float_as_uint(v), 0x141)); v += __uint_as_float(DPPU(__float_as_uint(v), 0x140)); return v;
}
#define CEX(a, b) do { const unsigned mx_ = umax_(a, b), mn_ = umin_(a, b); a = mx_; b = mn_; } while (0)
template <int N> DI unsigned top16_row(unsigned (&s)[N], int c) {
    unsigned list = 0u;
#pragma unroll 1
    for (int it = 0; it < 16; ++it) {
        const unsigned wm = row_max_u32(s[0]);
        const bool win = (s[0] == wm);
#pragma unroll
        for (int i = 0; i < N - 1; ++i) s[i] = win ? s[i + 1] : s[i];
        s[N - 1] = win ? 0u : s[N - 1];
        list = (c == it) ? wm : list;
    }
    return list;
}

template <int N> DI void top16_row2(unsigned (&s)[N], unsigned (&t)[N], int c, unsigned& l1, unsigned& l2) {
    l1 = 0u; l2 = 0u;
#pragma unroll 1
    for (int it = 0; it < 16; ++it) {
        const unsigned wm1 = row_max_u32(s[0]), wm2 = row_max_u32(t[0]);
        const bool win1 = (s[0] == wm1), win2 = (t[0] == wm2);
#pragma unroll
        for (int i = 0; i < N - 1; ++i) { s[i] = win1 ? s[i + 1] : s[i]; t[i] = win2 ? t[i + 1] : t[i]; }
        s[N - 1] = win1 ? 0u : s[N - 1]; t[N - 1] = win2 ? 0u : t[N - 1];
        l1 = (c == it) ? wm1 : l1; l2 = (c == it) ? wm2 : l2;
    }
}

DI void peer_select(const Params& p) {
    const int tid = threadIdx.x, lane = tid & 63, wave = __builtin_amdgcn_readfirstlane(tid >> 6), c = lane & 15, g = lane >> 4, rowbase = lane & 48;
    const bf16_t* Q = (const bf16_t*)(p.ws + WS_Q); const bf16_t* KB1 = (const bf16_t*)(p.ws + WS_KB1); const bf16_t* KB2 = (const bf16_t*)(p.ws + WS_KB2);
    int* SELID = (int*)(p.ws + WS_SELID); float* SELG = (float*)(p.ws + WS_SELG);
    unsigned pk = 0u, validmask = 0u;
#pragma unroll
    for (int q = 0; q < 4; ++q) {
        const int target = 4 * c + q; int ci = 0, cj = 0, cnt = 0; bool v = false;
#pragma unroll
        for (int i = 0; i < 16; ++i) { const int nj = 16 / (i + 1); if (target >= cnt && target < cnt + nj) { ci = i; cj = target - cnt; v = true; } cnt += nj; }
        pk |= (unsigned)((ci << 4) | cj) << (8 * q); validmask |= (v ? 1u : 0u) << q;
    }
    for (int tile = blockIdx.x * 8 + wave; tile < T_TOK / 16; tile += gridDim.x * 8) {
        const int tok0 = tile * 16;
        for (int h = 0; h < 8; ++h) {
            bf16x8 a1[2], a2[2];
            {
                const bf16_t* qp = Q + (size_t)(tok0 + c) * 1024 + h * 128 + g * 8;
                a1[0] = *(const bf16x8*)qp; a1[1] = *(const bf16x8*)(qp + 32); a2[0] = *(const bf16x8*)(qp + 64); a2[1] = *(const bf16x8*)(qp + 96);
            }
            f32x4 acc1[8], acc2[8];
#pragma unroll
            for (int nt = 0; nt < 8; ++nt) {
                const size_t ko = ((size_t)(h * 128 + nt * 16 + c)) * 64 + g * 8;
                acc1[nt] = (f32x4){0.f, 0.f, 0.f, 0.f}; acc2[nt] = (f32x4){0.f, 0.f, 0.f, 0.f};
                acc1[nt] = MFMA16(a1[0], *(const bf16x8*)(KB1 + ko), acc1[nt]); acc1[nt] = MFMA16(a1[1], *(const bf16x8*)(KB1 + ko + 32), acc1[nt]);
                acc2[nt] = MFMA16(a2[0], *(const bf16x8*)(KB2 + ko), acc2[nt]); acc2[nt] = MFMA16(a2[1], *(const bf16x8*)(KB2 + ko + 32), acc2[nt]);
            }
#pragma unroll
            for (int r = 0; r < 4; ++r) {
                unsigned s[8], s2[8];
#pragma unroll
                for (int nt = 0; nt < 8; ++nt) {
                    s[nt] = (ord_key(acc1[nt][r]) & ~0x7Fu) | (unsigned)(127 - (nt * 16 + c));
                    s2[nt] = (ord_key(acc2[nt][r]) & ~0x7Fu) | (unsigned)(127 - (nt * 16 + c));
                }
                CEX(s[0], s[1]); CEX(s[2], s[3]); CEX(s[4], s[5]); CEX(s[6], s[7]); CEX(s[0], s[2]); CEX(s[1], s[3]); CEX(s[4], s[6]); CEX(s[5], s[7]); CEX(s[1], s[2]); CEX(s[5], s[6]);
                CEX(s[0], s[4]); CEX(s[1], s[5]); CEX(s[2], s[6]); CEX(s[3], s[7]); CEX(s[2], s[4]); CEX(s[3], s[5]); CEX(s[1], s[2]); CEX(s[3], s[4]); CEX(s[5], s[6]);
                CEX(s2[0], s2[1]); CEX(s2[2], s2[3]); CEX(s2[4], s2[5]); CEX(s2[6], s2[7]); CEX(s2[0], s2[2]); CEX(s2[1], s2[3]); CEX(s2[4], s2[6]); CEX(s2[5], s2[7]); CEX(s2[1], s2[2]); CEX(s2[5], s2[6]);
                CEX(s2[0], s2[4]); CEX(s2[1], s2[5]); CEX(s2[2], s2[6]); CEX(s2[3], s2[7]); CEX(s2[2], s2[4]); CEX(s2[3], s2[5]); CEX(s2[1], s2[2]); CEX(s2[3], s2[4]); CEX(s2[5], s2[6]);
                unsigned list1, list2;
                top16_row2<8>(s, s2, c, list1, list2);
                unsigned cs[4];
#pragma unroll
                for (int q = 0; q < 4; ++q) {
                    const int ci = (int)((pk >> (8 * q + 4)) & 15u), cj = (int)((pk >> (8 * q)) & 15u);
                    const unsigned k1 = (unsigned)__shfl((int)list1, rowbase + ci), k2 = (unsigned)__shfl((int)list2, rowbase + cj);
                    const float cand = key_val(k1 & ~0x7Fu) + key_val(k2 & ~0x7Fu);
                    cs[q] = ((validmask >> q) & 1u) ? ((ord_key(cand) & ~0x3Fu) | (unsigned)(63 - (4 * c + q))) : 0u;
                }
                CEX(cs[0], cs[1]); CEX(cs[2], cs[3]); CEX(cs[0], cs[2]); CEX(cs[1], cs[3]); CEX(cs[1], cs[2]);
                const unsigned sel = top16_row<4>(cs, c);
                const int slot = 63 - (int)(sel & 63u);
                const unsigned pkv = (unsigned)__shfl((int)pk, rowbase + (slot >> 2));
                const int cij = (int)((pkv >> (8 * (slot & 3))) & 0xFFu);
                const unsigned e1 = (unsigned)__shfl((int)list1, rowbase + (cij >> 4)), e2 = (unsigned)__shfl((int)list2, rowbase + (cij & 15));
                const int eid = (127 - (int)(e1 & 127u)) * 128 + (127 - (int)(e2 & 127u));
                const float sv = key_val(sel & ~0x3Fu), mx = key_val(row_max_u32(sel) & ~0x3Fu);
                const float ev = __expf(sv - mx);
                const float sum = row_sum_f32(ev);
                const size_t o = (size_t)(tok0 + 4 * g + r) * 128 + h * 16 + c;
                SELID[o] = eid; SELG[o] = ev * rcpf_(sum);
            }
        }
    }
}

DI f32x2 pkfma(f32x2 a, f32x2 b, f32x2 c) { return __builtin_elementwise_fma(a, b, c); }
DI void peer_gather(const Params& p, LAS unsigned char* lds) {
    const int tid = threadIdx.x, lane = tid & 63, wave = __builtin_amdgcn_readfirstlane(tid >> 6);
    LAS float* scr = (LAS float*)lds + wave * (16 * 68);
    LAS float* cfl = (LAS float*)(lds + 8 * 16 * 68 * 4) + wave * 128;
    const unsigned char* Ub = p.ws + WS_UB; const unsigned char* Vb = p.ws + WS_VB;
    const float* PSS2 = (const float*)(p.ws + WS_PSS2);
    const int* SELID = (const int*)(p.ws + WS_SELID); const float* SELG = (const float*)(p.ws + WS_SELG);
    const int gw = blockIdx.x * 8 + wave, nw = gridDim.x * 8;
    for (int t = gw; t < T_TOK; t += nw) {
        const int idA = SELID[(size_t)t * 128 + lane], idB = SELID[(size_t)t * 128 + 64 + lane];
        const float gA = SELG[(size_t)t * 128 + lane], gB = SELG[(size_t)t * 128 + 64 + lane];
        const bf16_t* xrow = (const bf16_t*)(p.ws + WS_X1G) + (size_t)t * DM + lane * 32;
        float* orow = p.out + (size_t)t * DM + lane * 32;
        const float pv = lane < 32 ? PSS2[(size_t)t * 32 + lane] : 0.f;
        const float rstd2 = rsqrtf(wave_sum(pv) * (1.f / 2048.f) + EPS);
        f32x2 h2[16];
#pragma unroll
        for (int q = 0; q < 4; ++q) {
            const u32x4 xw = *(const u32x4*)(xrow + q * 8);
            const f32x4 g0 = *(const f32x4*)(p.norm2_g + lane * 32 + q * 8), g1 = *(const f32x4*)(p.norm2_g + lane * 32 + q * 8 + 4);
            h2[4 * q] = (f32x2){bflo(xw.x) * rstd2 * g0[0], bfhi(xw.x) * rstd2 * g0[1]};
            h2[4 * q + 1] = (f32x2){bflo(xw.y) * rstd2 * g0[2], bfhi(xw.y) * rstd2 * g0[3]};
            h2[4 * q + 2] = (f32x2){bflo(xw.z) * rstd2 * g1[0], bfhi(xw.z) * rstd2 * g1[1]};
            h2[4 * q + 3] = (f32x2){bflo(xw.w) * rstd2 * g1[2], bfhi(xw.w) * rstd2 * g1[3]};
        }
        constexpr int NPK = 8;
        u32x4 buf[2][NPK]; unsigned short bsc[2][NPK];
#define PEER_LOAD(TB, st, base) do { const int idv_ = ((base) < 64) ? idA : idB; _Pragma("unroll") for (int e_ = 0; e_ < NPK; ++e_) { \
            const int id_ = __builtin_amdgcn_readlane(idv_, ((base) + e_) & 63); const unsigned char* r_ = (TB) + (size_t)id_ * 1152; \
            buf[st][e_] = *(const u32x4*)(r_ + lane * 16); bsc[st][e_] = *(const unsigned short*)(r_ + 1024 + lane * 2); } } while (0)
#define PEER_DOT(st, slot0) do { _Pragma("unroll") for (int e_ = 0; e_ < NPK; ++e_) { f32x2 a2_ = {0.f, 0.f}; \
            _Pragma("unroll") for (int d_ = 0; d_ < 4; ++d_) { const unsigned w_ = buf[st][e_][d_]; \
                a2_ = pkfma(h2[d_ * 4 + 0], __builtin_amdgcn_cvt_scalef32_pk_f32_fp4(w_, 1.0f, 0), a2_); a2_ = pkfma(h2[d_ * 4 + 1], __builtin_amdgcn_cvt_scalef32_pk_f32_fp4(w_, 1.0f, 1), a2_); \
                a2_ = pkfma(h2[d_ * 4 + 2], __builtin_amdgcn_cvt_scalef32_pk_f32_fp4(w_, 1.0f, 2), a2_); a2_ = pkfma(h2[d_ * 4 + 3], __builtin_amdgcn_cvt_scalef32_pk_f32_fp4(w_, 1.0f, 3), a2_); } \
            scr[((slot0) + e_) * 68 + lane] = (a2_[0] + a2_[1]) * bf2f(bsc[st][e_]); } } while (0)
        PEER_LOAD(Ub, 0, 0);
        for (int b = 0; b < 128 / NPK; b += 2) {
            PEER_LOAD(Ub, 1, (b + 1) * NPK);
            PEER_DOT(0, (b * NPK) & 15);
            if (b + 2 < 128 / NPK) PEER_LOAD(Ub, 0, (b + 2) * NPK);
            PEER_DOT(1, ((b + 1) * NPK) & 15);
            if ((((b + 2) * NPK) & 15) == 0) {
                WAVE_LDS_SYNC();
                float sum = 0.f;
#pragma unroll
                for (int i = 0; i < 4; ++i) { const f32x4 r = *(const LAS f32x4*)(scr + (lane >> 2) * 68 + (lane & 3) * 16 + 4 * i); sum += (r[0] + r[1]) + (r[2] + r[3]); }
                sum += __shfl_xor(sum, 1); sum += __shfl_xor(sum, 2);
                const int k0 = (b + 2) * NPK - 16;
                const int k = k0 + (lane >> 2);
                const float gate = __shfl((k0 < 64) ? gA : gB, k & 63);
                if ((lane & 3) == 0) cfl[k] = gate * gelu_t(sum);
                WAVE_LDS_SYNC();
            }
        }
        f32x2 acc[16];
#pragma unroll
        for (int i = 0; i < 16; ++i) acc[i] = (f32x2){0.f, 0.f};
#define PEER_AXPY(st, base) do { _Pragma("unroll") for (int e_ = 0; e_ < NPK; ++e_) { const float c_ = cfl[(base) + e_] * bf2f(bsc[st][e_]); const f32x2 c2_ = {c_, c_}; \
            _Pragma("unroll") for (int d_ = 0; d_ < 4; ++d_) { const unsigned w_ = buf[st][e_][d_]; \
                acc[d_ * 4 + 0] = pkfma(c2_, __builtin_amdgcn_cvt_scalef32_pk_f32_fp4(w_, 1.0f, 0), acc[d_ * 4 + 0]); acc[d_ * 4 + 1] = pkfma(c2_, __builtin_amdgcn_cvt_scalef32_pk_f32_fp4(w_, 1.0f, 1), acc[d_ * 4 + 1]); \
                acc[d_ * 4 + 2] = pkfma(c2_, __builtin_amdgcn_cvt_scalef32_pk_f32_fp4(w_, 1.0f, 2), acc[d_ * 4 + 2]); acc[d_ * 4 + 3] = pkfma(c2_, __builtin_amdgcn_cvt_scalef32_pk_f32_fp4(w_, 1.0f, 3), acc[d_ * 4 + 3]); } } } while (0)
        PEER_LOAD(Vb, 0, 0);
        for (int b = 0; b < 128 / NPK; b += 2) {
            PEER_LOAD(Vb, 1, (b + 1) * NPK);
            PEER_AXPY(0, b * NPK);
            if (b + 2 < 128 / NPK) PEER_LOAD(Vb, 0, (b + 2) * NPK);
            PEER_AXPY(1, (b + 1) * NPK);
        }
        float ss = 0.f;
#pragma unroll
        for (int q = 0; q < 4; ++q) {
            const u32x4 xw = *(const u32x4*)(xrow + q * 8);
            acc[4 * q] += (f32x2){bflo(xw.x), bfhi(xw.x)}; acc[4 * q + 1] += (f32x2){bflo(xw.y), bfhi(xw.y)};
            acc[4 * q + 2] += (f32x2){bflo(xw.z), bfhi(xw.z)}; acc[4 * q + 3] += (f32x2){bflo(xw.w), bfhi(xw.w)};
#pragma unroll
            for (int i = 0; i < 4; ++i) { const f32x2 a = acc[4 * q + i]; ss += a[0] * a[0] + a[1] * a[1]; }
        }
        const float rstd = rsqrtf(wave_sum(ss) * (1.f / 2048.f) + EPS);
#pragma unroll
        for (int q = 0; q < 8; ++q) {
            const f32x4 g0 = *(const f32x4*)(p.final_g + lane * 32 + q * 4);
            const f32x2 a = acc[2 * q], b = acc[2 * q + 1];
            const f32x4 o0 = {a[0] * rstd * g0[0], a[1] * rstd * g0[1], b[0] * rstd * g0[2], b[1] * rstd * g0[3]};
            *(f32x4*)(orow + q * 4) = o0;
        }
        WAVE_LDS_SYNC();
    }
}

#define XB_TMO      128
#define XB_XCNT(j)  (256  + 64 * (j))
#define XB_XSUB(j)  (1280 + 64 * (j))
#define XB_XGEN(j)  (2304 + 64 * (j))
#define XB_TOP      3328
#define XB_TOPGEN   3392
#define XCD_BAR_WORDS 3456
#define XB_SPIN_CAP (1u << 18)

__device__ __forceinline__ unsigned xb_ld(unsigned* p)              { return __hip_atomic_load(p, __ATOMIC_RELAXED, __HIP_MEMORY_SCOPE_AGENT); }
__device__ __forceinline__ unsigned xb_add(unsigned* p, unsigned v) { return __hip_atomic_fetch_add(p, v, __ATOMIC_RELAXED, __HIP_MEMORY_SCOPE_AGENT); }
__device__ __forceinline__ unsigned xb_xcc_id() { return (unsigned)__builtin_amdgcn_s_getreg((3 << 11) | 20) & 0xFu; }
#define XB_SPIN(cond, bar) do { unsigned _sp = 0; while (cond) { __builtin_amdgcn_s_sleep(1); \
    if ((++_sp & 255u) == 0u) { if (xb_ld(&(bar)[XB_TMO])) break; if (_sp > XB_SPIN_CAP) { atomicAdd(&(bar)[XB_TMO], 1u); break; } } } } while (0)

struct XcdBarrier {
    unsigned* bar; unsigned x;
    volatile LAS unsigned* st;
};

__device__ __forceinline__ XcdBarrier xcd_barrier_post(unsigned* bar, volatile LAS unsigned* st) {
    XcdBarrier b; b.bar = bar; b.x = xb_xcc_id(); b.st = st;
    if (threadIdx.x == 0) (void)xb_add(&bar[XB_XCNT(b.x)], 1u);
    return b;
}
__device__ __forceinline__ void xcd_barrier_complete(unsigned* bar, unsigned x, unsigned& nloc, unsigned& nx) {
    const unsigned G = gridDim.x * gridDim.y * gridDim.z;
    unsigned sum, cnt, mine, sp = 0u;
    for (;;) {
        sum = 0u; cnt = 0u; mine = 0u;
#pragma unroll
        for (unsigned j = 0; j < 16; ++j) { const unsigned c = xb_ld(&bar[XB_XCNT(j)]); sum += c; cnt += (c > 0u) ? 1u : 0u; mine = (j == x) ? c : mine; }
        if (sum == G) break;
        __builtin_amdgcn_s_sleep(1);
        if ((++sp & 255u) == 0u) { if (xb_ld(&bar[XB_TMO])) break; if (sp > XB_SPIN_CAP) { atomicAdd(&bar[XB_TMO], 1u); break; } }
    }
    nloc = mine > 0u ? mine : 1u; nx = cnt > 0u ? cnt : 1u;
}

__device__ __forceinline__ void xcd_barrier(const XcdBarrier& b) {
    asm volatile("s_waitcnt vmcnt(0)" ::: "memory");
    __syncthreads();
    if (threadIdx.x == 0) {
        unsigned* bar = b.bar;
        __builtin_amdgcn_s_waitcnt(0);
        unsigned nloc = b.st[0], nx = b.st[1];
        if (nloc == 0u) { xcd_barrier_complete(bar, b.x, nloc, nx); b.st[0] = nloc; b.st[1] = nx; }
        const unsigned old = xb_add(&bar[XB_XSUB(b.x)], 1u);
        const unsigned gen = old / nloc;
        if (old + 1u == (gen + 1u) * nloc) {
            __builtin_amdgcn_fence(__ATOMIC_RELEASE, "agent");
            asm volatile("s_waitcnt vmcnt(0)" ::: "memory");
            const unsigned og = xb_add(&bar[XB_TOP], 1u);
            const unsigned tg = og / nx;
            if (og + 1u == (tg + 1u) * nx) xb_add(&bar[XB_TOPGEN], 1u);
            else XB_SPIN(xb_ld(&bar[XB_TOPGEN]) == tg, bar);
            __builtin_amdgcn_fence(__ATOMIC_ACQUIRE, "agent");
            xb_add(&bar[XB_XGEN(b.x)], 1u);
            asm volatile("s_waitcnt vmcnt(0)" ::: "memory");
        } else {
            XB_SPIN(xb_ld(&bar[XB_XGEN(b.x)]) == gen, bar);
            __builtin_amdgcn_fence(__ATOMIC_ACQUIRE, "agent");
            asm volatile("s_waitcnt vmcnt(0)" ::: "memory");
        }
    }
    __syncthreads();
}

#ifndef PROBE_DUP
#define PROBE_DUP 0
#endif
#define REP(bit) for (int rep_ = 0; rep_ < (((PROBE_DUP) >> (bit)) & 1) + 1; ++rep_)
#define PH1() { pg8::Gemm g{(const bf16_t*)(p.ws + WS_XN), (const bf16_t*)(p.ws + WS_WINT), T_TOK, NPROJ, DM}; pg8::StaticOrder S; S.init(T_TOK, NPROJ, G, bx); Epi1 E{(bf16_t*)(p.ws + WS_P), (float*)(p.ws + WS_PSSV)}; pg8::gemm_phase<Epi1, pg8::StaticOrder, true, true>(lds, g, S, E); xcd_barrier(xbar); }
#define PH3() { pg8::Gemm g{(const bf16_t*)(p.ws + WS_XN), (const bf16_t*)(p.ws + WS_WOUTT), T_TOK, DM, DM}; pg8::StaticOrder S; S.init(T_TOK, DM, G, bx); Epi2 E{p.x, (bf16_t*)(p.ws + WS_X1G), (float*)(p.ws + WS_PSS2)}; pg8::gemm_phase<Epi2, pg8::StaticOrder, true, true>(lds, g, S, E); xcd_barrier(xbar); }
#define PH4() { pg8::Gemm g{(const bf16_t*)(p.ws + WS_X1G), (const bf16_t*)(p.ws + WS_WQT), T_TOK, 1024, DM}; pg8::StaticOrder S; S.init(T_TOK, 1024, G, bx); Epi3 E{(bf16_t*)(p.ws + WS_Q), (const float*)(p.ws + WS_PSS2)}; pg8::gemm_phase<Epi3, pg8::StaticOrder, true, true>(lds, g, S, E); xcd_barrier(xbar); }
__global__ void __launch_bounds__(NTHREADS, 2) hymba_fwd(Params p) {
    extern __shared__ __attribute__((aligned(16))) unsigned char smem[];
    LAS unsigned char* lds = (LAS unsigned char*)smem;
    cg::grid_group grid = cg::this_grid();
    const int G = gridDim.x, bx = blockIdx.x;
    unsigned* barw = (unsigned*)(p.ws + WS_BAR);
    volatile LAS unsigned* xst = (volatile LAS unsigned*)(lds + LDS_BYTES - 16);
    if (threadIdx.x < 4) xst[threadIdx.x] = 0u;
    if (bx == 0) { for (int i = threadIdx.x; i < XCD_BAR_WORDS; i += NTHREADS) barw[i] = 0u; }
    __syncthreads();
    REP(0) { phase0(p, lds); grid.sync(); }
    const XcdBarrier xbar = xcd_barrier_post(barw, xst);
    PH1()
#if (PROBE_DUP >> 1) & 1
    PH1()
#endif
    REP(2) {
        for (int si = bx; si < 256; si += G) {
            const int b = si >> 6, c = si & 63;
            gmlp_bc(p, lds, b, c);
            for (int h = 0; h < 4; ++h) mlstm_local(p, lds, b, c, h);
        }
        xcd_barrier(xbar);
    }
    REP(3) { phase_scan(p); xcd_barrier(xbar); }
    REP(4) { for (int it = bx; it < 1024; it += G) mlstm_out(p, lds, it >> 8, (it >> 2) & 63, it & 3); xcd_barrier(xbar); }
    PH3()
#if (PROBE_DUP >> 5) & 1
    PH3()
#endif
    PH4()
#if (PROBE_DUP >> 6) & 1
    PH4()
#endif
    REP(7) { peer_select(p); xcd_barrier(xbar); }
    peer_gather(p, lds);
}

extern "C" void kernel_launch(void* const* d_in, const int* in_sizes, int n_in, void* d_out, int out_size, void* d_ws, size_t ws_size, hipStream_t stream) {
    static int grid_blocks = 0;
    if (grid_blocks == 0) {
        if (n_in != 20 || ws_size < WS_END) { fprintf(stderr, "kernel_launch: unexpected n_in %d or ws_size %zu (need %zu)\n", n_in, ws_size, (size_t)WS_END); grid_blocks = -1; return; }
        int dev = 0, cus = 0, per_cu = 0;
        hipGetDevice(&dev);
        hipDeviceGetAttribute(&cus, hipDeviceAttributeMultiprocessorCount, dev);
        hipFuncSetAttribute((const void*)hymba_fwd, hipFuncAttributeMaxDynamicSharedMemorySize, LDS_BYTES);
        hipOccupancyMaxActiveBlocksPerMultiprocessor(&per_cu, (const void*)hymba_fwd, NTHREADS, LDS_BYTES);
        if (per_cu < 1) { fprintf(stderr, "kernel_launch: occupancy query says %d blocks per CU\n", per_cu); per_cu = 1; }
        if (per_cu > 1) per_cu = 1;
        grid_blocks = cus * per_cu;
        (void)hipGetLastError();
    }
    if (grid_blocks < 0) return;
    Params p{};
    p.x = (const float*)d_in[0]; p.norm1_g = (const float*)d_in[1]; p.w_in = (const float*)d_in[2]; p.gm_vnorm_g = (const float*)d_in[3];
    p.w_spatial = (const float*)d_in[4]; p.b_spatial = (const float*)d_in[5]; p.ml_conv_w = (const float*)d_in[6]; p.ml_conv_b = (const float*)d_in[7];
    p.ml_b_i = (const float*)d_in[8]; p.ml_b_f = (const float*)d_in[9]; p.gm_out_g = (const float*)d_in[10]; p.ml_out_g = (const float*)d_in[11];
    p.w_out = (const float*)d_in[12]; p.norm2_g = (const float*)d_in[13]; p.peer_wq = (const float*)d_in[14]; p.peer_k1 = (const float*)d_in[15];
    p.peer_k2 = (const float*)d_in[16]; p.peer_u = (const float*)d_in[17]; p.peer_v = (const float*)d_in[18]; p.final_g = (const float*)d_in[19];
    p.out = (float*)d_out; p.ws = (unsigned char*)d_ws;
    void* args[] = {&p};
    hipError_t e = hipLaunchCooperativeKernel((const void*)hymba_fwd, dim3(grid_blocks), dim3(NTHREADS), args, LDS_BYTES, stream);
    if (e != hipSuccess) fprintf(stderr, "cooperative launch failed: %s (grid %d)\n", hipGetErrorString(e), grid_blocks);
}
```

```cpp
#include <hip/hip_runtime.h>
#include <hip/hip_cooperative_groups.h>
#include <cstdio>
#include <cstdint>
namespace cg = cooperative_groups;
namespace pg8 {
#define PG8_LAS __attribute__((address_space(3)))
typedef unsigned short bf16_t;
typedef short bf16x8 __attribute__((ext_vector_type(8)));
typedef float f32x4 __attribute__((ext_vector_type(4)));
typedef unsigned u32x4 __attribute__((ext_vector_type(4)));
constexpr int BM = 256, BK = 64, HALF = 128, HTB = HALF * BK * 2  , STAGE_BYTES = 8 * HTB, NXCD = 8, WGM = 8;

__host__ __device__ __forceinline__ int lds_byte(int r, int c) { const int st = (r >> 4) * 2 + (c >> 5), rr = r & 15, cc = c & 31, ob = rr * 64 + cc * 2; return st * 1024 + (ob ^ (((ob >> 9) & 1) << 5)); }
__host__ __device__ __forceinline__ void stage_rc(int b, int& R, int& C) { const int st = b / 1024, sb = b % 1024, swz = sb ^ (((sb >> 9) & 1) << 5); R = (st >> 1) * 16 + swz / 64; C = (st & 1) * 32 + (swz % 64) / 2; }
__host__ __device__ __forceinline__ int perm32(int rho) { const int n = rho >> 4, i = rho & 15; return 8 * (i >> 2) + 4 * n + (i & 3); }

struct Unit { int pm, pn; };
struct Gemm { const bf16_t* A; const bf16_t* Bt; int M, N, K; };

struct StaticOrder {
    int nM, nN, nwg, G, c;
    __host__ __device__ void init(int M, int N, int G_, int c_) { nM = M / BM; nN = N / BM; nwg = nM * nN; G = G_; c = c_; }
    __host__ __device__ bool next(int i, Unit& u) const {
        const long L = (long)i * G + c; if (L >= nwg) return false;
        int wgid = (int)L; { const int q = nwg / NXCD, r = nwg % NXCD, xcd = wgid % NXCD, off = wgid / NXCD; wgid = (xcd < r ? xcd * (q + 1) : r * (q + 1) + (xcd - r) * q) + off; }
        const int nig = WGM * nN, gid = wgid / nig, fm = gid * WGM, gsz = (nM - fm) < WGM ? (nM - fm) : WGM;
        u.pm = fm + ((wgid % nig) % gsz); u.pn = (wgid % nig) / gsz; return true;
    }
    __device__ __forceinline__ void a_ready(const Unit&) const {}
    __device__ __forceinline__ void done(const Unit&) const {}
};
__device__ __forceinline__ unsigned cvt_pk_bf16(float lo, float hi) { unsigned r; asm volatile("v_cvt_pk_bf16_f32 %0, %1, %2" : "=v"(r) : "v"(lo), "v"(hi)); return r; }
template <class Epi, class Sched, bool ALIGN_EPI = false, bool SP2 = false>
__device__ __forceinline__ void gemm_phase(PG8_LAS unsigned char* lds, const Gemm g, const Sched& S, const Epi& E) {
    const int tid = threadIdx.x, wid = __builtin_amdgcn_readfirstlane(tid >> 6), lane = tid & 63, wr = wid >> 2, wc = wid & 3, fr = lane & 15, fq = lane >> 4;
    const int K = g.K, nt = K / BK;
    unsigned voffA[2], voffB[2];
#pragma unroll
    for (int i = 0; i < 2; ++i) { int R, C; stage_rc(tid * 16 + i * 8192, R, C); const int Rb = Epi::PERM ? ((R & ~31) + perm32(R & 31)) : R;
        voffA[i] = (unsigned)(R * K + C) * 2u; voffB[i] = (unsigned)(Rb * K + C) * 2u; }
    const size_t kstep = (size_t)(BK * 2);
    const size_t hstep = (size_t)HALF * K * 2;
    const size_t tstep = 2 * hstep;
    const unsigned ldsw = (unsigned)wid * 1024u;
    const int aoff = lds_byte(wr * 64 + fr, fq * 8), boff = lds_byte(wc * 32 + fr, fq * 8);
#define PG8_SA(b, h) (((b) * 2 + (h)) * HTB)
#define PG8_SB(b, h) ((4 + (b) * 2 + (h)) * HTB)
#define PG8_STAGE(bufoff, gbase, voff) do { _Pragma("unroll") for (int _i = 0; _i < 2; ++_i) \
        __builtin_amdgcn_global_load_lds((const unsigned*)((const char*)(gbase) + (voff)[_i]), (PG8_LAS unsigned*)(lds + (bufoff) + ldsw + _i * 8192), 16, 0, 0); } while (0)
#define PG8_LDA(dst, b, h) do { _Pragma("unroll") for (int m = 0; m < 4; ++m) _Pragma("unroll") for (int k = 0; k < 2; ++k) dst[m][k] = *(const PG8_LAS bf16x8*)(lds + PG8_SA(b, h) + aoff + m * 2048 + k * 1024); } while (0)
#define PG8_LDB(dst, b, h) do { _Pragma("unroll") for (int n = 0; n < 2; ++n) _Pragma("unroll") for (int k = 0; k < 2; ++k) dst[n][k] = *(const PG8_LAS bf16x8*)(lds + PG8_SB(b, h) + boff + n * 2048 + k * 1024); } while (0)
#define PG8_MMA(ai, bj, At, Bt) do { __builtin_amdgcn_s_setprio(1); _Pragma("unroll") for (int m = 0; m < 4; ++m) _Pragma("unroll") for (int n = 0; n < 2; ++n) _Pragma("unroll") for (int k = 0; k < 2; ++k) \
        acc[ai][bj][m][n] = __builtin_amdgcn_mfma_f32_16x16x32_bf16(Bt[n][k], At[m][k], acc[ai][bj][m][n], 0, 0, 0); __builtin_amdgcn_s_setprio(0); } while (0)
#define PG8_WAIT_V(n) asm volatile("s_waitcnt vmcnt(" #n ")" ::: "memory")
#define PG8_WAIT_L(n) asm volatile("s_waitcnt lgkmcnt(" #n ")" ::: "memory")
#define PG8_BAR __builtin_amdgcn_s_barrier()
#define PG8_SCHED __builtin_amdgcn_sched_barrier(0)
    Unit cur, nxt; int ui = 0;
    if (!S.next(0, cur)) return;
    f32x4 acc[2][2][4][2];
#pragma unroll
    for (int a = 0; a < 2; ++a)
#pragma unroll
        for (int b = 0; b < 2; ++b)
#pragma unroll
            for (int m = 0; m < 4; ++m)
#pragma unroll
                for (int n = 0; n < 2; ++n) acc[a][b][m][n] = (f32x4){0.f, 0.f, 0.f, 0.f};
    bf16x8 At[4][2], B0[2][2], B1[2][2];
    const char* cA = (const char*)g.A + (size_t)cur.pm * tstep; const char* cB = (const char*)g.Bt + (size_t)cur.pn * tstep;
    S.a_ready(cur);
    if constexpr (SP2) {
        PG8_STAGE(PG8_SB(0, 0), cB, voffB); PG8_STAGE(PG8_SB(0, 1), cB + hstep, voffB); PG8_STAGE(PG8_SA(0, 0), cA, voffA); PG8_STAGE(PG8_SA(0, 1), cA + hstep, voffA);
        if (wr == 1) PG8_BAR;
        PG8_WAIT_V(2); PG8_BAR;
        PG8_STAGE(PG8_SB(1, 0), cB + kstep, voffB); PG8_STAGE(PG8_SA(1, 0), cA + kstep, voffA); PG8_STAGE(PG8_SB(1, 1), cB + hstep + kstep, voffB);
        PG8_WAIT_V(6); PG8_BAR;
    } else {
        PG8_STAGE(PG8_SB(0, 0), cB, voffB); PG8_STAGE(PG8_SA(0, 0), cA, voffA); PG8_STAGE(PG8_SB(0, 1), cB + hstep, voffB); PG8_STAGE(PG8_SA(0, 1), cA + hstep, voffA);
        if (wr == 1) PG8_BAR;
        PG8_WAIT_V(4); PG8_BAR;
        PG8_STAGE(PG8_SB(1, 0), cB + kstep, voffB); PG8_STAGE(PG8_SA(1, 0), cA + kstep, voffA); PG8_STAGE(PG8_SB(1, 1), cB + hstep + kstep, voffB);
        PG8_WAIT_V(6); PG8_BAR;
    }
    for (;;) {
        const bool has_next = S.next(ui + 1, nxt);
        const char* nA = has_next ? (const char*)g.A + (size_t)nxt.pm * tstep : cA; const char* nB = has_next ? (const char*)g.Bt + (size_t)nxt.pn * tstep : cB;
        for (int t = 0; t < nt; t += 2) {
            const bool last = (t == nt - 2);
            const char* a1 = cA + (size_t)(t + 1) * kstep;
            const char* a2 = last ? nA : cA + (size_t)(t + 2) * kstep; const char* b2 = last ? nB : cB + (size_t)(t + 2) * kstep;
            const char* a3 = a2 + kstep; const char* b3 = b2 + kstep;
            if (last && has_next) S.a_ready(nxt);
            if constexpr (SP2) {
            PG8_LDB(B0, 0, 0); PG8_LDB(B1, 0, 1); PG8_SCHED; PG8_LDA(At, 0, 0); PG8_STAGE(PG8_SA(1, 1), a1 + hstep, voffA);
            PG8_WAIT_V(8); PG8_WAIT_L(0); PG8_BAR; PG8_MMA(0, 0, At, B0); PG8_MMA(0, 1, At, B1); PG8_BAR; PG8_SCHED;
            PG8_LDA(At, 0, 1); PG8_STAGE(PG8_SB(0, 0), b2, voffB); PG8_STAGE(PG8_SB(0, 1), b2 + hstep, voffB); PG8_STAGE(PG8_SA(0, 0), a2, voffA);
            PG8_WAIT_V(8); PG8_WAIT_L(0); PG8_BAR; PG8_MMA(1, 0, At, B0); PG8_MMA(1, 1, At, B1); PG8_BAR; PG8_SCHED;
            PG8_LDB(B0, 1, 0); PG8_LDB(B1, 1, 1); PG8_SCHED; PG8_LDA(At, 1, 0); PG8_STAGE(PG8_SA(0, 1), a2 + hstep, voffA);
            PG8_WAIT_V(8); PG8_WAIT_L(0); PG8_BAR; PG8_MMA(0, 0, At, B0); PG8_MMA(0, 1, At, B1); PG8_BAR; PG8_SCHED;
            PG8_LDA(At, 1, 1); PG8_STAGE(PG8_SB(1, 0), b3, voffB); PG8_STAGE(PG8_SB(1, 1), b3 + hstep, voffB); PG8_STAGE(PG8_SA(1, 0), a3, voffA);
            PG8_WAIT_V(8); PG8_WAIT_L(0); PG8_BAR; PG8_MMA(1, 0, At, B0); PG8_MMA(1, 1, At, B1); PG8_BAR; PG8_SCHED;
            } else {
            PG8_LDB(B0, 0, 0); PG8_SCHED; PG8_LDA(At, 0, 0); PG8_STAGE(PG8_SA(1, 1), a1 + hstep, voffA);
            PG8_WAIT_L(8); PG8_BAR; PG8_WAIT_L(0); PG8_MMA(0, 0, At, B0); PG8_BAR; PG8_SCHED;
            PG8_LDB(B1, 0, 1); PG8_STAGE(PG8_SB(0, 0), b2, voffB);
            PG8_BAR; PG8_WAIT_L(0); PG8_MMA(0, 1, At, B1); PG8_BAR;
            PG8_LDA(At, 0, 1); PG8_STAGE(PG8_SA(0, 0), a2, voffA);
            PG8_BAR; PG8_WAIT_L(0); PG8_MMA(1, 0, At, B0); PG8_BAR; PG8_SCHED;
            PG8_STAGE(PG8_SB(0, 1), b2 + hstep, voffB);
            PG8_WAIT_V(6); PG8_BAR; PG8_MMA(1, 1, At, B1); PG8_BAR;
            PG8_LDB(B0, 1, 0); PG8_SCHED; PG8_LDA(At, 1, 0); PG8_STAGE(PG8_SA(0, 1), a2 + hstep, voffA);
            PG8_WAIT_L(8); PG8_BAR; PG8_WAIT_L(0); PG8_MMA(0, 0, At, B0); PG8_BAR; PG8_SCHED;
            PG8_LDB(B1, 1, 1); PG8_STAGE(PG8_SB(1, 0), b3, voffB);
            PG8_BAR; PG8_WAIT_L(0); PG8_MMA(0, 1, At, B1); PG8_BAR;
            PG8_LDA(At, 1, 1); PG8_STAGE(PG8_SA(1, 0), a3, voffA);
            PG8_BAR; PG8_WAIT_L(0); PG8_MMA(1, 0, At, B0); PG8_BAR; PG8_SCHED;
            PG8_STAGE(PG8_SB(1, 1), b3 + hstep, voffB);
            PG8_WAIT_V(6); PG8_BAR; PG8_MMA(1, 1, At, B1); PG8_BAR;
            }
        }
        if constexpr (ALIGN_EPI) { if (wr == 0) PG8_BAR; }
        if constexpr (!Epi::AFTER_DRAIN) { E(acc, cur, wr, wc, fr, fq); S.done(cur); }
        if (!has_next) break;
#pragma unroll
        for (int a = 0; a < 2; ++a)
#pragma unroll
            for (int b = 0; b < 2; ++b)
#pragma unroll
                for (int m = 0; m < 4; ++m)
#pragma unroll
                    for (int n = 0; n < 2; ++n) acc[a][b][m][n] = (f32x4){0.f, 0.f, 0.f, 0.f};
        cur = nxt; cA = nA; cB = nB; ++ui;
        if constexpr (ALIGN_EPI) { if (wr == 1) PG8_BAR; }
    }
    PG8_WAIT_V(0);
    if constexpr (!ALIGN_EPI) { if (wr == 0) PG8_BAR; }
    PG8_BAR;
    if constexpr (Epi::AFTER_DRAIN) { E.fused(acc, cur, wr, wc, fr, fq, lds, wid, lane); S.done(cur); }
#undef PG8_SA
#undef PG8_SB
#undef PG8_STAGE
#undef PG8_LDA
#undef PG8_LDB
#undef PG8_MMA
#undef PG8_WAIT_V
#undef PG8_WAIT_L
#undef PG8_BAR
#undef PG8_SCHED
}
}

#define LAS __attribute__((address_space(3)))
#define DI __device__ __forceinline__
using pg8::bf16_t; using pg8::bf16x8; using pg8::f32x4; using pg8::u32x4; using pg8::cvt_pk_bf16;
typedef unsigned u32x2 __attribute__((ext_vector_type(2)));
typedef float f32x2 __attribute__((ext_vector_type(2)));

constexpr int T_TOK = 32768, DM = 2048, NPROJ = 5120, PROJW = 5128;
constexpr int NTHREADS = 512;
constexpr int LDS_BYTES = 147456;
constexpr float EPS = 1e-6f;

constexpr size_t WS_XN = 0;
constexpr size_t WS_P = 134217728;
constexpr size_t WS_X1G = WS_P;
constexpr size_t WS_Q = WS_P + 134217728;
constexpr size_t WS_WINT = WS_P + 335544320;
constexpr size_t WS_WOUTT = WS_WINT + 20971520;
constexpr size_t WS_WQT = WS_WOUTT + 8388608;
constexpr size_t WS_UB = WS_WQT + 4194304;
constexpr size_t WS_VB = WS_UB + 67108864;
constexpr size_t WS_ST = WS_VB + 67108864;
constexpr size_t WS_CPT = WS_ST + 142606336;
constexpr size_t WS_QC = WS_CPT + 71303168;
constexpr size_t WS_KC = WS_QC + 33554432;
constexpr size_t WS_IG = WS_KC + 33554432;
constexpr size_t WS_LF = WS_IG + 524288;
constexpr size_t WS_PSSV = WS_LF + 524288;
constexpr size_t WS_PSS2 = WS_PSSV + 2097152;
constexpr size_t WS_BEND = WS_PSS2 + 4194304;
constexpr size_t WS_GMAX = WS_BEND + 4096;
constexpr size_t WS_MPREV = WS_GMAX + 4096;
constexpr size_t WS_SELID = WS_MPREV + 4096;
constexpr size_t WS_SELG = WS_SELID + 16777216;
constexpr size_t WS_KB1 = WS_SELG + 16777216;
constexpr size_t WS_KB2 = WS_KB1 + 131072;
constexpr size_t WS_BAR = WS_KB2 + 131072;
constexpr size_t WS_END = WS_BAR + 16384;

struct Params {
    const float *x, *norm1_g, *w_in, *gm_vnorm_g, *w_spatial, *b_spatial, *ml_conv_w, *ml_conv_b, *ml_b_i, *ml_b_f, *gm_out_g, *ml_out_g, *w_out, *norm2_g,
        *peer_wq, *peer_k1, *peer_k2, *peer_u, *peer_v, *final_g;
    float* out;
    unsigned char* ws;
};

template <int CB, int H, int W> DI size_t p_off(int t, int h, int d) { return (size_t)T_TOK * CB + ((size_t)((t >> 7) * H + h) * 128 + (t & 127)) * W + d; }
DI float bf2f(unsigned short h) { return __uint_as_float(((unsigned)h) << 16); }
DI float bflo(unsigned w) { return __uint_as_float(w << 16); }
DI float bfhi(unsigned w) { return __uint_as_float(w & 0xffff0000u); }
DI float rcpf_(float x) { return __builtin_amdgcn_rcpf(x); }
DI float sigmoid_(float x) { return rcpf_(1.f + __expf(-x)); }
DI float gelu_t(float x) { const float z = 1.5957691216057308f * (x + 0.044715f * x * x * x); return x * rcpf_(1.f + __expf(-z)); }
DI float wave_sum(float v) {
#pragma unroll
    for (int o = 32; o; o >>= 1) v += __shfl_xor(v, o);
    return v;
}
DI float wave_max(float v) {
#pragma unroll
    for (int o = 32; o; o >>= 1) v = fmaxf(v, __shfl_xor(v, o));
    return v;
}
DI bf16x8 ld_frag_lds(const LAS unsigned char* p) { return *(const LAS bf16x8*)p; }
#define MFMA16(a, b, c) __builtin_amdgcn_mfma_f32_16x16x32_bf16((a), (b), (c), 0, 0, 0)

struct Epi1 {
    static constexpr bool PERM = true, AFTER_DRAIN = false;
    bf16_t* P; float* pssv;
    DI void operator()(const f32x4 (&acc)[2][2][4][2], const pg8::Unit& u, int wr, int wc, int fr, int fq) const {
        const int row0 = u.pm * 256 + wr * 64 + fr, col0 = u.pn * 256 + wc * 32 + 8 * fq;
        const int mode = u.pn < 8 ? 1 : (u.pn >= 16 ? 2 : 0);
        const bool want_ss = (u.pn >= 4 && u.pn < 8);
#pragma unroll
        for (int ai = 0; ai < 2; ++ai)
#pragma unroll
            for (int m = 0; m < 4; ++m) {
                const int row = row0 + ai * 128 + m * 16;
                const int CB = u.pn < 4 ? 0 : (u.pn < 8 ? 1024 : (u.pn < 10 ? 2048 : (u.pn < 12 ? 2560 : (u.pn < 16 ? 3072 : 4096))));
                const int lw = u.pn < 12 ? 7 : 8, H = u.pn < 8 ? 8 : 4;
                float ss = 0.f;
#pragma unroll
                for (int bj = 0; bj < 2; ++bj) {
                    f32x4 v0 = acc[ai][bj][m][0], v1 = acc[ai][bj][m][1];
                    if (mode == 1) {
#pragma unroll
                        for (int j = 0; j < 4; ++j) { v0[j] = gelu_t(v0[j]); v1[j] = gelu_t(v1[j]); ss += v0[j] * v0[j] + v1[j] * v1[j]; }
                    } else if (mode == 2) {
#pragma unroll
                        for (int j = 0; j < 4; ++j) { v0[j] = sigmoid_(v0[j]); v1[j] = sigmoid_(v1[j]); }
                    }
                    u32x4 w; w.x = cvt_pk_bf16(v0[0], v0[1]); w.y = cvt_pk_bf16(v0[2], v0[3]); w.z = cvt_pk_bf16(v1[0], v1[1]); w.w = cvt_pk_bf16(v1[2], v1[3]);
                    {
                        const int cr = col0 + bj * 128 - CB, hh = cr >> lw, d = cr & ((1 << lw) - 1);
                        *(u32x4*)(P + (size_t)T_TOK * CB + (((size_t)((row >> 7) * H + hh) * 128 + (row & 127)) << lw) + d) = w;
                    }
                }
                if (want_ss) {
                    ss += __shfl_xor(ss, 16); ss += __shfl_xor(ss, 32);
                    if (fq == 0) pssv[(size_t)row * 16 + (u.pn - 4) * 4 + wc] = ss;
                }
            }
    }
};

struct Epi2 {
    static constexpr bool PERM = true, AFTER_DRAIN = false;
    const float* x; bf16_t* x1b; float* pss2;
    DI void operator()(const f32x4 (&acc)[2][2][4][2], const pg8::Unit& u, int wr, int wc, int fr, int fq) const {
        const int row0 = u.pm * 256 + wr * 64 + fr, col0 = u.pn * 256 + wc * 32 + 8 * fq;
#pragma unroll
        for (int ai = 0; ai < 2; ++ai)
#pragma unroll
            for (int m = 0; m < 4; ++m) {
                const int row = row0 + ai * 128 + m * 16;
                float ss = 0.f;
#pragma unroll
                for (int bj = 0; bj < 2; ++bj) {
                    const size_t o = (size_t)row * DM + col0 + bj * 128;
                    const f32x4 v0 = acc[ai][bj][m][0] + *(const f32x4*)(x + o), v1 = acc[ai][bj][m][1] + *(const f32x4*)(x + o + 4);
#pragma unroll
                    for (int j = 0; j < 4; ++j) ss += v0[j] * v0[j] + v1[j] * v1[j];
                    u32x4 w; w.x = cvt_pk_bf16(v0[0], v0[1]); w.y = cvt_pk_bf16(v0[2], v0[3]); w.z = cvt_pk_bf16(v1[0], v1[1]); w.w = cvt_pk_bf16(v1[2], v1[3]);
                    *(u32x4*)(x1b + o) = w;
                }
                ss += __shfl_xor(ss, 16); ss += __shfl_xor(ss, 32);
                if (fq == 0) pss2[(size_t)row * 32 + u.pn * 4 + wc] = ss;
            }
    }
};

struct Epi3 {
    static constexpr bool PERM = true, AFTER_DRAIN = false;
    bf16_t* Q; const float* pss2;
    DI void operator()(const f32x4 (&acc)[2][2][4][2], const pg8::Unit& u, int wr, int wc, int fr, int fq) const {
        const int row0 = u.pm * 256 + wr * 64 + fr, col0 = u.pn * 256 + wc * 32 + 8 * fq;
#pragma unroll
        for (int ai = 0; ai < 2; ++ai)
#pragma unroll
            for (int m = 0; m < 4; ++m) {
                const int row = row0 + ai * 128 + m * 16;
                float ss = 0.f;
#pragma unroll
                for (int i = 0; i < 8; ++i) { const f32x4 t = *(const f32x4*)(pss2 + (size_t)row * 32 + i * 4); ss += (t[0] + t[1]) + (t[2] + t[3]); }
                const float rstd = rsqrtf(ss * (1.f / 2048.f) + EPS);
#pragma unroll
                for (int bj = 0; bj < 2; ++bj) {
                    const f32x4 v0 = acc[ai][bj][m][0] * rstd, v1 = acc[ai][bj][m][1] * rstd;
                    u32x4 w; w.x = cvt_pk_bf16(v0[0], v0[1]); w.y = cvt_pk_bf16(v0[2], v0[3]); w.z = cvt_pk_bf16(v1[0], v1[1]); w.w = cvt_pk_bf16(v1[2], v1[3]);
                    *(u32x4*)(Q + (size_t)row * 1024 + col0 + bj * 128) = w;
                }
            }
    }
};

DI void phase0(const Params& p, LAS unsigned char* lds) {
    const int tid = threadIdx.x, lane = tid & 63, wave = tid >> 6;
    bf16_t* XN = (bf16_t*)(p.ws + WS_XN);
    {
        LAS float* scr = (LAS float*)lds + wave * (64 * 65);
        const int gw = blockIdx.x * 8 + wave, nw = gridDim.x * 8;
        for (int it = gw; it < 4096; it += nw) {
            const float* W; bf16_t* WT; int ldw, kt, nt;
            if (it < 2560) { W = p.w_in; WT = (bf16_t*)(p.ws + WS_WINT); ldw = PROJW; kt = it / 80; nt = it % 80; }
            else if (it < 3584) { const int j = it - 2560; W = p.w_out; WT = (bf16_t*)(p.ws + WS_WOUTT); ldw = 2048; kt = j >> 5; nt = j & 31; }
            else { const int j = it - 3584; W = p.peer_wq; WT = (bf16_t*)(p.ws + WS_WQT); ldw = 1024; kt = j >> 4; nt = j & 15; }
            const int k0 = kt * 64, n0 = nt * 64;
#pragma unroll 16
            for (int r = 0; r < 64; ++r) scr[r * 65 + lane] = W[(size_t)(k0 + r) * ldw + n0 + lane] * (it >= 3584 ? p.norm2_g[k0 + r] : 1.f);
            __builtin_amdgcn_fence(__ATOMIC_RELEASE, "wavefront"); __builtin_amdgcn_wave_barrier(); __builtin_amdgcn_fence(__ATOMIC_ACQUIRE, "wavefront");
            const int half = lane >> 5, kk = (lane & 31) * 2;
#pragma unroll 8
            for (int nn = 0; nn < 32; ++nn) {
                const int n = 2 * nn + half; const float a = scr[kk * 65 + n], b = scr[(kk + 1) * 65 + n];
                *(unsigned*)(WT + (size_t)(n0 + n) * 2048 + k0 + kk) = cvt_pk_bf16(a, b);
            }
            __builtin_amdgcn_fence(__ATOMIC_RELEASE, "wavefront"); __builtin_amdgcn_wave_barrier(); __builtin_amdgcn_fence(__ATOMIC_ACQUIRE, "wavefront");
        }
    }
    __syncthreads();
    {
        LAS float* wg = (LAS float*)lds;
        for (int idx = tid; idx < 4096; idx += NTHREADS) {
            const int k = idx >> 1, hf = idx & 1;
            const f32x4 v = *(const f32x4*)(p.w_in + (size_t)k * PROJW + 5120 + hf * 4);
            *(LAS f32x4*)(wg + k * 8 + (k >> 3) * 4 + hf * 4) = v;
        }
        __syncthreads();
        float* IG = (float*)(p.ws + WS_IG); float* LF = (float*)(p.ws + WS_LF);
        for (int row0 = 2 * (blockIdx.x * 8 + wave); row0 < T_TOK; row0 += 2 * gridDim.x * 8) {
            f32x4 xv[2][8];
#pragma unroll
            for (int rr = 0; rr < 2; ++rr) {
                const float* xr = p.x + (size_t)(row0 + rr) * DM;
#pragma unroll
                for (int i = 0; i < 4; ++i) { xv[rr][2 * i] = *(const f32x4*)(xr + i * 512 + lane * 8); xv[rr][2 * i + 1] = *(const f32x4*)(xr + i * 512 + lane * 8 + 4); }
            }
#pragma unroll
            for (int rr = 0; rr < 2; ++rr) {
                const int row = row0 + rr;
                float ss = 0.f;
#pragma unroll
                for (int i = 0; i < 8; ++i) ss += (xv[rr][i][0] * xv[rr][i][0] + xv[rr][i][1] * xv[rr][i][1]) + (xv[rr][i][2] * xv[rr][i][2] + xv[rr][i][3] * xv[rr][i][3]);
                ss = wave_sum(ss);
                const float rstd = rsqrtf(ss * (1.f / 2048.f) + EPS);
                f32x4 ga = {0.f, 0.f, 0.f, 0.f}, gb = {0.f, 0.f, 0.f, 0.f};
#pragma unroll
                for (int i = 0; i < 4; ++i) {
                    const f32x4 g0 = *(const f32x4*)(p.norm1_g + i * 512 + lane * 8), g1 = *(const f32x4*)(p.norm1_g + i * 512 + lane * 8 + 4);
                    const f32x4 h0 = xv[rr][2 * i] * rstd * g0, h1 = xv[rr][2 * i + 1] * rstd * g1;
                    u32x4 w; w.x = cvt_pk_bf16(h0[0], h0[1]); w.y = cvt_pk_bf16(h0[2], h0[3]); w.z = cvt_pk_bf16(h1[0], h1[1]); w.w = cvt_pk_bf16(h1[2], h1[3]);
                    *(u32x4*)(XN + (size_t)row * DM + i * 512 + lane * 8) = w;
                    const LAS float* wb = wg + (i * 512 + lane * 8) * 8 + (i * 64 + lane) * 4;
#pragma unroll
                    for (int e = 0; e < 8; ++e) {
                        const float hv = e < 4 ? h0[e & 3] : h1[e & 3];
                        const f32x4 w0 = *(const LAS f32x4*)(wb + e * 8), w1 = *(const LAS f32x4*)(wb + e * 8 + 4);
                        ga = ga + w0 * hv; gb = gb + w1 * hv;
                    }
                }
                f32x4 m4 = lane < 32 ? ga : gb, s4 = lane < 32 ? gb : ga;
#pragma unroll
                for (int j = 0; j < 4; ++j) m4[j] += __shfl_xor(s4[j], 32);
                const bool up16 = (lane & 16) != 0;
                float m2a = up16 ? m4[2] : m4[0], m2b = up16 ? m4[3] : m4[1];
                const float s2a = up16 ? m4[0] : m4[2], s2b = up16 ? m4[1] : m4[3];
                m2a += __shfl_xor(s2a, 16); m2b += __shfl_xor(s2b, 16);
                const bool up8 = (lane & 8) != 0;
                float m1 = up8 ? m2b : m2a; const float s1 = up8 ? m2a : m2b;
                m1 += __shfl_xor(s1, 8);
                m1 += __shfl_xor(m1, 4); m1 += __shfl_xor(m1, 2); m1 += __shfl_xor(m1, 1);
                const int j = ((lane >> 5) << 2) | (((lane >> 4) & 1) << 1) | ((lane >> 3) & 1);
                if ((lane & 7) == 0) {
                    if (j < 4) IG[(size_t)row * 4 + j] = m1 + p.ml_b_i[j];
                    else { const float z = m1 + p.ml_b_f[j - 4]; LF[(size_t)row * 4 + j - 4] = fminf(z, 0.f) - log1pf(__expf(-fabsf(z))); }
                }
            }
        }
    }
    {
        const size_t nthr = (size_t)gridDim.x * NTHREADS, NQ = (size_t)16384 * 512;
        for (size_t base = (size_t)blockIdx.x * NTHREADS + tid; base < 2 * NQ; base += 16 * nthr) {
            f32x4 v[16];
#pragma unroll
            for (int u = 0; u < 16; ++u) {
                size_t i = base + u * nthr; if (i >= 2 * NQ) i = base;
                const int which = i >= NQ; const size_t j = i - (which ? NQ : 0);
                v[u] = *(const f32x4*)((which ? p.peer_v : p.peer_u) + j * 4);
            }
#pragma unroll
            for (int u = 0; u < 16; ++u) {
                size_t i = base + u * nthr; if (i >= 2 * NQ) i = base;
                const int which = i >= NQ; const size_t j = i - (which ? NQ : 0);
                const int row = (int)(j >> 9), c4 = (int)(j & 511);
                float amax = fmaxf(fmaxf(fabsf(v[u][0]), fabsf(v[u][1])), fmaxf(fabsf(v[u][2]), fabsf(v[u][3])));
                amax = fmaxf(amax, __uint_as_float((unsigned)__builtin_amdgcn_update_dpp(0, (int)__float_as_uint(amax), 0xB1, 0xF, 0xF, true)));
                amax = fmaxf(amax, __uint_as_float((unsigned)__builtin_amdgcn_update_dpp(0, (int)__float_as_uint(amax), 0x4E, 0xF, 0xF, true)));
                amax = fmaxf(amax, __uint_as_float((unsigned)__builtin_amdgcn_update_dpp(0, (int)__float_as_uint(amax), 0x141, 0xF, 0xF, true)));
                const unsigned sb = cvt_pk_bf16(amax * (1.f / 6.f), 0.f) & 0xffffu;
                float sc = bflo(sb); if (sc == 0.f) sc = 1.f;
                const float inv = 1.f / sc;
                unsigned r = 0u;
                r = __builtin_amdgcn_cvt_scalef32_pk_fp4_f32(r, v[u][0] * inv, v[u][1] * inv, 1.0f, 0);
                r = __builtin_amdgcn_cvt_scalef32_pk_fp4_f32(r, v[u][2] * inv, v[u][3] * inv, 1.0f, 1);
                unsigned char* dst = p.ws + (which ? WS_VB : WS_UB) + (size_t)row * 1152;
                *(unsigned short*)(dst + c4 * 2) = (unsigned short)(r & 0xffffu);
                if ((c4 & 7) == 0) *(unsigned short*)(dst + 1024 + (c4 >> 3) * 2) = (unsigned short)(sb == 0u ? 0x3F80u : sb);
            }
        }
    }
    {
        bf16_t* KB1 = (bf16_t*)(p.ws + WS_KB1); bf16_t* KB2 = (bf16_t*)(p.ws + WS_KB2);
        for (int i = blockIdx.x * NTHREADS + tid; i < 65536 / 4; i += gridDim.x * NTHREADS) {
            const f32x4 a = *(const f32x4*)(p.peer_k1 + i * 4), b = *(const f32x4*)(p.peer_k2 + i * 4);
            u32x2 w; w.x = cvt_pk_bf16(a[0], a[1]); w.y = cvt_pk_bf16(a[2], a[3]); *(u32x2*)(KB1 + i * 4) = w;
            w.x = cvt_pk_bf16(b[0], b[1]); w.y = cvt_pk_bf16(b[2], b[3]); *(u32x2*)(KB2 + i * 4) = w;
        }
    }
}

#define WAVE_LDS_SYNC() do { __builtin_amdgcn_fence(__ATOMIC_RELEASE, "wavefront"); __builtin_amdgcn_wave_barrier(); __builtin_amdgcn_fence(__ATOMIC_ACQUIRE, "wavefront"); } while (0)

template <int NG> DI void stage_T_load(const bf16_t* src, int ld, u32x4 (&r0)[NG], u32x4 (&r1)[NG], int wave, int lane) {
#pragma unroll
    for (int i = 0; i < NG; ++i) {
        const int g = wave + 8 * i;
        r0[i] = *(const u32x4*)(src + (size_t)(2 * lane) * ld + g * 8);
        r1[i] = *(const u32x4*)(src + (size_t)(2 * lane + 1) * ld + g * 8);
    }
}
template <int NG> DI void stage_T_store(const u32x4 (&r0)[NG], const u32x4 (&r1)[NG], LAS unsigned char* dst, int wave, int lane) {
#pragma unroll
    for (int i = 0; i < NG; ++i) {
        const int g = wave + 8 * i;
#pragma unroll
        for (int w = 0; w < 4; ++w) {
            const unsigned a = r0[i][w], b = r1[i][w];
            *(LAS unsigned*)(dst + (g * 8 + 2 * w) * 272 + lane * 4) = (a & 0xffffu) | (b << 16);
            *(LAS unsigned*)(dst + (g * 8 + 2 * w + 1) * 272 + lane * 4) = (a >> 16) | (b & 0xffff0000u);
        }
    }
}
template <int NG> DI void stage_T(const bf16_t* src, int ld, LAS unsigned char* dst, int wave, int lane) {
    u32x4 r0[NG], r1[NG];
    stage_T_load<NG>(src, ld, r0, r1, wave, lane);
    stage_T_store<NG>(r0, r1, dst, wave, lane);
}

DI void gmlp_bc(const Params& p, LAS unsigned char* lds, int b, int c) {
    const int tid = threadIdx.x, lane = tid & 63, wave = __builtin_amdgcn_readfirstlane(tid >> 6), fr = lane & 15, fq = lane >> 4;
    const int t0 = b * 8192 + c * 128;
    LAS unsigned char* Wl = lds; LAS unsigned char* GvT = lds + 34816; LAS float* rstdv = (LAS float*)(lds + 69632);
    const bf16_t* P = (const bf16_t*)(p.ws + WS_P); bf16_t* YM = (bf16_t*)(p.ws + WS_XN);
    const float* PSSV = (const float*)(p.ws + WS_PSSV);
    __syncthreads();
    if (tid < 128) {
        float ss = 0.f;
#pragma unroll
        for (int i = 0; i < 4; ++i) { const f32x4 v = *(const f32x4*)(PSSV + (size_t)(t0 + tid) * 16 + i * 4); ss += (v[0] + v[1]) + (v[2] + v[3]); }
        rstdv[tid] = rsqrtf(ss * (1.f / 1024.f) + EPS);
    }
    f32x4 wa[4][2]; u32x4 gr0[2], gr1[2];
#define GMLP_PREFETCH(hh) do { _Pragma("unroll") for (int it = 0; it < 4; ++it) { const int e = (it * NTHREADS + tid) * 8, t = e >> 7, s0 = e & 127; \
            const float* wp = p.w_spatial + ((size_t)((hh) * 128 + t)) * 128 + s0; wa[it][0] = *(const f32x4*)wp; wa[it][1] = *(const f32x4*)(wp + 4); } \
        stage_T_load<2>(P + p_off<1024, 8, 128>(t0, (hh), 0), 128, gr0, gr1, wave, lane); } while (0)
    GMLP_PREFETCH(0);
    for (int h = 0; h < 8; ++h) {
        __syncthreads();
#pragma unroll
        for (int it = 0; it < 4; ++it) {
            const int e = (it * NTHREADS + tid) * 8, t = e >> 7, s0 = e & 127;
            float v[8];
#pragma unroll
            for (int j = 0; j < 8; ++j) { const float a = j < 4 ? wa[it][0][j & 3] : wa[it][1][j & 3]; v[j] = (s0 + j <= t) ? a * rstdv[s0 + j] : 0.f; }
            u32x4 w; w.x = cvt_pk_bf16(v[0], v[1]); w.y = cvt_pk_bf16(v[2], v[3]); w.z = cvt_pk_bf16(v[4], v[5]); w.w = cvt_pk_bf16(v[6], v[7]);
            *(LAS u32x4*)(Wl + t * 272 + s0 * 2) = w;
        }
        stage_T_store<2>(gr0, gr1, GvT, wave, lane);
        __syncthreads();
        if (h + 1 < 8) GMLP_PREFETCH(h + 1);
        f32x4 acc[8];
#pragma unroll
        for (int n = 0; n < 8; ++n) acc[n] = (f32x4){0.f, 0.f, 0.f, 0.f};
        const int kmax = (16 * wave + 15) >> 5;
#pragma unroll
        for (int kk = 0; kk < 4; ++kk) {
            if (kk <= kmax) {
                const bf16x8 bfrag = ld_frag_lds(Wl + (16 * wave + fr) * 272 + (32 * kk + 8 * fq) * 2);
#pragma unroll
                for (int n = 0; n < 8; ++n) { const bf16x8 afrag = ld_frag_lds(GvT + (16 * n + fr) * 272 + (32 * kk + 8 * fq) * 2); acc[n] = MFMA16(afrag, bfrag, acc[n]); }
            }
        }
        const int t = 16 * wave + fr; const size_t grow = (size_t)(t0 + t);
        const float bsp = p.b_spatial[h * 128 + t];
        float ss = 0.f;
#pragma unroll
        for (int n = 0; n < 8; ++n) {
            const int d0 = 16 * n + 4 * fq;
            const u32x2 uw = *(const u32x2*)(P + p_off<0, 8, 128>(t0 + t, h, d0));
            const f32x4 gv = *(const f32x4*)(p.gm_vnorm_g + h * 128 + d0);
            f32x4 y;
            y[0] = bflo(uw.x) * (gv[0] * acc[n][0] + bsp); y[1] = bfhi(uw.x) * (gv[1] * acc[n][1] + bsp);
            y[2] = bflo(uw.y) * (gv[2] * acc[n][2] + bsp); y[3] = bfhi(uw.y) * (gv[3] * acc[n][3] + bsp);
            ss += (y[0] * y[0] + y[1] * y[1]) + (y[2] * y[2] + y[3] * y[3]);
            acc[n] = y;
        }
        ss += __shfl_xor(ss, 16); ss += __shfl_xor(ss, 32);
        const float rstd = rsqrtf(ss * (1.f / 128.f) + EPS);
#pragma unroll
        for (int n = 0; n < 8; ++n) {
            const int d0 = 16 * n + 4 * fq;
            const f32x4 g = *(const f32x4*)(p.gm_out_g + h * 128 + d0);
            const f32x4 o = acc[n] * rstd * g;
            u32x2 w; w.x = cvt_pk_bf16(o[0], o[1]); w.y = cvt_pk_bf16(o[2], o[3]);
            *(u32x2*)(YM + grow * DM + h * 128 + d0) = w;
        }
    }
}

DI void mlstm_local(const Params& p, LAS unsigned char* lds, int b, int c, int h) {
    const int tid = threadIdx.x, lane = tid & 63, wave = __builtin_amdgcn_readfirstlane(tid >> 6), fr = lane & 15, fq = lane >> 4;
    const int bh = b * 4 + h, t0 = b * 8192 + c * 128;
    LAS unsigned char* KT = lds; LAS unsigned char* VT = lds + 34816; LAS float* wsv = (LAS float*)(lds + 108800);
    const bf16_t* P = (const bf16_t*)(p.ws + WS_P);
    bf16_t* QC = (bf16_t*)(p.ws + WS_QC); bf16_t* KC = (bf16_t*)(p.ws + WS_KC);
    const float* IG = (const float*)(p.ws + WS_IG); const float* LF = (const float*)(p.ws + WS_LF);
    LAS float* cwl = (LAS float*)(lds + 109312);
    __syncthreads();
    u32x4 xw[2][5];
#define CONV_LOAD(half) do { _Pragma("unroll") for (int gi = 0; gi < 2; ++gi) { const int g = wave + 8 * (gi + 2 * (half)); const int cgp = (g & 15) * 8; \
        _Pragma("unroll") for (int dj = 0; dj < 5; ++dj) { const int srow = 2 * lane - 3 + dj; xw[gi][dj] = (u32x4){0u, 0u, 0u, 0u}; \
            if (c > 0 || srow >= 0) xw[gi][dj] = *(const u32x4*)(P + ((half) ? p_off<2560, 4, 128>(t0 + srow, h, cgp) : p_off<2048, 4, 128>(t0 + srow, h, cgp))); } } } while (0)
    CONV_LOAD(0);
    for (int idx = tid; idx < 1280; idx += NTHREADS) {
        const int j = idx >> 8, cc = idx & 255, ch = (cc >= 128 ? 512 : 0) + h * 128 + (cc & 127);
        cwl[idx] = j < 4 ? p.ml_conv_w[j * 1024 + ch] : p.ml_conv_b[ch];
    }
    if (wave == 0) {
        const float l0 = LF[(size_t)(t0 + 2 * lane) * 4 + h], l1 = LF[(size_t)(t0 + 2 * lane + 1) * 4 + h];
        const float i0 = IG[(size_t)(t0 + 2 * lane) * 4 + h], i1 = IG[(size_t)(t0 + 2 * lane + 1) * 4 + h];
        float s = l0 + l1;
#pragma unroll
        for (int off = 1; off < 64; off <<= 1) { const float tt = __shfl_up(s, off); if (lane >= off) s += tt; }
        const float b1 = s, b0 = s - l1, bend = __shfl(s, 63);
        const float g0 = bend - b0 + i0, g1 = bend - b1 + i1;
        const float gmax = wave_max(fmaxf(g0, g1));
        wsv[2 * lane] = __expf(g0 - gmax); wsv[2 * lane + 1] = __expf(g1 - gmax);
        if (lane == 0) { ((float*)(p.ws + WS_BEND))[bh * 64 + c] = bend; ((float*)(p.ws + WS_GMAX))[bh * 64 + c] = gmax; }
    }
    __syncthreads();
#pragma unroll
    for (int gi4 = 0; gi4 < 4; ++gi4) {
        const int gi = gi4 & 1;
        if (gi4 == 2) CONV_LOAD(1);
        const int g = wave + 8 * gi4; const bool isk = gi4 >= 2; const int cgp = (g & 15) * 8;
        const int cc0 = (isk ? 128 : 0) + cgp;
        const int s = 2 * lane;
        float y0[8], y1[8];
        {
            const f32x4 cb0 = *(const LAS f32x4*)(cwl + 1024 + cc0), cb1 = *(const LAS f32x4*)(cwl + 1024 + cc0 + 4);
#pragma unroll
            for (int e = 0; e < 8; ++e) { y0[e] = e < 4 ? cb0[e & 3] : cb1[e & 3]; y1[e] = y0[e]; }
#pragma unroll
            for (int j = 0; j < 5; ++j) {
                float xr[8];
#pragma unroll
                for (int q = 0; q < 4; ++q) { xr[2 * q] = bflo(xw[gi][j][q]); xr[2 * q + 1] = bfhi(xw[gi][j][q]); }
                if (j < 4) {
                    const f32x4 w0 = *(const LAS f32x4*)(cwl + j * 256 + cc0), w1 = *(const LAS f32x4*)(cwl + j * 256 + cc0 + 4);
#pragma unroll
                    for (int e = 0; e < 8; ++e) y0[e] += (e < 4 ? w0[e & 3] : w1[e & 3]) * xr[e];
                }
                if (j > 0) {
                    const f32x4 w0 = *(const LAS f32x4*)(cwl + (j - 1) * 256 + cc0), w1 = *(const LAS f32x4*)(cwl + (j - 1) * 256 + cc0 + 4);
#pragma unroll
                    for (int e = 0; e < 8; ++e) y1[e] += (e < 4 ? w0[e & 3] : w1[e & 3]) * xr[e];
                }
            }
        }
        const float sc = isk ? 0.08838834764831845f : 1.f;
#pragma unroll
        for (int e = 0; e < 8; ++e) { y0[e] = y0[e] * sigmoid_(y0[e]) * sc; y1[e] = y1[e] * sigmoid_(y1[e]) * sc; }
        bf16_t* dst = (isk ? KC : QC) + (size_t)(t0 + s) * 512 + h * 128 + cgp;
        u32x4 w; w.x = cvt_pk_bf16(y0[0], y0[1]); w.y = cvt_pk_bf16(y0[2], y0[3]); w.z = cvt_pk_bf16(y0[4], y0[5]); w.w = cvt_pk_bf16(y0[6], y0[7]);
        *(u32x4*)dst = w;
        w.x = cvt_pk_bf16(y1[0], y1[1]); w.y = cvt_pk_bf16(y1[2], y1[3]); w.z = cvt_pk_bf16(y1[4], y1[5]); w.w = cvt_pk_bf16(y1[6], y1[7]);
        *(u32x4*)(dst + 512) = w;
        if (isk) {
            const float w0 = wsv[s], w1 = wsv[s + 1];
#pragma unroll
            for (int e = 0; e < 8; ++e) *(LAS unsigned*)(KT + (cgp + e) * 272 + lane * 4) = cvt_pk_bf16(y0[e] * w0, y1[e] * w1);
        }
    }
    stage_T<4>(P + p_off<3072, 4, 256>(t0, h, 0), 256, VT, wave, lane);
    for (int i = tid; i < 1024; i += NTHREADS) { const int r = i >> 6, w = i & 63; *(LAS unsigned*)(VT + (256 + r) * 272 + w * 4) = 0x3F803F80u; }
    __syncthreads();
    bf16x8 af[4];
#pragma unroll
    for (int kk = 0; kk < 4; ++kk) af[kk] = ld_frag_lds(KT + (16 * wave + fr) * 272 + (32 * kk + 8 * fq) * 2);
    float* ST = (float*)(p.ws + WS_ST) + ((size_t)(bh * 64 + c) * 272) * 128;
#pragma unroll
    for (int n = 0; n < 17; ++n) {
        f32x4 acc = {0.f, 0.f, 0.f, 0.f};
#pragma unroll
        for (int kk = 0; kk < 4; ++kk) { const bf16x8 bfr = ld_frag_lds(VT + (16 * n + fr) * 272 + (32 * kk + 8 * fq) * 2); acc = MFMA16(af[kk], bfr, acc); }
        if (n < 16 || fr == 0) *(f32x4*)(ST + (size_t)(16 * n + fr) * 128 + 16 * wave + 4 * fq) = acc;
    }
}

DI void phase_scan(const Params& p) {
    const float* ST = (const float*)(p.ws + WS_ST); bf16_t* CPT = (bf16_t*)(p.ws + WS_CPT);
    const float* BEND = (const float*)(p.ws + WS_BEND); const float* GMAX = (const float*)(p.ws + WS_GMAX); float* MPREV = (float*)(p.ws + WS_MPREV);
    const int gtid = blockIdx.x * NTHREADS + threadIdx.x, nthr = gridDim.x * NTHREADS;
    constexpr int PER = 8224;
    constexpr size_t CST = 272 * 128;
    for (int item = gtid; item < 16 * PER; item += nthr) {
        const int bh = item / PER, e4 = item - bh * PER;
        const float* src = ST + (size_t)bh * 64 * CST + (size_t)e4 * 4;
        bf16_t* dst = CPT + (size_t)bh * 64 * CST + (size_t)e4 * 4;
        f32x4 st = {0.f, 0.f, 0.f, 0.f}; float m = 0.f;
        for (int c0 = 0; c0 < 64; c0 += 8) {
            f32x4 d[8];
#pragma unroll
            for (int j = 0; j < 8; ++j) d[j] = *(const f32x4*)(src + (size_t)(c0 + j) * CST);
#pragma unroll
            for (int j = 0; j < 8; ++j) {
                const int c = c0 + j;
                const float be = BEND[bh * 64 + c], gm = GMAX[bh * 64 + c];
                const float mn = fmaxf(be + m, gm), a = __expf(be + m - mn), sc = __expf(gm - mn);
                u32x2 w; w.x = cvt_pk_bf16(st[0], st[1]); w.y = cvt_pk_bf16(st[2], st[3]);
                *(u32x2*)(dst + (size_t)c * CST) = w;
                if (e4 == 0) MPREV[bh * 64 + c] = m;
                st = st * a + d[j] * sc; m = mn;
            }
        }
    }
}

DI void mlstm_out(const Params& p, LAS unsigned char* lds, int b, int c, int h) {
    const int tid = threadIdx.x, lane = tid & 63, wave = __builtin_amdgcn_readfirstlane(tid >> 6), fr = lane & 15, fq = lane >> 4;
    const int bh = b * 4 + h, t0 = b * 8192 + c * 128;
    LAS unsigned char* Kl = lds; LAS unsigned char* Sl = lds + 34816; LAS unsigned char* VTe = lds + 69632;
    LAS float* av = (LAS float*)(lds + 143616); LAS float* Mv = (LAS float*)(lds + 144128); LAS float* bv = (LAS float*)(lds + 144640);
    const bf16_t* P = (const bf16_t*)(p.ws + WS_P); bf16_t* YM = (bf16_t*)(p.ws + WS_XN);
    const bf16_t* QC = (const bf16_t*)(p.ws + WS_QC); const bf16_t* KC = (const bf16_t*)(p.ws + WS_KC);
    const float* IG = (const float*)(p.ws + WS_IG); const float* LF = (const float*)(p.ws + WS_LF);
    const float mprev = ((const float*)(p.ws + WS_MPREV))[bh * 64 + c];
    __syncthreads();
    if (wave == 0) {
        const float l0 = LF[(size_t)(t0 + 2 * lane) * 4 + h], l1 = LF[(size_t)(t0 + 2 * lane + 1) * 4 + h];
        const float i0 = IG[(size_t)(t0 + 2 * lane) * 4 + h], i1 = IG[(size_t)(t0 + 2 * lane + 1) * 4 + h];
        float s = l0 + l1;
#pragma unroll
        for (int off = 1; off < 64; off <<= 1) { const float tt = __shfl_up(s, off); if (lane >= off) s += tt; }
        const float b1 = s, b0 = s - l1;
        const float a0 = i0 - b0, a1 = i1 - b1;
        float pm = fmaxf(a0, a1);
#pragma unroll
        for (int off = 1; off < 64; off <<= 1) { const float tt = __shfl_up(pm, off); if (lane >= off) pm = fmaxf(pm, tt); }
        float ex = __shfl_up(pm, 1); if (lane == 0) ex = -3.0e38f;
        Mv[2 * lane] = fmaxf(mprev, fmaxf(ex, a0)); Mv[2 * lane + 1] = fmaxf(mprev, pm);
        av[2 * lane] = a0; av[2 * lane + 1] = a1; bv[2 * lane] = b0; bv[2 * lane + 1] = b1;
    }
#pragma unroll
    for (int it = 0; it < 4; ++it) {
        const int e = (it * NTHREADS + tid) * 8, s = e >> 7, d0 = e & 127;
        *(LAS u32x4*)(Kl + s * 272 + d0 * 2) = *(const u32x4*)(KC + (size_t)(t0 + s) * 512 + h * 128 + d0);
    }
    stage_T<4>(P + p_off<3072, 4, 256>(t0, h, 0), 256, VTe, wave, lane);
    for (int i = tid; i < 1024; i += NTHREADS) { const int r = i >> 6, w = i & 63; *(LAS unsigned*)(VTe + (256 + r) * 272 + w * 4) = 0x3F803F80u; }
    bf16x8 qf[4];
#pragma unroll
    for (int kk = 0; kk < 4; ++kk) qf[kk] = *(const bf16x8*)(QC + (size_t)(t0 + 16 * wave + fr) * 512 + h * 128 + 32 * kk + 8 * fq);
    __syncthreads();
    const int t = 16 * wave + fr; const float Mt = Mv[t];
    const int stmax = wave | 1;
    for (int st = 0; st <= stmax; ++st) {
        f32x4 s4 = {0.f, 0.f, 0.f, 0.f};
#pragma unroll
        for (int kk = 0; kk < 4; ++kk) { const bf16x8 kf = ld_frag_lds(Kl + (16 * st + fr) * 272 + (32 * kk + 8 * fq) * 2); s4 = MFMA16(kf, qf[kk], s4); }
#pragma unroll
        for (int r = 0; r < 4; ++r) { const int s = 16 * st + 4 * fq + r; const float w = (s <= t) ? __expf(av[s] - Mt) : 0.f; s4[r] *= w; }
        u32x2 w; w.x = cvt_pk_bf16(s4[0], s4[1]); w.y = cvt_pk_bf16(s4[2], s4[3]);
        *(LAS u32x2*)(Sl + t * 272 + (16 * st + 4 * fq) * 2) = w;
    }
    __syncthreads();
    const bf16_t* cpt = (const bf16_t*)(p.ws + WS_CPT) + ((size_t)(bh * 64 + c) * 272) * 128;
    f32x4 acc[17];
#pragma unroll
    for (int n = 0; n < 17; ++n) {
        acc[n] = (f32x4){0.f, 0.f, 0.f, 0.f};
#pragma unroll
        for (int kk = 0; kk < 4; ++kk) { const bf16x8 cf = *(const bf16x8*)(cpt + (size_t)(16 * n + fr) * 128 + 32 * kk + 8 * fq); acc[n] = MFMA16(cf, qf[kk], acc[n]); }
    }
    const float ai = __expf(mprev - Mt);
#pragma unroll
    for (int n = 0; n < 17; ++n) acc[n] = acc[n] * ai;
    const int k2max = (16 * wave + 15) >> 5;
#pragma unroll
    for (int kk = 0; kk < 4; ++kk) {
        if (kk <= k2max) {
            const bf16x8 sf = ld_frag_lds(Sl + t * 272 + (32 * kk + 8 * fq) * 2);
#pragma unroll
            for (int n = 0; n < 17; ++n) { const bf16x8 vf = ld_frag_lds(VTe + (16 * n + fr) * 272 + (32 * kk + 8 * fq) * 2); acc[n] = MFMA16(vf, sf, acc[n]); }
        }
    }
    const float den = __shfl(acc[16][0], fr);
    const float mt = bv[t] + Mt;
    const float inv = rcpf_(fmaxf(fabsf(den), __expf(-mt)));
    const size_t grow = (size_t)(t0 + t);
    float ss = 0.f;
#pragma unroll
    for (int n = 0; n < 16; ++n) {
        const int v0 = 16 * n + 4 * fq;
        const u32x2 ow = *(const u32x2*)(P + p_off<4096, 4, 256>(t0 + t, h, v0));
        f32x4 y;
        y[0] = bflo(ow.x) * acc[n][0] * inv; y[1] = bfhi(ow.x) * acc[n][1] * inv; y[2] = bflo(ow.y) * acc[n][2] * inv; y[3] = bfhi(ow.y) * acc[n][3] * inv;
        ss += (y[0] * y[0] + y[1] * y[1]) + (y[2] * y[2] + y[3] * y[3]);
        acc[n] = y;
    }
    ss += __shfl_xor(ss, 16); ss += __shfl_xor(ss, 32);
    const float rstd = rsqrtf(ss * (1.f / 256.f) + EPS);
#pragma unroll
    for (int n = 0; n < 16; ++n) {
        const int v0 = 16 * n + 4 * fq;
        const f32x4 g = *(const f32x4*)(p.ml_out_g + h * 256 + v0);
        const f32x4 o = acc[n] * rstd * g;
        u32x2 w; w.x = cvt_pk_bf16(o[0], o[1]); w.y = cvt_pk_bf16(o[2], o[3]);
        *(u32x2*)(YM + grow * DM + 1024 + h * 256 + v0) = w;
    }
}

DI unsigned ord_key(float f) { const unsigned u = __float_as_uint(f); return (u & 0x80000000u) ? ~u : (u | 0x80000000u); }
DI float key_val(unsigned k) { return (k & 0x80000000u) ? __uint_as_float(k & 0x7fffffffu) : __uint_as_float(~k); }
DI unsigned umax_(unsigned a, unsigned b) { return a > b ? a : b; }
DI unsigned umin_(unsigned a, unsigned b) { return a < b ? a : b; }
#define DPPU(v, ctrl) ((unsigned)__builtin_amdgcn_update_dpp(0, (int)(v), (ctrl), 0xF, 0xF, true))
DI unsigned row_max_u32(unsigned v) {
    v = umax_(v, DPPU(v, 0xB1)); v = umax_(v, DPPU(v, 0x4E)); v = umax_(v, DPPU(v, 0x141)); v = umax_(v, DPPU(v, 0x140)); return v;
}
DI float row_sum_f32(float v) {
    v += __uint_as_float(DPPU(__float_as_uint(v), 0xB1)); v += __uint_as_float(DPPU(__float_as_uint(v), 0x4E));
    v += __uint_as_float(DPPU(__float_as_uint(v), 0x141)); v += __uint_as_float(DPPU(__float_as_uint(v), 0x140)); return v;
}
#define CEX(a, b) do { const unsigned mx_ = umax_(a, b), mn_ = umin_(a, b); a = mx_; b = mn_; } while (0)
template <int N> DI unsigned top16_row(unsigned (&s)[N], int c) {
    unsigned list = 0u;
#pragma unroll 1
    for (int it = 0; it < 16; ++it) {
        const unsigned wm = row_max_u32(s[0]);
        const bool win = (s[0] == wm);
#pragma unroll
        for (int i = 0; i < N - 1; ++i) s[i] = win ? s[i + 1] : s[i];
        s[N - 1] = win ? 0u : s[N - 1];
        list = (c == it) ? wm : list;
    }
    return list;
}

template <int N> DI void top16_row2(unsigned (&s)[N], unsigned (&t)[N], int c, unsigned& l1, unsigned& l2) {
    l1 = 0u; l2 = 0u;
#pragma unroll 1
    for (int it = 0; it < 16; ++it) {
        const unsigned wm1 = row_max_u32(s[0]), wm2 = row_max_u32(t[0]);
        const bool win1 = (s[0] == wm1), win2 = (t[0] == wm2);
#pragma unroll
        for (int i = 0; i < N - 1; ++i) { s[i] = win1 ? s[i + 1] : s[i]; t[i] = win2 ? t[i + 1] : t[i]; }
        s[N - 1] = win1 ? 0u : s[N - 1]; t[N - 1] = win2 ? 0u : t[N - 1];
        l1 = (c == it) ? wm1 : l1; l2 = (c == it) ? wm2 : l2;
    }
}

template <int N> DI void top16_row4(unsigned (&s)[N], unsigned (&t)[N], unsigned (&u)[N], unsigned (&v)[N], int c, unsigned& l1, unsigned& l2, unsigned& l3, unsigned& l4) {
    l1 = 0u; l2 = 0u; l3 = 0u; l4 = 0u;
#pragma unroll 1
    for (int it = 0; it < 16; ++it) {
        const unsigned wm1 = row_max_u32(s[0]), wm2 = row_max_u32(t[0]), wm3 = row_max_u32(u[0]), wm4 = row_max_u32(v[0]);
        const bool win1 = (s[0] == wm1), win2 = (t[0] == wm2), win3 = (u[0] == wm3), win4 = (v[0] == wm4);
#pragma unroll
        for (int i = 0; i < N - 1; ++i) { s[i] = win1 ? s[i + 1] : s[i]; t[i] = win2 ? t[i + 1] : t[i]; u[i] = win3 ? u[i + 1] : u[i]; v[i] = win4 ? v[i + 1] : v[i]; }
        s[N - 1] = win1 ? 0u : s[N - 1]; t[N - 1] = win2 ? 0u : t[N - 1]; u[N - 1] = win3 ? 0u : u[N - 1]; v[N - 1] = win4 ? 0u : v[N - 1];
        l1 = (c == it) ? wm1 : l1; l2 = (c == it) ? wm2 : l2; l3 = (c == it) ? wm3 : l3; l4 = (c == it) ? wm4 : l4;
    }
}
#define SORT8(s) do { CEX(s[0], s[1]); CEX(s[2], s[3]); CEX(s[4], s[5]); CEX(s[6], s[7]); CEX(s[0], s[2]); CEX(s[1], s[3]); CEX(s[4], s[6]); CEX(s[5], s[7]); CEX(s[1], s[2]); CEX(s[5], s[6]); \
    CEX(s[0], s[4]); CEX(s[1], s[5]); CEX(s[2], s[6]); CEX(s[3], s[7]); CEX(s[2], s[4]); CEX(s[3], s[5]); CEX(s[1], s[2]); CEX(s[3], s[4]); CEX(s[5], s[6]); } while (0)
#define SORT4(s) do { CEX(s[0], s[1]); CEX(s[2], s[3]); CEX(s[0], s[2]); CEX(s[1], s[3]); CEX(s[1], s[2]); } while (0)

DI void peer_select(const Params& p) {
    const int tid = threadIdx.x, lane = tid & 63, wave = __builtin_amdgcn_readfirstlane(tid >> 6), c = lane & 15, g = lane >> 4, rowbase = lane & 48;
    const bf16_t* Q = (const bf16_t*)(p.ws + WS_Q); const bf16_t* KB1 = (const bf16_t*)(p.ws + WS_KB1); const bf16_t* KB2 = (const bf16_t*)(p.ws + WS_KB2);
    int* SELID = (int*)(p.ws + WS_SELID); float* SELG = (float*)(p.ws + WS_SELG);
    unsigned pk = 0u, validmask = 0u;
#pragma unroll
    for (int q = 0; q < 4; ++q) {
        const int target = 4 * c + q; int ci = 0, cj = 0, cnt = 0; bool v = false;
#pragma unroll
        for (int i = 0; i < 16; ++i) { const int nj = 16 / (i + 1); if (target >= cnt && target < cnt + nj) { ci = i; cj = target - cnt; v = true; } cnt += nj; }
        pk |= (unsigned)((ci << 4) | cj) << (8 * q); validmask |= (v ? 1u : 0u) << q;
    }
    for (int tile = blockIdx.x * 8 + wave; tile < T_TOK / 16; tile += gridDim.x * 8) {
        const int tok0 = tile * 16;
        for (int h = 0; h < 8; ++h) {
            bf16x8 a1[2], a2[2];
            {
                const bf16_t* qp = Q + (size_t)(tok0 + c) * 1024 + h * 128 + g * 8;
                a1[0] = *(const bf16x8*)qp; a1[1] = *(const bf16x8*)(qp + 32); a2[0] = *(const bf16x8*)(qp + 64); a2[1] = *(const bf16x8*)(qp + 96);
            }
            f32x4 acc1[8], acc2[8];
#pragma unroll
            for (int nt = 0; nt < 8; ++nt) {
                const size_t ko = ((size_t)(h * 128 + nt * 16 + c)) * 64 + g * 8;
                acc1[nt] = (f32x4){0.f, 0.f, 0.f, 0.f}; acc2[nt] = (f32x4){0.f, 0.f, 0.f, 0.f};
                acc1[nt] = MFMA16(a1[0], *(const bf16x8*)(KB1 + ko), acc1[nt]); acc1[nt] = MFMA16(a1[1], *(const bf16x8*)(KB1 + ko + 32), acc1[nt]);
                acc2[nt] = MFMA16(a2[0], *(const bf16x8*)(KB2 + ko), acc2[nt]); acc2[nt] = MFMA16(a2[1], *(const bf16x8*)(KB2 + ko + 32), acc2[nt]);
            }
#pragma unroll
            for (int rp = 0; rp < 2; ++rp) {
                const int r0 = 2 * rp, r1 = 2 * rp + 1;
                unsigned sA[8], sB[8], sC[8], sD[8];
#pragma unroll
                for (int nt = 0; nt < 8; ++nt) {
                    const unsigned ix = (unsigned)(127 - (nt * 16 + c));
                    sA[nt] = (ord_key(acc1[nt][r0]) & ~0x7Fu) | ix; sB[nt] = (ord_key(acc2[nt][r0]) & ~0x7Fu) | ix;
                    sC[nt] = (ord_key(acc1[nt][r1]) & ~0x7Fu) | ix; sD[nt] = (ord_key(acc2[nt][r1]) & ~0x7Fu) | ix;
                }
                SORT8(sA); SORT8(sB); SORT8(sC); SORT8(sD);
                unsigned lA, lB, lC, lD;
                top16_row4<8>(sA, sB, sC, sD, c, lA, lB, lC, lD);
                unsigned c0[4], c1[4];
#pragma unroll
                for (int q = 0; q < 4; ++q) {
                    const int ci = (int)((pk >> (8 * q + 4)) & 15u), cj = (int)((pk >> (8 * q)) & 15u);
                    const unsigned ka = (unsigned)__shfl((int)lA, rowbase + ci), kb = (unsigned)__shfl((int)lB, rowbase + cj);
                    const unsigned kc = (unsigned)__shfl((int)lC, rowbase + ci), kd = (unsigned)__shfl((int)lD, rowbase + cj);
                    const float cand0 = key_val(ka & ~0x7Fu) + key_val(kb & ~0x7Fu), cand1 = key_val(kc & ~0x7Fu) + key_val(kd & ~0x7Fu);
                    const bool ok = ((validmask >> q) & 1u) != 0u; const unsigned ix = (unsigned)(63 - (4 * c + q));
                    c0[q] = ok ? ((ord_key(cand0) & ~0x3Fu) | ix) : 0u; c1[q] = ok ? ((ord_key(cand1) & ~0x3Fu) | ix) : 0u;
                }
                SORT4(c0); SORT4(c1);
                unsigned sel0, sel1;
                top16_row2<4>(c0, c1, c, sel0, sel1);
#pragma unroll
                for (int u = 0; u < 2; ++u) {
                    const unsigned sel = u ? sel1 : sel0, list1 = u ? lC : lA, list2 = u ? lD : lB; const int r = u ? r1 : r0;
                    const int slot = 63 - (int)(sel & 63u);
                    const unsigned pkv = (unsigned)__shfl((int)pk, rowbase + (slot >> 2));
                    const int cij = (int)((pkv >> (8 * (slot & 3))) & 0xFFu);
                    const unsigned e1 = (unsigned)__shfl((int)list1, rowbase + (cij >> 4)), e2 = (unsigned)__shfl((int)list2, rowbase + (cij & 15));
                    const int eid = (127 - (int)(e1 & 127u)) * 128 + (127 - (int)(e2 & 127u));
                    const float sv = key_val(sel & ~0x3Fu), mx = key_val(row_max_u32(sel) & ~0x3Fu);
                    const float ev = __expf(sv - mx);
                    const float sum = row_sum_f32(ev);
                    const size_t o = (size_t)(tok0 + 4 * g + r) * 128 + h * 16 + c;
                    SELID[o] = eid; SELG[o] = ev * rcpf_(sum);
                }
            }
        }
    }
}

DI f32x2 pkfma(f32x2 a, f32x2 b, f32x2 c) { return __builtin_elementwise_fma(a, b, c); }
DI void peer_gather(const Params& p, LAS unsigned char* lds) {
    const int tid = threadIdx.x, lane = tid & 63, wave = __builtin_amdgcn_readfirstlane(tid >> 6);
    LAS float* scr = (LAS float*)lds + wave * (16 * 68);
    LAS float* cfl = (LAS float*)(lds + 8 * 16 * 68 * 4) + wave * 128;
    const unsigned char* Ub = p.ws + WS_UB; const unsigned char* Vb = p.ws + WS_VB;
    const float* PSS2 = (const float*)(p.ws + WS_PSS2);
    const int* SELID = (const int*)(p.ws + WS_SELID); const float* SELG = (const float*)(p.ws + WS_SELG);
    const int gw = blockIdx.x * 8 + wave, nw = gridDim.x * 8;
    for (int t = gw; t < T_TOK; t += nw) {
        const int idA = SELID[(size_t)t * 128 + lane], idB = SELID[(size_t)t * 128 + 64 + lane];
        const float gA = SELG[(size_t)t * 128 + lane], gB = SELG[(size_t)t * 128 + 64 + lane];
        const bf16_t* xrow = (const bf16_t*)(p.ws + WS_X1G) + (size_t)t * DM + lane * 32;
        float* orow = p.out + (size_t)t * DM + lane * 32;
        const float pv = lane < 32 ? PSS2[(size_t)t * 32 + lane] : 0.f;
        const float rstd2 = rsqrtf(wave_sum(pv) * (1.f / 2048.f) + EPS);
        f32x2 h2[16];
#pragma unroll
        for (int q = 0; q < 4; ++q) {
            const u32x4 xw = *(const u32x4*)(xrow + q * 8);
            const f32x4 g0 = *(const f32x4*)(p.norm2_g + lane * 32 + q * 8), g1 = *(const f32x4*)(p.norm2_g + lane * 32 + q * 8 + 4);
            h2[4 * q] = (f32x2){bflo(xw.x) * rstd2 * g0[0], bfhi(xw.x) * rstd2 * g0[1]};
            h2[4 * q + 1] = (f32x2){bflo(xw.y) * rstd2 * g0[2], bfhi(xw.y) * rstd2 * g0[3]};
            h2[4 * q + 2] = (f32x2){bflo(xw.z) * rstd2 * g1[0], bfhi(xw.z) * rstd2 * g1[1]};
            h2[4 * q + 3] = (f32x2){bflo(xw.w) * rstd2 * g1[2], bfhi(xw.w) * rstd2 * g1[3]};
        }
        constexpr int NPK = 8;
        u32x4 buf[2][NPK]; unsigned short bsc[2][NPK];
#define PEER_LOAD(TB, st, base) do { const int idv_ = ((base) < 64) ? idA : idB; _Pragma("unroll") for (int e_ = 0; e_ < NPK; ++e_) { \
            const int id_ = __builtin_amdgcn_readlane(idv_, ((base) + e_) & 63); const unsigned char* r_ = (TB) + (size_t)id_ * 1152; \
            buf[st][e_] = *(const u32x4*)(r_ + lane * 16); bsc[st][e_] = *(const unsigned short*)(r_ + 1024 + lane * 2); } } while (0)
#define PEER_DOT(st, slot0) do { _Pragma("unroll") for (int e_ = 0; e_ < NPK; ++e_) { f32x2 a2_ = {0.f, 0.f}; \
            _Pragma("unroll") for (int d_ = 0; d_ < 4; ++d_) { const unsigned w_ = buf[st][e_][d_]; \
                a2_ = pkfma(h2[d_ * 4 + 0], __builtin_amdgcn_cvt_scalef32_pk_f32_fp4(w_, 1.0f, 0), a2_); a2_ = pkfma(h2[d_ * 4 + 1], __builtin_amdgcn_cvt_scalef32_pk_f32_fp4(w_, 1.0f, 1), a2_); \
                a2_ = pkfma(h2[d_ * 4 + 2], __builtin_amdgcn_cvt_scalef32_pk_f32_fp4(w_, 1.0f, 2), a2_); a2_ = pkfma(h2[d_ * 4 + 3], __builtin_amdgcn_cvt_scalef32_pk_f32_fp4(w_, 1.0f, 3), a2_); } \
            scr[((slot0) + e_) * 68 + lane] = (a2_[0] + a2_[1]) * bf2f(bsc[st][e_]); } } while (0)
        PEER_LOAD(Ub, 0, 0);
        for (int b = 0; b < 128 / NPK; b += 2) {
            PEER_LOAD(Ub, 1, (b + 1) * NPK);
            PEER_DOT(0, (b * NPK) & 15);
            if (b + 2 < 128 / NPK) PEER_LOAD(Ub, 0, (b + 2) * NPK);
            PEER_DOT(1, ((b + 1) * NPK) & 15);
            if ((((b + 2) * NPK) & 15) == 0) {
                WAVE_LDS_SYNC();
                float sum = 0.f;
#pragma unroll
                for (int i = 0; i < 4; ++i) { const f32x4 r = *(const LAS f32x4*)(scr + (lane >> 2) * 68 + (lane & 3) * 16 + 4 * i); sum += (r[0] + r[1]) + (r[2] + r[3]); }
                sum += __shfl_xor(sum, 1); sum += __shfl_xor(sum, 2);
                const int k0 = (b + 2) * NPK - 16;
                const int k = k0 + (lane >> 2);
                const float gate = __shfl((k0 < 64) ? gA : gB, k & 63);
                if ((lane & 3) == 0) cfl[k] = gate * gelu_t(sum);
                WAVE_LDS_SYNC();
            }
        }
        f32x2 acc[16];
#pragma unroll
        for (int i = 0; i < 16; ++i) acc[i] = (f32x2){0.f, 0.f};
#define PEER_AXPY(st, base) do { _Pragma("unroll") for (int e_ = 0; e_ < NPK; ++e_) { const float c_ = cfl[(base) + e_] * bf2f(bsc[st][e_]); const f32x2 c2_ = {c_, c_}; \
            _Pragma("unroll") for (int d_ = 0; d_ < 4; ++d_) { const unsigned w_ = buf[st][e_][d_]; \
                acc[d_ * 4 + 0] = pkfma(c2_, __builtin_amdgcn_cvt_scalef32_pk_f32_fp4(w_, 1.0f, 0), acc[d_ * 4 + 0]); acc[d_ * 4 + 1] = pkfma(c2_, __builtin_amdgcn_cvt_scalef32_pk_f32_fp4(w_, 1.0f, 1), acc[d_ * 4 + 1]); \
                acc[d_ * 4 + 2] = pkfma(c2_, __builtin_amdgcn_cvt_scalef32_pk_f32_fp4(w_, 1.0f, 2), acc[d_ * 4 + 2]); acc[d_ * 4 + 3] = pkfma(c2_, __builtin_amdgcn_cvt_scalef32_pk_f32_fp4(w_, 1.0f, 3), acc[d_ * 4 + 3]); } } } while (0)
        PEER_LOAD(Vb, 0, 0);
        for (int b = 0; b < 128 / NPK; b += 2) {
            PEER_LOAD(Vb, 1, (b + 1) * NPK);
            PEER_AXPY(0, b * NPK);
            if (b + 2 < 128 / NPK) PEER_LOAD(Vb, 0, (b + 2) * NPK);
            PEER_AXPY(1, (b + 1) * NPK);
        }
        float ss = 0.f;
#pragma unroll
        for (int q = 0; q < 4; ++q) {
            const u32x4 xw = *(const u32x4*)(xrow + q * 8);
            acc[4 * q] += (f32x2){bflo(xw.x), bfhi(xw.x)}; acc[4 * q + 1] += (f32x2){bflo(xw.y), bfhi(xw.y)};
            acc[4 * q + 2] += (f32x2){bflo(xw.z), bfhi(xw.z)}; acc[4 * q + 3] += (f32x2){bflo(xw.w), bfhi(xw.w)};
#pragma unroll
            for (int i = 0; i < 4; ++i) { const f32x2 a = acc[4 * q + i]; ss += a[0] * a[0] + a[1] * a[1]; }
        }
        const float rstd = rsqrtf(wave_sum(ss) * (1.f / 2048.f) + EPS);
#pragma unroll
        for (int q = 0; q < 8; ++q) {
            const f32x4 g0 = *(const f32x4*)(p.final_g + lane * 32 + q * 4);
            const f32x2 a = acc[2 * q], b = acc[2 * q + 1];
            const f32x4 o0 = {a[0] * rstd * g0[0], a[1] * rstd * g0[1], b[0] * rstd * g0[2], b[1] * rstd * g0[3]};
            *(f32x4*)(orow + q * 4) = o0;
        }
        WAVE_LDS_SYNC();
    }
}

#define XB_TMO      128
#define XB_XCNT(j)  (256  + 64 * (j))
#define XB_XSUB(j)  (1280 + 64 * (j))
#define XB_XGEN(j)  (2304 + 64 * (j))
#define XB_TOP      3328
#define XB_TOPGEN   3392
#define XCD_BAR_WORDS 3456
#define XB_SPIN_CAP (1u << 18)

__device__ __forceinline__ unsigned xb_ld(unsigned* p)              { return __hip_atomic_load(p, __ATOMIC_RELAXED, __HIP_MEMORY_SCOPE_AGENT); }
__device__ __forceinline__ unsigned xb_add(unsigned* p, unsigned v) { return __hip_atomic_fetch_add(p, v, __ATOMIC_RELAXED, __HIP_MEMORY_SCOPE_AGENT); }
__device__ __forceinline__ unsigned xb_xcc_id() { return (unsigned)__builtin_amdgcn_s_getreg((3 << 11) | 20) & 0xFu; }
#define XB_SPIN(cond, bar) do { unsigned _sp = 0; while (cond) { __builtin_amdgcn_s_sleep(1); \
    if ((++_sp & 255u) == 0u) { if (xb_ld(&(bar)[XB_TMO])) break; if (_sp > XB_SPIN_CAP) { atomicAdd(&(bar)[XB_TMO], 1u); break; } } } } while (0)

struct XcdBarrier {
    unsigned* bar; unsigned x;
    volatile LAS unsigned* st;
};

__device__ __forceinline__ XcdBarrier xcd_barrier_post(unsigned* bar, volatile LAS unsigned* st) {
    XcdBarrier b; b.bar = bar; b.x = xb_xcc_id(); b.st = st;
    if (threadIdx.x == 0) (void)xb_add(&bar[XB_XCNT(b.x)], 1u);
    return b;
}
__device__ __forceinline__ void xcd_barrier_complete(unsigned* bar, unsigned x, unsigned& nloc, unsigned& nx) {
    const unsigned G = gridDim.x * gridDim.y * gridDim.z;
    unsigned sum, cnt, mine, sp = 0u;
    for (;;) {
        sum = 0u; cnt = 0u; mine = 0u;
#pragma unroll
        for (unsigned j = 0; j < 16; ++j) { const unsigned c = xb_ld(&bar[XB_XCNT(j)]); sum += c; cnt += (c > 0u) ? 1u : 0u; mine = (j == x) ? c : mine; }
        if (sum == G) break;
        __builtin_amdgcn_s_sleep(1);
        if ((++sp & 255u) == 0u) { if (xb_ld(&bar[XB_TMO])) break; if (sp > XB_SPIN_CAP) { atomicAdd(&bar[XB_TMO], 1u); break; } }
    }
    nloc = mine > 0u ? mine : 1u; nx = cnt > 0u ? cnt : 1u;
}

__device__ __forceinline__ void xcd_barrier(const XcdBarrier& b) {
    asm volatile("s_waitcnt vmcnt(0)" ::: "memory");
    __syncthreads();
    if (threadIdx.x == 0) {
        unsigned* bar = b.bar;
        __builtin_amdgcn_s_waitcnt(0);
        unsigned nloc = b.st[0], nx = b.st[1];
        if (nloc == 0u) { xcd_barrier_complete(bar, b.x, nloc, nx); b.st[0] = nloc; b.st[1] = nx; }
        const unsigned old = xb_add(&bar[XB_XSUB(b.x)], 1u);
        const unsigned gen = old / nloc;
        if (old + 1u == (gen + 1u) * nloc) {
            __builtin_amdgcn_fence(__ATOMIC_RELEASE, "agent");
            asm volatile("s_waitcnt vmcnt(0)" ::: "memory");
            const unsigned og = xb_add(&bar[XB_TOP], 1u);
            const unsigned tg = og / nx;
            if (og + 1u == (tg + 1u) * nx) xb_add(&bar[XB_TOPGEN], 1u);
            else XB_SPIN(xb_ld(&bar[XB_TOPGEN]) == tg, bar);
            __builtin_amdgcn_fence(__ATOMIC_ACQUIRE, "agent");
            xb_add(&bar[XB_XGEN(b.x)], 1u);
            asm volatile("s_waitcnt vmcnt(0)" ::: "memory");
        } else {
            XB_SPIN(xb_ld(&bar[XB_XGEN(b.x)]) == gen, bar);
            __builtin_amdgcn_fence(__ATOMIC_ACQUIRE, "agent");
            asm volatile("s_waitcnt vmcnt(0)" ::: "memory");
        }
    }
    __syncthreads();
}

#ifndef PROBE_DUP
#define PROBE_DUP 0
#endif
#define REP(bit) for (int rep_ = 0; rep_ < (((PROBE_DUP) >> (bit)) & 1) + 1; ++rep_)
#define PH1() { pg8::Gemm g{(const bf16_t*)(p.ws + WS_XN), (const bf16_t*)(p.ws + WS_WINT), T_TOK, NPROJ, DM}; pg8::StaticOrder S; S.init(T_TOK, NPROJ, G, bx); Epi1 E{(bf16_t*)(p.ws + WS_P), (float*)(p.ws + WS_PSSV)}; pg8::gemm_phase<Epi1, pg8::StaticOrder, true, true>(lds, g, S, E); xcd_barrier(xbar); }
#define PH3() { pg8::Gemm g{(const bf16_t*)(p.ws + WS_XN), (const bf16_t*)(p.ws + WS_WOUTT), T_TOK, DM, DM}; pg8::StaticOrder S; S.init(T_TOK, DM, G, bx); Epi2 E{p.x, (bf16_t*)(p.ws + WS_X1G), (float*)(p.ws + WS_PSS2)}; pg8::gemm_phase<Epi2, pg8::StaticOrder, true, true>(lds, g, S, E); xcd_barrier(xbar); }
#define PH4() { pg8::Gemm g{(const bf16_t*)(p.ws + WS_X1G), (const bf16_t*)(p.ws + WS_WQT), T_TOK, 1024, DM}; pg8::StaticOrder S; S.init(T_TOK, 1024, G, bx); Epi3 E{(bf16_t*)(p.ws + WS_Q), (const float*)(p.ws + WS_PSS2)}; pg8::gemm_phase<Epi3, pg8::StaticOrder, true, true>(lds, g, S, E); xcd_barrier(xbar); }
__global__ void __launch_bounds__(NTHREADS, 2) hymba_fwd(Params p) {
    extern __shared__ __attribute__((aligned(16))) unsigned char smem[];
    LAS unsigned char* lds = (LAS unsigned char*)smem;
    cg::grid_group grid = cg::this_grid();
    const int G = gridDim.x, bx = blockIdx.x;
    unsigned* barw = (unsigned*)(p.ws + WS_BAR);
    volatile LAS unsigned* xst = (volatile LAS unsigned*)(lds + LDS_BYTES - 16);
    if (threadIdx.x < 4) xst[threadIdx.x] = 0u;
    if (bx == 0) { for (int i = threadIdx.x; i < XCD_BAR_WORDS; i += NTHREADS) barw[i] = 0u; }
    __syncthreads();
    REP(0) { phase0(p, lds); grid.sync(); }
    const XcdBarrier xbar = xcd_barrier_post(barw, xst);
    PH1()
#if (PROBE_DUP >> 1) & 1
    PH1()
#endif
    REP(2) {
        for (int si = bx; si < 256; si += G) {
            const int b = si >> 6, c = si & 63;
            gmlp_bc(p, lds, b, c);
            for (int h = 0; h < 4; ++h) mlstm_local(p, lds, b, c, h);
        }
        xcd_barrier(xbar);
    }
    REP(3) { phase_scan(p); xcd_barrier(xbar); }
    REP(4) { for (int it = bx; it < 1024; it += G) mlstm_out(p, lds, it >> 8, (it >> 2) & 63, it & 3); xcd_barrier(xbar); }
    PH3()
#if (PROBE_DUP >> 5) & 1
    PH3()
#endif
    PH4()
#if (PROBE_DUP >> 6) & 1
    PH4()
#endif
    REP(7) { peer_select(p); xcd_barrier(xbar); }
    peer_gather(p, lds);
}

extern "C" void kernel_launch(void* const* d_in, const int* in_sizes, int n_in, void* d_out, int out_size, void* d_ws, size_t ws_size, hipStream_t stream) {
    static int grid_blocks = 0;
    if (grid_blocks == 0) {
        if (n_in != 20 || ws_size < WS_END) { fprintf(stderr, "kernel_launch: unexpected n_in %d or ws_size %zu (need %zu)\n", n_in, ws_size, (size_t)WS_END); grid_blocks = -1; return; }
        int dev = 0, cus = 0, per_cu = 0;
        hipGetDevice(&dev);
        hipDeviceGetAttribute(&cus, hipDeviceAttributeMultiprocessorCount, dev);
        hipFuncSetAttribute((const void*)hymba_fwd, hipFuncAttributeMaxDynamicSharedMemorySize, LDS_BYTES);
        hipOccupancyMaxActiveBlocksPerMultiprocessor(&per_cu, (const void*)hymba_fwd, NTHREADS, LDS_BYTES);
        if (per_cu < 1) { fprintf(stderr, "kernel_launch: occupancy query says %d blocks per CU\n", per_cu); per_cu = 1; }
        if (per_cu > 1) per_cu = 1;
        grid_blocks = cus * per_cu;
        (void)hipGetLastError();
    }
    if (grid_blocks < 0) return;
    Params p{};
    p.x = (const float*)d_in[0]; p.norm1_g = (const float*)d_in[1]; p.w_in = (const float*)d_in[2]; p.gm_vnorm_g = (const float*)d_in[3];
    p.w_spatial = (const float*)d_in[4]; p.b_spatial = (const float*)d_in[5]; p.ml_conv_w = (const float*)d_in[6]; p.ml_conv_b = (const float*)d_in[7];
    p.ml_b_i = (const float*)d_in[8]; p.ml_b_f = (const float*)d_in[9]; p.gm_out_g = (const float*)d_in[10]; p.ml_out_g = (const float*)d_in[11];
    p.w_out = (const float*)d_in[12]; p.norm2_g = (const float*)d_in[13]; p.peer_wq = (const float*)d_in[14]; p.peer_k1 = (const float*)d_in[15];
    p.peer_k2 = (const float*)d_in[16]; p.peer_u = (const float*)d_in[17]; p.peer_v = (const float*)d_in[18]; p.final_g = (const float*)d_in[19];
    p.out = (float*)d_out; p.ws = (unsigned char*)d_ws;
    void* args[] = {&p};
    hipError_t e = hipLaunchCooperativeKernel((const void*)hymba_fwd, dim3(grid_blocks), dim3(NTHREADS), args, LDS_BYTES, stream);
    if (e != hipSuccess) fprintf(stderr, "cooperative launch failed: %s (grid %d)\n", hipGetErrorString(e), grid_blocks);
}
```

```cpp
#include <hip/hip_runtime.h>
#include <hip/hip_cooperative_groups.h>
#include <cstdio>
#include <cstdint>
namespace cg = cooperative_groups;
namespace pg8 {
#define PG8_LAS __attribute__((address_space(3)))
typedef unsigned short bf16_t;
typedef short bf16x8 __attribute__((ext_vector_type(8)));
typedef float f32x4 __attribute__((ext_vector_type(4)));
typedef unsigned u32x4 __attribute__((ext_vector_type(4)));
constexpr int BM = 256, BK = 64, HALF = 128, HTB = HALF * BK * 2  , STAGE_BYTES = 8 * HTB, NXCD = 8, WGM = 8;

__host__ __device__ __forceinline__ int lds_byte(int r, int c) { const int st = (r >> 4) * 2 + (c >> 5), rr = r & 15, cc = c & 31, ob = rr * 64 + cc * 2; return st * 1024 + (ob ^ (((ob >> 9) & 1) << 5)); }
__host__ __device__ __forceinline__ void stage_rc(int b, int& R, int& C) { const int st = b / 1024, sb = b % 1024, swz = sb ^ (((sb >> 9) & 1) << 5); R = (st >> 1) * 16 + swz / 64; C = (st & 1) * 32 + (swz % 64) / 2; }
__host__ __device__ __forceinline__ int perm32(int rho) { const int n = rho >> 4, i = rho & 15; return 8 * (i >> 2) + 4 * n + (i & 3); }

struct Unit { int pm, pn; };
struct Gemm { const bf16_t* A; const bf16_t* Bt; int M, N, K; };

struct StaticOrder {
    int nM, nN, nwg, G, c;
    __host__ __device__ void init(int M, int N, int G_, int c_) { nM = M / BM; nN = N / BM; nwg = nM * nN; G = G_; c = c_; }
    __host__ __device__ bool next(int i, Unit& u) const {
        const long L = (long)i * G + c; if (L >= nwg) return false;
        int wgid = (int)L; { const int q = nwg / NXCD, r = nwg % NXCD, xcd = wgid % NXCD, off = wgid / NXCD; wgid = (xcd < r ? xcd * (q + 1) : r * (q + 1) + (xcd - r) * q) + off; }
        const int nig = WGM * nN, gid = wgid / nig, fm = gid * WGM, gsz = (nM - fm) < WGM ? (nM - fm) : WGM;
        u.pm = fm + ((wgid % nig) % gsz); u.pn = (wgid % nig) / gsz; return true;
    }
    __device__ __forceinline__ void a_ready(const Unit&) const {}
    __device__ __forceinline__ void done(const Unit&) const {}
};
__device__ __forceinline__ unsigned cvt_pk_bf16(float lo, float hi) { unsigned r; asm volatile("v_cvt_pk_bf16_f32 %0, %1, %2" : "=v"(r) : "v"(lo), "v"(hi)); return r; }
template <class Epi, class Sched, bool ALIGN_EPI = false, bool SP2 = false>
__device__ __forceinline__ void gemm_phase(PG8_LAS unsigned char* lds, const Gemm g, const Sched& S, const Epi& E) {
    const int tid = threadIdx.x, wid = __builtin_amdgcn_readfirstlane(tid >> 6), lane = tid & 63, wr = wid >> 2, wc = wid & 3, fr = lane & 15, fq = lane >> 4;
    const int K = g.K, nt = K / BK;
    unsigned voffA[2], voffB[2];
#pragma unroll
    for (int i = 0; i < 2; ++i) { int R, C; stage_rc(tid * 16 + i * 8192, R, C); const int Rb = Epi::PERM ? ((R & ~31) + perm32(R & 31)) : R;
        voffA[i] = (unsigned)(R * K + C) * 2u; voffB[i] = (unsigned)(Rb * K + C) * 2u; }
    const size_t kstep = (size_t)(BK * 2);
    const size_t hstep = (size_t)HALF * K * 2;
    const size_t tstep = 2 * hstep;
    const unsigned ldsw = (unsigned)wid * 1024u;
    const int aoff = lds_byte(wr * 64 + fr, fq * 8), boff = lds_byte(wc * 32 + fr, fq * 8);
#define PG8_SA(b, h) (((b) * 2 + (h)) * HTB)
#define PG8_SB(b, h) ((4 + (b) * 2 + (h)) * HTB)
#define PG8_STAGE(bufoff, gbase, voff) do { _Pragma("unroll") for (int _i = 0; _i < 2; ++_i) \
        __builtin_amdgcn_global_load_lds((const unsigned*)((const char*)(gbase) + (voff)[_i]), (PG8_LAS unsigned*)(lds + (bufoff) + ldsw + _i * 8192), 16, 0, 0); } while (0)
#define PG8_LDA(dst, b, h) do { _Pragma("unroll") for (int m = 0; m < 4; ++m) _Pragma("unroll") for (int k = 0; k < 2; ++k) dst[m][k] = *(const PG8_LAS bf16x8*)(lds + PG8_SA(b, h) + aoff + m * 2048 + k * 1024); } while (0)
#define PG8_LDB(dst, b, h) do { _Pragma("unroll") for (int n = 0; n < 2; ++n) _Pragma("unroll") for (int k = 0; k < 2; ++k) dst[n][k] = *(const PG8_LAS bf16x8*)(lds + PG8_SB(b, h) + boff + n * 2048 + k * 1024); } while (0)
#define PG8_MMA(ai, bj, At, Bt) do { __builtin_amdgcn_s_setprio(1); _Pragma("unroll") for (int m = 0; m < 4; ++m) _Pragma("unroll") for (int n = 0; n < 2; ++n) _Pragma("unroll") for (int k = 0; k < 2; ++k) \
        acc[ai][bj][m][n] = __builtin_amdgcn_mfma_f32_16x16x32_bf16(Bt[n][k], At[m][k], acc[ai][bj][m][n], 0, 0, 0); __builtin_amdgcn_s_setprio(0); } while (0)
#define PG8_WAIT_V(n) asm volatile("s_waitcnt vmcnt(" #n ")" ::: "memory")
#define PG8_WAIT_L(n) asm volatile("s_waitcnt lgkmcnt(" #n ")" ::: "memory")
#define PG8_BAR __builtin_amdgcn_s_barrier()
#define PG8_SCHED __builtin_amdgcn_sched_barrier(0)
    Unit cur, nxt; int ui = 0;
    if (!S.next(0, cur)) return;
    f32x4 acc[2][2][4][2];
#pragma unroll
    for (int a = 0; a < 2; ++a)
#pragma unroll
        for (int b = 0; b < 2; ++b)
#pragma unroll
            for (int m = 0; m < 4; ++m)
#pragma unroll
                for (int n = 0; n < 2; ++n) acc[a][b][m][n] = (f32x4){0.f, 0.f, 0.f, 0.f};
    bf16x8 At[4][2], B0[2][2], B1[2][2];
    const char* cA = (const char*)g.A + (size_t)cur.pm * tstep; const char* cB = (const char*)g.Bt + (size_t)cur.pn * tstep;
    S.a_ready(cur);
    if constexpr (SP2) {
        PG8_STAGE(PG8_SB(0, 0), cB, voffB); PG8_STAGE(PG8_SB(0, 1), cB + hstep, voffB); PG8_STAGE(PG8_SA(0, 0), cA, voffA); PG8_STAGE(PG8_SA(0, 1), cA + hstep, voffA);
        if (wr == 1) PG8_BAR;
        PG8_WAIT_V(2); PG8_BAR;
        PG8_STAGE(PG8_SB(1, 0), cB + kstep, voffB); PG8_STAGE(PG8_SA(1, 0), cA + kstep, voffA); PG8_STAGE(PG8_SB(1, 1), cB + hstep + kstep, voffB);
        PG8_WAIT_V(6); PG8_BAR;
    } else {
        PG8_STAGE(PG8_SB(0, 0), cB, voffB); PG8_STAGE(PG8_SA(0, 0), cA, voffA); PG8_STAGE(PG8_SB(0, 1), cB + hstep, voffB); PG8_STAGE(PG8_SA(0, 1), cA + hstep, voffA);
        if (wr == 1) PG8_BAR;
        PG8_WAIT_V(4); PG8_BAR;
        PG8_STAGE(PG8_SB(1, 0), cB + kstep, voffB); PG8_STAGE(PG8_SA(1, 0), cA + kstep, voffA); PG8_STAGE(PG8_SB(1, 1), cB + hstep + kstep, voffB);
        PG8_WAIT_V(6); PG8_BAR;
    }
    for (;;) {
        const bool has_next = S.next(ui + 1, nxt);
        const char* nA = has_next ? (const char*)g.A + (size_t)nxt.pm * tstep : cA; const char* nB = has_next ? (const char*)g.Bt + (size_t)nxt.pn * tstep : cB;
        for (int t = 0; t < nt; t += 2) {
            const bool last = (t == nt - 2);
            const char* a1 = cA + (size_t)(t + 1) * kstep;
            const char* a2 = last ? nA : cA + (size_t)(t + 2) * kstep; const char* b2 = last ? nB : cB + (size_t)(t + 2) * kstep;
            const char* a3 = a2 + kstep; const char* b3 = b2 + kstep;
            if (last && has_next) S.a_ready(nxt);
            if constexpr (SP2) {
            PG8_LDB(B0, 0, 0); PG8_LDB(B1, 0, 1); PG8_SCHED; PG8_LDA(At, 0, 0); PG8_STAGE(PG8_SA(1, 1), a1 + hstep, voffA);
            PG8_WAIT_V(8); PG8_WAIT_L(0); PG8_BAR; PG8_MMA(0, 0, At, B0); PG8_MMA(0, 1, At, B1); PG8_BAR; PG8_SCHED;
            PG8_LDA(At, 0, 1); PG8_STAGE(PG8_SB(0, 0), b2, voffB); PG8_STAGE(PG8_SB(0, 1), b2 + hstep, voffB); PG8_STAGE(PG8_SA(0, 0), a2, voffA);
            PG8_WAIT_V(8); PG8_WAIT_L(0); PG8_BAR; PG8_MMA(1, 0, At, B0); PG8_MMA(1, 1, At, B1); PG8_BAR; PG8_SCHED;
            PG8_LDB(B0, 1, 0); PG8_LDB(B1, 1, 1); PG8_SCHED; PG8_LDA(At, 1, 0); PG8_STAGE(PG8_SA(0, 1), a2 + hstep, voffA);
            PG8_WAIT_V(8); PG8_WAIT_L(0); PG8_BAR; PG8_MMA(0, 0, At, B0); PG8_MMA(0, 1, At, B1); PG8_BAR; PG8_SCHED;
            PG8_LDA(At, 1, 1); PG8_STAGE(PG8_SB(1, 0), b3, voffB); PG8_STAGE(PG8_SB(1, 1), b3 + hstep, voffB); PG8_STAGE(PG8_SA(1, 0), a3, voffA);
            PG8_WAIT_V(8); PG8_WAIT_L(0); PG8_BAR; PG8_MMA(1, 0, At, B0); PG8_MMA(1, 1, At, B1); PG8_BAR; PG8_SCHED;
            } else {
            PG8_LDB(B0, 0, 0); PG8_SCHED; PG8_LDA(At, 0, 0); PG8_STAGE(PG8_SA(1, 1), a1 + hstep, voffA);
            PG8_WAIT_L(8); PG8_BAR; PG8_WAIT_L(0); PG8_MMA(0, 0, At, B0); PG8_BAR; PG8_SCHED;
            PG8_LDB(B1, 0, 1); PG8_STAGE(PG8_SB(0, 0), b2, voffB);
            PG8_BAR; PG8_WAIT_L(0); PG8_MMA(0, 1, At, B1); PG8_BAR;
            PG8_LDA(At, 0, 1); PG8_STAGE(PG8_SA(0, 0), a2, voffA);
            PG8_BAR; PG8_WAIT_L(0); PG8_MMA(1, 0, At, B0); PG8_BAR; PG8_SCHED;
            PG8_STAGE(PG8_SB(0, 1), b2 + hstep, voffB);
            PG8_WAIT_V(6); PG8_BAR; PG8_MMA(1, 1, At, B1); PG8_BAR;
            PG8_LDB(B0, 1, 0); PG8_SCHED; PG8_LDA(At, 1, 0); PG8_STAGE(PG8_SA(0, 1), a2 + hstep, voffA);
            PG8_WAIT_L(8); PG8_BAR; PG8_WAIT_L(0); PG8_MMA(0, 0, At, B0); PG8_BAR; PG8_SCHED;
            PG8_LDB(B1, 1, 1); PG8_STAGE(PG8_SB(1, 0), b3, voffB);
            PG8_BAR; PG8_WAIT_L(0); PG8_MMA(0, 1, At, B1); PG8_BAR;
            PG8_LDA(At, 1, 1); PG8_STAGE(PG8_SA(1, 0), a3, voffA);
            PG8_BAR; PG8_WAIT_L(0); PG8_MMA(1, 0, At, B0); PG8_BAR; PG8_SCHED;
            PG8_STAGE(PG8_SB(1, 1), b3 + hstep, voffB);
            PG8_WAIT_V(6); PG8_BAR; PG8_MMA(1, 1, At, B1); PG8_BAR;
            }
        }
        if constexpr (ALIGN_EPI) { if (wr == 0) PG8_BAR; }
        if constexpr (!Epi::AFTER_DRAIN) { E(acc, cur, wr, wc, fr, fq); S.done(cur); }
        if (!has_next) break;
#pragma unroll
        for (int a = 0; a < 2; ++a)
#pragma unroll
            for (int b = 0; b < 2; ++b)
#pragma unroll
                for (int m = 0; m < 4; ++m)
#pragma unroll
                    for (int n = 0; n < 2; ++n) acc[a][b][m][n] = (f32x4){0.f, 0.f, 0.f, 0.f};
        cur = nxt; cA = nA; cB = nB; ++ui;
        if constexpr (ALIGN_EPI) { if (wr == 1) PG8_BAR; }
    }
    PG8_WAIT_V(0);
    if constexpr (!ALIGN_EPI) { if (wr == 0) PG8_BAR; }
    PG8_BAR;
    if constexpr (Epi::AFTER_DRAIN) { E.fused(acc, cur, wr, wc, fr, fq, lds, wid, lane); S.done(cur); }
#undef PG8_SA
#undef PG8_SB
#undef PG8_STAGE
#undef PG8_LDA
#undef PG8_LDB
#undef PG8_MMA
#undef PG8_WAIT_V
#undef PG8_WAIT_L
#undef PG8_BAR
#undef PG8_SCHED
}
}

#define LAS __attribute__((address_space(3)))
#define DI __device__ __forceinline__
using pg8::bf16_t; using pg8::bf16x8; using pg8::f32x4; using pg8::u32x4; using pg8::cvt_pk_bf16;
typedef unsigned u32x2 __attribute__((ext_vector_type(2)));
typedef float f32x2 __attribute__((ext_vector_type(2)));

constexpr int T_TOK = 32768, DM = 2048, NPROJ = 5120, PROJW = 5128;
constexpr int NTHREADS = 512;
constexpr int LDS_BYTES = 147456;
constexpr float EPS = 1e-6f;

constexpr size_t WS_XN = 0;
constexpr size_t WS_P = 134217728;
constexpr size_t WS_X1G = WS_P;
constexpr size_t WS_Q = WS_P + 134217728;
constexpr size_t WS_WINT = WS_P + 335544320;
constexpr size_t WS_WOUTT = WS_WINT + 20971520;
constexpr size_t WS_WQT = WS_WOUTT + 8388608;
constexpr size_t WS_UB = WS_WQT + 4194304;
constexpr size_t WS_VB = WS_UB + 67108864;
constexpr size_t WS_ST = WS_VB + 67108864;
constexpr size_t WS_CPT = WS_ST + 142606336;
constexpr size_t WS_QC = WS_CPT + 71303168;
constexpr size_t WS_KC = WS_QC + 33554432;
constexpr size_t WS_IG = WS_KC + 33554432;
constexpr size_t WS_LF = WS_IG + 524288;
constexpr size_t WS_PSSV = WS_LF + 524288;
constexpr size_t WS_PSS2 = WS_PSSV + 2097152;
constexpr size_t WS_BEND = WS_PSS2 + 4194304;
constexpr size_t WS_GMAX = WS_BEND + 4096;
constexpr size_t WS_MPREV = WS_GMAX + 4096;
constexpr size_t WS_SELID = WS_MPREV + 4096;
constexpr size_t WS_SELG = WS_SELID + 16777216;
constexpr size_t WS_KB1 = WS_SELG + 16777216;
constexpr size_t WS_KB2 = WS_KB1 + 131072;
constexpr size_t WS_BAR = WS_KB2 + 131072;
constexpr size_t WS_END = WS_BAR + 16384;

struct Params {
    const float *x, *norm1_g, *w_in, *gm_vnorm_g, *w_spatial, *b_spatial, *ml_conv_w, *ml_conv_b, *ml_b_i, *ml_b_f, *gm_out_g, *ml_out_g, *w_out, *norm2_g,
        *peer_wq, *peer_k1, *peer_k2, *peer_u, *peer_v, *final_g;
    float* out;
    unsigned char* ws;
};

template <int CB, int H, int W> DI size_t p_off(int t, int h, int d) { return (size_t)T_TOK * CB + ((size_t)((t >> 7) * H + h) * 128 + (t & 127)) * W + d; }
DI float bf2f(unsigned short h) { return __uint_as_float(((unsigned)h) << 16); }
DI float bflo(unsigned w) { return __uint_as_float(w << 16); }
DI float bfhi(unsigned w) { return __uint_as_float(w & 0xffff0000u); }
DI float rcpf_(float x) { return __builtin_amdgcn_rcpf(x); }
DI float sigmoid_(float x) { return rcpf_(1.f + __expf(-x)); }
DI float gelu_t(float x) { const float z = 1.5957691216057308f * (x + 0.044715f * x * x * x); return x * rcpf_(1.f + __expf(-z)); }
DI float wave_sum(float v) {
#pragma unroll
    for (int o = 32; o; o >>= 1) v += __shfl_xor(v, o);
    return v;
}
DI float wave_max(float v) {
#pragma unroll
    for (int o = 32; o; o >>= 1) v = fmaxf(v, __shfl_xor(v, o));
    return v;
}
DI bf16x8 ld_frag_lds(const LAS unsigned char* p) { return *(const LAS bf16x8*)p; }
#define MFMA16(a, b, c) __builtin_amdgcn_mfma_f32_16x16x32_bf16((a), (b), (c), 0, 0, 0)

struct Epi1 {
    static constexpr bool PERM = true, AFTER_DRAIN = false;
    bf16_t* P; float* pssv;
    DI void operator()(const f32x4 (&acc)[2][2][4][2], const pg8::Unit& u, int wr, int wc, int fr, int fq) const {
        const int row0 = u.pm * 256 + wr * 64 + fr, col0 = u.pn * 256 + wc * 32 + 8 * fq;
        const int mode = u.pn < 8 ? 1 : (u.pn >= 16 ? 2 : 0);
        const bool want_ss = (u.pn >= 4 && u.pn < 8);
#pragma unroll
        for (int ai = 0; ai < 2; ++ai)
#pragma unroll
            for (int m = 0; m < 4; ++m) {
                const int row = row0 + ai * 128 + m * 16;
                const int CB = u.pn < 4 ? 0 : (u.pn < 8 ? 1024 : (u.pn < 10 ? 2048 : (u.pn < 12 ? 2560 : (u.pn < 16 ? 3072 : 4096))));
                const int lw = u.pn < 12 ? 7 : 8, H = u.pn < 8 ? 8 : 4;
                float ss = 0.f;
#pragma unroll
                for (int bj = 0; bj < 2; ++bj) {
                    f32x4 v0 = acc[ai][bj][m][0], v1 = acc[ai][bj][m][1];
                    if (mode == 1) {
#pragma unroll
                        for (int j = 0; j < 4; ++j) { v0[j] = gelu_t(v0[j]); v1[j] = gelu_t(v1[j]); ss += v0[j] * v0[j] + v1[j] * v1[j]; }
                    } else if (mode == 2) {
#pragma unroll
                        for (int j = 0; j < 4; ++j) { v0[j] = sigmoid_(v0[j]); v1[j] = sigmoid_(v1[j]); }
                    }
                    u32x4 w; w.x = cvt_pk_bf16(v0[0], v0[1]); w.y = cvt_pk_bf16(v0[2], v0[3]); w.z = cvt_pk_bf16(v1[0], v1[1]); w.w = cvt_pk_bf16(v1[2], v1[3]);
                    {
                        const int cr = col0 + bj * 128 - CB, hh = cr >> lw, d = cr & ((1 << lw) - 1);
                        *(u32x4*)(P + (size_t)T_TOK * CB + (((size_t)((row >> 7) * H + hh) * 128 + (row & 127)) << lw) + d) = w;
                    }
                }
                if (want_ss) {
                    ss += __shfl_xor(ss, 16); ss += __shfl_xor(ss, 32);
                    if (fq == 0) pssv[(size_t)row * 16 + (u.pn - 4) * 4 + wc] = ss;
                }
            }
    }
};

struct Epi2 {
    static constexpr bool PERM = true, AFTER_DRAIN = false;
    const float* x; bf16_t* x1b; float* pss2;
    DI void operator()(const f32x4 (&acc)[2][2][4][2], const pg8::Unit& u, int wr, int wc, int fr, int fq) const {
        const int row0 = u.pm * 256 + wr * 64 + fr, col0 = u.pn * 256 + wc * 32 + 8 * fq;
#pragma unroll
        for (int ai = 0; ai < 2; ++ai)
#pragma unroll
            for (int m = 0; m < 4; ++m) {
                const int row = row0 + ai * 128 + m * 16;
                float ss = 0.f;
#pragma unroll
                for (int bj = 0; bj < 2; ++bj) {
                    const size_t o = (size_t)row * DM + col0 + bj * 128;
                    const f32x4 v0 = acc[ai][bj][m][0] + *(const f32x4*)(x + o), v1 = acc[ai][bj][m][1] + *(const f32x4*)(x + o + 4);
#pragma unroll
                    for (int j = 0; j < 4; ++j) ss += v0[j] * v0[j] + v1[j] * v1[j];
                    u32x4 w; w.x = cvt_pk_bf16(v0[0], v0[1]); w.y = cvt_pk_bf16(v0[2], v0[3]); w.z = cvt_pk_bf16(v1[0], v1[1]); w.w = cvt_pk_bf16(v1[2], v1[3]);
                    *(u32x4*)(x1b + o) = w;
                }
                ss += __shfl_xor(ss, 16); ss += __shfl_xor(ss, 32);
                if (fq == 0) pss2[(size_t)row * 32 + u.pn * 4 + wc] = ss;
            }
    }
};

struct Epi3 {
    static constexpr bool PERM = true, AFTER_DRAIN = false;
    bf16_t* Q; const float* pss2;
    DI void operator()(const f32x4 (&acc)[2][2][4][2], const pg8::Unit& u, int wr, int wc, int fr, int fq) const {
        const int row0 = u.pm * 256 + wr * 64 + fr, col0 = u.pn * 256 + wc * 32 + 8 * fq;
#pragma unroll
        for (int ai = 0; ai < 2; ++ai)
#pragma unroll
            for (int m = 0; m < 4; ++m) {
                const int row = row0 + ai * 128 + m * 16;
                float ss = 0.f;
#pragma unroll
                for (int i = 0; i < 8; ++i) { const f32x4 t = *(const f32x4*)(pss2 + (size_t)row * 32 + i * 4); ss += (t[0] + t[1]) + (t[2] + t[3]); }
                const float rstd = rsqrtf(ss * (1.f / 2048.f) + EPS);
#pragma unroll
                for (int bj = 0; bj < 2; ++bj) {
                    const f32x4 v0 = acc[ai][bj][m][0] * rstd, v1 = acc[ai][bj][m][1] * rstd;
                    u32x4 w; w.x = cvt_pk_bf16(v0[0], v0[1]); w.y = cvt_pk_bf16(v0[2], v0[3]); w.z = cvt_pk_bf16(v1[0], v1[1]); w.w = cvt_pk_bf16(v1[2], v1[3]);
                    *(u32x4*)(Q + (size_t)row * 1024 + col0 + bj * 128) = w;
                }
            }
    }
};

DI void phase0(const Params& p, LAS unsigned char* lds) {
    const int tid = threadIdx.x, lane = tid & 63, wave = tid >> 6;
    bf16_t* XN = (bf16_t*)(p.ws + WS_XN);
    {
        LAS float* scr = (LAS float*)lds + wave * (64 * 65);
        const int gw = blockIdx.x * 8 + wave, nw = gridDim.x * 8;
        for (int it = gw; it < 4096; it += nw) {
            const float* W; bf16_t* WT; int ldw, kt, nt;
            if (it < 2560) { W = p.w_in; WT = (bf16_t*)(p.ws + WS_WINT); ldw = PROJW; kt = it / 80; nt = it % 80; }
            else if (it < 3584) { const int j = it - 2560; W = p.w_out; WT = (bf16_t*)(p.ws + WS_WOUTT); ldw = 2048; kt = j >> 5; nt = j & 31; }
            else { const int j = it - 3584; W = p.peer_wq; WT = (bf16_t*)(p.ws + WS_WQT); ldw = 1024; kt = j >> 4; nt = j & 15; }
            const int k0 = kt * 64, n0 = nt * 64;
#pragma unroll 16
            for (int r = 0; r < 64; ++r) scr[r * 65 + lane] = W[(size_t)(k0 + r) * ldw + n0 + lane] * (it >= 3584 ? p.norm2_g[k0 + r] : 1.f);
            __builtin_amdgcn_fence(__ATOMIC_RELEASE, "wavefront"); __builtin_amdgcn_wave_barrier(); __builtin_amdgcn_fence(__ATOMIC_ACQUIRE, "wavefront");
            const int half = lane >> 5, kk = (lane & 31) * 2;
#pragma unroll 8
            for (int nn = 0; nn < 32; ++nn) {
                const int n = 2 * nn + half; const float a = scr[kk * 65 + n], b = scr[(kk + 1) * 65 + n];
                *(unsigned*)(WT + (size_t)(n0 + n) * 2048 + k0 + kk) = cvt_pk_bf16(a, b);
            }
            __builtin_amdgcn_fence(__ATOMIC_RELEASE, "wavefront"); __builtin_amdgcn_wave_barrier(); __builtin_amdgcn_fence(__ATOMIC_ACQUIRE, "wavefront");
        }
    }
    __syncthreads();
    {
        LAS float* wg = (LAS float*)lds;
        for (int idx = tid; idx < 4096; idx += NTHREADS) {
            const int k = idx >> 1, hf = idx & 1;
            const f32x4 v = *(const f32x4*)(p.w_in + (size_t)k * PROJW + 5120 + hf * 4);
            *(LAS f32x4*)(wg + k * 8 + (k >> 3) * 4 + hf * 4) = v;
        }
        __syncthreads();
        float* IG = (float*)(p.ws + WS_IG); float* LF = (float*)(p.ws + WS_LF);
        for (int row0 = 2 * (blockIdx.x * 8 + wave); row0 < T_TOK; row0 += 2 * gridDim.x * 8) {
            f32x4 xv[2][8];
#pragma unroll
            for (int rr = 0; rr < 2; ++rr) {
                const float* xr = p.x + (size_t)(row0 + rr) * DM;
#pragma unroll
                for (int i = 0; i < 4; ++i) { xv[rr][2 * i] = *(const f32x4*)(xr + i * 512 + lane * 8); xv[rr][2 * i + 1] = *(const f32x4*)(xr + i * 512 + lane * 8 + 4); }
            }
#pragma unroll
            for (int rr = 0; rr < 2; ++rr) {
                const int row = row0 + rr;
                float ss = 0.f;
#pragma unroll
                for (int i = 0; i < 8; ++i) ss += (xv[rr][i][0] * xv[rr][i][0] + xv[rr][i][1] * xv[rr][i][1]) + (xv[rr][i][2] * xv[rr][i][2] + xv[rr][i][3] * xv[rr][i][3]);
                ss = wave_sum(ss);
                const float rstd = rsqrtf(ss * (1.f / 2048.f) + EPS);
                f32x4 ga = {0.f, 0.f, 0.f, 0.f}, gb = {0.f, 0.f, 0.f, 0.f};
#pragma unroll
                for (int i = 0; i < 4; ++i) {
                    const f32x4 g0 = *(const f32x4*)(p.norm1_g + i * 512 + lane * 8), g1 = *(const f32x4*)(p.norm1_g + i * 512 + lane * 8 + 4);
                    const f32x4 h0 = xv[rr][2 * i] * rstd * g0, h1 = xv[rr][2 * i + 1] * rstd * g1;
                    u32x4 w; w.x = cvt_pk_bf16(h0[0], h0[1]); w.y = cvt_pk_bf16(h0[2], h0[3]); w.z = cvt_pk_bf16(h1[0], h1[1]); w.w = cvt_pk_bf16(h1[2], h1[3]);
                    *(u32x4*)(XN + (size_t)row * DM + i * 512 + lane * 8) = w;
                    const LAS float* wb = wg + (i * 512 + lane * 8) * 8 + (i * 64 + lane) * 4;
#pragma unroll
                    for (int e = 0; e < 8; ++e) {
                        const float hv = e < 4 ? h0[e & 3] : h1[e & 3];
                        const f32x4 w0 = *(const LAS f32x4*)(wb + e * 8), w1 = *(const LAS f32x4*)(wb + e * 8 + 4);
                        ga = ga + w0 * hv; gb = gb + w1 * hv;
                    }
                }
                f32x4 m4 = lane < 32 ? ga : gb, s4 = lane < 32 ? gb : ga;
#pragma unroll
                for (int j = 0; j < 4; ++j) m4[j] += __shfl_xor(s4[j], 32);
                const bool up16 = (lane & 16) != 0;
                float m2a = up16 ? m4[2] : m4[0], m2b = up16 ? m4[3] : m4[1];
                const float s2a = up16 ? m4[0] : m4[2], s2b = up16 ? m4[1] : m4[3];
                m2a += __shfl_xor(s2a, 16); m2b += __shfl_xor(s2b, 16);
                const bool up8 = (lane & 8) != 0;
                float m1 = up8 ? m2b : m2a; const float s1 = up8 ? m2a : m2b;
                m1 += __shfl_xor(s1, 8);
                m1 += __shfl_xor(m1, 4); m1 += __shfl_xor(m1, 2); m1 += __shfl_xor(m1, 1);
                const int j = ((lane >> 5) << 2) | (((lane >> 4) & 1) << 1) | ((lane >> 3) & 1);
                if ((lane & 7) == 0) {
                    if (j < 4) IG[(size_t)row * 4 + j] = m1 + p.ml_b_i[j];
                    else { const float z = m1 + p.ml_b_f[j - 4]; LF[(size_t)row * 4 + j - 4] = fminf(z, 0.f) - log1pf(__expf(-fabsf(z))); }
                }
            }
        }
    }
    {
        const size_t nthr = (size_t)gridDim.x * NTHREADS, NQ = (size_t)16384 * 512;
        for (size_t base = (size_t)blockIdx.x * NTHREADS + tid; base < 2 * NQ; base += 16 * nthr) {
            f32x4 v[16];
#pragma unroll
            for (int u = 0; u < 16; ++u) {
                size_t i = base + u * nthr; if (i >= 2 * NQ) i = base;
                const int which = i >= NQ; const size_t j = i - (which ? NQ : 0);
                v[u] = *(const f32x4*)((which ? p.peer_v : p.peer_u) + j * 4);
            }
#pragma unroll
            for (int u = 0; u < 16; ++u) {
                size_t i = base + u * nthr; if (i >= 2 * NQ) i = base;
                const int which = i >= NQ; const size_t j = i - (which ? NQ : 0);
                const int row = (int)(j >> 9), c4 = (int)(j & 511);
                float amax = fmaxf(fmaxf(fabsf(v[u][0]), fabsf(v[u][1])), fmaxf(fabsf(v[u][2]), fabsf(v[u][3])));
                amax = fmaxf(amax, __uint_as_float((unsigned)__builtin_amdgcn_update_dpp(0, (int)__float_as_uint(amax), 0xB1, 0xF, 0xF, true)));
                amax = fmaxf(amax, __uint_as_float((unsigned)__builtin_amdgcn_update_dpp(0, (int)__float_as_uint(amax), 0x4E, 0xF, 0xF, true)));
                amax = fmaxf(amax, __uint_as_float((unsigned)__builtin_amdgcn_update_dpp(0, (int)__float_as_uint(amax), 0x141, 0xF, 0xF, true)));
                amax = fmaxf(amax, __uint_as_float((unsigned)__builtin_amdgcn_update_dpp(0, (int)__float_as_uint(amax), 0x140, 0xF, 0xF, true)));
                const unsigned sb = cvt_pk_bf16(amax * (1.f / 6.f), 0.f) & 0xffffu;
                float sc = bflo(sb); if (sc == 0.f) sc = 1.f;
                const float inv = 1.f / sc;
                unsigned r = 0u;
                r = __builtin_amdgcn_cvt_scalef32_pk_fp4_f32(r, v[u][0] * inv, v[u][1] * inv, 1.0f, 0);
                r = __builtin_amdgcn_cvt_scalef32_pk_fp4_f32(r, v[u][2] * inv, v[u][3] * inv, 1.0f, 1);
                unsigned char* dst = p.ws + (which ? WS_VB : WS_UB) + (size_t)row * 1088;
                *(unsigned short*)(dst + c4 * 2) = (unsigned short)(r & 0xffffu);
                if ((c4 & 15) == 0) *(unsigned short*)(dst + 1024 + (c4 >> 4) * 2) = (unsigned short)(sb == 0u ? 0x3F80u : sb);
            }
        }
    }
    {
        bf16_t* KB1 = (bf16_t*)(p.ws + WS_KB1); bf16_t* KB2 = (bf16_t*)(p.ws + WS_KB2);
        for (int i = blockIdx.x * NTHREADS + tid; i < 65536 / 4; i += gridDim.x * NTHREADS) {
            const f32x4 a = *(const f32x4*)(p.peer_k1 + i * 4), b = *(const f32x4*)(p.peer_k2 + i * 4);
            u32x2 w; w.x = cvt_pk_bf16(a[0], a[1]); w.y = cvt_pk_bf16(a[2], a[3]); *(u32x2*)(KB1 + i * 4) = w;
            w.x = cvt_pk_bf16(b[0], b[1]); w.y = cvt_pk_bf16(b[2], b[3]); *(u32x2*)(KB2 + i * 4) = w;
        }
    }
}

#define WAVE_LDS_SYNC() do { __builtin_amdgcn_fence(__ATOMIC_RELEASE, "wavefront"); __builtin_amdgcn_wave_barrier(); __builtin_amdgcn_fence(__ATOMIC_ACQUIRE, "wavefront"); } while (0)

template <int NG> DI void stage_T_load(const bf16_t* src, int ld, u32x4 (&r0)[NG], u32x4 (&r1)[NG], int wave, int lane) {
#pragma unroll
    for (int i = 0; i < NG; ++i) {
        const int g = wave + 8 * i;
        r0[i] = *(const u32x4*)(src + (size_t)(2 * lane) * ld + g * 8);
        r1[i] = *(const u32x4*)(src + (size_t)(2 * lane + 1) * ld + g * 8);
    }
}
template <int NG> DI void stage_T_store(const u32x4 (&r0)[NG], const u32x4 (&r1)[NG], LAS unsigned char* dst, int wave, int lane) {
#pragma unroll
    for (int i = 0; i < NG; ++i) {
        const int g = wave + 8 * i;
#pragma unroll
        for (int w = 0; w < 4; ++w) {
            const unsigned a = r0[i][w], b = r1[i][w];
            *(LAS unsigned*)(dst + (g * 8 + 2 * w) * 272 + lane * 4) = (a & 0xffffu) | (b << 16);
            *(LAS unsigned*)(dst + (g * 8 + 2 * w + 1) * 272 + lane * 4) = (a >> 16) | (b & 0xffff0000u);
        }
    }
}
template <int NG> DI void stage_T(const bf16_t* src, int ld, LAS unsigned char* dst, int wave, int lane) {
    u32x4 r0[NG], r1[NG];
    stage_T_load<NG>(src, ld, r0, r1, wave, lane);
    stage_T_store<NG>(r0, r1, dst, wave, lane);
}

DI void gmlp_bc(const Params& p, LAS unsigned char* lds, int b, int c) {
    const int tid = threadIdx.x, lane = tid & 63, wave = __builtin_amdgcn_readfirstlane(tid >> 6), fr = lane & 15, fq = lane >> 4;
    const int t0 = b * 8192 + c * 128;
    LAS unsigned char* Wl = lds; LAS unsigned char* GvT = lds + 34816; LAS float* rstdv = (LAS float*)(lds + 69632);
    const bf16_t* P = (const bf16_t*)(p.ws + WS_P); bf16_t* YM = (bf16_t*)(p.ws + WS_XN);
    const float* PSSV = (const float*)(p.ws + WS_PSSV);
    __syncthreads();
    if (tid < 128) {
        float ss = 0.f;
#pragma unroll
        for (int i = 0; i < 4; ++i) { const f32x4 v = *(const f32x4*)(PSSV + (size_t)(t0 + tid) * 16 + i * 4); ss += (v[0] + v[1]) + (v[2] + v[3]); }
        rstdv[tid] = rsqrtf(ss * (1.f / 1024.f) + EPS);
    }
    f32x4 wa[4][2]; u32x4 gr0[2], gr1[2];
#define GMLP_PREFETCH(hh) do { _Pragma("unroll") for (int it = 0; it < 4; ++it) { const int e = (it * NTHREADS + tid) * 8, t = e >> 7, s0 = e & 127; \
            const float* wp = p.w_spatial + ((size_t)((hh) * 128 + t)) * 128 + s0; wa[it][0] = *(const f32x4*)wp; wa[it][1] = *(const f32x4*)(wp + 4); } \
        stage_T_load<2>(P + p_off<1024, 8, 128>(t0, (hh), 0), 128, gr0, gr1, wave, lane); } while (0)
    GMLP_PREFETCH(0);
    for (int h = 0; h < 8; ++h) {
        __syncthreads();
#pragma unroll
        for (int it = 0; it < 4; ++it) {
            const int e = (it * NTHREADS + tid) * 8, t = e >> 7, s0 = e & 127;
            float v[8];
#pragma unroll
            for (int j = 0; j < 8; ++j) { const float a = j < 4 ? wa[it][0][j & 3] : wa[it][1][j & 3]; v[j] = (s0 + j <= t) ? a * rstdv[s0 + j] : 0.f; }
            u32x4 w; w.x = cvt_pk_bf16(v[0], v[1]); w.y = cvt_pk_bf16(v[2], v[3]); w.z = cvt_pk_bf16(v[4], v[5]); w.w = cvt_pk_bf16(v[6], v[7]);
            *(LAS u32x4*)(Wl + t * 272 + s0 * 2) = w;
        }
        stage_T_store<2>(gr0, gr1, GvT, wave, lane);
        __syncthreads();
        if (h + 1 < 8) GMLP_PREFETCH(h + 1);
        f32x4 acc[8];
#pragma unroll
        for (int n = 0; n < 8; ++n) acc[n] = (f32x4){0.f, 0.f, 0.f, 0.f};
        const int kmax = (16 * wave + 15) >> 5;
#pragma unroll
        for (int kk = 0; kk < 4; ++kk) {
            if (kk <= kmax) {
                const bf16x8 bfrag = ld_frag_lds(Wl + (16 * wave + fr) * 272 + (32 * kk + 8 * fq) * 2);
#pragma unroll
                for (int n = 0; n < 8; ++n) { const bf16x8 afrag = ld_frag_lds(GvT + (16 * n + fr) * 272 + (32 * kk + 8 * fq) * 2); acc[n] = MFMA16(afrag, bfrag, acc[n]); }
            }
        }
        const int t = 16 * wave + fr; const size_t grow = (size_t)(t0 + t);
        const float bsp = p.b_spatial[h * 128 + t];
        float ss = 0.f;
#pragma unroll
        for (int n = 0; n < 8; ++n) {
            const int d0 = 16 * n + 4 * fq;
            const u32x2 uw = *(const u32x2*)(P + p_off<0, 8, 128>(t0 + t, h, d0));
            const f32x4 gv = *(const f32x4*)(p.gm_vnorm_g + h * 128 + d0);
            f32x4 y;
            y[0] = bflo(uw.x) * (gv[0] * acc[n][0] + bsp); y[1] = bfhi(uw.x) * (gv[1] * acc[n][1] + bsp);
            y[2] = bflo(uw.y) * (gv[2] * acc[n][2] + bsp); y[3] = bfhi(uw.y) * (gv[3] * acc[n][3] + bsp);
            ss += (y[0] * y[0] + y[1] * y[1]) + (y[2] * y[2] + y[3] * y[3]);
            acc[n] = y;
        }
        ss += __shfl_xor(ss, 16); ss += __shfl_xor(ss, 32);
        const float rstd = rsqrtf(ss * (1.f / 128.f) + EPS);
#pragma unroll
        for (int n = 0; n < 8; ++n) {
            const int d0 = 16 * n + 4 * fq;
            const f32x4 g = *(const f32x4*)(p.gm_out_g + h * 128 + d0);
            const f32x4 o = acc[n] * rstd * g;
            u32x2 w; w.x = cvt_pk_bf16(o[0], o[1]); w.y = cvt_pk_bf16(o[2], o[3]);
            *(u32x2*)(YM + grow * DM + h * 128 + d0) = w;
        }
    }
}

DI void mlstm_local(const Params& p, LAS unsigned char* lds, int b, int c, int h) {
    const int tid = threadIdx.x, lane = tid & 63, wave = __builtin_amdgcn_readfirstlane(tid >> 6), fr = lane & 15, fq = lane >> 4;
    const int bh = b * 4 + h, t0 = b * 8192 + c * 128;
    LAS unsigned char* KT = lds; LAS unsigned char* VT = lds + 34816; LAS float* wsv = (LAS float*)(lds + 108800);
    const bf16_t* P = (const bf16_t*)(p.ws + WS_P);
    bf16_t* QC = (bf16_t*)(p.ws + WS_QC); bf16_t* KC = (bf16_t*)(p.ws + WS_KC);
    const float* IG = (const float*)(p.ws + WS_IG); const float* LF = (const float*)(p.ws + WS_LF);
    LAS float* cwl = (LAS float*)(lds + 109312);
    __syncthreads();
    u32x4 xw[2][5];
#define CONV_LOAD(half) do { _Pragma("unroll") for (int gi = 0; gi < 2; ++gi) { const int g = wave + 8 * (gi + 2 * (half)); const int cgp = (g & 15) * 8; \
        _Pragma("unroll") for (int dj = 0; dj < 5; ++dj) { const int srow = 2 * lane - 3 + dj; xw[gi][dj] = (u32x4){0u, 0u, 0u, 0u}; \
            if (c > 0 || srow >= 0) xw[gi][dj] = *(const u32x4*)(P + ((half) ? p_off<2560, 4, 128>(t0 + srow, h, cgp) : p_off<2048, 4, 128>(t0 + srow, h, cgp))); } } } while (0)
    CONV_LOAD(0);
    for (int idx = tid; idx < 1280; idx += NTHREADS) {
        const int j = idx >> 8, cc = idx & 255, ch = (cc >= 128 ? 512 : 0) + h * 128 + (cc & 127);
        cwl[idx] = j < 4 ? p.ml_conv_w[j * 1024 + ch] : p.ml_conv_b[ch];
    }
    if (wave == 0) {
        const float l0 = LF[(size_t)(t0 + 2 * lane) * 4 + h], l1 = LF[(size_t)(t0 + 2 * lane + 1) * 4 + h];
        const float i0 = IG[(size_t)(t0 + 2 * lane) * 4 + h], i1 = IG[(size_t)(t0 + 2 * lane + 1) * 4 + h];
        float s = l0 + l1;
#pragma unroll
        for (int off = 1; off < 64; off <<= 1) { const float tt = __shfl_up(s, off); if (lane >= off) s += tt; }
        const float b1 = s, b0 = s - l1, bend = __shfl(s, 63);
        const float g0 = bend - b0 + i0, g1 = bend - b1 + i1;
        const float gmax = wave_max(fmaxf(g0, g1));
        wsv[2 * lane] = __expf(g0 - gmax); wsv[2 * lane + 1] = __expf(g1 - gmax);
        if (lane == 0) { ((float*)(p.ws + WS_BEND))[bh * 64 + c] = bend; ((float*)(p.ws + WS_GMAX))[bh * 64 + c] = gmax; }
    }
    __syncthreads();
#pragma unroll
    for (int gi4 = 0; gi4 < 4; ++gi4) {
        const int gi = gi4 & 1;
        if (gi4 == 2) CONV_LOAD(1);
        const int g = wave + 8 * gi4; const bool isk = gi4 >= 2; const int cgp = (g & 15) * 8;
        const int cc0 = (isk ? 128 : 0) + cgp;
        const int s = 2 * lane;
        float y0[8], y1[8];
        {
            const f32x4 cb0 = *(const LAS f32x4*)(cwl + 1024 + cc0), cb1 = *(const LAS f32x4*)(cwl + 1024 + cc0 + 4);
#pragma unroll
            for (int e = 0; e < 8; ++e) { y0[e] = e < 4 ? cb0[e & 3] : cb1[e & 3]; y1[e] = y0[e]; }
#pragma unroll
            for (int j = 0; j < 5; ++j) {
                float xr[8];
#pragma unroll
                for (int q = 0; q < 4; ++q) { xr[2 * q] = bflo(xw[gi][j][q]); xr[2 * q + 1] = bfhi(xw[gi][j][q]); }
                if (j < 4) {
                    const f32x4 w0 = *(const LAS f32x4*)(cwl + j * 256 + cc0), w1 = *(const LAS f32x4*)(cwl + j * 256 + cc0 + 4);
#pragma unroll
                    for (int e = 0; e < 8; ++e) y0[e] += (e < 4 ? w0[e & 3] : w1[e & 3]) * xr[e];
                }
                if (j > 0) {
                    const f32x4 w0 = *(const LAS f32x4*)(cwl + (j - 1) * 256 + cc0), w1 = *(const LAS f32x4*)(cwl + (j - 1) * 256 + cc0 + 4);
#pragma unroll
                    for (int e = 0; e < 8; ++e) y1[e] += (e < 4 ? w0[e & 3] : w1[e & 3]) * xr[e];
                }
            }
        }
        const float sc = isk ? 0.08838834764831845f : 1.f;
#pragma unroll
        for (int e = 0; e < 8; ++e) { y0[e] = y0[e] * sigmoid_(y0[e]) * sc; y1[e] = y1[e] * sigmoid_(y1[e]) * sc; }
        bf16_t* dst = (isk ? KC : QC) + (size_t)(t0 + s) * 512 + h * 128 + cgp;
        u32x4 w; w.x = cvt_pk_bf16(y0[0], y0[1]); w.y = cvt_pk_bf16(y0[2], y0[3]); w.z = cvt_pk_bf16(y0[4], y0[5]); w.w = cvt_pk_bf16(y0[6], y0[7]);
        *(u32x4*)dst = w;
        w.x = cvt_pk_bf16(y1[0], y1[1]); w.y = cvt_pk_bf16(y1[2], y1[3]); w.z = cvt_pk_bf16(y1[4], y1[5]); w.w = cvt_pk_bf16(y1[6], y1[7]);
        *(u32x4*)(dst + 512) = w;
        if (isk) {
            const float w0 = wsv[s], w1 = wsv[s + 1];
#pragma unroll
            for (int e = 0; e < 8; ++e) *(LAS unsigned*)(KT + (cgp + e) * 272 + lane * 4) = cvt_pk_bf16(y0[e] * w0, y1[e] * w1);
        }
    }
    stage_T<4>(P + p_off<3072, 4, 256>(t0, h, 0), 256, VT, wave, lane);
    for (int i = tid; i < 1024; i += NTHREADS) { const int r = i >> 6, w = i & 63; *(LAS unsigned*)(VT + (256 + r) * 272 + w * 4) = 0x3F803F80u; }
    __syncthreads();
    bf16x8 af[4];
#pragma unroll
    for (int kk = 0; kk < 4; ++kk) af[kk] = ld_frag_lds(KT + (16 * wave + fr) * 272 + (32 * kk + 8 * fq) * 2);
    float* ST = (float*)(p.ws + WS_ST) + ((size_t)(bh * 64 + c) * 272) * 128;
#pragma unroll
    for (int n = 0; n < 17; ++n) {
        f32x4 acc = {0.f, 0.f, 0.f, 0.f};
#pragma unroll
        for (int kk = 0; kk < 4; ++kk) { const bf16x8 bfr = ld_frag_lds(VT + (16 * n + fr) * 272 + (32 * kk + 8 * fq) * 2); acc = MFMA16(af[kk], bfr, acc); }
        if (n < 16 || fr == 0) *(f32x4*)(ST + (size_t)(16 * n + fr) * 128 + 16 * wave + 4 * fq) = acc;
    }
}

DI void phase_scan(const Params& p) {
    const float* ST = (const float*)(p.ws + WS_ST); bf16_t* CPT = (bf16_t*)(p.ws + WS_CPT);
    const float* BEND = (const float*)(p.ws + WS_BEND); const float* GMAX = (const float*)(p.ws + WS_GMAX); float* MPREV = (float*)(p.ws + WS_MPREV);
    const int gtid = blockIdx.x * NTHREADS + threadIdx.x, nthr = gridDim.x * NTHREADS;
    constexpr int PER = 8224;
    constexpr size_t CST = 272 * 128;
    for (int item = gtid; item < 16 * PER; item += nthr) {
        const int bh = item / PER, e4 = item - bh * PER;
        const float* src = ST + (size_t)bh * 64 * CST + (size_t)e4 * 4;
        bf16_t* dst = CPT + (size_t)bh * 64 * CST + (size_t)e4 * 4;
        f32x4 st = {0.f, 0.f, 0.f, 0.f}; float m = 0.f;
        for (int c0 = 0; c0 < 64; c0 += 8) {
            f32x4 d[8];
#pragma unroll
            for (int j = 0; j < 8; ++j) d[j] = *(const f32x4*)(src + (size_t)(c0 + j) * CST);
#pragma unroll
            for (int j = 0; j < 8; ++j) {
                const int c = c0 + j;
                const float be = BEND[bh * 64 + c], gm = GMAX[bh * 64 + c];
                const float mn = fmaxf(be + m, gm), a = __expf(be + m - mn), sc = __expf(gm - mn);
                u32x2 w; w.x = cvt_pk_bf16(st[0], st[1]); w.y = cvt_pk_bf16(st[2], st[3]);
                *(u32x2*)(dst + (size_t)c * CST) = w;
                if (e4 == 0) MPREV[bh * 64 + c] = m;
                st = st * a + d[j] * sc; m = mn;
            }
        }
    }
}

DI void mlstm_out(const Params& p, LAS unsigned char* lds, int b, int c, int h) {
    const int tid = threadIdx.x, lane = tid & 63, wave = __builtin_amdgcn_readfirstlane(tid >> 6), fr = lane & 15, fq = lane >> 4;
    const int bh = b * 4 + h, t0 = b * 8192 + c * 128;
    LAS unsigned char* Kl = lds; LAS unsigned char* Sl = lds + 34816; LAS unsigned char* VTe = lds + 69632;
    LAS float* av = (LAS float*)(lds + 143616); LAS float* Mv = (LAS float*)(lds + 144128); LAS float* bv = (LAS float*)(lds + 144640);
    const bf16_t* P = (const bf16_t*)(p.ws + WS_P); bf16_t* YM = (bf16_t*)(p.ws + WS_XN);
    const bf16_t* QC = (const bf16_t*)(p.ws + WS_QC); const bf16_t* KC = (const bf16_t*)(p.ws + WS_KC);
    const float* IG = (const float*)(p.ws + WS_IG); const float* LF = (const float*)(p.ws + WS_LF);
    const float mprev = ((const float*)(p.ws + WS_MPREV))[bh * 64 + c];
    __syncthreads();
    if (wave == 0) {
        const float l0 = LF[(size_t)(t0 + 2 * lane) * 4 + h], l1 = LF[(size_t)(t0 + 2 * lane + 1) * 4 + h];
        const float i0 = IG[(size_t)(t0 + 2 * lane) * 4 + h], i1 = IG[(size_t)(t0 + 2 * lane + 1) * 4 + h];
        float s = l0 + l1;
#pragma unroll
        for (int off = 1; off < 64; off <<= 1) { const float tt = __shfl_up(s, off); if (lane >= off) s += tt; }
        const float b1 = s, b0 = s - l1;
        const float a0 = i0 - b0, a1 = i1 - b1;
        float pm = fmaxf(a0, a1);
#pragma unroll
        for (int off = 1; off < 64; off <<= 1) { const float tt = __shfl_up(pm, off); if (lane >= off) pm = fmaxf(pm, tt); }
        float ex = __shfl_up(pm, 1); if (lane == 0) ex = -3.0e38f;
        Mv[2 * lane] = fmaxf(mprev, fmaxf(ex, a0)); Mv[2 * lane + 1] = fmaxf(mprev, pm);
        av[2 * lane] = a0; av[2 * lane + 1] = a1; bv[2 * lane] = b0; bv[2 * lane + 1] = b1;
    }
#pragma unroll
    for (int it = 0; it < 4; ++it) {
        const int e = (it * NTHREADS + tid) * 8, s = e >> 7, d0 = e & 127;
        *(LAS u32x4*)(Kl + s * 272 + d0 * 2) = *(const u32x4*)(KC + (size_t)(t0 + s) * 512 + h * 128 + d0);
    }
    stage_T<4>(P + p_off<3072, 4, 256>(t0, h, 0), 256, VTe, wave, lane);
    for (int i = tid; i < 1024; i += NTHREADS) { const int r = i >> 6, w = i & 63; *(LAS unsigned*)(VTe + (256 + r) * 272 + w * 4) = 0x3F803F80u; }
    bf16x8 qf[4];
#pragma unroll
    for (int kk = 0; kk < 4; ++kk) qf[kk] = *(const bf16x8*)(QC + (size_t)(t0 + 16 * wave + fr) * 512 + h * 128 + 32 * kk + 8 * fq);
    __syncthreads();
    const int t = 16 * wave + fr; const float Mt = Mv[t];
    const int stmax = wave | 1;
    for (int st = 0; st <= stmax; ++st) {
        f32x4 s4 = {0.f, 0.f, 0.f, 0.f};
#pragma unroll
        for (int kk = 0; kk < 4; ++kk) { const bf16x8 kf = ld_frag_lds(Kl + (16 * st + fr) * 272 + (32 * kk + 8 * fq) * 2); s4 = MFMA16(kf, qf[kk], s4); }
#pragma unroll
        for (int r = 0; r < 4; ++r) { const int s = 16 * st + 4 * fq + r; const float w = (s <= t) ? __expf(av[s] - Mt) : 0.f; s4[r] *= w; }
        u32x2 w; w.x = cvt_pk_bf16(s4[0], s4[1]); w.y = cvt_pk_bf16(s4[2], s4[3]);
        *(LAS u32x2*)(Sl + t * 272 + (16 * st + 4 * fq) * 2) = w;
    }
    __syncthreads();
    const bf16_t* cpt = (const bf16_t*)(p.ws + WS_CPT) + ((size_t)(bh * 64 + c) * 272) * 128;
    f32x4 acc[17];
#pragma unroll
    for (int n = 0; n < 17; ++n) {
        acc[n] = (f32x4){0.f, 0.f, 0.f, 0.f};
#pragma unroll
        for (int kk = 0; kk < 4; ++kk) { const bf16x8 cf = *(const bf16x8*)(cpt + (size_t)(16 * n + fr) * 128 + 32 * kk + 8 * fq); acc[n] = MFMA16(cf, qf[kk], acc[n]); }
    }
    const float ai = __expf(mprev - Mt);
#pragma unroll
    for (int n = 0; n < 17; ++n) acc[n] = acc[n] * ai;
    const int k2max = (16 * wave + 15) >> 5;
#pragma unroll
    for (int kk = 0; kk < 4; ++kk) {
        if (kk <= k2max) {
            const bf16x8 sf = ld_frag_lds(Sl + t * 272 + (32 * kk + 8 * fq) * 2);
#pragma unroll
            for (int n = 0; n < 17; ++n) { const bf16x8 vf = ld_frag_lds(VTe + (16 * n + fr) * 272 + (32 * kk + 8 * fq) * 2); acc[n] = MFMA16(vf, sf, acc[n]); }
        }
    }
    const float den = __shfl(acc[16][0], fr);
    const float mt = bv[t] + Mt;
    const float inv = rcpf_(fmaxf(fabsf(den), __expf(-mt)));
    const size_t grow = (size_t)(t0 + t);
    float ss = 0.f;
#pragma unroll
    for (int n = 0; n < 16; ++n) {
        const int v0 = 16 * n + 4 * fq;
        const u32x2 ow = *(const u32x2*)(P + p_off<4096, 4, 256>(t0 + t, h, v0));
        f32x4 y;
        y[0] = bflo(ow.x) * acc[n][0] * inv; y[1] = bfhi(ow.x) * acc[n][1] * inv; y[2] = bflo(ow.y) * acc[n][2] * inv; y[3] = bfhi(ow.y) * acc[n][3] * inv;
        ss += (y[0] * y[0] + y[1] * y[1]) + (y[2] * y[2] + y[3] * y[3]);
        acc[n] = y;
    }
    ss += __shfl_xor(ss, 16); ss += __shfl_xor(ss, 32);
    const float rstd = rsqrtf(ss * (1.f / 256.f) + EPS);
#pragma unroll
    for (int n = 0; n < 16; ++n) {
        const int v0 = 16 * n + 4 * fq;
        const f32x4 g = *(const f32x4*)(p.ml_out_g + h * 256 + v0);
        const f32x4 o = acc[n] * rstd * g;
        u32x2 w; w.x = cvt_pk_bf16(o[0], o[1]); w.y = cvt_pk_bf16(o[2], o[3]);
        *(u32x2*)(YM + grow * DM + 1024 + h * 256 + v0) = w;
    }
}

DI unsigned ord_key(float f) { const unsigned u = __float_as_uint(f); return (u & 0x80000000u) ? ~u : (u | 0x80000000u); }
DI float key_val(unsigned k) { return (k & 0x80000000u) ? __uint_as_float(k & 0x7fffffffu) : __uint_as_float(~k); }
DI unsigned umax_(unsigned a, unsigned b) { return a > b ? a : b; }
DI unsigned umin_(unsigned a, unsigned b) { return a < b ? a : b; }
#define DPPU(v, ctrl) ((unsigned)__builtin_amdgcn_update_dpp(0, (int)(v), (ctrl), 0xF, 0xF, true))
DI unsigned row_max_u32(unsigned v) {
    v = umax_(v, DPPU(v, 0xB1)); v = umax_(v, DPPU(v, 0x4E)); v = umax_(v, DPPU(v, 0x141)); v = umax_(v, DPPU(v, 0x140)); return v;
}
DI float row_sum_f32(float v) {
    v += __uint_as_float(DPPU(__float_as_uint(v), 0xB1)); v += __uint_as_float(DPPU(__float_as_uint(v), 0x4E));
    v += __uint_as_float(DPPU(__float_as_uint(v), 0x141)); v += __uint_as_float(DPPU(__float_as_uint(v), 0x140)); return v;
}
#define CEX(a, b) do { const unsigned mx_ = umax_(a, b), mn_ = umin_(a, b); a = mx_; b = mn_; } while (0)
template <int N> DI unsigned top16_row(unsigned (&s)[N], int c) {
    unsigned list = 0u;
#pragma unroll 1
    for (int it = 0; it < 16; ++it) {
        const unsigned wm = row_max_u32(s[0]);
        const bool win = (s[0] == wm);
#pragma unroll
        for (int i = 0; i < N - 1; ++i) s[i] = win ? s[i + 1] : s[i];
        s[N - 1] = win ? 0u : s[N - 1];
        list = (c == it) ? wm : list;
    }
    return list;
}

template <int N> DI void top16_row2(unsigned (&s)[N], unsigned (&t)[N], int c, unsigned& l1, unsigned& l2) {
    l1 = 0u; l2 = 0u;
#pragma unroll 1
    for (int it = 0; it < 16; ++it) {
        const unsigned wm1 = row_max_u32(s[0]), wm2 = row_max_u32(t[0]);
        const bool win1 = (s[0] == wm1), win2 = (t[0] == wm2);
#pragma unroll
        for (int i = 0; i < N - 1; ++i) { s[i] = win1 ? s[i + 1] : s[i]; t[i] = win2 ? t[i + 1] : t[i]; }
        s[N - 1] = win1 ? 0u : s[N - 1]; t[N - 1] = win2 ? 0u : t[N - 1];
        l1 = (c == it) ? wm1 : l1; l2 = (c == it) ? wm2 : l2;
    }
}

template <int N> DI void top16_row4(unsigned (&s)[N], unsigned (&t)[N], unsigned (&u)[N], unsigned (&v)[N], int c, unsigned& l1, unsigned& l2, unsigned& l3, unsigned& l4) {
    l1 = 0u; l2 = 0u; l3 = 0u; l4 = 0u;
#pragma unroll 1
    for (int it = 0; it < 16; ++it) {
        const unsigned wm1 = row_max_u32(s[0]), wm2 = row_max_u32(t[0]), wm3 = row_max_u32(u[0]), wm4 = row_max_u32(v[0]);
        const bool win1 = (s[0] == wm1), win2 = (t[0] == wm2), win3 = (u[0] == wm3), win4 = (v[0] == wm4);
#pragma unroll
        for (int i = 0; i < N - 1; ++i) { s[i] = win1 ? s[i + 1] : s[i]; t[i] = win2 ? t[i + 1] : t[i]; u[i] = win3 ? u[i + 1] : u[i]; v[i] = win4 ? v[i + 1] : v[i]; }
        s[N - 1] = win1 ? 0u : s[N - 1]; t[N - 1] = win2 ? 0u : t[N - 1]; u[N - 1] = win3 ? 0u : u[N - 1]; v[N - 1] = win4 ? 0u : v[N - 1];
        l1 = (c == it) ? wm1 : l1; l2 = (c == it) ? wm2 : l2; l3 = (c == it) ? wm3 : l3; l4 = (c == it) ? wm4 : l4;
    }
}
#define SORT8(s) do { CEX(s[0], s[1]); CEX(s[2], s[3]); CEX(s[4], s[5]); CEX(s[6], s[7]); CEX(s[0], s[2]); CEX(s[1], s[3]); CEX(s[4], s[6]); CEX(s[5], s[7]); CEX(s[1], s[2]); CEX(s[5], s[6]); \
    CEX(s[0], s[4]); CEX(s[1], s[5]); CEX(s[2], s[6]); CEX(s[3], s[7]); CEX(s[2], s[4]); CEX(s[3], s[5]); CEX(s[1], s[2]); CEX(s[3], s[4]); CEX(s[5], s[6]); } while (0)
#define SORT4(s) do { CEX(s[0], s[1]); CEX(s[2], s[3]); CEX(s[0], s[2]); CEX(s[1], s[3]); CEX(s[1], s[2]); } while (0)

DI void peer_select(const Params& p) {
    const int tid = threadIdx.x, lane = tid & 63, wave = __builtin_amdgcn_readfirstlane(tid >> 6), c = lane & 15, g = lane >> 4, rowbase = lane & 48;
    const bf16_t* Q = (const bf16_t*)(p.ws + WS_Q); const bf16_t* KB1 = (const bf16_t*)(p.ws + WS_KB1); const bf16_t* KB2 = (const bf16_t*)(p.ws + WS_KB2);
    int* SELID = (int*)(p.ws + WS_SELID); float* SELG = (float*)(p.ws + WS_SELG);
    unsigned pk = 0u, validmask = 0u;
#pragma unroll
    for (int q = 0; q < 4; ++q) {
        const int target = 4 * c + q; int ci = 0, cj = 0, cnt = 0; bool v = false;
#pragma unroll
        for (int i = 0; i < 16; ++i) { const int nj = 16 / (i + 1); if (target >= cnt && target < cnt + nj) { ci = i; cj = target - cnt; v = true; } cnt += nj; }
        pk |= (unsigned)((ci << 4) | cj) << (8 * q); validmask |= (v ? 1u : 0u) << q;
    }
    for (int tile = blockIdx.x * 8 + wave; tile < T_TOK / 16; tile += gridDim.x * 8) {
        const int tok0 = tile * 16;
        for (int h = 0; h < 8; ++h) {
            bf16x8 a1[2], a2[2];
            {
                const bf16_t* qp = Q + (size_t)(tok0 + c) * 1024 + h * 128 + g * 8;
                a1[0] = *(const bf16x8*)qp; a1[1] = *(const bf16x8*)(qp + 32); a2[0] = *(const bf16x8*)(qp + 64); a2[1] = *(const bf16x8*)(qp + 96);
            }
            f32x4 acc1[8], acc2[8];
#pragma unroll
            for (int nt = 0; nt < 8; ++nt) {
                const size_t ko = ((size_t)(h * 128 + nt * 16 + c)) * 64 + g * 8;
                acc1[nt] = (f32x4){0.f, 0.f, 0.f, 0.f}; acc2[nt] = (f32x4){0.f, 0.f, 0.f, 0.f};
                acc1[nt] = MFMA16(a1[0], *(const bf16x8*)(KB1 + ko), acc1[nt]); acc1[nt] = MFMA16(a1[1], *(const bf16x8*)(KB1 + ko + 32), acc1[nt]);
                acc2[nt] = MFMA16(a2[0], *(const bf16x8*)(KB2 + ko), acc2[nt]); acc2[nt] = MFMA16(a2[1], *(const bf16x8*)(KB2 + ko + 32), acc2[nt]);
            }
#pragma unroll
            for (int rp = 0; rp < 2; ++rp) {
                const int r0 = 2 * rp, r1 = 2 * rp + 1;
                unsigned sA[8], sB[8], sC[8], sD[8];
#pragma unroll
                for (int nt = 0; nt < 8; ++nt) {
                    const unsigned ix = (unsigned)(127 - (nt * 16 + c));
                    sA[nt] = (ord_key(acc1[nt][r0]) & ~0x7Fu) | ix; sB[nt] = (ord_key(acc2[nt][r0]) & ~0x7Fu) | ix;
                    sC[nt] = (ord_key(acc1[nt][r1]) & ~0x7Fu) | ix; sD[nt] = (ord_key(acc2[nt][r1]) & ~0x7Fu) | ix;
                }
                SORT8(sA); SORT8(sB); SORT8(sC); SORT8(sD);
                unsigned lA, lB, lC, lD;
                top16_row4<8>(sA, sB, sC, sD, c, lA, lB, lC, lD);
                unsigned c0[4], c1[4];
#pragma unroll
                for (int q = 0; q < 4; ++q) {
                    const int ci = (int)((pk >> (8 * q + 4)) & 15u), cj = (int)((pk >> (8 * q)) & 15u);
                    const unsigned ka = (unsigned)__shfl((int)lA, rowbase + ci), kb = (unsigned)__shfl((int)lB, rowbase + cj);
                    const unsigned kc = (unsigned)__shfl((int)lC, rowbase + ci), kd = (unsigned)__shfl((int)lD, rowbase + cj);
                    const float cand0 = key_val(ka & ~0x7Fu) + key_val(kb & ~0x7Fu), cand1 = key_val(kc & ~0x7Fu) + key_val(kd & ~0x7Fu);
                    const bool ok = ((validmask >> q) & 1u) != 0u; const unsigned ix = (unsigned)(63 - (4 * c + q));
                    c0[q] = ok ? ((ord_key(cand0) & ~0x3Fu) | ix) : 0u; c1[q] = ok ? ((ord_key(cand1) & ~0x3Fu) | ix) : 0u;
                }
                SORT4(c0); SORT4(c1);
                unsigned sel0, sel1;
                top16_row2<4>(c0, c1, c, sel0, sel1);
#pragma unroll
                for (int u = 0; u < 2; ++u) {
                    const unsigned sel = u ? sel1 : sel0, list1 = u ? lC : lA, list2 = u ? lD : lB; const int r = u ? r1 : r0;
                    const int slot = 63 - (int)(sel & 63u);
                    const unsigned pkv = (unsigned)__shfl((int)pk, rowbase + (slot >> 2));
                    const int cij = (int)((pkv >> (8 * (slot & 3))) & 0xFFu);
                    const unsigned e1 = (unsigned)__shfl((int)list1, rowbase + (cij >> 4)), e2 = (unsigned)__shfl((int)list2, rowbase + (cij & 15));
                    const int eid = (127 - (int)(e1 & 127u)) * 128 + (127 - (int)(e2 & 127u));
                    const float sv = key_val(sel & ~0x3Fu), mx = key_val(row_max_u32(sel) & ~0x3Fu);
                    const float ev = __expf(sv - mx);
                    const float sum = row_sum_f32(ev);
                    const size_t o = (size_t)(tok0 + 4 * g + r) * 128 + h * 16 + c;
                    SELID[o] = eid; SELG[o] = ev * rcpf_(sum);
                }
            }
        }
    }
}

DI f32x2 pkfma(f32x2 a, f32x2 b, f32x2 c) { return __builtin_elementwise_fma(a, b, c); }
DI void peer_gather(const Params& p, LAS unsigned char* lds) {
    const int tid = threadIdx.x, lane = tid & 63, wave = __builtin_amdgcn_readfirstlane(tid >> 6);
    LAS float* scr = (LAS float*)lds + wave * (16 * 68);
    LAS float* cfl = (LAS float*)(lds + 8 * 16 * 68 * 4) + wave * 128;
    const unsigned char* Ub = p.ws + WS_UB; const unsigned char* Vb = p.ws + WS_VB;
    const float* PSS2 = (const float*)(p.ws + WS_PSS2);
    const int* SELID = (const int*)(p.ws + WS_SELID); const float* SELG = (const float*)(p.ws + WS_SELG);
    const int gw = blockIdx.x * 8 + wave, nw = gridDim.x * 8;
    for (int t = gw; t < T_TOK; t += nw) {
        const int idA = SELID[(size_t)t * 128 + lane], idB = SELID[(size_t)t * 128 + 64 + lane];
        const float gA = SELG[(size_t)t * 128 + lane], gB = SELG[(size_t)t * 128 + 64 + lane];
        const bf16_t* xrow = (const bf16_t*)(p.ws + WS_X1G) + (size_t)t * DM + lane * 32;
        float* orow = p.out + (size_t)t * DM + lane * 32;
        const float pv = lane < 32 ? PSS2[(size_t)t * 32 + lane] : 0.f;
        const float rstd2 = rsqrtf(wave_sum(pv) * (1.f / 2048.f) + EPS);
        f32x2 h2[16];
#pragma unroll
        for (int q = 0; q < 4; ++q) {
            const u32x4 xw = *(const u32x4*)(xrow + q * 8);
            const f32x4 g0 = *(const f32x4*)(p.norm2_g + lane * 32 + q * 8), g1 = *(const f32x4*)(p.norm2_g + lane * 32 + q * 8 + 4);
            h2[4 * q] = (f32x2){bflo(xw.x) * rstd2 * g0[0], bfhi(xw.x) * rstd2 * g0[1]};
            h2[4 * q + 1] = (f32x2){bflo(xw.y) * rstd2 * g0[2], bfhi(xw.y) * rstd2 * g0[3]};
            h2[4 * q + 2] = (f32x2){bflo(xw.z) * rstd2 * g1[0], bfhi(xw.z) * rstd2 * g1[1]};
            h2[4 * q + 3] = (f32x2){bflo(xw.w) * rstd2 * g1[2], bfhi(xw.w) * rstd2 * g1[3]};
        }
        constexpr int NPK = 8;
        u32x4 buf[2][NPK]; unsigned short bsc[2][NPK];
#define PEER_LOAD(TB, st, base) do { const int idv_ = ((base) < 64) ? idA : idB; _Pragma("unroll") for (int e_ = 0; e_ < NPK; ++e_) { \
            const int id_ = __builtin_amdgcn_readlane(idv_, ((base) + e_) & 63); const unsigned char* r_ = (TB) + (size_t)id_ * 1088; \
            buf[st][e_] = *(const u32x4*)(r_ + lane * 16); bsc[st][e_] = *(const unsigned short*)(r_ + 1024 + (lane >> 1) * 2); } } while (0)
#define PEER_DOT(st, slot0) do { _Pragma("unroll") for (int e_ = 0; e_ < NPK; ++e_) { f32x2 a2_ = {0.f, 0.f}; \
            _Pragma("unroll") for (int d_ = 0; d_ < 4; ++d_) { const unsigned w_ = buf[st][e_][d_]; \
                a2_ = pkfma(h2[d_ * 4 + 0], __builtin_amdgcn_cvt_scalef32_pk_f32_fp4(w_, 1.0f, 0), a2_); a2_ = pkfma(h2[d_ * 4 + 1], __builtin_amdgcn_cvt_scalef32_pk_f32_fp4(w_, 1.0f, 1), a2_); \
                a2_ = pkfma(h2[d_ * 4 + 2], __builtin_amdgcn_cvt_scalef32_pk_f32_fp4(w_, 1.0f, 2), a2_); a2_ = pkfma(h2[d_ * 4 + 3], __builtin_amdgcn_cvt_scalef32_pk_f32_fp4(w_, 1.0f, 3), a2_); } \
            scr[((slot0) + e_) * 68 + lane] = (a2_[0] + a2_[1]) * bf2f(bsc[st][e_]); } } while (0)
        PEER_LOAD(Ub, 0, 0);
        for (int b = 0; b < 128 / NPK; b += 2) {
            PEER_LOAD(Ub, 1, (b + 1) * NPK);
            PEER_DOT(0, (b * NPK) & 15);
            if (b + 2 < 128 / NPK) PEER_LOAD(Ub, 0, (b + 2) * NPK);
            PEER_DOT(1, ((b + 1) * NPK) & 15);
            if ((((b + 2) * NPK) & 15) == 0) {
                WAVE_LDS_SYNC();
                float sum = 0.f;
#pragma unroll
                for (int i = 0; i < 4; ++i) { const f32x4 r = *(const LAS f32x4*)(scr + (lane >> 2) * 68 + (lane & 3) * 16 + 4 * i); sum += (r[0] + r[1]) + (r[2] + r[3]); }
                sum += __shfl_xor(sum, 1); sum += __shfl_xor(sum, 2);
                const int k0 = (b + 2) * NPK - 16;
                const int k = k0 + (lane >> 2);
                const float gate = __shfl((k0 < 64) ? gA : gB, k & 63);
                if ((lane & 3) == 0) cfl[k] = gate * gelu_t(sum);
                WAVE_LDS_SYNC();
            }
        }
        f32x2 acc[16];
#pragma unroll
        for (int i = 0; i < 16; ++i) acc[i] = (f32x2){0.f, 0.f};
#define PEER_AXPY(st, base) do { _Pragma("unroll") for (int e_ = 0; e_ < NPK; ++e_) { const float c_ = cfl[(base) + e_] * bf2f(bsc[st][e_]); const f32x2 c2_ = {c_, c_}; \
            _Pragma("unroll") for (int d_ = 0; d_ < 4; ++d_) { const unsigned w_ = buf[st][e_][d_]; \
                acc[d_ * 4 + 0] = pkfma(c2_, __builtin_amdgcn_cvt_scalef32_pk_f32_fp4(w_, 1.0f, 0), acc[d_ * 4 + 0]); acc[d_ * 4 + 1] = pkfma(c2_, __builtin_amdgcn_cvt_scalef32_pk_f32_fp4(w_, 1.0f, 1), acc[d_ * 4 + 1]); \
                acc[d_ * 4 + 2] = pkfma(c2_, __builtin_amdgcn_cvt_scalef32_pk_f32_fp4(w_, 1.0f, 2), acc[d_ * 4 + 2]); acc[d_ * 4 + 3] = pkfma(c2_, __builtin_amdgcn_cvt_scalef32_pk_f32_fp4(w_, 1.0f, 3), acc[d_ * 4 + 3]); } } } while (0)
        PEER_LOAD(Vb, 0, 0);
        for (int b = 0; b < 128 / NPK; b += 2) {
            PEER_LOAD(Vb, 1, (b + 1) * NPK);
            PEER_AXPY(0, b * NPK);
            if (b + 2 < 128 / NPK) PEER_LOAD(Vb, 0, (b + 2) * NPK);
            PEER_AXPY(1, (b + 1) * NPK);
        }
        float ss = 0.f;
#pragma unroll
        for (int q = 0; q < 4; ++q) {
            const u32x4 xw = *(const u32x4*)(xrow + q * 8);
            acc[4 * q] += (f32x2){bflo(xw.x), bfhi(xw.x)}; acc[4 * q + 1] += (f32x2){bflo(xw.y), bfhi(xw.y)};
            acc[4 * q + 2] += (f32x2){bflo(xw.z), bfhi(xw.z)}; acc[4 * q + 3] += (f32x2){bflo(xw.w), bfhi(xw.w)};
#pragma unroll
            for (int i = 0; i < 4; ++i) { const f32x2 a = acc[4 * q + i]; ss += a[0] * a[0] + a[1] * a[1]; }
        }
        const float rstd = rsqrtf(wave_sum(ss) * (1.f / 2048.f) + EPS);
#pragma unroll
        for (int q = 0; q < 8; ++q) {
            const f32x4 g0 = *(const f32x4*)(p.final_g + lane * 32 + q * 4);
            const f32x2 a = acc[2 * q], b = acc[2 * q + 1];
            const f32x4 o0 = {a[0] * rstd * g0[0], a[1] * rstd * g0[1], b[0] * rstd * g0[2], b[1] * rstd * g0[3]};
            *(f32x4*)(orow + q * 4) = o0;
        }
        WAVE_LDS_SYNC();
    }
}

#define XB_TMO      128
#define XB_XCNT(j)  (256  + 64 * (j))
#define XB_XSUB(j)  (1280 + 64 * (j))
#define XB_XGEN(j)  (2304 + 64 * (j))
#define XB_TOP      3328
#define XB_TOPGEN   3392
#define XCD_BAR_WORDS 3456
#define XB_SPIN_CAP (1u << 18)

__device__ __forceinline__ unsigned xb_ld(unsigned* p)              { return __hip_atomic_load(p, __ATOMIC_RELAXED, __HIP_MEMORY_SCOPE_AGENT); }
__device__ __forceinline__ unsigned xb_add(unsigned* p, unsigned v) { return __hip_atomic_fetch_add(p, v, __ATOMIC_RELAXED, __HIP_MEMORY_SCOPE_AGENT); }
__device__ __forceinline__ unsigned xb_xcc_id() { return (unsigned)__builtin_amdgcn_s_getreg((3 << 11) | 20) & 0xFu; }
#define XB_SPIN(cond, bar) do { unsigned _sp = 0; while (cond) { __builtin_amdgcn_s_sleep(1); \
    if ((++_sp & 255u) == 0u) { if (xb_ld(&(bar)[XB_TMO])) break; if (_sp > XB_SPIN_CAP) { atomicAdd(&(bar)[XB_TMO], 1u); break; } } } } while (0)

struct XcdBarrier {
    unsigned* bar; unsigned x;
    volatile LAS unsigned* st;
};

__device__ __forceinline__ XcdBarrier xcd_barrier_post(unsigned* bar, volatile LAS unsigned* st) {
    XcdBarrier b; b.bar = bar; b.x = xb_xcc_id(); b.st = st;
    if (threadIdx.x == 0) (void)xb_add(&bar[XB_XCNT(b.x)], 1u);
    return b;
}
__device__ __forceinline__ void xcd_barrier_complete(unsigned* bar, unsigned x, unsigned& nloc, unsigned& nx) {
    const unsigned G = gridDim.x * gridDim.y * gridDim.z;
    unsigned sum, cnt, mine, sp = 0u;
    for (;;) {
        sum = 0u; cnt = 0u; mine = 0u;
#pragma unroll
        for (unsigned j = 0; j < 16; ++j) { const unsigned c = xb_ld(&bar[XB_XCNT(j)]); sum += c; cnt += (c > 0u) ? 1u : 0u; mine = (j == x) ? c : mine; }
        if (sum == G) break;
        __builtin_amdgcn_s_sleep(1);
        if ((++sp & 255u) == 0u) { if (xb_ld(&bar[XB_TMO])) break; if (sp > XB_SPIN_CAP) { atomicAdd(&bar[XB_TMO], 1u); break; } }
    }
    nloc = mine > 0u ? mine : 1u; nx = cnt > 0u ? cnt : 1u;
}

__device__ __forceinline__ void xcd_barrier(const XcdBarrier& b) {
    asm volatile("s_waitcnt vmcnt(0)" ::: "memory");
    __syncthreads();
    if (threadIdx.x == 0) {
        unsigned* bar = b.bar;
        __builtin_amdgcn_s_waitcnt(0);
        unsigned nloc = b.st[0], nx = b.st[1];
        if (nloc == 0u) { xcd_barrier_complete(bar, b.x, nloc, nx); b.st[0] = nloc; b.st[1] = nx; }
        const unsigned old = xb_add(&bar[XB_XSUB(b.x)], 1u);
        const unsigned gen = old / nloc;
        if (old + 1u == (gen + 1u) * nloc) {
            __builtin_amdgcn_fence(__ATOMIC_RELEASE, "agent");
            asm volatile("s_waitcnt vmcnt(0)" ::: "memory");
            const unsigned og = xb_add(&bar[XB_TOP], 1u);
            const unsigned tg = og / nx;
            if (og + 1u == (tg + 1u) * nx) xb_add(&bar[XB_TOPGEN], 1u);
            else XB_SPIN(xb_ld(&bar[XB_TOPGEN]) == tg, bar);
            __builtin_amdgcn_fence(__ATOMIC_ACQUIRE, "agent");
            xb_add(&bar[XB_XGEN(b.x)], 1u);
            asm volatile("s_waitcnt vmcnt(0)" ::: "memory");
        } else {
            XB_SPIN(xb_ld(&bar[XB_XGEN(b.x)]) == gen, bar);
            __builtin_amdgcn_fence(__ATOMIC_ACQUIRE, "agent");
            asm volatile("s_waitcnt vmcnt(0)" ::: "memory");
        }
    }
    __syncthreads();
}

#ifndef PROBE_DUP
#define PROBE_DUP 0
#endif
#define REP(bit) for (int rep_ = 0; rep_ < (((PROBE_DUP) >> (bit)) & 1) + 1; ++rep_)
#define PH1() { pg8::Gemm g{(const bf16_t*)(p.ws + WS_XN), (const bf16_t*)(p.ws + WS_WINT), T_TOK, NPROJ, DM}; pg8::StaticOrder S; S.init(T_TOK, NPROJ, G, bx); Epi1 E{(bf16_t*)(p.ws + WS_P), (float*)(p.ws + WS_PSSV)}; pg8::gemm_phase<Epi1, pg8::StaticOrder, true, true>(lds, g, S, E); xcd_barrier(xbar); }
#define PH3() { pg8::Gemm g{(const bf16_t*)(p.ws + WS_XN), (const bf16_t*)(p.ws + WS_WOUTT), T_TOK, DM, DM}; pg8::StaticOrder S; S.init(T_TOK, DM, G, bx); Epi2 E{p.x, (bf16_t*)(p.ws + WS_X1G), (float*)(p.ws + WS_PSS2)}; pg8::gemm_phase<Epi2, pg8::StaticOrder, true, true>(lds, g, S, E); xcd_barrier(xbar); }
#define PH4() { pg8::Gemm g{(const bf16_t*)(p.ws + WS_X1G), (const bf16_t*)(p.ws + WS_WQT), T_TOK, 1024, DM}; pg8::StaticOrder S; S.init(T_TOK, 1024, G, bx); Epi3 E{(bf16_t*)(p.ws + WS_Q), (const float*)(p.ws + WS_PSS2)}; pg8::gemm_phase<Epi3, pg8::StaticOrder, true, true>(lds, g, S, E); xcd_barrier(xbar); }
__global__ void __launch_bounds__(NTHREADS, 2) hymba_fwd(Params p) {
    extern __shared__ __attribute__((aligned(16))) unsigned char smem[];
    LAS unsigned char* lds = (LAS unsigned char*)smem;
    cg::grid_group grid = cg::this_grid();
    const int G = gridDim.x, bx = blockIdx.x;
    unsigned* barw = (unsigned*)(p.ws + WS_BAR);
    volatile LAS unsigned* xst = (volatile LAS unsigned*)(lds + LDS_BYTES - 16);
    if (threadIdx.x < 4) xst[threadIdx.x] = 0u;
    if (bx == 0) { for (int i = threadIdx.x; i < XCD_BAR_WORDS; i += NTHREADS) barw[i] = 0u; }
    __syncthreads();
    REP(0) { phase0(p, lds); grid.sync(); }
    const XcdBarrier xbar = xcd_barrier_post(barw, xst);
    PH1()
#if (PROBE_DUP >> 1) & 1
    PH1()
#endif
    REP(2) {
        for (int si = bx; si < 256; si += G) {
            const int b = si >> 6, c = si & 63;
            gmlp_bc(p, lds, b, c);
            for (int h = 0; h < 4; ++h) mlstm_local(p, lds, b, c, h);
        }
        xcd_barrier(xbar);
    }
    REP(3) { phase_scan(p); xcd_barrier(xbar); }
    REP(4) { for (int it = bx; it < 1024; it += G) mlstm_out(p, lds, it >> 8, (it >> 2) & 63, it & 3); xcd_barrier(xbar); }
    PH3()
#if (PROBE_DUP >> 5) & 1
    PH3()
#endif
    PH4()
#if (PROBE_DUP >> 6) & 1
    PH4()
#endif
    REP(7) { peer_select(p); xcd_barrier(xbar); }
    peer_gather(p, lds);
}

extern "C" void kernel_launch(void* const* d_in, const int* in_sizes, int n_in, void* d_out, int out_size, void* d_ws, size_t ws_size, hipStream_t stream) {
    static int grid_blocks = 0;
    if (grid_blocks == 0) {
        if (n_in != 20 || ws_size < WS_END) { fprintf(stderr, "kernel_launch: unexpected n_in %d or ws_size %zu (need %zu)\n", n_in, ws_size, (size_t)WS_END); grid_blocks = -1; return; }
        int dev = 0, cus = 0, per_cu = 0;
        hipGetDevice(&dev);
        hipDeviceGetAttribute(&cus, hipDeviceAttributeMultiprocessorCount, dev);
        hipFuncSetAttribute((const void*)hymba_fwd, hipFuncAttributeMaxDynamicSharedMemorySize, LDS_BYTES);
        hipOccupancyMaxActiveBlocksPerMultiprocessor(&per_cu, (const void*)hymba_fwd, NTHREADS, LDS_BYTES);
        if (per_cu < 1) { fprintf(stderr, "kernel_launch: occupancy query says %d blocks per CU\n", per_cu); per_cu = 1; }
        if (per_cu > 1) per_cu = 1;
        grid_blocks = cus * per_cu;
        (void)hipGetLastError();
    }
    if (grid_blocks < 0) return;
    Params p{};
    p.x = (const float*)d_in[0]; p.norm1_g = (const float*)d_in[1]; p.w_in = (const float*)d_in[2]; p.gm_vnorm_g = (const float*)d_in[3];
    p.w_spatial = (const float*)d_in[4]; p.b_spatial = (const float*)d_in[5]; p.ml_conv_w = (const float*)d_in[6]; p.ml_conv_b = (const float*)d_in[7];
    p.ml_b_i = (const float*)d_in[8]; p.ml_b_f = (const float*)d_in[9]; p.gm_out_g = (const float*)d_in[10]; p.ml_out_g = (const float*)d_in[11];
    p.w_out = (const float*)d_in[12]; p.norm2_g = (const float*)d_in[13]; p.peer_wq = (const float*)d_in[14]; p.peer_k1 = (const float*)d_in[15];
    p.peer_k2 = (const float*)d_in[16]; p.peer_u = (const float*)d_in[17]; p.peer_v = (const float*)d_in[18]; p.final_g = (const float*)d_in[19];
    p.out = (float*)d_out; p.ws = (unsigned char*)d_ws;
    void* args[] = {&p};
    hipError_t e = hipLaunchCooperativeKernel((const void*)hymba_fwd, dim3(grid_blocks), dim3(NTHREADS), args, LDS_BYTES, stream);
    if (e != hipSuccess) fprintf(stderr, "cooperative launch failed: %s (grid %d)\n", hipGetErrorString(e), grid_blocks);
}
```

```cpp
#include <hip/hip_runtime.h>
#include <hip/hip_cooperative_groups.h>
#include <cstdio>
#include <cstdint>
namespace cg = cooperative_groups;
namespace pg8 {
#define PG8_LAS __attribute__((address_space(3)))
typedef unsigned short bf16_t;
typedef short bf16x8 __attribute__((ext_vector_type(8)));
typedef float f32x4 __attribute__((ext_vector_type(4)));
typedef unsigned u32x4 __attribute__((ext_vector_type(4)));
constexpr int BM = 256, BK = 64, HALF = 128, HTB = HALF * BK * 2  , STAGE_BYTES = 8 * HTB, NXCD = 8, WGM = 8;

__host__ __device__ __forceinline__ int lds_byte(int r, int c) { const int st = (r >> 4) * 2 + (c >> 5), rr = r & 15, cc = c & 31, ob = rr * 64 + cc * 2; return st * 1024 + (ob ^ (((ob >> 9) & 1) << 5)); }
__host__ __device__ __forceinline__ void stage_rc(int b, int& R, int& C) { const int st = b / 1024, sb = b % 1024, swz = sb ^ (((sb >> 9) & 1) << 5); R = (st >> 1) * 16 + swz / 64; C = (st & 1) * 32 + (swz % 64) / 2; }
__host__ __device__ __forceinline__ int perm32(int rho) { const int n = rho >> 4, i = rho & 15; return 8 * (i >> 2) + 4 * n + (i & 3); }

struct Unit { int pm, pn; };
struct Gemm { const bf16_t* A; const bf16_t* Bt; int M, N, K; };

struct StaticOrder {
    int nM, nN, nwg, G, c;
    __host__ __device__ void init(int M, int N, int G_, int c_) { nM = M / BM; nN = N / BM; nwg = nM * nN; G = G_; c = c_; }
    __host__ __device__ bool next(int i, Unit& u) const {
        const long L = (long)i * G + c; if (L >= nwg) return false;
        int wgid = (int)L; { const int q = nwg / NXCD, r = nwg % NXCD, xcd = wgid % NXCD, off = wgid / NXCD; wgid = (xcd < r ? xcd * (q + 1) : r * (q + 1) + (xcd - r) * q) + off; }
        const int nig = WGM * nN, gid = wgid / nig, fm = gid * WGM, gsz = (nM - fm) < WGM ? (nM - fm) : WGM;
        u.pm = fm + ((wgid % nig) % gsz); u.pn = (wgid % nig) / gsz; return true;
    }
    __device__ __forceinline__ void a_ready(const Unit&) const {}
    __device__ __forceinline__ void done(const Unit&) const {}
};
__device__ __forceinline__ unsigned cvt_pk_bf16(float lo, float hi) { unsigned r; asm volatile("v_cvt_pk_bf16_f32 %0, %1, %2" : "=v"(r) : "v"(lo), "v"(hi)); return r; }
template <class Epi, class Sched, bool ALIGN_EPI = false, bool SP2 = false>
__device__ __forceinline__ void gemm_phase(PG8_LAS unsigned char* lds, const Gemm g, const Sched& S, const Epi& E) {
    const int tid = threadIdx.x, wid = __builtin_amdgcn_readfirstlane(tid >> 6), lane = tid & 63, wr = wid >> 2, wc = wid & 3, fr = lane & 15, fq = lane >> 4;
    const int K = g.K, nt = K / BK;
    unsigned voffA[2], voffB[2];
#pragma unroll
    for (int i = 0; i < 2; ++i) { int R, C; stage_rc(tid * 16 + i * 8192, R, C); const int Rb = Epi::PERM ? ((R & ~31) + perm32(R & 31)) : R;
        voffA[i] = (unsigned)(R * K + C) * 2u; voffB[i] = (unsigned)(Rb * K + C) * 2u; }
    const size_t kstep = (size_t)(BK * 2);
    const size_t hstep = (size_t)HALF * K * 2;
    const size_t tstep = 2 * hstep;
    const unsigned ldsw = (unsigned)wid * 1024u;
    const int aoff = lds_byte(wr * 64 + fr, fq * 8), boff = lds_byte(wc * 32 + fr, fq * 8);
#define PG8_SA(b, h) (((b) * 2 + (h)) * HTB)
#define PG8_SB(b, h) ((4 + (b) * 2 + (h)) * HTB)
#define PG8_STAGE(bufoff, gbase, voff) do { _Pragma("unroll") for (int _i = 0; _i < 2; ++_i) \
        __builtin_amdgcn_global_load_lds((const unsigned*)((const char*)(gbase) + (voff)[_i]), (PG8_LAS unsigned*)(lds + (bufoff) + ldsw + _i * 8192), 16, 0, 0); } while (0)
#define PG8_LDA(dst, b, h) do { _Pragma("unroll") for (int m = 0; m < 4; ++m) _Pragma("unroll") for (int k = 0; k < 2; ++k) dst[m][k] = *(const PG8_LAS bf16x8*)(lds + PG8_SA(b, h) + aoff + m * 2048 + k * 1024); } while (0)
#define PG8_LDB(dst, b, h) do { _Pragma("unroll") for (int n = 0; n < 2; ++n) _Pragma("unroll") for (int k = 0; k < 2; ++k) dst[n][k] = *(const PG8_LAS bf16x8*)(lds + PG8_SB(b, h) + boff + n * 2048 + k * 1024); } while (0)
#define PG8_MMA(ai, bj, At, Bt) do { __builtin_amdgcn_s_setprio(1); _Pragma("unroll") for (int m = 0; m < 4; ++m) _Pragma("unroll") for (int n = 0; n < 2; ++n) _Pragma("unroll") for (int k = 0; k < 2; ++k) \
        acc[ai][bj][m][n] = __builtin_amdgcn_mfma_f32_16x16x32_bf16(Bt[n][k], At[m][k], acc[ai][bj][m][n], 0, 0, 0); __builtin_amdgcn_s_setprio(0); } while (0)
#define PG8_WAIT_V(n) asm volatile("s_waitcnt vmcnt(" #n ")" ::: "memory")
#define PG8_WAIT_L(n) asm volatile("s_waitcnt lgkmcnt(" #n ")" ::: "memory")
#define PG8_BAR __builtin_amdgcn_s_barrier()
#define PG8_SCHED __builtin_amdgcn_sched_barrier(0)
    Unit cur, nxt; int ui = 0;
    if (!S.next(0, cur)) return;
    f32x4 acc[2][2][4][2];
#pragma unroll
    for (int a = 0; a < 2; ++a)
#pragma unroll
        for (int b = 0; b < 2; ++b)
#pragma unroll
            for (int m = 0; m < 4; ++m)
#pragma unroll
                for (int n = 0; n < 2; ++n) acc[a][b][m][n] = (f32x4){0.f, 0.f, 0.f, 0.f};
    bf16x8 At[4][2], B0[2][2], B1[2][2];
    const char* cA = (const char*)g.A + (size_t)cur.pm * tstep; const char* cB = (const char*)g.Bt + (size_t)cur.pn * tstep;
    S.a_ready(cur);
    if constexpr (SP2) {
        PG8_STAGE(PG8_SB(0, 0), cB, voffB); PG8_STAGE(PG8_SB(0, 1), cB + hstep, voffB); PG8_STAGE(PG8_SA(0, 0), cA, voffA); PG8_STAGE(PG8_SA(0, 1), cA + hstep, voffA);
        if (wr == 1) PG8_BAR;
        PG8_WAIT_V(2); PG8_BAR;
        PG8_STAGE(PG8_SB(1, 0), cB + kstep, voffB); PG8_STAGE(PG8_SA(1, 0), cA + kstep, voffA); PG8_STAGE(PG8_SB(1, 1), cB + hstep + kstep, voffB);
        PG8_WAIT_V(6); PG8_BAR;
    } else {
        PG8_STAGE(PG8_SB(0, 0), cB, voffB); PG8_STAGE(PG8_SA(0, 0), cA, voffA); PG8_STAGE(PG8_SB(0, 1), cB + hstep, voffB); PG8_STAGE(PG8_SA(0, 1), cA + hstep, voffA);
        if (wr == 1) PG8_BAR;
        PG8_WAIT_V(4); PG8_BAR;
        PG8_STAGE(PG8_SB(1, 0), cB + kstep, voffB); PG8_STAGE(PG8_SA(1, 0), cA + kstep, voffA); PG8_STAGE(PG8_SB(1, 1), cB + hstep + kstep, voffB);
        PG8_WAIT_V(6); PG8_BAR;
    }
    for (;;) {
        const bool has_next = S.next(ui + 1, nxt);
        const char* nA = has_next ? (const char*)g.A + (size_t)nxt.pm * tstep : cA; const char* nB = has_next ? (const char*)g.Bt + (size_t)nxt.pn * tstep : cB;
        for (int t = 0; t < nt; t += 2) {
            const bool last = (t == nt - 2);
            const char* a1 = cA + (size_t)(t + 1) * kstep;
            const char* a2 = last ? nA : cA + (size_t)(t + 2) * kstep; const char* b2 = last ? nB : cB + (size_t)(t + 2) * kstep;
            const char* a3 = a2 + kstep; const char* b3 = b2 + kstep;
            if (last && has_next) S.a_ready(nxt);
            if constexpr (SP2) {
            PG8_LDB(B0, 0, 0); PG8_LDB(B1, 0, 1); PG8_SCHED; PG8_LDA(At, 0, 0); PG8_STAGE(PG8_SA(1, 1), a1 + hstep, voffA);
            PG8_WAIT_V(8); PG8_WAIT_L(0); PG8_BAR; PG8_MMA(0, 0, At, B0); PG8_MMA(0, 1, At, B1); PG8_BAR; PG8_SCHED;
            PG8_LDA(At, 0, 1); PG8_STAGE(PG8_SB(0, 0), b2, voffB); PG8_STAGE(PG8_SB(0, 1), b2 + hstep, voffB); PG8_STAGE(PG8_SA(0, 0), a2, voffA);
            PG8_WAIT_V(8); PG8_WAIT_L(0); PG8_BAR; PG8_MMA(1, 0, At, B0); PG8_MMA(1, 1, At, B1); PG8_BAR; PG8_SCHED;
            PG8_LDB(B0, 1, 0); PG8_LDB(B1, 1, 1); PG8_SCHED; PG8_LDA(At, 1, 0); PG8_STAGE(PG8_SA(0, 1), a2 + hstep, voffA);
            PG8_WAIT_V(8); PG8_WAIT_L(0); PG8_BAR; PG8_MMA(0, 0, At, B0); PG8_MMA(0, 1, At, B1); PG8_BAR; PG8_SCHED;
            PG8_LDA(At, 1, 1); PG8_STAGE(PG8_SB(1, 0), b3, voffB); PG8_STAGE(PG8_SB(1, 1), b3 + hstep, voffB); PG8_STAGE(PG8_SA(1, 0), a3, voffA);
            PG8_WAIT_V(8); PG8_WAIT_L(0); PG8_BAR; PG8_MMA(1, 0, At, B0); PG8_MMA(1, 1, At, B1); PG8_BAR; PG8_SCHED;
            } else {
            PG8_LDB(B0, 0, 0); PG8_SCHED; PG8_LDA(At, 0, 0); PG8_STAGE(PG8_SA(1, 1), a1 + hstep, voffA);
            PG8_WAIT_L(8); PG8_BAR; PG8_WAIT_L(0); PG8_MMA(0, 0, At, B0); PG8_BAR; PG8_SCHED;
            PG8_LDB(B1, 0, 1); PG8_STAGE(PG8_SB(0, 0), b2, voffB);
            PG8_BAR; PG8_WAIT_L(0); PG8_MMA(0, 1, At, B1); PG8_BAR;
            PG8_LDA(At, 0, 1); PG8_STAGE(PG8_SA(0, 0), a2, voffA);
            PG8_BAR; PG8_WAIT_L(0); PG8_MMA(1, 0, At, B0); PG8_BAR; PG8_SCHED;
            PG8_STAGE(PG8_SB(0, 1), b2 + hstep, voffB);
            PG8_WAIT_V(6); PG8_BAR; PG8_MMA(1, 1, At, B1); PG8_BAR;
            PG8_LDB(B0, 1, 0); PG8_SCHED; PG8_LDA(At, 1, 0); PG8_STAGE(PG8_SA(0, 1), a2 + hstep, voffA);
            PG8_WAIT_L(8); PG8_BAR; PG8_WAIT_L(0); PG8_MMA(0, 0, At, B0); PG8_BAR; PG8_SCHED;
            PG8_LDB(B1, 1, 1); PG8_STAGE(PG8_SB(1, 0), b3, voffB);
            PG8_BAR; PG8_WAIT_L(0); PG8_MMA(0, 1, At, B1); PG8_BAR;
            PG8_LDA(At, 1, 1); PG8_STAGE(PG8_SA(1, 0), a3, voffA);
            PG8_BAR; PG8_WAIT_L(0); PG8_MMA(1, 0, At, B0); PG8_BAR; PG8_SCHED;
            PG8_STAGE(PG8_SB(1, 1), b3 + hstep, voffB);
            PG8_WAIT_V(6); PG8_BAR; PG8_MMA(1, 1, At, B1); PG8_BAR;
            }
        }
        if constexpr (ALIGN_EPI) { if (wr == 0) PG8_BAR; }
        if constexpr (!Epi::AFTER_DRAIN) { E(acc, cur, wr, wc, fr, fq); S.done(cur); }
        if (!has_next) break;
#pragma unroll
        for (int a = 0; a < 2; ++a)
#pragma unroll
            for (int b = 0; b < 2; ++b)
#pragma unroll
                for (int m = 0; m < 4; ++m)
#pragma unroll
                    for (int n = 0; n < 2; ++n) acc[a][b][m][n] = (f32x4){0.f, 0.f, 0.f, 0.f};
        cur = nxt; cA = nA; cB = nB; ++ui;
        if constexpr (ALIGN_EPI) { if (wr == 1) PG8_BAR; }
    }
    PG8_WAIT_V(0);
    if constexpr (!ALIGN_EPI) { if (wr == 0) PG8_BAR; }
    PG8_BAR;
    if constexpr (Epi::AFTER_DRAIN) { E.fused(acc, cur, wr, wc, fr, fq, lds, wid, lane); S.done(cur); }
#undef PG8_SA
#undef PG8_SB
#undef PG8_STAGE
#undef PG8_LDA
#undef PG8_LDB
#undef PG8_MMA
#undef PG8_WAIT_V
#undef PG8_WAIT_L
#undef PG8_BAR
#undef PG8_SCHED
}
}

#define LAS __attribute__((address_space(3)))
#define DI __device__ __forceinline__
using pg8::bf16_t; using pg8::bf16x8; using pg8::f32x4; using pg8::u32x4; using pg8::cvt_pk_bf16;
typedef unsigned u32x2 __attribute__((ext_vector_type(2)));
typedef float f32x2 __attribute__((ext_vector_type(2)));

constexpr int T_TOK = 32768, DM = 2048, NPROJ = 5120, PROJW = 5128;
constexpr int NTHREADS = 512;
constexpr int LDS_BYTES = 147456;
constexpr float EPS = 1e-6f;

constexpr size_t WS_XN = 0;
constexpr size_t WS_P = 134217728;
constexpr size_t WS_X1G = WS_P;
constexpr size_t WS_Q = WS_P + 134217728;
constexpr size_t WS_WINT = WS_P + 335544320;
constexpr size_t WS_WOUTT = WS_WINT + 20971520;
constexpr size_t WS_WQT = WS_WOUTT + 8388608;
constexpr size_t WS_UB = WS_WQT + 4194304;
constexpr size_t WS_VB = WS_UB + 67108864;
constexpr size_t WS_ST = WS_VB + 67108864;
constexpr size_t WS_CPT = WS_ST + 142606336;
constexpr size_t WS_QC = WS_CPT + 71303168;
constexpr size_t WS_KC = WS_QC + 33554432;
constexpr size_t WS_IG = WS_KC + 33554432;
constexpr size_t WS_LF = WS_IG + 524288;
constexpr size_t WS_PSSV = WS_LF + 524288;
constexpr size_t WS_PSS2 = WS_PSSV + 2097152;
constexpr size_t WS_BEND = WS_PSS2 + 4194304;
constexpr size_t WS_GMAX = WS_BEND + 4096;
constexpr size_t WS_MPREV = WS_GMAX + 4096;
constexpr size_t WS_SELID = WS_MPREV + 4096;
constexpr size_t WS_SELG = WS_SELID + 16777216;
constexpr size_t WS_KB1 = WS_SELG + 16777216;
constexpr size_t WS_KB2 = WS_KB1 + 131072;
constexpr size_t WS_BAR = WS_KB2 + 131072;
constexpr size_t WS_END = WS_BAR + 16384;

struct Params {
    const float *x, *norm1_g, *w_in, *gm_vnorm_g, *w_spatial, *b_spatial, *ml_conv_w, *ml_conv_b, *ml_b_i, *ml_b_f, *gm_out_g, *ml_out_g, *w_out, *norm2_g,
        *peer_wq, *peer_k1, *peer_k2, *peer_u, *peer_v, *final_g;
    float* out;
    unsigned char* ws;
};

template <int CB, int H, int W> DI size_t p_off(int t, int h, int d) { return (size_t)T_TOK * CB + ((size_t)((t >> 7) * H + h) * 128 + (t & 127)) * W + d; }
DI float bf2f(unsigned short h) { return __uint_as_float(((unsigned)h) << 16); }
DI float bflo(unsigned w) { return __uint_as_float(w << 16); }
DI float bfhi(unsigned w) { return __uint_as_float(w & 0xffff0000u); }
DI float rcpf_(float x) { return __builtin_amdgcn_rcpf(x); }
DI float sigmoid_(float x) { return rcpf_(1.f + __expf(-x)); }
DI float gelu_t(float x) { const float z = 1.5957691216057308f * (x + 0.044715f * x * x * x); return x * rcpf_(1.f + __expf(-z)); }
DI float wave_sum(float v) {
#pragma unroll
    for (int o = 32; o; o >>= 1) v += __shfl_xor(v, o);
    return v;
}
DI float wave_max(float v) {
#pragma unroll
    for (int o = 32; o; o >>= 1) v = fmaxf(v, __shfl_xor(v, o));
    return v;
}
DI bf16x8 ld_frag_lds(const LAS unsigned char* p) { return *(const LAS bf16x8*)p; }
#define MFMA16(a, b, c) __builtin_amdgcn_mfma_f32_16x16x32_bf16((a), (b), (c), 0, 0, 0)

struct Epi1 {
    static constexpr bool PERM = true, AFTER_DRAIN = false;
    bf16_t* P; float* pssv;
    DI void operator()(const f32x4 (&acc)[2][2][4][2], const pg8::Unit& u, int wr, int wc, int fr, int fq) const {
        const int row0 = u.pm * 256 + wr * 64 + fr, col0 = u.pn * 256 + wc * 32 + 8 * fq;
        const int mode = u.pn < 8 ? 1 : (u.pn >= 16 ? 2 : 0);
        const bool want_ss = (u.pn >= 4 && u.pn < 8);
#pragma unroll
        for (int ai = 0; ai < 2; ++ai)
#pragma unroll
            for (int m = 0; m < 4; ++m) {
                const int row = row0 + ai * 128 + m * 16;
                const int CB = u.pn < 4 ? 0 : (u.pn < 8 ? 1024 : (u.pn < 10 ? 2048 : (u.pn < 12 ? 2560 : (u.pn < 16 ? 3072 : 4096))));
                const int lw = u.pn < 12 ? 7 : 8, H = u.pn < 8 ? 8 : 4;
                float ss = 0.f;
#pragma unroll
                for (int bj = 0; bj < 2; ++bj) {
                    f32x4 v0 = acc[ai][bj][m][0], v1 = acc[ai][bj][m][1];
                    if (mode == 1) {
#pragma unroll
                        for (int j = 0; j < 4; ++j) { v0[j] = gelu_t(v0[j]); v1[j] = gelu_t(v1[j]); ss += v0[j] * v0[j] + v1[j] * v1[j]; }
                    } else if (mode == 2) {
#pragma unroll
                        for (int j = 0; j < 4; ++j) { v0[j] = sigmoid_(v0[j]); v1[j] = sigmoid_(v1[j]); }
                    }
                    u32x4 w; w.x = cvt_pk_bf16(v0[0], v0[1]); w.y = cvt_pk_bf16(v0[2], v0[3]); w.z = cvt_pk_bf16(v1[0], v1[1]); w.w = cvt_pk_bf16(v1[2], v1[3]);
                    {
                        const int cr = col0 + bj * 128 - CB, hh = cr >> lw, d = cr & ((1 << lw) - 1);
                        *(u32x4*)(P + (size_t)T_TOK * CB + (((size_t)((row >> 7) * H + hh) * 128 + (row & 127)) << lw) + d) = w;
                    }
                }
                if (want_ss) {
                    ss += __shfl_xor(ss, 16); ss += __shfl_xor(ss, 32);
                    if (fq == 0) pssv[(size_t)row * 16 + (u.pn - 4) * 4 + wc] = ss;
                }
            }
    }
};

struct Epi2 {
    static constexpr bool PERM = true, AFTER_DRAIN = false;
    const float* x; bf16_t* x1b; float* pss2;
    DI void operator()(const f32x4 (&acc)[2][2][4][2], const pg8::Unit& u, int wr, int wc, int fr, int fq) const {
        const int row0 = u.pm * 256 + wr * 64 + fr, col0 = u.pn * 256 + wc * 32 + 8 * fq;
#pragma unroll
        for (int ai = 0; ai < 2; ++ai)
#pragma unroll
            for (int m = 0; m < 4; ++m) {
                const int row = row0 + ai * 128 + m * 16;
                float ss = 0.f;
#pragma unroll
                for (int bj = 0; bj < 2; ++bj) {
                    const size_t o = (size_t)row * DM + col0 + bj * 128;
                    const f32x4 v0 = acc[ai][bj][m][0] + *(const f32x4*)(x + o), v1 = acc[ai][bj][m][1] + *(const f32x4*)(x + o + 4);
#pragma unroll
                    for (int j = 0; j < 4; ++j) ss += v0[j] * v0[j] + v1[j] * v1[j];
                    u32x4 w; w.x = cvt_pk_bf16(v0[0], v0[1]); w.y = cvt_pk_bf16(v0[2], v0[3]); w.z = cvt_pk_bf16(v1[0], v1[1]); w.w = cvt_pk_bf16(v1[2], v1[3]);
                    *(u32x4*)(x1b + o) = w;
                }
                ss += __shfl_xor(ss, 16); ss += __shfl_xor(ss, 32);
                if (fq == 0) pss2[(size_t)row * 32 + u.pn * 4 + wc] = ss;
            }
    }
};

struct Epi3 {
    static constexpr bool PERM = true, AFTER_DRAIN = false;
    bf16_t* Q; const float* pss2;
    DI void operator()(const f32x4 (&acc)[2][2][4][2], const pg8::Unit& u, int wr, int wc, int fr, int fq) const {
        const int row0 = u.pm * 256 + wr * 64 + fr, col0 = u.pn * 256 + wc * 32 + 8 * fq;
#pragma unroll
        for (int ai = 0; ai < 2; ++ai)
#pragma unroll
            for (int m = 0; m < 4; ++m) {
                const int row = row0 + ai * 128 + m * 16;
                float ss = 0.f;
#pragma unroll
                for (int i = 0; i < 8; ++i) { const f32x4 t = *(const f32x4*)(pss2 + (size_t)row * 32 + i * 4); ss += (t[0] + t[1]) + (t[2] + t[3]); }
                const float rstd = rsqrtf(ss * (1.f / 2048.f) + EPS);
#pragma unroll
                for (int bj = 0; bj < 2; ++bj) {
                    const f32x4 v0 = acc[ai][bj][m][0] * rstd, v1 = acc[ai][bj][m][1] * rstd;
                    u32x4 w; w.x = cvt_pk_bf16(v0[0], v0[1]); w.y = cvt_pk_bf16(v0[2], v0[3]); w.z = cvt_pk_bf16(v1[0], v1[1]); w.w = cvt_pk_bf16(v1[2], v1[3]);
                    *(u32x4*)(Q + (size_t)row * 1024 + col0 + bj * 128) = w;
                }
            }
    }
};

DI void phase0(const Params& p, LAS unsigned char* lds) {
    const int tid = threadIdx.x, lane = tid & 63, wave = tid >> 6;
    bf16_t* XN = (bf16_t*)(p.ws + WS_XN);
    {
        LAS float* scr = (LAS float*)lds + wave * (64 * 65);
        const int gw = blockIdx.x * 8 + wave, nw = gridDim.x * 8;
        for (int it = gw; it < 4096; it += nw) {
            const float* W; bf16_t* WT; int ldw, kt, nt;
            if (it < 2560) { W = p.w_in; WT = (bf16_t*)(p.ws + WS_WINT); ldw = PROJW; kt = it / 80; nt = it % 80; }
            else if (it < 3584) { const int j = it - 2560; W = p.w_out; WT = (bf16_t*)(p.ws + WS_WOUTT); ldw = 2048; kt = j >> 5; nt = j & 31; }
            else { const int j = it - 3584; W = p.peer_wq; WT = (bf16_t*)(p.ws + WS_WQT); ldw = 1024; kt = j >> 4; nt = j & 15; }
            const int k0 = kt * 64, n0 = nt * 64;
            {
                f32x4 tv[16];
#pragma unroll
                for (int i = 0; i < 16; ++i) tv[i] = *(const f32x4*)(W + (size_t)(k0 + 4 * i + (lane >> 4)) * ldw + n0 + 4 * (lane & 15));
#pragma unroll
                for (int i = 0; i < 16; ++i) {
                    const int r = 4 * i + (lane >> 4);
                    const float gsc = it >= 3584 ? p.norm2_g[k0 + r] : 1.f;
                    LAS float* d = scr + r * 65 + 4 * (lane & 15);
                    d[0] = tv[i][0] * gsc; d[1] = tv[i][1] * gsc; d[2] = tv[i][2] * gsc; d[3] = tv[i][3] * gsc;
                }
            }
            __builtin_amdgcn_fence(__ATOMIC_RELEASE, "wavefront"); __builtin_amdgcn_wave_barrier(); __builtin_amdgcn_fence(__ATOMIC_ACQUIRE, "wavefront");
            const int half = lane >> 5, kk = (lane & 31) * 2;
#pragma unroll 8
            for (int nn = 0; nn < 32; ++nn) {
                const int n = 2 * nn + half; const float a = scr[kk * 65 + n], b = scr[(kk + 1) * 65 + n];
                *(unsigned*)(WT + (size_t)(n0 + n) * 2048 + k0 + kk) = cvt_pk_bf16(a, b);
            }
            __builtin_amdgcn_fence(__ATOMIC_RELEASE, "wavefront"); __builtin_amdgcn_wave_barrier(); __builtin_amdgcn_fence(__ATOMIC_ACQUIRE, "wavefront");
        }
    }
    __syncthreads();
    {
        LAS float* wg = (LAS float*)lds;
        for (int idx = tid; idx < 4096; idx += NTHREADS) {
            const int k = idx >> 1, hf = idx & 1;
            const f32x4 v = *(const f32x4*)(p.w_in + (size_t)k * PROJW + 5120 + hf * 4);
            *(LAS f32x4*)(wg + k * 8 + (k >> 3) * 4 + hf * 4) = v;
        }
        __syncthreads();
        float* IG = (float*)(p.ws + WS_IG); float* LF = (float*)(p.ws + WS_LF);
        for (int row0 = 2 * (blockIdx.x * 8 + wave); row0 < T_TOK; row0 += 2 * gridDim.x * 8) {
            f32x4 xv[2][8];
#pragma unroll
            for (int rr = 0; rr < 2; ++rr) {
                const float* xr = p.x + (size_t)(row0 + rr) * DM;
#pragma unroll
                for (int i = 0; i < 4; ++i) { xv[rr][2 * i] = *(const f32x4*)(xr + i * 512 + lane * 8); xv[rr][2 * i + 1] = *(const f32x4*)(xr + i * 512 + lane * 8 + 4); }
            }
#pragma unroll
            for (int rr = 0; rr < 2; ++rr) {
                const int row = row0 + rr;
                float ss = 0.f;
#pragma unroll
                for (int i = 0; i < 8; ++i) ss += (xv[rr][i][0] * xv[rr][i][0] + xv[rr][i][1] * xv[rr][i][1]) + (xv[rr][i][2] * xv[rr][i][2] + xv[rr][i][3] * xv[rr][i][3]);
                ss = wave_sum(ss);
                const float rstd = rsqrtf(ss * (1.f / 2048.f) + EPS);
                f32x4 ga = {0.f, 0.f, 0.f, 0.f}, gb = {0.f, 0.f, 0.f, 0.f};
#pragma unroll
                for (int i = 0; i < 4; ++i) {
                    const f32x4 g0 = *(const f32x4*)(p.norm1_g + i * 512 + lane * 8), g1 = *(const f32x4*)(p.norm1_g + i * 512 + lane * 8 + 4);
                    const f32x4 h0 = xv[rr][2 * i] * rstd * g0, h1 = xv[rr][2 * i + 1] * rstd * g1;
                    u32x4 w; w.x = cvt_pk_bf16(h0[0], h0[1]); w.y = cvt_pk_bf16(h0[2], h0[3]); w.z = cvt_pk_bf16(h1[0], h1[1]); w.w = cvt_pk_bf16(h1[2], h1[3]);
                    *(u32x4*)(XN + (size_t)row * DM + i * 512 + lane * 8) = w;
                    const LAS float* wb = wg + (i * 512 + lane * 8) * 8 + (i * 64 + lane) * 4;
#pragma unroll
                    for (int e = 0; e < 8; ++e) {
                        const float hv = e < 4 ? h0[e & 3] : h1[e & 3];
                        const f32x4 w0 = *(const LAS f32x4*)(wb + e * 8), w1 = *(const LAS f32x4*)(wb + e * 8 + 4);
                        ga = ga + w0 * hv; gb = gb + w1 * hv;
                    }
                }
                f32x4 m4 = lane < 32 ? ga : gb, s4 = lane < 32 ? gb : ga;
#pragma unroll
                for (int j = 0; j < 4; ++j) m4[j] += __shfl_xor(s4[j], 32);
                const bool up16 = (lane & 16) != 0;
                float m2a = up16 ? m4[2] : m4[0], m2b = up16 ? m4[3] : m4[1];
                const float s2a = up16 ? m4[0] : m4[2], s2b = up16 ? m4[1] : m4[3];
                m2a += __shfl_xor(s2a, 16); m2b += __shfl_xor(s2b, 16);
                const bool up8 = (lane & 8) != 0;
                float m1 = up8 ? m2b : m2a; const float s1 = up8 ? m2a : m2b;
                m1 += __shfl_xor(s1, 8);
                m1 += __shfl_xor(m1, 4); m1 += __shfl_xor(m1, 2); m1 += __shfl_xor(m1, 1);
                const int j = ((lane >> 5) << 2) | (((lane >> 4) & 1) << 1) | ((lane >> 3) & 1);
                if ((lane & 7) == 0) {
                    if (j < 4) IG[(size_t)row * 4 + j] = m1 + p.ml_b_i[j];
                    else { const float z = m1 + p.ml_b_f[j - 4]; LF[(size_t)row * 4 + j - 4] = fminf(z, 0.f) - log1pf(__expf(-fabsf(z))); }
                }
            }
        }
    }
    {
        const size_t nthr = (size_t)gridDim.x * NTHREADS, NQ = (size_t)16384 * 512;
        for (size_t base = (size_t)blockIdx.x * NTHREADS + tid; base < 2 * NQ; base += 16 * nthr) {
            f32x4 v[16];
#pragma unroll
            for (int u = 0; u < 16; ++u) {
                size_t i = base + u * nthr; if (i >= 2 * NQ) i = base;
                const int which = i >= NQ; const size_t j = i - (which ? NQ : 0);
                v[u] = *(const f32x4*)((which ? p.peer_v : p.peer_u) + j * 4);
            }
#pragma unroll
            for (int u = 0; u < 16; ++u) {
                size_t i = base + u * nthr; if (i >= 2 * NQ) i = base;
                const int which = i >= NQ; const size_t j = i - (which ? NQ : 0);
                const int row = (int)(j >> 9), c4 = (int)(j & 511);
                float amax = fmaxf(fmaxf(fabsf(v[u][0]), fabsf(v[u][1])), fmaxf(fabsf(v[u][2]), fabsf(v[u][3])));
                amax = fmaxf(amax, __uint_as_float((unsigned)__builtin_amdgcn_update_dpp(0, (int)__float_as_uint(amax), 0xB1, 0xF, 0xF, true)));
                amax = fmaxf(amax, __uint_as_float((unsigned)__builtin_amdgcn_update_dpp(0, (int)__float_as_uint(amax), 0x4E, 0xF, 0xF, true)));
                amax = fmaxf(amax, __uint_as_float((unsigned)__builtin_amdgcn_update_dpp(0, (int)__float_as_uint(amax), 0x141, 0xF, 0xF, true)));
                amax = fmaxf(amax, __uint_as_float((unsigned)__builtin_amdgcn_update_dpp(0, (int)__float_as_uint(amax), 0x140, 0xF, 0xF, true)));
                const unsigned sb = cvt_pk_bf16(amax * (1.f / 6.f), 0.f) & 0xffffu;
                float sc = bflo(sb); if (sc == 0.f) sc = 1.f;
                const float inv = 1.f / sc;
                unsigned r = 0u;
                r = __builtin_amdgcn_cvt_scalef32_pk_fp4_f32(r, v[u][0] * inv, v[u][1] * inv, 1.0f, 0);
                r = __builtin_amdgcn_cvt_scalef32_pk_fp4_f32(r, v[u][2] * inv, v[u][3] * inv, 1.0f, 1);
                unsigned char* dst = p.ws + (which ? WS_VB : WS_UB) + (size_t)row * 1088;
                *(unsigned short*)(dst + c4 * 2) = (unsigned short)(r & 0xffffu);
                if ((c4 & 15) == 0) *(unsigned short*)(dst + 1024 + (c4 >> 4) * 2) = (unsigned short)(sb == 0u ? 0x3F80u : sb);
            }
        }
    }
    {
        bf16_t* KB1 = (bf16_t*)(p.ws + WS_KB1); bf16_t* KB2 = (bf16_t*)(p.ws + WS_KB2);
        for (int i = blockIdx.x * NTHREADS + tid; i < 65536 / 4; i += gridDim.x * NTHREADS) {
            const f32x4 a = *(const f32x4*)(p.peer_k1 + i * 4), b = *(const f32x4*)(p.peer_k2 + i * 4);
            u32x2 w; w.x = cvt_pk_bf16(a[0], a[1]); w.y = cvt_pk_bf16(a[2], a[3]); *(u32x2*)(KB1 + i * 4) = w;
            w.x = cvt_pk_bf16(b[0], b[1]); w.y = cvt_pk_bf16(b[2], b[3]); *(u32x2*)(KB2 + i * 4) = w;
        }
    }
}

#define WAVE_LDS_SYNC() do { __builtin_amdgcn_fence(__ATOMIC_RELEASE, "wavefront"); __builtin_amdgcn_wave_barrier(); __builtin_amdgcn_fence(__ATOMIC_ACQUIRE, "wavefront"); } while (0)

template <int NG> DI void stage_T_load(const bf16_t* src, int ld, u32x4 (&r0)[NG], u32x4 (&r1)[NG], int wave, int lane) {
#pragma unroll
    for (int i = 0; i < NG; ++i) {
        const int g = wave + 8 * i;
        r0[i] = *(const u32x4*)(src + (size_t)(2 * lane) * ld + g * 8);
        r1[i] = *(const u32x4*)(src + (size_t)(2 * lane + 1) * ld + g * 8);
    }
}
template <int NG> DI void stage_T_store(const u32x4 (&r0)[NG], const u32x4 (&r1)[NG], LAS unsigned char* dst, int wave, int lane) {
#pragma unroll
    for (int i = 0; i < NG; ++i) {
        const int g = wave + 8 * i;
#pragma unroll
        for (int w = 0; w < 4; ++w) {
            const unsigned a = r0[i][w], b = r1[i][w];
            *(LAS unsigned*)(dst + (g * 8 + 2 * w) * 272 + lane * 4) = (a & 0xffffu) | (b << 16);
            *(LAS unsigned*)(dst + (g * 8 + 2 * w + 1) * 272 + lane * 4) = (a >> 16) | (b & 0xffff0000u);
        }
    }
}
template <int NG> DI void stage_T(const bf16_t* src, int ld, LAS unsigned char* dst, int wave, int lane) {
    u32x4 r0[NG], r1[NG];
    stage_T_load<NG>(src, ld, r0, r1, wave, lane);
    stage_T_store<NG>(r0, r1, dst, wave, lane);
}

DI void gmlp_bc(const Params& p, LAS unsigned char* lds, int b, int c) {
    const int tid = threadIdx.x, lane = tid & 63, wave = __builtin_amdgcn_readfirstlane(tid >> 6), fr = lane & 15, fq = lane >> 4;
    const int t0 = b * 8192 + c * 128;
    LAS unsigned char* Wl = lds; LAS unsigned char* GvT = lds + 34816; LAS float* rstdv = (LAS float*)(lds + 69632);
    const bf16_t* P = (const bf16_t*)(p.ws + WS_P); bf16_t* YM = (bf16_t*)(p.ws + WS_XN);
    const float* PSSV = (const float*)(p.ws + WS_PSSV);
    __syncthreads();
    if (tid < 128) {
        float ss = 0.f;
#pragma unroll
        for (int i = 0; i < 4; ++i) { const f32x4 v = *(const f32x4*)(PSSV + (size_t)(t0 + tid) * 16 + i * 4); ss += (v[0] + v[1]) + (v[2] + v[3]); }
        rstdv[tid] = rsqrtf(ss * (1.f / 1024.f) + EPS);
    }
    f32x4 wa[4][2]; u32x4 gr0[2], gr1[2];
#define GMLP_PREFETCH(hh) do { _Pragma("unroll") for (int it = 0; it < 4; ++it) { const int e = (it * NTHREADS + tid) * 8, t = e >> 7, s0 = e & 127; \
            const float* wp = p.w_spatial + ((size_t)((hh) * 128 + t)) * 128 + s0; wa[it][0] = *(const f32x4*)wp; wa[it][1] = *(const f32x4*)(wp + 4); } \
        stage_T_load<2>(P + p_off<1024, 8, 128>(t0, (hh), 0), 128, gr0, gr1, wave, lane); } while (0)
    GMLP_PREFETCH(0);
    for (int h = 0; h < 8; ++h) {
        __syncthreads();
#pragma unroll
        for (int it = 0; it < 4; ++it) {
            const int e = (it * NTHREADS + tid) * 8, t = e >> 7, s0 = e & 127;
            float v[8];
#pragma unroll
            for (int j = 0; j < 8; ++j) { const float a = j < 4 ? wa[it][0][j & 3] : wa[it][1][j & 3]; v[j] = (s0 + j <= t) ? a * rstdv[s0 + j] : 0.f; }
            u32x4 w; w.x = cvt_pk_bf16(v[0], v[1]); w.y = cvt_pk_bf16(v[2], v[3]); w.z = cvt_pk_bf16(v[4], v[5]); w.w = cvt_pk_bf16(v[6], v[7]);
            *(LAS u32x4*)(Wl + t * 272 + s0 * 2) = w;
        }
        stage_T_store<2>(gr0, gr1, GvT, wave, lane);
        __syncthreads();
        if (h + 1 < 8) GMLP_PREFETCH(h + 1);
        f32x4 acc[8];
#pragma unroll
        for (int n = 0; n < 8; ++n) acc[n] = (f32x4){0.f, 0.f, 0.f, 0.f};
        const int kmax = (16 * wave + 15) >> 5;
#pragma unroll
        for (int kk = 0; kk < 4; ++kk) {
            if (kk <= kmax) {
                const bf16x8 bfrag = ld_frag_lds(Wl + (16 * wave + fr) * 272 + (32 * kk + 8 * fq) * 2);
#pragma unroll
                for (int n = 0; n < 8; ++n) { const bf16x8 afrag = ld_frag_lds(GvT + (16 * n + fr) * 272 + (32 * kk + 8 * fq) * 2); acc[n] = MFMA16(afrag, bfrag, acc[n]); }
            }
        }
        const int t = 16 * wave + fr; const size_t grow = (size_t)(t0 + t);
        const float bsp = p.b_spatial[h * 128 + t];
        float ss = 0.f;
#pragma unroll
        for (int n = 0; n < 8; ++n) {
            const int d0 = 16 * n + 4 * fq;
            const u32x2 uw = *(const u32x2*)(P + p_off<0, 8, 128>(t0 + t, h, d0));
            const f32x4 gv = *(const f32x4*)(p.gm_vnorm_g + h * 128 + d0);
            f32x4 y;
            y[0] = bflo(uw.x) * (gv[0] * acc[n][0] + bsp); y[1] = bfhi(uw.x) * (gv[1] * acc[n][1] + bsp);
            y[2] = bflo(uw.y) * (gv[2] * acc[n][2] + bsp); y[3] = bfhi(uw.y) * (gv[3] * acc[n][3] + bsp);
            ss += (y[0] * y[0] + y[1] * y[1]) + (y[2] * y[2] + y[3] * y[3]);
            acc[n] = y;
        }
        ss += __shfl_xor(ss, 16); ss += __shfl_xor(ss, 32);
        const float rstd = rsqrtf(ss * (1.f / 128.f) + EPS);
#pragma unroll
        for (int n = 0; n < 8; ++n) {
            const int d0 = 16 * n + 4 * fq;
            const f32x4 g = *(const f32x4*)(p.gm_out_g + h * 128 + d0);
            const f32x4 o = acc[n] * rstd * g;
            u32x2 w; w.x = cvt_pk_bf16(o[0], o[1]); w.y = cvt_pk_bf16(o[2], o[3]);
            *(u32x2*)(YM + grow * DM + h * 128 + d0) = w;
        }
    }
}

DI void mlstm_local(const Params& p, LAS unsigned char* lds, int b, int c, int h) {
    const int tid = threadIdx.x, lane = tid & 63, wave = __builtin_amdgcn_readfirstlane(tid >> 6), fr = lane & 15, fq = lane >> 4;
    const int bh = b * 4 + h, t0 = b * 8192 + c * 128;
    LAS unsigned char* KT = lds; LAS unsigned char* VT = lds + 34816; LAS float* wsv = (LAS float*)(lds + 108800);
    const bf16_t* P = (const bf16_t*)(p.ws + WS_P);
    bf16_t* QC = (bf16_t*)(p.ws + WS_QC); bf16_t* KC = (bf16_t*)(p.ws + WS_KC);
    const float* IG = (const float*)(p.ws + WS_IG); const float* LF = (const float*)(p.ws + WS_LF);
    LAS float* cwl = (LAS float*)(lds + 109312);
    __syncthreads();
    u32x4 xw[2][5];
#define CONV_LOAD(half) do { _Pragma("unroll") for (int gi = 0; gi < 2; ++gi) { const int g = wave + 8 * (gi + 2 * (half)); const int cgp = (g & 15) * 8; \
        _Pragma("unroll") for (int dj = 0; dj < 5; ++dj) { const int srow = 2 * lane - 3 + dj; xw[gi][dj] = (u32x4){0u, 0u, 0u, 0u}; \
            if (c > 0 || srow >= 0) xw[gi][dj] = *(const u32x4*)(P + ((half) ? p_off<2560, 4, 128>(t0 + srow, h, cgp) : p_off<2048, 4, 128>(t0 + srow, h, cgp))); } } } while (0)
    CONV_LOAD(0);
    for (int idx = tid; idx < 1280; idx += NTHREADS) {
        const int j = idx >> 8, cc = idx & 255, ch = (cc >= 128 ? 512 : 0) + h * 128 + (cc & 127);
        cwl[idx] = j < 4 ? p.ml_conv_w[j * 1024 + ch] : p.ml_conv_b[ch];
    }
    if (wave == 0) {
        const float l0 = LF[(size_t)(t0 + 2 * lane) * 4 + h], l1 = LF[(size_t)(t0 + 2 * lane + 1) * 4 + h];
        const float i0 = IG[(size_t)(t0 + 2 * lane) * 4 + h], i1 = IG[(size_t)(t0 + 2 * lane + 1) * 4 + h];
        float s = l0 + l1;
#pragma unroll
        for (int off = 1; off < 64; off <<= 1) { const float tt = __shfl_up(s, off); if (lane >= off) s += tt; }
        const float b1 = s, b0 = s - l1, bend = __shfl(s, 63);
        const float g0 = bend - b0 + i0, g1 = bend - b1 + i1;
        const float gmax = wave_max(fmaxf(g0, g1));
        wsv[2 * lane] = __expf(g0 - gmax); wsv[2 * lane + 1] = __expf(g1 - gmax);
        if (lane == 0) { ((float*)(p.ws + WS_BEND))[bh * 64 + c] = bend; ((float*)(p.ws + WS_GMAX))[bh * 64 + c] = gmax; }
    }
    __syncthreads();
#pragma unroll
    for (int gi4 = 0; gi4 < 4; ++gi4) {
        const int gi = gi4 & 1;
        if (gi4 == 2) CONV_LOAD(1);
        const int g = wave + 8 * gi4; const bool isk = gi4 >= 2; const int cgp = (g & 15) * 8;
        const int cc0 = (isk ? 128 : 0) + cgp;
        const int s = 2 * lane;
        float y0[8], y1[8];
        {
            const f32x4 cb0 = *(const LAS f32x4*)(cwl + 1024 + cc0), cb1 = *(const LAS f32x4*)(cwl + 1024 + cc0 + 4);
#pragma unroll
            for (int e = 0; e < 8; ++e) { y0[e] = e < 4 ? cb0[e & 3] : cb1[e & 3]; y1[e] = y0[e]; }
#pragma unroll
            for (int j = 0; j < 5; ++j) {
                float xr[8];
#pragma unroll
                for (int q = 0; q < 4; ++q) { xr[2 * q] = bflo(xw[gi][j][q]); xr[2 * q + 1] = bfhi(xw[gi][j][q]); }
                if (j < 4) {
                    const f32x4 w0 = *(const LAS f32x4*)(cwl + j * 256 + cc0), w1 = *(const LAS f32x4*)(cwl + j * 256 + cc0 + 4);
#pragma unroll
                    for (int e = 0; e < 8; ++e) y0[e] += (e < 4 ? w0[e & 3] : w1[e & 3]) * xr[e];
                }
                if (j > 0) {
                    const f32x4 w0 = *(const LAS f32x4*)(cwl + (j - 1) * 256 + cc0), w1 = *(const LAS f32x4*)(cwl + (j - 1) * 256 + cc0 + 4);
#pragma unroll
                    for (int e = 0; e < 8; ++e) y1[e] += (e < 4 ? w0[e & 3] : w1[e & 3]) * xr[e];
                }
            }
        }
        const float sc = isk ? 0.08838834764831845f : 1.f;
#pragma unroll
        for (int e = 0; e < 8; ++e) { y0[e] = y0[e] * sigmoid_(y0[e]) * sc; y1[e] = y1[e] * sigmoid_(y1[e]) * sc; }
        bf16_t* dst = (isk ? KC : QC) + (size_t)(t0 + s) * 512 + h * 128 + cgp;
        u32x4 w; w.x = cvt_pk_bf16(y0[0], y0[1]); w.y = cvt_pk_bf16(y0[2], y0[3]); w.z = cvt_pk_bf16(y0[4], y0[5]); w.w = cvt_pk_bf16(y0[6], y0[7]);
        *(u32x4*)dst = w;
        w.x = cvt_pk_bf16(y1[0], y1[1]); w.y = cvt_pk_bf16(y1[2], y1[3]); w.z = cvt_pk_bf16(y1[4], y1[5]); w.w = cvt_pk_bf16(y1[6], y1[7]);
        *(u32x4*)(dst + 512) = w;
        if (isk) {
            const float w0 = wsv[s], w1 = wsv[s + 1];
#pragma unroll
            for (int e = 0; e < 8; ++e) *(LAS unsigned*)(KT + (cgp + e) * 272 + lane * 4) = cvt_pk_bf16(y0[e] * w0, y1[e] * w1);
        }
    }
    stage_T<4>(P + p_off<3072, 4, 256>(t0, h, 0), 256, VT, wave, lane);
    for (int i = tid; i < 1024; i += NTHREADS) { const int r = i >> 6, w = i & 63; *(LAS unsigned*)(VT + (256 + r) * 272 + w * 4) = 0x3F803F80u; }
    __syncthreads();
    bf16x8 af[4];
#pragma unroll
    for (int kk = 0; kk < 4; ++kk) af[kk] = ld_frag_lds(KT + (16 * wave + fr) * 272 + (32 * kk + 8 * fq) * 2);
    float* ST = (float*)(p.ws + WS_ST) + ((size_t)(bh * 64 + c) * 272) * 128;
#pragma unroll
    for (int n = 0; n < 17; ++n) {
        f32x4 acc = {0.f, 0.f, 0.f, 0.f};
#pragma unroll
        for (int kk = 0; kk < 4; ++kk) { const bf16x8 bfr = ld_frag_lds(VT + (16 * n + fr) * 272 + (32 * kk + 8 * fq) * 2); acc = MFMA16(af[kk], bfr, acc); }
        if (n < 16 || fr == 0) *(f32x4*)(ST + (size_t)(16 * n + fr) * 128 + 16 * wave + 4 * fq) = acc;
    }
}

DI void phase_scan(const Params& p) {
    const float* ST = (const float*)(p.ws + WS_ST); bf16_t* CPT = (bf16_t*)(p.ws + WS_CPT);
    const float* BEND = (const float*)(p.ws + WS_BEND); const float* GMAX = (const float*)(p.ws + WS_GMAX); float* MPREV = (float*)(p.ws + WS_MPREV);
    const int gtid = blockIdx.x * NTHREADS + threadIdx.x, nthr = gridDim.x * NTHREADS;
    constexpr int PER = 8224;
    constexpr size_t CST = 272 * 128;
    for (int item = gtid; item < 16 * PER; item += nthr) {
        const int bh = item / PER, e4 = item - bh * PER;
        const float* src = ST + (size_t)bh * 64 * CST + (size_t)e4 * 4;
        bf16_t* dst = CPT + (size_t)bh * 64 * CST + (size_t)e4 * 4;
        f32x4 st = {0.f, 0.f, 0.f, 0.f}; float m = 0.f;
        for (int c0 = 0; c0 < 64; c0 += 8) {
            f32x4 d[8];
#pragma unroll
            for (int j = 0; j < 8; ++j) d[j] = *(const f32x4*)(src + (size_t)(c0 + j) * CST);
#pragma unroll
            for (int j = 0; j < 8; ++j) {
                const int c = c0 + j;
                const float be = BEND[bh * 64 + c], gm = GMAX[bh * 64 + c];
                const float mn = fmaxf(be + m, gm), a = __expf(be + m - mn), sc = __expf(gm - mn);
                u32x2 w; w.x = cvt_pk_bf16(st[0], st[1]); w.y = cvt_pk_bf16(st[2], st[3]);
                *(u32x2*)(dst + (size_t)c * CST) = w;
                if (e4 == 0) MPREV[bh * 64 + c] = m;
                st = st * a + d[j] * sc; m = mn;
            }
        }
    }
}

DI void mlstm_out(const Params& p, LAS unsigned char* lds, int b, int c, int h) {
    const int tid = threadIdx.x, lane = tid & 63, wave = __builtin_amdgcn_readfirstlane(tid >> 6), fr = lane & 15, fq = lane >> 4;
    const int bh = b * 4 + h, t0 = b * 8192 + c * 128;
    LAS unsigned char* Kl = lds; LAS unsigned char* Sl = lds + 34816; LAS unsigned char* VTe = lds + 69632;
    LAS float* av = (LAS float*)(lds + 143616); LAS float* Mv = (LAS float*)(lds + 144128); LAS float* bv = (LAS float*)(lds + 144640);
    const bf16_t* P = (const bf16_t*)(p.ws + WS_P); bf16_t* YM = (bf16_t*)(p.ws + WS_XN);
    const bf16_t* QC = (const bf16_t*)(p.ws + WS_QC); const bf16_t* KC = (const bf16_t*)(p.ws + WS_KC);
    const float* IG = (const float*)(p.ws + WS_IG); const float* LF = (const float*)(p.ws + WS_LF);
    const float mprev = ((const float*)(p.ws + WS_MPREV))[bh * 64 + c];
    __syncthreads();
    if (wave == 0) {
        const float l0 = LF[(size_t)(t0 + 2 * lane) * 4 + h], l1 = LF[(size_t)(t0 + 2 * lane + 1) * 4 + h];
        const float i0 = IG[(size_t)(t0 + 2 * lane) * 4 + h], i1 = IG[(size_t)(t0 + 2 * lane + 1) * 4 + h];
        float s = l0 + l1;
#pragma unroll
        for (int off = 1; off < 64; off <<= 1) { const float tt = __shfl_up(s, off); if (lane >= off) s += tt; }
        const float b1 = s, b0 = s - l1;
        const float a0 = i0 - b0, a1 = i1 - b1;
        float pm = fmaxf(a0, a1);
#pragma unroll
        for (int off = 1; off < 64; off <<= 1) { const float tt = __shfl_up(pm, off); if (lane >= off) pm = fmaxf(pm, tt); }
        float ex = __shfl_up(pm, 1); if (lane == 0) ex = -3.0e38f;
        Mv[2 * lane] = fmaxf(mprev, fmaxf(ex, a0)); Mv[2 * lane + 1] = fmaxf(mprev, pm);
        av[2 * lane] = a0; av[2 * lane + 1] = a1; bv[2 * lane] = b0; bv[2 * lane + 1] = b1;
    }
#pragma unroll
    for (int it = 0; it < 4; ++it) {
        const int e = (it * NTHREADS + tid) * 8, s = e >> 7, d0 = e & 127;
        *(LAS u32x4*)(Kl + s * 272 + d0 * 2) = *(const u32x4*)(KC + (size_t)(t0 + s) * 512 + h * 128 + d0);
    }
    stage_T<4>(P + p_off<3072, 4, 256>(t0, h, 0), 256, VTe, wave, lane);
    for (int i = tid; i < 1024; i += NTHREADS) { const int r = i >> 6, w = i & 63; *(LAS unsigned*)(VTe + (256 + r) * 272 + w * 4) = 0x3F803F80u; }
    bf16x8 qf[4];
#pragma unroll
    for (int kk = 0; kk < 4; ++kk) qf[kk] = *(const bf16x8*)(QC + (size_t)(t0 + 16 * wave + fr) * 512 + h * 128 + 32 * kk + 8 * fq);
    __syncthreads();
    const int t = 16 * wave + fr; const float Mt = Mv[t];
    const int stmax = wave | 1;
    for (int st = 0; st <= stmax; ++st) {
        f32x4 s4 = {0.f, 0.f, 0.f, 0.f};
#pragma unroll
        for (int kk = 0; kk < 4; ++kk) { const bf16x8 kf = ld_frag_lds(Kl + (16 * st + fr) * 272 + (32 * kk + 8 * fq) * 2); s4 = MFMA16(kf, qf[kk], s4); }
#pragma unroll
        for (int r = 0; r < 4; ++r) { const int s = 16 * st + 4 * fq + r; const float w = (s <= t) ? __expf(av[s] - Mt) : 0.f; s4[r] *= w; }
        u32x2 w; w.x = cvt_pk_bf16(s4[0], s4[1]); w.y = cvt_pk_bf16(s4[2], s4[3]);
        *(LAS u32x2*)(Sl + t * 272 + (16 * st + 4 * fq) * 2) = w;
    }
    __syncthreads();
    const bf16_t* cpt = (const bf16_t*)(p.ws + WS_CPT) + ((size_t)(bh * 64 + c) * 272) * 128;
    f32x4 acc[17];
#pragma unroll
    for (int n = 0; n < 17; ++n) {
        acc[n] = (f32x4){0.f, 0.f, 0.f, 0.f};
#pragma unroll
        for (int kk = 0; kk < 4; ++kk) { const bf16x8 cf = *(const bf16x8*)(cpt + (size_t)(16 * n + fr) * 128 + 32 * kk + 8 * fq); acc[n] = MFMA16(cf, qf[kk], acc[n]); }
    }
    const float ai = __expf(mprev - Mt);
#pragma unroll
    for (int n = 0; n < 17; ++n) acc[n] = acc[n] * ai;
    const int k2max = (16 * wave + 15) >> 5;
#pragma unroll
    for (int kk = 0; kk < 4; ++kk) {
        if (kk <= k2max) {
            const bf16x8 sf = ld_frag_lds(Sl + t * 272 + (32 * kk + 8 * fq) * 2);
#pragma unroll
            for (int n = 0; n < 17; ++n) { const bf16x8 vf = ld_frag_lds(VTe + (16 * n + fr) * 272 + (32 * kk + 8 * fq) * 2); acc[n] = MFMA16(vf, sf, acc[n]); }
        }
    }
    const float den = __shfl(acc[16][0], fr);
    const float mt = bv[t] + Mt;
    const float inv = rcpf_(fmaxf(fabsf(den), __expf(-mt)));
    const size_t grow = (size_t)(t0 + t);
    float ss = 0.f;
#pragma unroll
    for (int n = 0; n < 16; ++n) {
        const int v0 = 16 * n + 4 * fq;
        const u32x2 ow = *(const u32x2*)(P + p_off<4096, 4, 256>(t0 + t, h, v0));
        f32x4 y;
        y[0] = bflo(ow.x) * acc[n][0] * inv; y[1] = bfhi(ow.x) * acc[n][1] * inv; y[2] = bflo(ow.y) * acc[n][2] * inv; y[3] = bfhi(ow.y) * acc[n][3] * inv;
        ss += (y[0] * y[0] + y[1] * y[1]) + (y[2] * y[2] + y[3] * y[3]);
        acc[n] = y;
    }
    ss += __shfl_xor(ss, 16); ss += __shfl_xor(ss, 32);
    const float rstd = rsqrtf(ss * (1.f / 256.f) + EPS);
#pragma unroll
    for (int n = 0; n < 16; ++n) {
        const int v0 = 16 * n + 4 * fq;
        const f32x4 g = *(const f32x4*)(p.ml_out_g + h * 256 + v0);
        const f32x4 o = acc[n] * rstd * g;
        u32x2 w; w.x = cvt_pk_bf16(o[0], o[1]); w.y = cvt_pk_bf16(o[2], o[3]);
        *(u32x2*)(YM + grow * DM + 1024 + h * 256 + v0) = w;
    }
}

DI unsigned ord_key(float f) { const unsigned u = __float_as_uint(f); return (u & 0x80000000u) ? ~u : (u | 0x80000000u); }
DI float key_val(unsigned k) { return (k & 0x80000000u) ? __uint_as_float(k & 0x7fffffffu) : __uint_as_float(~k); }
DI unsigned umax_(unsigned a, unsigned b) { return a > b ? a : b; }
DI unsigned umin_(unsigned a, unsigned b) { return a < b ? a : b; }
#define DPPU(v, ctrl) ((unsigned)__builtin_amdgcn_update_dpp(0, (int)(v), (ctrl), 0xF, 0xF, true))
DI unsigned row_max_u32(unsigned v) {
    v = umax_(v, DPPU(v, 0xB1)); v = umax_(v, DPPU(v, 0x4E)); v = umax_(v, DPPU(v, 0x141)); v = umax_(v, DPPU(v, 0x140)); return v;
}
DI float row_sum_f32(float v) {
    v += __uint_as_float(DPPU(__float_as_uint(v), 0xB1)); v += __uint_as_float(DPPU(__float_as_uint(v), 0x4E));
    v += __uint_as_float(DPPU(__float_as_uint(v), 0x141)); v += __uint_as_float(DPPU(__float_as_uint(v), 0x140)); return v;
}
#define CEX(a, b) do { const unsigned mx_ = umax_(a, b), mn_ = umin_(a, b); a = mx_; b = mn_; } while (0)
template <int N> DI unsigned top16_row(unsigned (&s)[N], int c) {
    unsigned list = 0u;
#pragma unroll 1
    for (int it = 0; it < 16; ++it) {
        const unsigned wm = row_max_u32(s[0]);
        const bool win = (s[0] == wm);
#pragma unroll
        for (int i = 0; i < N - 1; ++i) s[i] = win ? s[i + 1] : s[i];
        s[N - 1] = win ? 0u : s[N - 1];
        list = (c == it) ? wm : list;
    }
    return list;
}

template <int N> DI void top16_row2(unsigned (&s)[N], unsigned (&t)[N], int c, unsigned& l1, unsigned& l2) {
    l1 = 0u; l2 = 0u;
#pragma unroll 1
    for (int it = 0; it < 16; ++it) {
        const unsigned wm1 = row_max_u32(s[0]), wm2 = row_max_u32(t[0]);
        const bool win1 = (s[0] == wm1), win2 = (t[0] == wm2);
#pragma unroll
        for (int i = 0; i < N - 1; ++i) { s[i] = win1 ? s[i + 1] : s[i]; t[i] = win2 ? t[i + 1] : t[i]; }
        s[N - 1] = win1 ? 0u : s[N - 1]; t[N - 1] = win2 ? 0u : t[N - 1];
        l1 = (c == it) ? wm1 : l1; l2 = (c == it) ? wm2 : l2;
    }
}

template <int N> DI void top16_row4(unsigned (&s)[N], unsigned (&t)[N], unsigned (&u)[N], unsigned (&v)[N], int c, unsigned& l1, unsigned& l2, unsigned& l3, unsigned& l4) {
    l1 = 0u; l2 = 0u; l3 = 0u; l4 = 0u;
#pragma unroll 1
    for (int it = 0; it < 16; ++it) {
        const unsigned wm1 = row_max_u32(s[0]), wm2 = row_max_u32(t[0]), wm3 = row_max_u32(u[0]), wm4 = row_max_u32(v[0]);
        const bool win1 = (s[0] == wm1), win2 = (t[0] == wm2), win3 = (u[0] == wm3), win4 = (v[0] == wm4);
#pragma unroll
        for (int i = 0; i < N - 1; ++i) { s[i] = win1 ? s[i + 1] : s[i]; t[i] = win2 ? t[i + 1] : t[i]; u[i] = win3 ? u[i + 1] : u[i]; v[i] = win4 ? v[i + 1] : v[i]; }
        s[N - 1] = win1 ? 0u : s[N - 1]; t[N - 1] = win2 ? 0u : t[N - 1]; u[N - 1] = win3 ? 0u : u[N - 1]; v[N - 1] = win4 ? 0u : v[N - 1];
        l1 = (c == it) ? wm1 : l1; l2 = (c == it) ? wm2 : l2; l3 = (c == it) ? wm3 : l3; l4 = (c == it) ? wm4 : l4;
    }
}
#define SORT8(s) do { CEX(s[0], s[1]); CEX(s[2], s[3]); CEX(s[4], s[5]); CEX(s[6], s[7]); CEX(s[0], s[2]); CEX(s[1], s[3]); CEX(s[4], s[6]); CEX(s[5], s[7]); CEX(s[1], s[2]); CEX(s[5], s[6]); \
    CEX(s[0], s[4]); CEX(s[1], s[5]); CEX(s[2], s[6]); CEX(s[3], s[7]); CEX(s[2], s[4]); CEX(s[3], s[5]); CEX(s[1], s[2]); CEX(s[3], s[4]); CEX(s[5], s[6]); } while (0)
#define SORT4(s) do { CEX(s[0], s[1]); CEX(s[2], s[3]); CEX(s[0], s[2]); CEX(s[1], s[3]); CEX(s[1], s[2]); } while (0)

DI void peer_select(const Params& p) {
    const int tid = threadIdx.x, lane = tid & 63, wave = __builtin_amdgcn_readfirstlane(tid >> 6), c = lane & 15, g = lane >> 4, rowbase = lane & 48;
    const bf16_t* Q = (const bf16_t*)(p.ws + WS_Q); const bf16_t* KB1 = (const bf16_t*)(p.ws + WS_KB1); const bf16_t* KB2 = (const bf16_t*)(p.ws + WS_KB2);
    int* SELID = (int*)(p.ws + WS_SELID); float* SELG = (float*)(p.ws + WS_SELG);
    unsigned pk = 0u, validmask = 0u;
#pragma unroll
    for (int q = 0; q < 4; ++q) {
        const int target = 4 * c + q; int ci = 0, cj = 0, cnt = 0; bool v = false;
#pragma unroll
        for (int i = 0; i < 16; ++i) { const int nj = 16 / (i + 1); if (target >= cnt && target < cnt + nj) { ci = i; cj = target - cnt; v = true; } cnt += nj; }
        pk |= (unsigned)((ci << 4) | cj) << (8 * q); validmask |= (v ? 1u : 0u) << q;
    }
    for (int tile = blockIdx.x * 8 + wave; tile < T_TOK / 16; tile += gridDim.x * 8) {
        const int tok0 = tile * 16;
        for (int h = 0; h < 8; ++h) {
            bf16x8 a1[2], a2[2];
            {
                const bf16_t* qp = Q + (size_t)(tok0 + c) * 1024 + h * 128 + g * 8;
                a1[0] = *(const bf16x8*)qp; a1[1] = *(const bf16x8*)(qp + 32); a2[0] = *(const bf16x8*)(qp + 64); a2[1] = *(const bf16x8*)(qp + 96);
            }
            f32x4 acc1[8], acc2[8];
#pragma unroll
            for (int nt = 0; nt < 8; ++nt) {
                const size_t ko = ((size_t)(h * 128 + nt * 16 + c)) * 64 + g * 8;
                acc1[nt] = (f32x4){0.f, 0.f, 0.f, 0.f}; acc2[nt] = (f32x4){0.f, 0.f, 0.f, 0.f};
                acc1[nt] = MFMA16(a1[0], *(const bf16x8*)(KB1 + ko), acc1[nt]); acc1[nt] = MFMA16(a1[1], *(const bf16x8*)(KB1 + ko + 32), acc1[nt]);
                acc2[nt] = MFMA16(a2[0], *(const bf16x8*)(KB2 + ko), acc2[nt]); acc2[nt] = MFMA16(a2[1], *(const bf16x8*)(KB2 + ko + 32), acc2[nt]);
            }
#pragma unroll
            for (int rp = 0; rp < 2; ++rp) {
                const int r0 = 2 * rp, r1 = 2 * rp + 1;
                unsigned sA[8], sB[8], sC[8], sD[8];
#pragma unroll
                for (int nt = 0; nt < 8; ++nt) {
                    const unsigned ix = (unsigned)(127 - (nt * 16 + c));
                    sA[nt] = (ord_key(acc1[nt][r0]) & ~0x7Fu) | ix; sB[nt] = (ord_key(acc2[nt][r0]) & ~0x7Fu) | ix;
                    sC[nt] = (ord_key(acc1[nt][r1]) & ~0x7Fu) | ix; sD[nt] = (ord_key(acc2[nt][r1]) & ~0x7Fu) | ix;
                }
                SORT8(sA); SORT8(sB); SORT8(sC); SORT8(sD);
                unsigned lA, lB, lC, lD;
                top16_row4<8>(sA, sB, sC, sD, c, lA, lB, lC, lD);
                unsigned c0[4], c1[4];
#pragma unroll
                for (int q = 0; q < 4; ++q) {
                    const int ci = (int)((pk >> (8 * q + 4)) & 15u), cj = (int)((pk >> (8 * q)) & 15u);
                    const unsigned ka = (unsigned)__shfl((int)lA, rowbase + ci), kb = (unsigned)__shfl((int)lB, rowbase + cj);
                    const unsigned kc = (unsigned)__shfl((int)lC, rowbase + ci), kd = (unsigned)__shfl((int)lD, rowbase + cj);
                    const float cand0 = key_val(ka & ~0x7Fu) + key_val(kb & ~0x7Fu), cand1 = key_val(kc & ~0x7Fu) + key_val(kd & ~0x7Fu);
                    const bool ok = ((validmask >> q) & 1u) != 0u; const unsigned ix = (unsigned)(63 - (4 * c + q));
                    c0[q] = ok ? ((ord_key(cand0) & ~0x3Fu) | ix) : 0u; c1[q] = ok ? ((ord_key(cand1) & ~0x3Fu) | ix) : 0u;
                }
                SORT4(c0); SORT4(c1);
                unsigned sel0, sel1;
                top16_row2<4>(c0, c1, c, sel0, sel1);
#pragma unroll
                for (int u = 0; u < 2; ++u) {
                    const unsigned sel = u ? sel1 : sel0, list1 = u ? lC : lA, list2 = u ? lD : lB; const int r = u ? r1 : r0;
                    const int slot = 63 - (int)(sel & 63u);
                    const unsigned pkv = (unsigned)__shfl((int)pk, rowbase + (slot >> 2));
                    const int cij = (int)((pkv >> (8 * (slot & 3))) & 0xFFu);
                    const unsigned e1 = (unsigned)__shfl((int)list1, rowbase + (cij >> 4)), e2 = (unsigned)__shfl((int)list2, rowbase + (cij & 15));
                    const int eid = (127 - (int)(e1 & 127u)) * 128 + (127 - (int)(e2 & 127u));
                    const float sv = key_val(sel & ~0x3Fu), mx = key_val(row_max_u32(sel) & ~0x3Fu);
                    const float ev = __expf(sv - mx);
                    const float sum = row_sum_f32(ev);
                    const size_t o = (size_t)(tok0 + 4 * g + r) * 128 + h * 16 + c;
                    SELID[o] = eid; SELG[o] = ev * rcpf_(sum);
                }
            }
        }
    }
}

DI f32x2 pkfma(f32x2 a, f32x2 b, f32x2 c) { return __builtin_elementwise_fma(a, b, c); }
DI void peer_gather(const Params& p, LAS unsigned char* lds) {
    const int tid = threadIdx.x, lane = tid & 63, wave = __builtin_amdgcn_readfirstlane(tid >> 6);
    LAS float* scr = (LAS float*)lds + wave * (16 * 68);
    LAS float* cfl = (LAS float*)(lds + 8 * 16 * 68 * 4) + wave * 128;
    const unsigned char* Ub = p.ws + WS_UB; const unsigned char* Vb = p.ws + WS_VB;
    const float* PSS2 = (const float*)(p.ws + WS_PSS2);
    const int* SELID = (const int*)(p.ws + WS_SELID); const float* SELG = (const float*)(p.ws + WS_SELG);
    const int gw = blockIdx.x * 8 + wave, nw = gridDim.x * 8;
    for (int t = gw; t < T_TOK; t += nw) {
        const int idA = SELID[(size_t)t * 128 + lane], idB = SELID[(size_t)t * 128 + 64 + lane];
        const float gA = SELG[(size_t)t * 128 + lane], gB = SELG[(size_t)t * 128 + 64 + lane];
        const bf16_t* xrow = (const bf16_t*)(p.ws + WS_X1G) + (size_t)t * DM + lane * 32;
        float* orow = p.out + (size_t)t * DM + lane * 32;
        const float pv = lane < 32 ? PSS2[(size_t)t * 32 + lane] : 0.f;
        const float rstd2 = rsqrtf(wave_sum(pv) * (1.f / 2048.f) + EPS);
        f32x2 h2[16];
#pragma unroll
        for (int q = 0; q < 4; ++q) {
            const u32x4 xw = *(const u32x4*)(xrow + q * 8);
            const f32x4 g0 = *(const f32x4*)(p.norm2_g + lane * 32 + q * 8), g1 = *(const f32x4*)(p.norm2_g + lane * 32 + q * 8 + 4);
            h2[4 * q] = (f32x2){bflo(xw.x) * rstd2 * g0[0], bfhi(xw.x) * rstd2 * g0[1]};
            h2[4 * q + 1] = (f32x2){bflo(xw.y) * rstd2 * g0[2], bfhi(xw.y) * rstd2 * g0[3]};
            h2[4 * q + 2] = (f32x2){bflo(xw.z) * rstd2 * g1[0], bfhi(xw.z) * rstd2 * g1[1]};
            h2[4 * q + 3] = (f32x2){bflo(xw.w) * rstd2 * g1[2], bfhi(xw.w) * rstd2 * g1[3]};
        }
        constexpr int NPK = 8;
        u32x4 buf[2][NPK]; unsigned short bsc[2][NPK];
#define PEER_LOAD(TB, st, base) do { const int idv_ = ((base) < 64) ? idA : idB; _Pragma("unroll") for (int e_ = 0; e_ < NPK; ++e_) { \
            const int id_ = __builtin_amdgcn_readlane(idv_, ((base) + e_) & 63); const unsigned char* r_ = (TB) + (size_t)id_ * 1088; \
            buf[st][e_] = *(const u32x4*)(r_ + lane * 16); bsc[st][e_] = *(const unsigned short*)(r_ + 1024 + (lane >> 1) * 2); } } while (0)
#define PEER_DOT(st, slot0) do { _Pragma("unroll") for (int e_ = 0; e_ < NPK; ++e_) { f32x2 a2_ = {0.f, 0.f}; \
            _Pragma("unroll") for (int d_ = 0; d_ < 4; ++d_) { const unsigned w_ = buf[st][e_][d_]; \
                a2_ = pkfma(h2[d_ * 4 + 0], __builtin_amdgcn_cvt_scalef32_pk_f32_fp4(w_, 1.0f, 0), a2_); a2_ = pkfma(h2[d_ * 4 + 1], __builtin_amdgcn_cvt_scalef32_pk_f32_fp4(w_, 1.0f, 1), a2_); \
                a2_ = pkfma(h2[d_ * 4 + 2], __builtin_amdgcn_cvt_scalef32_pk_f32_fp4(w_, 1.0f, 2), a2_); a2_ = pkfma(h2[d_ * 4 + 3], __builtin_amdgcn_cvt_scalef32_pk_f32_fp4(w_, 1.0f, 3), a2_); } \
            scr[((slot0) + e_) * 68 + lane] = (a2_[0] + a2_[1]) * bf2f(bsc[st][e_]); } } while (0)
        PEER_LOAD(Ub, 0, 0);
        for (int b = 0; b < 128 / NPK; b += 2) {
            PEER_LOAD(Ub, 1, (b + 1) * NPK);
            PEER_DOT(0, (b * NPK) & 15);
            if (b + 2 < 128 / NPK) PEER_LOAD(Ub, 0, (b + 2) * NPK);
            PEER_DOT(1, ((b + 1) * NPK) & 15);
            if ((((b + 2) * NPK) & 15) == 0) {
                WAVE_LDS_SYNC();
                float sum = 0.f;
#pragma unroll
                for (int i = 0; i < 4; ++i) { const f32x4 r = *(const LAS f32x4*)(scr + (lane >> 2) * 68 + (lane & 3) * 16 + 4 * i); sum += (r[0] + r[1]) + (r[2] + r[3]); }
                sum += __shfl_xor(sum, 1); sum += __shfl_xor(sum, 2);
                const int k0 = (b + 2) * NPK - 16;
                const int k = k0 + (lane >> 2);
                const float gate = __shfl((k0 < 64) ? gA : gB, k & 63);
                if ((lane & 3) == 0) cfl[k] = gate * gelu_t(sum);
                WAVE_LDS_SYNC();
            }
        }
        f32x2 acc[16];
#pragma unroll
        for (int i = 0; i < 16; ++i) acc[i] = (f32x2){0.f, 0.f};
#define PEER_AXPY(st, base) do { _Pragma("unroll") for (int e_ = 0; e_ < NPK; ++e_) { const float c_ = cfl[(base) + e_] * bf2f(bsc[st][e_]); const f32x2 c2_ = {c_, c_}; \
            _Pragma("unroll") for (int d_ = 0; d_ < 4; ++d_) { const unsigned w_ = buf[st][e_][d_]; \
                acc[d_ * 4 + 0] = pkfma(c2_, __builtin_amdgcn_cvt_scalef32_pk_f32_fp4(w_, 1.0f, 0), acc[d_ * 4 + 0]); acc[d_ * 4 + 1] = pkfma(c2_, __builtin_amdgcn_cvt_scalef32_pk_f32_fp4(w_, 1.0f, 1), acc[d_ * 4 + 1]); \
                acc[d_ * 4 + 2] = pkfma(c2_, __builtin_amdgcn_cvt_scalef32_pk_f32_fp4(w_, 1.0f, 2), acc[d_ * 4 + 2]); acc[d_ * 4 + 3] = pkfma(c2_, __builtin_amdgcn_cvt_scalef32_pk_f32_fp4(w_, 1.0f, 3), acc[d_ * 4 + 3]); } } } while (0)
        PEER_LOAD(Vb, 0, 0);
        for (int b = 0; b < 128 / NPK; b += 2) {
            PEER_LOAD(Vb, 1, (b + 1) * NPK);
            PEER_AXPY(0, b * NPK);
            if (b + 2 < 128 / NPK) PEER_LOAD(Vb, 0, (b + 2) * NPK);
            PEER_AXPY(1, (b + 1) * NPK);
        }
        float ss = 0.f;
#pragma unroll
        for (int q = 0; q < 4; ++q) {
            const u32x4 xw = *(const u32x4*)(xrow + q * 8);
            acc[4 * q] += (f32x2){bflo(xw.x), bfhi(xw.x)}; acc[4 * q + 1] += (f32x2){bflo(xw.y), bfhi(xw.y)};
            acc[4 * q + 2] += (f32x2){bflo(xw.z), bfhi(xw.z)}; acc[4 * q + 3] += (f32x2){bflo(xw.w), bfhi(xw.w)};
#pragma unroll
            for (int i = 0; i < 4; ++i) { const f32x2 a = acc[4 * q + i]; ss += a[0] * a[0] + a[1] * a[1]; }
        }
        const float rstd = rsqrtf(wave_sum(ss) * (1.f / 2048.f) + EPS);
#pragma unroll
        for (int q = 0; q < 8; ++q) {
            const f32x4 g0 = *(const f32x4*)(p.final_g + lane * 32 + q * 4);
            const f32x2 a = acc[2 * q], b = acc[2 * q + 1];
            const f32x4 o0 = {a[0] * rstd * g0[0], a[1] * rstd * g0[1], b[0] * rstd * g0[2], b[1] * rstd * g0[3]};
            *(f32x4*)(orow + q * 4) = o0;
        }
        WAVE_LDS_SYNC();
    }
}

#define XB_TMO      128
#define XB_XCNT(j)  (256  + 64 * (j))
#define XB_XSUB(j)  (1280 + 64 * (j))
#define XB_XGEN(j)  (2304 + 64 * (j))
#define XB_TOP      3328
#define XB_TOPGEN   3392
#define XCD_BAR_WORDS 3456
#define XB_SPIN_CAP (1u << 18)

__device__ __forceinline__ unsigned xb_ld(unsigned* p)              { return __hip_atomic_load(p, __ATOMIC_RELAXED, __HIP_MEMORY_SCOPE_AGENT); }
__device__ __forceinline__ unsigned xb_add(unsigned* p, unsigned v) { return __hip_atomic_fetch_add(p, v, __ATOMIC_RELAXED, __HIP_MEMORY_SCOPE_AGENT); }
__device__ __forceinline__ unsigned xb_xcc_id() { return (unsigned)__builtin_amdgcn_s_getreg((3 << 11) | 20) & 0xFu; }
#define XB_SPIN(cond, bar) do { unsigned _sp = 0; while (cond) { __builtin_amdgcn_s_sleep(1); \
    if ((++_sp & 255u) == 0u) { if (xb_ld(&(bar)[XB_TMO])) break; if (_sp > XB_SPIN_CAP) { atomicAdd(&(bar)[XB_TMO], 1u); break; } } } } while (0)

struct XcdBarrier {
    unsigned* bar; unsigned x;
    volatile LAS unsigned* st;
};

__device__ __forceinline__ XcdBarrier xcd_barrier_post(unsigned* bar, volatile LAS unsigned* st) {
    XcdBarrier b; b.bar = bar; b.x = xb_xcc_id(); b.st = st;
    if (threadIdx.x == 0) (void)xb_add(&bar[XB_XCNT(b.x)], 1u);
    return b;
}
__device__ __forceinline__ void xcd_barrier_complete(unsigned* bar, unsigned x, unsigned& nloc, unsigned& nx) {
    const unsigned G = gridDim.x * gridDim.y * gridDim.z;
    unsigned sum, cnt, mine, sp = 0u;
    for (;;) {
        sum = 0u; cnt = 0u; mine = 0u;
#pragma unroll
        for (unsigned j = 0; j < 16; ++j) { const unsigned c = xb_ld(&bar[XB_XCNT(j)]); sum += c; cnt += (c > 0u) ? 1u : 0u; mine = (j == x) ? c : mine; }
        if (sum == G) break;
        __builtin_amdgcn_s_sleep(1);
        if ((++sp & 255u) == 0u) { if (xb_ld(&bar[XB_TMO])) break; if (sp > XB_SPIN_CAP) { atomicAdd(&bar[XB_TMO], 1u); break; } }
    }
    nloc = mine > 0u ? mine : 1u; nx = cnt > 0u ? cnt : 1u;
}

__device__ __forceinline__ void xcd_barrier(const XcdBarrier& b) {
    asm volatile("s_waitcnt vmcnt(0)" ::: "memory");
    __syncthreads();
    if (threadIdx.x == 0) {
        unsigned* bar = b.bar;
        __builtin_amdgcn_s_waitcnt(0);
        unsigned nloc = b.st[0], nx = b.st[1];
        if (nloc == 0u) { xcd_barrier_complete(bar, b.x, nloc, nx); b.st[0] = nloc; b.st[1] = nx; }
        const unsigned old = xb_add(&bar[XB_XSUB(b.x)], 1u);
        const unsigned gen = old / nloc;
        if (old + 1u == (gen + 1u) * nloc) {
            __builtin_amdgcn_fence(__ATOMIC_RELEASE, "agent");
            asm volatile("s_waitcnt vmcnt(0)" ::: "memory");
            const unsigned og = xb_add(&bar[XB_TOP], 1u);
            const unsigned tg = og / nx;
            if (og + 1u == (tg + 1u) * nx) xb_add(&bar[XB_TOPGEN], 1u);
            else XB_SPIN(xb_ld(&bar[XB_TOPGEN]) == tg, bar);
            __builtin_amdgcn_fence(__ATOMIC_ACQUIRE, "agent");
            xb_add(&bar[XB_XGEN(b.x)], 1u);
            asm volatile("s_waitcnt vmcnt(0)" ::: "memory");
        } else {
            XB_SPIN(xb_ld(&bar[XB_XGEN(b.x)]) == gen, bar);
            __builtin_amdgcn_fence(__ATOMIC_ACQUIRE, "agent");
            asm volatile("s_waitcnt vmcnt(0)" ::: "memory");
        }
    }
    __syncthreads();
}

#ifndef PROBE_DUP
#define PROBE_DUP 0
#endif
#define REP(bit) for (int rep_ = 0; rep_ < (((PROBE_DUP) >> (bit)) & 1) + 1; ++rep_)
#define PH1() { pg8::Gemm g{(const bf16_t*)(p.ws + WS_XN), (const bf16_t*)(p.ws + WS_WINT), T_TOK, NPROJ, DM}; pg8::StaticOrder S; S.init(T_TOK, NPROJ, G, bx); Epi1 E{(bf16_t*)(p.ws + WS_P), (float*)(p.ws + WS_PSSV)}; pg8::gemm_phase<Epi1, pg8::StaticOrder, true, true>(lds, g, S, E); xcd_barrier(xbar); }
#define PH3() { pg8::Gemm g{(const bf16_t*)(p.ws + WS_XN), (const bf16_t*)(p.ws + WS_WOUTT), T_TOK, DM, DM}; pg8::StaticOrder S; S.init(T_TOK, DM, G, bx); Epi2 E{p.x, (bf16_t*)(p.ws + WS_X1G), (float*)(p.ws + WS_PSS2)}; pg8::gemm_phase<Epi2, pg8::StaticOrder, true, true>(lds, g, S, E); xcd_barrier(xbar); }
#define PH4() { pg8::Gemm g{(const bf16_t*)(p.ws + WS_X1G), (const bf16_t*)(p.ws + WS_WQT), T_TOK, 1024, DM}; pg8::StaticOrder S; S.init(T_TOK, 1024, G, bx); Epi3 E{(bf16_t*)(p.ws + WS_Q), (const float*)(p.ws + WS_PSS2)}; pg8::gemm_phase<Epi3, pg8::StaticOrder, true, true>(lds, g, S, E); xcd_barrier(xbar); }
__global__ void __launch_bounds__(NTHREADS, 2) hymba_fwd(Params p) {
    extern __shared__ __attribute__((aligned(16))) unsigned char smem[];
    LAS unsigned char* lds = (LAS unsigned char*)smem;
    cg::grid_group grid = cg::this_grid();
    const int G = gridDim.x, bx = blockIdx.x;
    unsigned* barw = (unsigned*)(p.ws + WS_BAR);
    volatile LAS unsigned* xst = (volatile LAS unsigned*)(lds + LDS_BYTES - 16);
    if (threadIdx.x < 4) xst[threadIdx.x] = 0u;
    if (bx == 0) { for (int i = threadIdx.x; i < XCD_BAR_WORDS; i += NTHREADS) barw[i] = 0u; }
    __syncthreads();
    REP(0) { phase0(p, lds); grid.sync(); }
    const XcdBarrier xbar = xcd_barrier_post(barw, xst);
    PH1()
#if (PROBE_DUP >> 1) & 1
    PH1()
#endif
    REP(2) {
        for (int si = bx; si < 256; si += G) {
            const int b = si >> 6, c = si & 63;
            gmlp_bc(p, lds, b, c);
            for (int h = 0; h < 4; ++h) mlstm_local(p, lds, b, c, h);
        }
        xcd_barrier(xbar);
    }
    REP(3) { phase_scan(p); xcd_barrier(xbar); }
    REP(4) { for (int it = bx; it < 1024; it += G) mlstm_out(p, lds, it >> 8, (it >> 2) & 63, it & 3); xcd_barrier(xbar); }
    PH3()
#if (PROBE_DUP >> 5) & 1
    PH3()
#endif
    PH4()
#if (PROBE_DUP >> 6) & 1
    PH4()
#endif
    REP(7) { peer_select(p); xcd_barrier(xbar); }
    peer_gather(p, lds);
}

extern "C" void kernel_launch(void* const* d_in, const int* in_sizes, int n_in, void* d_out, int out_size, void* d_ws, size_t ws_size, hipStream_t stream) {
    static int grid_blocks = 0;
    if (grid_blocks == 0) {
        if (n_in != 20 || ws_size < WS_END) { fprintf(stderr, "kernel_launch: unexpected n_in %d or ws_size %zu (need %zu)\n", n_in, ws_size, (size_t)WS_END); grid_blocks = -1; return; }
        int dev = 0, cus = 0, per_cu = 0;
        hipGetDevice(&dev);
        hipDeviceGetAttribute(&cus, hipDeviceAttributeMultiprocessorCount, dev);
        hipFuncSetAttribute((const void*)hymba_fwd, hipFuncAttributeMaxDynamicSharedMemorySize, LDS_BYTES);
        hipOccupancyMaxActiveBlocksPerMultiprocessor(&per_cu, (const void*)hymba_fwd, NTHREADS, LDS_BYTES);
        if (per_cu < 1) { fprintf(stderr, "kernel_launch: occupancy query says %d blocks per CU\n", per_cu); per_cu = 1; }
        if (per_cu > 1) per_cu = 1;
        grid_blocks = cus * per_cu;
        (void)hipGetLastError();
    }
    if (grid_blocks < 0) return;
    Params p{};
    p.x = (const float*)d_in[0]; p.norm1_g = (const float*)d_in[1]; p.w_in = (const float*)d_in[2]; p.gm_vnorm_g = (const float*)d_in[3];
    p.w_spatial = (const float*)d_in[4]; p.b_spatial = (const float*)d_in[5]; p.ml_conv_w = (const float*)d_in[6]; p.ml_conv_b = (const float*)d_in[7];
    p.ml_b_i = (const float*)d_in[8]; p.ml_b_f = (const float*)d_in[9]; p.gm_out_g = (const float*)d_in[10]; p.ml_out_g = (const float*)d_in[11];
    p.w_out = (const float*)d_in[12]; p.norm2_g = (const float*)d_in[13]; p.peer_wq = (const float*)d_in[14]; p.peer_k1 = (const float*)d_in[15];
    p.peer_k2 = (const float*)d_in[16]; p.peer_u = (const float*)d_in[17]; p.peer_v = (const float*)d_in[18]; p.final_g = (const float*)d_in[19];
    p.out = (float*)d_out; p.ws = (unsigned char*)d_ws;
    void* args[] = {&p};
    hipError_t e = hipLaunchCooperativeKernel((const void*)hymba_fwd, dim3(grid_blocks), dim3(NTHREADS), args, LDS_BYTES, stream);
    if (e != hipSuccess) fprintf(stderr, "cooperative launch failed: %s (grid %d)\n", hipGetErrorString(e), grid_blocks);
}
```

```cpp
#include <hip/hip_runtime.h>
#include <hip/hip_cooperative_groups.h>
#include <cstdio>
#include <cstdint>
namespace cg = cooperative_groups;
namespace pg8 {
#define PG8_LAS __attribute__((address_space(3)))
typedef unsigned short bf16_t;
typedef short bf16x8 __attribute__((ext_vector_type(8)));
typedef float f32x4 __attribute__((ext_vector_type(4)));
typedef unsigned u32x4 __attribute__((ext_vector_type(4)));
constexpr int BM = 256, BK = 64, HALF = 128, HTB = HALF * BK * 2  , STAGE_BYTES = 8 * HTB, NXCD = 8, WGM = 8;

__host__ __device__ __forceinline__ int lds_byte(int r, int c) { const int st = (r >> 4) * 2 + (c >> 5), rr = r & 15, cc = c & 31, ob = rr * 64 + cc * 2; return st * 1024 + (ob ^ (((ob >> 9) & 1) << 5)); }
__host__ __device__ __forceinline__ void stage_rc(int b, int& R, int& C) { const int st = b / 1024, sb = b % 1024, swz = sb ^ (((sb >> 9) & 1) << 5); R = (st >> 1) * 16 + swz / 64; C = (st & 1) * 32 + (swz % 64) / 2; }
__host__ __device__ __forceinline__ int perm32(int rho) { const int n = rho >> 4, i = rho & 15; return 8 * (i >> 2) + 4 * n + (i & 3); }

struct Unit { int pm, pn; };
struct Gemm { const bf16_t* A; const bf16_t* Bt; int M, N, K; };

struct StaticOrder {
    int nM, nN, nwg, G, c;
    __host__ __device__ void init(int M, int N, int G_, int c_) { nM = M / BM; nN = N / BM; nwg = nM * nN; G = G_; c = c_; }
    __host__ __device__ bool next(int i, Unit& u) const {
        const long L = (long)i * G + c; if (L >= nwg) return false;
        int wgid = (int)L; { const int q = nwg / NXCD, r = nwg % NXCD, xcd = wgid % NXCD, off = wgid / NXCD; wgid = (xcd < r ? xcd * (q + 1) : r * (q + 1) + (xcd - r) * q) + off; }
        const int nig = WGM * nN, gid = wgid / nig, fm = gid * WGM, gsz = (nM - fm) < WGM ? (nM - fm) : WGM;
        u.pm = fm + ((wgid % nig) % gsz); u.pn = (wgid % nig) / gsz; return true;
    }
    __device__ __forceinline__ void a_ready(const Unit&) const {}
    __device__ __forceinline__ void done(const Unit&) const {}
};
__device__ __forceinline__ unsigned cvt_pk_bf16(float lo, float hi) { unsigned r; asm volatile("v_cvt_pk_bf16_f32 %0, %1, %2" : "=v"(r) : "v"(lo), "v"(hi)); return r; }
template <class Epi, class Sched, bool ALIGN_EPI = false, bool SP2 = false>
__device__ __forceinline__ void gemm_phase(PG8_LAS unsigned char* lds, const Gemm g, const Sched& S, const Epi& E) {
    const int tid = threadIdx.x, wid = __builtin_amdgcn_readfirstlane(tid >> 6), lane = tid & 63, wr = wid >> 2, wc = wid & 3, fr = lane & 15, fq = lane >> 4;
    const int K = g.K, nt = K / BK;
    unsigned voffA[2], voffB[2];
#pragma unroll
    for (int i = 0; i < 2; ++i) { int R, C; stage_rc(tid * 16 + i * 8192, R, C); const int Rb = Epi::PERM ? ((R & ~31) + perm32(R & 31)) : R;
        voffA[i] = (unsigned)(R * K + C) * 2u; voffB[i] = (unsigned)(Rb * K + C) * 2u; }
    const size_t kstep = (size_t)(BK * 2);
    const size_t hstep = (size_t)HALF * K * 2;
    const size_t tstep = 2 * hstep;
    const unsigned ldsw = (unsigned)wid * 1024u;
    const int aoff = lds_byte(wr * 64 + fr, fq * 8), boff = lds_byte(wc * 32 + fr, fq * 8);
#define PG8_SA(b, h) (((b) * 2 + (h)) * HTB)
#define PG8_SB(b, h) ((4 + (b) * 2 + (h)) * HTB)
#define PG8_STAGE(bufoff, gbase, voff) do { _Pragma("unroll") for (int _i = 0; _i < 2; ++_i) \
        __builtin_amdgcn_global_load_lds((const unsigned*)((const char*)(gbase) + (voff)[_i]), (PG8_LAS unsigned*)(lds + (bufoff) + ldsw + _i * 8192), 16, 0, 0); } while (0)
#define PG8_LDA(dst, b, h) do { _Pragma("unroll") for (int m = 0; m < 4; ++m) _Pragma("unroll") for (int k = 0; k < 2; ++k) dst[m][k] = *(const PG8_LAS bf16x8*)(lds + PG8_SA(b, h) + aoff + m * 2048 + k * 1024); } while (0)
#define PG8_LDB(dst, b, h) do { _Pragma("unroll") for (int n = 0; n < 2; ++n) _Pragma("unroll") for (int k = 0; k < 2; ++k) dst[n][k] = *(const PG8_LAS bf16x8*)(lds + PG8_SB(b, h) + boff + n * 2048 + k * 1024); } while (0)
#define PG8_MMA(ai, bj, At, Bt) do { __builtin_amdgcn_s_setprio(1); _Pragma("unroll") for (int m = 0; m < 4; ++m) _Pragma("unroll") for (int n = 0; n < 2; ++n) _Pragma("unroll") for (int k = 0; k < 2; ++k) \
        acc[ai][bj][m][n] = __builtin_amdgcn_mfma_f32_16x16x32_bf16(Bt[n][k], At[m][k], acc[ai][bj][m][n], 0, 0, 0); __builtin_amdgcn_s_setprio(0); } while (0)
#define PG8_WAIT_V(n) asm volatile("s_waitcnt vmcnt(" #n ")" ::: "memory")
#define PG8_WAIT_L(n) asm volatile("s_waitcnt lgkmcnt(" #n ")" ::: "memory")
#define PG8_BAR __builtin_amdgcn_s_barrier()
#define PG8_SCHED __builtin_amdgcn_sched_barrier(0)
    Unit cur, nxt; int ui = 0;
    if (!S.next(0, cur)) return;
    f32x4 acc[2][2][4][2];
#pragma unroll
    for (int a = 0; a < 2; ++a)
#pragma unroll
        for (int b = 0; b < 2; ++b)
#pragma unroll
            for (int m = 0; m < 4; ++m)
#pragma unroll
                for (int n = 0; n < 2; ++n) acc[a][b][m][n] = (f32x4){0.f, 0.f, 0.f, 0.f};
    bf16x8 At[4][2], B0[2][2], B1[2][2];
    const char* cA = (const char*)g.A + (size_t)cur.pm * tstep; const char* cB = (const char*)g.Bt + (size_t)cur.pn * tstep;
    S.a_ready(cur);
    if constexpr (SP2) {
        PG8_STAGE(PG8_SB(0, 0), cB, voffB); PG8_STAGE(PG8_SB(0, 1), cB + hstep, voffB); PG8_STAGE(PG8_SA(0, 0), cA, voffA); PG8_STAGE(PG8_SA(0, 1), cA + hstep, voffA);
        if (wr == 1) PG8_BAR;
        PG8_WAIT_V(2); PG8_BAR;
        PG8_STAGE(PG8_SB(1, 0), cB + kstep, voffB); PG8_STAGE(PG8_SA(1, 0), cA + kstep, voffA); PG8_STAGE(PG8_SB(1, 1), cB + hstep + kstep, voffB);
        PG8_WAIT_V(6); PG8_BAR;
    } else {
        PG8_STAGE(PG8_SB(0, 0), cB, voffB); PG8_STAGE(PG8_SA(0, 0), cA, voffA); PG8_STAGE(PG8_SB(0, 1), cB + hstep, voffB); PG8_STAGE(PG8_SA(0, 1), cA + hstep, voffA);
        if (wr == 1) PG8_BAR;
        PG8_WAIT_V(4); PG8_BAR;
        PG8_STAGE(PG8_SB(1, 0), cB + kstep, voffB); PG8_STAGE(PG8_SA(1, 0), cA + kstep, voffA); PG8_STAGE(PG8_SB(1, 1), cB + hstep + kstep, voffB);
        PG8_WAIT_V(6); PG8_BAR;
    }
    for (;;) {
        const bool has_next = S.next(ui + 1, nxt);
        const char* nA = has_next ? (const char*)g.A + (size_t)nxt.pm * tstep : cA; const char* nB = has_next ? (const char*)g.Bt + (size_t)nxt.pn * tstep : cB;
        for (int t = 0; t < nt; t += 2) {
            const bool last = (t == nt - 2);
            const char* a1 = cA + (size_t)(t + 1) * kstep;
            const char* a2 = last ? nA : cA + (size_t)(t + 2) * kstep; const char* b2 = last ? nB : cB + (size_t)(t + 2) * kstep;
            const char* a3 = a2 + kstep; const char* b3 = b2 + kstep;
            if (last && has_next) S.a_ready(nxt);
            if constexpr (SP2) {
            PG8_LDB(B0, 0, 0); PG8_LDB(B1, 0, 1); PG8_SCHED; PG8_LDA(At, 0, 0); PG8_STAGE(PG8_SA(1, 1), a1 + hstep, voffA);
            PG8_WAIT_V(8); PG8_WAIT_L(0); PG8_BAR; PG8_MMA(0, 0, At, B0); PG8_MMA(0, 1, At, B1); PG8_BAR; PG8_SCHED;
            PG8_LDA(At, 0, 1); PG8_STAGE(PG8_SB(0, 0), b2, voffB); PG8_STAGE(PG8_SB(0, 1), b2 + hstep, voffB); PG8_STAGE(PG8_SA(0, 0), a2, voffA);
            PG8_WAIT_V(8); PG8_WAIT_L(0); PG8_BAR; PG8_MMA(1, 0, At, B0); PG8_MMA(1, 1, At, B1); PG8_BAR; PG8_SCHED;
            PG8_LDB(B0, 1, 0); PG8_LDB(B1, 1, 1); PG8_SCHED; PG8_LDA(At, 1, 0); PG8_STAGE(PG8_SA(0, 1), a2 + hstep, voffA);
            PG8_WAIT_V(8); PG8_WAIT_L(0); PG8_BAR; PG8_MMA(0, 0, At, B0); PG8_MMA(0, 1, At, B1); PG8_BAR; PG8_SCHED;
            PG8_LDA(At, 1, 1); PG8_STAGE(PG8_SB(1, 0), b3, voffB); PG8_STAGE(PG8_SB(1, 1), b3 + hstep, voffB); PG8_STAGE(PG8_SA(1, 0), a3, voffA);
            PG8_WAIT_V(8); PG8_WAIT_L(0); PG8_BAR; PG8_MMA(1, 0, At, B0); PG8_MMA(1, 1, At, B1); PG8_BAR; PG8_SCHED;
            } else {
            PG8_LDB(B0, 0, 0); PG8_SCHED; PG8_LDA(At, 0, 0); PG8_STAGE(PG8_SA(1, 1), a1 + hstep, voffA);
            PG8_WAIT_L(8); PG8_BAR; PG8_WAIT_L(0); PG8_MMA(0, 0, At, B0); PG8_BAR; PG8_SCHED;
            PG8_LDB(B1, 0, 1); PG8_STAGE(PG8_SB(0, 0), b2, voffB);
            PG8_BAR; PG8_WAIT_L(0); PG8_MMA(0, 1, At, B1); PG8_BAR;
            PG8_LDA(At, 0, 1); PG8_STAGE(PG8_SA(0, 0), a2, voffA);
            PG8_BAR; PG8_WAIT_L(0); PG8_MMA(1, 0, At, B0); PG8_BAR; PG8_SCHED;
            PG8_STAGE(PG8_SB(0, 1), b2 + hstep, voffB);
            PG8_WAIT_V(6); PG8_BAR; PG8_MMA(1, 1, At, B1); PG8_BAR;
            PG8_LDB(B0, 1, 0); PG8_SCHED; PG8_LDA(At, 1, 0); PG8_STAGE(PG8_SA(0, 1), a2 + hstep, voffA);
            PG8_WAIT_L(8); PG8_BAR; PG8_WAIT_L(0); PG8_MMA(0, 0, At, B0); PG8_BAR; PG8_SCHED;
            PG8_LDB(B1, 1, 1); PG8_STAGE(PG8_SB(1, 0), b3, voffB);
            PG8_BAR; PG8_WAIT_L(0); PG8_MMA(0, 1, At, B1); PG8_BAR;
            PG8_LDA(At, 1, 1); PG8_STAGE(PG8_SA(1, 0), a3, voffA);
            PG8_BAR; PG8_WAIT_L(0); PG8_MMA(1, 0, At, B0); PG8_BAR; PG8_SCHED;
            PG8_STAGE(PG8_SB(1, 1), b3 + hstep, voffB);
            PG8_WAIT_V(6); PG8_BAR; PG8_MMA(1, 1, At, B1); PG8_BAR;
            }
        }
        if constexpr (ALIGN_EPI) { if (wr == 0) PG8_BAR; }
        if constexpr (!Epi::AFTER_DRAIN) { E(acc, cur, wr, wc, fr, fq); S.done(cur); }
        if (!has_next) break;
#pragma unroll
        for (int a = 0; a < 2; ++a)
#pragma unroll
            for (int b = 0; b < 2; ++b)
#pragma unroll
                for (int m = 0; m < 4; ++m)
#pragma unroll
                    for (int n = 0; n < 2; ++n) acc[a][b][m][n] = (f32x4){0.f, 0.f, 0.f, 0.f};
        cur = nxt; cA = nA; cB = nB; ++ui;
        if constexpr (ALIGN_EPI) { if (wr == 1) PG8_BAR; }
    }
    PG8_WAIT_V(0);
    if constexpr (!ALIGN_EPI) { if (wr == 0) PG8_BAR; }
    PG8_BAR;
    if constexpr (Epi::AFTER_DRAIN) { E.fused(acc, cur, wr, wc, fr, fq, lds, wid, lane); S.done(cur); }
#undef PG8_SA
#undef PG8_SB
#undef PG8_STAGE
#undef PG8_LDA
#undef PG8_LDB
#undef PG8_MMA
#undef PG8_WAIT_V
#undef PG8_WAIT_L
#undef PG8_BAR
#undef PG8_SCHED
}
}

#define LAS __attribute__((address_space(3)))
#define DI __device__ __forceinline__
using pg8::bf16_t; using pg8::bf16x8; using pg8::f32x4; using pg8::u32x4; using pg8::cvt_pk_bf16;
typedef unsigned u32x2 __attribute__((ext_vector_type(2)));
typedef float f32x2 __attribute__((ext_vector_type(2)));

constexpr int T_TOK = 32768, DM = 2048, NPROJ = 5120, PROJW = 5128;
constexpr int NTHREADS = 512;
constexpr int LDS_BYTES = 147456;
constexpr float EPS = 1e-6f;

constexpr size_t WS_XN = 0;
constexpr size_t WS_P = 134217728;
constexpr size_t WS_X1G = WS_P;
constexpr size_t WS_Q = WS_P + 134217728;
constexpr size_t WS_WINT = WS_P + 335544320;
constexpr size_t WS_WOUTT = WS_WINT + 20971520;
constexpr size_t WS_WQT = WS_WOUTT + 8388608;
constexpr size_t WS_UB = WS_WQT + 4194304;
constexpr size_t WS_VB = WS_UB + 67108864;
constexpr size_t WS_ST = WS_VB + 67108864;
constexpr size_t WS_CPT = WS_ST + 142606336;
constexpr size_t WS_QC = WS_CPT + 71303168;
constexpr size_t WS_KC = WS_QC + 33554432;
constexpr size_t WS_IG = WS_KC + 33554432;
constexpr size_t WS_LF = WS_IG + 524288;
constexpr size_t WS_PSSV = WS_LF + 524288;
constexpr size_t WS_PSS2 = WS_PSSV + 2097152;
constexpr size_t WS_BEND = WS_PSS2 + 4194304;
constexpr size_t WS_GMAX = WS_BEND + 4096;
constexpr size_t WS_MPREV = WS_GMAX + 4096;
constexpr size_t WS_SELID = WS_MPREV + 4096;
constexpr size_t WS_SELG = WS_SELID + 16777216;
constexpr size_t WS_KB1 = WS_SELG + 16777216;
constexpr size_t WS_KB2 = WS_KB1 + 131072;
constexpr size_t WS_BAR = WS_KB2 + 131072;
constexpr size_t WS_END = WS_BAR + 16384;

struct Params {
    const float *x, *norm1_g, *w_in, *gm_vnorm_g, *w_spatial, *b_spatial, *ml_conv_w, *ml_conv_b, *ml_b_i, *ml_b_f, *gm_out_g, *ml_out_g, *w_out, *norm2_g,
        *peer_wq, *peer_k1, *peer_k2, *peer_u, *peer_v, *final_g;
    float* out;
    unsigned char* ws;
};

template <int CB, int H, int W> DI size_t p_off(int t, int h, int d) { return (size_t)T_TOK * CB + ((size_t)((t >> 7) * H + h) * 128 + (t & 127)) * W + d; }
DI float bf2f(unsigned short h) { return __uint_as_float(((unsigned)h) << 16); }
DI float bflo(unsigned w) { return __uint_as_float(w << 16); }
DI float bfhi(unsigned w) { return __uint_as_float(w & 0xffff0000u); }
DI float rcpf_(float x) { return __builtin_amdgcn_rcpf(x); }
DI float sigmoid_(float x) { return rcpf_(1.f + __expf(-x)); }
DI float gelu_t(float x) { const float z = 1.5957691216057308f * (x + 0.044715f * x * x * x); return x * rcpf_(1.f + __expf(-z)); }
DI float wave_sum(float v) {
#pragma unroll
    for (int o = 32; o; o >>= 1) v += __shfl_xor(v, o);
    return v;
}
DI float wave_max(float v) {
#pragma unroll
    for (int o = 32; o; o >>= 1) v = fmaxf(v, __shfl_xor(v, o));
    return v;
}
DI bf16x8 ld_frag_lds(const LAS unsigned char* p) { return *(const LAS bf16x8*)p; }
#define MFMA16(a, b, c) __builtin_amdgcn_mfma_f32_16x16x32_bf16((a), (b), (c), 0, 0, 0)

struct Epi1 {
    static constexpr bool PERM = true, AFTER_DRAIN = false;
    bf16_t* P; float* pssv;
    DI void operator()(const f32x4 (&acc)[2][2][4][2], const pg8::Unit& u, int wr, int wc, int fr, int fq) const {
        const int row0 = u.pm * 256 + wr * 64 + fr, col0 = u.pn * 256 + wc * 32 + 8 * fq;
        const int mode = u.pn < 8 ? 1 : (u.pn >= 16 ? 2 : 0);
        const bool want_ss = (u.pn >= 4 && u.pn < 8);
#pragma unroll
        for (int ai = 0; ai < 2; ++ai)
#pragma unroll
            for (int m = 0; m < 4; ++m) {
                const int row = row0 + ai * 128 + m * 16;
                const int CB = u.pn < 4 ? 0 : (u.pn < 8 ? 1024 : (u.pn < 10 ? 2048 : (u.pn < 12 ? 2560 : (u.pn < 16 ? 3072 : 4096))));
                const int lw = u.pn < 12 ? 7 : 8, H = u.pn < 8 ? 8 : 4;
                float ss = 0.f;
#pragma unroll
                for (int bj = 0; bj < 2; ++bj) {
                    f32x4 v0 = acc[ai][bj][m][0], v1 = acc[ai][bj][m][1];
                    if (mode == 1) {
#pragma unroll
                        for (int j = 0; j < 4; ++j) { v0[j] = gelu_t(v0[j]); v1[j] = gelu_t(v1[j]); ss += v0[j] * v0[j] + v1[j] * v1[j]; }
                    } else if (mode == 2) {
#pragma unroll
                        for (int j = 0; j < 4; ++j) { v0[j] = sigmoid_(v0[j]); v1[j] = sigmoid_(v1[j]); }
                    }
                    u32x4 w; w.x = cvt_pk_bf16(v0[0], v0[1]); w.y = cvt_pk_bf16(v0[2], v0[3]); w.z = cvt_pk_bf16(v1[0], v1[1]); w.w = cvt_pk_bf16(v1[2], v1[3]);
                    {
                        const int cr = col0 + bj * 128 - CB, hh = cr >> lw, d = cr & ((1 << lw) - 1);
                        *(u32x4*)(P + (size_t)T_TOK * CB + (((size_t)((row >> 7) * H + hh) * 128 + (row & 127)) << lw) + d) = w;
                    }
                }
                if (want_ss) {
                    ss += __shfl_xor(ss, 16); ss += __shfl_xor(ss, 32);
                    if (fq == 0) pssv[(size_t)row * 16 + (u.pn - 4) * 4 + wc] = ss;
                }
            }
    }
};

struct Epi2 {
    static constexpr bool PERM = true, AFTER_DRAIN = false;
    const float* x; bf16_t* x1b; float* pss2;
    DI void operator()(const f32x4 (&acc)[2][2][4][2], const pg8::Unit& u, int wr, int wc, int fr, int fq) const {
        const int row0 = u.pm * 256 + wr * 64 + fr, col0 = u.pn * 256 + wc * 32 + 8 * fq;
#pragma unroll
        for (int ai = 0; ai < 2; ++ai)
#pragma unroll
            for (int m = 0; m < 4; ++m) {
                const int row = row0 + ai * 128 + m * 16;
                float ss = 0.f;
#pragma unroll
                for (int bj = 0; bj < 2; ++bj) {
                    const size_t o = (size_t)row * DM + col0 + bj * 128;
                    const f32x4 v0 = acc[ai][bj][m][0] + *(const f32x4*)(x + o), v1 = acc[ai][bj][m][1] + *(const f32x4*)(x + o + 4);
#pragma unroll
                    for (int j = 0; j < 4; ++j) ss += v0[j] * v0[j] + v1[j] * v1[j];
                    u32x4 w; w.x = cvt_pk_bf16(v0[0], v0[1]); w.y = cvt_pk_bf16(v0[2], v0[3]); w.z = cvt_pk_bf16(v1[0], v1[1]); w.w = cvt_pk_bf16(v1[2], v1[3]);
                    *(u32x4*)(x1b + o) = w;
                }
                ss += __shfl_xor(ss, 16); ss += __shfl_xor(ss, 32);
                if (fq == 0) pss2[(size_t)row * 32 + u.pn * 4 + wc] = ss;
            }
    }
};

struct Epi3 {
    static constexpr bool PERM = true, AFTER_DRAIN = false;
    bf16_t* Q; const float* pss2;
    DI void operator()(const f32x4 (&acc)[2][2][4][2], const pg8::Unit& u, int wr, int wc, int fr, int fq) const {
        const int row0 = u.pm * 256 + wr * 64 + fr, col0 = u.pn * 256 + wc * 32 + 8 * fq;
#pragma unroll
        for (int ai = 0; ai < 2; ++ai)
#pragma unroll
            for (int m = 0; m < 4; ++m) {
                const int row = row0 + ai * 128 + m * 16;
                float ss = 0.f;
#pragma unroll
                for (int i = 0; i < 8; ++i) { const f32x4 t = *(const f32x4*)(pss2 + (size_t)row * 32 + i * 4); ss += (t[0] + t[1]) + (t[2] + t[3]); }
                const float rstd = rsqrtf(ss * (1.f / 2048.f) + EPS);
#pragma unroll
                for (int bj = 0; bj < 2; ++bj) {
                    const f32x4 v0 = acc[ai][bj][m][0] * rstd, v1 = acc[ai][bj][m][1] * rstd;
                    u32x4 w; w.x = cvt_pk_bf16(v0[0], v0[1]); w.y = cvt_pk_bf16(v0[2], v0[3]); w.z = cvt_pk_bf16(v1[0], v1[1]); w.w = cvt_pk_bf16(v1[2], v1[3]);
                    *(u32x4*)(Q + (size_t)row * 1024 + col0 + bj * 128) = w;
                }
            }
    }
};

DI void phase0(const Params& p, LAS unsigned char* lds) {
    const int tid = threadIdx.x, lane = tid & 63, wave = tid >> 6;
    bf16_t* XN = (bf16_t*)(p.ws + WS_XN);
    {
        LAS float* scr = (LAS float*)lds + wave * (64 * 65);
        const int gw = blockIdx.x * 8 + wave, nw = gridDim.x * 8;
        for (int it = gw; it < 4096; it += nw) {
            const float* W; bf16_t* WT; int ldw, kt, nt;
            if (it < 2560) { W = p.w_in; WT = (bf16_t*)(p.ws + WS_WINT); ldw = PROJW; kt = it / 80; nt = it % 80; }
            else if (it < 3584) { const int j = it - 2560; W = p.w_out; WT = (bf16_t*)(p.ws + WS_WOUTT); ldw = 2048; kt = j >> 5; nt = j & 31; }
            else { const int j = it - 3584; W = p.peer_wq; WT = (bf16_t*)(p.ws + WS_WQT); ldw = 1024; kt = j >> 4; nt = j & 15; }
            const int k0 = kt * 64, n0 = nt * 64;
            {
                f32x4 tv[16];
#pragma unroll
                for (int i = 0; i < 16; ++i) tv[i] = *(const f32x4*)(W + (size_t)(k0 + 4 * i + (lane >> 4)) * ldw + n0 + 4 * (lane & 15));
#pragma unroll
                for (int i = 0; i < 16; ++i) {
                    const int r = 4 * i + (lane >> 4);
                    const float gsc = it >= 3584 ? p.norm2_g[k0 + r] : 1.f;
                    LAS float* d = scr + r * 65 + 4 * (lane & 15);
                    d[0] = tv[i][0] * gsc; d[1] = tv[i][1] * gsc; d[2] = tv[i][2] * gsc; d[3] = tv[i][3] * gsc;
                }
            }
            __builtin_amdgcn_fence(__ATOMIC_RELEASE, "wavefront"); __builtin_amdgcn_wave_barrier(); __builtin_amdgcn_fence(__ATOMIC_ACQUIRE, "wavefront");
            const int half = lane >> 5, kk = (lane & 31) * 2;
#pragma unroll 8
            for (int nn = 0; nn < 32; ++nn) {
                const int n = 2 * nn + half; const float a = scr[kk * 65 + n], b = scr[(kk + 1) * 65 + n];
                *(unsigned*)(WT + (size_t)(n0 + n) * 2048 + k0 + kk) = cvt_pk_bf16(a, b);
            }
            __builtin_amdgcn_fence(__ATOMIC_RELEASE, "wavefront"); __builtin_amdgcn_wave_barrier(); __builtin_amdgcn_fence(__ATOMIC_ACQUIRE, "wavefront");
        }
    }
    __syncthreads();
    {
        LAS float* wg = (LAS float*)lds;
        for (int idx = tid; idx < 4096; idx += NTHREADS) {
            const int k = idx >> 1, hf = idx & 1;
            const f32x4 v = *(const f32x4*)(p.w_in + (size_t)k * PROJW + 5120 + hf * 4);
            *(LAS f32x4*)(wg + k * 8 + (k >> 3) * 4 + hf * 4) = v;
        }
        __syncthreads();
        float* IG = (float*)(p.ws + WS_IG); float* LF = (float*)(p.ws + WS_LF);
        for (int row0 = 2 * (blockIdx.x * 8 + wave); row0 < T_TOK; row0 += 2 * gridDim.x * 8) {
            f32x4 xv[2][8];
#pragma unroll
            for (int rr = 0; rr < 2; ++rr) {
                const float* xr = p.x + (size_t)(row0 + rr) * DM;
#pragma unroll
                for (int i = 0; i < 4; ++i) { xv[rr][2 * i] = *(const f32x4*)(xr + i * 512 + lane * 8); xv[rr][2 * i + 1] = *(const f32x4*)(xr + i * 512 + lane * 8 + 4); }
            }
#pragma unroll
            for (int rr = 0; rr < 2; ++rr) {
                const int row = row0 + rr;
                float ss = 0.f;
#pragma unroll
                for (int i = 0; i < 8; ++i) ss += (xv[rr][i][0] * xv[rr][i][0] + xv[rr][i][1] * xv[rr][i][1]) + (xv[rr][i][2] * xv[rr][i][2] + xv[rr][i][3] * xv[rr][i][3]);
                ss = wave_sum(ss);
                const float rstd = rsqrtf(ss * (1.f / 2048.f) + EPS);
                f32x4 ga = {0.f, 0.f, 0.f, 0.f}, gb = {0.f, 0.f, 0.f, 0.f};
#pragma unroll
                for (int i = 0; i < 4; ++i) {
                    const f32x4 g0 = *(const f32x4*)(p.norm1_g + i * 512 + lane * 8), g1 = *(const f32x4*)(p.norm1_g + i * 512 + lane * 8 + 4);
                    const f32x4 h0 = xv[rr][2 * i] * rstd * g0, h1 = xv[rr][2 * i + 1] * rstd * g1;
                    u32x4 w; w.x = cvt_pk_bf16(h0[0], h0[1]); w.y = cvt_pk_bf16(h0[2], h0[3]); w.z = cvt_pk_bf16(h1[0], h1[1]); w.w = cvt_pk_bf16(h1[2], h1[3]);
                    *(u32x4*)(XN + (size_t)row * DM + i * 512 + lane * 8) = w;
                    const LAS float* wb = wg + (i * 512 + lane * 8) * 8 + (i * 64 + lane) * 4;
#pragma unroll
                    for (int e = 0; e < 8; ++e) {
                        const float hv = e < 4 ? h0[e & 3] : h1[e & 3];
                        const f32x4 w0 = *(const LAS f32x4*)(wb + e * 8), w1 = *(const LAS f32x4*)(wb + e * 8 + 4);
                        ga = ga + w0 * hv; gb = gb + w1 * hv;
                    }
                }
                f32x4 m4 = lane < 32 ? ga : gb, s4 = lane < 32 ? gb : ga;
#pragma unroll
                for (int j = 0; j < 4; ++j) m4[j] += __shfl_xor(s4[j], 32);
                const bool up16 = (lane & 16) != 0;
                float m2a = up16 ? m4[2] : m4[0], m2b = up16 ? m4[3] : m4[1];
                const float s2a = up16 ? m4[0] : m4[2], s2b = up16 ? m4[1] : m4[3];
                m2a += __shfl_xor(s2a, 16); m2b += __shfl_xor(s2b, 16);
                const bool up8 = (lane & 8) != 0;
                float m1 = up8 ? m2b : m2a; const float s1 = up8 ? m2a : m2b;
                m1 += __shfl_xor(s1, 8);
                m1 += __shfl_xor(m1, 4); m1 += __shfl_xor(m1, 2); m1 += __shfl_xor(m1, 1);
                const int j = ((lane >> 5) << 2) | (((lane >> 4) & 1) << 1) | ((lane >> 3) & 1);
                if ((lane & 7) == 0) {
                    if (j < 4) IG[(size_t)row * 4 + j] = m1 + p.ml_b_i[j];
                    else { const float z = m1 + p.ml_b_f[j - 4]; LF[(size_t)row * 4 + j - 4] = fminf(z, 0.f) - log1pf(__expf(-fabsf(z))); }
                }
            }
        }
    }
    {
        const size_t nthr = (size_t)gridDim.x * NTHREADS, NQ = (size_t)16384 * 512;
        for (size_t base = (size_t)blockIdx.x * NTHREADS + tid; base < 2 * NQ; base += 16 * nthr) {
            f32x4 v[16];
#pragma unroll
            for (int u = 0; u < 16; ++u) {
                size_t i = base + u * nthr; if (i >= 2 * NQ) i = base;
                const int which = i >= NQ; const size_t j = i - (which ? NQ : 0);
                v[u] = *(const f32x4*)((which ? p.peer_v : p.peer_u) + j * 4);
            }
#pragma unroll
            for (int u = 0; u < 16; ++u) {
                size_t i = base + u * nthr; if (i >= 2 * NQ) i = base;
                const int which = i >= NQ; const size_t j = i - (which ? NQ : 0);
                const int row = (int)(j >> 9), c4 = (int)(j & 511);
                float amax = fmaxf(fmaxf(fabsf(v[u][0]), fabsf(v[u][1])), fmaxf(fabsf(v[u][2]), fabsf(v[u][3])));
                amax = fmaxf(amax, __uint_as_float((unsigned)__builtin_amdgcn_update_dpp(0, (int)__float_as_uint(amax), 0xB1, 0xF, 0xF, true)));
                amax = fmaxf(amax, __uint_as_float((unsigned)__builtin_amdgcn_update_dpp(0, (int)__float_as_uint(amax), 0x4E, 0xF, 0xF, true)));
                amax = fmaxf(amax, __uint_as_float((unsigned)__builtin_amdgcn_update_dpp(0, (int)__float_as_uint(amax), 0x141, 0xF, 0xF, true)));
                amax = fmaxf(amax, __uint_as_float((unsigned)__builtin_amdgcn_update_dpp(0, (int)__float_as_uint(amax), 0x140, 0xF, 0xF, true)));
                const unsigned sb = cvt_pk_bf16(amax * (1.f / 6.f), 0.f) & 0xffffu;
                float sc = bflo(sb); if (sc == 0.f) sc = 1.f;
                const float inv = 1.f / sc;
                unsigned r = 0u;
                r = __builtin_amdgcn_cvt_scalef32_pk_fp4_f32(r, v[u][0] * inv, v[u][1] * inv, 1.0f, 0);
                r = __builtin_amdgcn_cvt_scalef32_pk_fp4_f32(r, v[u][2] * inv, v[u][3] * inv, 1.0f, 1);
                unsigned char* dst = p.ws + (which ? WS_VB : WS_UB) + (size_t)row * 1088;
                *(unsigned short*)(dst + c4 * 2) = (unsigned short)(r & 0xffffu);
                if ((c4 & 15) == 0) *(unsigned short*)(dst + 1024 + (c4 >> 4) * 2) = (unsigned short)(sb == 0u ? 0x3F80u : sb);
            }
        }
    }
    {
        bf16_t* KB1 = (bf16_t*)(p.ws + WS_KB1); bf16_t* KB2 = (bf16_t*)(p.ws + WS_KB2);
        for (int i = blockIdx.x * NTHREADS + tid; i < 65536 / 4; i += gridDim.x * NTHREADS) {
            const f32x4 a = *(const f32x4*)(p.peer_k1 + i * 4), b = *(const f32x4*)(p.peer_k2 + i * 4);
            u32x2 w; w.x = cvt_pk_bf16(a[0], a[1]); w.y = cvt_pk_bf16(a[2], a[3]); *(u32x2*)(KB1 + i * 4) = w;
            w.x = cvt_pk_bf16(b[0], b[1]); w.y = cvt_pk_bf16(b[2], b[3]); *(u32x2*)(KB2 + i * 4) = w;
        }
    }
}

#define WAVE_LDS_SYNC() do { __builtin_amdgcn_fence(__ATOMIC_RELEASE, "wavefront"); __builtin_amdgcn_wave_barrier(); __builtin_amdgcn_fence(__ATOMIC_ACQUIRE, "wavefront"); } while (0)

template <int NG> DI void stage_T_load(const bf16_t* src, int ld, u32x4 (&r0)[NG], u32x4 (&r1)[NG], int wave, int lane) {
#pragma unroll
    for (int i = 0; i < NG; ++i) {
        const int g = wave + 8 * i;
        r0[i] = *(const u32x4*)(src + (size_t)(2 * lane) * ld + g * 8);
        r1[i] = *(const u32x4*)(src + (size_t)(2 * lane + 1) * ld + g * 8);
    }
}
template <int NG> DI void stage_T_store(const u32x4 (&r0)[NG], const u32x4 (&r1)[NG], LAS unsigned char* dst, int wave, int lane) {
#pragma unroll
    for (int i = 0; i < NG; ++i) {
        const int g = wave + 8 * i;
#pragma unroll
        for (int w = 0; w < 4; ++w) {
            const unsigned a = r0[i][w], b = r1[i][w];
            *(LAS unsigned*)(dst + (g * 8 + 2 * w) * 272 + lane * 4) = (a & 0xffffu) | (b << 16);
            *(LAS unsigned*)(dst + (g * 8 + 2 * w + 1) * 272 + lane * 4) = (a >> 16) | (b & 0xffff0000u);
        }
    }
}
template <int NG> DI void stage_T(const bf16_t* src, int ld, LAS unsigned char* dst, int wave, int lane) {
    u32x4 r0[NG], r1[NG];
    stage_T_load<NG>(src, ld, r0, r1, wave, lane);
    stage_T_store<NG>(r0, r1, dst, wave, lane);
}

DI void gmlp_bc(const Params& p, LAS unsigned char* lds, int b, int c) {
    const int tid = threadIdx.x, lane = tid & 63, wave = __builtin_amdgcn_readfirstlane(tid >> 6), fr = lane & 15, fq = lane >> 4;
    const int t0 = b * 8192 + c * 128;
    LAS unsigned char* Wl = lds; LAS unsigned char* GvT = lds + 34816; LAS float* rstdv = (LAS float*)(lds + 69632);
    const bf16_t* P = (const bf16_t*)(p.ws + WS_P); bf16_t* YM = (bf16_t*)(p.ws + WS_XN);
    const float* PSSV = (const float*)(p.ws + WS_PSSV);
    __syncthreads();
    if (tid < 128) {
        float ss = 0.f;
#pragma unroll
        for (int i = 0; i < 4; ++i) { const f32x4 v = *(const f32x4*)(PSSV + (size_t)(t0 + tid) * 16 + i * 4); ss += (v[0] + v[1]) + (v[2] + v[3]); }
        rstdv[tid] = rsqrtf(ss * (1.f / 1024.f) + EPS);
    }
    f32x4 wa[4][2]; u32x4 gr0[2], gr1[2];
#define GMLP_PREFETCH(hh) do { _Pragma("unroll") for (int it = 0; it < 4; ++it) { const int e = (it * NTHREADS + tid) * 8, t = e >> 7, s0 = e & 127; \
            const float* wp = p.w_spatial + ((size_t)((hh) * 128 + t)) * 128 + s0; wa[it][0] = *(const f32x4*)wp; wa[it][1] = *(const f32x4*)(wp + 4); } \
        stage_T_load<2>(P + p_off<1024, 8, 128>(t0, (hh), 0), 128, gr0, gr1, wave, lane); } while (0)
    GMLP_PREFETCH(0);
    for (int h = 0; h < 8; ++h) {
        __syncthreads();
#pragma unroll
        for (int it = 0; it < 4; ++it) {
            const int e = (it * NTHREADS + tid) * 8, t = e >> 7, s0 = e & 127;
            float v[8];
#pragma unroll
            for (int j = 0; j < 8; ++j) { const float a = j < 4 ? wa[it][0][j & 3] : wa[it][1][j & 3]; v[j] = (s0 + j <= t) ? a * rstdv[s0 + j] : 0.f; }
            u32x4 w; w.x = cvt_pk_bf16(v[0], v[1]); w.y = cvt_pk_bf16(v[2], v[3]); w.z = cvt_pk_bf16(v[4], v[5]); w.w = cvt_pk_bf16(v[6], v[7]);
            *(LAS u32x4*)(Wl + t * 272 + s0 * 2) = w;
        }
        stage_T_store<2>(gr0, gr1, GvT, wave, lane);
        __syncthreads();
        if (h + 1 < 8) GMLP_PREFETCH(h + 1);
        f32x4 acc[8];
#pragma unroll
        for (int n = 0; n < 8; ++n) acc[n] = (f32x4){0.f, 0.f, 0.f, 0.f};
        const int kmax = (16 * wave + 15) >> 5;
#pragma unroll
        for (int kk = 0; kk < 4; ++kk) {
            if (kk <= kmax) {
                const bf16x8 bfrag = ld_frag_lds(Wl + (16 * wave + fr) * 272 + (32 * kk + 8 * fq) * 2);
#pragma unroll
                for (int n = 0; n < 8; ++n) { const bf16x8 afrag = ld_frag_lds(GvT + (16 * n + fr) * 272 + (32 * kk + 8 * fq) * 2); acc[n] = MFMA16(afrag, bfrag, acc[n]); }
            }
        }
        const int t = 16 * wave + fr; const size_t grow = (size_t)(t0 + t);
        const float bsp = p.b_spatial[h * 128 + t];
        float ss = 0.f;
#pragma unroll
        for (int n = 0; n < 8; ++n) {
            const int d0 = 16 * n + 4 * fq;
            const u32x2 uw = *(const u32x2*)(P + p_off<0, 8, 128>(t0 + t, h, d0));
            const f32x4 gv = *(const f32x4*)(p.gm_vnorm_g + h * 128 + d0);
            f32x4 y;
            y[0] = bflo(uw.x) * (gv[0] * acc[n][0] + bsp); y[1] = bfhi(uw.x) * (gv[1] * acc[n][1] + bsp);
            y[2] = bflo(uw.y) * (gv[2] * acc[n][2] + bsp); y[3] = bfhi(uw.y) * (gv[3] * acc[n][3] + bsp);
            ss += (y[0] * y[0] + y[1] * y[1]) + (y[2] * y[2] + y[3] * y[3]);
            acc[n] = y;
        }
        ss += __shfl_xor(ss, 16); ss += __shfl_xor(ss, 32);
        const float rstd = rsqrtf(ss * (1.f / 128.f) + EPS);
#pragma unroll
        for (int n = 0; n < 8; ++n) {
            const int d0 = 16 * n + 4 * fq;
            const f32x4 g = *(const f32x4*)(p.gm_out_g + h * 128 + d0);
            const f32x4 o = acc[n] * rstd * g;
            u32x2 w; w.x = cvt_pk_bf16(o[0], o[1]); w.y = cvt_pk_bf16(o[2], o[3]);
            *(u32x2*)(YM + grow * DM + h * 128 + d0) = w;
        }
    }
}

DI void mlstm_local(const Params& p, LAS unsigned char* lds, int b, int c, int h) {
    const int tid = threadIdx.x, lane = tid & 63, wave = __builtin_amdgcn_readfirstlane(tid >> 6), fr = lane & 15, fq = lane >> 4;
    const int bh = b * 4 + h, t0 = b * 8192 + c * 128;
    LAS unsigned char* KT = lds; LAS unsigned char* VT = lds + 34816; LAS float* wsv = (LAS float*)(lds + 108800);
    const bf16_t* P = (const bf16_t*)(p.ws + WS_P);
    bf16_t* QC = (bf16_t*)(p.ws + WS_QC); bf16_t* KC = (bf16_t*)(p.ws + WS_KC);
    const float* IG = (const float*)(p.ws + WS_IG); const float* LF = (const float*)(p.ws + WS_LF);
    LAS float* cwl = (LAS float*)(lds + 109312);
    __syncthreads();
    u32x4 xw[2][5];
#define CONV_LOAD(half) do { _Pragma("unroll") for (int gi = 0; gi < 2; ++gi) { const int g = wave + 8 * (gi + 2 * (half)); const int cgp = (g & 15) * 8; \
        _Pragma("unroll") for (int dj = 0; dj < 5; ++dj) { const int srow = 2 * lane - 3 + dj; xw[gi][dj] = (u32x4){0u, 0u, 0u, 0u}; \
            if (c > 0 || srow >= 0) xw[gi][dj] = *(const u32x4*)(P + ((half) ? p_off<2560, 4, 128>(t0 + srow, h, cgp) : p_off<2048, 4, 128>(t0 + srow, h, cgp))); } } } while (0)
    CONV_LOAD(0);
    for (int idx = tid; idx < 1280; idx += NTHREADS) {
        const int j = idx >> 8, cc = idx & 255, ch = (cc >= 128 ? 512 : 0) + h * 128 + (cc & 127);
        cwl[idx] = j < 4 ? p.ml_conv_w[j * 1024 + ch] : p.ml_conv_b[ch];
    }
    if (wave == 0) {
        const float l0 = LF[(size_t)(t0 + 2 * lane) * 4 + h], l1 = LF[(size_t)(t0 + 2 * lane + 1) * 4 + h];
        const float i0 = IG[(size_t)(t0 + 2 * lane) * 4 + h], i1 = IG[(size_t)(t0 + 2 * lane + 1) * 4 + h];
        float s = l0 + l1;
#pragma unroll
        for (int off = 1; off < 64; off <<= 1) { const float tt = __shfl_up(s, off); if (lane >= off) s += tt; }
        const float b1 = s, b0 = s - l1, bend = __shfl(s, 63);
        const float g0 = bend - b0 + i0, g1 = bend - b1 + i1;
        const float gmax = wave_max(fmaxf(g0, g1));
        wsv[2 * lane] = __expf(g0 - gmax); wsv[2 * lane + 1] = __expf(g1 - gmax);
        if (lane == 0) { ((float*)(p.ws + WS_BEND))[bh * 64 + c] = bend; ((float*)(p.ws + WS_GMAX))[bh * 64 + c] = gmax; }
    }
    __syncthreads();
#pragma unroll
    for (int gi4 = 0; gi4 < 4; ++gi4) {
        const int gi = gi4 & 1;
        if (gi4 == 2) CONV_LOAD(1);
        const int g = wave + 8 * gi4; const bool isk = gi4 >= 2; const int cgp = (g & 15) * 8;
        const int cc0 = (isk ? 128 : 0) + cgp;
        const int s = 2 * lane;
        float y0[8], y1[8];
        {
            const f32x4 cb0 = *(const LAS f32x4*)(cwl + 1024 + cc0), cb1 = *(const LAS f32x4*)(cwl + 1024 + cc0 + 4);
#pragma unroll
            for (int e = 0; e < 8; ++e) { y0[e] = e < 4 ? cb0[e & 3] : cb1[e & 3]; y1[e] = y0[e]; }
#pragma unroll
            for (int j = 0; j < 5; ++j) {
                float xr[8];
#pragma unroll
                for (int q = 0; q < 4; ++q) { xr[2 * q] = bflo(xw[gi][j][q]); xr[2 * q + 1] = bfhi(xw[gi][j][q]); }
                if (j < 4) {
                    const f32x4 w0 = *(const LAS f32x4*)(cwl + j * 256 + cc0), w1 = *(const LAS f32x4*)(cwl + j * 256 + cc0 + 4);
#pragma unroll
                    for (int e = 0; e < 8; ++e) y0[e] += (e < 4 ? w0[e & 3] : w1[e & 3]) * xr[e];
                }
                if (j > 0) {
                    const f32x4 w0 = *(const LAS f32x4*)(cwl + (j - 1) * 256 + cc0), w1 = *(const LAS f32x4*)(cwl + (j - 1) * 256 + cc0 + 4);
#pragma unroll
                    for (int e = 0; e < 8; ++e) y1[e] += (e < 4 ? w0[e & 3] : w1[e & 3]) * xr[e];
                }
            }
        }
        const float sc = isk ? 0.08838834764831845f : 1.f;
#pragma unroll
        for (int e = 0; e < 8; ++e) { y0[e] = y0[e] * sigmoid_(y0[e]) * sc; y1[e] = y1[e] * sigmoid_(y1[e]) * sc; }
        bf16_t* dst = (isk ? KC : QC) + (size_t)(t0 + s) * 512 + h * 128 + cgp;
        u32x4 w; w.x = cvt_pk_bf16(y0[0], y0[1]); w.y = cvt_pk_bf16(y0[2], y0[3]); w.z = cvt_pk_bf16(y0[4], y0[5]); w.w = cvt_pk_bf16(y0[6], y0[7]);
        *(u32x4*)dst = w;
        w.x = cvt_pk_bf16(y1[0], y1[1]); w.y = cvt_pk_bf16(y1[2], y1[3]); w.z = cvt_pk_bf16(y1[4], y1[5]); w.w = cvt_pk_bf16(y1[6], y1[7]);
        *(u32x4*)(dst + 512) = w;
        if (isk) {
            const float w0 = wsv[s], w1 = wsv[s + 1];
#pragma unroll
            for (int e = 0; e < 8; ++e) *(LAS unsigned*)(KT + (cgp + e) * 272 + lane * 4) = cvt_pk_bf16(y0[e] * w0, y1[e] * w1);
        }
    }
    stage_T<4>(P + p_off<3072, 4, 256>(t0, h, 0), 256, VT, wave, lane);
    for (int i = tid; i < 1024; i += NTHREADS) { const int r = i >> 6, w = i & 63; *(LAS unsigned*)(VT + (256 + r) * 272 + w * 4) = 0x3F803F80u; }
    __syncthreads();
    bf16x8 af[4];
#pragma unroll
    for (int kk = 0; kk < 4; ++kk) af[kk] = ld_frag_lds(KT + (16 * wave + fr) * 272 + (32 * kk + 8 * fq) * 2);
    float* ST = (float*)(p.ws + WS_ST) + ((size_t)(bh * 64 + c) * 272) * 128;
#pragma unroll
    for (int n = 0; n < 17; ++n) {
        f32x4 acc = {0.f, 0.f, 0.f, 0.f};
#pragma unroll
        for (int kk = 0; kk < 4; ++kk) { const bf16x8 bfr = ld_frag_lds(VT + (16 * n + fr) * 272 + (32 * kk + 8 * fq) * 2); acc = MFMA16(af[kk], bfr, acc); }
        if (n < 16 || fr == 0) *(f32x4*)(ST + (size_t)(16 * n + fr) * 128 + 16 * wave + 4 * fq) = acc;
    }
}

DI void phase_scan(const Params& p) {
    const float* ST = (const float*)(p.ws + WS_ST); bf16_t* CPT = (bf16_t*)(p.ws + WS_CPT);
    const float* BEND = (const float*)(p.ws + WS_BEND); const float* GMAX = (const float*)(p.ws + WS_GMAX); float* MPREV = (float*)(p.ws + WS_MPREV);
    const int gtid = blockIdx.x * NTHREADS + threadIdx.x, nthr = gridDim.x * NTHREADS;
    constexpr int PER = 8224;
    constexpr size_t CST = 272 * 128;
    if (nthr == 16 * 8192) {
        const int bh = gtid >> 13, e4 = gtid & 8191;
        const bool extra = (gtid & 255) == 0;
        const int e42 = 8192 + ((gtid >> 8) & 31);
        const float* src = ST + (size_t)bh * 64 * CST + (size_t)e4 * 4;
        bf16_t* dst = CPT + (size_t)bh * 64 * CST + (size_t)e4 * 4;
        const float* src2 = ST + (size_t)bh * 64 * CST + (size_t)e42 * 4;
        bf16_t* dst2 = CPT + (size_t)bh * 64 * CST + (size_t)e42 * 4;
        f32x4 st = {0.f, 0.f, 0.f, 0.f}, st2 = {0.f, 0.f, 0.f, 0.f}; float m = 0.f;
        for (int c0 = 0; c0 < 64; c0 += 8) {
            f32x4 d[8], d2[8]; float be[8], gm[8];
#pragma unroll
            for (int j = 0; j < 8; ++j) { d[j] = *(const f32x4*)(src + (size_t)(c0 + j) * CST); be[j] = BEND[bh * 64 + c0 + j]; gm[j] = GMAX[bh * 64 + c0 + j]; }
#pragma unroll
            for (int j = 0; j < 8; ++j) d2[j] = extra ? *(const f32x4*)(src2 + (size_t)(c0 + j) * CST) : (f32x4){0.f, 0.f, 0.f, 0.f};
#pragma unroll
            for (int j = 0; j < 8; ++j) {
                const int c = c0 + j;
                const float mn = fmaxf(be[j] + m, gm[j]), a = __expf(be[j] + m - mn), sc = __expf(gm[j] - mn);
                u32x2 w; w.x = cvt_pk_bf16(st[0], st[1]); w.y = cvt_pk_bf16(st[2], st[3]);
                *(u32x2*)(dst + (size_t)c * CST) = w;
                if (extra) { u32x2 w2; w2.x = cvt_pk_bf16(st2[0], st2[1]); w2.y = cvt_pk_bf16(st2[2], st2[3]); *(u32x2*)(dst2 + (size_t)c * CST) = w2; }
                if (e4 == 0) MPREV[bh * 64 + c] = m;
                st = st * a + d[j] * sc; st2 = st2 * a + d2[j] * sc; m = mn;
            }
        }
        return;
    }
    for (int item = gtid; item < 16 * PER; item += nthr) {
        const int bh = item / PER, e4 = item - bh * PER;
        const float* src = ST + (size_t)bh * 64 * CST + (size_t)e4 * 4;
        bf16_t* dst = CPT + (size_t)bh * 64 * CST + (size_t)e4 * 4;
        f32x4 st = {0.f, 0.f, 0.f, 0.f}; float m = 0.f;
        for (int c0 = 0; c0 < 64; c0 += 8) {
            f32x4 d[8]; float be[8], gm[8];
#pragma unroll
            for (int j = 0; j < 8; ++j) { d[j] = *(const f32x4*)(src + (size_t)(c0 + j) * CST); be[j] = BEND[bh * 64 + c0 + j]; gm[j] = GMAX[bh * 64 + c0 + j]; }
#pragma unroll
            for (int j = 0; j < 8; ++j) {
                const int c = c0 + j;
                const float mn = fmaxf(be[j] + m, gm[j]), a = __expf(be[j] + m - mn), sc = __expf(gm[j] - mn);
                u32x2 w; w.x = cvt_pk_bf16(st[0], st[1]); w.y = cvt_pk_bf16(st[2], st[3]);
                *(u32x2*)(dst + (size_t)c * CST) = w;
                if (e4 == 0) MPREV[bh * 64 + c] = m;
                st = st * a + d[j] * sc; m = mn;
            }
        }
    }
}

DI void mlstm_out(const Params& p, LAS unsigned char* lds, int b, int c, int h) {
    const int tid = threadIdx.x, lane = tid & 63, wave = __builtin_amdgcn_readfirstlane(tid >> 6), fr = lane & 15, fq = lane >> 4;
    const int bh = b * 4 + h, t0 = b * 8192 + c * 128;
    LAS unsigned char* Kl = lds; LAS unsigned char* Sl = lds + 34816; LAS unsigned char* VTe = lds + 69632;
    LAS float* av = (LAS float*)(lds + 143616); LAS float* Mv = (LAS float*)(lds + 144128); LAS float* bv = (LAS float*)(lds + 144640);
    const bf16_t* P = (const bf16_t*)(p.ws + WS_P); bf16_t* YM = (bf16_t*)(p.ws + WS_XN);
    const bf16_t* QC = (const bf16_t*)(p.ws + WS_QC); const bf16_t* KC = (const bf16_t*)(p.ws + WS_KC);
    const float* IG = (const float*)(p.ws + WS_IG); const float* LF = (const float*)(p.ws + WS_LF);
    const float mprev = ((const float*)(p.ws + WS_MPREV))[bh * 64 + c];
    __syncthreads();
    if (wave == 0) {
        const float l0 = LF[(size_t)(t0 + 2 * lane) * 4 + h], l1 = LF[(size_t)(t0 + 2 * lane + 1) * 4 + h];
        const float i0 = IG[(size_t)(t0 + 2 * lane) * 4 + h], i1 = IG[(size_t)(t0 + 2 * lane + 1) * 4 + h];
        float s = l0 + l1;
#pragma unroll
        for (int off = 1; off < 64; off <<= 1) { const float tt = __shfl_up(s, off); if (lane >= off) s += tt; }
        const float b1 = s, b0 = s - l1;
        const float a0 = i0 - b0, a1 = i1 - b1;
        float pm = fmaxf(a0, a1);
#pragma unroll
        for (int off = 1; off < 64; off <<= 1) { const float tt = __shfl_up(pm, off); if (lane >= off) pm = fmaxf(pm, tt); }
        float ex = __shfl_up(pm, 1); if (lane == 0) ex = -3.0e38f;
        Mv[2 * lane] = fmaxf(mprev, fmaxf(ex, a0)); Mv[2 * lane + 1] = fmaxf(mprev, pm);
        av[2 * lane] = a0; av[2 * lane + 1] = a1; bv[2 * lane] = b0; bv[2 * lane + 1] = b1;
    }
#pragma unroll
    for (int it = 0; it < 4; ++it) {
        const int e = (it * NTHREADS + tid) * 8, s = e >> 7, d0 = e & 127;
        *(LAS u32x4*)(Kl + s * 272 + d0 * 2) = *(const u32x4*)(KC + (size_t)(t0 + s) * 512 + h * 128 + d0);
    }
    stage_T<4>(P + p_off<3072, 4, 256>(t0, h, 0), 256, VTe, wave, lane);
    for (int i = tid; i < 1024; i += NTHREADS) { const int r = i >> 6, w = i & 63; *(LAS unsigned*)(VTe + (256 + r) * 272 + w * 4) = 0x3F803F80u; }
    bf16x8 qf[4];
#pragma unroll
    for (int kk = 0; kk < 4; ++kk) qf[kk] = *(const bf16x8*)(QC + (size_t)(t0 + 16 * wave + fr) * 512 + h * 128 + 32 * kk + 8 * fq);
    __syncthreads();
    const int t = 16 * wave + fr; const float Mt = Mv[t];
    const int stmax = wave | 1;
    for (int st = 0; st <= stmax; ++st) {
        f32x4 s4 = {0.f, 0.f, 0.f, 0.f};
#pragma unroll
        for (int kk = 0; kk < 4; ++kk) { const bf16x8 kf = ld_frag_lds(Kl + (16 * st + fr) * 272 + (32 * kk + 8 * fq) * 2); s4 = MFMA16(kf, qf[kk], s4); }
#pragma unroll
        for (int r = 0; r < 4; ++r) { const int s = 16 * st + 4 * fq + r; const float w = (s <= t) ? __expf(av[s] - Mt) : 0.f; s4[r] *= w; }
        u32x2 w; w.x = cvt_pk_bf16(s4[0], s4[1]); w.y = cvt_pk_bf16(s4[2], s4[3]);
        *(LAS u32x2*)(Sl + t * 272 + (16 * st + 4 * fq) * 2) = w;
    }
    __syncthreads();
    const bf16_t* cpt = (const bf16_t*)(p.ws + WS_CPT) + ((size_t)(bh * 64 + c) * 272) * 128;
    f32x4 acc[17];
#pragma unroll
    for (int n = 0; n < 17; ++n) {
        acc[n] = (f32x4){0.f, 0.f, 0.f, 0.f};
#pragma unroll
        for (int kk = 0; kk < 4; ++kk) { const bf16x8 cf = *(const bf16x8*)(cpt + (size_t)(16 * n + fr) * 128 + 32 * kk + 8 * fq); acc[n] = MFMA16(cf, qf[kk], acc[n]); }
    }
    const float ai = __expf(mprev - Mt);
#pragma unroll
    for (int n = 0; n < 17; ++n) acc[n] = acc[n] * ai;
    const int k2max = (16 * wave + 15) >> 5;
#pragma unroll
    for (int kk = 0; kk < 4; ++kk) {
        if (kk <= k2max) {
            const bf16x8 sf = ld_frag_lds(Sl + t * 272 + (32 * kk + 8 * fq) * 2);
#pragma unroll
            for (int n = 0; n < 17; ++n) { const bf16x8 vf = ld_frag_lds(VTe + (16 * n + fr) * 272 + (32 * kk + 8 * fq) * 2); acc[n] = MFMA16(vf, sf, acc[n]); }
        }
    }
    const float den = __shfl(acc[16][0], fr);
    const float mt = bv[t] + Mt;
    const float inv = rcpf_(fmaxf(fabsf(den), __expf(-mt)));
    const size_t grow = (size_t)(t0 + t);
    float ss = 0.f;
#pragma unroll
    for (int n = 0; n < 16; ++n) {
        const int v0 = 16 * n + 4 * fq;
        const u32x2 ow = *(const u32x2*)(P + p_off<4096, 4, 256>(t0 + t, h, v0));
        f32x4 y;
        y[0] = bflo(ow.x) * acc[n][0] * inv; y[1] = bfhi(ow.x) * acc[n][1] * inv; y[2] = bflo(ow.y) * acc[n][2] * inv; y[3] = bfhi(ow.y) * acc[n][3] * inv;
        ss += (y[0] * y[0] + y[1] * y[1]) + (y[2] * y[2] + y[3] * y[3]);
        acc[n] = y;
    }
    ss += __shfl_xor(ss, 16); ss += __shfl_xor(ss, 32);
    const float rstd = rsqrtf(ss * (1.f / 256.f) + EPS);
#pragma unroll
    for (int n = 0; n < 16; ++n) {
        const int v0 = 16 * n + 4 * fq;
        const f32x4 g = *(const f32x4*)(p.ml_out_g + h * 256 + v0);
        const f32x4 o = acc[n] * rstd * g;
        u32x2 w; w.x = cvt_pk_bf16(o[0], o[1]); w.y = cvt_pk_bf16(o[2], o[3]);
        *(u32x2*)(YM + grow * DM + 1024 + h * 256 + v0) = w;
    }
}

DI unsigned ord_key(float f) { const unsigned u = __float_as_uint(f); return (u & 0x80000000u) ? ~u : (u | 0x80000000u); }
DI float key_val(unsigned k) { return (k & 0x80000000u) ? __uint_as_float(k & 0x7fffffffu) : __uint_as_float(~k); }
DI unsigned umax_(unsigned a, unsigned b) { return a > b ? a : b; }
DI unsigned umin_(unsigned a, unsigned b) { return a < b ? a : b; }
#define DPPU(v, ctrl) ((unsigned)__builtin_amdgcn_update_dpp(0, (int)(v), (ctrl), 0xF, 0xF, true))
DI unsigned row_max_u32(unsigned v) {
    v = umax_(v, DPPU(v, 0xB1)); v = umax_(v, DPPU(v, 0x4E)); v = umax_(v, DPPU(v, 0x141)); v = umax_(v, DPPU(v, 0x140)); return v;
}
DI float row_sum_f32(float v) {
    v += __uint_as_float(DPPU(__float_as_uint(v), 0xB1)); v += __uint_as_float(DPPU(__float_as_uint(v), 0x4E));
    v += __uint_as_float(DPPU(__float_as_uint(v), 0x141)); v += __uint_as_float(DPPU(__float_as_uint(v), 0x140)); return v;
}
#define CEX(a, b) do { const unsigned mx_ = umax_(a, b), mn_ = umin_(a, b); a = mx_; b = mn_; } while (0)
template <int N> DI unsigned top16_row(unsigned (&s)[N], int c) {
    unsigned list = 0u;
#pragma unroll 1
    for (int it = 0; it < 16; ++it) {
        const unsigned wm = row_max_u32(s[0]);
        const bool win = (s[0] == wm);
#pragma unroll
        for (int i = 0; i < N - 1; ++i) s[i] = win ? s[i + 1] : s[i];
        s[N - 1] = win ? 0u : s[N - 1];
        list = (c == it) ? wm : list;
    }
    return list;
}

template <int N> DI void top16_row2(unsigned (&s)[N], unsigned (&t)[N], int c, unsigned& l1, unsigned& l2) {
    l1 = 0u; l2 = 0u;
#pragma unroll 1
    for (int it = 0; it < 16; ++it) {
        const unsigned wm1 = row_max_u32(s[0]), wm2 = row_max_u32(t[0]);
        const bool win1 = (s[0] == wm1), win2 = (t[0] == wm2);
#pragma unroll
        for (int i = 0; i < N - 1; ++i) { s[i] = win1 ? s[i + 1] : s[i]; t[i] = win2 ? t[i + 1] : t[i]; }
        s[N - 1] = win1 ? 0u : s[N - 1]; t[N - 1] = win2 ? 0u : t[N - 1];
        l1 = (c == it) ? wm1 : l1; l2 = (c == it) ? wm2 : l2;
    }
}

template <int N> DI void top16_row4(unsigned (&s)[N], unsigned (&t)[N], unsigned (&u)[N], unsigned (&v)[N], int c, unsigned& l1, unsigned& l2, unsigned& l3, unsigned& l4) {
    l1 = 0u; l2 = 0u; l3 = 0u; l4 = 0u;
#pragma unroll 1
    for (int it = 0; it < 16; ++it) {
        const unsigned wm1 = row_max_u32(s[0]), wm2 = row_max_u32(t[0]), wm3 = row_max_u32(u[0]), wm4 = row_max_u32(v[0]);
        const bool win1 = (s[0] == wm1), win2 = (t[0] == wm2), win3 = (u[0] == wm3), win4 = (v[0] == wm4);
#pragma unroll
        for (int i = 0; i < N - 1; ++i) { s[i] = win1 ? s[i + 1] : s[i]; t[i] = win2 ? t[i + 1] : t[i]; u[i] = win3 ? u[i + 1] : u[i]; v[i] = win4 ? v[i + 1] : v[i]; }
        s[N - 1] = win1 ? 0u : s[N - 1]; t[N - 1] = win2 ? 0u : t[N - 1]; u[N - 1] = win3 ? 0u : u[N - 1]; v[N - 1] = win4 ? 0u : v[N - 1];
        l1 = (c == it) ? wm1 : l1; l2 = (c == it) ? wm2 : l2; l3 = (c == it) ? wm3 : l3; l4 = (c == it) ? wm4 : l4;
    }
}
#define SORT8(s) do { CEX(s[0], s[1]); CEX(s[2], s[3]); CEX(s[4], s[5]); CEX(s[6], s[7]); CEX(s[0], s[2]); CEX(s[1], s[3]); CEX(s[4], s[6]); CEX(s[5], s[7]); CEX(s[1], s[2]); CEX(s[5], s[6]); \
    CEX(s[0], s[4]); CEX(s[1], s[5]); CEX(s[2], s[6]); CEX(s[3], s[7]); CEX(s[2], s[4]); CEX(s[3], s[5]); CEX(s[1], s[2]); CEX(s[3], s[4]); CEX(s[5], s[6]); } while (0)
#define SORT4(s) do { CEX(s[0], s[1]); CEX(s[2], s[3]); CEX(s[0], s[2]); CEX(s[1], s[3]); CEX(s[1], s[2]); } while (0)

DI void peer_select(const Params& p) {
    const int tid = threadIdx.x, lane = tid & 63, wave = __builtin_amdgcn_readfirstlane(tid >> 6), c = lane & 15, g = lane >> 4, rowbase = lane & 48;
    const bf16_t* Q = (const bf16_t*)(p.ws + WS_Q); const bf16_t* KB1 = (const bf16_t*)(p.ws + WS_KB1); const bf16_t* KB2 = (const bf16_t*)(p.ws + WS_KB2);
    int* SELID = (int*)(p.ws + WS_SELID); float* SELG = (float*)(p.ws + WS_SELG);
    unsigned pk = 0u, validmask = 0u;
#pragma unroll
    for (int q = 0; q < 4; ++q) {
        const int target = 4 * c + q; int ci = 0, cj = 0, cnt = 0; bool v = false;
#pragma unroll
        for (int i = 0; i < 16; ++i) { const int nj = 16 / (i + 1); if (target >= cnt && target < cnt + nj) { ci = i; cj = target - cnt; v = true; } cnt += nj; }
        pk |= (unsigned)((ci << 4) | cj) << (8 * q); validmask |= (v ? 1u : 0u) << q;
    }
    for (int tile = blockIdx.x * 8 + wave; tile < T_TOK / 16; tile += gridDim.x * 8) {
        const int tok0 = tile * 16;
        for (int h = 0; h < 8; ++h) {
            bf16x8 a1[2], a2[2];
            {
                const bf16_t* qp = Q + (size_t)(tok0 + c) * 1024 + h * 128 + g * 8;
                a1[0] = *(const bf16x8*)qp; a1[1] = *(const bf16x8*)(qp + 32); a2[0] = *(const bf16x8*)(qp + 64); a2[1] = *(const bf16x8*)(qp + 96);
            }
            f32x4 acc1[8], acc2[8];
#pragma unroll
            for (int nt = 0; nt < 8; ++nt) {
                const size_t ko = ((size_t)(h * 128 + nt * 16 + c)) * 64 + g * 8;
                acc1[nt] = (f32x4){0.f, 0.f, 0.f, 0.f}; acc2[nt] = (f32x4){0.f, 0.f, 0.f, 0.f};
                acc1[nt] = MFMA16(a1[0], *(const bf16x8*)(KB1 + ko), acc1[nt]); acc1[nt] = MFMA16(a1[1], *(const bf16x8*)(KB1 + ko + 32), acc1[nt]);
                acc2[nt] = MFMA16(a2[0], *(const bf16x8*)(KB2 + ko), acc2[nt]); acc2[nt] = MFMA16(a2[1], *(const bf16x8*)(KB2 + ko + 32), acc2[nt]);
            }
#pragma unroll
            for (int rp = 0; rp < 2; ++rp) {
                const int r0 = 2 * rp, r1 = 2 * rp + 1;
                unsigned sA[8], sB[8], sC[8], sD[8];
#pragma unroll
                for (int nt = 0; nt < 8; ++nt) {
                    const unsigned ix = (unsigned)(127 - (nt * 16 + c));
                    sA[nt] = (ord_key(acc1[nt][r0]) & ~0x7Fu) | ix; sB[nt] = (ord_key(acc2[nt][r0]) & ~0x7Fu) | ix;
                    sC[nt] = (ord_key(acc1[nt][r1]) & ~0x7Fu) | ix; sD[nt] = (ord_key(acc2[nt][r1]) & ~0x7Fu) | ix;
                }
                SORT8(sA); SORT8(sB); SORT8(sC); SORT8(sD);
                unsigned lA, lB, lC, lD;
                top16_row4<8>(sA, sB, sC, sD, c, lA, lB, lC, lD);
                unsigned c0[4], c1[4];
#pragma unroll
                for (int q = 0; q < 4; ++q) {
                    const int ci = (int)((pk >> (8 * q + 4)) & 15u), cj = (int)((pk >> (8 * q)) & 15u);
                    const unsigned ka = (unsigned)__shfl((int)lA, rowbase + ci), kb = (unsigned)__shfl((int)lB, rowbase + cj);
                    const unsigned kc = (unsigned)__shfl((int)lC, rowbase + ci), kd = (unsigned)__shfl((int)lD, rowbase + cj);
                    const float cand0 = key_val(ka & ~0x7Fu) + key_val(kb & ~0x7Fu), cand1 = key_val(kc & ~0x7Fu) + key_val(kd & ~0x7Fu);
                    const bool ok = ((validmask >> q) & 1u) != 0u; const unsigned ix = (unsigned)(63 - (4 * c + q));
                    c0[q] = ok ? ((ord_key(cand0) & ~0x3Fu) | ix) : 0u; c1[q] = ok ? ((ord_key(cand1) & ~0x3Fu) | ix) : 0u;
                }
                SORT4(c0); SORT4(c1);
                unsigned sel0, sel1;
                top16_row2<4>(c0, c1, c, sel0, sel1);
#pragma unroll
                for (int u = 0; u < 2; ++u) {
                    const unsigned sel = u ? sel1 : sel0, list1 = u ? lC : lA, list2 = u ? lD : lB; const int r = u ? r1 : r0;
                    const int slot = 63 - (int)(sel & 63u);
                    const unsigned pkv = (unsigned)__shfl((int)pk, rowbase + (slot >> 2));
                    const int cij = (int)((pkv >> (8 * (slot & 3))) & 0xFFu);
                    const unsigned e1 = (unsigned)__shfl((int)list1, rowbase + (cij >> 4)), e2 = (unsigned)__shfl((int)list2, rowbase + (cij & 15));
                    const int eid = (127 - (int)(e1 & 127u)) * 128 + (127 - (int)(e2 & 127u));
                    const float sv = key_val(sel & ~0x3Fu), mx = key_val(row_max_u32(sel) & ~0x3Fu);
                    const float ev = __expf(sv - mx);
                    const float sum = row_sum_f32(ev);
                    const size_t o = (size_t)(tok0 + 4 * g + r) * 128 + h * 16 + c;
                    SELID[o] = eid; SELG[o] = ev * rcpf_(sum);
                }
            }
        }
    }
}

DI f32x2 pkfma(f32x2 a, f32x2 b, f32x2 c) { return __builtin_elementwise_fma(a, b, c); }
DI void peer_gather(const Params& p, LAS unsigned char* lds) {
    const int tid = threadIdx.x, lane = tid & 63, wave = __builtin_amdgcn_readfirstlane(tid >> 6);
    LAS float* scr = (LAS float*)lds + wave * (16 * 68);
    LAS float* cfl = (LAS float*)(lds + 8 * 16 * 68 * 4) + wave * 128;
    const unsigned char* Ub = p.ws + WS_UB; const unsigned char* Vb = p.ws + WS_VB;
    const float* PSS2 = (const float*)(p.ws + WS_PSS2);
    const int* SELID = (const int*)(p.ws + WS_SELID); const float* SELG = (const float*)(p.ws + WS_SELG);
    const int gw = blockIdx.x * 8 + wave, nw = gridDim.x * 8;
    for (int t = gw; t < T_TOK; t += nw) {
        const int idA = SELID[(size_t)t * 128 + lane], idB = SELID[(size_t)t * 128 + 64 + lane];
        const float gA = SELG[(size_t)t * 128 + lane], gB = SELG[(size_t)t * 128 + 64 + lane];
        const bf16_t* xrow = (const bf16_t*)(p.ws + WS_X1G) + (size_t)t * DM + lane * 32;
        float* orow = p.out + (size_t)t * DM + lane * 32;
        const float pv = lane < 32 ? PSS2[(size_t)t * 32 + lane] : 0.f;
        const float rstd2 = rsqrtf(wave_sum(pv) * (1.f / 2048.f) + EPS);
        f32x2 h2[16];
#pragma unroll
        for (int q = 0; q < 4; ++q) {
            const u32x4 xw = *(const u32x4*)(xrow + q * 8);
            const f32x4 g0 = *(const f32x4*)(p.norm2_g + lane * 32 + q * 8), g1 = *(const f32x4*)(p.norm2_g + lane * 32 + q * 8 + 4);
            h2[4 * q] = (f32x2){bflo(xw.x) * rstd2 * g0[0], bfhi(xw.x) * rstd2 * g0[1]};
            h2[4 * q + 1] = (f32x2){bflo(xw.y) * rstd2 * g0[2], bfhi(xw.y) * rstd2 * g0[3]};
            h2[4 * q + 2] = (f32x2){bflo(xw.z) * rstd2 * g1[0], bfhi(xw.z) * rstd2 * g1[1]};
            h2[4 * q + 3] = (f32x2){bflo(xw.w) * rstd2 * g1[2], bfhi(xw.w) * rstd2 * g1[3]};
        }
        constexpr int NPK = 8;
        u32x4 buf[2][NPK]; unsigned short bsc[2][NPK];
#define PEER_LOAD(TB, st, base) do { const int idv_ = ((base) < 64) ? idA : idB; _Pragma("unroll") for (int e_ = 0; e_ < NPK; ++e_) { \
            const int id_ = __builtin_amdgcn_readlane(idv_, ((base) + e_) & 63); const unsigned char* r_ = (TB) + (size_t)id_ * 1088; \
            buf[st][e_] = *(const u32x4*)(r_ + lane * 16); bsc[st][e_] = *(const unsigned short*)(r_ + 1024 + (lane >> 1) * 2); } } while (0)
#define PEER_DOT(st, slot0) do { _Pragma("unroll") for (int e_ = 0; e_ < NPK; ++e_) { f32x2 a2_ = {0.f, 0.f}; \
            _Pragma("unroll") for (int d_ = 0; d_ < 4; ++d_) { const unsigned w_ = buf[st][e_][d_]; \
                a2_ = pkfma(h2[d_ * 4 + 0], __builtin_amdgcn_cvt_scalef32_pk_f32_fp4(w_, 1.0f, 0), a2_); a2_ = pkfma(h2[d_ * 4 + 1], __builtin_amdgcn_cvt_scalef32_pk_f32_fp4(w_, 1.0f, 1), a2_); \
                a2_ = pkfma(h2[d_ * 4 + 2], __builtin_amdgcn_cvt_scalef32_pk_f32_fp4(w_, 1.0f, 2), a2_); a2_ = pkfma(h2[d_ * 4 + 3], __builtin_amdgcn_cvt_scalef32_pk_f32_fp4(w_, 1.0f, 3), a2_); } \
            scr[((slot0) + e_) * 68 + lane] = (a2_[0] + a2_[1]) * bf2f(bsc[st][e_]); } } while (0)
        PEER_LOAD(Ub, 0, 0);
        for (int b = 0; b < 128 / NPK; b += 2) {
            PEER_LOAD(Ub, 1, (b + 1) * NPK);
            PEER_DOT(0, (b * NPK) & 15);
            if (b + 2 < 128 / NPK) PEER_LOAD(Ub, 0, (b + 2) * NPK);
            PEER_DOT(1, ((b + 1) * NPK) & 15);
            if ((((b + 2) * NPK) & 15) == 0) {
                WAVE_LDS_SYNC();
                float sum = 0.f;
#pragma unroll
                for (int i = 0; i < 4; ++i) { const f32x4 r = *(const LAS f32x4*)(scr + (lane >> 2) * 68 + (lane & 3) * 16 + 4 * i); sum += (r[0] + r[1]) + (r[2] + r[3]); }
                sum += __shfl_xor(sum, 1); sum += __shfl_xor(sum, 2);
                const int k0 = (b + 2) * NPK - 16;
                const int k = k0 + (lane >> 2);
                const float gate = __shfl((k0 < 64) ? gA : gB, k & 63);
                if ((lane & 3) == 0) cfl[k] = gate * gelu_t(sum);
                WAVE_LDS_SYNC();
            }
        }
        f32x2 acc[16];
#pragma unroll
        for (int i = 0; i < 16; ++i) acc[i] = (f32x2){0.f, 0.f};
#define PEER_AXPY(st, base) do { _Pragma("unroll") for (int e_ = 0; e_ < NPK; ++e_) { const float c_ = cfl[(base) + e_] * bf2f(bsc[st][e_]); const f32x2 c2_ = {c_, c_}; \
            _Pragma("unroll") for (int d_ = 0; d_ < 4; ++d_) { const unsigned w_ = buf[st][e_][d_]; \
                acc[d_ * 4 + 0] = pkfma(c2_, __builtin_amdgcn_cvt_scalef32_pk_f32_fp4(w_, 1.0f, 0), acc[d_ * 4 + 0]); acc[d_ * 4 + 1] = pkfma(c2_, __builtin_amdgcn_cvt_scalef32_pk_f32_fp4(w_, 1.0f, 1), acc[d_ * 4 + 1]); \
                acc[d_ * 4 + 2] = pkfma(c2_, __builtin_amdgcn_cvt_scalef32_pk_f32_fp4(w_, 1.0f, 2), acc[d_ * 4 + 2]); acc[d_ * 4 + 3] = pkfma(c2_, __builtin_amdgcn_cvt_scalef32_pk_f32_fp4(w_, 1.0f, 3), acc[d_ * 4 + 3]); } } } while (0)
        PEER_LOAD(Vb, 0, 0);
        for (int b = 0; b < 128 / NPK; b += 2) {
            PEER_LOAD(Vb, 1, (b + 1) * NPK);
            PEER_AXPY(0, b * NPK);
            if (b + 2 < 128 / NPK) PEER_LOAD(Vb, 0, (b + 2) * NPK);
            PEER_AXPY(1, (b + 1) * NPK);
        }
        float ss = 0.f;
#pragma unroll
        for (int q = 0; q < 4; ++q) {
            const u32x4 xw = *(const u32x4*)(xrow + q * 8);
            acc[4 * q] += (f32x2){bflo(xw.x), bfhi(xw.x)}; acc[4 * q + 1] += (f32x2){bflo(xw.y), bfhi(xw.y)};
            acc[4 * q + 2] += (f32x2){bflo(xw.z), bfhi(xw.z)}; acc[4 * q + 3] += (f32x2){bflo(xw.w), bfhi(xw.w)};
#pragma unroll
            for (int i = 0; i < 4; ++i) { const f32x2 a = acc[4 * q + i]; ss += a[0] * a[0] + a[1] * a[1]; }
        }
        const float rstd = rsqrtf(wave_sum(ss) * (1.f / 2048.f) + EPS);
#pragma unroll
        for (int q = 0; q < 8; ++q) {
            const f32x4 g0 = *(const f32x4*)(p.final_g + lane * 32 + q * 4);
            const f32x2 a = acc[2 * q], b = acc[2 * q + 1];
            const f32x4 o0 = {a[0] * rstd * g0[0], a[1] * rstd * g0[1], b[0] * rstd * g0[2], b[1] * rstd * g0[3]};
            *(f32x4*)(orow + q * 4) = o0;
        }
        WAVE_LDS_SYNC();
    }
}

#define XB_TMO      128
#define XB_XCNT(j)  (256  + 64 * (j))
#define XB_XSUB(j)  (1280 + 64 * (j))
#define XB_XGEN(j)  (2304 + 64 * (j))
#define XB_TOP      3328
#define XB_TOPGEN   3392
#define XCD_BAR_WORDS 3456
#define XB_SPIN_CAP (1u << 18)

__device__ __forceinline__ unsigned xb_ld(unsigned* p)              { return __hip_atomic_load(p, __ATOMIC_RELAXED, __HIP_MEMORY_SCOPE_AGENT); }
__device__ __forceinline__ unsigned xb_add(unsigned* p, unsigned v) { return __hip_atomic_fetch_add(p, v, __ATOMIC_RELAXED, __HIP_MEMORY_SCOPE_AGENT); }
__device__ __forceinline__ unsigned xb_xcc_id() { return (unsigned)__builtin_amdgcn_s_getreg((3 << 11) | 20) & 0xFu; }
#define XB_SPIN(cond, bar) do { unsigned _sp = 0; while (cond) { __builtin_amdgcn_s_sleep(1); \
    if ((++_sp & 255u) == 0u) { if (xb_ld(&(bar)[XB_TMO])) break; if (_sp > XB_SPIN_CAP) { atomicAdd(&(bar)[XB_TMO], 1u); break; } } } } while (0)

struct XcdBarrier {
    unsigned* bar; unsigned x;
    volatile LAS unsigned* st;
};

__device__ __forceinline__ XcdBarrier xcd_barrier_post(unsigned* bar, volatile LAS unsigned* st) {
    XcdBarrier b; b.bar = bar; b.x = xb_xcc_id(); b.st = st;
    if (threadIdx.x == 0) (void)xb_add(&bar[XB_XCNT(b.x)], 1u);
    return b;
}
__device__ __forceinline__ void xcd_barrier_complete(unsigned* bar, unsigned x, unsigned& nloc, unsigned& nx) {
    const unsigned G = gridDim.x * gridDim.y * gridDim.z;
    unsigned sum, cnt, mine, sp = 0u;
    for (;;) {
        sum = 0u; cnt = 0u; mine = 0u;
#pragma unroll
        for (unsigned j = 0; j < 16; ++j) { const unsigned c = xb_ld(&bar[XB_XCNT(j)]); sum += c; cnt += (c > 0u) ? 1u : 0u; mine = (j == x) ? c : mine; }
        if (sum == G) break;
        __builtin_amdgcn_s_sleep(1);
        if ((++sp & 255u) == 0u) { if (xb_ld(&bar[XB_TMO])) break; if (sp > XB_SPIN_CAP) { atomicAdd(&bar[XB_TMO], 1u); break; } }
    }
    nloc = mine > 0u ? mine : 1u; nx = cnt > 0u ? cnt : 1u;
}

__device__ __forceinline__ void xcd_barrier(const XcdBarrier& b) {
    asm volatile("s_waitcnt vmcnt(0)" ::: "memory");
    __syncthreads();
    if (threadIdx.x == 0) {
        unsigned* bar = b.bar;
        __builtin_amdgcn_s_waitcnt(0);
        unsigned nloc = b.st[0], nx = b.st[1];
        if (nloc == 0u) { xcd_barrier_complete(bar, b.x, nloc, nx); b.st[0] = nloc; b.st[1] = nx; }
        const unsigned old = xb_add(&bar[XB_XSUB(b.x)], 1u);
        const unsigned gen = old / nloc;
        if (old + 1u == (gen + 1u) * nloc) {
            __builtin_amdgcn_fence(__ATOMIC_RELEASE, "agent");
            asm volatile("s_waitcnt vmcnt(0)" ::: "memory");
            const unsigned og = xb_add(&bar[XB_TOP], 1u);
            const unsigned tg = og / nx;
            if (og + 1u == (tg + 1u) * nx) xb_add(&bar[XB_TOPGEN], 1u);
            else XB_SPIN(xb_ld(&bar[XB_TOPGEN]) == tg, bar);
            __builtin_amdgcn_fence(__ATOMIC_ACQUIRE, "agent");
            xb_add(&bar[XB_XGEN(b.x)], 1u);
            asm volatile("s_waitcnt vmcnt(0)" ::: "memory");
        } else {
            XB_SPIN(xb_ld(&bar[XB_XGEN(b.x)]) == gen, bar);
            __builtin_amdgcn_fence(__ATOMIC_ACQUIRE, "agent");
            asm volatile("s_waitcnt vmcnt(0)" ::: "memory");
        }
    }
    __syncthreads();
}

#ifndef PROBE_DUP
#define PROBE_DUP 0
#endif
#define REP(bit) for (int rep_ = 0; rep_ < (((PROBE_DUP) >> (bit)) & 1) + 1; ++rep_)
#define PH1() { pg8::Gemm g{(const bf16_t*)(p.ws + WS_XN), (const bf16_t*)(p.ws + WS_WINT), T_TOK, NPROJ, DM}; pg8::StaticOrder S; S.init(T_TOK, NPROJ, G, bx); Epi1 E{(bf16_t*)(p.ws + WS_P), (float*)(p.ws + WS_PSSV)}; pg8::gemm_phase<Epi1, pg8::StaticOrder, true, true>(lds, g, S, E); xcd_barrier(xbar); }
#define PH3() { pg8::Gemm g{(const bf16_t*)(p.ws + WS_XN), (const bf16_t*)(p.ws + WS_WOUTT), T_TOK, DM, DM}; pg8::StaticOrder S; S.init(T_TOK, DM, G, bx); Epi2 E{p.x, (bf16_t*)(p.ws + WS_X1G), (float*)(p.ws + WS_PSS2)}; pg8::gemm_phase<Epi2, pg8::StaticOrder, true, true>(lds, g, S, E); xcd_barrier(xbar); }
#define PH4() { pg8::Gemm g{(const bf16_t*)(p.ws + WS_X1G), (const bf16_t*)(p.ws + WS_WQT), T_TOK, 1024, DM}; pg8::StaticOrder S; S.init(T_TOK, 1024, G, bx); Epi3 E{(bf16_t*)(p.ws + WS_Q), (const float*)(p.ws + WS_PSS2)}; pg8::gemm_phase<Epi3, pg8::StaticOrder, true, true>(lds, g, S, E); xcd_barrier(xbar); }
__global__ void __launch_bounds__(NTHREADS, 2) hymba_fwd(Params p) {
    extern __shared__ __attribute__((aligned(16))) unsigned char smem[];
    LAS unsigned char* lds = (LAS unsigned char*)smem;
    cg::grid_group grid = cg::this_grid();
    const int G = gridDim.x, bx = blockIdx.x;
    unsigned* barw = (unsigned*)(p.ws + WS_BAR);
    volatile LAS unsigned* xst = (volatile LAS unsigned*)(lds + LDS_BYTES - 16);
    if (threadIdx.x < 4) xst[threadIdx.x] = 0u;
    if (bx == 0) { for (int i = threadIdx.x; i < XCD_BAR_WORDS; i += NTHREADS) barw[i] = 0u; }
    __syncthreads();
    REP(0) { phase0(p, lds); grid.sync(); }
    const XcdBarrier xbar = xcd_barrier_post(barw, xst);
    PH1()
#if (PROBE_DUP >> 1) & 1
    PH1()
#endif
    REP(2) {
        for (int si = bx; si < 256; si += G) {
            const int b = si >> 6, c = si & 63;
            gmlp_bc(p, lds, b, c);
            for (int h = 0; h < 4; ++h) mlstm_local(p, lds, b, c, h);
        }
        xcd_barrier(xbar);
    }
    REP(3) { phase_scan(p); xcd_barrier(xbar); }
    REP(4) { for (int it = bx; it < 1024; it += G) mlstm_out(p, lds, it >> 8, (it >> 2) & 63, it & 3); xcd_barrier(xbar); }
    PH3()
#if (PROBE_DUP >> 5) & 1
    PH3()
#endif
    PH4()
#if (PROBE_DUP >> 6) & 1
    PH4()
#endif
    REP(7) { peer_select(p); xcd_barrier(xbar); }
    peer_gather(p, lds);
}

extern "C" void kernel_launch(void* const* d_in, const int* in_sizes, int n_in, void* d_out, int out_size, void* d_ws, size_t ws_size, hipStream_t stream) {
    static int grid_blocks = 0;
    if (grid_blocks == 0) {
        if (n_in != 20 || ws_size < WS_END) { fprintf(stderr, "kernel_launch: unexpected n_in %d or ws_size %zu (need %zu)\n", n_in, ws_size, (size_t)WS_END); grid_blocks = -1; return; }
        int dev = 0, cus = 0, per_cu = 0;
        hipGetDevice(&dev);
        hipDeviceGetAttribute(&cus, hipDeviceAttributeMultiprocessorCount, dev);
        hipFuncSetAttribute((const void*)hymba_fwd, hipFuncAttributeMaxDynamicSharedMemorySize, LDS_BYTES);
        hipOccupancyMaxActiveBlocksPerMultiprocessor(&per_cu, (const void*)hymba_fwd, NTHREADS, LDS_BYTES);
        if (per_cu < 1) { fprintf(stderr, "kernel_launch: occupancy query says %d blocks per CU\n", per_cu); per_cu = 1; }
        if (per_cu > 1) per_cu = 1;
        grid_blocks = cus * per_cu;
        (void)hipGetLastError();
    }
    if (grid_blocks < 0) return;
    Params p{};
    p.x = (const float*)d_in[0]; p.norm1_g = (const float*)d_in[1]; p.w_in = (const float*)d_in[2]; p.gm_vnorm_g = (const float*)d_in[3];
    p.w_spatial = (const float*)d_in[4]; p.b_spatial = (const float*)d_in[5]; p.ml_conv_w = (const float*)d_in[6]; p.ml_conv_b = (const float*)d_in[7];
    p.ml_b_i = (const float*)d_in[8]; p.ml_b_f = (const float*)d_in[9]; p.gm_out_g = (const float*)d_in[10]; p.ml_out_g = (const float*)d_in[11];
    p.w_out = (const float*)d_in[12]; p.norm2_g = (const float*)d_in[13]; p.peer_wq = (const float*)d_in[14]; p.peer_k1 = (const float*)d_in[15];
    p.peer_k2 = (const float*)d_in[16]; p.peer_u = (const float*)d_in[17]; p.peer_v = (const float*)d_in[18]; p.final_g = (const float*)d_in[19];
    p.out = (float*)d_out; p.ws = (unsigned char*)d_ws;
    void* args[] = {&p};
    hipError_t e = hipLaunchCooperativeKernel((const void*)hymba_fwd, dim3(grid_blocks), dim3(NTHREADS), args, LDS_BYTES, stream);
    if (e != hipSuccess) fprintf(stderr, "cooperative launch failed: %s (grid %d)\n", hipGetErrorString(e), grid_blocks);
}
```

```cpp
#include <hip/hip_runtime.h>
#include <hip/hip_cooperative_groups.h>
#include <cstdio>
#include <cstdint>
namespace cg = cooperative_groups;
namespace pg8 {
#define PG8_LAS __attribute__((address_space(3)))
typedef unsigned short bf16_t;
typedef short bf16x8 __attribute__((ext_vector_type(8)));
typedef float f32x4 __attribute__((ext_vector_type(4)));
typedef unsigned u32x4 __attribute__((ext_vector_type(4)));
constexpr int BM = 256, BK = 64, HALF = 128, HTB = HALF * BK * 2  , STAGE_BYTES = 8 * HTB, NXCD = 8, WGM = 8;

__host__ __device__ __forceinline__ int lds_byte(int r, int c) { const int st = (r >> 4) * 2 + (c >> 5), rr = r & 15, cc = c & 31, ob = rr * 64 + cc * 2; return st * 1024 + (ob ^ (((ob >> 9) & 1) << 5)); }
__host__ __device__ __forceinline__ void stage_rc(int b, int& R, int& C) { const int st = b / 1024, sb = b % 1024, swz = sb ^ (((sb >> 9) & 1) << 5); R = (st >> 1) * 16 + swz / 64; C = (st & 1) * 32 + (swz % 64) / 2; }
__host__ __device__ __forceinline__ int perm32(int rho) { const int n = rho >> 4, i = rho & 15; return 8 * (i >> 2) + 4 * n + (i & 3); }

struct Unit { int pm, pn; };
struct Gemm { const bf16_t* A; const bf16_t* Bt; int M, N, K; };

struct StaticOrder {
    int nM, nN, nwg, G, c;
    __host__ __device__ void init(int M, int N, int G_, int c_) { nM = M / BM; nN = N / BM; nwg = nM * nN; G = G_; c = c_; }
    __host__ __device__ bool next(int i, Unit& u) const {
        const long L = (long)i * G + c; if (L >= nwg) return false;
        int wgid = (int)L; { const int q = nwg / NXCD, r = nwg % NXCD, xcd = wgid % NXCD, off = wgid / NXCD; wgid = (xcd < r ? xcd * (q + 1) : r * (q + 1) + (xcd - r) * q) + off; }
        const int nig = WGM * nN, gid = wgid / nig, fm = gid * WGM, gsz = (nM - fm) < WGM ? (nM - fm) : WGM;
        u.pm = fm + ((wgid % nig) % gsz); u.pn = (wgid % nig) / gsz; return true;
    }
    __device__ __forceinline__ void a_ready(const Unit&) const {}
    __device__ __forceinline__ void done(const Unit&) const {}
};
__device__ __forceinline__ unsigned cvt_pk_bf16(float lo, float hi) { unsigned r; asm volatile("v_cvt_pk_bf16_f32 %0, %1, %2" : "=v"(r) : "v"(lo), "v"(hi)); return r; }
template <class Epi, class Sched, bool ALIGN_EPI = false, bool SP2 = false>
__device__ __forceinline__ void gemm_phase(PG8_LAS unsigned char* lds, const Gemm g, const Sched& S, const Epi& E) {
    const int tid = threadIdx.x, wid = __builtin_amdgcn_readfirstlane(tid >> 6), lane = tid & 63, wr = wid >> 2, wc = wid & 3, fr = lane & 15, fq = lane >> 4;
    const int K = g.K, nt = K / BK;
    unsigned voffA[2], voffB[2];
#pragma unroll
    for (int i = 0; i < 2; ++i) { int R, C; stage_rc(tid * 16 + i * 8192, R, C); const int Rb = Epi::PERM ? ((R & ~31) + perm32(R & 31)) : R;
        voffA[i] = (unsigned)(R * K + C) * 2u; voffB[i] = (unsigned)(Rb * K + C) * 2u; }
    const size_t kstep = (size_t)(BK * 2);
    const size_t hstep = (size_t)HALF * K * 2;
    const size_t tstep = 2 * hstep;
    const unsigned ldsw = (unsigned)wid * 1024u;
    const int aoff = lds_byte(wr * 64 + fr, fq * 8), boff = lds_byte(wc * 32 + fr, fq * 8);
#define PG8_SA(b, h) (((b) * 2 + (h)) * HTB)
#define PG8_SB(b, h) ((4 + (b) * 2 + (h)) * HTB)
#define PG8_STAGE(bufoff, gbase, voff) do { _Pragma("unroll") for (int _i = 0; _i < 2; ++_i) \
        __builtin_amdgcn_global_load_lds((const unsigned*)((const char*)(gbase) + (voff)[_i]), (PG8_LAS unsigned*)(lds + (bufoff) + ldsw + _i * 8192), 16, 0, 0); } while (0)
#define PG8_LDA(dst, b, h) do { _Pragma("unroll") for (int m = 0; m < 4; ++m) _Pragma("unroll") for (int k = 0; k < 2; ++k) dst[m][k] = *(const PG8_LAS bf16x8*)(lds + PG8_SA(b, h) + aoff + m * 2048 + k * 1024); } while (0)
#define PG8_LDB(dst, b, h) do { _Pragma("unroll") for (int n = 0; n < 2; ++n) _Pragma("unroll") for (int k = 0; k < 2; ++k) dst[n][k] = *(const PG8_LAS bf16x8*)(lds + PG8_SB(b, h) + boff + n * 2048 + k * 1024); } while (0)
#define PG8_MMA(ai, bj, At, Bt) do { __builtin_amdgcn_s_setprio(1); _Pragma("unroll") for (int m = 0; m < 4; ++m) _Pragma("unroll") for (int n = 0; n < 2; ++n) _Pragma("unroll") for (int k = 0; k < 2; ++k) \
        acc[ai][bj][m][n] = __builtin_amdgcn_mfma_f32_16x16x32_bf16(Bt[n][k], At[m][k], acc[ai][bj][m][n], 0, 0, 0); __builtin_amdgcn_s_setprio(0); } while (0)
#define PG8_WAIT_V(n) asm volatile("s_waitcnt vmcnt(" #n ")" ::: "memory")
#define PG8_WAIT_L(n) asm volatile("s_waitcnt lgkmcnt(" #n ")" ::: "memory")
#define PG8_BAR __builtin_amdgcn_s_barrier()
#define PG8_SCHED __builtin_amdgcn_sched_barrier(0)
    Unit cur, nxt; int ui = 0;
    if (!S.next(0, cur)) return;
    f32x4 acc[2][2][4][2];
#pragma unroll
    for (int a = 0; a < 2; ++a)
#pragma unroll
        for (int b = 0; b < 2; ++b)
#pragma unroll
            for (int m = 0; m < 4; ++m)
#pragma unroll
                for (int n = 0; n < 2; ++n) acc[a][b][m][n] = (f32x4){0.f, 0.f, 0.f, 0.f};
    bf16x8 At[4][2], B0[2][2], B1[2][2];
    const char* cA = (const char*)g.A + (size_t)cur.pm * tstep; const char* cB = (const char*)g.Bt + (size_t)cur.pn * tstep;
    S.a_ready(cur);
    if constexpr (SP2) {
        PG8_STAGE(PG8_SB(0, 0), cB, voffB); PG8_STAGE(PG8_SB(0, 1), cB + hstep, voffB); PG8_STAGE(PG8_SA(0, 0), cA, voffA); PG8_STAGE(PG8_SA(0, 1), cA + hstep, voffA);
        if (wr == 1) PG8_BAR;
        PG8_WAIT_V(2); PG8_BAR;
        PG8_STAGE(PG8_SB(1, 0), cB + kstep, voffB); PG8_STAGE(PG8_SA(1, 0), cA + kstep, voffA); PG8_STAGE(PG8_SB(1, 1), cB + hstep + kstep, voffB);
        PG8_WAIT_V(6); PG8_BAR;
    } else {
        PG8_STAGE(PG8_SB(0, 0), cB, voffB); PG8_STAGE(PG8_SA(0, 0), cA, voffA); PG8_STAGE(PG8_SB(0, 1), cB + hstep, voffB); PG8_STAGE(PG8_SA(0, 1), cA + hstep, voffA);
        if (wr == 1) PG8_BAR;
        PG8_WAIT_V(4); PG8_BAR;
        PG8_STAGE(PG8_SB(1, 0), cB + kstep, voffB); PG8_STAGE(PG8_SA(1, 0), cA + kstep, voffA); PG8_STAGE(PG8_SB(1, 1), cB + hstep + kstep, voffB);
        PG8_WAIT_V(6); PG8_BAR;
    }
    for (;;) {
        const bool has_next = S.next(ui + 1, nxt);
        const char* nA = has_next ? (const char*)g.A + (size_t)nxt.pm * tstep : cA; const char* nB = has_next ? (const char*)g.Bt + (size_t)nxt.pn * tstep : cB;
        for (int t = 0; t < nt; t += 2) {
            const bool last = (t == nt - 2);
            const char* a1 = cA + (size_t)(t + 1) * kstep;
            const char* a2 = last ? nA : cA + (size_t)(t + 2) * kstep; const char* b2 = last ? nB : cB + (size_t)(t + 2) * kstep;
            const char* a3 = a2 + kstep; const char* b3 = b2 + kstep;
            if (last && has_next) S.a_ready(nxt);
            if constexpr (SP2) {
            PG8_LDB(B0, 0, 0); PG8_LDB(B1, 0, 1); PG8_SCHED; PG8_LDA(At, 0, 0); PG8_STAGE(PG8_SA(1, 1), a1 + hstep, voffA);
            PG8_WAIT_V(8); PG8_WAIT_L(0); PG8_BAR; PG8_MMA(0, 0, At, B0); PG8_MMA(0, 1, At, B1); PG8_BAR; PG8_SCHED;
            PG8_LDA(At, 0, 1); PG8_STAGE(PG8_SB(0, 0), b2, voffB); PG8_STAGE(PG8_SB(0, 1), b2 + hstep, voffB); PG8_STAGE(PG8_SA(0, 0), a2, voffA);
            PG8_WAIT_V(8); PG8_WAIT_L(0); PG8_BAR; PG8_MMA(1, 0, At, B0); PG8_MMA(1, 1, At, B1); PG8_BAR; PG8_SCHED;
            PG8_LDB(B0, 1, 0); PG8_LDB(B1, 1, 1); PG8_SCHED; PG8_LDA(At, 1, 0); PG8_STAGE(PG8_SA(0, 1), a2 + hstep, voffA);
            PG8_WAIT_V(8); PG8_WAIT_L(0); PG8_BAR; PG8_MMA(0, 0, At, B0); PG8_MMA(0, 1, At, B1); PG8_BAR; PG8_SCHED;
            PG8_LDA(At, 1, 1); PG8_STAGE(PG8_SB(1, 0), b3, voffB); PG8_STAGE(PG8_SB(1, 1), b3 + hstep, voffB); PG8_STAGE(PG8_SA(1, 0), a3, voffA);
            PG8_WAIT_V(8); PG8_WAIT_L(0); PG8_BAR; PG8_MMA(1, 0, At, B0); PG8_MMA(1, 1, At, B1); PG8_BAR; PG8_SCHED;
            } else {
            PG8_LDB(B0, 0, 0); PG8_SCHED; PG8_LDA(At, 0, 0); PG8_STAGE(PG8_SA(1, 1), a1 + hstep, voffA);
            PG8_WAIT_L(8); PG8_BAR; PG8_WAIT_L(0); PG8_MMA(0, 0, At, B0); PG8_BAR; PG8_SCHED;
            PG8_LDB(B1, 0, 1); PG8_STAGE(PG8_SB(0, 0), b2, voffB);
            PG8_BAR; PG8_WAIT_L(0); PG8_MMA(0, 1, At, B1); PG8_BAR;
            PG8_LDA(At, 0, 1); PG8_STAGE(PG8_SA(0, 0), a2, voffA);
            PG8_BAR; PG8_WAIT_L(0); PG8_MMA(1, 0, At, B0); PG8_BAR; PG8_SCHED;
            PG8_STAGE(PG8_SB(0, 1), b2 + hstep, voffB);
            PG8_WAIT_V(6); PG8_BAR; PG8_MMA(1, 1, At, B1); PG8_BAR;
            PG8_LDB(B0, 1, 0); PG8_SCHED; PG8_LDA(At, 1, 0); PG8_STAGE(PG8_SA(0, 1), a2 + hstep, voffA);
            PG8_WAIT_L(8); PG8_BAR; PG8_WAIT_L(0); PG8_MMA(0, 0, At, B0); PG8_BAR; PG8_SCHED;
            PG8_LDB(B1, 1, 1); PG8_STAGE(PG8_SB(1, 0), b3, voffB);
            PG8_BAR; PG8_WAIT_L(0); PG8_MMA(0, 1, At, B1); PG8_BAR;
            PG8_LDA(At, 1, 1); PG8_STAGE(PG8_SA(1, 0), a3, voffA);
            PG8_BAR; PG8_WAIT_L(0); PG8_MMA(1, 0, At, B0); PG8_BAR; PG8_SCHED;
            PG8_STAGE(PG8_SB(1, 1), b3 + hstep, voffB);
            PG8_WAIT_V(6); PG8_BAR; PG8_MMA(1, 1, At, B1); PG8_BAR;
            }
        }
        if constexpr (ALIGN_EPI) { if (wr == 0) PG8_BAR; }
        if constexpr (!Epi::AFTER_DRAIN) { E(acc, cur, wr, wc, fr, fq); S.done(cur); }
        if (!has_next) break;
#pragma unroll
        for (int a = 0; a < 2; ++a)
#pragma unroll
            for (int b = 0; b < 2; ++b)
#pragma unroll
                for (int m = 0; m < 4; ++m)
#pragma unroll
                    for (int n = 0; n < 2; ++n) acc[a][b][m][n] = (f32x4){0.f, 0.f, 0.f, 0.f};
        cur = nxt; cA = nA; cB = nB; ++ui;
        if constexpr (ALIGN_EPI) { if (wr == 1) PG8_BAR; }
    }
    PG8_WAIT_V(0);
    if constexpr (!ALIGN_EPI) { if (wr == 0) PG8_BAR; }
    PG8_BAR;
    if constexpr (Epi::AFTER_DRAIN) { E.fused(acc, cur, wr, wc, fr, fq, lds, wid, lane); S.done(cur); }
#undef PG8_SA
#undef PG8_SB
#undef PG8_STAGE
#undef PG8_LDA
#undef PG8_LDB
#undef PG8_MMA
#undef PG8_WAIT_V
#undef PG8_WAIT_L
#undef PG8_BAR
#undef PG8_SCHED
}
}

#define LAS __attribute__((address_space(3)))
#define DI __device__ __forceinline__
using pg8::bf16_t; using pg8::bf16x8; using pg8::f32x4; using pg8::u32x4; using pg8::cvt_pk_bf16;
typedef unsigned u32x2 __attribute__((ext_vector_type(2)));
typedef float f32x2 __attribute__((ext_vector_type(2)));

constexpr int T_TOK = 32768, DM = 2048, NPROJ = 5120, PROJW = 5128;
constexpr int NTHREADS = 512;
constexpr int LDS_BYTES = 147456;
constexpr float EPS = 1e-6f;

constexpr size_t WS_XN = 0;
constexpr size_t WS_P = 134217728;
constexpr size_t WS_X1G = WS_P;
constexpr size_t WS_Q = WS_P + 134217728;
constexpr size_t WS_WINT = WS_P + 335544320;
constexpr size_t WS_WOUTT = WS_WINT + 20971520;
constexpr size_t WS_WQT = WS_WOUTT + 8388608;
constexpr size_t WS_UB = WS_WQT + 4194304;
constexpr size_t WS_VB = WS_UB + 67108864;
constexpr size_t WS_ST = WS_VB + 67108864;
constexpr size_t WS_CPT = WS_ST + 142606336;
constexpr size_t WS_QC = WS_CPT + 71303168;
constexpr size_t WS_KC = WS_QC + 33554432;
constexpr size_t WS_IG = WS_KC + 33554432;
constexpr size_t WS_LF = WS_IG + 524288;
constexpr size_t WS_PSSV = WS_LF + 524288;
constexpr size_t WS_PSS2 = WS_PSSV + 2097152;
constexpr size_t WS_BEND = WS_PSS2 + 4194304;
constexpr size_t WS_GMAX = WS_BEND + 4096;
constexpr size_t WS_MPREV = WS_GMAX + 4096;
constexpr size_t WS_SELID = WS_MPREV + 4096;
constexpr size_t WS_SELG = WS_SELID + 16777216;
constexpr size_t WS_KB1 = WS_SELG + 16777216;
constexpr size_t WS_KB2 = WS_KB1 + 131072;
constexpr size_t WS_BAR = WS_KB2 + 131072;
constexpr size_t WS_END = WS_BAR + 16384;

struct Params {
    const float *x, *norm1_g, *w_in, *gm_vnorm_g, *w_spatial, *b_spatial, *ml_conv_w, *ml_conv_b, *ml_b_i, *ml_b_f, *gm_out_g, *ml_out_g, *w_out, *norm2_g,
        *peer_wq, *peer_k1, *peer_k2, *peer_u, *peer_v, *final_g;
    float* out;
    unsigned char* ws;
};

template <int CB, int H, int W> DI size_t p_off(int t, int h, int d) { return (size_t)T_TOK * CB + ((size_t)((t >> 7) * H + h) * 128 + (t & 127)) * W + d; }
DI float bf2f(unsigned short h) { return __uint_as_float(((unsigned)h) << 16); }
DI float bflo(unsigned w) { return __uint_as_float(w << 16); }
DI float bfhi(unsigned w) { return __uint_as_float(w & 0xffff0000u); }
DI float rcpf_(float x) { return __builtin_amdgcn_rcpf(x); }
DI float sigmoid_(float x) { return rcpf_(1.f + __expf(-x)); }
DI float gelu_t(float x) { const float z = 1.5957691216057308f * (x + 0.044715f * x * x * x); return x * rcpf_(1.f + __expf(-z)); }
DI float wave_sum(float v) {
#pragma unroll
    for (int o = 32; o; o >>= 1) v += __shfl_xor(v, o);
    return v;
}
DI float wave_max(float v) {
#pragma unroll
    for (int o = 32; o; o >>= 1) v = fmaxf(v, __shfl_xor(v, o));
    return v;
}
DI bf16x8 ld_frag_lds(const LAS unsigned char* p) { return *(const LAS bf16x8*)p; }
#define MFMA16(a, b, c) __builtin_amdgcn_mfma_f32_16x16x32_bf16((a), (b), (c), 0, 0, 0)

struct Epi1 {
    static constexpr bool PERM = true, AFTER_DRAIN = false;
    bf16_t* P; float* pssv;
    DI void operator()(const f32x4 (&acc)[2][2][4][2], const pg8::Unit& u, int wr, int wc, int fr, int fq) const {
        const int row0 = u.pm * 256 + wr * 64 + fr, col0 = u.pn * 256 + wc * 32 + 8 * fq;
        const int mode = u.pn < 8 ? 1 : (u.pn >= 16 ? 2 : 0);
        const bool want_ss = (u.pn >= 4 && u.pn < 8);
#pragma unroll
        for (int ai = 0; ai < 2; ++ai)
#pragma unroll
            for (int m = 0; m < 4; ++m) {
                const int row = row0 + ai * 128 + m * 16;
                const int CB = u.pn < 4 ? 0 : (u.pn < 8 ? 1024 : (u.pn < 10 ? 2048 : (u.pn < 12 ? 2560 : (u.pn < 16 ? 3072 : 4096))));
                const int lw = u.pn < 12 ? 7 : 8, H = u.pn < 8 ? 8 : 4;
                float ss = 0.f;
#pragma unroll
                for (int bj = 0; bj < 2; ++bj) {
                    f32x4 v0 = acc[ai][bj][m][0], v1 = acc[ai][bj][m][1];
                    if (mode == 1) {
#pragma unroll
                        for (int j = 0; j < 4; ++j) { v0[j] = gelu_t(v0[j]); v1[j] = gelu_t(v1[j]); ss += v0[j] * v0[j] + v1[j] * v1[j]; }
                    } else if (mode == 2) {
#pragma unroll
                        for (int j = 0; j < 4; ++j) { v0[j] = sigmoid_(v0[j]); v1[j] = sigmoid_(v1[j]); }
                    }
                    u32x4 w; w.x = cvt_pk_bf16(v0[0], v0[1]); w.y = cvt_pk_bf16(v0[2], v0[3]); w.z = cvt_pk_bf16(v1[0], v1[1]); w.w = cvt_pk_bf16(v1[2], v1[3]);
                    {
                        const int cr = col0 + bj * 128 - CB, hh = cr >> lw, d = cr & ((1 << lw) - 1);
                        *(u32x4*)(P + (size_t)T_TOK * CB + (((size_t)((row >> 7) * H + hh) * 128 + (row & 127)) << lw) + d) = w;
                    }
                }
                if (want_ss) {
                    ss += __shfl_xor(ss, 16); ss += __shfl_xor(ss, 32);
                    if (fq == 0) pssv[(size_t)row * 16 + (u.pn - 4) * 4 + wc] = ss;
                }
            }
    }
};

struct Epi2 {
    static constexpr bool PERM = true, AFTER_DRAIN = false;
    const float* x; bf16_t* x1b; float* pss2;
    DI void operator()(const f32x4 (&acc)[2][2][4][2], const pg8::Unit& u, int wr, int wc, int fr, int fq) const {
        const int row0 = u.pm * 256 + wr * 64 + fr, col0 = u.pn * 256 + wc * 32 + 8 * fq;
#pragma unroll
        for (int ai = 0; ai < 2; ++ai)
#pragma unroll
            for (int m = 0; m < 4; ++m) {
                const int row = row0 + ai * 128 + m * 16;
                float ss = 0.f;
#pragma unroll
                for (int bj = 0; bj < 2; ++bj) {
                    const size_t o = (size_t)row * DM + col0 + bj * 128;
                    const f32x4 v0 = acc[ai][bj][m][0] + *(const f32x4*)(x + o), v1 = acc[ai][bj][m][1] + *(const f32x4*)(x + o + 4);
#pragma unroll
                    for (int j = 0; j < 4; ++j) ss += v0[j] * v0[j] + v1[j] * v1[j];
                    u32x4 w; w.x = cvt_pk_bf16(v0[0], v0[1]); w.y = cvt_pk_bf16(v0[2], v0[3]); w.z = cvt_pk_bf16(v1[0], v1[1]); w.w = cvt_pk_bf16(v1[2], v1[3]);
                    *(u32x4*)(x1b + o) = w;
                }
                ss += __shfl_xor(ss, 16); ss += __shfl_xor(ss, 32);
                if (fq == 0) pss2[(size_t)row * 32 + u.pn * 4 + wc] = ss;
            }
    }
};

struct Epi3 {
    static constexpr bool PERM = true, AFTER_DRAIN = false;
    bf16_t* Q; const float* pss2;
    DI void operator()(const f32x4 (&acc)[2][2][4][2], const pg8::Unit& u, int wr, int wc, int fr, int fq) const {
        const int row0 = u.pm * 256 + wr * 64 + fr, col0 = u.pn * 256 + wc * 32 + 8 * fq;
#pragma unroll
        for (int ai = 0; ai < 2; ++ai)
#pragma unroll
            for (int m = 0; m < 4; ++m) {
                const int row = row0 + ai * 128 + m * 16;
                float ss = 0.f;
#pragma unroll
                for (int i = 0; i < 8; ++i) { const f32x4 t = *(const f32x4*)(pss2 + (size_t)row * 32 + i * 4); ss += (t[0] + t[1]) + (t[2] + t[3]); }
                const float rstd = rsqrtf(ss * (1.f / 2048.f) + EPS);
#pragma unroll
                for (int bj = 0; bj < 2; ++bj) {
                    const f32x4 v0 = acc[ai][bj][m][0] * rstd, v1 = acc[ai][bj][m][1] * rstd;
                    u32x4 w; w.x = cvt_pk_bf16(v0[0], v0[1]); w.y = cvt_pk_bf16(v0[2], v0[3]); w.z = cvt_pk_bf16(v1[0], v1[1]); w.w = cvt_pk_bf16(v1[2], v1[3]);
                    *(u32x4*)(Q + (size_t)row * 1024 + col0 + bj * 128) = w;
                }
            }
    }
};

DI void phase0(const Params& p, LAS unsigned char* lds) {
    const int tid = threadIdx.x, lane = tid & 63, wave = tid >> 6;
    bf16_t* XN = (bf16_t*)(p.ws + WS_XN);
    {
        LAS float* scr = (LAS float*)lds + wave * (64 * 65);
        const int gw = blockIdx.x * 8 + wave, nw = gridDim.x * 8;
        for (int it = gw; it < 4096; it += nw) {
            const float* W; bf16_t* WT; int ldw, kt, nt;
            if (it < 2560) { W = p.w_in; WT = (bf16_t*)(p.ws + WS_WINT); ldw = PROJW; kt = it / 80; nt = it % 80; }
            else if (it < 3584) { const int j = it - 2560; W = p.w_out; WT = (bf16_t*)(p.ws + WS_WOUTT); ldw = 2048; kt = j >> 5; nt = j & 31; }
            else { const int j = it - 3584; W = p.peer_wq; WT = (bf16_t*)(p.ws + WS_WQT); ldw = 1024; kt = j >> 4; nt = j & 15; }
            const int k0 = kt * 64, n0 = nt * 64;
            {
                f32x4 tv[16];
#pragma unroll
                for (int i = 0; i < 16; ++i) tv[i] = *(const f32x4*)(W + (size_t)(k0 + 4 * i + (lane >> 4)) * ldw + n0 + 4 * (lane & 15));
#pragma unroll
                for (int i = 0; i < 16; ++i) {
                    const int r = 4 * i + (lane >> 4);
                    const float gsc = it >= 3584 ? p.norm2_g[k0 + r] : 1.f;
                    LAS float* d = scr + r * 65 + 4 * (lane & 15);
                    d[0] = tv[i][0] * gsc; d[1] = tv[i][1] * gsc; d[2] = tv[i][2] * gsc; d[3] = tv[i][3] * gsc;
                }
            }
            __builtin_amdgcn_fence(__ATOMIC_RELEASE, "wavefront"); __builtin_amdgcn_wave_barrier(); __builtin_amdgcn_fence(__ATOMIC_ACQUIRE, "wavefront");
            const int half = lane >> 5, kk = (lane & 31) * 2;
#pragma unroll 8
            for (int nn = 0; nn < 32; ++nn) {
                const int n = 2 * nn + half; const float a = scr[kk * 65 + n], b = scr[(kk + 1) * 65 + n];
                *(unsigned*)(WT + (size_t)(n0 + n) * 2048 + k0 + kk) = cvt_pk_bf16(a, b);
            }
            __builtin_amdgcn_fence(__ATOMIC_RELEASE, "wavefront"); __builtin_amdgcn_wave_barrier(); __builtin_amdgcn_fence(__ATOMIC_ACQUIRE, "wavefront");
        }
    }
    __syncthreads();
    {
        LAS float* wg = (LAS float*)lds;
        for (int idx = tid; idx < 4096; idx += NTHREADS) {
            const int k = idx >> 1, hf = idx & 1;
            const f32x4 v = *(const f32x4*)(p.w_in + (size_t)k * PROJW + 5120 + hf * 4);
            *(LAS f32x4*)(wg + k * 8 + (k >> 3) * 4 + hf * 4) = v;
        }
        __syncthreads();
        float* IG = (float*)(p.ws + WS_IG); float* LF = (float*)(p.ws + WS_LF);
        for (int row0 = 2 * (blockIdx.x * 8 + wave); row0 < T_TOK; row0 += 2 * gridDim.x * 8) {
            f32x4 xv[2][8];
#pragma unroll
            for (int rr = 0; rr < 2; ++rr) {
                const float* xr = p.x + (size_t)(row0 + rr) * DM;
#pragma unroll
                for (int i = 0; i < 4; ++i) { xv[rr][2 * i] = *(const f32x4*)(xr + i * 512 + lane * 8); xv[rr][2 * i + 1] = *(const f32x4*)(xr + i * 512 + lane * 8 + 4); }
            }
#pragma unroll
            for (int rr = 0; rr < 2; ++rr) {
                const int row = row0 + rr;
                float ss = 0.f;
#pragma unroll
                for (int i = 0; i < 8; ++i) ss += (xv[rr][i][0] * xv[rr][i][0] + xv[rr][i][1] * xv[rr][i][1]) + (xv[rr][i][2] * xv[rr][i][2] + xv[rr][i][3] * xv[rr][i][3]);
                ss = wave_sum(ss);
                const float rstd = rsqrtf(ss * (1.f / 2048.f) + EPS);
                f32x4 ga = {0.f, 0.f, 0.f, 0.f}, gb = {0.f, 0.f, 0.f, 0.f};
#pragma unroll
                for (int i = 0; i < 4; ++i) {
                    const f32x4 g0 = *(const f32x4*)(p.norm1_g + i * 512 + lane * 8), g1 = *(const f32x4*)(p.norm1_g + i * 512 + lane * 8 + 4);
                    const f32x4 h0 = xv[rr][2 * i] * rstd * g0, h1 = xv[rr][2 * i + 1] * rstd * g1;
                    u32x4 w; w.x = cvt_pk_bf16(h0[0], h0[1]); w.y = cvt_pk_bf16(h0[2], h0[3]); w.z = cvt_pk_bf16(h1[0], h1[1]); w.w = cvt_pk_bf16(h1[2], h1[3]);
                    *(u32x4*)(XN + (size_t)row * DM + i * 512 + lane * 8) = w;
                    const LAS float* wb = wg + (i * 512 + lane * 8) * 8 + (i * 64 + lane) * 4;
#pragma unroll
                    for (int e = 0; e < 8; ++e) {
                        const float hv = e < 4 ? h0[e & 3] : h1[e & 3];
                        const f32x4 w0 = *(const LAS f32x4*)(wb + e * 8), w1 = *(const LAS f32x4*)(wb + e * 8 + 4);
                        ga = ga + w0 * hv; gb = gb + w1 * hv;
                    }
                }
                f32x4 m4 = lane < 32 ? ga : gb, s4 = lane < 32 ? gb : ga;
#pragma unroll
                for (int j = 0; j < 4; ++j) m4[j] += __shfl_xor(s4[j], 32);
                const bool up16 = (lane & 16) != 0;
                float m2a = up16 ? m4[2] : m4[0], m2b = up16 ? m4[3] : m4[1];
                const float s2a = up16 ? m4[0] : m4[2], s2b = up16 ? m4[1] : m4[3];
                m2a += __shfl_xor(s2a, 16); m2b += __shfl_xor(s2b, 16);
                const bool up8 = (lane & 8) != 0;
                float m1 = up8 ? m2b : m2a; const float s1 = up8 ? m2a : m2b;
                m1 += __shfl_xor(s1, 8);
                m1 += __shfl_xor(m1, 4); m1 += __shfl_xor(m1, 2); m1 += __shfl_xor(m1, 1);
                const int j = ((lane >> 5) << 2) | (((lane >> 4) & 1) << 1) | ((lane >> 3) & 1);
                if ((lane & 7) == 0) {
                    if (j < 4) IG[(size_t)row * 4 + j] = m1 + p.ml_b_i[j];
                    else { const float z = m1 + p.ml_b_f[j - 4]; LF[(size_t)row * 4 + j - 4] = fminf(z, 0.f) - log1pf(__expf(-fabsf(z))); }
                }
            }
        }
    }
    {
        const size_t nthr = (size_t)gridDim.x * NTHREADS, NQ = (size_t)16384 * 512;
        for (size_t base = (size_t)blockIdx.x * NTHREADS + tid; base < 2 * NQ; base += 16 * nthr) {
            f32x4 v[16];
#pragma unroll
            for (int u = 0; u < 16; ++u) {
                size_t i = base + u * nthr; if (i >= 2 * NQ) i = base;
                const int which = i >= NQ; const size_t j = i - (which ? NQ : 0);
                v[u] = *(const f32x4*)((which ? p.peer_v : p.peer_u) + j * 4);
            }
#pragma unroll
            for (int u = 0; u < 16; ++u) {
                size_t i = base + u * nthr; if (i >= 2 * NQ) i = base;
                const int which = i >= NQ; const size_t j = i - (which ? NQ : 0);
                const int row = (int)(j >> 9), c4 = (int)(j & 511);
                float amax = fmaxf(fmaxf(fabsf(v[u][0]), fabsf(v[u][1])), fmaxf(fabsf(v[u][2]), fabsf(v[u][3])));
                amax = fmaxf(amax, __uint_as_float((unsigned)__builtin_amdgcn_update_dpp(0, (int)__float_as_uint(amax), 0xB1, 0xF, 0xF, true)));
                amax = fmaxf(amax, __uint_as_float((unsigned)__builtin_amdgcn_update_dpp(0, (int)__float_as_uint(amax), 0x4E, 0xF, 0xF, true)));
                amax = fmaxf(amax, __uint_as_float((unsigned)__builtin_amdgcn_update_dpp(0, (int)__float_as_uint(amax), 0x141, 0xF, 0xF, true)));
                amax = fmaxf(amax, __uint_as_float((unsigned)__builtin_amdgcn_update_dpp(0, (int)__float_as_uint(amax), 0x140, 0xF, 0xF, true)));
                const unsigned sb = cvt_pk_bf16(amax * (1.f / 6.f), 0.f) & 0xffffu;
                float sc = bflo(sb); if (sc == 0.f) sc = 1.f;
                const float inv = 1.f / sc;
                unsigned r = 0u;
                r = __builtin_amdgcn_cvt_scalef32_pk_fp4_f32(r, v[u][0] * inv, v[u][1] * inv, 1.0f, 0);
                r = __builtin_amdgcn_cvt_scalef32_pk_fp4_f32(r, v[u][2] * inv, v[u][3] * inv, 1.0f, 1);
                unsigned char* dst = p.ws + (which ? WS_VB : WS_UB) + (size_t)row * 1088;
                *(unsigned short*)(dst + c4 * 2) = (unsigned short)(r & 0xffffu);
                if ((c4 & 15) == 0) *(unsigned short*)(dst + 1024 + (c4 >> 4) * 2) = (unsigned short)(sb == 0u ? 0x3F80u : sb);
            }
        }
    }
    {
        bf16_t* KB1 = (bf16_t*)(p.ws + WS_KB1); bf16_t* KB2 = (bf16_t*)(p.ws + WS_KB2);
        for (int i = blockIdx.x * NTHREADS + tid; i < 65536 / 4; i += gridDim.x * NTHREADS) {
            const f32x4 a = *(const f32x4*)(p.peer_k1 + i * 4), b = *(const f32x4*)(p.peer_k2 + i * 4);
            u32x2 w; w.x = cvt_pk_bf16(a[0], a[1]); w.y = cvt_pk_bf16(a[2], a[3]); *(u32x2*)(KB1 + i * 4) = w;
            w.x = cvt_pk_bf16(b[0], b[1]); w.y = cvt_pk_bf16(b[2], b[3]); *(u32x2*)(KB2 + i * 4) = w;
        }
    }
}

#define WAVE_LDS_SYNC() do { __builtin_amdgcn_fence(__ATOMIC_RELEASE, "wavefront"); __builtin_amdgcn_wave_barrier(); __builtin_amdgcn_fence(__ATOMIC_ACQUIRE, "wavefront"); } while (0)

template <int NG> DI void stage_T_load(const bf16_t* src, int ld, u32x4 (&r0)[NG], u32x4 (&r1)[NG], int wave, int lane) {
#pragma unroll
    for (int i = 0; i < NG; ++i) {
        const int g = wave + 8 * i;
        r0[i] = *(const u32x4*)(src + (size_t)(2 * lane) * ld + g * 8);
        r1[i] = *(const u32x4*)(src + (size_t)(2 * lane + 1) * ld + g * 8);
    }
}
template <int NG> DI void stage_T_store(const u32x4 (&r0)[NG], const u32x4 (&r1)[NG], LAS unsigned char* dst, int wave, int lane) {
#pragma unroll
    for (int i = 0; i < NG; ++i) {
        const int g = wave + 8 * i;
#pragma unroll
        for (int w = 0; w < 4; ++w) {
            const unsigned a = r0[i][w], b = r1[i][w];
            *(LAS unsigned*)(dst + (g * 8 + 2 * w) * 272 + lane * 4) = (a & 0xffffu) | (b << 16);
            *(LAS unsigned*)(dst + (g * 8 + 2 * w + 1) * 272 + lane * 4) = (a >> 16) | (b & 0xffff0000u);
        }
    }
}
template <int NG> DI void stage_T(const bf16_t* src, int ld, LAS unsigned char* dst, int wave, int lane) {
    u32x4 r0[NG], r1[NG];
    stage_T_load<NG>(src, ld, r0, r1, wave, lane);
    stage_T_store<NG>(r0, r1, dst, wave, lane);
}

DI void gmlp_bc(const Params& p, LAS unsigned char* lds, int b, int c) {
    const int tid = threadIdx.x, lane = tid & 63, wave = __builtin_amdgcn_readfirstlane(tid >> 6), fr = lane & 15, fq = lane >> 4;
    const int t0 = b * 8192 + c * 128;
    LAS unsigned char* Wl = lds; LAS unsigned char* GvT = lds + 34816; LAS float* rstdv = (LAS float*)(lds + 69632);
    const bf16_t* P = (const bf16_t*)(p.ws + WS_P); bf16_t* YM = (bf16_t*)(p.ws + WS_XN);
    const float* PSSV = (const float*)(p.ws + WS_PSSV);
    __syncthreads();
    if (tid < 128) {
        float ss = 0.f;
#pragma unroll
        for (int i = 0; i < 4; ++i) { const f32x4 v = *(const f32x4*)(PSSV + (size_t)(t0 + tid) * 16 + i * 4); ss += (v[0] + v[1]) + (v[2] + v[3]); }
        rstdv[tid] = rsqrtf(ss * (1.f / 1024.f) + EPS);
    }
    f32x4 wa[4][2]; u32x4 gr0[2], gr1[2];
#define GMLP_PREFETCH(hh) do { _Pragma("unroll") for (int it = 0; it < 4; ++it) { const int e = (it * NTHREADS + tid) * 8, t = e >> 7, s0 = e & 127; \
            const float* wp = p.w_spatial + ((size_t)((hh) * 128 + t)) * 128 + s0; wa[it][0] = *(const f32x4*)wp; wa[it][1] = *(const f32x4*)(wp + 4); } \
        stage_T_load<2>(P + p_off<1024, 8, 128>(t0, (hh), 0), 128, gr0, gr1, wave, lane); } while (0)
    GMLP_PREFETCH(0);
    for (int h = 0; h < 8; ++h) {
        __syncthreads();
#pragma unroll
        for (int it = 0; it < 4; ++it) {
            const int e = (it * NTHREADS + tid) * 8, t = e >> 7, s0 = e & 127;
            float v[8];
#pragma unroll
            for (int j = 0; j < 8; ++j) { const float a = j < 4 ? wa[it][0][j & 3] : wa[it][1][j & 3]; v[j] = (s0 + j <= t) ? a * rstdv[s0 + j] : 0.f; }
            u32x4 w; w.x = cvt_pk_bf16(v[0], v[1]); w.y = cvt_pk_bf16(v[2], v[3]); w.z = cvt_pk_bf16(v[4], v[5]); w.w = cvt_pk_bf16(v[6], v[7]);
            *(LAS u32x4*)(Wl + t * 272 + s0 * 2) = w;
        }
        stage_T_store<2>(gr0, gr1, GvT, wave, lane);
        __syncthreads();
        if (h + 1 < 8) GMLP_PREFETCH(h + 1);
        f32x4 acc[8];
#pragma unroll
        for (int n = 0; n < 8; ++n) acc[n] = (f32x4){0.f, 0.f, 0.f, 0.f};
        const int kmax = (16 * wave + 15) >> 5;
#pragma unroll
        for (int kk = 0; kk < 4; ++kk) {
            if (kk <= kmax) {
                const bf16x8 bfrag = ld_frag_lds(Wl + (16 * wave + fr) * 272 + (32 * kk + 8 * fq) * 2);
#pragma unroll
                for (int n = 0; n < 8; ++n) { const bf16x8 afrag = ld_frag_lds(GvT + (16 * n + fr) * 272 + (32 * kk + 8 * fq) * 2); acc[n] = MFMA16(afrag, bfrag, acc[n]); }
            }
        }
        const int t = 16 * wave + fr; const size_t grow = (size_t)(t0 + t);
        const float bsp = p.b_spatial[h * 128 + t];
        float ss = 0.f;
#pragma unroll
        for (int n = 0; n < 8; ++n) {
            const int d0 = 16 * n + 4 * fq;
            const u32x2 uw = *(const u32x2*)(P + p_off<0, 8, 128>(t0 + t, h, d0));
            const f32x4 gv = *(const f32x4*)(p.gm_vnorm_g + h * 128 + d0);
            f32x4 y;
            y[0] = bflo(uw.x) * (gv[0] * acc[n][0] + bsp); y[1] = bfhi(uw.x) * (gv[1] * acc[n][1] + bsp);
            y[2] = bflo(uw.y) * (gv[2] * acc[n][2] + bsp); y[3] = bfhi(uw.y) * (gv[3] * acc[n][3] + bsp);
            ss += (y[0] * y[0] + y[1] * y[1]) + (y[2] * y[2] + y[3] * y[3]);
            acc[n] = y;
        }
        ss += __shfl_xor(ss, 16); ss += __shfl_xor(ss, 32);
        const float rstd = rsqrtf(ss * (1.f / 128.f) + EPS);
#pragma unroll
        for (int n = 0; n < 8; ++n) {
            const int d0 = 16 * n + 4 * fq;
            const f32x4 g = *(const f32x4*)(p.gm_out_g + h * 128 + d0);
            const f32x4 o = acc[n] * rstd * g;
            u32x2 w; w.x = cvt_pk_bf16(o[0], o[1]); w.y = cvt_pk_bf16(o[2], o[3]);
            *(u32x2*)(YM + grow * DM + h * 128 + d0) = w;
        }
    }
}

DI void mlstm_local(const Params& p, LAS unsigned char* lds, int b, int c, int h) {
    const int tid = threadIdx.x, lane = tid & 63, wave = __builtin_amdgcn_readfirstlane(tid >> 6), fr = lane & 15, fq = lane >> 4;
    const int bh = b * 4 + h, t0 = b * 8192 + c * 128;
    LAS unsigned char* KT = lds; LAS unsigned char* VT = lds + 34816; LAS float* wsv = (LAS float*)(lds + 108800);
    const bf16_t* P = (const bf16_t*)(p.ws + WS_P);
    bf16_t* QC = (bf16_t*)(p.ws + WS_QC); bf16_t* KC = (bf16_t*)(p.ws + WS_KC);
    const float* IG = (const float*)(p.ws + WS_IG); const float* LF = (const float*)(p.ws + WS_LF);
    LAS float* cwl = (LAS float*)(lds + 109312);
    __syncthreads();
    u32x4 xw[2][5];
#define CONV_LOAD(half) do { _Pragma("unroll") for (int gi = 0; gi < 2; ++gi) { const int g = wave + 8 * (gi + 2 * (half)); const int cgp = (g & 15) * 8; \
        _Pragma("unroll") for (int dj = 0; dj < 5; ++dj) { const int srow = 2 * lane - 3 + dj; xw[gi][dj] = (u32x4){0u, 0u, 0u, 0u}; \
            if (c > 0 || srow >= 0) xw[gi][dj] = *(const u32x4*)(P + ((half) ? p_off<2560, 4, 128>(t0 + srow, h, cgp) : p_off<2048, 4, 128>(t0 + srow, h, cgp))); } } } while (0)
    CONV_LOAD(0);
    for (int idx = tid; idx < 1280; idx += NTHREADS) {
        const int j = idx >> 8, cc = idx & 255, ch = (cc >= 128 ? 512 : 0) + h * 128 + (cc & 127);
        cwl[idx] = j < 4 ? p.ml_conv_w[j * 1024 + ch] : p.ml_conv_b[ch];
    }
    if (wave == 0) {
        const float l0 = LF[(size_t)(t0 + 2 * lane) * 4 + h], l1 = LF[(size_t)(t0 + 2 * lane + 1) * 4 + h];
        const float i0 = IG[(size_t)(t0 + 2 * lane) * 4 + h], i1 = IG[(size_t)(t0 + 2 * lane + 1) * 4 + h];
        float s = l0 + l1;
#pragma unroll
        for (int off = 1; off < 64; off <<= 1) { const float tt = __shfl_up(s, off); if (lane >= off) s += tt; }
        const float b1 = s, b0 = s - l1, bend = __shfl(s, 63);
        const float g0 = bend - b0 + i0, g1 = bend - b1 + i1;
        const float gmax = wave_max(fmaxf(g0, g1));
        wsv[2 * lane] = __expf(g0 - gmax); wsv[2 * lane + 1] = __expf(g1 - gmax);
        if (lane == 0) { ((float*)(p.ws + WS_BEND))[bh * 64 + c] = bend; ((float*)(p.ws + WS_GMAX))[bh * 64 + c] = gmax; }
    }
    __syncthreads();
#pragma unroll
    for (int gi4 = 0; gi4 < 4; ++gi4) {
        const int gi = gi4 & 1;
        if (gi4 == 2) CONV_LOAD(1);
        const int g = wave + 8 * gi4; const bool isk = gi4 >= 2; const int cgp = (g & 15) * 8;
        const int cc0 = (isk ? 128 : 0) + cgp;
        const int s = 2 * lane;
        float y0[8], y1[8];
        {
            const f32x4 cb0 = *(const LAS f32x4*)(cwl + 1024 + cc0), cb1 = *(const LAS f32x4*)(cwl + 1024 + cc0 + 4);
#pragma unroll
            for (int e = 0; e < 8; ++e) { y0[e] = e < 4 ? cb0[e & 3] : cb1[e & 3]; y1[e] = y0[e]; }
#pragma unroll
            for (int j = 0; j < 5; ++j) {
                float xr[8];
#pragma unroll
                for (int q = 0; q < 4; ++q) { xr[2 * q] = bflo(xw[gi][j][q]); xr[2 * q + 1] = bfhi(xw[gi][j][q]); }
                if (j < 4) {
                    const f32x4 w0 = *(const LAS f32x4*)(cwl + j * 256 + cc0), w1 = *(const LAS f32x4*)(cwl + j * 256 + cc0 + 4);
#pragma unroll
                    for (int e = 0; e < 8; ++e) y0[e] += (e < 4 ? w0[e & 3] : w1[e & 3]) * xr[e];
                }
                if (j > 0) {
                    const f32x4 w0 = *(const LAS f32x4*)(cwl + (j - 1) * 256 + cc0), w1 = *(const LAS f32x4*)(cwl + (j - 1) * 256 + cc0 + 4);
#pragma unroll
                    for (int e = 0; e < 8; ++e) y1[e] += (e < 4 ? w0[e & 3] : w1[e & 3]) * xr[e];
                }
            }
        }
        const float sc = isk ? 0.08838834764831845f : 1.f;
#pragma unroll
        for (int e = 0; e < 8; ++e) { y0[e] = y0[e] * sigmoid_(y0[e]) * sc; y1[e] = y1[e] * sigmoid_(y1[e]) * sc; }
        bf16_t* dst = (isk ? KC : QC) + (size_t)(t0 + s) * 512 + h * 128 + cgp;
        u32x4 w; w.x = cvt_pk_bf16(y0[0], y0[1]); w.y = cvt_pk_bf16(y0[2], y0[3]); w.z = cvt_pk_bf16(y0[4], y0[5]); w.w = cvt_pk_bf16(y0[6], y0[7]);
        *(u32x4*)dst = w;
        w.x = cvt_pk_bf16(y1[0], y1[1]); w.y = cvt_pk_bf16(y1[2], y1[3]); w.z = cvt_pk_bf16(y1[4], y1[5]); w.w = cvt_pk_bf16(y1[6], y1[7]);
        *(u32x4*)(dst + 512) = w;
        if (isk) {
            const float w0 = wsv[s], w1 = wsv[s + 1];
#pragma unroll
            for (int e = 0; e < 8; ++e) *(LAS unsigned*)(KT + (cgp + e) * 272 + lane * 4) = cvt_pk_bf16(y0[e] * w0, y1[e] * w1);
        }
    }
    stage_T<4>(P + p_off<3072, 4, 256>(t0, h, 0), 256, VT, wave, lane);
    for (int i = tid; i < 1024; i += NTHREADS) { const int r = i >> 6, w = i & 63; *(LAS unsigned*)(VT + (256 + r) * 272 + w * 4) = 0x3F803F80u; }
    __syncthreads();
    bf16x8 af[4];
#pragma unroll
    for (int kk = 0; kk < 4; ++kk) af[kk] = ld_frag_lds(KT + (16 * wave + fr) * 272 + (32 * kk + 8 * fq) * 2);
    float* ST = (float*)(p.ws + WS_ST) + ((size_t)(bh * 64 + c) * 272) * 128;
#pragma unroll
    for (int n = 0; n < 17; ++n) {
        f32x4 acc = {0.f, 0.f, 0.f, 0.f};
#pragma unroll
        for (int kk = 0; kk < 4; ++kk) { const bf16x8 bfr = ld_frag_lds(VT + (16 * n + fr) * 272 + (32 * kk + 8 * fq) * 2); acc = MFMA16(af[kk], bfr, acc); }
        if (n < 16 || fr == 0) __builtin_nontemporal_store(acc, (f32x4*)(ST + (size_t)(16 * n + fr) * 128 + 16 * wave + 4 * fq));
    }
}

DI void phase_scan(const Params& p) {
    const float* ST = (const float*)(p.ws + WS_ST); bf16_t* CPT = (bf16_t*)(p.ws + WS_CPT);
    const float* BEND = (const float*)(p.ws + WS_BEND); const float* GMAX = (const float*)(p.ws + WS_GMAX); float* MPREV = (float*)(p.ws + WS_MPREV);
    const int gtid = blockIdx.x * NTHREADS + threadIdx.x, nthr = gridDim.x * NTHREADS;
    constexpr int PER = 8224;
    constexpr size_t CST = 272 * 128;
    if (nthr == 16 * 8192) {
        const int bh = gtid >> 13, e4 = gtid & 8191;
        const bool extra = (gtid & 255) == 0;
        const int e42 = 8192 + ((gtid >> 8) & 31);
        const float* src = ST + (size_t)bh * 64 * CST + (size_t)e4 * 4;
        bf16_t* dst = CPT + (size_t)bh * 64 * CST + (size_t)e4 * 4;
        const float* src2 = ST + (size_t)bh * 64 * CST + (size_t)e42 * 4;
        bf16_t* dst2 = CPT + (size_t)bh * 64 * CST + (size_t)e42 * 4;
        f32x4 st = {0.f, 0.f, 0.f, 0.f}, st2 = {0.f, 0.f, 0.f, 0.f}; float m = 0.f;
        for (int c0 = 0; c0 < 64; c0 += 8) {
            f32x4 d[8], d2[8]; float be[8], gm[8];
#pragma unroll
            for (int j = 0; j < 8; ++j) { d[j] = __builtin_nontemporal_load((const f32x4*)(src + (size_t)(c0 + j) * CST)); be[j] = BEND[bh * 64 + c0 + j]; gm[j] = GMAX[bh * 64 + c0 + j]; }
#pragma unroll
            for (int j = 0; j < 8; ++j) d2[j] = extra ? __builtin_nontemporal_load((const f32x4*)(src2 + (size_t)(c0 + j) * CST)) : (f32x4){0.f, 0.f, 0.f, 0.f};
#pragma unroll
            for (int j = 0; j < 8; ++j) {
                const int c = c0 + j;
                const float mn = fmaxf(be[j] + m, gm[j]), a = __expf(be[j] + m - mn), sc = __expf(gm[j] - mn);
                u32x2 w; w.x = cvt_pk_bf16(st[0], st[1]); w.y = cvt_pk_bf16(st[2], st[3]);
                *(u32x2*)(dst + (size_t)c * CST) = w;
                if (extra) { u32x2 w2; w2.x = cvt_pk_bf16(st2[0], st2[1]); w2.y = cvt_pk_bf16(st2[2], st2[3]); *(u32x2*)(dst2 + (size_t)c * CST) = w2; }
                if (e4 == 0) MPREV[bh * 64 + c] = m;
                st = st * a + d[j] * sc; st2 = st2 * a + d2[j] * sc; m = mn;
            }
        }
        return;
    }
    for (int item = gtid; item < 16 * PER; item += nthr) {
        const int bh = item / PER, e4 = item - bh * PER;
        const float* src = ST + (size_t)bh * 64 * CST + (size_t)e4 * 4;
        bf16_t* dst = CPT + (size_t)bh * 64 * CST + (size_t)e4 * 4;
        f32x4 st = {0.f, 0.f, 0.f, 0.f}; float m = 0.f;
        for (int c0 = 0; c0 < 64; c0 += 8) {
            f32x4 d[8]; float be[8], gm[8];
#pragma unroll
            for (int j = 0; j < 8; ++j) { d[j] = __builtin_nontemporal_load((const f32x4*)(src + (size_t)(c0 + j) * CST)); be[j] = BEND[bh * 64 + c0 + j]; gm[j] = GMAX[bh * 64 + c0 + j]; }
#pragma unroll
            for (int j = 0; j < 8; ++j) {
                const int c = c0 + j;
                const float mn = fmaxf(be[j] + m, gm[j]), a = __expf(be[j] + m - mn), sc = __expf(gm[j] - mn);
                u32x2 w; w.x = cvt_pk_bf16(st[0], st[1]); w.y = cvt_pk_bf16(st[2], st[3]);
                *(u32x2*)(dst + (size_t)c * CST) = w;
                if (e4 == 0) MPREV[bh * 64 + c] = m;
                st = st * a + d[j] * sc; m = mn;
            }
        }
    }
}

DI void mlstm_out(const Params& p, LAS unsigned char* lds, int b, int c, int h) {
    const int tid = threadIdx.x, lane = tid & 63, wave = __builtin_amdgcn_readfirstlane(tid >> 6), fr = lane & 15, fq = lane >> 4;
    const int bh = b * 4 + h, t0 = b * 8192 + c * 128;
    LAS unsigned char* Kl = lds; LAS unsigned char* Sl = lds + 34816; LAS unsigned char* VTe = lds + 69632;
    LAS float* av = (LAS float*)(lds + 143616); LAS float* Mv = (LAS float*)(lds + 144128); LAS float* bv = (LAS float*)(lds + 144640);
    const bf16_t* P = (const bf16_t*)(p.ws + WS_P); bf16_t* YM = (bf16_t*)(p.ws + WS_XN);
    const bf16_t* QC = (const bf16_t*)(p.ws + WS_QC); const bf16_t* KC = (const bf16_t*)(p.ws + WS_KC);
    const float* IG = (const float*)(p.ws + WS_IG); const float* LF = (const float*)(p.ws + WS_LF);
    const float mprev = ((const float*)(p.ws + WS_MPREV))[bh * 64 + c];
    __syncthreads();
    if (wave == 0) {
        const float l0 = LF[(size_t)(t0 + 2 * lane) * 4 + h], l1 = LF[(size_t)(t0 + 2 * lane + 1) * 4 + h];
        const float i0 = IG[(size_t)(t0 + 2 * lane) * 4 + h], i1 = IG[(size_t)(t0 + 2 * lane + 1) * 4 + h];
        float s = l0 + l1;
#pragma unroll
        for (int off = 1; off < 64; off <<= 1) { const float tt = __shfl_up(s, off); if (lane >= off) s += tt; }
        const float b1 = s, b0 = s - l1;
        const float a0 = i0 - b0, a1 = i1 - b1;
        float pm = fmaxf(a0, a1);
#pragma unroll
        for (int off = 1; off < 64; off <<= 1) { const float tt = __shfl_up(pm, off); if (lane >= off) pm = fmaxf(pm, tt); }
        float ex = __shfl_up(pm, 1); if (lane == 0) ex = -3.0e38f;
        Mv[2 * lane] = fmaxf(mprev, fmaxf(ex, a0)); Mv[2 * lane + 1] = fmaxf(mprev, pm);
        av[2 * lane] = a0; av[2 * lane + 1] = a1; bv[2 * lane] = b0; bv[2 * lane + 1] = b1;
    }
#pragma unroll
    for (int it = 0; it < 4; ++it) {
        const int e = (it * NTHREADS + tid) * 8, s = e >> 7, d0 = e & 127;
        *(LAS u32x4*)(Kl + s * 272 + d0 * 2) = *(const u32x4*)(KC + (size_t)(t0 + s) * 512 + h * 128 + d0);
    }
    stage_T<4>(P + p_off<3072, 4, 256>(t0, h, 0), 256, VTe, wave, lane);
    for (int i = tid; i < 1024; i += NTHREADS) { const int r = i >> 6, w = i & 63; *(LAS unsigned*)(VTe + (256 + r) * 272 + w * 4) = 0x3F803F80u; }
    bf16x8 qf[4];
#pragma unroll
    for (int kk = 0; kk < 4; ++kk) qf[kk] = *(const bf16x8*)(QC + (size_t)(t0 + 16 * wave + fr) * 512 + h * 128 + 32 * kk + 8 * fq);
    __syncthreads();
    const int t = 16 * wave + fr; const float Mt = Mv[t];
    const int stmax = wave | 1;
    for (int st = 0; st <= stmax; ++st) {
        f32x4 s4 = {0.f, 0.f, 0.f, 0.f};
#pragma unroll
        for (int kk = 0; kk < 4; ++kk) { const bf16x8 kf = ld_frag_lds(Kl + (16 * st + fr) * 272 + (32 * kk + 8 * fq) * 2); s4 = MFMA16(kf, qf[kk], s4); }
#pragma unroll
        for (int r = 0; r < 4; ++r) { const int s = 16 * st + 4 * fq + r; const float w = (s <= t) ? __expf(av[s] - Mt) : 0.f; s4[r] *= w; }
        u32x2 w; w.x = cvt_pk_bf16(s4[0], s4[1]); w.y = cvt_pk_bf16(s4[2], s4[3]);
        *(LAS u32x2*)(Sl + t * 272 + (16 * st + 4 * fq) * 2) = w;
    }
    __syncthreads();
    const bf16_t* cpt = (const bf16_t*)(p.ws + WS_CPT) + ((size_t)(bh * 64 + c) * 272) * 128;
    f32x4 acc[17];
#pragma unroll
    for (int n = 0; n < 17; ++n) {
        acc[n] = (f32x4){0.f, 0.f, 0.f, 0.f};
#pragma unroll
        for (int kk = 0; kk < 4; ++kk) { const bf16x8 cf = *(const bf16x8*)(cpt + (size_t)(16 * n + fr) * 128 + 32 * kk + 8 * fq); acc[n] = MFMA16(cf, qf[kk], acc[n]); }
    }
    const float ai = __expf(mprev - Mt);
#pragma unroll
    for (int n = 0; n < 17; ++n) acc[n] = acc[n] * ai;
    const int k2max = (16 * wave + 15) >> 5;
#pragma unroll
    for (int kk = 0; kk < 4; ++kk) {
        if (kk <= k2max) {
            const bf16x8 sf = ld_frag_lds(Sl + t * 272 + (32 * kk + 8 * fq) * 2);
#pragma unroll
            for (int n = 0; n < 17; ++n) { const bf16x8 vf = ld_frag_lds(VTe + (16 * n + fr) * 272 + (32 * kk + 8 * fq) * 2); acc[n] = MFMA16(vf, sf, acc[n]); }
        }
    }
    const float den = __shfl(acc[16][0], fr);
    const float mt = bv[t] + Mt;
    const float inv = rcpf_(fmaxf(fabsf(den), __expf(-mt)));
    const size_t grow = (size_t)(t0 + t);
    float ss = 0.f;
#pragma unroll
    for (int n = 0; n < 16; ++n) {
        const int v0 = 16 * n + 4 * fq;
        const u32x2 ow = *(const u32x2*)(P + p_off<4096, 4, 256>(t0 + t, h, v0));
        f32x4 y;
        y[0] = bflo(ow.x) * acc[n][0] * inv; y[1] = bfhi(ow.x) * acc[n][1] * inv; y[2] = bflo(ow.y) * acc[n][2] * inv; y[3] = bfhi(ow.y) * acc[n][3] * inv;
        ss += (y[0] * y[0] + y[1] * y[1]) + (y[2] * y[2] + y[3] * y[3]);
        acc[n] = y;
    }
    ss += __shfl_xor(ss, 16); ss += __shfl_xor(ss, 32);
    const float rstd = rsqrtf(ss * (1.f / 256.f) + EPS);
#pragma unroll
    for (int n = 0; n < 16; ++n) {
        const int v0 = 16 * n + 4 * fq;
        const f32x4 g = *(const f32x4*)(p.ml_out_g + h * 256 + v0);
        const f32x4 o = acc[n] * rstd * g;
        u32x2 w; w.x = cvt_pk_bf16(o[0], o[1]); w.y = cvt_pk_bf16(o[2], o[3]);
        *(u32x2*)(YM + grow * DM + 1024 + h * 256 + v0) = w;
    }
}

DI unsigned ord_key(float f) { const unsigned u = __float_as_uint(f); return (u & 0x80000000u) ? ~u : (u | 0x80000000u); }
DI float key_val(unsigned k) { return (k & 0x80000000u) ? __uint_as_float(k & 0x7fffffffu) : __uint_as_float(~k); }
DI unsigned umax_(unsigned a, unsigned b) { return a > b ? a : b; }
DI unsigned umin_(unsigned a, unsigned b) { return a < b ? a : b; }
#define DPPU(v, ctrl) ((unsigned)__builtin_amdgcn_update_dpp(0, (int)(v), (ctrl), 0xF, 0xF, true))
DI unsigned row_max_u32(unsigned v) {
    v = umax_(v, DPPU(v, 0xB1)); v = umax_(v, DPPU(v, 0x4E)); v = umax_(v, DPPU(v, 0x141)); v = umax_(v, DPPU(v, 0x140)); return v;
}
DI float row_sum_f32(float v) {
    v += __uint_as_float(DPPU(__float_as_uint(v), 0xB1)); v += __uint_as_float(DPPU(__float_as_uint(v), 0x4E));
    v += __uint_as_float(DPPU(__float_as_uint(v), 0x141)); v += __uint_as_float(DPPU(__float_as_uint(v), 0x140)); return v;
}
#define CEX(a, b) do { const unsigned mx_ = umax_(a, b), mn_ = umin_(a, b); a = mx_; b = mn_; } while (0)
template <int N> DI unsigned top16_row(unsigned (&s)[N], int c) {
    unsigned list = 0u;
#pragma unroll 1
    for (int it = 0; it < 16; ++it) {
        const unsigned wm = row_max_u32(s[0]);
        const bool win = (s[0] == wm);
#pragma unroll
        for (int i = 0; i < N - 1; ++i) s[i] = win ? s[i + 1] : s[i];
        s[N - 1] = win ? 0u : s[N - 1];
        list = (c == it) ? wm : list;
    }
    return list;
}

template <int N> DI void top16_row2(unsigned (&s)[N], unsigned (&t)[N], int c, unsigned& l1, unsigned& l2) {
    l1 = 0u; l2 = 0u;
#pragma unroll 1
    for (int it = 0; it < 16; ++it) {
        const unsigned wm1 = row_max_u32(s[0]), wm2 = row_max_u32(t[0]);
        const bool win1 = (s[0] == wm1), win2 = (t[0] == wm2);
#pragma unroll
        for (int i = 0; i < N - 1; ++i) { s[i] = win1 ? s[i + 1] : s[i]; t[i] = win2 ? t[i + 1] : t[i]; }
        s[N - 1] = win1 ? 0u : s[N - 1]; t[N - 1] = win2 ? 0u : t[N - 1];
        l1 = (c == it) ? wm1 : l1; l2 = (c == it) ? wm2 : l2;
    }
}

template <int N> DI void top16_row4(unsigned (&s)[N], unsigned (&t)[N], unsigned (&u)[N], unsigned (&v)[N], int c, unsigned& l1, unsigned& l2, unsigned& l3, unsigned& l4) {
    l1 = 0u; l2 = 0u; l3 = 0u; l4 = 0u;
#pragma unroll 1
    for (int it = 0; it < 16; ++it) {
        const unsigned wm1 = row_max_u32(s[0]), wm2 = row_max_u32(t[0]), wm3 = row_max_u32(u[0]), wm4 = row_max_u32(v[0]);
        const bool win1 = (s[0] == wm1), win2 = (t[0] == wm2), win3 = (u[0] == wm3), win4 = (v[0] == wm4);
#pragma unroll
        for (int i = 0; i < N - 1; ++i) { s[i] = win1 ? s[i + 1] : s[i]; t[i] = win2 ? t[i + 1] : t[i]; u[i] = win3 ? u[i + 1] : u[i]; v[i] = win4 ? v[i + 1] : v[i]; }
        s[N - 1] = win1 ? 0u : s[N - 1]; t[N - 1] = win2 ? 0u : t[N - 1]; u[N - 1] = win3 ? 0u : u[N - 1]; v[N - 1] = win4 ? 0u : v[N - 1];
        l1 = (c == it) ? wm1 : l1; l2 = (c == it) ? wm2 : l2; l3 = (c == it) ? wm3 : l3; l4 = (c == it) ? wm4 : l4;
    }
}
#define SORT8(s) do { CEX(s[0], s[1]); CEX(s[2], s[3]); CEX(s[4], s[5]); CEX(s[6], s[7]); CEX(s[0], s[2]); CEX(s[1], s[3]); CEX(s[4], s[6]); CEX(s[5], s[7]); CEX(s[1], s[2]); CEX(s[5], s[6]); \
    CEX(s[0], s[4]); CEX(s[1], s[5]); CEX(s[2], s[6]); CEX(s[3], s[7]); CEX(s[2], s[4]); CEX(s[3], s[5]); CEX(s[1], s[2]); CEX(s[3], s[4]); CEX(s[5], s[6]); } while (0)
#define SORT4(s) do { CEX(s[0], s[1]); CEX(s[2], s[3]); CEX(s[0], s[2]); CEX(s[1], s[3]); CEX(s[1], s[2]); } while (0)

DI void peer_select(const Params& p) {
    const int tid = threadIdx.x, lane = tid & 63, wave = __builtin_amdgcn_readfirstlane(tid >> 6), c = lane & 15, g = lane >> 4, rowbase = lane & 48;
    const bf16_t* Q = (const bf16_t*)(p.ws + WS_Q); const bf16_t* KB1 = (const bf16_t*)(p.ws + WS_KB1); const bf16_t* KB2 = (const bf16_t*)(p.ws + WS_KB2);
    int* SELID = (int*)(p.ws + WS_SELID); float* SELG = (float*)(p.ws + WS_SELG);
    unsigned pk = 0u, validmask = 0u;
#pragma unroll
    for (int q = 0; q < 4; ++q) {
        const int target = 4 * c + q; int ci = 0, cj = 0, cnt = 0; bool v = false;
#pragma unroll
        for (int i = 0; i < 16; ++i) { const int nj = 16 / (i + 1); if (target >= cnt && target < cnt + nj) { ci = i; cj = target - cnt; v = true; } cnt += nj; }
        pk |= (unsigned)((ci << 4) | cj) << (8 * q); validmask |= (v ? 1u : 0u) << q;
    }
    for (int tile = blockIdx.x * 8 + wave; tile < T_TOK / 16; tile += gridDim.x * 8) {
        const int tok0 = tile * 16;
        for (int h = 0; h < 8; ++h) {
            bf16x8 a1[2], a2[2];
            {
                const bf16_t* qp = Q + (size_t)(tok0 + c) * 1024 + h * 128 + g * 8;
                a1[0] = *(const bf16x8*)qp; a1[1] = *(const bf16x8*)(qp + 32); a2[0] = *(const bf16x8*)(qp + 64); a2[1] = *(const bf16x8*)(qp + 96);
            }
            f32x4 acc1[8], acc2[8];
#pragma unroll
            for (int nt = 0; nt < 8; ++nt) {
                const size_t ko = ((size_t)(h * 128 + nt * 16 + c)) * 64 + g * 8;
                acc1[nt] = (f32x4){0.f, 0.f, 0.f, 0.f}; acc2[nt] = (f32x4){0.f, 0.f, 0.f, 0.f};
                acc1[nt] = MFMA16(a1[0], *(const bf16x8*)(KB1 + ko), acc1[nt]); acc1[nt] = MFMA16(a1[1], *(const bf16x8*)(KB1 + ko + 32), acc1[nt]);
                acc2[nt] = MFMA16(a2[0], *(const bf16x8*)(KB2 + ko), acc2[nt]); acc2[nt] = MFMA16(a2[1], *(const bf16x8*)(KB2 + ko + 32), acc2[nt]);
            }
#pragma unroll
            for (int rp = 0; rp < 2; ++rp) {
                const int r0 = 2 * rp, r1 = 2 * rp + 1;
                unsigned sA[8], sB[8], sC[8], sD[8];
#pragma unroll
                for (int nt = 0; nt < 8; ++nt) {
                    const unsigned ix = (unsigned)(127 - (nt * 16 + c));
                    sA[nt] = (ord_key(acc1[nt][r0]) & ~0x7Fu) | ix; sB[nt] = (ord_key(acc2[nt][r0]) & ~0x7Fu) | ix;
                    sC[nt] = (ord_key(acc1[nt][r1]) & ~0x7Fu) | ix; sD[nt] = (ord_key(acc2[nt][r1]) & ~0x7Fu) | ix;
                }
                SORT8(sA); SORT8(sB); SORT8(sC); SORT8(sD);
                unsigned lA, lB, lC, lD;
                top16_row4<8>(sA, sB, sC, sD, c, lA, lB, lC, lD);
                unsigned c0[4], c1[4];
#pragma unroll
                for (int q = 0; q < 4; ++q) {
                    const int ci = (int)((pk >> (8 * q + 4)) & 15u), cj = (int)((pk >> (8 * q)) & 15u);
                    const unsigned ka = (unsigned)__shfl((int)lA, rowbase + ci), kb = (unsigned)__shfl((int)lB, rowbase + cj);
                    const unsigned kc = (unsigned)__shfl((int)lC, rowbase + ci), kd = (unsigned)__shfl((int)lD, rowbase + cj);
                    const float cand0 = key_val(ka & ~0x7Fu) + key_val(kb & ~0x7Fu), cand1 = key_val(kc & ~0x7Fu) + key_val(kd & ~0x7Fu);
                    const bool ok = ((validmask >> q) & 1u) != 0u; const unsigned ix = (unsigned)(63 - (4 * c + q));
                    c0[q] = ok ? ((ord_key(cand0) & ~0x3Fu) | ix) : 0u; c1[q] = ok ? ((ord_key(cand1) & ~0x3Fu) | ix) : 0u;
                }
                SORT4(c0); SORT4(c1);
                unsigned sel0, sel1;
                top16_row2<4>(c0, c1, c, sel0, sel1);
#pragma unroll
                for (int u = 0; u < 2; ++u) {
                    const unsigned sel = u ? sel1 : sel0, list1 = u ? lC : lA, list2 = u ? lD : lB; const int r = u ? r1 : r0;
                    const int slot = 63 - (int)(sel & 63u);
                    const unsigned pkv = (unsigned)__shfl((int)pk, rowbase + (slot >> 2));
                    const int cij = (int)((pkv >> (8 * (slot & 3))) & 0xFFu);
                    const unsigned e1 = (unsigned)__shfl((int)list1, rowbase + (cij >> 4)), e2 = (unsigned)__shfl((int)list2, rowbase + (cij & 15));
                    const int eid = (127 - (int)(e1 & 127u)) * 128 + (127 - (int)(e2 & 127u));
                    const float sv = key_val(sel & ~0x3Fu), mx = key_val(row_max_u32(sel) & ~0x3Fu);
                    const float ev = __expf(sv - mx);
                    const float sum = row_sum_f32(ev);
                    const size_t o = (size_t)(tok0 + 4 * g + r) * 128 + h * 16 + c;
                    SELID[o] = eid; SELG[o] = ev * rcpf_(sum);
                }
            }
        }
    }
}

DI f32x2 pkfma(f32x2 a, f32x2 b, f32x2 c) { return __builtin_elementwise_fma(a, b, c); }
DI void peer_gather(const Params& p, LAS unsigned char* lds) {
    const int tid = threadIdx.x, lane = tid & 63, wave = __builtin_amdgcn_readfirstlane(tid >> 6);
    LAS float* scr = (LAS float*)lds + wave * (16 * 68);
    LAS float* cfl = (LAS float*)(lds + 8 * 16 * 68 * 4) + wave * 128;
    const unsigned char* Ub = p.ws + WS_UB; const unsigned char* Vb = p.ws + WS_VB;
    const float* PSS2 = (const float*)(p.ws + WS_PSS2);
    const int* SELID = (const int*)(p.ws + WS_SELID); const float* SELG = (const float*)(p.ws + WS_SELG);
    const int gw = blockIdx.x * 8 + wave, nw = gridDim.x * 8;
    for (int t = gw; t < T_TOK; t += nw) {
        const int idA = SELID[(size_t)t * 128 + lane], idB = SELID[(size_t)t * 128 + 64 + lane];
        const float gA = SELG[(size_t)t * 128 + lane], gB = SELG[(size_t)t * 128 + 64 + lane];
        const bf16_t* xrow = (const bf16_t*)(p.ws + WS_X1G) + (size_t)t * DM + lane * 32;
        float* orow = p.out + (size_t)t * DM + lane * 32;
        const float pv = lane < 32 ? PSS2[(size_t)t * 32 + lane] : 0.f;
        const float rstd2 = rsqrtf(wave_sum(pv) * (1.f / 2048.f) + EPS);
        f32x2 h2[16];
#pragma unroll
        for (int q = 0; q < 4; ++q) {
            const u32x4 xw = *(const u32x4*)(xrow + q * 8);
            const f32x4 g0 = *(const f32x4*)(p.norm2_g + lane * 32 + q * 8), g1 = *(const f32x4*)(p.norm2_g + lane * 32 + q * 8 + 4);
            h2[4 * q] = (f32x2){bflo(xw.x) * rstd2 * g0[0], bfhi(xw.x) * rstd2 * g0[1]};
            h2[4 * q + 1] = (f32x2){bflo(xw.y) * rstd2 * g0[2], bfhi(xw.y) * rstd2 * g0[3]};
            h2[4 * q + 2] = (f32x2){bflo(xw.z) * rstd2 * g1[0], bfhi(xw.z) * rstd2 * g1[1]};
            h2[4 * q + 3] = (f32x2){bflo(xw.w) * rstd2 * g1[2], bfhi(xw.w) * rstd2 * g1[3]};
        }
        constexpr int NPK = 8;
        u32x4 buf[2][NPK]; unsigned short bsc[2][NPK];
#define PEER_LOAD(TB, st, base) do { const int idv_ = ((base) < 64) ? idA : idB; _Pragma("unroll") for (int e_ = 0; e_ < NPK; ++e_) { \
            const int id_ = __builtin_amdgcn_readlane(idv_, ((base) + e_) & 63); const unsigned char* r_ = (TB) + (size_t)id_ * 1088; \
            buf[st][e_] = *(const u32x4*)(r_ + lane * 16); bsc[st][e_] = *(const unsigned short*)(r_ + 1024 + (lane >> 1) * 2); } } while (0)
#define PEER_DOT(st, slot0) do { _Pragma("unroll") for (int e_ = 0; e_ < NPK; ++e_) { f32x2 a2_ = {0.f, 0.f}; \
            _Pragma("unroll") for (int d_ = 0; d_ < 4; ++d_) { const unsigned w_ = buf[st][e_][d_]; \
                a2_ = pkfma(h2[d_ * 4 + 0], __builtin_amdgcn_cvt_scalef32_pk_f32_fp4(w_, 1.0f, 0), a2_); a2_ = pkfma(h2[d_ * 4 + 1], __builtin_amdgcn_cvt_scalef32_pk_f32_fp4(w_, 1.0f, 1), a2_); \
                a2_ = pkfma(h2[d_ * 4 + 2], __builtin_amdgcn_cvt_scalef32_pk_f32_fp4(w_, 1.0f, 2), a2_); a2_ = pkfma(h2[d_ * 4 + 3], __builtin_amdgcn_cvt_scalef32_pk_f32_fp4(w_, 1.0f, 3), a2_); } \
            scr[((slot0) + e_) * 68 + lane] = (a2_[0] + a2_[1]) * bf2f(bsc[st][e_]); } } while (0)
        PEER_LOAD(Ub, 0, 0);
        for (int b = 0; b < 128 / NPK; b += 2) {
            PEER_LOAD(Ub, 1, (b + 1) * NPK);
            PEER_DOT(0, (b * NPK) & 15);
            if (b + 2 < 128 / NPK) PEER_LOAD(Ub, 0, (b + 2) * NPK);
            PEER_DOT(1, ((b + 1) * NPK) & 15);
            if ((((b + 2) * NPK) & 15) == 0) {
                WAVE_LDS_SYNC();
                float sum = 0.f;
#pragma unroll
                for (int i = 0; i < 4; ++i) { const f32x4 r = *(const LAS f32x4*)(scr + (lane >> 2) * 68 + (lane & 3) * 16 + 4 * i); sum += (r[0] + r[1]) + (r[2] + r[3]); }
                sum += __shfl_xor(sum, 1); sum += __shfl_xor(sum, 2);
                const int k0 = (b + 2) * NPK - 16;
                const int k = k0 + (lane >> 2);
                const float gate = __shfl((k0 < 64) ? gA : gB, k & 63);
                if ((lane & 3) == 0) cfl[k] = gate * gelu_t(sum);
                WAVE_LDS_SYNC();
            }
        }
        f32x2 acc[16];
#pragma unroll
        for (int i = 0; i < 16; ++i) acc[i] = (f32x2){0.f, 0.f};
#define PEER_AXPY(st, base) do { _Pragma("unroll") for (int e_ = 0; e_ < NPK; ++e_) { const float c_ = cfl[(base) + e_] * bf2f(bsc[st][e_]); const f32x2 c2_ = {c_, c_}; \
            _Pragma("unroll") for (int d_ = 0; d_ < 4; ++d_) { const unsigned w_ = buf[st][e_][d_]; \
                acc[d_ * 4 + 0] = pkfma(c2_, __builtin_amdgcn_cvt_scalef32_pk_f32_fp4(w_, 1.0f, 0), acc[d_ * 4 + 0]); acc[d_ * 4 + 1] = pkfma(c2_, __builtin_amdgcn_cvt_scalef32_pk_f32_fp4(w_, 1.0f, 1), acc[d_ * 4 + 1]); \
                acc[d_ * 4 + 2] = pkfma(c2_, __builtin_amdgcn_cvt_scalef32_pk_f32_fp4(w_, 1.0f, 2), acc[d_ * 4 + 2]); acc[d_ * 4 + 3] = pkfma(c2_, __builtin_amdgcn_cvt_scalef32_pk_f32_fp4(w_, 1.0f, 3), acc[d_ * 4 + 3]); } } } while (0)
        PEER_LOAD(Vb, 0, 0);
        for (int b = 0; b < 128 / NPK; b += 2) {
            PEER_LOAD(Vb, 1, (b + 1) * NPK);
            PEER_AXPY(0, b * NPK);
            if (b + 2 < 128 / NPK) PEER_LOAD(Vb, 0, (b + 2) * NPK);
            PEER_AXPY(1, (b + 1) * NPK);
        }
        float ss = 0.f;
#pragma unroll
        for (int q = 0; q < 4; ++q) {
            const u32x4 xw = *(const u32x4*)(xrow + q * 8);
            acc[4 * q] += (f32x2){bflo(xw.x), bfhi(xw.x)}; acc[4 * q + 1] += (f32x2){bflo(xw.y), bfhi(xw.y)};
            acc[4 * q + 2] += (f32x2){bflo(xw.z), bfhi(xw.z)}; acc[4 * q + 3] += (f32x2){bflo(xw.w), bfhi(xw.w)};
#pragma unroll
            for (int i = 0; i < 4; ++i) { const f32x2 a = acc[4 * q + i]; ss += a[0] * a[0] + a[1] * a[1]; }
        }
        const float rstd = rsqrtf(wave_sum(ss) * (1.f / 2048.f) + EPS);
#pragma unroll
        for (int q = 0; q < 8; ++q) {
            const f32x4 g0 = *(const f32x4*)(p.final_g + lane * 32 + q * 4);
            const f32x2 a = acc[2 * q], b = acc[2 * q + 1];
            const f32x4 o0 = {a[0] * rstd * g0[0], a[1] * rstd * g0[1], b[0] * rstd * g0[2], b[1] * rstd * g0[3]};
            *(f32x4*)(orow + q * 4) = o0;
        }
        WAVE_LDS_SYNC();
    }
}

#define XB_TMO      128
#define XB_XCNT(j)  (256  + 64 * (j))
#define XB_XSUB(j)  (1280 + 64 * (j))
#define XB_XGEN(j)  (2304 + 64 * (j))
#define XB_TOP      3328
#define XB_TOPGEN   3392
#define XCD_BAR_WORDS 3456
#define XB_SPIN_CAP (1u << 18)

__device__ __forceinline__ unsigned xb_ld(unsigned* p)              { return __hip_atomic_load(p, __ATOMIC_RELAXED, __HIP_MEMORY_SCOPE_AGENT); }
__device__ __forceinline__ unsigned xb_add(unsigned* p, unsigned v) { return __hip_atomic_fetch_add(p, v, __ATOMIC_RELAXED, __HIP_MEMORY_SCOPE_AGENT); }
__device__ __forceinline__ unsigned xb_xcc_id() { return (unsigned)__builtin_amdgcn_s_getreg((3 << 11) | 20) & 0xFu; }
#define XB_SPIN(cond, bar) do { unsigned _sp = 0; while (cond) { __builtin_amdgcn_s_sleep(1); \
    if ((++_sp & 255u) == 0u) { if (xb_ld(&(bar)[XB_TMO])) break; if (_sp > XB_SPIN_CAP) { atomicAdd(&(bar)[XB_TMO], 1u); break; } } } } while (0)

struct XcdBarrier {
    unsigned* bar; unsigned x;
    volatile LAS unsigned* st;
};

__device__ __forceinline__ XcdBarrier xcd_barrier_post(unsigned* bar, volatile LAS unsigned* st) {
    XcdBarrier b; b.bar = bar; b.x = xb_xcc_id(); b.st = st;
    if (threadIdx.x == 0) (void)xb_add(&bar[XB_XCNT(b.x)], 1u);
    return b;
}
__device__ __forceinline__ void xcd_barrier_complete(unsigned* bar, unsigned x, unsigned& nloc, unsigned& nx) {
    const unsigned G = gridDim.x * gridDim.y * gridDim.z;
    unsigned sum, cnt, mine, sp = 0u;
    for (;;) {
        sum = 0u; cnt = 0u; mine = 0u;
#pragma unroll
        for (unsigned j = 0; j < 16; ++j) { const unsigned c = xb_ld(&bar[XB_XCNT(j)]); sum += c; cnt += (c > 0u) ? 1u : 0u; mine = (j == x) ? c : mine; }
        if (sum == G) break;
        __builtin_amdgcn_s_sleep(1);
        if ((++sp & 255u) == 0u) { if (xb_ld(&bar[XB_TMO])) break; if (sp > XB_SPIN_CAP) { atomicAdd(&bar[XB_TMO], 1u); break; } }
    }
    nloc = mine > 0u ? mine : 1u; nx = cnt > 0u ? cnt : 1u;
}

__device__ __forceinline__ void xcd_barrier(const XcdBarrier& b) {
    asm volatile("s_waitcnt vmcnt(0)" ::: "memory");
    __syncthreads();
    if (threadIdx.x == 0) {
        unsigned* bar = b.bar;
        __builtin_amdgcn_s_waitcnt(0);
        unsigned nloc = b.st[0], nx = b.st[1];
        if (nloc == 0u) { xcd_barrier_complete(bar, b.x, nloc, nx); b.st[0] = nloc; b.st[1] = nx; }
        const unsigned old = xb_add(&bar[XB_XSUB(b.x)], 1u);
        const unsigned gen = old / nloc;
        if (old + 1u == (gen + 1u) * nloc) {
            __builtin_amdgcn_fence(__ATOMIC_RELEASE, "agent");
            asm volatile("s_waitcnt vmcnt(0)" ::: "memory");
            const unsigned og = xb_add(&bar[XB_TOP], 1u);
            const unsigned tg = og / nx;
            if (og + 1u == (tg + 1u) * nx) xb_add(&bar[XB_TOPGEN], 1u);
            else XB_SPIN(xb_ld(&bar[XB_TOPGEN]) == tg, bar);
            __builtin_amdgcn_fence(__ATOMIC_ACQUIRE, "agent");
            xb_add(&bar[XB_XGEN(b.x)], 1u);
            asm volatile("s_waitcnt vmcnt(0)" ::: "memory");
        } else {
            XB_SPIN(xb_ld(&bar[XB_XGEN(b.x)]) == gen, bar);
            __builtin_amdgcn_fence(__ATOMIC_ACQUIRE, "agent");
            asm volatile("s_waitcnt vmcnt(0)" ::: "memory");
        }
    }
    __syncthreads();
}

#ifndef PROBE_DUP
#define PROBE_DUP 0
#endif
#define REP(bit) for (int rep_ = 0; rep_ < (((PROBE_DUP) >> (bit)) & 1) + 1; ++rep_)
#define PH1() { pg8::Gemm g{(const bf16_t*)(p.ws + WS_XN), (const bf16_t*)(p.ws + WS_WINT), T_TOK, NPROJ, DM}; pg8::StaticOrder S; S.init(T_TOK, NPROJ, G, bx); Epi1 E{(bf16_t*)(p.ws + WS_P), (float*)(p.ws + WS_PSSV)}; pg8::gemm_phase<Epi1, pg8::StaticOrder, true, true>(lds, g, S, E); xcd_barrier(xbar); }
#define PH3() { pg8::Gemm g{(const bf16_t*)(p.ws + WS_XN), (const bf16_t*)(p.ws + WS_WOUTT), T_TOK, DM, DM}; pg8::StaticOrder S; S.init(T_TOK, DM, G, bx); Epi2 E{p.x, (bf16_t*)(p.ws + WS_X1G), (float*)(p.ws + WS_PSS2)}; pg8::gemm_phase<Epi2, pg8::StaticOrder, true, true>(lds, g, S, E); xcd_barrier(xbar); }
#define PH4() { pg8::Gemm g{(const bf16_t*)(p.ws + WS_X1G), (const bf16_t*)(p.ws + WS_WQT), T_TOK, 1024, DM}; pg8::StaticOrder S; S.init(T_TOK, 1024, G, bx); Epi3 E{(bf16_t*)(p.ws + WS_Q), (const float*)(p.ws + WS_PSS2)}; pg8::gemm_phase<Epi3, pg8::StaticOrder, true, true>(lds, g, S, E); xcd_barrier(xbar); }
__global__ void __launch_bounds__(NTHREADS, 2) hymba_fwd(Params p) {
    extern __shared__ __attribute__((aligned(16))) unsigned char smem[];
    LAS unsigned char* lds = (LAS unsigned char*)smem;
    cg::grid_group grid = cg::this_grid();
    const int G = gridDim.x, bx = blockIdx.x;
    unsigned* barw = (unsigned*)(p.ws + WS_BAR);
    volatile LAS unsigned* xst = (volatile LAS unsigned*)(lds + LDS_BYTES - 16);
    if (threadIdx.x < 4) xst[threadIdx.x] = 0u;
    if (bx == 0) { for (int i = threadIdx.x; i < XCD_BAR_WORDS; i += NTHREADS) barw[i] = 0u; }
    __syncthreads();
    REP(0) { phase0(p, lds); grid.sync(); }
    const XcdBarrier xbar = xcd_barrier_post(barw, xst);
    PH1()
#if (PROBE_DUP >> 1) & 1
    PH1()
#endif
    REP(2) {
        for (int si = bx; si < 256; si += G) {
            const int b = si >> 6, c = si & 63;
            gmlp_bc(p, lds, b, c);
            for (int h = 0; h < 4; ++h) mlstm_local(p, lds, b, c, h);
        }
        xcd_barrier(xbar);
    }
    REP(3) { phase_scan(p); xcd_barrier(xbar); }
    REP(4) { for (int it = bx; it < 1024; it += G) mlstm_out(p, lds, it >> 8, (it >> 2) & 63, it & 3); xcd_barrier(xbar); }
    PH3()
#if (PROBE_DUP >> 5) & 1
    PH3()
#endif
    PH4()
#if (PROBE_DUP >> 6) & 1
    PH4()
#endif
    REP(7) { peer_select(p); xcd_barrier(xbar); }
    peer_gather(p, lds);
}

extern "C" void kernel_launch(void* const* d_in, const int* in_sizes, int n_in, void* d_out, int out_size, void* d_ws, size_t ws_size, hipStream_t stream) {
    static int grid_blocks = 0;
    if (grid_blocks == 0) {
        if (n_in != 20 || ws_size < WS_END) { fprintf(stderr, "kernel_launch: unexpected n_in %d or ws_size %zu (need %zu)\n", n_in, ws_size, (size_t)WS_END); grid_blocks = -1; return; }
        int dev = 0, cus = 0, per_cu = 0;
        hipGetDevice(&dev);
        hipDeviceGetAttribute(&cus, hipDeviceAttributeMultiprocessorCount, dev);
        hipFuncSetAttribute((const void*)hymba_fwd, hipFuncAttributeMaxDynamicSharedMemorySize, LDS_BYTES);
        hipOccupancyMaxActiveBlocksPerMultiprocessor(&per_cu, (const void*)hymba_fwd, NTHREADS, LDS_BYTES);
        if (per_cu < 1) { fprintf(stderr, "kernel_launch: occupancy query says %d blocks per CU\n", per_cu); per_cu = 1; }
        if (per_cu > 1) per_cu = 1;
        grid_blocks = cus * per_cu;
        (void)hipGetLastError();
    }
    if (grid_blocks < 0) return;
    Params p{};
    p.x = (const float*)d_in[0]; p.norm1_g = (const float*)d_in[1]; p.w_in = (const float*)d_in[2]; p.gm_vnorm_g = (const float*)d_in[3];
    p.w_spatial = (const float*)d_in[4]; p.b_spatial = (const float*)d_in[5]; p.ml_conv_w = (const float*)d_in[6]; p.ml_conv_b = (const float*)d_in[7];
    p.ml_b_i = (const float*)d_in[8]; p.ml_b_f = (const float*)d_in[9]; p.gm_out_g = (const float*)d_in[10]; p.ml_out_g = (const float*)d_in[11];
    p.w_out = (const float*)d_in[12]; p.norm2_g = (const float*)d_in[13]; p.peer_wq = (const float*)d_in[14]; p.peer_k1 = (const float*)d_in[15];
    p.peer_k2 = (const float*)d_in[16]; p.peer_u = (const float*)d_in[17]; p.peer_v = (const float*)d_in[18]; p.final_g = (const float*)d_in[19];
    p.out = (float*)d_out; p.ws = (unsigned char*)d_ws;
    void* args[] = {&p};
    hipError_t e = hipLaunchCooperativeKernel((const void*)hymba_fwd, dim3(grid_blocks), dim3(NTHREADS), args, LDS_BYTES, stream);
    if (e != hipSuccess) fprintf(stderr, "cooperative launch failed: %s (grid %d)\n", hipGetErrorString(e), grid_blocks);
}
```

```cpp
#include <hip/hip_runtime.h>
#include <hip/hip_cooperative_groups.h>
#include <cstdio>
#include <cstdint>
namespace cg = cooperative_groups;
namespace pg8 {
#define PG8_LAS __attribute__((address_space(3)))
typedef unsigned short bf16_t;
typedef short bf16x8 __attribute__((ext_vector_type(8)));
typedef float f32x4 __attribute__((ext_vector_type(4)));
typedef unsigned u32x4 __attribute__((ext_vector_type(4)));
constexpr int BM = 256, BK = 64, HALF = 128, HTB = HALF * BK * 2  , STAGE_BYTES = 8 * HTB, NXCD = 8, WGM = 8;

__host__ __device__ __forceinline__ int lds_byte(int r, int c) { const int st = (r >> 4) * 2 + (c >> 5), rr = r & 15, cc = c & 31, ob = rr * 64 + cc * 2; return st * 1024 + (ob ^ (((ob >> 9) & 1) << 5)); }
__host__ __device__ __forceinline__ void stage_rc(int b, int& R, int& C) { const int st = b / 1024, sb = b % 1024, swz = sb ^ (((sb >> 9) & 1) << 5); R = (st >> 1) * 16 + swz / 64; C = (st & 1) * 32 + (swz % 64) / 2; }
__host__ __device__ __forceinline__ int perm32(int rho) { const int n = rho >> 4, i = rho & 15; return 8 * (i >> 2) + 4 * n + (i & 3); }

struct Unit { int pm, pn; };
struct Gemm { const bf16_t* A; const bf16_t* Bt; int M, N, K; };

struct StaticOrder {
    int nM, nN, nwg, G, c;
    __host__ __device__ void init(int M, int N, int G_, int c_) { nM = M / BM; nN = N / BM; nwg = nM * nN; G = G_; c = c_; }
    __host__ __device__ bool next(int i, Unit& u) const {
        const long L = (long)i * G + c; if (L >= nwg) return false;
        int wgid = (int)L; { const int q = nwg / NXCD, r = nwg % NXCD, xcd = wgid % NXCD, off = wgid / NXCD; wgid = (xcd < r ? xcd * (q + 1) : r * (q + 1) + (xcd - r) * q) + off; }
        const int nig = WGM * nN, gid = wgid / nig, fm = gid * WGM, gsz = (nM - fm) < WGM ? (nM - fm) : WGM;
        u.pm = fm + ((wgid % nig) % gsz); u.pn = (wgid % nig) / gsz; return true;
    }
    __device__ __forceinline__ void a_ready(const Unit&) const {}
    __device__ __forceinline__ void done(const Unit&) const {}
};
__device__ __forceinline__ unsigned cvt_pk_bf16(float lo, float hi) { unsigned r; asm volatile("v_cvt_pk_bf16_f32 %0, %1, %2" : "=v"(r) : "v"(lo), "v"(hi)); return r; }
template <class Epi, class Sched, bool ALIGN_EPI = false, bool SP2 = false>
__device__ __forceinline__ void gemm_phase(PG8_LAS unsigned char* lds, const Gemm g, const Sched& S, const Epi& E) {
    const int tid = threadIdx.x, wid = __builtin_amdgcn_readfirstlane(tid >> 6), lane = tid & 63, wr = wid >> 2, wc = wid & 3, fr = lane & 15, fq = lane >> 4;
    const int K = g.K, nt = K / BK;
    unsigned voffA[2], voffB[2];
#pragma unroll
    for (int i = 0; i < 2; ++i) { int R, C; stage_rc(tid * 16 + i * 8192, R, C); const int Rb = Epi::PERM ? ((R & ~31) + perm32(R & 31)) : R;
        voffA[i] = (unsigned)(R * K + C) * 2u; voffB[i] = (unsigned)(Rb * K + C) * 2u; }
    const size_t kstep = (size_t)(BK * 2);
    const size_t hstep = (size_t)HALF * K * 2;
    const size_t tstep = 2 * hstep;
    const unsigned ldsw = (unsigned)wid * 1024u;
    const int aoff = lds_byte(wr * 64 + fr, fq * 8), boff = lds_byte(wc * 32 + fr, fq * 8);
#define PG8_SA(b, h) (((b) * 2 + (h)) * HTB)
#define PG8_SB(b, h) ((4 + (b) * 2 + (h)) * HTB)
#define PG8_STAGE(bufoff, gbase, voff) do { _Pragma("unroll") for (int _i = 0; _i < 2; ++_i) \
        __builtin_amdgcn_global_load_lds((const unsigned*)((const char*)(gbase) + (voff)[_i]), (PG8_LAS unsigned*)(lds + (bufoff) + ldsw + _i * 8192), 16, 0, 0); } while (0)
#define PG8_LDA(dst, b, h) do { _Pragma("unroll") for (int m = 0; m < 4; ++m) _Pragma("unroll") for (int k = 0; k < 2; ++k) dst[m][k] = *(const PG8_LAS bf16x8*)(lds + PG8_SA(b, h) + aoff + m * 2048 + k * 1024); } while (0)
#define PG8_LDB(dst, b, h) do { _Pragma("unroll") for (int n = 0; n < 2; ++n) _Pragma("unroll") for (int k = 0; k < 2; ++k) dst[n][k] = *(const PG8_LAS bf16x8*)(lds + PG8_SB(b, h) + boff + n * 2048 + k * 1024); } while (0)
#define PG8_MMA(ai, bj, At, Bt) do { __builtin_amdgcn_s_setprio(1); _Pragma("unroll") for (int m = 0; m < 4; ++m) _Pragma("unroll") for (int n = 0; n < 2; ++n) _Pragma("unroll") for (int k = 0; k < 2; ++k) \
        acc[ai][bj][m][n] = __builtin_amdgcn_mfma_f32_16x16x32_bf16(Bt[n][k], At[m][k], acc[ai][bj][m][n], 0, 0, 0); __builtin_amdgcn_s_setprio(0); } while (0)
#define PG8_WAIT_V(n) asm volatile("s_waitcnt vmcnt(" #n ")" ::: "memory")
#define PG8_WAIT_L(n) asm volatile("s_waitcnt lgkmcnt(" #n ")" ::: "memory")
#define PG8_BAR __builtin_amdgcn_s_barrier()
#define PG8_SCHED __builtin_amdgcn_sched_barrier(0)
    Unit cur, nxt; int ui = 0;
    if (!S.next(0, cur)) return;
    f32x4 acc[2][2][4][2];
#pragma unroll
    for (int a = 0; a < 2; ++a)
#pragma unroll
        for (int b = 0; b < 2; ++b)
#pragma unroll
            for (int m = 0; m < 4; ++m)
#pragma unroll
                for (int n = 0; n < 2; ++n) acc[a][b][m][n] = (f32x4){0.f, 0.f, 0.f, 0.f};
    bf16x8 At[4][2], B0[2][2], B1[2][2];
    const char* cA = (const char*)g.A + (size_t)cur.pm * tstep; const char* cB = (const char*)g.Bt + (size_t)cur.pn * tstep;
    S.a_ready(cur);
    if constexpr (SP2) {
        PG8_STAGE(PG8_SB(0, 0), cB, voffB); PG8_STAGE(PG8_SB(0, 1), cB + hstep, voffB); PG8_STAGE(PG8_SA(0, 0), cA, voffA); PG8_STAGE(PG8_SA(0, 1), cA + hstep, voffA);
        if (wr == 1) PG8_BAR;
        PG8_WAIT_V(2); PG8_BAR;
        PG8_STAGE(PG8_SB(1, 0), cB + kstep, voffB); PG8_STAGE(PG8_SA(1, 0), cA + kstep, voffA); PG8_STAGE(PG8_SB(1, 1), cB + hstep + kstep, voffB);
        PG8_WAIT_V(6); PG8_BAR;
    } else {
        PG8_STAGE(PG8_SB(0, 0), cB, voffB); PG8_STAGE(PG8_SA(0, 0), cA, voffA); PG8_STAGE(PG8_SB(0, 1), cB + hstep, voffB); PG8_STAGE(PG8_SA(0, 1), cA + hstep, voffA);
        if (wr == 1) PG8_BAR;
        PG8_WAIT_V(4); PG8_BAR;
        PG8_STAGE(PG8_SB(1, 0), cB + kstep, voffB); PG8_STAGE(PG8_SA(1, 0), cA + kstep, voffA); PG8_STAGE(PG8_SB(1, 1), cB + hstep + kstep, voffB);
        PG8_WAIT_V(6); PG8_BAR;
    }
    for (;;) {
        const bool has_next = S.next(ui + 1, nxt);
        const char* nA = has_next ? (const char*)g.A + (size_t)nxt.pm * tstep : cA; const char* nB = has_next ? (const char*)g.Bt + (size_t)nxt.pn * tstep : cB;
        for (int t = 0; t < nt; t += 2) {
            const bool last = (t == nt - 2);
            const char* a1 = cA + (size_t)(t + 1) * kstep;
            const char* a2 = last ? nA : cA + (size_t)(t + 2) * kstep; const char* b2 = last ? nB : cB + (size_t)(t + 2) * kstep;
            const char* a3 = a2 + kstep; const char* b3 = b2 + kstep;
            if (last && has_next) S.a_ready(nxt);
            if constexpr (SP2) {
            PG8_LDB(B0, 0, 0); PG8_LDB(B1, 0, 1); PG8_SCHED; PG8_LDA(At, 0, 0); PG8_STAGE(PG8_SA(1, 1), a1 + hstep, voffA);
            PG8_WAIT_V(8); PG8_WAIT_L(0); PG8_BAR; PG8_MMA(0, 0, At, B0); PG8_MMA(0, 1, At, B1); PG8_BAR; PG8_SCHED;
            PG8_LDA(At, 0, 1); PG8_STAGE(PG8_SB(0, 0), b2, voffB); PG8_STAGE(PG8_SB(0, 1), b2 + hstep, voffB); PG8_STAGE(PG8_SA(0, 0), a2, voffA);
            PG8_WAIT_V(8); PG8_WAIT_L(0); PG8_BAR; PG8_MMA(1, 0, At, B0); PG8_MMA(1, 1, At, B1); PG8_BAR; PG8_SCHED;
            PG8_LDB(B0, 1, 0); PG8_LDB(B1, 1, 1); PG8_SCHED; PG8_LDA(At, 1, 0); PG8_STAGE(PG8_SA(0, 1), a2 + hstep, voffA);
            PG8_WAIT_V(8); PG8_WAIT_L(0); PG8_BAR; PG8_MMA(0, 0, At, B0); PG8_MMA(0, 1, At, B1); PG8_BAR; PG8_SCHED;
            PG8_LDA(At, 1, 1); PG8_STAGE(PG8_SB(1, 0), b3, voffB); PG8_STAGE(PG8_SB(1, 1), b3 + hstep, voffB); PG8_STAGE(PG8_SA(1, 0), a3, voffA);
            PG8_WAIT_V(8); PG8_WAIT_L(0); PG8_BAR; PG8_MMA(1, 0, At, B0); PG8_MMA(1, 1, At, B1); PG8_BAR; PG8_SCHED;
            } else {
            PG8_LDB(B0, 0, 0); PG8_SCHED; PG8_LDA(At, 0, 0); PG8_STAGE(PG8_SA(1, 1), a1 + hstep, voffA);
            PG8_WAIT_L(8); PG8_BAR; PG8_WAIT_L(0); PG8_MMA(0, 0, At, B0); PG8_BAR; PG8_SCHED;
            PG8_LDB(B1, 0, 1); PG8_STAGE(PG8_SB(0, 0), b2, voffB);
            PG8_BAR; PG8_WAIT_L(0); PG8_MMA(0, 1, At, B1); PG8_BAR;
            PG8_LDA(At, 0, 1); PG8_STAGE(PG8_SA(0, 0), a2, voffA);
            PG8_BAR; PG8_WAIT_L(0); PG8_MMA(1, 0, At, B0); PG8_BAR; PG8_SCHED;
            PG8_STAGE(PG8_SB(0, 1), b2 + hstep, voffB);
            PG8_WAIT_V(6); PG8_BAR; PG8_MMA(1, 1, At, B1); PG8_BAR;
            PG8_LDB(B0, 1, 0); PG8_SCHED; PG8_LDA(At, 1, 0); PG8_STAGE(PG8_SA(0, 1), a2 + hstep, voffA);
            PG8_WAIT_L(8); PG8_BAR; PG8_WAIT_L(0); PG8_MMA(0, 0, At, B0); PG8_BAR; PG8_SCHED;
            PG8_LDB(B1, 1, 1); PG8_STAGE(PG8_SB(1, 0), b3, voffB);
            PG8_BAR; PG8_WAIT_L(0); PG8_MMA(0, 1, At, B1); PG8_BAR;
            PG8_LDA(At, 1, 1); PG8_STAGE(PG8_SA(1, 0), a3, voffA);
            PG8_BAR; PG8_WAIT_L(0); PG8_MMA(1, 0, At, B0); PG8_BAR; PG8_SCHED;
            PG8_STAGE(PG8_SB(1, 1), b3 + hstep, voffB);
            PG8_WAIT_V(6); PG8_BAR; PG8_MMA(1, 1, At, B1); PG8_BAR;
            }
        }
        if constexpr (ALIGN_EPI) { if (wr == 0) PG8_BAR; }
        if constexpr (!Epi::AFTER_DRAIN) { E(acc, cur, wr, wc, fr, fq); S.done(cur); }
        if (!has_next) break;
#pragma unroll
        for (int a = 0; a < 2; ++a)
#pragma unroll
            for (int b = 0; b < 2; ++b)
#pragma unroll
                for (int m = 0; m < 4; ++m)
#pragma unroll
                    for (int n = 0; n < 2; ++n) acc[a][b][m][n] = (f32x4){0.f, 0.f, 0.f, 0.f};
        cur = nxt; cA = nA; cB = nB; ++ui;
        if constexpr (ALIGN_EPI) { if (wr == 1) PG8_BAR; }
    }
    PG8_WAIT_V(0);
    if constexpr (!ALIGN_EPI) { if (wr == 0) PG8_BAR; }
    PG8_BAR;
    if constexpr (Epi::AFTER_DRAIN) { E.fused(acc, cur, wr, wc, fr, fq, lds, wid, lane); S.done(cur); }
#undef PG8_SA
#undef PG8_SB
#undef PG8_STAGE
#undef PG8_LDA
#undef PG8_LDB
#undef PG8_MMA
#undef PG8_WAIT_V
#undef PG8_WAIT_L
#undef PG8_BAR
#undef PG8_SCHED
}
}

#define LAS __attribute__((address_space(3)))
#define DI __device__ __forceinline__
using pg8::bf16_t; using pg8::bf16x8; using pg8::f32x4; using pg8::u32x4; using pg8::cvt_pk_bf16;
typedef unsigned u32x2 __attribute__((ext_vector_type(2)));
typedef float f32x2 __attribute__((ext_vector_type(2)));

constexpr int T_TOK = 32768, DM = 2048, NPROJ = 5120, PROJW = 5128;
constexpr int NTHREADS = 512;
constexpr int LDS_BYTES = 147456;
constexpr float EPS = 1e-6f;

constexpr size_t WS_XN = 0;
constexpr size_t WS_P = 134217728;
constexpr size_t WS_X1G = WS_P;
constexpr size_t WS_Q = WS_P + 134217728;
constexpr size_t WS_WINT = WS_P + 335544320;
constexpr size_t WS_WOUTT = WS_WINT + 20971520;
constexpr size_t WS_WQT = WS_WOUTT + 8388608;
constexpr size_t WS_UB = WS_WQT + 4194304;
constexpr size_t WS_VB = WS_UB + 67108864;
constexpr size_t WS_ST = WS_VB + 67108864;
constexpr size_t WS_CPT = WS_ST + 142606336;
constexpr size_t WS_QC = WS_CPT + 71303168;
constexpr size_t WS_KC = WS_QC + 33554432;
constexpr size_t WS_IG = WS_KC + 33554432;
constexpr size_t WS_LF = WS_IG + 524288;
constexpr size_t WS_PSSV = WS_LF + 524288;
constexpr size_t WS_PSS2 = WS_PSSV + 2097152;
constexpr size_t WS_BEND = WS_PSS2 + 4194304;
constexpr size_t WS_GMAX = WS_BEND + 4096;
constexpr size_t WS_MPREV = WS_GMAX + 4096;
constexpr size_t WS_SELID = WS_MPREV + 4096;
constexpr size_t WS_SELG = WS_SELID + 16777216;
constexpr size_t WS_KB1 = WS_SELG + 16777216;
constexpr size_t WS_KB2 = WS_KB1 + 131072;
constexpr size_t WS_BAR = WS_KB2 + 131072;
constexpr size_t WS_END = WS_BAR + 16384;

struct Params {
    const float *x, *norm1_g, *w_in, *gm_vnorm_g, *w_spatial, *b_spatial, *ml_conv_w, *ml_conv_b, *ml_b_i, *ml_b_f, *gm_out_g, *ml_out_g, *w_out, *norm2_g,
        *peer_wq, *peer_k1, *peer_k2, *peer_u, *peer_v, *final_g;
    float* out;
    unsigned char* ws;
};

template <int CB, int H, int W> DI size_t p_off(int t, int h, int d) { return (size_t)T_TOK * CB + ((size_t)((t >> 7) * H + h) * 128 + (t & 127)) * W + d; }
DI float bf2f(unsigned short h) { return __uint_as_float(((unsigned)h) << 16); }
DI float bflo(unsigned w) { return __uint_as_float(w << 16); }
DI float bfhi(unsigned w) { return __uint_as_float(w & 0xffff0000u); }
DI float rcpf_(float x) { return __builtin_amdgcn_rcpf(x); }
DI float sigmoid_(float x) { return rcpf_(1.f + __expf(-x)); }
DI float gelu_t(float x) { const float z = 1.5957691216057308f * (x + 0.044715f * x * x * x); return x * rcpf_(1.f + __expf(-z)); }
DI float wave_sum(float v) {
#pragma unroll
    for (int o = 32; o; o >>= 1) v += __shfl_xor(v, o);
    return v;
}
DI float wave_max(float v) {
#pragma unroll
    for (int o = 32; o; o >>= 1) v = fmaxf(v, __shfl_xor(v, o));
    return v;
}
DI bf16x8 ld_frag_lds(const LAS unsigned char* p) { return *(const LAS bf16x8*)p; }
#define MFMA16(a, b, c) __builtin_amdgcn_mfma_f32_16x16x32_bf16((a), (b), (c), 0, 0, 0)

struct Epi1 {
    static constexpr bool PERM = true, AFTER_DRAIN = false;
    bf16_t* P; float* pssv;
    DI void operator()(const f32x4 (&acc)[2][2][4][2], const pg8::Unit& u, int wr, int wc, int fr, int fq) const {
        const int row0 = u.pm * 256 + wr * 64 + fr, col0 = u.pn * 256 + wc * 32 + 8 * fq;
        const int mode = u.pn < 8 ? 1 : (u.pn >= 16 ? 2 : 0);
        const bool want_ss = (u.pn >= 4 && u.pn < 8);
#pragma unroll
        for (int ai = 0; ai < 2; ++ai)
#pragma unroll
            for (int m = 0; m < 4; ++m) {
                const int row = row0 + ai * 128 + m * 16;
                const int CB = u.pn < 4 ? 0 : (u.pn < 8 ? 1024 : (u.pn < 10 ? 2048 : (u.pn < 12 ? 2560 : (u.pn < 16 ? 3072 : 4096))));
                const int lw = u.pn < 12 ? 7 : 8, H = u.pn < 8 ? 8 : 4;
                float ss = 0.f;
#pragma unroll
                for (int bj = 0; bj < 2; ++bj) {
                    f32x4 v0 = acc[ai][bj][m][0], v1 = acc[ai][bj][m][1];
                    if (mode == 1) {
#pragma unroll
                        for (int j = 0; j < 4; ++j) { v0[j] = gelu_t(v0[j]); v1[j] = gelu_t(v1[j]); ss += v0[j] * v0[j] + v1[j] * v1[j]; }
                    } else if (mode == 2) {
#pragma unroll
                        for (int j = 0; j < 4; ++j) { v0[j] = sigmoid_(v0[j]); v1[j] = sigmoid_(v1[j]); }
                    }
                    u32x4 w; w.x = cvt_pk_bf16(v0[0], v0[1]); w.y = cvt_pk_bf16(v0[2], v0[3]); w.z = cvt_pk_bf16(v1[0], v1[1]); w.w = cvt_pk_bf16(v1[2], v1[3]);
                    {
                        const int cr = col0 + bj * 128 - CB, hh = cr >> lw, d = cr & ((1 << lw) - 1);
                        *(u32x4*)(P + (size_t)T_TOK * CB + (((size_t)((row >> 7) * H + hh) * 128 + (row & 127)) << lw) + d) = w;
                    }
                }
                if (want_ss) {
                    ss += __shfl_xor(ss, 16); ss += __shfl_xor(ss, 32);
                    if (fq == 0) pssv[(size_t)row * 16 + (u.pn - 4) * 4 + wc] = ss;
                }
            }
    }
};

struct Epi2 {
    static constexpr bool PERM = true, AFTER_DRAIN = false;
    const float* x; bf16_t* x1b; float* pss2;
    DI void operator()(const f32x4 (&acc)[2][2][4][2], const pg8::Unit& u, int wr, int wc, int fr, int fq) const {
        const int row0 = u.pm * 256 + wr * 64 + fr, col0 = u.pn * 256 + wc * 32 + 8 * fq;
#pragma unroll
        for (int ai = 0; ai < 2; ++ai)
#pragma unroll
            for (int m = 0; m < 4; ++m) {
                const int row = row0 + ai * 128 + m * 16;
                float ss = 0.f;
#pragma unroll
                for (int bj = 0; bj < 2; ++bj) {
                    const size_t o = (size_t)row * DM + col0 + bj * 128;
                    const f32x4 v0 = acc[ai][bj][m][0] + *(const f32x4*)(x + o), v1 = acc[ai][bj][m][1] + *(const f32x4*)(x + o + 4);
#pragma unroll
                    for (int j = 0; j < 4; ++j) ss += v0[j] * v0[j] + v1[j] * v1[j];
                    u32x4 w; w.x = cvt_pk_bf16(v0[0], v0[1]); w.y = cvt_pk_bf16(v0[2], v0[3]); w.z = cvt_pk_bf16(v1[0], v1[1]); w.w = cvt_pk_bf16(v1[2], v1[3]);
                    *(u32x4*)(x1b + o) = w;
                }
                ss += __shfl_xor(ss, 16); ss += __shfl_xor(ss, 32);
                if (fq == 0) pss2[(size_t)row * 32 + u.pn * 4 + wc] = ss;
            }
    }
};

struct Epi3 {
    static constexpr bool PERM = true, AFTER_DRAIN = false;
    bf16_t* Q; const float* pss2;
    DI void operator()(const f32x4 (&acc)[2][2][4][2], const pg8::Unit& u, int wr, int wc, int fr, int fq) const {
        const int row0 = u.pm * 256 + wr * 64 + fr, col0 = u.pn * 256 + wc * 32 + 8 * fq;
#pragma unroll
        for (int ai = 0; ai < 2; ++ai)
#pragma unroll
            for (int m = 0; m < 4; ++m) {
                const int row = row0 + ai * 128 + m * 16;
                float ss = 0.f;
#pragma unroll
                for (int i = 0; i < 8; ++i) { const f32x4 t = *(const f32x4*)(pss2 + (size_t)row * 32 + i * 4); ss += (t[0] + t[1]) + (t[2] + t[3]); }
                const float rstd = rsqrtf(ss * (1.f / 2048.f) + EPS);
#pragma unroll
                for (int bj = 0; bj < 2; ++bj) {
                    const f32x4 v0 = acc[ai][bj][m][0] * rstd, v1 = acc[ai][bj][m][1] * rstd;
                    u32x4 w; w.x = cvt_pk_bf16(v0[0], v0[1]); w.y = cvt_pk_bf16(v0[2], v0[3]); w.z = cvt_pk_bf16(v1[0], v1[1]); w.w = cvt_pk_bf16(v1[2], v1[3]);
                    *(u32x4*)(Q + (size_t)row * 1024 + col0 + bj * 128) = w;
                }
            }
    }
};

DI void phase0(const Params& p, LAS unsigned char* lds) {
    const int tid = threadIdx.x, lane = tid & 63, wave = tid >> 6;
    bf16_t* XN = (bf16_t*)(p.ws + WS_XN);
    {
        LAS float* scr = (LAS float*)lds + wave * (64 * 65);
        const int gw = blockIdx.x * 8 + wave, nw = gridDim.x * 8;
        for (int it = gw; it < 4096; it += nw) {
            const float* W; bf16_t* WT; int ldw, kt, nt;
            if (it < 2560) { W = p.w_in; WT = (bf16_t*)(p.ws + WS_WINT); ldw = PROJW; kt = it / 80; nt = it % 80; }
            else if (it < 3584) { const int j = it - 2560; W = p.w_out; WT = (bf16_t*)(p.ws + WS_WOUTT); ldw = 2048; kt = j >> 5; nt = j & 31; }
            else { const int j = it - 3584; W = p.peer_wq; WT = (bf16_t*)(p.ws + WS_WQT); ldw = 1024; kt = j >> 4; nt = j & 15; }
            const int k0 = kt * 64, n0 = nt * 64;
            {
                f32x4 tv[16];
#pragma unroll
                for (int i = 0; i < 16; ++i) tv[i] = *(const f32x4*)(W + (size_t)(k0 + 4 * i + (lane >> 4)) * ldw + n0 + 4 * (lane & 15));
#pragma unroll
                for (int i = 0; i < 16; ++i) {
                    const int r = 4 * i + (lane >> 4);
                    const float gsc = it >= 3584 ? p.norm2_g[k0 + r] : 1.f;
                    LAS float* d = scr + r * 65 + 4 * (lane & 15);
                    d[0] = tv[i][0] * gsc; d[1] = tv[i][1] * gsc; d[2] = tv[i][2] * gsc; d[3] = tv[i][3] * gsc;
                }
            }
            __builtin_amdgcn_fence(__ATOMIC_RELEASE, "wavefront"); __builtin_amdgcn_wave_barrier(); __builtin_amdgcn_fence(__ATOMIC_ACQUIRE, "wavefront");
            const int half = lane >> 5, kk = (lane & 31) * 2;
#pragma unroll 8
            for (int nn = 0; nn < 32; ++nn) {
                const int n = 2 * nn + half; const float a = scr[kk * 65 + n], b = scr[(kk + 1) * 65 + n];
                *(unsigned*)(WT + (size_t)(n0 + n) * 2048 + k0 + kk) = cvt_pk_bf16(a, b);
            }
            __builtin_amdgcn_fence(__ATOMIC_RELEASE, "wavefront"); __builtin_amdgcn_wave_barrier(); __builtin_amdgcn_fence(__ATOMIC_ACQUIRE, "wavefront");
        }
    }
    __syncthreads();
    {
        LAS float* wg = (LAS float*)lds;
        for (int idx = tid; idx < 4096; idx += NTHREADS) {
            const int k = idx >> 1, hf = idx & 1;
            const f32x4 v = *(const f32x4*)(p.w_in + (size_t)k * PROJW + 5120 + hf * 4);
            *(LAS f32x4*)(wg + k * 8 + (k >> 3) * 4 + hf * 4) = v;
        }
        __syncthreads();
        float* IG = (float*)(p.ws + WS_IG); float* LF = (float*)(p.ws + WS_LF);
        for (int row0 = 2 * (blockIdx.x * 8 + wave); row0 < T_TOK; row0 += 2 * gridDim.x * 8) {
            f32x4 xv[2][8];
#pragma unroll
            for (int rr = 0; rr < 2; ++rr) {
                const float* xr = p.x + (size_t)(row0 + rr) * DM;
#pragma unroll
                for (int i = 0; i < 4; ++i) { xv[rr][2 * i] = *(const f32x4*)(xr + i * 512 + lane * 8); xv[rr][2 * i + 1] = *(const f32x4*)(xr + i * 512 + lane * 8 + 4); }
            }
#pragma unroll
            for (int rr = 0; rr < 2; ++rr) {
                const int row = row0 + rr;
                float ss = 0.f;
#pragma unroll
                for (int i = 0; i < 8; ++i) ss += (xv[rr][i][0] * xv[rr][i][0] + xv[rr][i][1] * xv[rr][i][1]) + (xv[rr][i][2] * xv[rr][i][2] + xv[rr][i][3] * xv[rr][i][3]);
                ss = wave_sum(ss);
                const float rstd = rsqrtf(ss * (1.f / 2048.f) + EPS);
                f32x4 ga = {0.f, 0.f, 0.f, 0.f}, gb = {0.f, 0.f, 0.f, 0.f};
#pragma unroll
                for (int i = 0; i < 4; ++i) {
                    const f32x4 g0 = *(const f32x4*)(p.norm1_g + i * 512 + lane * 8), g1 = *(const f32x4*)(p.norm1_g + i * 512 + lane * 8 + 4);
                    const f32x4 h0 = xv[rr][2 * i] * rstd * g0, h1 = xv[rr][2 * i + 1] * rstd * g1;
                    u32x4 w; w.x = cvt_pk_bf16(h0[0], h0[1]); w.y = cvt_pk_bf16(h0[2], h0[3]); w.z = cvt_pk_bf16(h1[0], h1[1]); w.w = cvt_pk_bf16(h1[2], h1[3]);
                    *(u32x4*)(XN + (size_t)row * DM + i * 512 + lane * 8) = w;
                    const LAS float* wb = wg + (i * 512 + lane * 8) * 8 + (i * 64 + lane) * 4;
#pragma unroll
                    for (int e = 0; e < 8; ++e) {
                        const float hv = e < 4 ? h0[e & 3] : h1[e & 3];
                        const f32x4 w0 = *(const LAS f32x4*)(wb + e * 8), w1 = *(const LAS f32x4*)(wb + e * 8 + 4);
                        ga = ga + w0 * hv; gb = gb + w1 * hv;
                    }
                }
                f32x4 m4 = lane < 32 ? ga : gb, s4 = lane < 32 ? gb : ga;
#pragma unroll
                for (int j = 0; j < 4; ++j) m4[j] += __shfl_xor(s4[j], 32);
                const bool up16 = (lane & 16) != 0;
                float m2a = up16 ? m4[2] : m4[0], m2b = up16 ? m4[3] : m4[1];
                const float s2a = up16 ? m4[0] : m4[2], s2b = up16 ? m4[1] : m4[3];
                m2a += __shfl_xor(s2a, 16); m2b += __shfl_xor(s2b, 16);
                const bool up8 = (lane & 8) != 0;
                float m1 = up8 ? m2b : m2a; const float s1 = up8 ? m2a : m2b;
                m1 += __shfl_xor(s1, 8);
                m1 += __shfl_xor(m1, 4); m1 += __shfl_xor(m1, 2); m1 += __shfl_xor(m1, 1);
                const int j = ((lane >> 5) << 2) | (((lane >> 4) & 1) << 1) | ((lane >> 3) & 1);
                if ((lane & 7) == 0) {
                    if (j < 4) IG[(size_t)row * 4 + j] = m1 + p.ml_b_i[j];
                    else { const float z = m1 + p.ml_b_f[j - 4]; LF[(size_t)row * 4 + j - 4] = fminf(z, 0.f) - log1pf(__expf(-fabsf(z))); }
                }
            }
        }
    }
    {
        const size_t nthr = (size_t)gridDim.x * NTHREADS, NQ = (size_t)16384 * 512;
        for (size_t base = (size_t)blockIdx.x * NTHREADS + tid; base < 2 * NQ; base += 16 * nthr) {
            f32x4 v[16];
#pragma unroll
            for (int u = 0; u < 16; ++u) {
                size_t i = base + u * nthr; if (i >= 2 * NQ) i = base;
                const int which = i >= NQ; const size_t j = i - (which ? NQ : 0);
                v[u] = *(const f32x4*)((which ? p.peer_v : p.peer_u) + j * 4);
            }
#pragma unroll
            for (int u = 0; u < 16; ++u) {
                size_t i = base + u * nthr; if (i >= 2 * NQ) i = base;
                const int which = i >= NQ; const size_t j = i - (which ? NQ : 0);
                const int row = (int)(j >> 9), c4 = (int)(j & 511);
                float amax = fmaxf(fmaxf(fabsf(v[u][0]), fabsf(v[u][1])), fmaxf(fabsf(v[u][2]), fabsf(v[u][3])));
                amax = fmaxf(amax, __uint_as_float((unsigned)__builtin_amdgcn_update_dpp(0, (int)__float_as_uint(amax), 0xB1, 0xF, 0xF, true)));
                amax = fmaxf(amax, __uint_as_float((unsigned)__builtin_amdgcn_update_dpp(0, (int)__float_as_uint(amax), 0x4E, 0xF, 0xF, true)));
                amax = fmaxf(amax, __uint_as_float((unsigned)__builtin_amdgcn_update_dpp(0, (int)__float_as_uint(amax), 0x141, 0xF, 0xF, true)));
                amax = fmaxf(amax, __uint_as_float((unsigned)__builtin_amdgcn_update_dpp(0, (int)__float_as_uint(amax), 0x140, 0xF, 0xF, true)));
                const unsigned sb = cvt_pk_bf16(amax * (1.f / 6.f), 0.f) & 0xffffu;
                float sc = bflo(sb); if (sc == 0.f) sc = 1.f;
                const float inv = 1.f / sc;
                unsigned r = 0u;
                r = __builtin_amdgcn_cvt_scalef32_pk_fp4_f32(r, v[u][0] * inv, v[u][1] * inv, 1.0f, 0);
                r = __builtin_amdgcn_cvt_scalef32_pk_fp4_f32(r, v[u][2] * inv, v[u][3] * inv, 1.0f, 1);
                unsigned char* dst = p.ws + (which ? WS_VB : WS_UB) + (size_t)row * 1088;
                *(unsigned short*)(dst + c4 * 2) = (unsigned short)(r & 0xffffu);
                if ((c4 & 15) == 0) *(unsigned short*)(dst + 1024 + (c4 >> 4) * 2) = (unsigned short)(sb == 0u ? 0x3F80u : sb);
            }
        }
    }
    {
        bf16_t* KB1 = (bf16_t*)(p.ws + WS_KB1); bf16_t* KB2 = (bf16_t*)(p.ws + WS_KB2);
        for (int i = blockIdx.x * NTHREADS + tid; i < 65536 / 4; i += gridDim.x * NTHREADS) {
            const f32x4 a = *(const f32x4*)(p.peer_k1 + i * 4), b = *(const f32x4*)(p.peer_k2 + i * 4);
            u32x2 w; w.x = cvt_pk_bf16(a[0], a[1]); w.y = cvt_pk_bf16(a[2], a[3]); *(u32x2*)(KB1 + i * 4) = w;
            w.x = cvt_pk_bf16(b[0], b[1]); w.y = cvt_pk_bf16(b[2], b[3]); *(u32x2*)(KB2 + i * 4) = w;
        }
    }
}

#define WAVE_LDS_SYNC() do { __builtin_amdgcn_fence(__ATOMIC_RELEASE, "wavefront"); __builtin_amdgcn_wave_barrier(); __builtin_amdgcn_fence(__ATOMIC_ACQUIRE, "wavefront"); } while (0)

template <int NG> DI void stage_T_load(const bf16_t* src, int ld, u32x4 (&r0)[NG], u32x4 (&r1)[NG], int wave, int lane) {
#pragma unroll
    for (int i = 0; i < NG; ++i) {
        const int g = wave + 8 * i;
        r0[i] = *(const u32x4*)(src + (size_t)(2 * lane) * ld + g * 8);
        r1[i] = *(const u32x4*)(src + (size_t)(2 * lane + 1) * ld + g * 8);
    }
}
template <int NG> DI void stage_T_store(const u32x4 (&r0)[NG], const u32x4 (&r1)[NG], LAS unsigned char* dst, int wave, int lane) {
#pragma unroll
    for (int i = 0; i < NG; ++i) {
        const int g = wave + 8 * i;
#pragma unroll
        for (int w = 0; w < 4; ++w) {
            const unsigned a = r0[i][w], b = r1[i][w];
            *(LAS unsigned*)(dst + (g * 8 + 2 * w) * 272 + lane * 4) = (a & 0xffffu) | (b << 16);
            *(LAS unsigned*)(dst + (g * 8 + 2 * w + 1) * 272 + lane * 4) = (a >> 16) | (b & 0xffff0000u);
        }
    }
}
template <int NG> DI void stage_T(const bf16_t* src, int ld, LAS unsigned char* dst, int wave, int lane) {
    u32x4 r0[NG], r1[NG];
    stage_T_load<NG>(src, ld, r0, r1, wave, lane);
    stage_T_store<NG>(r0, r1, dst, wave, lane);
}

DI void gmlp_bc(const Params& p, LAS unsigned char* lds, int b, int c) {
    const int tid = threadIdx.x, lane = tid & 63, wave = __builtin_amdgcn_readfirstlane(tid >> 6), fr = lane & 15, fq = lane >> 4;
    const int t0 = b * 8192 + c * 128;
    LAS unsigned char* Wl = lds; LAS unsigned char* GvT = lds + 34816; LAS float* rstdv = (LAS float*)(lds + 69632);
    const bf16_t* P = (const bf16_t*)(p.ws + WS_P); bf16_t* YM = (bf16_t*)(p.ws + WS_XN);
    const float* PSSV = (const float*)(p.ws + WS_PSSV);
    __syncthreads();
    if (tid < 128) {
        float ss = 0.f;
#pragma unroll
        for (int i = 0; i < 4; ++i) { const f32x4 v = *(const f32x4*)(PSSV + (size_t)(t0 + tid) * 16 + i * 4); ss += (v[0] + v[1]) + (v[2] + v[3]); }
        rstdv[tid] = rsqrtf(ss * (1.f / 1024.f) + EPS);
    }
    f32x4 wa[4][2]; u32x4 gr0[2], gr1[2];
#define GMLP_PREFETCH(hh) do { _Pragma("unroll") for (int it = 0; it < 4; ++it) { const int e = (it * NTHREADS + tid) * 8, t = e >> 7, s0 = e & 127; \
            const float* wp = p.w_spatial + ((size_t)((hh) * 128 + t)) * 128 + s0; wa[it][0] = *(const f32x4*)wp; wa[it][1] = *(const f32x4*)(wp + 4); } \
        stage_T_load<2>(P + p_off<1024, 8, 128>(t0, (hh), 0), 128, gr0, gr1, wave, lane); } while (0)
    GMLP_PREFETCH(0);
    for (int h = 0; h < 8; ++h) {
        __syncthreads();
#pragma unroll
        for (int it = 0; it < 4; ++it) {
            const int e = (it * NTHREADS + tid) * 8, t = e >> 7, s0 = e & 127;
            float v[8];
#pragma unroll
            for (int j = 0; j < 8; ++j) { const float a = j < 4 ? wa[it][0][j & 3] : wa[it][1][j & 3]; v[j] = (s0 + j <= t) ? a * rstdv[s0 + j] : 0.f; }
            u32x4 w; w.x = cvt_pk_bf16(v[0], v[1]); w.y = cvt_pk_bf16(v[2], v[3]); w.z = cvt_pk_bf16(v[4], v[5]); w.w = cvt_pk_bf16(v[6], v[7]);
            *(LAS u32x4*)(Wl + t * 272 + s0 * 2) = w;
        }
        stage_T_store<2>(gr0, gr1, GvT, wave, lane);
        __syncthreads();
        if (h + 1 < 8) GMLP_PREFETCH(h + 1);
        f32x4 acc[8];
#pragma unroll
        for (int n = 0; n < 8; ++n) acc[n] = (f32x4){0.f, 0.f, 0.f, 0.f};
        const int kmax = (16 * wave + 15) >> 5;
#pragma unroll
        for (int kk = 0; kk < 4; ++kk) {
            if (kk <= kmax) {
                const bf16x8 bfrag = ld_frag_lds(Wl + (16 * wave + fr) * 272 + (32 * kk + 8 * fq) * 2);
#pragma unroll
                for (int n = 0; n < 8; ++n) { const bf16x8 afrag = ld_frag_lds(GvT + (16 * n + fr) * 272 + (32 * kk + 8 * fq) * 2); acc[n] = MFMA16(afrag, bfrag, acc[n]); }
            }
        }
        const int t = 16 * wave + fr; const size_t grow = (size_t)(t0 + t);
        const float bsp = p.b_spatial[h * 128 + t];
        float ss = 0.f;
#pragma unroll
        for (int n = 0; n < 8; ++n) {
            const int d0 = 16 * n + 4 * fq;
            const u32x2 uw = *(const u32x2*)(P + p_off<0, 8, 128>(t0 + t, h, d0));
            const f32x4 gv = *(const f32x4*)(p.gm_vnorm_g + h * 128 + d0);
            f32x4 y;
            y[0] = bflo(uw.x) * (gv[0] * acc[n][0] + bsp); y[1] = bfhi(uw.x) * (gv[1] * acc[n][1] + bsp);
            y[2] = bflo(uw.y) * (gv[2] * acc[n][2] + bsp); y[3] = bfhi(uw.y) * (gv[3] * acc[n][3] + bsp);
            ss += (y[0] * y[0] + y[1] * y[1]) + (y[2] * y[2] + y[3] * y[3]);
            acc[n] = y;
        }
        ss += __shfl_xor(ss, 16); ss += __shfl_xor(ss, 32);
        const float rstd = rsqrtf(ss * (1.f / 128.f) + EPS);
#pragma unroll
        for (int n = 0; n < 8; ++n) {
            const int d0 = 16 * n + 4 * fq;
            const f32x4 g = *(const f32x4*)(p.gm_out_g + h * 128 + d0);
            const f32x4 o = acc[n] * rstd * g;
            u32x2 w; w.x = cvt_pk_bf16(o[0], o[1]); w.y = cvt_pk_bf16(o[2], o[3]);
            *(u32x2*)(YM + grow * DM + h * 128 + d0) = w;
        }
    }
}

DI void mlstm_local(const Params& p, LAS unsigned char* lds, int b, int c, int h) {
    const int tid = threadIdx.x, lane = tid & 63, wave = __builtin_amdgcn_readfirstlane(tid >> 6), fr = lane & 15, fq = lane >> 4;
    const int bh = b * 4 + h, t0 = b * 8192 + c * 128;
    LAS unsigned char* KT = lds; LAS unsigned char* VT = lds + 34816; LAS float* wsv = (LAS float*)(lds + 108800);
    const bf16_t* P = (const bf16_t*)(p.ws + WS_P);
    bf16_t* QC = (bf16_t*)(p.ws + WS_QC); bf16_t* KC = (bf16_t*)(p.ws + WS_KC);
    const float* IG = (const float*)(p.ws + WS_IG); const float* LF = (const float*)(p.ws + WS_LF);
    LAS float* cwl = (LAS float*)(lds + 109312);
    __syncthreads();
    u32x4 xw[2][5];
#define CONV_LOAD(half) do { _Pragma("unroll") for (int gi = 0; gi < 2; ++gi) { const int g = wave + 8 * (gi + 2 * (half)); const int cgp = (g & 15) * 8; \
        _Pragma("unroll") for (int dj = 0; dj < 5; ++dj) { const int srow = 2 * lane - 3 + dj; xw[gi][dj] = (u32x4){0u, 0u, 0u, 0u}; \
            if (c > 0 || srow >= 0) xw[gi][dj] = *(const u32x4*)(P + ((half) ? p_off<2560, 4, 128>(t0 + srow, h, cgp) : p_off<2048, 4, 128>(t0 + srow, h, cgp))); } } } while (0)
    CONV_LOAD(0);
    for (int idx = tid; idx < 1280; idx += NTHREADS) {
        const int j = idx >> 8, cc = idx & 255, ch = (cc >= 128 ? 512 : 0) + h * 128 + (cc & 127);
        cwl[idx] = j < 4 ? p.ml_conv_w[j * 1024 + ch] : p.ml_conv_b[ch];
    }
    if (wave == 0) {
        const float l0 = LF[(size_t)(t0 + 2 * lane) * 4 + h], l1 = LF[(size_t)(t0 + 2 * lane + 1) * 4 + h];
        const float i0 = IG[(size_t)(t0 + 2 * lane) * 4 + h], i1 = IG[(size_t)(t0 + 2 * lane + 1) * 4 + h];
        float s = l0 + l1;
#pragma unroll
        for (int off = 1; off < 64; off <<= 1) { const float tt = __shfl_up(s, off); if (lane >= off) s += tt; }
        const float b1 = s, b0 = s - l1, bend = __shfl(s, 63);
        const float g0 = bend - b0 + i0, g1 = bend - b1 + i1;
        const float gmax = wave_max(fmaxf(g0, g1));
        wsv[2 * lane] = __expf(g0 - gmax); wsv[2 * lane + 1] = __expf(g1 - gmax);
        if (lane == 0) { ((float*)(p.ws + WS_BEND))[bh * 64 + c] = bend; ((float*)(p.ws + WS_GMAX))[bh * 64 + c] = gmax; }
    }
    __syncthreads();
#pragma unroll
    for (int gi4 = 0; gi4 < 4; ++gi4) {
        const int gi = gi4 & 1;
        if (gi4 == 2) CONV_LOAD(1);
        const int g = wave + 8 * gi4; const bool isk = gi4 >= 2; const int cgp = (g & 15) * 8;
        const int cc0 = (isk ? 128 : 0) + cgp;
        const int s = 2 * lane;
        float y0[8], y1[8];
        {
            const f32x4 cb0 = *(const LAS f32x4*)(cwl + 1024 + cc0), cb1 = *(const LAS f32x4*)(cwl + 1024 + cc0 + 4);
#pragma unroll
            for (int e = 0; e < 8; ++e) { y0[e] = e < 4 ? cb0[e & 3] : cb1[e & 3]; y1[e] = y0[e]; }
#pragma unroll
            for (int j = 0; j < 5; ++j) {
                float xr[8];
#pragma unroll
                for (int q = 0; q < 4; ++q) { xr[2 * q] = bflo(xw[gi][j][q]); xr[2 * q + 1] = bfhi(xw[gi][j][q]); }
                if (j < 4) {
                    const f32x4 w0 = *(const LAS f32x4*)(cwl + j * 256 + cc0), w1 = *(const LAS f32x4*)(cwl + j * 256 + cc0 + 4);
#pragma unroll
                    for (int e = 0; e < 8; ++e) y0[e] += (e < 4 ? w0[e & 3] : w1[e & 3]) * xr[e];
                }
                if (j > 0) {
                    const f32x4 w0 = *(const LAS f32x4*)(cwl + (j - 1) * 256 + cc0), w1 = *(const LAS f32x4*)(cwl + (j - 1) * 256 + cc0 + 4);
#pragma unroll
                    for (int e = 0; e < 8; ++e) y1[e] += (e < 4 ? w0[e & 3] : w1[e & 3]) * xr[e];
                }
            }
        }
        const float sc = isk ? 0.08838834764831845f : 1.f;
#pragma unroll
        for (int e = 0; e < 8; ++e) { y0[e] = y0[e] * sigmoid_(y0[e]) * sc; y1[e] = y1[e] * sigmoid_(y1[e]) * sc; }
        bf16_t* dst = (isk ? KC : QC) + (size_t)(t0 + s) * 512 + h * 128 + cgp;
        u32x4 w; w.x = cvt_pk_bf16(y0[0], y0[1]); w.y = cvt_pk_bf16(y0[2], y0[3]); w.z = cvt_pk_bf16(y0[4], y0[5]); w.w = cvt_pk_bf16(y0[6], y0[7]);
        *(u32x4*)dst = w;
        w.x = cvt_pk_bf16(y1[0], y1[1]); w.y = cvt_pk_bf16(y1[2], y1[3]); w.z = cvt_pk_bf16(y1[4], y1[5]); w.w = cvt_pk_bf16(y1[6], y1[7]);
        *(u32x4*)(dst + 512) = w;
        if (isk) {
            const float w0 = wsv[s], w1 = wsv[s + 1];
#pragma unroll
            for (int e = 0; e < 8; ++e) *(LAS unsigned*)(KT + (cgp + e) * 272 + lane * 4) = cvt_pk_bf16(y0[e] * w0, y1[e] * w1);
        }
    }
    stage_T<4>(P + p_off<3072, 4, 256>(t0, h, 0), 256, VT, wave, lane);
    for (int i = tid; i < 1024; i += NTHREADS) { const int r = i >> 6, w = i & 63; *(LAS unsigned*)(VT + (256 + r) * 272 + w * 4) = 0x3F803F80u; }
    __syncthreads();
    bf16x8 af[4];
#pragma unroll
    for (int kk = 0; kk < 4; ++kk) af[kk] = ld_frag_lds(KT + (16 * wave + fr) * 272 + (32 * kk + 8 * fq) * 2);
    float* ST = (float*)(p.ws + WS_ST) + ((size_t)(bh * 64 + c) * 272) * 128;
#pragma unroll
    for (int n = 0; n < 17; ++n) {
        f32x4 acc = {0.f, 0.f, 0.f, 0.f};
#pragma unroll
        for (int kk = 0; kk < 4; ++kk) { const bf16x8 bfr = ld_frag_lds(VT + (16 * n + fr) * 272 + (32 * kk + 8 * fq) * 2); acc = MFMA16(af[kk], bfr, acc); }
        if (n < 16 || fr == 0) __builtin_nontemporal_store(acc, (f32x4*)(ST + (size_t)(16 * n + fr) * 128 + 16 * wave + 4 * fq));
    }
}

DI void phase_scan(const Params& p) {
    const float* ST = (const float*)(p.ws + WS_ST); bf16_t* CPT = (bf16_t*)(p.ws + WS_CPT);
    const float* BEND = (const float*)(p.ws + WS_BEND); const float* GMAX = (const float*)(p.ws + WS_GMAX); float* MPREV = (float*)(p.ws + WS_MPREV);
    const int gtid = blockIdx.x * NTHREADS + threadIdx.x, nthr = gridDim.x * NTHREADS;
    constexpr int PER = 8224;
    constexpr size_t CST = 272 * 128;
    if (nthr == 16 * 8192) {
        const int bh = gtid >> 13, e4 = gtid & 8191;
        const bool extra = (gtid & 255) == 0;
        const int e42 = 8192 + ((gtid >> 8) & 31);
        const float* src = ST + (size_t)bh * 64 * CST + (size_t)e4 * 4;
        bf16_t* dst = CPT + (size_t)bh * 64 * CST + (size_t)e4 * 4;
        const float* src2 = ST + (size_t)bh * 64 * CST + (size_t)e42 * 4;
        bf16_t* dst2 = CPT + (size_t)bh * 64 * CST + (size_t)e42 * 4;
        f32x4 st = {0.f, 0.f, 0.f, 0.f}, st2 = {0.f, 0.f, 0.f, 0.f}; float m = 0.f;
        for (int c0 = 0; c0 < 64; c0 += 8) {
            f32x4 d[8], d2[8]; float be[8], gm[8];
#pragma unroll
            for (int j = 0; j < 8; ++j) { d[j] = __builtin_nontemporal_load((const f32x4*)(src + (size_t)(c0 + j) * CST)); be[j] = BEND[bh * 64 + c0 + j]; gm[j] = GMAX[bh * 64 + c0 + j]; }
#pragma unroll
            for (int j = 0; j < 8; ++j) d2[j] = extra ? __builtin_nontemporal_load((const f32x4*)(src2 + (size_t)(c0 + j) * CST)) : (f32x4){0.f, 0.f, 0.f, 0.f};
#pragma unroll
            for (int j = 0; j < 8; ++j) {
                const int c = c0 + j;
                const float mn = fmaxf(be[j] + m, gm[j]), a = __expf(be[j] + m - mn), sc = __expf(gm[j] - mn);
                u32x2 w; w.x = cvt_pk_bf16(st[0], st[1]); w.y = cvt_pk_bf16(st[2], st[3]);
                *(u32x2*)(dst + (size_t)c * CST) = w;
                if (extra) { u32x2 w2; w2.x = cvt_pk_bf16(st2[0], st2[1]); w2.y = cvt_pk_bf16(st2[2], st2[3]); *(u32x2*)(dst2 + (size_t)c * CST) = w2; }
                if (e4 == 0) MPREV[bh * 64 + c] = m;
                st = st * a + d[j] * sc; st2 = st2 * a + d2[j] * sc; m = mn;
            }
        }
        return;
    }
    for (int item = gtid; item < 16 * PER; item += nthr) {
        const int bh = item / PER, e4 = item - bh * PER;
        const float* src = ST + (size_t)bh * 64 * CST + (size_t)e4 * 4;
        bf16_t* dst = CPT + (size_t)bh * 64 * CST + (size_t)e4 * 4;
        f32x4 st = {0.f, 0.f, 0.f, 0.f}; float m = 0.f;
        for (int c0 = 0; c0 < 64; c0 += 8) {
            f32x4 d[8]; float be[8], gm[8];
#pragma unroll
            for (int j = 0; j < 8; ++j) { d[j] = __builtin_nontemporal_load((const f32x4*)(src + (size_t)(c0 + j) * CST)); be[j] = BEND[bh * 64 + c0 + j]; gm[j] = GMAX[bh * 64 + c0 + j]; }
#pragma unroll
            for (int j = 0; j < 8; ++j) {
                const int c = c0 + j;
                const float mn = fmaxf(be[j] + m, gm[j]), a = __expf(be[j] + m - mn), sc = __expf(gm[j] - mn);
                u32x2 w; w.x = cvt_pk_bf16(st[0], st[1]); w.y = cvt_pk_bf16(st[2], st[3]);
                *(u32x2*)(dst + (size_t)c * CST) = w;
                if (e4 == 0) MPREV[bh * 64 + c] = m;
                st = st * a + d[j] * sc; m = mn;
            }
        }
    }
}

DI void mlstm_out(const Params& p, LAS unsigned char* lds, int b, int c, int h) {
    const int tid = threadIdx.x, lane = tid & 63, wave = __builtin_amdgcn_readfirstlane(tid >> 6), fr = lane & 15, fq = lane >> 4;
    const int bh = b * 4 + h, t0 = b * 8192 + c * 128;
    LAS unsigned char* Kl = lds; LAS unsigned char* Sl = lds + 34816; LAS unsigned char* VTe = lds + 69632;
    LAS float* av = (LAS float*)(lds + 143616); LAS float* Mv = (LAS float*)(lds + 144128); LAS float* bv = (LAS float*)(lds + 144640);
    const bf16_t* P = (const bf16_t*)(p.ws + WS_P); bf16_t* YM = (bf16_t*)(p.ws + WS_XN);
    const bf16_t* QC = (const bf16_t*)(p.ws + WS_QC); const bf16_t* KC = (const bf16_t*)(p.ws + WS_KC);
    const float* IG = (const float*)(p.ws + WS_IG); const float* LF = (const float*)(p.ws + WS_LF);
    const float mprev = ((const float*)(p.ws + WS_MPREV))[bh * 64 + c];
    __syncthreads();
    if (wave == 0) {
        const float l0 = LF[(size_t)(t0 + 2 * lane) * 4 + h], l1 = LF[(size_t)(t0 + 2 * lane + 1) * 4 + h];
        const float i0 = IG[(size_t)(t0 + 2 * lane) * 4 + h], i1 = IG[(size_t)(t0 + 2 * lane + 1) * 4 + h];
        float s = l0 + l1;
#pragma unroll
        for (int off = 1; off < 64; off <<= 1) { const float tt = __shfl_up(s, off); if (lane >= off) s += tt; }
        const float b1 = s, b0 = s - l1;
        const float a0 = i0 - b0, a1 = i1 - b1;
        float pm = fmaxf(a0, a1);
#pragma unroll
        for (int off = 1; off < 64; off <<= 1) { const float tt = __shfl_up(pm, off); if (lane >= off) pm = fmaxf(pm, tt); }
        float ex = __shfl_up(pm, 1); if (lane == 0) ex = -3.0e38f;
        Mv[2 * lane] = fmaxf(mprev, fmaxf(ex, a0)); Mv[2 * lane + 1] = fmaxf(mprev, pm);
        av[2 * lane] = a0; av[2 * lane + 1] = a1; bv[2 * lane] = b0; bv[2 * lane + 1] = b1;
    }
#pragma unroll
    for (int it = 0; it < 4; ++it) {
        const int e = (it * NTHREADS + tid) * 8, s = e >> 7, d0 = e & 127;
        *(LAS u32x4*)(Kl + s * 272 + d0 * 2) = *(const u32x4*)(KC + (size_t)(t0 + s) * 512 + h * 128 + d0);
    }
    stage_T<4>(P + p_off<3072, 4, 256>(t0, h, 0), 256, VTe, wave, lane);
    for (int i = tid; i < 1024; i += NTHREADS) { const int r = i >> 6, w = i & 63; *(LAS unsigned*)(VTe + (256 + r) * 272 + w * 4) = 0x3F803F80u; }
    bf16x8 qf[4];
#pragma unroll
    for (int kk = 0; kk < 4; ++kk) qf[kk] = *(const bf16x8*)(QC + (size_t)(t0 + 16 * wave + fr) * 512 + h * 128 + 32 * kk + 8 * fq);
    __syncthreads();
    const int t = 16 * wave + fr; const float Mt = Mv[t];
    const int stmax = wave | 1;
    for (int st = 0; st <= stmax; ++st) {
        f32x4 s4 = {0.f, 0.f, 0.f, 0.f};
#pragma unroll
        for (int kk = 0; kk < 4; ++kk) { const bf16x8 kf = ld_frag_lds(Kl + (16 * st + fr) * 272 + (32 * kk + 8 * fq) * 2); s4 = MFMA16(kf, qf[kk], s4); }
#pragma unroll
        for (int r = 0; r < 4; ++r) { const int s = 16 * st + 4 * fq + r; const float w = (s <= t) ? __expf(av[s] - Mt) : 0.f; s4[r] *= w; }
        u32x2 w; w.x = cvt_pk_bf16(s4[0], s4[1]); w.y = cvt_pk_bf16(s4[2], s4[3]);
        *(LAS u32x2*)(Sl + t * 272 + (16 * st + 4 * fq) * 2) = w;
    }
    __syncthreads();
    const bf16_t* cpt = (const bf16_t*)(p.ws + WS_CPT) + ((size_t)(bh * 64 + c) * 272) * 128;
    f32x4 acc[17];
#pragma unroll
    for (int n = 0; n < 17; ++n) acc[n] = (f32x4){0.f, 0.f, 0.f, 0.f};
#pragma unroll
    for (int half = 0; half < 2; ++half) {
        if (half) __syncthreads();
#pragma unroll 2
        for (int it = 0; it < 4; ++it) {
            const int e = (it * NTHREADS + tid) * 8, r = e >> 7, d0 = e & 127;
            *(LAS u32x4*)(Kl + r * 272 + d0 * 2) = *(const u32x4*)(cpt + (size_t)(128 * half + r) * 128 + d0);
        }
        __syncthreads();
#pragma unroll
        for (int n8 = 0; n8 < 8; ++n8) {
#pragma unroll
            for (int kk = 0; kk < 4; ++kk) { const bf16x8 cf = ld_frag_lds(Kl + (16 * n8 + fr) * 272 + (32 * kk + 8 * fq) * 2); acc[8 * half + n8] = MFMA16(cf, qf[kk], acc[8 * half + n8]); }
        }
    }
#pragma unroll
    for (int kk = 0; kk < 4; ++kk) { const bf16x8 cf = *(const bf16x8*)(cpt + (size_t)(256 + fr) * 128 + 32 * kk + 8 * fq); acc[16] = MFMA16(cf, qf[kk], acc[16]); }
    const float ai = __expf(mprev - Mt);
#pragma unroll
    for (int n = 0; n < 17; ++n) acc[n] = acc[n] * ai;
    const int k2max = (16 * wave + 15) >> 5;
#pragma unroll
    for (int kk = 0; kk < 4; ++kk) {
        if (kk <= k2max) {
            const bf16x8 sf = ld_frag_lds(Sl + t * 272 + (32 * kk + 8 * fq) * 2);
#pragma unroll
            for (int n = 0; n < 17; ++n) { const bf16x8 vf = ld_frag_lds(VTe + (16 * n + fr) * 272 + (32 * kk + 8 * fq) * 2); acc[n] = MFMA16(vf, sf, acc[n]); }
        }
    }
    const float den = __shfl(acc[16][0], fr);
    const float mt = bv[t] + Mt;
    const float inv = rcpf_(fmaxf(fabsf(den), __expf(-mt)));
    const size_t grow = (size_t)(t0 + t);
    float ss = 0.f;
#pragma unroll
    for (int n = 0; n < 16; ++n) {
        const int v0 = 16 * n + 4 * fq;
        const u32x2 ow = *(const u32x2*)(P + p_off<4096, 4, 256>(t0 + t, h, v0));
        f32x4 y;
        y[0] = bflo(ow.x) * acc[n][0] * inv; y[1] = bfhi(ow.x) * acc[n][1] * inv; y[2] = bflo(ow.y) * acc[n][2] * inv; y[3] = bfhi(ow.y) * acc[n][3] * inv;
        ss += (y[0] * y[0] + y[1] * y[1]) + (y[2] * y[2] + y[3] * y[3]);
        acc[n] = y;
    }
    ss += __shfl_xor(ss, 16); ss += __shfl_xor(ss, 32);
    const float rstd = rsqrtf(ss * (1.f / 256.f) + EPS);
#pragma unroll
    for (int n = 0; n < 16; ++n) {
        const int v0 = 16 * n + 4 * fq;
        const f32x4 g = *(const f32x4*)(p.ml_out_g + h * 256 + v0);
        const f32x4 o = acc[n] * rstd * g;
        u32x2 w; w.x = cvt_pk_bf16(o[0], o[1]); w.y = cvt_pk_bf16(o[2], o[3]);
        *(u32x2*)(YM + grow * DM + 1024 + h * 256 + v0) = w;
    }
}

DI unsigned ord_key(float f) { const unsigned u = __float_as_uint(f); return (u & 0x80000000u) ? ~u : (u | 0x80000000u); }
DI float key_val(unsigned k) { return (k & 0x80000000u) ? __uint_as_float(k & 0x7fffffffu) : __uint_as_float(~k); }
DI unsigned umax_(unsigned a, unsigned b) { return a > b ? a : b; }
DI unsigned umin_(unsigned a, unsigned b) { return a < b ? a : b; }
#define DPPU(v, ctrl) ((unsigned)__builtin_amdgcn_update_dpp(0, (int)(v), (ctrl), 0xF, 0xF, true))
DI unsigned row_max_u32(unsigned v) {
    v = umax_(v, DPPU(v, 0xB1)); v = umax_(v, DPPU(v, 0x4E)); v = umax_(v, DPPU(v, 0x141)); v = umax_(v, DPPU(v, 0x140)); return v;
}
DI float row_sum_f32(float v) {
    v += __uint_as_float(DPPU(__float_as_uint(v), 0xB1)); v += __uint_as_float(DPPU(__float_as_uint(v), 0x4E));
    v += __uint_as_float(DPPU(__float_as_uint(v), 0x141)); v += __uint_as_float(DPPU(__float_as_uint(v), 0x140)); return v;
}
#define CEX(a, b) do { const unsigned mx_ = umax_(a, b), mn_ = umin_(a, b); a = mx_; b = mn_; } while (0)
template <int N> DI unsigned top16_row(unsigned (&s)[N], int c) {
    unsigned list = 0u;
#pragma unroll 1
    for (int it = 0; it < 16; ++it) {
        const unsigned wm = row_max_u32(s[0]);
        const bool win = (s[0] == wm);
#pragma unroll
        for (int i = 0; i < N - 1; ++i) s[i] = win ? s[i + 1] : s[i];
        s[N - 1] = win ? 0u : s[N - 1];
        list = (c == it) ? wm : list;
    }
    return list;
}

template <int N> DI void top16_row2(unsigned (&s)[N], unsigned (&t)[N], int c, unsigned& l1, unsigned& l2) {
    l1 = 0u; l2 = 0u;
#pragma unroll 1
    for (int it = 0; it < 16; ++it) {
        const unsigned wm1 = row_max_u32(s[0]), wm2 = row_max_u32(t[0]);
        const bool win1 = (s[0] == wm1), win2 = (t[0] == wm2);
#pragma unroll
        for (int i = 0; i < N - 1; ++i) { s[i] = win1 ? s[i + 1] : s[i]; t[i] = win2 ? t[i + 1] : t[i]; }
        s[N - 1] = win1 ? 0u : s[N - 1]; t[N - 1] = win2 ? 0u : t[N - 1];
        l1 = (c == it) ? wm1 : l1; l2 = (c == it) ? wm2 : l2;
    }
}

template <int N> DI void top16_row4(unsigned (&s)[N], unsigned (&t)[N], unsigned (&u)[N], unsigned (&v)[N], int c, unsigned& l1, unsigned& l2, unsigned& l3, unsigned& l4) {
    l1 = 0u; l2 = 0u; l3 = 0u; l4 = 0u;
#pragma unroll 1
    for (int it = 0; it < 16; ++it) {
        const unsigned wm1 = row_max_u32(s[0]), wm2 = row_max_u32(t[0]), wm3 = row_max_u32(u[0]), wm4 = row_max_u32(v[0]);
        const bool win1 = (s[0] == wm1), win2 = (t[0] == wm2), win3 = (u[0] == wm3), win4 = (v[0] == wm4);
#pragma unroll
        for (int i = 0; i < N - 1; ++i) { s[i] = win1 ? s[i + 1] : s[i]; t[i] = win2 ? t[i + 1] : t[i]; u[i] = win3 ? u[i + 1] : u[i]; v[i] = win4 ? v[i + 1] : v[i]; }
        s[N - 1] = win1 ? 0u : s[N - 1]; t[N - 1] = win2 ? 0u : t[N - 1]; u[N - 1] = win3 ? 0u : u[N - 1]; v[N - 1] = win4 ? 0u : v[N - 1];
        l1 = (c == it) ? wm1 : l1; l2 = (c == it) ? wm2 : l2; l3 = (c == it) ? wm3 : l3; l4 = (c == it) ? wm4 : l4;
    }
}
#define SORT8(s) do { CEX(s[0], s[1]); CEX(s[2], s[3]); CEX(s[4], s[5]); CEX(s[6], s[7]); CEX(s[0], s[2]); CEX(s[1], s[3]); CEX(s[4], s[6]); CEX(s[5], s[7]); CEX(s[1], s[2]); CEX(s[5], s[6]); \
    CEX(s[0], s[4]); CEX(s[1], s[5]); CEX(s[2], s[6]); CEX(s[3], s[7]); CEX(s[2], s[4]); CEX(s[3], s[5]); CEX(s[1], s[2]); CEX(s[3], s[4]); CEX(s[5], s[6]); } while (0)
#define SORT4(s) do { CEX(s[0], s[1]); CEX(s[2], s[3]); CEX(s[0], s[2]); CEX(s[1], s[3]); CEX(s[1], s[2]); } while (0)

DI void peer_select(const Params& p) {
    const int tid = threadIdx.x, lane = tid & 63, wave = __builtin_amdgcn_readfirstlane(tid >> 6), c = lane & 15, g = lane >> 4, rowbase = lane & 48;
    const bf16_t* Q = (const bf16_t*)(p.ws + WS_Q); const bf16_t* KB1 = (const bf16_t*)(p.ws + WS_KB1); const bf16_t* KB2 = (const bf16_t*)(p.ws + WS_KB2);
    int* SELID = (int*)(p.ws + WS_SELID); float* SELG = (float*)(p.ws + WS_SELG);
    unsigned pk = 0u, validmask = 0u;
#pragma unroll
    for (int q = 0; q < 4; ++q) {
        const int target = 4 * c + q; int ci = 0, cj = 0, cnt = 0; bool v = false;
#pragma unroll
        for (int i = 0; i < 16; ++i) { const int nj = 16 / (i + 1); if (target >= cnt && target < cnt + nj) { ci = i; cj = target - cnt; v = true; } cnt += nj; }
        pk |= (unsigned)((ci << 4) | cj) << (8 * q); validmask |= (v ? 1u : 0u) << q;
    }
    for (int tile = blockIdx.x * 8 + wave; tile < T_TOK / 16; tile += gridDim.x * 8) {
        const int tok0 = tile * 16;
        for (int h = 0; h < 8; ++h) {
            bf16x8 a1[2], a2[2];
            {
                const bf16_t* qp = Q + (size_t)(tok0 + c) * 1024 + h * 128 + g * 8;
                a1[0] = *(const bf16x8*)qp; a1[1] = *(const bf16x8*)(qp + 32); a2[0] = *(const bf16x8*)(qp + 64); a2[1] = *(const bf16x8*)(qp + 96);
            }
            f32x4 acc1[8], acc2[8];
#pragma unroll
            for (int nt = 0; nt < 8; ++nt) {
                const size_t ko = ((size_t)(h * 128 + nt * 16 + c)) * 64 + g * 8;
                acc1[nt] = (f32x4){0.f, 0.f, 0.f, 0.f}; acc2[nt] = (f32x4){0.f, 0.f, 0.f, 0.f};
                acc1[nt] = MFMA16(a1[0], *(const bf16x8*)(KB1 + ko), acc1[nt]); acc1[nt] = MFMA16(a1[1], *(const bf16x8*)(KB1 + ko + 32), acc1[nt]);
                acc2[nt] = MFMA16(a2[0], *(const bf16x8*)(KB2 + ko), acc2[nt]); acc2[nt] = MFMA16(a2[1], *(const bf16x8*)(KB2 + ko + 32), acc2[nt]);
            }
#pragma unroll
            for (int rp = 0; rp < 2; ++rp) {
                const int r0 = 2 * rp, r1 = 2 * rp + 1;
                unsigned sA[8], sB[8], sC[8], sD[8];
#pragma unroll
                for (int nt = 0; nt < 8; ++nt) {
                    const unsigned ix = (unsigned)(127 - (nt * 16 + c));
                    sA[nt] = (ord_key(acc1[nt][r0]) & ~0x7Fu) | ix; sB[nt] = (ord_key(acc2[nt][r0]) & ~0x7Fu) | ix;
                    sC[nt] = (ord_key(acc1[nt][r1]) & ~0x7Fu) | ix; sD[nt] = (ord_key(acc2[nt][r1]) & ~0x7Fu) | ix;
                }
                SORT8(sA); SORT8(sB); SORT8(sC); SORT8(sD);
                unsigned lA, lB, lC, lD;
                top16_row4<8>(sA, sB, sC, sD, c, lA, lB, lC, lD);
                unsigned c0[4], c1[4];
#pragma unroll
                for (int q = 0; q < 4; ++q) {
                    const int ci = (int)((pk >> (8 * q + 4)) & 15u), cj = (int)((pk >> (8 * q)) & 15u);
                    const unsigned ka = (unsigned)__shfl((int)lA, rowbase + ci), kb = (unsigned)__shfl((int)lB, rowbase + cj);
                    const unsigned kc = (unsigned)__shfl((int)lC, rowbase + ci), kd = (unsigned)__shfl((int)lD, rowbase + cj);
                    const float cand0 = key_val(ka & ~0x7Fu) + key_val(kb & ~0x7Fu), cand1 = key_val(kc & ~0x7Fu) + key_val(kd & ~0x7Fu);
                    const bool ok = ((validmask >> q) & 1u) != 0u; const unsigned ix = (unsigned)(63 - (4 * c + q));
                    c0[q] = ok ? ((ord_key(cand0) & ~0x3Fu) | ix) : 0u; c1[q] = ok ? ((ord_key(cand1) & ~0x3Fu) | ix) : 0u;
                }
                SORT4(c0); SORT4(c1);
                unsigned sel0, sel1;
                top16_row2<4>(c0, c1, c, sel0, sel1);
#pragma unroll
                for (int u = 0; u < 2; ++u) {
                    const unsigned sel = u ? sel1 : sel0, list1 = u ? lC : lA, list2 = u ? lD : lB; const int r = u ? r1 : r0;
                    const int slot = 63 - (int)(sel & 63u);
                    const unsigned pkv = (unsigned)__shfl((int)pk, rowbase + (slot >> 2));
                    const int cij = (int)((pkv >> (8 * (slot & 3))) & 0xFFu);
                    const unsigned e1 = (unsigned)__shfl((int)list1, rowbase + (cij >> 4)), e2 = (unsigned)__shfl((int)list2, rowbase + (cij & 15));
                    const int eid = (127 - (int)(e1 & 127u)) * 128 + (127 - (int)(e2 & 127u));
                    const float sv = key_val(sel & ~0x3Fu), mx = key_val(row_max_u32(sel) & ~0x3Fu);
                    const float ev = __expf(sv - mx);
                    const float sum = row_sum_f32(ev);
                    const size_t o = (size_t)(tok0 + 4 * g + r) * 128 + h * 16 + c;
                    SELID[o] = eid; SELG[o] = ev * rcpf_(sum);
                }
            }
        }
    }
}

DI f32x2 pkfma(f32x2 a, f32x2 b, f32x2 c) { return __builtin_elementwise_fma(a, b, c); }
DI void peer_gather(const Params& p, LAS unsigned char* lds) {
    const int tid = threadIdx.x, lane = tid & 63, wave = __builtin_amdgcn_readfirstlane(tid >> 6);
    LAS float* scr = (LAS float*)lds + wave * (16 * 68);
    LAS float* cfl = (LAS float*)(lds + 8 * 16 * 68 * 4) + wave * 128;
    const unsigned char* Ub = p.ws + WS_UB; const unsigned char* Vb = p.ws + WS_VB;
    const float* PSS2 = (const float*)(p.ws + WS_PSS2);
    const int* SELID = (const int*)(p.ws + WS_SELID); const float* SELG = (const float*)(p.ws + WS_SELG);
    const int gw = blockIdx.x * 8 + wave, nw = gridDim.x * 8;
    for (int t = gw; t < T_TOK; t += nw) {
        const int idA = SELID[(size_t)t * 128 + lane], idB = SELID[(size_t)t * 128 + 64 + lane];
        const float gA = SELG[(size_t)t * 128 + lane], gB = SELG[(size_t)t * 128 + 64 + lane];
        const bf16_t* xrow = (const bf16_t*)(p.ws + WS_X1G) + (size_t)t * DM + lane * 32;
        float* orow = p.out + (size_t)t * DM + lane * 32;
        const float pv = lane < 32 ? PSS2[(size_t)t * 32 + lane] : 0.f;
        const float rstd2 = rsqrtf(wave_sum(pv) * (1.f / 2048.f) + EPS);
        f32x2 h2[16];
#pragma unroll
        for (int q = 0; q < 4; ++q) {
            const u32x4 xw = *(const u32x4*)(xrow + q * 8);
            const f32x4 g0 = *(const f32x4*)(p.norm2_g + lane * 32 + q * 8), g1 = *(const f32x4*)(p.norm2_g + lane * 32 + q * 8 + 4);
            h2[4 * q] = (f32x2){bflo(xw.x) * rstd2 * g0[0], bfhi(xw.x) * rstd2 * g0[1]};
            h2[4 * q + 1] = (f32x2){bflo(xw.y) * rstd2 * g0[2], bfhi(xw.y) * rstd2 * g0[3]};
            h2[4 * q + 2] = (f32x2){bflo(xw.z) * rstd2 * g1[0], bfhi(xw.z) * rstd2 * g1[1]};
            h2[4 * q + 3] = (f32x2){bflo(xw.w) * rstd2 * g1[2], bfhi(xw.w) * rstd2 * g1[3]};
        }
        constexpr int NPK = 8;
        u32x4 buf[2][NPK]; unsigned short bsc[2][NPK];
#define PEER_LOAD(TB, st, base) do { const int idv_ = ((base) < 64) ? idA : idB; _Pragma("unroll") for (int e_ = 0; e_ < NPK; ++e_) { \
            const int id_ = __builtin_amdgcn_readlane(idv_, ((base) + e_) & 63); const unsigned char* r_ = (TB) + (size_t)id_ * 1088; \
            buf[st][e_] = *(const u32x4*)(r_ + lane * 16); bsc[st][e_] = *(const unsigned short*)(r_ + 1024 + (lane >> 1) * 2); } } while (0)
#define PEER_DOT(st, slot0) do { _Pragma("unroll") for (int e_ = 0; e_ < NPK; ++e_) { f32x2 a2_ = {0.f, 0.f}; \
            _Pragma("unroll") for (int d_ = 0; d_ < 4; ++d_) { const unsigned w_ = buf[st][e_][d_]; \
                a2_ = pkfma(h2[d_ * 4 + 0], __builtin_amdgcn_cvt_scalef32_pk_f32_fp4(w_, 1.0f, 0), a2_); a2_ = pkfma(h2[d_ * 4 + 1], __builtin_amdgcn_cvt_scalef32_pk_f32_fp4(w_, 1.0f, 1), a2_); \
                a2_ = pkfma(h2[d_ * 4 + 2], __builtin_amdgcn_cvt_scalef32_pk_f32_fp4(w_, 1.0f, 2), a2_); a2_ = pkfma(h2[d_ * 4 + 3], __builtin_amdgcn_cvt_scalef32_pk_f32_fp4(w_, 1.0f, 3), a2_); } \
            scr[((slot0) + e_) * 68 + lane] = (a2_[0] + a2_[1]) * bf2f(bsc[st][e_]); } } while (0)
        PEER_LOAD(Ub, 0, 0);
        for (int b = 0; b < 128 / NPK; b += 2) {
            PEER_LOAD(Ub, 1, (b + 1) * NPK);
            PEER_DOT(0, (b * NPK) & 15);
            if (b + 2 < 128 / NPK) PEER_LOAD(Ub, 0, (b + 2) * NPK);
            PEER_DOT(1, ((b + 1) * NPK) & 15);
            if ((((b + 2) * NPK) & 15) == 0) {
                WAVE_LDS_SYNC();
                float sum = 0.f;
#pragma unroll
                for (int i = 0; i < 4; ++i) { const f32x4 r = *(const LAS f32x4*)(scr + (lane >> 2) * 68 + (lane & 3) * 16 + 4 * i); sum += (r[0] + r[1]) + (r[2] + r[3]); }
                sum += __shfl_xor(sum, 1); sum += __shfl_xor(sum, 2);
                const int k0 = (b + 2) * NPK - 16;
                const int k = k0 + (lane >> 2);
                const float gate = __shfl((k0 < 64) ? gA : gB, k & 63);
                if ((lane & 3) == 0) cfl[k] = gate * gelu_t(sum);
                WAVE_LDS_SYNC();
            }
        }
        f32x2 acc[16];
#pragma unroll
        for (int i = 0; i < 16; ++i) acc[i] = (f32x2){0.f, 0.f};
#define PEER_AXPY(st, base) do { _Pragma("unroll") for (int e_ = 0; e_ < NPK; ++e_) { const float c_ = cfl[(base) + e_] * bf2f(bsc[st][e_]); const f32x2 c2_ = {c_, c_}; \
            _Pragma("unroll") for (int d_ = 0; d_ < 4; ++d_) { const unsigned w_ = buf[st][e_][d_]; \
                acc[d_ * 4 + 0] = pkfma(c2_, __builtin_amdgcn_cvt_scalef32_pk_f32_fp4(w_, 1.0f, 0), acc[d_ * 4 + 0]); acc[d_ * 4 + 1] = pkfma(c2_, __builtin_amdgcn_cvt_scalef32_pk_f32_fp4(w_, 1.0f, 1), acc[d_ * 4 + 1]); \
                acc[d_ * 4 + 2] = pkfma(c2_, __builtin_amdgcn_cvt_scalef32_pk_f32_fp4(w_, 1.0f, 2), acc[d_ * 4 + 2]); acc[d_ * 4 + 3] = pkfma(c2_, __builtin_amdgcn_cvt_scalef32_pk_f32_fp4(w_, 1.0f, 3), acc[d_ * 4 + 3]); } } } while (0)
        PEER_LOAD(Vb, 0, 0);
        for (int b = 0; b < 128 / NPK; b += 2) {
            PEER_LOAD(Vb, 1, (b + 1) * NPK);
            PEER_AXPY(0, b * NPK);
            if (b + 2 < 128 / NPK) PEER_LOAD(Vb, 0, (b + 2) * NPK);
            PEER_AXPY(1, (b + 1) * NPK);
        }
        float ss = 0.f;
#pragma unroll
        for (int q = 0; q < 4; ++q) {
            const u32x4 xw = *(const u32x4*)(xrow + q * 8);
            acc[4 * q] += (f32x2){bflo(xw.x), bfhi(xw.x)}; acc[4 * q + 1] += (f32x2){bflo(xw.y), bfhi(xw.y)};
            acc[4 * q + 2] += (f32x2){bflo(xw.z), bfhi(xw.z)}; acc[4 * q + 3] += (f32x2){bflo(xw.w), bfhi(xw.w)};
#pragma unroll
            for (int i = 0; i < 4; ++i) { const f32x2 a = acc[4 * q + i]; ss += a[0] * a[0] + a[1] * a[1]; }
        }
        const float rstd = rsqrtf(wave_sum(ss) * (1.f / 2048.f) + EPS);
#pragma unroll
        for (int q = 0; q < 8; ++q) {
            const f32x4 g0 = *(const f32x4*)(p.final_g + lane * 32 + q * 4);
            const f32x2 a = acc[2 * q], b = acc[2 * q + 1];
            const f32x4 o0 = {a[0] * rstd * g0[0], a[1] * rstd * g0[1], b[0] * rstd * g0[2], b[1] * rstd * g0[3]};
            *(f32x4*)(orow + q * 4) = o0;
        }
        WAVE_LDS_SYNC();
    }
}

#define XB_TMO      128
#define XB_XCNT(j)  (256  + 64 * (j))
#define XB_XSUB(j)  (1280 + 64 * (j))
#define XB_XGEN(j)  (2304 + 64 * (j))
#define XB_TOP      3328
#define XB_TOPGEN   3392
#define XCD_BAR_WORDS 3456
#define XB_SPIN_CAP (1u << 18)

__device__ __forceinline__ unsigned xb_ld(unsigned* p)              { return __hip_atomic_load(p, __ATOMIC_RELAXED, __HIP_MEMORY_SCOPE_AGENT); }
__device__ __forceinline__ unsigned xb_add(unsigned* p, unsigned v) { return __hip_atomic_fetch_add(p, v, __ATOMIC_RELAXED, __HIP_MEMORY_SCOPE_AGENT); }
__device__ __forceinline__ unsigned xb_xcc_id() { return (unsigned)__builtin_amdgcn_s_getreg((3 << 11) | 20) & 0xFu; }
#define XB_SPIN(cond, bar) do { unsigned _sp = 0; while (cond) { __builtin_amdgcn_s_sleep(1); \
    if ((++_sp & 255u) == 0u) { if (xb_ld(&(bar)[XB_TMO])) break; if (_sp > XB_SPIN_CAP) { atomicAdd(&(bar)[XB_TMO], 1u); break; } } } } while (0)

struct XcdBarrier {
    unsigned* bar; unsigned x;
    volatile LAS unsigned* st;
};

__device__ __forceinline__ XcdBarrier xcd_barrier_post(unsigned* bar, volatile LAS unsigned* st) {
    XcdBarrier b; b.bar = bar; b.x = xb_xcc_id(); b.st = st;
    if (threadIdx.x == 0) (void)xb_add(&bar[XB_XCNT(b.x)], 1u);
    return b;
}
__device__ __forceinline__ void xcd_barrier_complete(unsigned* bar, unsigned x, unsigned& nloc, unsigned& nx) {
    const unsigned G = gridDim.x * gridDim.y * gridDim.z;
    unsigned sum, cnt, mine, sp = 0u;
    for (;;) {
        sum = 0u; cnt = 0u; mine = 0u;
#pragma unroll
        for (unsigned j = 0; j < 16; ++j) { const unsigned c = xb_ld(&bar[XB_XCNT(j)]); sum += c; cnt += (c > 0u) ? 1u : 0u; mine = (j == x) ? c : mine; }
        if (sum == G) break;
        __builtin_amdgcn_s_sleep(1);
        if ((++sp & 255u) == 0u) { if (xb_ld(&bar[XB_TMO])) break; if (sp > XB_SPIN_CAP) { atomicAdd(&bar[XB_TMO], 1u); break; } }
    }
    nloc = mine > 0u ? mine : 1u; nx = cnt > 0u ? cnt : 1u;
}

__device__ __forceinline__ void xcd_barrier(const XcdBarrier& b) {
    asm volatile("s_waitcnt vmcnt(0)" ::: "memory");
    __syncthreads();
    if (threadIdx.x == 0) {
        unsigned* bar = b.bar;
        __builtin_amdgcn_s_waitcnt(0);
        unsigned nloc = b.st[0], nx = b.st[1];
        if (nloc == 0u) { xcd_barrier_complete(bar, b.x, nloc, nx); b.st[0] = nloc; b.st[1] = nx; }
        const unsigned old = xb_add(&bar[XB_XSUB(b.x)], 1u);
        const unsigned gen = old / nloc;
        if (old + 1u == (gen + 1u) * nloc) {
            __builtin_amdgcn_fence(__ATOMIC_RELEASE, "agent");
            asm volatile("s_waitcnt vmcnt(0)" ::: "memory");
            const unsigned og = xb_add(&bar[XB_TOP], 1u);
            const unsigned tg = og / nx;
            if (og + 1u == (tg + 1u) * nx) xb_add(&bar[XB_TOPGEN], 1u);
            else XB_SPIN(xb_ld(&bar[XB_TOPGEN]) == tg, bar);
            __builtin_amdgcn_fence(__ATOMIC_ACQUIRE, "agent");
            xb_add(&bar[XB_XGEN(b.x)], 1u);
            asm volatile("s_waitcnt vmcnt(0)" ::: "memory");
        } else {
            XB_SPIN(xb_ld(&bar[XB_XGEN(b.x)]) == gen, bar);
            __builtin_amdgcn_fence(__ATOMIC_ACQUIRE, "agent");
            asm volatile("s_waitcnt vmcnt(0)" ::: "memory");
        }
    }
    __syncthreads();
}

#ifndef PROBE_DUP
#define PROBE_DUP 0
#endif
#define REP(bit) for (int rep_ = 0; rep_ < (((PROBE_DUP) >> (bit)) & 1) + 1; ++rep_)
#define PH1() { pg8::Gemm g{(const bf16_t*)(p.ws + WS_XN), (const bf16_t*)(p.ws + WS_WINT), T_TOK, NPROJ, DM}; pg8::StaticOrder S; S.init(T_TOK, NPROJ, G, bx); Epi1 E{(bf16_t*)(p.ws + WS_P), (float*)(p.ws + WS_PSSV)}; pg8::gemm_phase<Epi1, pg8::StaticOrder, true, true>(lds, g, S, E); xcd_barrier(xbar); }
#define PH3() { pg8::Gemm g{(const bf16_t*)(p.ws + WS_XN), (const bf16_t*)(p.ws + WS_WOUTT), T_TOK, DM, DM}; pg8::StaticOrder S; S.init(T_TOK, DM, G, bx); Epi2 E{p.x, (bf16_t*)(p.ws + WS_X1G), (float*)(p.ws + WS_PSS2)}; pg8::gemm_phase<Epi2, pg8::StaticOrder, true, true>(lds, g, S, E); xcd_barrier(xbar); }
#define PH4() { pg8::Gemm g{(const bf16_t*)(p.ws + WS_X1G), (const bf16_t*)(p.ws + WS_WQT), T_TOK, 1024, DM}; pg8::StaticOrder S; S.init(T_TOK, 1024, G, bx); Epi3 E{(bf16_t*)(p.ws + WS_Q), (const float*)(p.ws + WS_PSS2)}; pg8::gemm_phase<Epi3, pg8::StaticOrder, true, true>(lds, g, S, E); xcd_barrier(xbar); }
__global__ void __launch_bounds__(NTHREADS, 2) hymba_fwd(Params p) {
    extern __shared__ __attribute__((aligned(16))) unsigned char smem[];
    LAS unsigned char* lds = (LAS unsigned char*)smem;
    cg::grid_group grid = cg::this_grid();
    const int G = gridDim.x, bx = blockIdx.x;
    unsigned* barw = (unsigned*)(p.ws + WS_BAR);
    volatile LAS unsigned* xst = (volatile LAS unsigned*)(lds + LDS_BYTES - 16);
    if (threadIdx.x < 4) xst[threadIdx.x] = 0u;
    if (bx == 0) { for (int i = threadIdx.x; i < XCD_BAR_WORDS; i += NTHREADS) barw[i] = 0u; }
    __syncthreads();
    REP(0) { phase0(p, lds); grid.sync(); }
    const XcdBarrier xbar = xcd_barrier_post(barw, xst);
    PH1()
#if (PROBE_DUP >> 1) & 1
    PH1()
#endif
    REP(2) {
        for (int si = bx; si < 256; si += G) {
            const int b = si >> 6, c = si & 63;
            gmlp_bc(p, lds, b, c);
            for (int h = 0; h < 4; ++h) mlstm_local(p, lds, b, c, h);
        }
        xcd_barrier(xbar);
    }
    REP(3) { phase_scan(p); xcd_barrier(xbar); }
    REP(4) { for (int it = bx; it < 1024; it += G) mlstm_out(p, lds, it >> 8, (it >> 2) & 63, it & 3); xcd_barrier(xbar); }
    PH3()
#if (PROBE_DUP >> 5) & 1
    PH3()
#endif
    PH4()
#if (PROBE_DUP >> 6) & 1
    PH4()
#endif
    REP(7) { peer_select(p); xcd_barrier(xbar); }
    peer_gather(p, lds);
}

extern "C" void kernel_launch(void* const* d_in, const int* in_sizes, int n_in, void* d_out, int out_size, void* d_ws, size_t ws_size, hipStream_t stream) {
    static int grid_blocks = 0;
    if (grid_blocks == 0) {
        if (n_in != 20 || ws_size < WS_END) { fprintf(stderr, "kernel_launch: unexpected n_in %d or ws_size %zu (need %zu)\n", n_in, ws_size, (size_t)WS_END); grid_blocks = -1; return; }
        int dev = 0, cus = 0, per_cu = 0;
        hipGetDevice(&dev);
        hipDeviceGetAttribute(&cus, hipDeviceAttributeMultiprocessorCount, dev);
        hipFuncSetAttribute((const void*)hymba_fwd, hipFuncAttributeMaxDynamicSharedMemorySize, LDS_BYTES);
        hipOccupancyMaxActiveBlocksPerMultiprocessor(&per_cu, (const void*)hymba_fwd, NTHREADS, LDS_BYTES);
        if (per_cu < 1) { fprintf(stderr, "kernel_launch: occupancy query says %d blocks per CU\n", per_cu); per_cu = 1; }
        if (per_cu > 1) per_cu = 1;
        grid_blocks = cus * per_cu;
        (void)hipGetLastError();
    }
    if (grid_blocks < 0) return;
    Params p{};
    p.x = (const float*)d_in[0]; p.norm1_g = (const float*)d_in[1]; p.w_in = (const float*)d_in[2]; p.gm_vnorm_g = (const float*)d_in[3];
    p.w_spatial = (const float*)d_in[4]; p.b_spatial = (const float*)d_in[5]; p.ml_conv_w = (const float*)d_in[6]; p.ml_conv_b = (const float*)d_in[7];
    p.ml_b_i = (const float*)d_in[8]; p.ml_b_f = (const float*)d_in[9]; p.gm_out_g = (const float*)d_in[10]; p.ml_out_g = (const float*)d_in[11];
    p.w_out = (const float*)d_in[12]; p.norm2_g = (const float*)d_in[13]; p.peer_wq = (const float*)d_in[14]; p.peer_k1 = (const float*)d_in[15];
    p.peer_k2 = (const float*)d_in[16]; p.peer_u = (const float*)d_in[17]; p.peer_v = (const float*)d_in[18]; p.final_g = (const float*)d_in[19];
    p.out = (float*)d_out; p.ws = (unsigned char*)d_ws;
    void* args[] = {&p};
    hipError_t e = hipLaunchCooperativeKernel((const void*)hymba_fwd, dim3(grid_blocks), dim3(NTHREADS), args, LDS_BYTES, stream);
    if (e != hipSuccess) fprintf(stderr, "cooperative launch failed: %s (grid %d)\n", hipGetErrorString(e), grid_blocks);
}
```

```cpp
#include <hip/hip_runtime.h>
#include <hip/hip_cooperative_groups.h>
#include <cstdio>
#include <cstdint>
namespace cg = cooperative_groups;
namespace pg8 {
#define PG8_LAS __attribute__((address_space(3)))
typedef unsigned short bf16_t;
typedef short bf16x8 __attribute__((ext_vector_type(8)));
typedef float f32x4 __attribute__((ext_vector_type(4)));
typedef unsigned u32x4 __attribute__((ext_vector_type(4)));
constexpr int BM = 256, BK = 64, HALF = 128, HTB = HALF * BK * 2  , STAGE_BYTES = 8 * HTB, NXCD = 8, WGM = 8;

__host__ __device__ __forceinline__ int lds_byte(int r, int c) { const int st = (r >> 4) * 2 + (c >> 5), rr = r & 15, cc = c & 31, ob = rr * 64 + cc * 2; return st * 1024 + (ob ^ (((ob >> 9) & 1) << 5)); }
__host__ __device__ __forceinline__ void stage_rc(int b, int& R, int& C) { const int st = b / 1024, sb = b % 1024, swz = sb ^ (((sb >> 9) & 1) << 5); R = (st >> 1) * 16 + swz / 64; C = (st & 1) * 32 + (swz % 64) / 2; }
__host__ __device__ __forceinline__ int perm32(int rho) { const int n = rho >> 4, i = rho & 15; return 8 * (i >> 2) + 4 * n + (i & 3); }

struct Unit { int pm, pn; };
struct Gemm { const bf16_t* A; const bf16_t* Bt; int M, N, K; };

struct StaticOrder {
    int nM, nN, nwg, G, c;
    __host__ __device__ void init(int M, int N, int G_, int c_) { nM = M / BM; nN = N / BM; nwg = nM * nN; G = G_; c = c_; }
    __host__ __device__ bool next(int i, Unit& u) const {
        const long L = (long)i * G + c; if (L >= nwg) return false;
        int wgid = (int)L; { const int q = nwg / NXCD, r = nwg % NXCD, xcd = wgid % NXCD, off = wgid / NXCD; wgid = (xcd < r ? xcd * (q + 1) : r * (q + 1) + (xcd - r) * q) + off; }
        const int nig = WGM * nN, gid = wgid / nig, fm = gid * WGM, gsz = (nM - fm) < WGM ? (nM - fm) : WGM;
        u.pm = fm + ((wgid % nig) % gsz); u.pn = (wgid % nig) / gsz; return true;
    }
    __device__ __forceinline__ void a_ready(const Unit&) const {}
    __device__ __forceinline__ void done(const Unit&) const {}
};
__device__ __forceinline__ unsigned cvt_pk_bf16(float lo, float hi) { unsigned r; asm volatile("v_cvt_pk_bf16_f32 %0, %1, %2" : "=v"(r) : "v"(lo), "v"(hi)); return r; }
template <class Epi, class Sched, bool ALIGN_EPI = false, bool SP2 = false>
__device__ __forceinline__ void gemm_phase(PG8_LAS unsigned char* lds, const Gemm g, const Sched& S, const Epi& E) {
    const int tid = threadIdx.x, wid = __builtin_amdgcn_readfirstlane(tid >> 6), lane = tid & 63, wr = wid >> 2, wc = wid & 3, fr = lane & 15, fq = lane >> 4;
    const int K = g.K, nt = K / BK;
    unsigned voffA[2], voffB[2];
#pragma unroll
    for (int i = 0; i < 2; ++i) { int R, C; stage_rc(tid * 16 + i * 8192, R, C); const int Rb = Epi::PERM ? ((R & ~31) + perm32(R & 31)) : R;
        voffA[i] = (unsigned)(R * K + C) * 2u; voffB[i] = (unsigned)(Rb * K + C) * 2u; }
    const size_t kstep = (size_t)(BK * 2);
    const size_t hstep = (size_t)HALF * K * 2;
    const size_t tstep = 2 * hstep;
    const unsigned ldsw = (unsigned)wid * 1024u;
    const int aoff = lds_byte(wr * 64 + fr, fq * 8), boff = lds_byte(wc * 32 + fr, fq * 8);
#define PG8_SA(b, h) (((b) * 2 + (h)) * HTB)
#define PG8_SB(b, h) ((4 + (b) * 2 + (h)) * HTB)
#define PG8_STAGE(bufoff, gbase, voff) do { _Pragma("unroll") for (int _i = 0; _i < 2; ++_i) \
        __builtin_amdgcn_global_load_lds((const unsigned*)((const char*)(gbase) + (voff)[_i]), (PG8_LAS unsigned*)(lds + (bufoff) + ldsw + _i * 8192), 16, 0, 0); } while (0)
#define PG8_LDA(dst, b, h) do { _Pragma("unroll") for (int m = 0; m < 4; ++m) _Pragma("unroll") for (int k = 0; k < 2; ++k) dst[m][k] = *(const PG8_LAS bf16x8*)(lds + PG8_SA(b, h) + aoff + m * 2048 + k * 1024); } while (0)
#define PG8_LDB(dst, b, h) do { _Pragma("unroll") for (int n = 0; n < 2; ++n) _Pragma("unroll") for (int k = 0; k < 2; ++k) dst[n][k] = *(const PG8_LAS bf16x8*)(lds + PG8_SB(b, h) + boff + n * 2048 + k * 1024); } while (0)
#define PG8_MMA(ai, bj, At, Bt) do { __builtin_amdgcn_s_setprio(1); _Pragma("unroll") for (int m = 0; m < 4; ++m) _Pragma("unroll") for (int n = 0; n < 2; ++n) _Pragma("unroll") for (int k = 0; k < 2; ++k) \
        acc[ai][bj][m][n] = __builtin_amdgcn_mfma_f32_16x16x32_bf16(Bt[n][k], At[m][k], acc[ai][bj][m][n], 0, 0, 0); __builtin_amdgcn_s_setprio(0); } while (0)
#define PG8_WAIT_V(n) asm volatile("s_waitcnt vmcnt(" #n ")" ::: "memory")
#define PG8_WAIT_L(n) asm volatile("s_waitcnt lgkmcnt(" #n ")" ::: "memory")
#define PG8_BAR __builtin_amdgcn_s_barrier()
#define PG8_SCHED __builtin_amdgcn_sched_barrier(0)
    Unit cur, nxt; int ui = 0;
    if (!S.next(0, cur)) return;
    f32x4 acc[2][2][4][2];
#pragma unroll
    for (int a = 0; a < 2; ++a)
#pragma unroll
        for (int b = 0; b < 2; ++b)
#pragma unroll
            for (int m = 0; m < 4; ++m)
#pragma unroll
                for (int n = 0; n < 2; ++n) acc[a][b][m][n] = (f32x4){0.f, 0.f, 0.f, 0.f};
    bf16x8 At[4][2], B0[2][2], B1[2][2];
    const char* cA = (const char*)g.A + (size_t)cur.pm * tstep; const char* cB = (const char*)g.Bt + (size_t)cur.pn * tstep;
    S.a_ready(cur);
    if constexpr (SP2) {
        PG8_STAGE(PG8_SB(0, 0), cB, voffB); PG8_STAGE(PG8_SB(0, 1), cB + hstep, voffB); PG8_STAGE(PG8_SA(0, 0), cA, voffA); PG8_STAGE(PG8_SA(0, 1), cA + hstep, voffA);
        if (wr == 1) PG8_BAR;
        PG8_WAIT_V(2); PG8_BAR;
        PG8_STAGE(PG8_SB(1, 0), cB + kstep, voffB); PG8_STAGE(PG8_SA(1, 0), cA + kstep, voffA); PG8_STAGE(PG8_SB(1, 1), cB + hstep + kstep, voffB);
        PG8_WAIT_V(6); PG8_BAR;
    } else {
        PG8_STAGE(PG8_SB(0, 0), cB, voffB); PG8_STAGE(PG8_SA(0, 0), cA, voffA); PG8_STAGE(PG8_SB(0, 1), cB + hstep, voffB); PG8_STAGE(PG8_SA(0, 1), cA + hstep, voffA);
        if (wr == 1) PG8_BAR;
        PG8_WAIT_V(4); PG8_BAR;
        PG8_STAGE(PG8_SB(1, 0), cB + kstep, voffB); PG8_STAGE(PG8_SA(1, 0), cA + kstep, voffA); PG8_STAGE(PG8_SB(1, 1), cB + hstep + kstep, voffB);
        PG8_WAIT_V(6); PG8_BAR;
    }
    for (;;) {
        const bool has_next = S.next(ui + 1, nxt);
        const char* nA = has_next ? (const char*)g.A + (size_t)nxt.pm * tstep : cA; const char* nB = has_next ? (const char*)g.Bt + (size_t)nxt.pn * tstep : cB;
        for (int t = 0; t < nt; t += 2) {
            const bool last = (t == nt - 2);
            const char* a1 = cA + (size_t)(t + 1) * kstep;
            const char* a2 = last ? nA : cA + (size_t)(t + 2) * kstep; const char* b2 = last ? nB : cB + (size_t)(t + 2) * kstep;
            const char* a3 = a2 + kstep; const char* b3 = b2 + kstep;
            if (last && has_next) S.a_ready(nxt);
            if constexpr (SP2) {
            PG8_LDB(B0, 0, 0); PG8_LDB(B1, 0, 1); PG8_SCHED; PG8_LDA(At, 0, 0); PG8_STAGE(PG8_SA(1, 1), a1 + hstep, voffA);
            PG8_WAIT_V(8); PG8_WAIT_L(0); PG8_BAR; PG8_MMA(0, 0, At, B0); PG8_MMA(0, 1, At, B1); PG8_BAR; PG8_SCHED;
            PG8_LDA(At, 0, 1); PG8_STAGE(PG8_SB(0, 0), b2, voffB); PG8_STAGE(PG8_SB(0, 1), b2 + hstep, voffB); PG8_STAGE(PG8_SA(0, 0), a2, voffA);
            PG8_WAIT_V(8); PG8_WAIT_L(0); PG8_BAR; PG8_MMA(1, 0, At, B0); PG8_MMA(1, 1, At, B1); PG8_BAR; PG8_SCHED;
            PG8_LDB(B0, 1, 0); PG8_LDB(B1, 1, 1); PG8_SCHED; PG8_LDA(At, 1, 0); PG8_STAGE(PG8_SA(0, 1), a2 + hstep, voffA);
            PG8_WAIT_V(8); PG8_WAIT_L(0); PG8_BAR; PG8_MMA(0, 0, At, B0); PG8_MMA(0, 1, At, B1); PG8_BAR; PG8_SCHED;
            PG8_LDA(At, 1, 1); PG8_STAGE(PG8_SB(1, 0), b3, voffB); PG8_STAGE(PG8_SB(1, 1), b3 + hstep, voffB); PG8_STAGE(PG8_SA(1, 0), a3, voffA);
            PG8_WAIT_V(8); PG8_WAIT_L(0); PG8_BAR; PG8_MMA(1, 0, At, B0); PG8_MMA(1, 1, At, B1); PG8_BAR; PG8_SCHED;
            } else {
            PG8_LDB(B0, 0, 0); PG8_SCHED; PG8_LDA(At, 0, 0); PG8_STAGE(PG8_SA(1, 1), a1 + hstep, voffA);
            PG8_WAIT_L(8); PG8_BAR; PG8_WAIT_L(0); PG8_MMA(0, 0, At, B0); PG8_BAR; PG8_SCHED;
            PG8_LDB(B1, 0, 1); PG8_STAGE(PG8_SB(0, 0), b2, voffB);
            PG8_BAR; PG8_WAIT_L(0); PG8_MMA(0, 1, At, B1); PG8_BAR;
            PG8_LDA(At, 0, 1); PG8_STAGE(PG8_SA(0, 0), a2, voffA);
            PG8_BAR; PG8_WAIT_L(0); PG8_MMA(1, 0, At, B0); PG8_BAR; PG8_SCHED;
            PG8_STAGE(PG8_SB(0, 1), b2 + hstep, voffB);
            PG8_WAIT_V(6); PG8_BAR; PG8_MMA(1, 1, At, B1); PG8_BAR;
            PG8_LDB(B0, 1, 0); PG8_SCHED; PG8_LDA(At, 1, 0); PG8_STAGE(PG8_SA(0, 1), a2 + hstep, voffA);
            PG8_WAIT_L(8); PG8_BAR; PG8_WAIT_L(0); PG8_MMA(0, 0, At, B0); PG8_BAR; PG8_SCHED;
            PG8_LDB(B1, 1, 1); PG8_STAGE(PG8_SB(1, 0), b3, voffB);
            PG8_BAR; PG8_WAIT_L(0); PG8_MMA(0, 1, At, B1); PG8_BAR;
            PG8_LDA(At, 1, 1); PG8_STAGE(PG8_SA(1, 0), a3, voffA);
            PG8_BAR; PG8_WAIT_L(0); PG8_MMA(1, 0, At, B0); PG8_BAR; PG8_SCHED;
            PG8_STAGE(PG8_SB(1, 1), b3 + hstep, voffB);
            PG8_WAIT_V(6); PG8_BAR; PG8_MMA(1, 1, At, B1); PG8_BAR;
            }
        }
        if constexpr (ALIGN_EPI) { if (wr == 0) PG8_BAR; }
        if constexpr (!Epi::AFTER_DRAIN) { E(acc, cur, wr, wc, fr, fq); S.done(cur); }
        if (!has_next) break;
#pragma unroll
        for (int a = 0; a < 2; ++a)
#pragma unroll
            for (int b = 0; b < 2; ++b)
#pragma unroll
                for (int m = 0; m < 4; ++m)
#pragma unroll
                    for (int n = 0; n < 2; ++n) acc[a][b][m][n] = (f32x4){0.f, 0.f, 0.f, 0.f};
        cur = nxt; cA = nA; cB = nB; ++ui;
        if constexpr (ALIGN_EPI) { if (wr == 1) PG8_BAR; }
    }
    PG8_WAIT_V(0);
    if constexpr (!ALIGN_EPI) { if (wr == 0) PG8_BAR; }
    PG8_BAR;
    if constexpr (Epi::AFTER_DRAIN) { E.fused(acc, cur, wr, wc, fr, fq, lds, wid, lane); S.done(cur); }
#undef PG8_SA
#undef PG8_SB
#undef PG8_STAGE
#undef PG8_LDA
#undef PG8_LDB
#undef PG8_MMA
#undef PG8_WAIT_V
#undef PG8_WAIT_L
#undef PG8_BAR
#undef PG8_SCHED
}
}

#define LAS __attribute__((address_space(3)))
#define DI __device__ __forceinline__
using pg8::bf16_t; using pg8::bf16x8; using pg8::f32x4; using pg8::u32x4; using pg8::cvt_pk_bf16;
typedef unsigned u32x2 __attribute__((ext_vector_type(2)));
typedef float f32x2 __attribute__((ext_vector_type(2)));

constexpr int T_TOK = 32768, DM = 2048, NPROJ = 5120, PROJW = 5128;
constexpr int NTHREADS = 512;
constexpr int LDS_BYTES = 147456;
constexpr float EPS = 1e-6f;

constexpr size_t WS_XN = 0;
constexpr size_t WS_P = 134217728;
constexpr size_t WS_X1G = WS_P;
constexpr size_t WS_Q = WS_P + 134217728;
constexpr size_t WS_WINT = WS_P + 335544320;
constexpr size_t WS_WOUTT = WS_WINT + 20971520;
constexpr size_t WS_WQT = WS_WOUTT + 8388608;
constexpr size_t WS_UB = WS_WQT + 4194304;
constexpr size_t WS_VB = WS_UB + 67108864;
constexpr size_t WS_ST = WS_VB + 67108864;
constexpr size_t WS_CPT = WS_ST + 142606336;
constexpr size_t WS_QC = WS_CPT + 71303168;
constexpr size_t WS_KC = WS_QC + 33554432;
constexpr size_t WS_IG = WS_KC + 33554432;
constexpr size_t WS_LF = WS_IG + 524288;
constexpr size_t WS_PSSV = WS_LF + 524288;
constexpr size_t WS_PSS2 = WS_PSSV + 2097152;
constexpr size_t WS_BEND = WS_PSS2 + 4194304;
constexpr size_t WS_GMAX = WS_BEND + 4096;
constexpr size_t WS_MPREV = WS_GMAX + 4096;
constexpr size_t WS_SELID = WS_MPREV + 4096;
constexpr size_t WS_SELG = WS_SELID + 16777216;
constexpr size_t WS_KB1 = WS_SELG + 16777216;
constexpr size_t WS_KB2 = WS_KB1 + 131072;
constexpr size_t WS_BAR = WS_KB2 + 131072;
constexpr size_t WS_END = WS_BAR + 16384;

struct Params {
    const float *x, *norm1_g, *w_in, *gm_vnorm_g, *w_spatial, *b_spatial, *ml_conv_w, *ml_conv_b, *ml_b_i, *ml_b_f, *gm_out_g, *ml_out_g, *w_out, *norm2_g,
        *peer_wq, *peer_k1, *peer_k2, *peer_u, *peer_v, *final_g;
    float* out;
    unsigned char* ws;
};

template <int CB, int H, int W> DI size_t p_off(int t, int h, int d) { return (size_t)T_TOK * CB + ((size_t)((t >> 7) * H + h) * 128 + (t & 127)) * W + d; }
DI float bf2f(unsigned short h) { return __uint_as_float(((unsigned)h) << 16); }
DI float bflo(unsigned w) { return __uint_as_float(w << 16); }
DI float bfhi(unsigned w) { return __uint_as_float(w & 0xffff0000u); }
DI float rcpf_(float x) { return __builtin_amdgcn_rcpf(x); }
DI float sigmoid_(float x) { return rcpf_(1.f + __expf(-x)); }
DI float gelu_t(float x) { const float z = 1.5957691216057308f * (x + 0.044715f * x * x * x); return x * rcpf_(1.f + __expf(-z)); }
DI float wave_sum(float v) {
#pragma unroll
    for (int o = 32; o; o >>= 1) v += __shfl_xor(v, o);
    return v;
}
DI float wave_max(float v) {
#pragma unroll
    for (int o = 32; o; o >>= 1) v = fmaxf(v, __shfl_xor(v, o));
    return v;
}
DI bf16x8 ld_frag_lds(const LAS unsigned char* p) { return *(const LAS bf16x8*)p; }
#define MFMA16(a, b, c) __builtin_amdgcn_mfma_f32_16x16x32_bf16((a), (b), (c), 0, 0, 0)

struct Epi1 {
    static constexpr bool PERM = true, AFTER_DRAIN = false;
    bf16_t* P; float* pssv;
    DI void operator()(const f32x4 (&acc)[2][2][4][2], const pg8::Unit& u, int wr, int wc, int fr, int fq) const {
        const int row0 = u.pm * 256 + wr * 64 + fr, col0 = u.pn * 256 + wc * 32 + 8 * fq;
        const int mode = u.pn < 8 ? 1 : (u.pn >= 16 ? 2 : 0);
        const bool want_ss = (u.pn >= 4 && u.pn < 8);
#pragma unroll
        for (int ai = 0; ai < 2; ++ai)
#pragma unroll
            for (int m = 0; m < 4; ++m) {
                const int row = row0 + ai * 128 + m * 16;
                const int CB = u.pn < 4 ? 0 : (u.pn < 8 ? 1024 : (u.pn < 10 ? 2048 : (u.pn < 12 ? 2560 : (u.pn < 16 ? 3072 : 4096))));
                const int lw = u.pn < 12 ? 7 : 8, H = u.pn < 8 ? 8 : 4;
                float ss = 0.f;
#pragma unroll
                for (int bj = 0; bj < 2; ++bj) {
                    f32x4 v0 = acc[ai][bj][m][0], v1 = acc[ai][bj][m][1];
                    if (mode == 1) {
#pragma unroll
                        for (int j = 0; j < 4; ++j) { v0[j] = gelu_t(v0[j]); v1[j] = gelu_t(v1[j]); ss += v0[j] * v0[j] + v1[j] * v1[j]; }
                    } else if (mode == 2) {
#pragma unroll
                        for (int j = 0; j < 4; ++j) { v0[j] = sigmoid_(v0[j]); v1[j] = sigmoid_(v1[j]); }
                    }
                    u32x4 w; w.x = cvt_pk_bf16(v0[0], v0[1]); w.y = cvt_pk_bf16(v0[2], v0[3]); w.z = cvt_pk_bf16(v1[0], v1[1]); w.w = cvt_pk_bf16(v1[2], v1[3]);
                    {
                        const int cr = col0 + bj * 128 - CB, hh = cr >> lw, d = cr & ((1 << lw) - 1);
                        *(u32x4*)(P + (size_t)T_TOK * CB + (((size_t)((row >> 7) * H + hh) * 128 + (row & 127)) << lw) + d) = w;
                    }
                }
                if (want_ss) {
                    ss += __shfl_xor(ss, 16); ss += __shfl_xor(ss, 32);
                    if (fq == 0) pssv[(size_t)row * 16 + (u.pn - 4) * 4 + wc] = ss;
                }
            }
    }
};

struct Epi2 {
    static constexpr bool PERM = true, AFTER_DRAIN = false;
    const float* x; bf16_t* x1b; float* pss2;
    DI void operator()(const f32x4 (&acc)[2][2][4][2], const pg8::Unit& u, int wr, int wc, int fr, int fq) const {
        const int row0 = u.pm * 256 + wr * 64 + fr, col0 = u.pn * 256 + wc * 32 + 8 * fq;
#pragma unroll
        for (int ai = 0; ai < 2; ++ai)
#pragma unroll
            for (int m = 0; m < 4; ++m) {
                const int row = row0 + ai * 128 + m * 16;
                float ss = 0.f;
#pragma unroll
                for (int bj = 0; bj < 2; ++bj) {
                    const size_t o = (size_t)row * DM + col0 + bj * 128;
                    const f32x4 v0 = acc[ai][bj][m][0] + *(const f32x4*)(x + o), v1 = acc[ai][bj][m][1] + *(const f32x4*)(x + o + 4);
#pragma unroll
                    for (int j = 0; j < 4; ++j) ss += v0[j] * v0[j] + v1[j] * v1[j];
                    u32x4 w; w.x = cvt_pk_bf16(v0[0], v0[1]); w.y = cvt_pk_bf16(v0[2], v0[3]); w.z = cvt_pk_bf16(v1[0], v1[1]); w.w = cvt_pk_bf16(v1[2], v1[3]);
                    *(u32x4*)(x1b + o) = w;
                }
                ss += __shfl_xor(ss, 16); ss += __shfl_xor(ss, 32);
                if (fq == 0) pss2[(size_t)row * 32 + u.pn * 4 + wc] = ss;
            }
    }
};

struct Epi3 {
    static constexpr bool PERM = true, AFTER_DRAIN = false;
    bf16_t* Q; const float* pss2;
    DI void operator()(const f32x4 (&acc)[2][2][4][2], const pg8::Unit& u, int wr, int wc, int fr, int fq) const {
        const int row0 = u.pm * 256 + wr * 64 + fr, col0 = u.pn * 256 + wc * 32 + 8 * fq;
#pragma unroll
        for (int ai = 0; ai < 2; ++ai)
#pragma unroll
            for (int m = 0; m < 4; ++m) {
                const int row = row0 + ai * 128 + m * 16;
                float ss = 0.f;
#pragma unroll
                for (int i = 0; i < 8; ++i) { const f32x4 t = *(const f32x4*)(pss2 + (size_t)row * 32 + i * 4); ss += (t[0] + t[1]) + (t[2] + t[3]); }
                const float rstd = rsqrtf(ss * (1.f / 2048.f) + EPS);
#pragma unroll
                for (int bj = 0; bj < 2; ++bj) {
                    const f32x4 v0 = acc[ai][bj][m][0] * rstd, v1 = acc[ai][bj][m][1] * rstd;
                    u32x4 w; w.x = cvt_pk_bf16(v0[0], v0[1]); w.y = cvt_pk_bf16(v0[2], v0[3]); w.z = cvt_pk_bf16(v1[0], v1[1]); w.w = cvt_pk_bf16(v1[2], v1[3]);
                    *(u32x4*)(Q + (size_t)row * 1024 + col0 + bj * 128) = w;
                }
            }
    }
};

DI void phase0(const Params& p, LAS unsigned char* lds) {
    const int tid = threadIdx.x, lane = tid & 63, wave = tid >> 6;
    bf16_t* XN = (bf16_t*)(p.ws + WS_XN);
    {
        LAS float* scr = (LAS float*)lds + wave * (64 * 65);
        const int gw = blockIdx.x * 8 + wave, nw = gridDim.x * 8;
        for (int it = gw; it < 4096; it += nw) {
            const float* W; bf16_t* WT; int ldw, kt, nt;
            if (it < 2560) { W = p.w_in; WT = (bf16_t*)(p.ws + WS_WINT); ldw = PROJW; kt = it / 80; nt = it % 80; }
            else if (it < 3584) { const int j = it - 2560; W = p.w_out; WT = (bf16_t*)(p.ws + WS_WOUTT); ldw = 2048; kt = j >> 5; nt = j & 31; }
            else { const int j = it - 3584; W = p.peer_wq; WT = (bf16_t*)(p.ws + WS_WQT); ldw = 1024; kt = j >> 4; nt = j & 15; }
            const int k0 = kt * 64, n0 = nt * 64;
            {
                f32x4 tv[16];
#pragma unroll
                for (int i = 0; i < 16; ++i) tv[i] = *(const f32x4*)(W + (size_t)(k0 + 4 * i + (lane >> 4)) * ldw + n0 + 4 * (lane & 15));
#pragma unroll
                for (int i = 0; i < 16; ++i) {
                    const int r = 4 * i + (lane >> 4);
                    const float gsc = it >= 3584 ? p.norm2_g[k0 + r] : 1.f;
                    LAS float* d = scr + r * 65 + 4 * (lane & 15);
                    d[0] = tv[i][0] * gsc; d[1] = tv[i][1] * gsc; d[2] = tv[i][2] * gsc; d[3] = tv[i][3] * gsc;
                }
            }
            __builtin_amdgcn_fence(__ATOMIC_RELEASE, "wavefront"); __builtin_amdgcn_wave_barrier(); __builtin_amdgcn_fence(__ATOMIC_ACQUIRE, "wavefront");
            const int half = lane >> 5, kk = (lane & 31) * 2;
#pragma unroll 8
            for (int nn = 0; nn < 32; ++nn) {
                const int n = 2 * nn + half; const float a = scr[kk * 65 + n], b = scr[(kk + 1) * 65 + n];
                *(unsigned*)(WT + (size_t)(n0 + n) * 2048 + k0 + kk) = cvt_pk_bf16(a, b);
            }
            __builtin_amdgcn_fence(__ATOMIC_RELEASE, "wavefront"); __builtin_amdgcn_wave_barrier(); __builtin_amdgcn_fence(__ATOMIC_ACQUIRE, "wavefront");
        }
    }
    __syncthreads();
    {
        LAS float* wg = (LAS float*)lds;
        for (int idx = tid; idx < 4096; idx += NTHREADS) {
            const int k = idx >> 1, hf = idx & 1;
            const f32x4 v = *(const f32x4*)(p.w_in + (size_t)k * PROJW + 5120 + hf * 4);
            *(LAS f32x4*)(wg + k * 8 + (k >> 3) * 4 + hf * 4) = v;
        }
        __syncthreads();
        float* IG = (float*)(p.ws + WS_IG); float* LF = (float*)(p.ws + WS_LF);
        for (int row0 = 2 * (blockIdx.x * 8 + wave); row0 < T_TOK; row0 += 2 * gridDim.x * 8) {
            f32x4 xv[2][8];
#pragma unroll
            for (int rr = 0; rr < 2; ++rr) {
                const float* xr = p.x + (size_t)(row0 + rr) * DM;
#pragma unroll
                for (int i = 0; i < 4; ++i) { xv[rr][2 * i] = *(const f32x4*)(xr + i * 512 + lane * 8); xv[rr][2 * i + 1] = *(const f32x4*)(xr + i * 512 + lane * 8 + 4); }
            }
#pragma unroll
            for (int rr = 0; rr < 2; ++rr) {
                const int row = row0 + rr;
                float ss = 0.f;
#pragma unroll
                for (int i = 0; i < 8; ++i) ss += (xv[rr][i][0] * xv[rr][i][0] + xv[rr][i][1] * xv[rr][i][1]) + (xv[rr][i][2] * xv[rr][i][2] + xv[rr][i][3] * xv[rr][i][3]);
                ss = wave_sum(ss);
                const float rstd = rsqrtf(ss * (1.f / 2048.f) + EPS);
                f32x4 ga = {0.f, 0.f, 0.f, 0.f}, gb = {0.f, 0.f, 0.f, 0.f};
#pragma unroll
                for (int i = 0; i < 4; ++i) {
                    const f32x4 g0 = *(const f32x4*)(p.norm1_g + i * 512 + lane * 8), g1 = *(const f32x4*)(p.norm1_g + i * 512 + lane * 8 + 4);
                    const f32x4 h0 = xv[rr][2 * i] * rstd * g0, h1 = xv[rr][2 * i + 1] * rstd * g1;
                    u32x4 w; w.x = cvt_pk_bf16(h0[0], h0[1]); w.y = cvt_pk_bf16(h0[2], h0[3]); w.z = cvt_pk_bf16(h1[0], h1[1]); w.w = cvt_pk_bf16(h1[2], h1[3]);
                    *(u32x4*)(XN + (size_t)row * DM + i * 512 + lane * 8) = w;
                    const LAS float* wb = wg + (i * 512 + lane * 8) * 8 + (i * 64 + lane) * 4;
#pragma unroll
                    for (int e = 0; e < 8; ++e) {
                        const float hv = e < 4 ? h0[e & 3] : h1[e & 3];
                        const f32x4 w0 = *(const LAS f32x4*)(wb + e * 8), w1 = *(const LAS f32x4*)(wb + e * 8 + 4);
                        ga = ga + w0 * hv; gb = gb + w1 * hv;
                    }
                }
                f32x4 m4 = lane < 32 ? ga : gb, s4 = lane < 32 ? gb : ga;
#pragma unroll
                for (int j = 0; j < 4; ++j) m4[j] += __shfl_xor(s4[j], 32);
                const bool up16 = (lane & 16) != 0;
                float m2a = up16 ? m4[2] : m4[0], m2b = up16 ? m4[3] : m4[1];
                const float s2a = up16 ? m4[0] : m4[2], s2b = up16 ? m4[1] : m4[3];
                m2a += __shfl_xor(s2a, 16); m2b += __shfl_xor(s2b, 16);
                const bool up8 = (lane & 8) != 0;
                float m1 = up8 ? m2b : m2a; const float s1 = up8 ? m2a : m2b;
                m1 += __shfl_xor(s1, 8);
                m1 += __shfl_xor(m1, 4); m1 += __shfl_xor(m1, 2); m1 += __shfl_xor(m1, 1);
                const int j = ((lane >> 5) << 2) | (((lane >> 4) & 1) << 1) | ((lane >> 3) & 1);
                if ((lane & 7) == 0) {
                    if (j < 4) IG[(size_t)row * 4 + j] = m1 + p.ml_b_i[j];
                    else { const float z = m1 + p.ml_b_f[j - 4]; LF[(size_t)row * 4 + j - 4] = fminf(z, 0.f) - log1pf(__expf(-fabsf(z))); }
                }
            }
        }
    }
    {
        const size_t nthr = (size_t)gridDim.x * NTHREADS, NQ = (size_t)16384 * 512;
        for (size_t base = (size_t)blockIdx.x * NTHREADS + tid; base < 2 * NQ; base += 16 * nthr) {
            f32x4 v[16];
#pragma unroll
            for (int u = 0; u < 16; ++u) {
                size_t i = base + u * nthr; if (i >= 2 * NQ) i = base;
                const int which = i >= NQ; const size_t j = i - (which ? NQ : 0);
                v[u] = *(const f32x4*)((which ? p.peer_v : p.peer_u) + j * 4);
            }
#pragma unroll
            for (int u = 0; u < 16; ++u) {
                size_t i = base + u * nthr; if (i >= 2 * NQ) i = base;
                const int which = i >= NQ; const size_t j = i - (which ? NQ : 0);
                const int row = (int)(j >> 9), c4 = (int)(j & 511);
                float amax = fmaxf(fmaxf(fabsf(v[u][0]), fabsf(v[u][1])), fmaxf(fabsf(v[u][2]), fabsf(v[u][3])));
                amax = fmaxf(amax, __uint_as_float((unsigned)__builtin_amdgcn_update_dpp(0, (int)__float_as_uint(amax), 0xB1, 0xF, 0xF, true)));
                amax = fmaxf(amax, __uint_as_float((unsigned)__builtin_amdgcn_update_dpp(0, (int)__float_as_uint(amax), 0x4E, 0xF, 0xF, true)));
                amax = fmaxf(amax, __uint_as_float((unsigned)__builtin_amdgcn_update_dpp(0, (int)__float_as_uint(amax), 0x141, 0xF, 0xF, true)));
                amax = fmaxf(amax, __uint_as_float((unsigned)__builtin_amdgcn_update_dpp(0, (int)__float_as_uint(amax), 0x140, 0xF, 0xF, true)));
                const unsigned sb = cvt_pk_bf16(amax * (1.f / 6.f), 0.f) & 0xffffu;
                float sc = bflo(sb); if (sc == 0.f) sc = 1.f;
                const float inv = 1.f / sc;
                unsigned r = 0u;
                r = __builtin_amdgcn_cvt_scalef32_pk_fp4_f32(r, v[u][0] * inv, v[u][1] * inv, 1.0f, 0);
                r = __builtin_amdgcn_cvt_scalef32_pk_fp4_f32(r, v[u][2] * inv, v[u][3] * inv, 1.0f, 1);
                unsigned char* dst = p.ws + (which ? WS_VB : WS_UB) + (size_t)row * 1088;
                *(unsigned short*)(dst + c4 * 2) = (unsigned short)(r & 0xffffu);
                if ((c4 & 15) == 0) *(unsigned short*)(dst + 1024 + (c4 >> 4) * 2) = (unsigned short)(sb == 0u ? 0x3F80u : sb);
            }
        }
    }
    {
        bf16_t* KB1 = (bf16_t*)(p.ws + WS_KB1); bf16_t* KB2 = (bf16_t*)(p.ws + WS_KB2);
        for (int i = blockIdx.x * NTHREADS + tid; i < 65536 / 4; i += gridDim.x * NTHREADS) {
            const f32x4 a = *(const f32x4*)(p.peer_k1 + i * 4), b = *(const f32x4*)(p.peer_k2 + i * 4);
            u32x2 w; w.x = cvt_pk_bf16(a[0], a[1]); w.y = cvt_pk_bf16(a[2], a[3]); *(u32x2*)(KB1 + i * 4) = w;
            w.x = cvt_pk_bf16(b[0], b[1]); w.y = cvt_pk_bf16(b[2], b[3]); *(u32x2*)(KB2 + i * 4) = w;
        }
    }
}

#define WAVE_LDS_SYNC() do { __builtin_amdgcn_fence(__ATOMIC_RELEASE, "wavefront"); __builtin_amdgcn_wave_barrier(); __builtin_amdgcn_fence(__ATOMIC_ACQUIRE, "wavefront"); } while (0)

template <int NG> DI void stage_T_load(const bf16_t* src, int ld, u32x4 (&r0)[NG], u32x4 (&r1)[NG], int wave, int lane) {
#pragma unroll
    for (int i = 0; i < NG; ++i) {
        const int g = wave + 8 * i;
        r0[i] = *(const u32x4*)(src + (size_t)(2 * lane) * ld + g * 8);
        r1[i] = *(const u32x4*)(src + (size_t)(2 * lane + 1) * ld + g * 8);
    }
}
template <int NG> DI void stage_T_store(const u32x4 (&r0)[NG], const u32x4 (&r1)[NG], LAS unsigned char* dst, int wave, int lane) {
#pragma unroll
    for (int i = 0; i < NG; ++i) {
        const int g = wave + 8 * i;
#pragma unroll
        for (int w = 0; w < 4; ++w) {
            const unsigned a = r0[i][w], b = r1[i][w];
            *(LAS unsigned*)(dst + (g * 8 + 2 * w) * 272 + lane * 4) = (a & 0xffffu) | (b << 16);
            *(LAS unsigned*)(dst + (g * 8 + 2 * w + 1) * 272 + lane * 4) = (a >> 16) | (b & 0xffff0000u);
        }
    }
}
template <int NG> DI void stage_T(const bf16_t* src, int ld, LAS unsigned char* dst, int wave, int lane) {
    u32x4 r0[NG], r1[NG];
    stage_T_load<NG>(src, ld, r0, r1, wave, lane);
    stage_T_store<NG>(r0, r1, dst, wave, lane);
}

DI void gmlp_bc(const Params& p, LAS unsigned char* lds, int b, int c) {
    const int tid = threadIdx.x, lane = tid & 63, wave = __builtin_amdgcn_readfirstlane(tid >> 6), fr = lane & 15, fq = lane >> 4;
    const int t0 = b * 8192 + c * 128;
    LAS unsigned char* Wl = lds; LAS unsigned char* GvT = lds + 34816; LAS float* rstdv = (LAS float*)(lds + 69632);
    const bf16_t* P = (const bf16_t*)(p.ws + WS_P); bf16_t* YM = (bf16_t*)(p.ws + WS_XN);
    const float* PSSV = (const float*)(p.ws + WS_PSSV);
    __syncthreads();
    if (tid < 128) {
        float ss = 0.f;
#pragma unroll
        for (int i = 0; i < 4; ++i) { const f32x4 v = *(const f32x4*)(PSSV + (size_t)(t0 + tid) * 16 + i * 4); ss += (v[0] + v[1]) + (v[2] + v[3]); }
        rstdv[tid] = rsqrtf(ss * (1.f / 1024.f) + EPS);
    }
    f32x4 wa[4][2]; u32x4 gr0[2], gr1[2];
#define GMLP_PREFETCH(hh) do { _Pragma("unroll") for (int it = 0; it < 4; ++it) { const int e = (it * NTHREADS + tid) * 8, t = e >> 7, s0 = e & 127; \
            const float* wp = p.w_spatial + ((size_t)((hh) * 128 + t)) * 128 + s0; wa[it][0] = *(const f32x4*)wp; wa[it][1] = *(const f32x4*)(wp + 4); } \
        stage_T_load<2>(P + p_off<1024, 8, 128>(t0, (hh), 0), 128, gr0, gr1, wave, lane); } while (0)
    GMLP_PREFETCH(0);
    for (int h = 0; h < 8; ++h) {
        __syncthreads();
#pragma unroll
        for (int it = 0; it < 4; ++it) {
            const int e = (it * NTHREADS + tid) * 8, t = e >> 7, s0 = e & 127;
            float v[8];
#pragma unroll
            for (int j = 0; j < 8; ++j) { const float a = j < 4 ? wa[it][0][j & 3] : wa[it][1][j & 3]; v[j] = (s0 + j <= t) ? a * rstdv[s0 + j] : 0.f; }
            u32x4 w; w.x = cvt_pk_bf16(v[0], v[1]); w.y = cvt_pk_bf16(v[2], v[3]); w.z = cvt_pk_bf16(v[4], v[5]); w.w = cvt_pk_bf16(v[6], v[7]);
            *(LAS u32x4*)(Wl + t * 272 + s0 * 2) = w;
        }
        stage_T_store<2>(gr0, gr1, GvT, wave, lane);
        __syncthreads();
        if (h + 1 < 8) GMLP_PREFETCH(h + 1);
        f32x4 acc[8];
#pragma unroll
        for (int n = 0; n < 8; ++n) acc[n] = (f32x4){0.f, 0.f, 0.f, 0.f};
        const int kmax = (16 * wave + 15) >> 5;
#pragma unroll
        for (int kk = 0; kk < 4; ++kk) {
            if (kk <= kmax) {
                const bf16x8 bfrag = ld_frag_lds(Wl + (16 * wave + fr) * 272 + (32 * kk + 8 * fq) * 2);
#pragma unroll
                for (int n = 0; n < 8; ++n) { const bf16x8 afrag = ld_frag_lds(GvT + (16 * n + fr) * 272 + (32 * kk + 8 * fq) * 2); acc[n] = MFMA16(afrag, bfrag, acc[n]); }
            }
        }
        const int t = 16 * wave + fr; const size_t grow = (size_t)(t0 + t);
        const float bsp = p.b_spatial[h * 128 + t];
        float ss = 0.f;
#pragma unroll
        for (int n = 0; n < 8; ++n) {
            const int d0 = 16 * n + 4 * fq;
            const u32x2 uw = *(const u32x2*)(P + p_off<0, 8, 128>(t0 + t, h, d0));
            const f32x4 gv = *(const f32x4*)(p.gm_vnorm_g + h * 128 + d0);
            f32x4 y;
            y[0] = bflo(uw.x) * (gv[0] * acc[n][0] + bsp); y[1] = bfhi(uw.x) * (gv[1] * acc[n][1] + bsp);
            y[2] = bflo(uw.y) * (gv[2] * acc[n][2] + bsp); y[3] = bfhi(uw.y) * (gv[3] * acc[n][3] + bsp);
            ss += (y[0] * y[0] + y[1] * y[1]) + (y[2] * y[2] + y[3] * y[3]);
            acc[n] = y;
        }
        ss += __shfl_xor(ss, 16); ss += __shfl_xor(ss, 32);
        const float rstd = rsqrtf(ss * (1.f / 128.f) + EPS);
#pragma unroll
        for (int n = 0; n < 8; ++n) {
            const int d0 = 16 * n + 4 * fq;
            const f32x4 g = *(const f32x4*)(p.gm_out_g + h * 128 + d0);
            const f32x4 o = acc[n] * rstd * g;
            u32x2 w; w.x = cvt_pk_bf16(o[0], o[1]); w.y = cvt_pk_bf16(o[2], o[3]);
            *(u32x2*)(YM + grow * DM + h * 128 + d0) = w;
        }
    }
}

DI void mlstm_local(const Params& p, LAS unsigned char* lds, int b, int c, int h) {
    const int tid = threadIdx.x, lane = tid & 63, wave = __builtin_amdgcn_readfirstlane(tid >> 6), fr = lane & 15, fq = lane >> 4;
    const int bh = b * 4 + h, t0 = b * 8192 + c * 128;
    LAS unsigned char* KT = lds; LAS unsigned char* VT = lds + 34816; LAS float* wsv = (LAS float*)(lds + 108800);
    const bf16_t* P = (const bf16_t*)(p.ws + WS_P);
    bf16_t* QC = (bf16_t*)(p.ws + WS_QC); bf16_t* KC = (bf16_t*)(p.ws + WS_KC);
    const float* IG = (const float*)(p.ws + WS_IG); const float* LF = (const float*)(p.ws + WS_LF);
    LAS float* cwl = (LAS float*)(lds + 109312);
    __syncthreads();
    u32x4 xw[2][5];
#define CONV_LOAD(half) do { _Pragma("unroll") for (int gi = 0; gi < 2; ++gi) { const int g = wave + 8 * (gi + 2 * (half)); const int cgp = (g & 15) * 8; \
        _Pragma("unroll") for (int dj = 0; dj < 5; ++dj) { const int srow = 2 * lane - 3 + dj; xw[gi][dj] = (u32x4){0u, 0u, 0u, 0u}; \
            if (c > 0 || srow >= 0) xw[gi][dj] = *(const u32x4*)(P + ((half) ? p_off<2560, 4, 128>(t0 + srow, h, cgp) : p_off<2048, 4, 128>(t0 + srow, h, cgp))); } } } while (0)
    CONV_LOAD(0);
    for (int idx = tid; idx < 1280; idx += NTHREADS) {
        const int j = idx >> 8, cc = idx & 255, ch = (cc >= 128 ? 512 : 0) + h * 128 + (cc & 127);
        cwl[idx] = j < 4 ? p.ml_conv_w[j * 1024 + ch] : p.ml_conv_b[ch];
    }
    if (wave == 0) {
        const float l0 = LF[(size_t)(t0 + 2 * lane) * 4 + h], l1 = LF[(size_t)(t0 + 2 * lane + 1) * 4 + h];
        const float i0 = IG[(size_t)(t0 + 2 * lane) * 4 + h], i1 = IG[(size_t)(t0 + 2 * lane + 1) * 4 + h];
        float s = l0 + l1;
#pragma unroll
        for (int off = 1; off < 64; off <<= 1) { const float tt = __shfl_up(s, off); if (lane >= off) s += tt; }
        const float b1 = s, b0 = s - l1, bend = __shfl(s, 63);
        const float g0 = bend - b0 + i0, g1 = bend - b1 + i1;
        const float gmax = wave_max(fmaxf(g0, g1));
        wsv[2 * lane] = __expf(g0 - gmax); wsv[2 * lane + 1] = __expf(g1 - gmax);
        if (lane == 0) { ((float*)(p.ws + WS_BEND))[bh * 64 + c] = bend; ((float*)(p.ws + WS_GMAX))[bh * 64 + c] = gmax; }
    }
    __syncthreads();
#pragma unroll
    for (int gi4 = 0; gi4 < 4; ++gi4) {
        const int gi = gi4 & 1;
        if (gi4 == 2) CONV_LOAD(1);
        const int g = wave + 8 * gi4; const bool isk = gi4 >= 2; const int cgp = (g & 15) * 8;
        const int cc0 = (isk ? 128 : 0) + cgp;
        const int s = 2 * lane;
        float y0[8], y1[8];
        {
            const f32x4 cb0 = *(const LAS f32x4*)(cwl + 1024 + cc0), cb1 = *(const LAS f32x4*)(cwl + 1024 + cc0 + 4);
#pragma unroll
            for (int e = 0; e < 8; ++e) { y0[e] = e < 4 ? cb0[e & 3] : cb1[e & 3]; y1[e] = y0[e]; }
#pragma unroll
            for (int j = 0; j < 5; ++j) {
                float xr[8];
#pragma unroll
                for (int q = 0; q < 4; ++q) { xr[2 * q] = bflo(xw[gi][j][q]); xr[2 * q + 1] = bfhi(xw[gi][j][q]); }
                if (j < 4) {
                    const f32x4 w0 = *(const LAS f32x4*)(cwl + j * 256 + cc0), w1 = *(const LAS f32x4*)(cwl + j * 256 + cc0 + 4);
#pragma unroll
                    for (int e = 0; e < 8; ++e) y0[e] += (e < 4 ? w0[e & 3] : w1[e & 3]) * xr[e];
                }
                if (j > 0) {
                    const f32x4 w0 = *(const LAS f32x4*)(cwl + (j - 1) * 256 + cc0), w1 = *(const LAS f32x4*)(cwl + (j - 1) * 256 + cc0 + 4);
#pragma unroll
                    for (int e = 0; e < 8; ++e) y1[e] += (e < 4 ? w0[e & 3] : w1[e & 3]) * xr[e];
                }
            }
        }
        const float sc = isk ? 0.08838834764831845f : 1.f;
#pragma unroll
        for (int e = 0; e < 8; ++e) { y0[e] = y0[e] * sigmoid_(y0[e]) * sc; y1[e] = y1[e] * sigmoid_(y1[e]) * sc; }
        bf16_t* dst = (isk ? KC : QC) + (size_t)(t0 + s) * 512 + h * 128 + cgp;
        u32x4 w; w.x = cvt_pk_bf16(y0[0], y0[1]); w.y = cvt_pk_bf16(y0[2], y0[3]); w.z = cvt_pk_bf16(y0[4], y0[5]); w.w = cvt_pk_bf16(y0[6], y0[7]);
        *(u32x4*)dst = w;
        w.x = cvt_pk_bf16(y1[0], y1[1]); w.y = cvt_pk_bf16(y1[2], y1[3]); w.z = cvt_pk_bf16(y1[4], y1[5]); w.w = cvt_pk_bf16(y1[6], y1[7]);
        *(u32x4*)(dst + 512) = w;
        if (isk) {
            const float w0 = wsv[s], w1 = wsv[s + 1];
#pragma unroll
            for (int e = 0; e < 8; ++e) *(LAS unsigned*)(KT + (cgp + e) * 272 + lane * 4) = cvt_pk_bf16(y0[e] * w0, y1[e] * w1);
        }
    }
    stage_T<4>(P + p_off<3072, 4, 256>(t0, h, 0), 256, VT, wave, lane);
    for (int i = tid; i < 1024; i += NTHREADS) { const int r = i >> 6, w = i & 63; *(LAS unsigned*)(VT + (256 + r) * 272 + w * 4) = 0x3F803F80u; }
    __syncthreads();
    bf16x8 af[4];
#pragma unroll
    for (int kk = 0; kk < 4; ++kk) af[kk] = ld_frag_lds(KT + (16 * wave + fr) * 272 + (32 * kk + 8 * fq) * 2);
    float* ST = (float*)(p.ws + WS_ST) + ((size_t)(bh * 64 + c) * 272) * 128;
#pragma unroll
    for (int n = 0; n < 17; ++n) {
        f32x4 acc = {0.f, 0.f, 0.f, 0.f};
#pragma unroll
        for (int kk = 0; kk < 4; ++kk) { const bf16x8 bfr = ld_frag_lds(VT + (16 * n + fr) * 272 + (32 * kk + 8 * fq) * 2); acc = MFMA16(af[kk], bfr, acc); }
        if (n < 16 || fr == 0) __builtin_nontemporal_store(acc, (f32x4*)(ST + (size_t)(16 * n + fr) * 128 + 16 * wave + 4 * fq));
    }
}

DI void phase_scan(const Params& p) {
    const float* ST = (const float*)(p.ws + WS_ST); bf16_t* CPT = (bf16_t*)(p.ws + WS_CPT);
    const float* BEND = (const float*)(p.ws + WS_BEND); const float* GMAX = (const float*)(p.ws + WS_GMAX); float* MPREV = (float*)(p.ws + WS_MPREV);
    const int gtid = blockIdx.x * NTHREADS + threadIdx.x, nthr = gridDim.x * NTHREADS;
    constexpr int PER = 8224;
    constexpr size_t CST = 272 * 128;
    if (nthr == 16 * 8192) {
        const int bh = gtid >> 13, e4 = gtid & 8191;
        const bool extra = (gtid & 255) == 0;
        const int e42 = 8192 + ((gtid >> 8) & 31);
        const float* src = ST + (size_t)bh * 64 * CST + (size_t)e4 * 4;
        bf16_t* dst = CPT + (size_t)bh * 64 * CST + (size_t)e4 * 4;
        const float* src2 = ST + (size_t)bh * 64 * CST + (size_t)e42 * 4;
        bf16_t* dst2 = CPT + (size_t)bh * 64 * CST + (size_t)e42 * 4;
        f32x4 st = {0.f, 0.f, 0.f, 0.f}, st2 = {0.f, 0.f, 0.f, 0.f}; float m = 0.f;
        for (int c0 = 0; c0 < 64; c0 += 8) {
            f32x4 d[8], d2[8]; float be[8], gm[8];
#pragma unroll
            for (int j = 0; j < 8; ++j) { d[j] = __builtin_nontemporal_load((const f32x4*)(src + (size_t)(c0 + j) * CST)); be[j] = BEND[bh * 64 + c0 + j]; gm[j] = GMAX[bh * 64 + c0 + j]; }
#pragma unroll
            for (int j = 0; j < 8; ++j) d2[j] = extra ? __builtin_nontemporal_load((const f32x4*)(src2 + (size_t)(c0 + j) * CST)) : (f32x4){0.f, 0.f, 0.f, 0.f};
#pragma unroll
            for (int j = 0; j < 8; ++j) {
                const int c = c0 + j;
                const float mn = fmaxf(be[j] + m, gm[j]), a = __expf(be[j] + m - mn), sc = __expf(gm[j] - mn);
                u32x2 w; w.x = cvt_pk_bf16(st[0], st[1]); w.y = cvt_pk_bf16(st[2], st[3]);
                *(u32x2*)(dst + (size_t)c * CST) = w;
                if (extra) { u32x2 w2; w2.x = cvt_pk_bf16(st2[0], st2[1]); w2.y = cvt_pk_bf16(st2[2], st2[3]); *(u32x2*)(dst2 + (size_t)c * CST) = w2; }
                if (e4 == 0) MPREV[bh * 64 + c] = m;
                st = st * a + d[j] * sc; st2 = st2 * a + d2[j] * sc; m = mn;
            }
        }
        return;
    }
    for (int item = gtid; item < 16 * PER; item += nthr) {
        const int bh = item / PER, e4 = item - bh * PER;
        const float* src = ST + (size_t)bh * 64 * CST + (size_t)e4 * 4;
        bf16_t* dst = CPT + (size_t)bh * 64 * CST + (size_t)e4 * 4;
        f32x4 st = {0.f, 0.f, 0.f, 0.f}; float m = 0.f;
        for (int c0 = 0; c0 < 64; c0 += 8) {
            f32x4 d[8]; float be[8], gm[8];
#pragma unroll
            for (int j = 0; j < 8; ++j) { d[j] = __builtin_nontemporal_load((const f32x4*)(src + (size_t)(c0 + j) * CST)); be[j] = BEND[bh * 64 + c0 + j]; gm[j] = GMAX[bh * 64 + c0 + j]; }
#pragma unroll
            for (int j = 0; j < 8; ++j) {
                const int c = c0 + j;
                const float mn = fmaxf(be[j] + m, gm[j]), a = __expf(be[j] + m - mn), sc = __expf(gm[j] - mn);
                u32x2 w; w.x = cvt_pk_bf16(st[0], st[1]); w.y = cvt_pk_bf16(st[2], st[3]);
                *(u32x2*)(dst + (size_t)c * CST) = w;
                if (e4 == 0) MPREV[bh * 64 + c] = m;
                st = st * a + d[j] * sc; m = mn;
            }
        }
    }
}

DI void mlstm_out(const Params& p, LAS unsigned char* lds, int b, int c, int h) {
    const int tid = threadIdx.x, lane = tid & 63, wave = __builtin_amdgcn_readfirstlane(tid >> 6), fr = lane & 15, fq = lane >> 4;
    const int bh = b * 4 + h, t0 = b * 8192 + c * 128;
    LAS unsigned char* Kl = lds; LAS unsigned char* Sl = lds + 34816; LAS unsigned char* VTe = lds + 69632;
    LAS float* av = (LAS float*)(lds + 143616); LAS float* Mv = (LAS float*)(lds + 144128); LAS float* bv = (LAS float*)(lds + 144640);
    const bf16_t* P = (const bf16_t*)(p.ws + WS_P); bf16_t* YM = (bf16_t*)(p.ws + WS_XN);
    const bf16_t* QC = (const bf16_t*)(p.ws + WS_QC); const bf16_t* KC = (const bf16_t*)(p.ws + WS_KC);
    const float* IG = (const float*)(p.ws + WS_IG); const float* LF = (const float*)(p.ws + WS_LF);
    const float mprev = ((const float*)(p.ws + WS_MPREV))[bh * 64 + c];
    __syncthreads();
    if (wave == 0) {
        const float l0 = LF[(size_t)(t0 + 2 * lane) * 4 + h], l1 = LF[(size_t)(t0 + 2 * lane + 1) * 4 + h];
        const float i0 = IG[(size_t)(t0 + 2 * lane) * 4 + h], i1 = IG[(size_t)(t0 + 2 * lane + 1) * 4 + h];
        float s = l0 + l1;
#pragma unroll
        for (int off = 1; off < 64; off <<= 1) { const float tt = __shfl_up(s, off); if (lane >= off) s += tt; }
        const float b1 = s, b0 = s - l1;
        const float a0 = i0 - b0, a1 = i1 - b1;
        float pm = fmaxf(a0, a1);
#pragma unroll
        for (int off = 1; off < 64; off <<= 1) { const float tt = __shfl_up(pm, off); if (lane >= off) pm = fmaxf(pm, tt); }
        float ex = __shfl_up(pm, 1); if (lane == 0) ex = -3.0e38f;
        Mv[2 * lane] = fmaxf(mprev, fmaxf(ex, a0)); Mv[2 * lane + 1] = fmaxf(mprev, pm);
        av[2 * lane] = a0; av[2 * lane + 1] = a1; bv[2 * lane] = b0; bv[2 * lane + 1] = b1;
    }
#pragma unroll
    for (int it = 0; it < 4; ++it) {
        const int e = (it * NTHREADS + tid) * 8, s = e >> 7, d0 = e & 127;
        *(LAS u32x4*)(Kl + s * 272 + d0 * 2) = *(const u32x4*)(KC + (size_t)(t0 + s) * 512 + h * 128 + d0);
    }
    stage_T<4>(P + p_off<3072, 4, 256>(t0, h, 0), 256, VTe, wave, lane);
    for (int i = tid; i < 1024; i += NTHREADS) { const int r = i >> 6, w = i & 63; *(LAS unsigned*)(VTe + (256 + r) * 272 + w * 4) = 0x3F803F80u; }
    bf16x8 qf[4];
#pragma unroll
    for (int kk = 0; kk < 4; ++kk) qf[kk] = *(const bf16x8*)(QC + (size_t)(t0 + 16 * wave + fr) * 512 + h * 128 + 32 * kk + 8 * fq);
    __syncthreads();
    const int t = 16 * wave + fr; const float Mt = Mv[t];
    const int stmax = wave | 1;
    for (int st = 0; st <= stmax; ++st) {
        f32x4 s4 = {0.f, 0.f, 0.f, 0.f};
#pragma unroll
        for (int kk = 0; kk < 4; ++kk) { const bf16x8 kf = ld_frag_lds(Kl + (16 * st + fr) * 272 + (32 * kk + 8 * fq) * 2); s4 = MFMA16(kf, qf[kk], s4); }
#pragma unroll
        for (int r = 0; r < 4; ++r) { const int s = 16 * st + 4 * fq + r; const float w = (s <= t) ? __expf(av[s] - Mt) : 0.f; s4[r] *= w; }
        u32x2 w; w.x = cvt_pk_bf16(s4[0], s4[1]); w.y = cvt_pk_bf16(s4[2], s4[3]);
        *(LAS u32x2*)(Sl + t * 272 + (16 * st + 4 * fq) * 2) = w;
    }
    __syncthreads();
    const bf16_t* cpt = (const bf16_t*)(p.ws + WS_CPT) + ((size_t)(bh * 64 + c) * 272) * 128;
    f32x4 acc[17];
#pragma unroll
    for (int n = 0; n < 17; ++n) acc[n] = (f32x4){0.f, 0.f, 0.f, 0.f};
#pragma unroll
    for (int half = 0; half < 2; ++half) {
        if (half) __syncthreads();
#pragma unroll 1
        for (int it = 0; it < 4; it += 2) {
            const int e = (it * NTHREADS + tid) * 8, r = e >> 7, d0 = e & 127;
            const u32x4 c0_ = *(const u32x4*)(cpt + (size_t)(128 * half + r) * 128 + d0), c1_ = *(const u32x4*)(cpt + (size_t)(128 * half + r + 32) * 128 + d0);
            *(LAS u32x4*)(Kl + (r + 32) * 272 + d0 * 2) = c1_;
            *(LAS u32x4*)(Kl + r * 272 + d0 * 2) = c0_;
        }
        __syncthreads();
#pragma unroll
        for (int n8 = 0; n8 < 8; ++n8) {
#pragma unroll
            for (int kk = 0; kk < 4; ++kk) { const bf16x8 cf = ld_frag_lds(Kl + (16 * n8 + fr) * 272 + (32 * kk + 8 * fq) * 2); acc[8 * half + n8] = MFMA16(cf, qf[kk], acc[8 * half + n8]); }
        }
    }
#pragma unroll
    for (int kk = 0; kk < 4; ++kk) { const bf16x8 cf = *(const bf16x8*)(cpt + (size_t)(256 + fr) * 128 + 32 * kk + 8 * fq); acc[16] = MFMA16(cf, qf[kk], acc[16]); }
    const float ai = __expf(mprev - Mt);
#pragma unroll
    for (int n = 0; n < 17; ++n) acc[n] = acc[n] * ai;
    const int k2max = (16 * wave + 15) >> 5;
#pragma unroll
    for (int kk = 0; kk < 4; ++kk) {
        if (kk <= k2max) {
            const bf16x8 sf = ld_frag_lds(Sl + t * 272 + (32 * kk + 8 * fq) * 2);
#pragma unroll
            for (int n = 0; n < 17; ++n) { const bf16x8 vf = ld_frag_lds(VTe + (16 * n + fr) * 272 + (32 * kk + 8 * fq) * 2); acc[n] = MFMA16(vf, sf, acc[n]); }
        }
    }
    const float den = __shfl(acc[16][0], fr);
    const float mt = bv[t] + Mt;
    const float inv = rcpf_(fmaxf(fabsf(den), __expf(-mt)));
    const size_t grow = (size_t)(t0 + t);
    float ss = 0.f;
#pragma unroll
    for (int n = 0; n < 16; ++n) {
        const int v0 = 16 * n + 4 * fq;
        const u32x2 ow = *(const u32x2*)(P + p_off<4096, 4, 256>(t0 + t, h, v0));
        f32x4 y;
        y[0] = bflo(ow.x) * acc[n][0] * inv; y[1] = bfhi(ow.x) * acc[n][1] * inv; y[2] = bflo(ow.y) * acc[n][2] * inv; y[3] = bfhi(ow.y) * acc[n][3] * inv;
        ss += (y[0] * y[0] + y[1] * y[1]) + (y[2] * y[2] + y[3] * y[3]);
        acc[n] = y;
    }
    ss += __shfl_xor(ss, 16); ss += __shfl_xor(ss, 32);
    const float rstd = rsqrtf(ss * (1.f / 256.f) + EPS);
#pragma unroll
    for (int n = 0; n < 16; ++n) {
        const int v0 = 16 * n + 4 * fq;
        const f32x4 g = *(const f32x4*)(p.ml_out_g + h * 256 + v0);
        const f32x4 o = acc[n] * rstd * g;
        u32x2 w; w.x = cvt_pk_bf16(o[0], o[1]); w.y = cvt_pk_bf16(o[2], o[3]);
        *(u32x2*)(YM + grow * DM + 1024 + h * 256 + v0) = w;
    }
}

DI unsigned ord_key(float f) { const unsigned u = __float_as_uint(f); return (u & 0x80000000u) ? ~u : (u | 0x80000000u); }
DI float key_val(unsigned k) { return (k & 0x80000000u) ? __uint_as_float(k & 0x7fffffffu) : __uint_as_float(~k); }
DI unsigned umax_(unsigned a, unsigned b) { return a > b ? a : b; }
DI unsigned umin_(unsigned a, unsigned b) { return a < b ? a : b; }
#define DPPU(v, ctrl) ((unsigned)__builtin_amdgcn_update_dpp(0, (int)(v), (ctrl), 0xF, 0xF, true))
DI unsigned row_max_u32(unsigned v) {
    v = umax_(v, DPPU(v, 0xB1)); v = umax_(v, DPPU(v, 0x4E)); v = umax_(v, DPPU(v, 0x141)); v = umax_(v, DPPU(v, 0x140)); return v;
}
DI float row_sum_f32(float v) {
    v += __uint_as_float(DPPU(__float_as_uint(v), 0xB1)); v += __uint_as_float(DPPU(__float_as_uint(v), 0x4E));
    v += __uint_as_float(DPPU(__float_as_uint(v), 0x141)); v += __uint_as_float(DPPU(__float_as_uint(v), 0x140)); return v;
}
#define CEX(a, b) do { const unsigned mx_ = umax_(a, b), mn_ = umin_(a, b); a = mx_; b = mn_; } while (0)
template <int N> DI unsigned top16_row(unsigned (&s)[N], int c) {
    unsigned list = 0u;
#pragma unroll 1
    for (int it = 0; it < 16; ++it) {
        const unsigned wm = row_max_u32(s[0]);
        const bool win = (s[0] == wm);
#pragma unroll
        for (int i = 0; i < N - 1; ++i) s[i] = win ? s[i + 1] : s[i];
        s[N - 1] = win ? 0u : s[N - 1];
        list = (c == it) ? wm : list;
    }
    return list;
}

template <int N> DI void top16_row2(unsigned (&s)[N], unsigned (&t)[N], int c, unsigned& l1, unsigned& l2) {
    l1 = 0u; l2 = 0u;
#pragma unroll 1
    for (int it = 0; it < 16; ++it) {
        const unsigned wm1 = row_max_u32(s[0]), wm2 = row_max_u32(t[0]);
        const bool win1 = (s[0] == wm1), win2 = (t[0] == wm2);
#pragma unroll
        for (int i = 0; i < N - 1; ++i) { s[i] = win1 ? s[i + 1] : s[i]; t[i] = win2 ? t[i + 1] : t[i]; }
        s[N - 1] = win1 ? 0u : s[N - 1]; t[N - 1] = win2 ? 0u : t[N - 1];
        l1 = (c == it) ? wm1 : l1; l2 = (c == it) ? wm2 : l2;
    }
}

template <int N> DI void top16_row4(unsigned (&s)[N], unsigned (&t)[N], unsigned (&u)[N], unsigned (&v)[N], int c, unsigned& l1, unsigned& l2, unsigned& l3, unsigned& l4) {
    l1 = 0u; l2 = 0u; l3 = 0u; l4 = 0u;
#pragma unroll 1
    for (int it = 0; it < 16; ++it) {
        const unsigned wm1 = row_max_u32(s[0]), wm2 = row_max_u32(t[0]), wm3 = row_max_u32(u[0]), wm4 = row_max_u32(v[0]);
        const bool win1 = (s[0] == wm1), win2 = (t[0] == wm2), win3 = (u[0] == wm3), win4 = (v[0] == wm4);
#pragma unroll
        for (int i = 0; i < N - 1; ++i) { s[i] = win1 ? s[i + 1] : s[i]; t[i] = win2 ? t[i + 1] : t[i]; u[i] = win3 ? u[i + 1] : u[i]; v[i] = win4 ? v[i + 1] : v[i]; }
        s[N - 1] = win1 ? 0u : s[N - 1]; t[N - 1] = win2 ? 0u : t[N - 1]; u[N - 1] = win3 ? 0u : u[N - 1]; v[N - 1] = win4 ? 0u : v[N - 1];
        l1 = (c == it) ? wm1 : l1; l2 = (c == it) ? wm2 : l2; l3 = (c == it) ? wm3 : l3; l4 = (c == it) ? wm4 : l4;
    }
}
#define SORT8(s) do { CEX(s[0], s[1]); CEX(s[2], s[3]); CEX(s[4], s[5]); CEX(s[6], s[7]); CEX(s[0], s[2]); CEX(s[1], s[3]); CEX(s[4], s[6]); CEX(s[5], s[7]); CEX(s[1], s[2]); CEX(s[5], s[6]); \
    CEX(s[0], s[4]); CEX(s[1], s[5]); CEX(s[2], s[6]); CEX(s[3], s[7]); CEX(s[2], s[4]); CEX(s[3], s[5]); CEX(s[1], s[2]); CEX(s[3], s[4]); CEX(s[5], s[6]); } while (0)
#define SORT4(s) do { CEX(s[0], s[1]); CEX(s[2], s[3]); CEX(s[0], s[2]); CEX(s[1], s[3]); CEX(s[1], s[2]); } while (0)

DI void peer_select(const Params& p, LAS unsigned char* lds) {
    const int tid = threadIdx.x, lane = tid & 63, wave = __builtin_amdgcn_readfirstlane(tid >> 6), c = lane & 15, g = lane >> 4, rowbase = lane & 48;
    const bf16_t* Q = (const bf16_t*)(p.ws + WS_Q); const bf16_t* KB1 = (const bf16_t*)(p.ws + WS_KB1); const bf16_t* KB2 = (const bf16_t*)(p.ws + WS_KB2);
    int* SELID = (int*)(p.ws + WS_SELID); float* SELG = (float*)(p.ws + WS_SELG);
    unsigned pk = 0u, validmask = 0u;
#pragma unroll
    for (int q = 0; q < 4; ++q) {
        const int target = 4 * c + q; int ci = 0, cj = 0, cnt = 0; bool v = false;
#pragma unroll
        for (int i = 0; i < 16; ++i) { const int nj = 16 / (i + 1); if (target >= cnt && target < cnt + nj) { ci = i; cj = target - cnt; v = true; } cnt += nj; }
        pk |= (unsigned)((ci << 4) | cj) << (8 * q); validmask |= (v ? 1u : 0u) << q;
    }
    for (int tile = blockIdx.x * 8 + wave; tile < T_TOK / 16; tile += gridDim.x * 8) {
        const int tok0 = tile * 16;
        for (int h = 0; h < 8; ++h) {
            __syncthreads();
            int tl = tid; asm volatile("" : "+v"(tl));
#pragma unroll 1
            for (int it = 0; it < 4; ++it) {
                const int idx = it * NTHREADS + tl, which = idx >> 10, r = (idx & 1023) >> 3, q = idx & 7;
                *(LAS u32x4*)(lds + which * 18432 + r * 144 + q * 16) = *(const u32x4*)((which ? KB2 : KB1) + ((size_t)(h * 128 + r)) * 64 + q * 8);
            }
            bf16x8 a1[2], a2[2];
            {
                const bf16_t* qp = Q + (size_t)(tok0 + c) * 1024 + h * 128 + g * 8;
                a1[0] = *(const bf16x8*)qp; a1[1] = *(const bf16x8*)(qp + 32); a2[0] = *(const bf16x8*)(qp + 64); a2[1] = *(const bf16x8*)(qp + 96);
            }
            __syncthreads();
            f32x4 acc1[8], acc2[8];
#pragma unroll
            for (int nt = 0; nt < 8; ++nt) {
                const LAS unsigned char* kp = lds + (nt * 16 + c) * 144 + g * 16;
                acc1[nt] = (f32x4){0.f, 0.f, 0.f, 0.f}; acc2[nt] = (f32x4){0.f, 0.f, 0.f, 0.f};
                acc1[nt] = MFMA16(a1[0], ld_frag_lds(kp), acc1[nt]); acc1[nt] = MFMA16(a1[1], ld_frag_lds(kp + 64), acc1[nt]);
                acc2[nt] = MFMA16(a2[0], ld_frag_lds(kp + 18432), acc2[nt]); acc2[nt] = MFMA16(a2[1], ld_frag_lds(kp + 18432 + 64), acc2[nt]);
            }
#pragma unroll
            for (int rp = 0; rp < 2; ++rp) {
                const int r0 = 2 * rp, r1 = 2 * rp + 1;
                unsigned sA[8], sB[8], sC[8], sD[8];
#pragma unroll
                for (int nt = 0; nt < 8; ++nt) {
                    const unsigned ix = (unsigned)(127 - (nt * 16 + c));
                    sA[nt] = (ord_key(acc1[nt][r0]) & ~0x7Fu) | ix; sB[nt] = (ord_key(acc2[nt][r0]) & ~0x7Fu) | ix;
                    sC[nt] = (ord_key(acc1[nt][r1]) & ~0x7Fu) | ix; sD[nt] = (ord_key(acc2[nt][r1]) & ~0x7Fu) | ix;
                }
                SORT8(sA); SORT8(sB); SORT8(sC); SORT8(sD);
                unsigned lA, lB, lC, lD;
                top16_row4<8>(sA, sB, sC, sD, c, lA, lB, lC, lD);
                unsigned c0[4], c1[4];
#pragma unroll
                for (int q = 0; q < 4; ++q) {
                    const int ci = (int)((pk >> (8 * q + 4)) & 15u), cj = (int)((pk >> (8 * q)) & 15u);
                    const unsigned ka = (unsigned)__shfl((int)lA, rowbase + ci), kb = (unsigned)__shfl((int)lB, rowbase + cj);
                    const unsigned kc = (unsigned)__shfl((int)lC, rowbase + ci), kd = (unsigned)__shfl((int)lD, rowbase + cj);
                    const float cand0 = key_val(ka & ~0x7Fu) + key_val(kb & ~0x7Fu), cand1 = key_val(kc & ~0x7Fu) + key_val(kd & ~0x7Fu);
                    const bool ok = ((validmask >> q) & 1u) != 0u; const unsigned ix = (unsigned)(63 - (4 * c + q));
                    c0[q] = ok ? ((ord_key(cand0) & ~0x3Fu) | ix) : 0u; c1[q] = ok ? ((ord_key(cand1) & ~0x3Fu) | ix) : 0u;
                }
                SORT4(c0); SORT4(c1);
                unsigned sel0, sel1;
                top16_row2<4>(c0, c1, c, sel0, sel1);
#pragma unroll
                for (int u = 0; u < 2; ++u) {
                    const unsigned sel = u ? sel1 : sel0, list1 = u ? lC : lA, list2 = u ? lD : lB; const int r = u ? r1 : r0;
                    const int slot = 63 - (int)(sel & 63u);
                    const unsigned pkv = (unsigned)__shfl((int)pk, rowbase + (slot >> 2));
                    const int cij = (int)((pkv >> (8 * (slot & 3))) & 0xFFu);
                    const unsigned e1 = (unsigned)__shfl((int)list1, rowbase + (cij >> 4)), e2 = (unsigned)__shfl((int)list2, rowbase + (cij & 15));
                    const int eid = (127 - (int)(e1 & 127u)) * 128 + (127 - (int)(e2 & 127u));
                    const float sv = key_val(sel & ~0x3Fu), mx = key_val(row_max_u32(sel) & ~0x3Fu);
                    const float ev = __expf(sv - mx);
                    const float sum = row_sum_f32(ev);
                    const size_t o = (size_t)(tok0 + 4 * g + r) * 128 + h * 16 + c;
                    SELID[o] = eid; SELG[o] = ev * rcpf_(sum);
                }
            }
        }
    }
}

DI f32x2 pkfma(f32x2 a, f32x2 b, f32x2 c) { return __builtin_elementwise_fma(a, b, c); }
DI void peer_gather(const Params& p, LAS unsigned char* lds) {
    const int tid = threadIdx.x, lane = tid & 63, wave = __builtin_amdgcn_readfirstlane(tid >> 6);
    LAS float* scr = (LAS float*)lds + wave * (16 * 68);
    LAS float* cfl = (LAS float*)(lds + 8 * 16 * 68 * 4) + wave * 128;
    const unsigned char* Ub = p.ws + WS_UB; const unsigned char* Vb = p.ws + WS_VB;
    const float* PSS2 = (const float*)(p.ws + WS_PSS2);
    const int* SELID = (const int*)(p.ws + WS_SELID); const float* SELG = (const float*)(p.ws + WS_SELG);
    const int gw = blockIdx.x * 8 + wave, nw = gridDim.x * 8;
    for (int t = gw; t < T_TOK; t += nw) {
        const int idA = SELID[(size_t)t * 128 + lane], idB = SELID[(size_t)t * 128 + 64 + lane];
        const float gA = SELG[(size_t)t * 128 + lane], gB = SELG[(size_t)t * 128 + 64 + lane];
        const bf16_t* xrow = (const bf16_t*)(p.ws + WS_X1G) + (size_t)t * DM + lane * 32;
        float* orow = p.out + (size_t)t * DM + lane * 32;
        const float pv = lane < 32 ? PSS2[(size_t)t * 32 + lane] : 0.f;
        const float rstd2 = rsqrtf(wave_sum(pv) * (1.f / 2048.f) + EPS);
        f32x2 h2[16];
#pragma unroll
        for (int q = 0; q < 4; ++q) {
            const u32x4 xw = *(const u32x4*)(xrow + q * 8);
            const f32x4 g0 = *(const f32x4*)(p.norm2_g + lane * 32 + q * 8), g1 = *(const f32x4*)(p.norm2_g + lane * 32 + q * 8 + 4);
            h2[4 * q] = (f32x2){bflo(xw.x) * rstd2 * g0[0], bfhi(xw.x) * rstd2 * g0[1]};
            h2[4 * q + 1] = (f32x2){bflo(xw.y) * rstd2 * g0[2], bfhi(xw.y) * rstd2 * g0[3]};
            h2[4 * q + 2] = (f32x2){bflo(xw.z) * rstd2 * g1[0], bfhi(xw.z) * rstd2 * g1[1]};
            h2[4 * q + 3] = (f32x2){bflo(xw.w) * rstd2 * g1[2], bfhi(xw.w) * rstd2 * g1[3]};
        }
        constexpr int NPK = 8;
        u32x4 buf[2][NPK]; unsigned short bsc[2][NPK];
#define PEER_LOAD(TB, st, base) do { const int idv_ = ((base) < 64) ? idA : idB; _Pragma("unroll") for (int e_ = 0; e_ < NPK; ++e_) { \
            const int id_ = __builtin_amdgcn_readlane(idv_, ((base) + e_) & 63); const unsigned char* r_ = (TB) + (size_t)id_ * 1088; \
            buf[st][e_] = *(const u32x4*)(r_ + lane * 16); bsc[st][e_] = *(const unsigned short*)(r_ + 1024 + (lane >> 1) * 2); } } while (0)
#define PEER_DOT(st, slot0) do { _Pragma("unroll") for (int e_ = 0; e_ < NPK; ++e_) { f32x2 a2_ = {0.f, 0.f}; \
            _Pragma("unroll") for (int d_ = 0; d_ < 4; ++d_) { const unsigned w_ = buf[st][e_][d_]; \
                a2_ = pkfma(h2[d_ * 4 + 0], __builtin_amdgcn_cvt_scalef32_pk_f32_fp4(w_, 1.0f, 0), a2_); a2_ = pkfma(h2[d_ * 4 + 1], __builtin_amdgcn_cvt_scalef32_pk_f32_fp4(w_, 1.0f, 1), a2_); \
                a2_ = pkfma(h2[d_ * 4 + 2], __builtin_amdgcn_cvt_scalef32_pk_f32_fp4(w_, 1.0f, 2), a2_); a2_ = pkfma(h2[d_ * 4 + 3], __builtin_amdgcn_cvt_scalef32_pk_f32_fp4(w_, 1.0f, 3), a2_); } \
            scr[((slot0) + e_) * 68 + lane] = (a2_[0] + a2_[1]) * bf2f(bsc[st][e_]); } } while (0)
        PEER_LOAD(Ub, 0, 0);
        for (int b = 0; b < 128 / NPK; b += 2) {
            PEER_LOAD(Ub, 1, (b + 1) * NPK);
            PEER_DOT(0, (b * NPK) & 15);
            if (b + 2 < 128 / NPK) PEER_LOAD(Ub, 0, (b + 2) * NPK);
            PEER_DOT(1, ((b + 1) * NPK) & 15);
            if ((((b + 2) * NPK) & 15) == 0) {
                WAVE_LDS_SYNC();
                float sum = 0.f;
#pragma unroll
                for (int i = 0; i < 4; ++i) { const f32x4 r = *(const LAS f32x4*)(scr + (lane >> 2) * 68 + (lane & 3) * 16 + 4 * i); sum += (r[0] + r[1]) + (r[2] + r[3]); }
                sum += __shfl_xor(sum, 1); sum += __shfl_xor(sum, 2);
                const int k0 = (b + 2) * NPK - 16;
                const int k = k0 + (lane >> 2);
                const float gate = __shfl((k0 < 64) ? gA : gB, k & 63);
                if ((lane & 3) == 0) cfl[k] = gate * gelu_t(sum);
                WAVE_LDS_SYNC();
            }
        }
        f32x2 acc[16];
#pragma unroll
        for (int i = 0; i < 16; ++i) acc[i] = (f32x2){0.f, 0.f};
#define PEER_AXPY(st, base) do { _Pragma("unroll") for (int e_ = 0; e_ < NPK; ++e_) { const float c_ = cfl[(base) + e_] * bf2f(bsc[st][e_]); const f32x2 c2_ = {c_, c_}; \
            _Pragma("unroll") for (int d_ = 0; d_ < 4; ++d_) { const unsigned w_ = buf[st][e_][d_]; \
                acc[d_ * 4 + 0] = pkfma(c2_, __builtin_amdgcn_cvt_scalef32_pk_f32_fp4(w_, 1.0f, 0), acc[d_ * 4 + 0]); acc[d_ * 4 + 1] = pkfma(c2_, __builtin_amdgcn_cvt_scalef32_pk_f32_fp4(w_, 1.0f, 1), acc[d_ * 4 + 1]); \
                acc[d_ * 4 + 2] = pkfma(c2_, __builtin_amdgcn_cvt_scalef32_pk_f32_fp4(w_, 1.0f, 2), acc[d_ * 4 + 2]); acc[d_ * 4 + 3] = pkfma(c2_, __builtin_amdgcn_cvt_scalef32_pk_f32_fp4(w_, 1.0f, 3), acc[d_ * 4 + 3]); } } } while (0)
        PEER_LOAD(Vb, 0, 0);
        for (int b = 0; b < 128 / NPK; b += 2) {
            PEER_LOAD(Vb, 1, (b + 1) * NPK);
            PEER_AXPY(0, b * NPK);
            if (b + 2 < 128 / NPK) PEER_LOAD(Vb, 0, (b + 2) * NPK);
            PEER_AXPY(1, (b + 1) * NPK);
        }
        float ss = 0.f;
#pragma unroll
        for (int q = 0; q < 4; ++q) {
            const u32x4 xw = *(const u32x4*)(xrow + q * 8);
            acc[4 * q] += (f32x2){bflo(xw.x), bfhi(xw.x)}; acc[4 * q + 1] += (f32x2){bflo(xw.y), bfhi(xw.y)};
            acc[4 * q + 2] += (f32x2){bflo(xw.z), bfhi(xw.z)}; acc[4 * q + 3] += (f32x2){bflo(xw.w), bfhi(xw.w)};
#pragma unroll
            for (int i = 0; i < 4; ++i) { const f32x2 a = acc[4 * q + i]; ss += a[0] * a[0] + a[1] * a[1]; }
        }
        const float rstd = rsqrtf(wave_sum(ss) * (1.f / 2048.f) + EPS);
#pragma unroll
        for (int q = 0; q < 8; ++q) {
            const f32x4 g0 = *(const f32x4*)(p.final_g + lane * 32 + q * 4);
            const f32x2 a = acc[2 * q], b = acc[2 * q + 1];
            const f32x4 o0 = {a[0] * rstd * g0[0], a[1] * rstd * g0[1], b[0] * rstd * g0[2], b[1] * rstd * g0[3]};
            *(f32x4*)(orow + q * 4) = o0;
        }
        WAVE_LDS_SYNC();
    }
}

#define XB_TMO      128
#define XB_XCNT(j)  (256  + 64 * (j))
#define XB_XSUB(j)  (1280 + 64 * (j))
#define XB_XGEN(j)  (2304 + 64 * (j))
#define XB_TOP      3328
#define XB_TOPGEN   3392
#define XCD_BAR_WORDS 3456
#define XB_SPIN_CAP (1u << 18)

__device__ __forceinline__ unsigned xb_ld(unsigned* p)              { return __hip_atomic_load(p, __ATOMIC_RELAXED, __HIP_MEMORY_SCOPE_AGENT); }
__device__ __forceinline__ unsigned xb_add(unsigned* p, unsigned v) { return __hip_atomic_fetch_add(p, v, __ATOMIC_RELAXED, __HIP_MEMORY_SCOPE_AGENT); }
__device__ __forceinline__ unsigned xb_xcc_id() { return (unsigned)__builtin_amdgcn_s_getreg((3 << 11) | 20) & 0xFu; }
#define XB_SPIN(cond, bar) do { unsigned _sp = 0; while (cond) { __builtin_amdgcn_s_sleep(1); \
    if ((++_sp & 255u) == 0u) { if (xb_ld(&(bar)[XB_TMO])) break; if (_sp > XB_SPIN_CAP) { atomicAdd(&(bar)[XB_TMO], 1u); break; } } } } while (0)

struct XcdBarrier {
    unsigned* bar; unsigned x;
    volatile LAS unsigned* st;
};

__device__ __forceinline__ XcdBarrier xcd_barrier_post(unsigned* bar, volatile LAS unsigned* st) {
    XcdBarrier b; b.bar = bar; b.x = xb_xcc_id(); b.st = st;
    if (threadIdx.x == 0) (void)xb_add(&bar[XB_XCNT(b.x)], 1u);
    return b;
}
__device__ __forceinline__ void xcd_barrier_complete(unsigned* bar, unsigned x, unsigned& nloc, unsigned& nx) {
    const unsigned G = gridDim.x * gridDim.y * gridDim.z;
    unsigned sum, cnt, mine, sp = 0u;
    for (;;) {
        sum = 0u; cnt = 0u; mine = 0u;
#pragma unroll
        for (unsigned j = 0; j < 16; ++j) { const unsigned c = xb_ld(&bar[XB_XCNT(j)]); sum += c; cnt += (c > 0u) ? 1u : 0u; mine = (j == x) ? c : mine; }
        if (sum == G) break;
        __builtin_amdgcn_s_sleep(1);
        if ((++sp & 255u) == 0u) { if (xb_ld(&bar[XB_TMO])) break; if (sp > XB_SPIN_CAP) { atomicAdd(&bar[XB_TMO], 1u); break; } }
    }
    nloc = mine > 0u ? mine : 1u; nx = cnt > 0u ? cnt : 1u;
}

__device__ __forceinline__ void xcd_barrier(const XcdBarrier& b) {
    asm volatile("s_waitcnt vmcnt(0)" ::: "memory");
    __syncthreads();
    if (threadIdx.x == 0) {
        unsigned* bar = b.bar;
        __builtin_amdgcn_s_waitcnt(0);
        unsigned nloc = b.st[0], nx = b.st[1];
        if (nloc == 0u) { xcd_barrier_complete(bar, b.x, nloc, nx); b.st[0] = nloc; b.st[1] = nx; }
        const unsigned old = xb_add(&bar[XB_XSUB(b.x)], 1u);
        const unsigned gen = old / nloc;
        if (old + 1u == (gen + 1u) * nloc) {
            __builtin_amdgcn_fence(__ATOMIC_RELEASE, "agent");
            asm volatile("s_waitcnt vmcnt(0)" ::: "memory");
            const unsigned og = xb_add(&bar[XB_TOP], 1u);
            const unsigned tg = og / nx;
            if (og + 1u == (tg + 1u) * nx) xb_add(&bar[XB_TOPGEN], 1u);
            else XB_SPIN(xb_ld(&bar[XB_TOPGEN]) == tg, bar);
            __builtin_amdgcn_fence(__ATOMIC_ACQUIRE, "agent");
            xb_add(&bar[XB_XGEN(b.x)], 1u);
            asm volatile("s_waitcnt vmcnt(0)" ::: "memory");
        } else {
            XB_SPIN(xb_ld(&bar[XB_XGEN(b.x)]) == gen, bar);
            __builtin_amdgcn_fence(__ATOMIC_ACQUIRE, "agent");
            asm volatile("s_waitcnt vmcnt(0)" ::: "memory");
        }
    }
    __syncthreads();
}

#ifndef PROBE_DUP
#define PROBE_DUP 0
#endif
#define REP(bit) for (int rep_ = 0; rep_ < (((PROBE_DUP) >> (bit)) & 1) + 1; ++rep_)
#define PH1() { pg8::Gemm g{(const bf16_t*)(p.ws + WS_XN), (const bf16_t*)(p.ws + WS_WINT), T_TOK, NPROJ, DM}; pg8::StaticOrder S; S.init(T_TOK, NPROJ, G, bx); Epi1 E{(bf16_t*)(p.ws + WS_P), (float*)(p.ws + WS_PSSV)}; pg8::gemm_phase<Epi1, pg8::StaticOrder, true, true>(lds, g, S, E); xcd_barrier(xbar); }
#define PH3() { pg8::Gemm g{(const bf16_t*)(p.ws + WS_XN), (const bf16_t*)(p.ws + WS_WOUTT), T_TOK, DM, DM}; pg8::StaticOrder S; S.init(T_TOK, DM, G, bx); Epi2 E{p.x, (bf16_t*)(p.ws + WS_X1G), (float*)(p.ws + WS_PSS2)}; pg8::gemm_phase<Epi2, pg8::StaticOrder, true, true>(lds, g, S, E); xcd_barrier(xbar); }
#define PH4() { pg8::Gemm g{(const bf16_t*)(p.ws + WS_X1G), (const bf16_t*)(p.ws + WS_WQT), T_TOK, 1024, DM}; pg8::StaticOrder S; S.init(T_TOK, 1024, G, bx); Epi3 E{(bf16_t*)(p.ws + WS_Q), (const float*)(p.ws + WS_PSS2)}; pg8::gemm_phase<Epi3, pg8::StaticOrder, true, true>(lds, g, S, E); xcd_barrier(xbar); }
__global__ void __launch_bounds__(NTHREADS, 2) hymba_fwd(Params p) {
    extern __shared__ __attribute__((aligned(16))) unsigned char smem[];
    LAS unsigned char* lds = (LAS unsigned char*)smem;
    cg::grid_group grid = cg::this_grid();
    const int G = gridDim.x, bx = blockIdx.x;
    unsigned* barw = (unsigned*)(p.ws + WS_BAR);
    volatile LAS unsigned* xst = (volatile LAS unsigned*)(lds + LDS_BYTES - 16);
    if (threadIdx.x < 4) xst[threadIdx.x] = 0u;
    if (bx == 0) { for (int i = threadIdx.x; i < XCD_BAR_WORDS; i += NTHREADS) barw[i] = 0u; }
    __syncthreads();
    REP(0) { phase0(p, lds); grid.sync(); }
    const XcdBarrier xbar = xcd_barrier_post(barw, xst);
    PH1()
#if (PROBE_DUP >> 1) & 1
    PH1()
#endif
    REP(2) {
        for (int si = bx; si < 256; si += G) {
            const int b = si >> 6, c = si & 63;
            gmlp_bc(p, lds, b, c);
            for (int h = 0; h < 4; ++h) mlstm_local(p, lds, b, c, h);
        }
        xcd_barrier(xbar);
    }
    REP(3) { phase_scan(p); xcd_barrier(xbar); }
    REP(4) { for (int it = bx; it < 1024; it += G) mlstm_out(p, lds, it >> 8, (it >> 2) & 63, it & 3); xcd_barrier(xbar); }
    PH3()
#if (PROBE_DUP >> 5) & 1
    PH3()
#endif
    PH4()
#if (PROBE_DUP >> 6) & 1
    PH4()
#endif
    REP(7) { peer_select(p, lds); xcd_barrier(xbar); }
    peer_gather(p, lds);
}

extern "C" void kernel_launch(void* const* d_in, const int* in_sizes, int n_in, void* d_out, int out_size, void* d_ws, size_t ws_size, hipStream_t stream) {
    static int grid_blocks = 0;
    if (grid_blocks == 0) {
        if (n_in != 20 || ws_size < WS_END) { fprintf(stderr, "kernel_launch: unexpected n_in %d or ws_size %zu (need %zu)\n", n_in, ws_size, (size_t)WS_END); grid_blocks = -1; return; }
        int dev = 0, cus = 0, per_cu = 0;
        hipGetDevice(&dev);
        hipDeviceGetAttribute(&cus, hipDeviceAttributeMultiprocessorCount, dev);
        hipFuncSetAttribute((const void*)hymba_fwd, hipFuncAttributeMaxDynamicSharedMemorySize, LDS_BYTES);
        hipOccupancyMaxActiveBlocksPerMultiprocessor(&per_cu, (const void*)hymba_fwd, NTHREADS, LDS_BYTES);
        if (per_cu < 1) { fprintf(stderr, "kernel_launch: occupancy query says %d blocks per CU\n", per_cu); per_cu = 1; }
        if (per_cu > 1) per_cu = 1;
        grid_blocks = cus * per_cu;
        (void)hipGetLastError();
    }
    if (grid_blocks < 0) return;
    Params p{};
    p.x = (const float*)d_in[0]; p.norm1_g = (const float*)d_in[1]; p.w_in = (const float*)d_in[2]; p.gm_vnorm_g = (const float*)d_in[3];
    p.w_spatial = (const float*)d_in[4]; p.b_spatial = (const float*)d_in[5]; p.ml_conv_w = (const float*)d_in[6]; p.ml_conv_b = (const float*)d_in[7];
    p.ml_b_i = (const float*)d_in[8]; p.ml_b_f = (const float*)d_in[9]; p.gm_out_g = (const float*)d_in[10]; p.ml_out_g = (const float*)d_in[11];
    p.w_out = (const float*)d_in[12]; p.norm2_g = (const float*)d_in[13]; p.peer_wq = (const float*)d_in[14]; p.peer_k1 = (const float*)d_in[15];
    p.peer_k2 = (const float*)d_in[16]; p.peer_u = (const float*)d_in[17]; p.peer_v = (const float*)d_in[18]; p.final_g = (const float*)d_in[19];
    p.out = (float*)d_out; p.ws = (unsigned char*)d_ws;
    void* args[] = {&p};
    hipError_t e = hipLaunchCooperativeKernel((const void*)hymba_fwd, dim3(grid_blocks), dim3(NTHREADS), args, LDS_BYTES, stream);
    if (e != hipSuccess) fprintf(stderr, "cooperative launch failed: %s (grid %d)\n", hipGetErrorString(e), grid_blocks);
}
```

```cpp
#include <hip/hip_runtime.h>
#include <hip/hip_cooperative_groups.h>
#include <cstdio>
#include <cstdint>
namespace cg = cooperative_groups;
namespace pg8 {
#define PG8_LAS __attribute__((address_space(3)))
typedef unsigned short bf16_t;
typedef short bf16x8 __attribute__((ext_vector_type(8)));
typedef float f32x4 __attribute__((ext_vector_type(4)));
typedef unsigned u32x4 __attribute__((ext_vector_type(4)));
constexpr int BM = 256, BK = 64, HALF = 128, HTB = HALF * BK * 2  , STAGE_BYTES = 8 * HTB, NXCD = 8, WGM = 8;

__host__ __device__ __forceinline__ int lds_byte(int r, int c) { const int st = (r >> 4) * 2 + (c >> 5), rr = r & 15, cc = c & 31, ob = rr * 64 + cc * 2; return st * 1024 + (ob ^ (((ob >> 9) & 1) << 5)); }
__host__ __device__ __forceinline__ void stage_rc(int b, int& R, int& C) { const int st = b / 1024, sb = b % 1024, swz = sb ^ (((sb >> 9) & 1) << 5); R = (st >> 1) * 16 + swz / 64; C = (st & 1) * 32 + (swz % 64) / 2; }
__host__ __device__ __forceinline__ int perm32(int rho) { const int n = rho >> 4, i = rho & 15; return 8 * (i >> 2) + 4 * n + (i & 3); }

struct Unit { int pm, pn; };
struct Gemm { const bf16_t* A; const bf16_t* Bt; int M, N, K; };

struct StaticOrder {
    int nM, nN, nwg, G, c;
    __host__ __device__ void init(int M, int N, int G_, int c_) { nM = M / BM; nN = N / BM; nwg = nM * nN; G = G_; c = c_; }
    __host__ __device__ bool next(int i, Unit& u) const {
        const long L = (long)i * G + c; if (L >= nwg) return false;
        int wgid = (int)L; { const int q = nwg / NXCD, r = nwg % NXCD, xcd = wgid % NXCD, off = wgid / NXCD; wgid = (xcd < r ? xcd * (q + 1) : r * (q + 1) + (xcd - r) * q) + off; }
        const int nig = WGM * nN, gid = wgid / nig, fm = gid * WGM, gsz = (nM - fm) < WGM ? (nM - fm) : WGM;
        u.pm = fm + ((wgid % nig) % gsz); u.pn = (wgid % nig) / gsz; return true;
    }
    __device__ __forceinline__ void a_ready(const Unit&) const {}
    __device__ __forceinline__ void done(const Unit&) const {}
};
__device__ __forceinline__ unsigned cvt_pk_bf16(float lo, float hi) { unsigned r; asm volatile("v_cvt_pk_bf16_f32 %0, %1, %2" : "=v"(r) : "v"(lo), "v"(hi)); return r; }
template <class Epi, class Sched, bool ALIGN_EPI = false, bool SP2 = false>
__device__ __forceinline__ void gemm_phase(PG8_LAS unsigned char* lds, const Gemm g, const Sched& S, const Epi& E) {
    const int tid = threadIdx.x, wid = __builtin_amdgcn_readfirstlane(tid >> 6), lane = tid & 63, wr = wid >> 2, wc = wid & 3, fr = lane & 15, fq = lane >> 4;
    const int K = g.K, nt = K / BK;
    unsigned voffA[2], voffB[2];
#pragma unroll
    for (int i = 0; i < 2; ++i) { int R, C; stage_rc(tid * 16 + i * 8192, R, C); const int Rb = Epi::PERM ? ((R & ~31) + perm32(R & 31)) : R;
        voffA[i] = (unsigned)(R * K + C) * 2u; voffB[i] = (unsigned)(Rb * K + C) * 2u; }
    const size_t kstep = (size_t)(BK * 2);
    const size_t hstep = (size_t)HALF * K * 2;
    const size_t tstep = 2 * hstep;
    const unsigned ldsw = (unsigned)wid * 1024u;
    const int aoff = lds_byte(wr * 64 + fr, fq * 8), boff = lds_byte(wc * 32 + fr, fq * 8);
#define PG8_SA(b, h) (((b) * 2 + (h)) * HTB)
#define PG8_SB(b, h) ((4 + (b) * 2 + (h)) * HTB)
#define PG8_STAGE(bufoff, gbase, voff) do { _Pragma("unroll") for (int _i = 0; _i < 2; ++_i) \
        __builtin_amdgcn_global_load_lds((const unsigned*)((const char*)(gbase) + (voff)[_i]), (PG8_LAS unsigned*)(lds + (bufoff) + ldsw + _i * 8192), 16, 0, 0); } while (0)
#define PG8_LDA(dst, b, h) do { _Pragma("unroll") for (int m = 0; m < 4; ++m) _Pragma("unroll") for (int k = 0; k < 2; ++k) dst[m][k] = *(const PG8_LAS bf16x8*)(lds + PG8_SA(b, h) + aoff + m * 2048 + k * 1024); } while (0)
#define PG8_LDB(dst, b, h) do { _Pragma("unroll") for (int n = 0; n < 2; ++n) _Pragma("unroll") for (int k = 0; k < 2; ++k) dst[n][k] = *(const PG8_LAS bf16x8*)(lds + PG8_SB(b, h) + boff + n * 2048 + k * 1024); } while (0)
#define PG8_MMA(ai, bj, At, Bt) do { __builtin_amdgcn_s_setprio(1); _Pragma("unroll") for (int m = 0; m < 4; ++m) _Pragma("unroll") for (int n = 0; n < 2; ++n) _Pragma("unroll") for (int k = 0; k < 2; ++k) \
        acc[ai][bj][m][n] = __builtin_amdgcn_mfma_f32_16x16x32_bf16(Bt[n][k], At[m][k], acc[ai][bj][m][n], 0, 0, 0); __builtin_amdgcn_s_setprio(0); } while (0)
#define PG8_WAIT_V(n) asm volatile("s_waitcnt vmcnt(" #n ")" ::: "memory")
#define PG8_WAIT_L(n) asm volatile("s_waitcnt lgkmcnt(" #n ")" ::: "memory")
#define PG8_BAR __builtin_amdgcn_s_barrier()
#define PG8_SCHED __builtin_amdgcn_sched_barrier(0)
    Unit cur, nxt; int ui = 0;
    if (!S.next(0, cur)) return;
    f32x4 acc[2][2][4][2];
#pragma unroll
    for (int a = 0; a < 2; ++a)
#pragma unroll
        for (int b = 0; b < 2; ++b)
#pragma unroll
            for (int m = 0; m < 4; ++m)
#pragma unroll
                for (int n = 0; n < 2; ++n) acc[a][b][m][n] = (f32x4){0.f, 0.f, 0.f, 0.f};
    bf16x8 At[4][2], B0[2][2], B1[2][2];
    const char* cA = (const char*)g.A + (size_t)cur.pm * tstep; const char* cB = (const char*)g.Bt + (size_t)cur.pn * tstep;
    S.a_ready(cur);
    if constexpr (SP2) {
        PG8_STAGE(PG8_SB(0, 0), cB, voffB); PG8_STAGE(PG8_SB(0, 1), cB + hstep, voffB); PG8_STAGE(PG8_SA(0, 0), cA, voffA); PG8_STAGE(PG8_SA(0, 1), cA + hstep, voffA);
        if (wr == 1) PG8_BAR;
        PG8_WAIT_V(2); PG8_BAR;
        PG8_STAGE(PG8_SB(1, 0), cB + kstep, voffB); PG8_STAGE(PG8_SA(1, 0), cA + kstep, voffA); PG8_STAGE(PG8_SB(1, 1), cB + hstep + kstep, voffB);
        PG8_WAIT_V(6); PG8_BAR;
    } else {
        PG8_STAGE(PG8_SB(0, 0), cB, voffB); PG8_STAGE(PG8_SA(0, 0), cA, voffA); PG8_STAGE(PG8_SB(0, 1), cB + hstep, voffB); PG8_STAGE(PG8_SA(0, 1), cA + hstep, voffA);
        if (wr == 1) PG8_BAR;
        PG8_WAIT_V(4); PG8_BAR;
        PG8_STAGE(PG8_SB(1, 0), cB + kstep, voffB); PG8_STAGE(PG8_SA(1, 0), cA + kstep, voffA); PG8_STAGE(PG8_SB(1, 1), cB + hstep + kstep, voffB);
        PG8_WAIT_V(6); PG8_BAR;
    }
    for (;;) {
        const bool has_next = S.next(ui + 1, nxt);
        const char* nA = has_next ? (const char*)g.A + (size_t)nxt.pm * tstep : cA; const char* nB = has_next ? (const char*)g.Bt + (size_t)nxt.pn * tstep : cB;
        for (int t = 0; t < nt; t += 2) {
            const bool last = (t == nt - 2);
            const char* a1 = cA + (size_t)(t + 1) * kstep;
            const char* a2 = last ? nA : cA + (size_t)(t + 2) * kstep; const char* b2 = last ? nB : cB + (size_t)(t + 2) * kstep;
            const char* a3 = a2 + kstep; const char* b3 = b2 + kstep;
            if (last && has_next) S.a_ready(nxt);
            if constexpr (SP2) {
            PG8_LDB(B0, 0, 0); PG8_LDB(B1, 0, 1); PG8_SCHED; PG8_LDA(At, 0, 0); PG8_STAGE(PG8_SA(1, 1), a1 + hstep, voffA);
            PG8_WAIT_V(8); PG8_WAIT_L(0); PG8_BAR; PG8_MMA(0, 0, At, B0); PG8_MMA(0, 1, At, B1); PG8_BAR; PG8_SCHED;
            PG8_LDA(At, 0, 1); PG8_STAGE(PG8_SB(0, 0), b2, voffB); PG8_STAGE(PG8_SB(0, 1), b2 + hstep, voffB); PG8_STAGE(PG8_SA(0, 0), a2, voffA);
            PG8_WAIT_V(8); PG8_WAIT_L(0); PG8_BAR; PG8_MMA(1, 0, At, B0); PG8_MMA(1, 1, At, B1); PG8_BAR; PG8_SCHED;
            PG8_LDB(B0, 1, 0); PG8_LDB(B1, 1, 1); PG8_SCHED; PG8_LDA(At, 1, 0); PG8_STAGE(PG8_SA(0, 1), a2 + hstep, voffA);
            PG8_WAIT_V(8); PG8_WAIT_L(0); PG8_BAR; PG8_MMA(0, 0, At, B0); PG8_MMA(0, 1, At, B1); PG8_BAR; PG8_SCHED;
            PG8_LDA(At, 1, 1); PG8_STAGE(PG8_SB(1, 0), b3, voffB); PG8_STAGE(PG8_SB(1, 1), b3 + hstep, voffB); PG8_STAGE(PG8_SA(1, 0), a3, voffA);
            PG8_WAIT_V(8); PG8_WAIT_L(0); PG8_BAR; PG8_MMA(1, 0, At, B0); PG8_MMA(1, 1, At, B1); PG8_BAR; PG8_SCHED;
            } else {
            PG8_LDB(B0, 0, 0); PG8_SCHED; PG8_LDA(At, 0, 0); PG8_STAGE(PG8_SA(1, 1), a1 + hstep, voffA);
            PG8_WAIT_L(8); PG8_BAR; PG8_WAIT_L(0); PG8_MMA(0, 0, At, B0); PG8_BAR; PG8_SCHED;
            PG8_LDB(B1, 0, 1); PG8_STAGE(PG8_SB(0, 0), b2, voffB);
            PG8_BAR; PG8_WAIT_L(0); PG8_MMA(0, 1, At, B1); PG8_BAR;
            PG8_LDA(At, 0, 1); PG8_STAGE(PG8_SA(0, 0), a2, voffA);
            PG8_BAR; PG8_WAIT_L(0); PG8_MMA(1, 0, At, B0); PG8_BAR; PG8_SCHED;
            PG8_STAGE(PG8_SB(0, 1), b2 + hstep, voffB);
            PG8_WAIT_V(6); PG8_BAR; PG8_MMA(1, 1, At, B1); PG8_BAR;
            PG8_LDB(B0, 1, 0); PG8_SCHED; PG8_LDA(At, 1, 0); PG8_STAGE(PG8_SA(0, 1), a2 + hstep, voffA);
            PG8_WAIT_L(8); PG8_BAR; PG8_WAIT_L(0); PG8_MMA(0, 0, At, B0); PG8_BAR; PG8_SCHED;
            PG8_LDB(B1, 1, 1); PG8_STAGE(PG8_SB(1, 0), b3, voffB);
            PG8_BAR; PG8_WAIT_L(0); PG8_MMA(0, 1, At, B1); PG8_BAR;
            PG8_LDA(At, 1, 1); PG8_STAGE(PG8_SA(1, 0), a3, voffA);
            PG8_BAR; PG8_WAIT_L(0); PG8_MMA(1, 0, At, B0); PG8_BAR; PG8_SCHED;
            PG8_STAGE(PG8_SB(1, 1), b3 + hstep, voffB);
            PG8_WAIT_V(6); PG8_BAR; PG8_MMA(1, 1, At, B1); PG8_BAR;
            }
        }
        if constexpr (ALIGN_EPI) { if (wr == 0) PG8_BAR; }
        if constexpr (!Epi::AFTER_DRAIN) { E(acc, cur, wr, wc, fr, fq); S.done(cur); }
        if (!has_next) break;
#pragma unroll
        for (int a = 0; a < 2; ++a)
#pragma unroll
            for (int b = 0; b < 2; ++b)
#pragma unroll
                for (int m = 0; m < 4; ++m)
#pragma unroll
                    for (int n = 0; n < 2; ++n) acc[a][b][m][n] = (f32x4){0.f, 0.f, 0.f, 0.f};
        cur = nxt; cA = nA; cB = nB; ++ui;
        if constexpr (ALIGN_EPI) { if (wr == 1) PG8_BAR; }
    }
    PG8_WAIT_V(0);
    if constexpr (!ALIGN_EPI) { if (wr == 0) PG8_BAR; }
    PG8_BAR;
    if constexpr (Epi::AFTER_DRAIN) { E.fused(acc, cur, wr, wc, fr, fq, lds, wid, lane); S.done(cur); }
#undef PG8_SA
#undef PG8_SB
#undef PG8_STAGE
#undef PG8_LDA
#undef PG8_LDB
#undef PG8_MMA
#undef PG8_WAIT_V
#undef PG8_WAIT_L
#undef PG8_BAR
#undef PG8_SCHED
}
}

#define LAS __attribute__((address_space(3)))
#define DI __device__ __forceinline__
using pg8::bf16_t; using pg8::bf16x8; using pg8::f32x4; using pg8::u32x4; using pg8::cvt_pk_bf16;
typedef unsigned u32x2 __attribute__((ext_vector_type(2)));
typedef float f32x2 __attribute__((ext_vector_type(2)));

constexpr int T_TOK = 32768, DM = 2048, NPROJ = 5120, PROJW = 5128;
constexpr int NTHREADS = 512;
constexpr int LDS_BYTES = 147456;
constexpr float EPS = 1e-6f;

constexpr size_t WS_XN = 0;
constexpr size_t WS_P = 134217728;
constexpr size_t WS_X1G = WS_P;
constexpr size_t WS_Q = WS_P + 134217728;
constexpr size_t WS_WINT = WS_P + 335544320;
constexpr size_t WS_WOUTT = WS_WINT + 20971520;
constexpr size_t WS_WQT = WS_WOUTT + 8388608;
constexpr size_t WS_UB = WS_WQT + 4194304;
constexpr size_t WS_VB = WS_UB + 67108864;
constexpr size_t WS_ST = WS_VB + 67108864;
constexpr size_t WS_CPT = WS_ST + 142606336;
constexpr size_t WS_QC = WS_CPT + 71303168;
constexpr size_t WS_KC = WS_QC + 33554432;
constexpr size_t WS_IG = WS_KC + 33554432;
constexpr size_t WS_LF = WS_IG + 524288;
constexpr size_t WS_PSSV = WS_LF + 524288;
constexpr size_t WS_PSS2 = WS_PSSV + 2097152;
constexpr size_t WS_BEND = WS_PSS2 + 4194304;
constexpr size_t WS_GMAX = WS_BEND + 4096;
constexpr size_t WS_MPREV = WS_GMAX + 4096;
constexpr size_t WS_SELID = WS_MPREV + 4096;
constexpr size_t WS_SELG = WS_SELID + 16777216;
constexpr size_t WS_KB1 = WS_SELG + 16777216;
constexpr size_t WS_KB2 = WS_KB1 + 131072;
constexpr size_t WS_BAR = WS_KB2 + 131072;
constexpr size_t WS_END = WS_BAR + 16384;

struct Params {
    const float *x, *norm1_g, *w_in, *gm_vnorm_g, *w_spatial, *b_spatial, *ml_conv_w, *ml_conv_b, *ml_b_i, *ml_b_f, *gm_out_g, *ml_out_g, *w_out, *norm2_g,
        *peer_wq, *peer_k1, *peer_k2, *peer_u, *peer_v, *final_g;
    float* out;
    unsigned char* ws;
};

template <int CB, int H, int W> DI size_t p_off(int t, int h, int d) { return (size_t)T_TOK * CB + ((size_t)((t >> 7) * H + h) * 128 + (t & 127)) * W + d; }
DI float bf2f(unsigned short h) { return __uint_as_float(((unsigned)h) << 16); }
DI float bflo(unsigned w) { return __uint_as_float(w << 16); }
DI float bfhi(unsigned w) { return __uint_as_float(w & 0xffff0000u); }
DI float rcpf_(float x) { return __builtin_amdgcn_rcpf(x); }
DI float sigmoid_(float x) { return rcpf_(1.f + __expf(-x)); }
DI float gelu_t(float x) { const float z = 1.5957691216057308f * (x + 0.044715f * x * x * x); return x * rcpf_(1.f + __expf(-z)); }
DI float wave_sum(float v) {
#pragma unroll
    for (int o = 32; o; o >>= 1) v += __shfl_xor(v, o);
    return v;
}
DI float wave_max(float v) {
#pragma unroll
    for (int o = 32; o; o >>= 1) v = fmaxf(v, __shfl_xor(v, o));
    return v;
}
DI bf16x8 ld_frag_lds(const LAS unsigned char* p) { return *(const LAS bf16x8*)p; }
#define MFMA16(a, b, c) __builtin_amdgcn_mfma_f32_16x16x32_bf16((a), (b), (c), 0, 0, 0)

struct Epi1 {
    static constexpr bool PERM = true, AFTER_DRAIN = false;
    bf16_t* P; float* pssv;
    DI void operator()(const f32x4 (&acc)[2][2][4][2], const pg8::Unit& u, int wr, int wc, int fr, int fq) const {
        const int row0 = u.pm * 256 + wr * 64 + fr, col0 = u.pn * 256 + wc * 32 + 8 * fq;
        const int mode = u.pn < 8 ? 1 : (u.pn >= 16 ? 2 : 0);
        const bool want_ss = (u.pn >= 4 && u.pn < 8);
#pragma unroll
        for (int ai = 0; ai < 2; ++ai)
#pragma unroll
            for (int m = 0; m < 4; ++m) {
                const int row = row0 + ai * 128 + m * 16;
                const int CB = u.pn < 4 ? 0 : (u.pn < 8 ? 1024 : (u.pn < 10 ? 2048 : (u.pn < 12 ? 2560 : (u.pn < 16 ? 3072 : 4096))));
                const int lw = u.pn < 12 ? 7 : 8, H = u.pn < 8 ? 8 : 4;
                float ss = 0.f;
#pragma unroll
                for (int bj = 0; bj < 2; ++bj) {
                    f32x4 v0 = acc[ai][bj][m][0], v1 = acc[ai][bj][m][1];
                    if (mode == 1) {
#pragma unroll
                        for (int j = 0; j < 4; ++j) { v0[j] = gelu_t(v0[j]); v1[j] = gelu_t(v1[j]); ss += v0[j] * v0[j] + v1[j] * v1[j]; }
                    } else if (mode == 2) {
#pragma unroll
                        for (int j = 0; j < 4; ++j) { v0[j] = sigmoid_(v0[j]); v1[j] = sigmoid_(v1[j]); }
                    }
                    u32x4 w; w.x = cvt_pk_bf16(v0[0], v0[1]); w.y = cvt_pk_bf16(v0[2], v0[3]); w.z = cvt_pk_bf16(v1[0], v1[1]); w.w = cvt_pk_bf16(v1[2], v1[3]);
                    {
                        const int cr = col0 + bj * 128 - CB, hh = cr >> lw, d = cr & ((1 << lw) - 1);
                        *(u32x4*)(P + (size_t)T_TOK * CB + (((size_t)((row >> 7) * H + hh) * 128 + (row & 127)) << lw) + d) = w;
                    }
                }
                if (want_ss) {
                    ss += __shfl_xor(ss, 16); ss += __shfl_xor(ss, 32);
                    if (fq == 0) pssv[(size_t)row * 16 + (u.pn - 4) * 4 + wc] = ss;
                }
            }
    }
};

struct Epi2 {
    static constexpr bool PERM = true, AFTER_DRAIN = false;
    const float* x; bf16_t* x1b; float* pss2;
    DI void operator()(const f32x4 (&acc)[2][2][4][2], const pg8::Unit& u, int wr, int wc, int fr, int fq) const {
        const int row0 = u.pm * 256 + wr * 64 + fr, col0 = u.pn * 256 + wc * 32 + 8 * fq;
#pragma unroll
        for (int ai = 0; ai < 2; ++ai)
#pragma unroll
            for (int m = 0; m < 4; ++m) {
                const int row = row0 + ai * 128 + m * 16;
                float ss = 0.f;
#pragma unroll
                for (int bj = 0; bj < 2; ++bj) {
                    const size_t o = (size_t)row * DM + col0 + bj * 128;
                    const f32x4 v0 = acc[ai][bj][m][0] + *(const f32x4*)(x + o), v1 = acc[ai][bj][m][1] + *(const f32x4*)(x + o + 4);
#pragma unroll
                    for (int j = 0; j < 4; ++j) ss += v0[j] * v0[j] + v1[j] * v1[j];
                    u32x4 w; w.x = cvt_pk_bf16(v0[0], v0[1]); w.y = cvt_pk_bf16(v0[2], v0[3]); w.z = cvt_pk_bf16(v1[0], v1[1]); w.w = cvt_pk_bf16(v1[2], v1[3]);
                    *(u32x4*)(x1b + o) = w;
                }
                ss += __shfl_xor(ss, 16); ss += __shfl_xor(ss, 32);
                if (fq == 0) pss2[(size_t)row * 32 + u.pn * 4 + wc] = ss;
            }
    }
};

struct Epi3 {
    static constexpr bool PERM = true, AFTER_DRAIN = false;
    bf16_t* Q; const float* pss2;
    DI void operator()(const f32x4 (&acc)[2][2][4][2], const pg8::Unit& u, int wr, int wc, int fr, int fq) const {
        const int row0 = u.pm * 256 + wr * 64 + fr, col0 = u.pn * 256 + wc * 32 + 8 * fq;
#pragma unroll
        for (int ai = 0; ai < 2; ++ai)
#pragma unroll
            for (int m = 0; m < 4; ++m) {
                const int row = row0 + ai * 128 + m * 16;
                float ss = 0.f;
#pragma unroll
                for (int i = 0; i < 8; ++i) { const f32x4 t = *(const f32x4*)(pss2 + (size_t)row * 32 + i * 4); ss += (t[0] + t[1]) + (t[2] + t[3]); }
                const float rstd = rsqrtf(ss * (1.f / 2048.f) + EPS);
#pragma unroll
                for (int bj = 0; bj < 2; ++bj) {
                    const f32x4 v0 = acc[ai][bj][m][0] * rstd, v1 = acc[ai][bj][m][1] * rstd;
                    u32x4 w; w.x = cvt_pk_bf16(v0[0], v0[1]); w.y = cvt_pk_bf16(v0[2], v0[3]); w.z = cvt_pk_bf16(v1[0], v1[1]); w.w = cvt_pk_bf16(v1[2], v1[3]);
                    *(u32x4*)(Q + (size_t)row * 1024 + col0 + bj * 128) = w;
                }
            }
    }
};

DI void phase0(const Params& p, LAS unsigned char* lds) {
    const int tid = threadIdx.x, lane = tid & 63, wave = tid >> 6;
    bf16_t* XN = (bf16_t*)(p.ws + WS_XN);
    {
        LAS float* scr = (LAS float*)lds + wave * (64 * 65);
        const int gw = blockIdx.x * 8 + wave, nw = gridDim.x * 8;
        for (int it = gw; it < 4096; it += nw) {
            const float* W; bf16_t* WT; int ldw, kt, nt;
            if (it < 2560) { W = p.w_in; WT = (bf16_t*)(p.ws + WS_WINT); ldw = PROJW; kt = it / 80; nt = it % 80; }
            else if (it < 3584) { const int j = it - 2560; W = p.w_out; WT = (bf16_t*)(p.ws + WS_WOUTT); ldw = 2048; kt = j >> 5; nt = j & 31; }
            else { const int j = it - 3584; W = p.peer_wq; WT = (bf16_t*)(p.ws + WS_WQT); ldw = 1024; kt = j >> 4; nt = j & 15; }
            const int k0 = kt * 64, n0 = nt * 64;
            {
                f32x4 tv[16];
#pragma unroll
                for (int i = 0; i < 16; ++i) tv[i] = *(const f32x4*)(W + (size_t)(k0 + 4 * i + (lane >> 4)) * ldw + n0 + 4 * (lane & 15));
#pragma unroll
                for (int i = 0; i < 16; ++i) {
                    const int r = 4 * i + (lane >> 4);
                    const float gsc = it >= 3584 ? p.norm2_g[k0 + r] : 1.f;
                    LAS float* d = scr + r * 65 + 4 * (lane & 15);
                    d[0] = tv[i][0] * gsc; d[1] = tv[i][1] * gsc; d[2] = tv[i][2] * gsc; d[3] = tv[i][3] * gsc;
                }
            }
            __builtin_amdgcn_fence(__ATOMIC_RELEASE, "wavefront"); __builtin_amdgcn_wave_barrier(); __builtin_amdgcn_fence(__ATOMIC_ACQUIRE, "wavefront");
            const int half = lane >> 5, kk = (lane & 31) * 2;
#pragma unroll 8
            for (int nn = 0; nn < 32; ++nn) {
                const int n = 2 * nn + half; const float a = scr[kk * 65 + n], b = scr[(kk + 1) * 65 + n];
                *(unsigned*)(WT + (size_t)(n0 + n) * 2048 + k0 + kk) = cvt_pk_bf16(a, b);
            }
            __builtin_amdgcn_fence(__ATOMIC_RELEASE, "wavefront"); __builtin_amdgcn_wave_barrier(); __builtin_amdgcn_fence(__ATOMIC_ACQUIRE, "wavefront");
        }
    }
    __syncthreads();
    {
        LAS float* wg = (LAS float*)lds;
        for (int idx = tid; idx < 4096; idx += NTHREADS) {
            const int k = idx >> 1, hf = idx & 1;
            const f32x4 v = *(const f32x4*)(p.w_in + (size_t)k * PROJW + 5120 + hf * 4);
            *(LAS f32x4*)(wg + k * 8 + (k >> 3) * 4 + hf * 4) = v;
        }
        __syncthreads();
        float* IG = (float*)(p.ws + WS_IG); float* LF = (float*)(p.ws + WS_LF);
        for (int row0 = 2 * (blockIdx.x * 8 + wave); row0 < T_TOK; row0 += 2 * gridDim.x * 8) {
            f32x4 xv[2][8];
#pragma unroll
            for (int rr = 0; rr < 2; ++rr) {
                const float* xr = p.x + (size_t)(row0 + rr) * DM;
#pragma unroll
                for (int i = 0; i < 4; ++i) { xv[rr][2 * i] = *(const f32x4*)(xr + i * 512 + lane * 8); xv[rr][2 * i + 1] = *(const f32x4*)(xr + i * 512 + lane * 8 + 4); }
            }
#pragma unroll
            for (int rr = 0; rr < 2; ++rr) {
                const int row = row0 + rr;
                float ss = 0.f;
#pragma unroll
                for (int i = 0; i < 8; ++i) ss += (xv[rr][i][0] * xv[rr][i][0] + xv[rr][i][1] * xv[rr][i][1]) + (xv[rr][i][2] * xv[rr][i][2] + xv[rr][i][3] * xv[rr][i][3]);
                ss = wave_sum(ss);
                const float rstd = rsqrtf(ss * (1.f / 2048.f) + EPS);
                f32x4 ga = {0.f, 0.f, 0.f, 0.f}, gb = {0.f, 0.f, 0.f, 0.f};
#pragma unroll
                for (int i = 0; i < 4; ++i) {
                    const f32x4 g0 = *(const f32x4*)(p.norm1_g + i * 512 + lane * 8), g1 = *(const f32x4*)(p.norm1_g + i * 512 + lane * 8 + 4);
                    const f32x4 h0 = xv[rr][2 * i] * rstd * g0, h1 = xv[rr][2 * i + 1] * rstd * g1;
                    u32x4 w; w.x = cvt_pk_bf16(h0[0], h0[1]); w.y = cvt_pk_bf16(h0[2], h0[3]); w.z = cvt_pk_bf16(h1[0], h1[1]); w.w = cvt_pk_bf16(h1[2], h1[3]);
                    *(u32x4*)(XN + (size_t)row * DM + i * 512 + lane * 8) = w;
                    const LAS float* wb = wg + (i * 512 + lane * 8) * 8 + (i * 64 + lane) * 4;
#pragma unroll
                    for (int e = 0; e < 8; ++e) {
                        const float hv = e < 4 ? h0[e & 3] : h1[e & 3];
                        const f32x4 w0 = *(const LAS f32x4*)(wb + e * 8), w1 = *(const LAS f32x4*)(wb + e * 8 + 4);
                        ga = ga + w0 * hv; gb = gb + w1 * hv;
                    }
                }
                f32x4 m4 = lane < 32 ? ga : gb, s4 = lane < 32 ? gb : ga;
#pragma unroll
                for (int j = 0; j < 4; ++j) m4[j] += __shfl_xor(s4[j], 32);
                const bool up16 = (lane & 16) != 0;
                float m2a = up16 ? m4[2] : m4[0], m2b = up16 ? m4[3] : m4[1];
                const float s2a = up16 ? m4[0] : m4[2], s2b = up16 ? m4[1] : m4[3];
                m2a += __shfl_xor(s2a, 16); m2b += __shfl_xor(s2b, 16);
                const bool up8 = (lane & 8) != 0;
                float m1 = up8 ? m2b : m2a; const float s1 = up8 ? m2a : m2b;
                m1 += __shfl_xor(s1, 8);
                m1 += __shfl_xor(m1, 4); m1 += __shfl_xor(m1, 2); m1 += __shfl_xor(m1, 1);
                const int j = ((lane >> 5) << 2) | (((lane >> 4) & 1) << 1) | ((lane >> 3) & 1);
                if ((lane & 7) == 0) {
                    if (j < 4) IG[(size_t)row * 4 + j] = m1 + p.ml_b_i[j];
                    else { const float z = m1 + p.ml_b_f[j - 4]; LF[(size_t)row * 4 + j - 4] = fminf(z, 0.f) - log1pf(__expf(-fabsf(z))); }
                }
            }
        }
    }
    {
        const size_t nthr = (size_t)gridDim.x * NTHREADS, NQ = (size_t)16384 * 512;
        for (size_t base = (size_t)blockIdx.x * NTHREADS + tid; base < 2 * NQ; base += 16 * nthr) {
            f32x4 v[16];
#pragma unroll
            for (int u = 0; u < 16; ++u) {
                size_t i = base + u * nthr; if (i >= 2 * NQ) i = base;
                const int which = i >= NQ; const size_t j = i - (which ? NQ : 0);
                v[u] = *(const f32x4*)((which ? p.peer_v : p.peer_u) + j * 4);
            }
#pragma unroll
            for (int u = 0; u < 16; ++u) {
                size_t i = base + u * nthr; if (i >= 2 * NQ) i = base;
                const int which = i >= NQ; const size_t j = i - (which ? NQ : 0);
                const int row = (int)(j >> 9), c4 = (int)(j & 511);
                float amax = fmaxf(fmaxf(fabsf(v[u][0]), fabsf(v[u][1])), fmaxf(fabsf(v[u][2]), fabsf(v[u][3])));
                amax = fmaxf(amax, __uint_as_float((unsigned)__builtin_amdgcn_update_dpp(0, (int)__float_as_uint(amax), 0xB1, 0xF, 0xF, true)));
                amax = fmaxf(amax, __uint_as_float((unsigned)__builtin_amdgcn_update_dpp(0, (int)__float_as_uint(amax), 0x4E, 0xF, 0xF, true)));
                amax = fmaxf(amax, __uint_as_float((unsigned)__builtin_amdgcn_update_dpp(0, (int)__float_as_uint(amax), 0x141, 0xF, 0xF, true)));
                amax = fmaxf(amax, __uint_as_float((unsigned)__builtin_amdgcn_update_dpp(0, (int)__float_as_uint(amax), 0x140, 0xF, 0xF, true)));
                const unsigned sb = cvt_pk_bf16(amax * (1.f / 6.f), 0.f) & 0xffffu;
                float sc = bflo(sb); if (sc == 0.f) sc = 1.f;
                const float inv = 1.f / sc;
                unsigned r = 0u;
                r = __builtin_amdgcn_cvt_scalef32_pk_fp4_f32(r, v[u][0] * inv, v[u][1] * inv, 1.0f, 0);
                r = __builtin_amdgcn_cvt_scalef32_pk_fp4_f32(r, v[u][2] * inv, v[u][3] * inv, 1.0f, 1);
                unsigned char* dst = p.ws + (which ? WS_VB : WS_UB) + (size_t)row * 1088;
                *(unsigned short*)(dst + c4 * 2) = (unsigned short)(r & 0xffffu);
                if ((c4 & 15) == 0) *(unsigned short*)(dst + 1024 + (c4 >> 4) * 2) = (unsigned short)(sb == 0u ? 0x3F80u : sb);
            }
        }
    }
    {
        bf16_t* KB1 = (bf16_t*)(p.ws + WS_KB1); bf16_t* KB2 = (bf16_t*)(p.ws + WS_KB2);
        for (int i = blockIdx.x * NTHREADS + tid; i < 65536 / 4; i += gridDim.x * NTHREADS) {
            const f32x4 a = *(const f32x4*)(p.peer_k1 + i * 4), b = *(const f32x4*)(p.peer_k2 + i * 4);
            u32x2 w; w.x = cvt_pk_bf16(a[0], a[1]); w.y = cvt_pk_bf16(a[2], a[3]); *(u32x2*)(KB1 + i * 4) = w;
            w.x = cvt_pk_bf16(b[0], b[1]); w.y = cvt_pk_bf16(b[2], b[3]); *(u32x2*)(KB2 + i * 4) = w;
        }
    }
}

#define WAVE_LDS_SYNC() do { __builtin_amdgcn_fence(__ATOMIC_RELEASE, "wavefront"); __builtin_amdgcn_wave_barrier(); __builtin_amdgcn_fence(__ATOMIC_ACQUIRE, "wavefront"); } while (0)

template <int NG> DI void stage_T_load(const bf16_t* src, int ld, u32x4 (&r0)[NG], u32x4 (&r1)[NG], int wave, int lane) {
#pragma unroll
    for (int i = 0; i < NG; ++i) {
        const int g = wave + 8 * i;
        r0[i] = *(const u32x4*)(src + (size_t)(2 * lane) * ld + g * 8);
        r1[i] = *(const u32x4*)(src + (size_t)(2 * lane + 1) * ld + g * 8);
    }
}
template <int NG> DI void stage_T_store(const u32x4 (&r0)[NG], const u32x4 (&r1)[NG], LAS unsigned char* dst, int wave, int lane) {
#pragma unroll
    for (int i = 0; i < NG; ++i) {
        const int g = wave + 8 * i;
#pragma unroll
        for (int w = 0; w < 4; ++w) {
            const unsigned a = r0[i][w], b = r1[i][w];
            *(LAS unsigned*)(dst + (g * 8 + 2 * w) * 272 + lane * 4) = (a & 0xffffu) | (b << 16);
            *(LAS unsigned*)(dst + (g * 8 + 2 * w + 1) * 272 + lane * 4) = (a >> 16) | (b & 0xffff0000u);
        }
    }
}
template <int NG> DI void stage_T(const bf16_t* src, int ld, LAS unsigned char* dst, int wave, int lane) {
    u32x4 r0[NG], r1[NG];
    stage_T_load<NG>(src, ld, r0, r1, wave, lane);
    stage_T_store<NG>(r0, r1, dst, wave, lane);
}

DI void gmlp_bc(const Params& p, LAS unsigned char* lds, int b, int c) {
    const int tid = threadIdx.x, lane = tid & 63, wave = __builtin_amdgcn_readfirstlane(tid >> 6), fr = lane & 15, fq = lane >> 4;
    const int t0 = b * 8192 + c * 128;
    LAS unsigned char* Wl = lds; LAS unsigned char* GvT = lds + 34816; LAS float* rstdv = (LAS float*)(lds + 69632);
    const bf16_t* P = (const bf16_t*)(p.ws + WS_P); bf16_t* YM = (bf16_t*)(p.ws + WS_XN);
    const float* PSSV = (const float*)(p.ws + WS_PSSV);
    __syncthreads();
    if (tid < 128) {
        float ss = 0.f;
#pragma unroll
        for (int i = 0; i < 4; ++i) { const f32x4 v = *(const f32x4*)(PSSV + (size_t)(t0 + tid) * 16 + i * 4); ss += (v[0] + v[1]) + (v[2] + v[3]); }
        rstdv[tid] = rsqrtf(ss * (1.f / 1024.f) + EPS);
    }
    f32x4 wa[4][2]; u32x4 gr0[2], gr1[2];
#define GMLP_PREFETCH(hh) do { _Pragma("unroll") for (int it = 0; it < 4; ++it) { const int e = (it * NTHREADS + tid) * 8, t = e >> 7, s0 = e & 127; \
            const float* wp = p.w_spatial + ((size_t)((hh) * 128 + t)) * 128 + s0; wa[it][0] = *(const f32x4*)wp; wa[it][1] = *(const f32x4*)(wp + 4); } \
        stage_T_load<2>(P + p_off<1024, 8, 128>(t0, (hh), 0), 128, gr0, gr1, wave, lane); } while (0)
    GMLP_PREFETCH(0);
    for (int h = 0; h < 8; ++h) {
        __syncthreads();
#pragma unroll
        for (int it = 0; it < 4; ++it) {
            const int e = (it * NTHREADS + tid) * 8, t = e >> 7, s0 = e & 127;
            float v[8];
#pragma unroll
            for (int j = 0; j < 8; ++j) { const float a = j < 4 ? wa[it][0][j & 3] : wa[it][1][j & 3]; v[j] = (s0 + j <= t) ? a * rstdv[s0 + j] : 0.f; }
            u32x4 w; w.x = cvt_pk_bf16(v[0], v[1]); w.y = cvt_pk_bf16(v[2], v[3]); w.z = cvt_pk_bf16(v[4], v[5]); w.w = cvt_pk_bf16(v[6], v[7]);
            *(LAS u32x4*)(Wl + t * 272 + s0 * 2) = w;
        }
        stage_T_store<2>(gr0, gr1, GvT, wave, lane);
        __syncthreads();
        if (h + 1 < 8) GMLP_PREFETCH(h + 1);
        f32x4 acc[8];
#pragma unroll
        for (int n = 0; n < 8; ++n) acc[n] = (f32x4){0.f, 0.f, 0.f, 0.f};
        const int kmax = (16 * wave + 15) >> 5;
#pragma unroll
        for (int kk = 0; kk < 4; ++kk) {
            if (kk <= kmax) {
                const bf16x8 bfrag = ld_frag_lds(Wl + (16 * wave + fr) * 272 + (32 * kk + 8 * fq) * 2);
#pragma unroll
                for (int n = 0; n < 8; ++n) { const bf16x8 afrag = ld_frag_lds(GvT + (16 * n + fr) * 272 + (32 * kk + 8 * fq) * 2); acc[n] = MFMA16(afrag, bfrag, acc[n]); }
            }
        }
        const int t = 16 * wave + fr; const size_t grow = (size_t)(t0 + t);
        const float bsp = p.b_spatial[h * 128 + t];
        float ss = 0.f;
#pragma unroll
        for (int n = 0; n < 8; ++n) {
            const int d0 = 16 * n + 4 * fq;
            const u32x2 uw = *(const u32x2*)(P + p_off<0, 8, 128>(t0 + t, h, d0));
            const f32x4 gv = *(const f32x4*)(p.gm_vnorm_g + h * 128 + d0);
            f32x4 y;
            y[0] = bflo(uw.x) * (gv[0] * acc[n][0] + bsp); y[1] = bfhi(uw.x) * (gv[1] * acc[n][1] + bsp);
            y[2] = bflo(uw.y) * (gv[2] * acc[n][2] + bsp); y[3] = bfhi(uw.y) * (gv[3] * acc[n][3] + bsp);
            ss += (y[0] * y[0] + y[1] * y[1]) + (y[2] * y[2] + y[3] * y[3]);
            acc[n] = y;
        }
        ss += __shfl_xor(ss, 16); ss += __shfl_xor(ss, 32);
        const float rstd = rsqrtf(ss * (1.f / 128.f) + EPS);
#pragma unroll
        for (int n = 0; n < 8; ++n) {
            const int d0 = 16 * n + 4 * fq;
            const f32x4 g = *(const f32x4*)(p.gm_out_g + h * 128 + d0);
            const f32x4 o = acc[n] * rstd * g;
            u32x2 w; w.x = cvt_pk_bf16(o[0], o[1]); w.y = cvt_pk_bf16(o[2], o[3]);
            *(u32x2*)(YM + grow * DM + h * 128 + d0) = w;
        }
    }
}

DI void mlstm_local(const Params& p, LAS unsigned char* lds, int b, int c, int h) {
    const int tid = threadIdx.x, lane = tid & 63, wave = __builtin_amdgcn_readfirstlane(tid >> 6), fr = lane & 15, fq = lane >> 4;
    const int bh = b * 4 + h, t0 = b * 8192 + c * 128;
    LAS unsigned char* KT = lds; LAS unsigned char* VT = lds + 34816; LAS float* wsv = (LAS float*)(lds + 108800);
    const bf16_t* P = (const bf16_t*)(p.ws + WS_P);
    bf16_t* QC = (bf16_t*)(p.ws + WS_QC); bf16_t* KC = (bf16_t*)(p.ws + WS_KC);
    const float* IG = (const float*)(p.ws + WS_IG); const float* LF = (const float*)(p.ws + WS_LF);
    LAS float* cwl = (LAS float*)(lds + 109312);
    __syncthreads();
    u32x4 xw[2][5];
#define CONV_LOAD(half) do { _Pragma("unroll") for (int gi = 0; gi < 2; ++gi) { const int g = wave + 8 * (gi + 2 * (half)); const int cgp = (g & 15) * 8; \
        _Pragma("unroll") for (int dj = 0; dj < 5; ++dj) { const int srow = 2 * lane - 3 + dj; xw[gi][dj] = (u32x4){0u, 0u, 0u, 0u}; \
            if (c > 0 || srow >= 0) xw[gi][dj] = *(const u32x4*)(P + ((half) ? p_off<2560, 4, 128>(t0 + srow, h, cgp) : p_off<2048, 4, 128>(t0 + srow, h, cgp))); } } } while (0)
    CONV_LOAD(0);
    for (int idx = tid; idx < 1280; idx += NTHREADS) {
        const int j = idx >> 8, cc = idx & 255, ch = (cc >= 128 ? 512 : 0) + h * 128 + (cc & 127);
        cwl[idx] = j < 4 ? p.ml_conv_w[j * 1024 + ch] : p.ml_conv_b[ch];
    }
    if (wave == 0) {
        const float l0 = LF[(size_t)(t0 + 2 * lane) * 4 + h], l1 = LF[(size_t)(t0 + 2 * lane + 1) * 4 + h];
        const float i0 = IG[(size_t)(t0 + 2 * lane) * 4 + h], i1 = IG[(size_t)(t0 + 2 * lane + 1) * 4 + h];
        float s = l0 + l1;
#pragma unroll
        for (int off = 1; off < 64; off <<= 1) { const float tt = __shfl_up(s, off); if (lane >= off) s += tt; }
        const float b1 = s, b0 = s - l1, bend = __shfl(s, 63);
        const float g0 = bend - b0 + i0, g1 = bend - b1 + i1;
        const float gmax = wave_max(fmaxf(g0, g1));
        wsv[2 * lane] = __expf(g0 - gmax); wsv[2 * lane + 1] = __expf(g1 - gmax);
        if (lane == 0) { ((float*)(p.ws + WS_BEND))[bh * 64 + c] = bend; ((float*)(p.ws + WS_GMAX))[bh * 64 + c] = gmax; }
    }
    __syncthreads();
#pragma unroll
    for (int gi4 = 0; gi4 < 4; ++gi4) {
        const int gi = gi4 & 1;
        if (gi4 == 2) CONV_LOAD(1);
        const int g = wave + 8 * gi4; const bool isk = gi4 >= 2; const int cgp = (g & 15) * 8;
        const int cc0 = (isk ? 128 : 0) + cgp;
        const int s = 2 * lane;
        float y0[8], y1[8];
        {
            const f32x4 cb0 = *(const LAS f32x4*)(cwl + 1024 + cc0), cb1 = *(const LAS f32x4*)(cwl + 1024 + cc0 + 4);
#pragma unroll
            for (int e = 0; e < 8; ++e) { y0[e] = e < 4 ? cb0[e & 3] : cb1[e & 3]; y1[e] = y0[e]; }
#pragma unroll
            for (int j = 0; j < 5; ++j) {
                float xr[8];
#pragma unroll
                for (int q = 0; q < 4; ++q) { xr[2 * q] = bflo(xw[gi][j][q]); xr[2 * q + 1] = bfhi(xw[gi][j][q]); }
                if (j < 4) {
                    const f32x4 w0 = *(const LAS f32x4*)(cwl + j * 256 + cc0), w1 = *(const LAS f32x4*)(cwl + j * 256 + cc0 + 4);
#pragma unroll
                    for (int e = 0; e < 8; ++e) y0[e] += (e < 4 ? w0[e & 3] : w1[e & 3]) * xr[e];
                }
                if (j > 0) {
                    const f32x4 w0 = *(const LAS f32x4*)(cwl + (j - 1) * 256 + cc0), w1 = *(const LAS f32x4*)(cwl + (j - 1) * 256 + cc0 + 4);
#pragma unroll
                    for (int e = 0; e < 8; ++e) y1[e] += (e < 4 ? w0[e & 3] : w1[e & 3]) * xr[e];
                }
            }
        }
        const float sc = isk ? 0.08838834764831845f : 1.f;
#pragma unroll
        for (int e = 0; e < 8; ++e) { y0[e] = y0[e] * sigmoid_(y0[e]) * sc; y1[e] = y1[e] * sigmoid_(y1[e]) * sc; }
        bf16_t* dst = (isk ? KC : QC) + (size_t)(t0 + s) * 512 + h * 128 + cgp;
        u32x4 w; w.x = cvt_pk_bf16(y0[0], y0[1]); w.y = cvt_pk_bf16(y0[2], y0[3]); w.z = cvt_pk_bf16(y0[4], y0[5]); w.w = cvt_pk_bf16(y0[6], y0[7]);
        *(u32x4*)dst = w;
        w.x = cvt_pk_bf16(y1[0], y1[1]); w.y = cvt_pk_bf16(y1[2], y1[3]); w.z = cvt_pk_bf16(y1[4], y1[5]); w.w = cvt_pk_bf16(y1[6], y1[7]);
        *(u32x4*)(dst + 512) = w;
        if (isk) {
            const float w0 = wsv[s], w1 = wsv[s + 1];
#pragma unroll
            for (int e = 0; e < 8; ++e) *(LAS unsigned*)(KT + (cgp + e) * 272 + lane * 4) = cvt_pk_bf16(y0[e] * w0, y1[e] * w1);
        }
    }
    stage_T<4>(P + p_off<3072, 4, 256>(t0, h, 0), 256, VT, wave, lane);
    for (int i = tid; i < 1024; i += NTHREADS) { const int r = i >> 6, w = i & 63; *(LAS unsigned*)(VT + (256 + r) * 272 + w * 4) = 0x3F803F80u; }
    __syncthreads();
    bf16x8 af[4];
#pragma unroll
    for (int kk = 0; kk < 4; ++kk) af[kk] = ld_frag_lds(KT + (16 * wave + fr) * 272 + (32 * kk + 8 * fq) * 2);
    float* ST = (float*)(p.ws + WS_ST) + ((size_t)(bh * 64 + c) * 272) * 128;
#pragma unroll
    for (int n = 0; n < 17; ++n) {
        f32x4 acc = {0.f, 0.f, 0.f, 0.f};
#pragma unroll
        for (int kk = 0; kk < 4; ++kk) { const bf16x8 bfr = ld_frag_lds(VT + (16 * n + fr) * 272 + (32 * kk + 8 * fq) * 2); acc = MFMA16(af[kk], bfr, acc); }
        if (n < 16 || fr == 0) __builtin_nontemporal_store(acc, (f32x4*)(ST + (size_t)(16 * n + fr) * 128 + 16 * wave + 4 * fq));
    }
}

DI void phase_scan(const Params& p) {
    const float* ST = (const float*)(p.ws + WS_ST); bf16_t* CPT = (bf16_t*)(p.ws + WS_CPT);
    const float* BEND = (const float*)(p.ws + WS_BEND); const float* GMAX = (const float*)(p.ws + WS_GMAX); float* MPREV = (float*)(p.ws + WS_MPREV);
    const int gtid = blockIdx.x * NTHREADS + threadIdx.x, nthr = gridDim.x * NTHREADS;
    constexpr int PER = 8224;
    constexpr size_t CST = 272 * 128;
    if (nthr == 16 * 8192) {
        const int bh = gtid >> 13, e4 = gtid & 8191;
        const bool extra = (gtid & 255) == 0;
        const int e42 = 8192 + ((gtid >> 8) & 31);
        const float* src = ST + (size_t)bh * 64 * CST + (size_t)e4 * 4;
        bf16_t* dst = CPT + (size_t)bh * 64 * CST + (size_t)e4 * 4;
        const float* src2 = ST + (size_t)bh * 64 * CST + (size_t)e42 * 4;
        bf16_t* dst2 = CPT + (size_t)bh * 64 * CST + (size_t)e42 * 4;
        f32x4 st = {0.f, 0.f, 0.f, 0.f}, st2 = {0.f, 0.f, 0.f, 0.f}; float m = 0.f;
        for (int c0 = 0; c0 < 64; c0 += 8) {
            f32x4 d[8], d2[8]; float be[8], gm[8];
#pragma unroll
            for (int j = 0; j < 8; ++j) { d[j] = __builtin_nontemporal_load((const f32x4*)(src + (size_t)(c0 + j) * CST)); be[j] = BEND[bh * 64 + c0 + j]; gm[j] = GMAX[bh * 64 + c0 + j]; }
#pragma unroll
            for (int j = 0; j < 8; ++j) d2[j] = extra ? __builtin_nontemporal_load((const f32x4*)(src2 + (size_t)(c0 + j) * CST)) : (f32x4){0.f, 0.f, 0.f, 0.f};
#pragma unroll
            for (int j = 0; j < 8; ++j) {
                const int c = c0 + j;
                const float mn = fmaxf(be[j] + m, gm[j]), a = __expf(be[j] + m - mn), sc = __expf(gm[j] - mn);
                u32x2 w; w.x = cvt_pk_bf16(st[0], st[1]); w.y = cvt_pk_bf16(st[2], st[3]);
                *(u32x2*)(dst + (size_t)c * CST) = w;
                if (extra) { u32x2 w2; w2.x = cvt_pk_bf16(st2[0], st2[1]); w2.y = cvt_pk_bf16(st2[2], st2[3]); *(u32x2*)(dst2 + (size_t)c * CST) = w2; }
                if (e4 == 0) MPREV[bh * 64 + c] = m;
                st = st * a + d[j] * sc; st2 = st2 * a + d2[j] * sc; m = mn;
            }
        }
        return;
    }
    for (int item = gtid; item < 16 * PER; item += nthr) {
        const int bh = item / PER, e4 = item - bh * PER;
        const float* src = ST + (size_t)bh * 64 * CST + (size_t)e4 * 4;
        bf16_t* dst = CPT + (size_t)bh * 64 * CST + (size_t)e4 * 4;
        f32x4 st = {0.f, 0.f, 0.f, 0.f}; float m = 0.f;
        for (int c0 = 0; c0 < 64; c0 += 8) {
            f32x4 d[8]; float be[8], gm[8];
#pragma unroll
            for (int j = 0; j < 8; ++j) { d[j] = __builtin_nontemporal_load((const f32x4*)(src + (size_t)(c0 + j) * CST)); be[j] = BEND[bh * 64 + c0 + j]; gm[j] = GMAX[bh * 64 + c0 + j]; }
#pragma unroll
            for (int j = 0; j < 8; ++j) {
                const int c = c0 + j;
                const float mn = fmaxf(be[j] + m, gm[j]), a = __expf(be[j] + m - mn), sc = __expf(gm[j] - mn);
                u32x2 w; w.x = cvt_pk_bf16(st[0], st[1]); w.y = cvt_pk_bf16(st[2], st[3]);
                *(u32x2*)(dst + (size_t)c * CST) = w;
                if (e4 == 0) MPREV[bh * 64 + c] = m;
                st = st * a + d[j] * sc; m = mn;
            }
        }
    }
}

DI void mlstm_out(const Params& p, LAS unsigned char* lds, int b, int c, int h) {
    const int tid = threadIdx.x, lane = tid & 63, wave = __builtin_amdgcn_readfirstlane(tid >> 6), fr = lane & 15, fq = lane >> 4;
    const int bh = b * 4 + h, t0 = b * 8192 + c * 128;
    LAS unsigned char* Kl = lds; LAS unsigned char* Sl = lds + 34816; LAS unsigned char* VTe = lds + 69632;
    LAS float* av = (LAS float*)(lds + 143616); LAS float* Mv = (LAS float*)(lds + 144128); LAS float* bv = (LAS float*)(lds + 144640);
    const bf16_t* P = (const bf16_t*)(p.ws + WS_P); bf16_t* YM = (bf16_t*)(p.ws + WS_XN);
    const bf16_t* QC = (const bf16_t*)(p.ws + WS_QC); const bf16_t* KC = (const bf16_t*)(p.ws + WS_KC);
    const float* IG = (const float*)(p.ws + WS_IG); const float* LF = (const float*)(p.ws + WS_LF);
    const float mprev = ((const float*)(p.ws + WS_MPREV))[bh * 64 + c];
    __syncthreads();
    if (wave == 0) {
        const float l0 = LF[(size_t)(t0 + 2 * lane) * 4 + h], l1 = LF[(size_t)(t0 + 2 * lane + 1) * 4 + h];
        const float i0 = IG[(size_t)(t0 + 2 * lane) * 4 + h], i1 = IG[(size_t)(t0 + 2 * lane + 1) * 4 + h];
        float s = l0 + l1;
#pragma unroll
        for (int off = 1; off < 64; off <<= 1) { const float tt = __shfl_up(s, off); if (lane >= off) s += tt; }
        const float b1 = s, b0 = s - l1;
        const float a0 = i0 - b0, a1 = i1 - b1;
        float pm = fmaxf(a0, a1);
#pragma unroll
        for (int off = 1; off < 64; off <<= 1) { const float tt = __shfl_up(pm, off); if (lane >= off) pm = fmaxf(pm, tt); }
        float ex = __shfl_up(pm, 1); if (lane == 0) ex = -3.0e38f;
        Mv[2 * lane] = fmaxf(mprev, fmaxf(ex, a0)); Mv[2 * lane + 1] = fmaxf(mprev, pm);
        av[2 * lane] = a0; av[2 * lane + 1] = a1; bv[2 * lane] = b0; bv[2 * lane + 1] = b1;
    }
#pragma unroll
    for (int it = 0; it < 4; ++it) {
        const int e = (it * NTHREADS + tid) * 8, s = e >> 7, d0 = e & 127;
        *(LAS u32x4*)(Kl + s * 272 + d0 * 2) = *(const u32x4*)(KC + (size_t)(t0 + s) * 512 + h * 128 + d0);
    }
    stage_T<4>(P + p_off<3072, 4, 256>(t0, h, 0), 256, VTe, wave, lane);
    for (int i = tid; i < 1024; i += NTHREADS) { const int r = i >> 6, w = i & 63; *(LAS unsigned*)(VTe + (256 + r) * 272 + w * 4) = 0x3F803F80u; }
    bf16x8 qf[4];
#pragma unroll
    for (int kk = 0; kk < 4; ++kk) qf[kk] = *(const bf16x8*)(QC + (size_t)(t0 + 16 * wave + fr) * 512 + h * 128 + 32 * kk + 8 * fq);
    __syncthreads();
    const int t = 16 * wave + fr; const float Mt = Mv[t];
    const int stmax = wave | 1;
    for (int st = 0; st <= stmax; ++st) {
        f32x4 s4 = {0.f, 0.f, 0.f, 0.f};
#pragma unroll
        for (int kk = 0; kk < 4; ++kk) { const bf16x8 kf = ld_frag_lds(Kl + (16 * st + fr) * 272 + (32 * kk + 8 * fq) * 2); s4 = MFMA16(kf, qf[kk], s4); }
#pragma unroll
        for (int r = 0; r < 4; ++r) { const int s = 16 * st + 4 * fq + r; const float w = (s <= t) ? __expf(av[s] - Mt) : 0.f; s4[r] *= w; }
        u32x2 w; w.x = cvt_pk_bf16(s4[0], s4[1]); w.y = cvt_pk_bf16(s4[2], s4[3]);
        *(LAS u32x2*)(Sl + t * 272 + (16 * st + 4 * fq) * 2) = w;
    }
    __syncthreads();
    const bf16_t* cpt = (const bf16_t*)(p.ws + WS_CPT) + ((size_t)(bh * 64 + c) * 272) * 128;
    f32x4 acc[17];
#pragma unroll
    for (int n = 0; n < 17; ++n) acc[n] = (f32x4){0.f, 0.f, 0.f, 0.f};
#pragma unroll
    for (int half = 0; half < 2; ++half) {
        if (half) __syncthreads();
#pragma unroll 1
        for (int it = 0; it < 4; it += 2) {
            const int e = (it * NTHREADS + tid) * 8, r = e >> 7, d0 = e & 127;
            const u32x4 c0_ = *(const u32x4*)(cpt + (size_t)(128 * half + r) * 128 + d0), c1_ = *(const u32x4*)(cpt + (size_t)(128 * half + r + 32) * 128 + d0);
            *(LAS u32x4*)(Kl + (r + 32) * 272 + d0 * 2) = c1_;
            *(LAS u32x4*)(Kl + r * 272 + d0 * 2) = c0_;
        }
        __syncthreads();
#pragma unroll
        for (int n8 = 0; n8 < 8; ++n8) {
#pragma unroll
            for (int kk = 0; kk < 4; ++kk) { const bf16x8 cf = ld_frag_lds(Kl + (16 * n8 + fr) * 272 + (32 * kk + 8 * fq) * 2); acc[8 * half + n8] = MFMA16(cf, qf[kk], acc[8 * half + n8]); }
        }
    }
#pragma unroll
    for (int kk = 0; kk < 4; ++kk) { const bf16x8 cf = *(const bf16x8*)(cpt + (size_t)(256 + fr) * 128 + 32 * kk + 8 * fq); acc[16] = MFMA16(cf, qf[kk], acc[16]); }
    const float ai = __expf(mprev - Mt);
#pragma unroll
    for (int n = 0; n < 17; ++n) acc[n] = acc[n] * ai;
    const int k2max = (16 * wave + 15) >> 5;
#pragma unroll
    for (int kk = 0; kk < 4; ++kk) {
        if (kk <= k2max) {
            const bf16x8 sf = ld_frag_lds(Sl + t * 272 + (32 * kk + 8 * fq) * 2);
#pragma unroll
            for (int n = 0; n < 17; ++n) { const bf16x8 vf = ld_frag_lds(VTe + (16 * n + fr) * 272 + (32 * kk + 8 * fq) * 2); acc[n] = MFMA16(vf, sf, acc[n]); }
        }
    }
    const float den = __shfl(acc[16][0], fr);
    const float mt = bv[t] + Mt;
    const float inv = rcpf_(fmaxf(fabsf(den), __expf(-mt)));
    const size_t grow = (size_t)(t0 + t);
    float ss = 0.f;
#pragma unroll
    for (int n = 0; n < 16; ++n) {
        const int v0 = 16 * n + 4 * fq;
        const u32x2 ow = *(const u32x2*)(P + p_off<4096, 4, 256>(t0 + t, h, v0));
        f32x4 y;
        y[0] = bflo(ow.x) * acc[n][0] * inv; y[1] = bfhi(ow.x) * acc[n][1] * inv; y[2] = bflo(ow.y) * acc[n][2] * inv; y[3] = bfhi(ow.y) * acc[n][3] * inv;
        ss += (y[0] * y[0] + y[1] * y[1]) + (y[2] * y[2] + y[3] * y[3]);
        acc[n] = y;
    }
    ss += __shfl_xor(ss, 16); ss += __shfl_xor(ss, 32);
    const float rstd = rsqrtf(ss * (1.f / 256.f) + EPS);
#pragma unroll
    for (int n = 0; n < 16; ++n) {
        const int v0 = 16 * n + 4 * fq;
        const f32x4 g = *(const f32x4*)(p.ml_out_g + h * 256 + v0);
        const f32x4 o = acc[n] * rstd * g;
        u32x2 w; w.x = cvt_pk_bf16(o[0], o[1]); w.y = cvt_pk_bf16(o[2], o[3]);
        *(u32x2*)(YM + grow * DM + 1024 + h * 256 + v0) = w;
    }
}

DI unsigned ord_key(float f) { const unsigned u = __float_as_uint(f); return (u & 0x80000000u) ? ~u : (u | 0x80000000u); }
DI float key_val(unsigned k) { return (k & 0x80000000u) ? __uint_as_float(k & 0x7fffffffu) : __uint_as_float(~k); }
DI unsigned umax_(unsigned a, unsigned b) { return a > b ? a : b; }
DI unsigned umin_(unsigned a, unsigned b) { return a < b ? a : b; }
#define DPPU(v, ctrl) ((unsigned)__builtin_amdgcn_update_dpp(0, (int)(v), (ctrl), 0xF, 0xF, true))
DI unsigned row_max_u32(unsigned v) {
    v = umax_(v, DPPU(v, 0xB1)); v = umax_(v, DPPU(v, 0x4E)); v = umax_(v, DPPU(v, 0x141)); v = umax_(v, DPPU(v, 0x140)); return v;
}
DI float row_sum_f32(float v) {
    v += __uint_as_float(DPPU(__float_as_uint(v), 0xB1)); v += __uint_as_float(DPPU(__float_as_uint(v), 0x4E));
    v += __uint_as_float(DPPU(__float_as_uint(v), 0x141)); v += __uint_as_float(DPPU(__float_as_uint(v), 0x140)); return v;
}
#define CEX(a, b) do { const unsigned mx_ = umax_(a, b), mn_ = umin_(a, b); a = mx_; b = mn_; } while (0)
template <int N> DI unsigned top16_row(unsigned (&s)[N], int c) {
    unsigned list = 0u;
#pragma unroll 1
    for (int it = 0; it < 16; ++it) {
        const unsigned wm = row_max_u32(s[0]);
        const bool win = (s[0] == wm);
#pragma unroll
        for (int i = 0; i < N - 1; ++i) s[i] = win ? s[i + 1] : s[i];
        s[N - 1] = win ? 0u : s[N - 1];
        list = (c == it) ? wm : list;
    }
    return list;
}

template <int N> DI void top16_row2(unsigned (&s)[N], unsigned (&t)[N], int c, unsigned& l1, unsigned& l2) {
    l1 = 0u; l2 = 0u;
#pragma unroll 1
    for (int it = 0; it < 16; ++it) {
        const unsigned wm1 = row_max_u32(s[0]), wm2 = row_max_u32(t[0]);
        const bool win1 = (s[0] == wm1), win2 = (t[0] == wm2);
#pragma unroll
        for (int i = 0; i < N - 1; ++i) { s[i] = win1 ? s[i + 1] : s[i]; t[i] = win2 ? t[i + 1] : t[i]; }
        s[N - 1] = win1 ? 0u : s[N - 1]; t[N - 1] = win2 ? 0u : t[N - 1];
        l1 = (c == it) ? wm1 : l1; l2 = (c == it) ? wm2 : l2;
    }
}

template <int N> DI void top16_row4(unsigned (&s)[N], unsigned (&t)[N], unsigned (&u)[N], unsigned (&v)[N], int c, unsigned& l1, unsigned& l2, unsigned& l3, unsigned& l4) {
    l1 = 0u; l2 = 0u; l3 = 0u; l4 = 0u;
#pragma unroll 1
    for (int it = 0; it < 16; ++it) {
        const unsigned wm1 = row_max_u32(s[0]), wm2 = row_max_u32(t[0]), wm3 = row_max_u32(u[0]), wm4 = row_max_u32(v[0]);
        const bool win1 = (s[0] == wm1), win2 = (t[0] == wm2), win3 = (u[0] == wm3), win4 = (v[0] == wm4);
#pragma unroll
        for (int i = 0; i < N - 1; ++i) { s[i] = win1 ? s[i + 1] : s[i]; t[i] = win2 ? t[i + 1] : t[i]; u[i] = win3 ? u[i + 1] : u[i]; v[i] = win4 ? v[i + 1] : v[i]; }
        s[N - 1] = win1 ? 0u : s[N - 1]; t[N - 1] = win2 ? 0u : t[N - 1]; u[N - 1] = win3 ? 0u : u[N - 1]; v[N - 1] = win4 ? 0u : v[N - 1];
        l1 = (c == it) ? wm1 : l1; l2 = (c == it) ? wm2 : l2; l3 = (c == it) ? wm3 : l3; l4 = (c == it) ? wm4 : l4;
    }
}
#define SORT8(s) do { CEX(s[0], s[1]); CEX(s[2], s[3]); CEX(s[4], s[5]); CEX(s[6], s[7]); CEX(s[0], s[2]); CEX(s[1], s[3]); CEX(s[4], s[6]); CEX(s[5], s[7]); CEX(s[1], s[2]); CEX(s[5], s[6]); \
    CEX(s[0], s[4]); CEX(s[1], s[5]); CEX(s[2], s[6]); CEX(s[3], s[7]); CEX(s[2], s[4]); CEX(s[3], s[5]); CEX(s[1], s[2]); CEX(s[3], s[4]); CEX(s[5], s[6]); } while (0)
#define SORT4(s) do { CEX(s[0], s[1]); CEX(s[2], s[3]); CEX(s[0], s[2]); CEX(s[1], s[3]); CEX(s[1], s[2]); } while (0)

DI void peer_select(const Params& p, LAS unsigned char* lds) {
    const int tid = threadIdx.x, lane = tid & 63, wave = __builtin_amdgcn_readfirstlane(tid >> 6), c = lane & 15, g = lane >> 4, rowbase = lane & 48;
    const bf16_t* Q = (const bf16_t*)(p.ws + WS_Q); const bf16_t* KB1 = (const bf16_t*)(p.ws + WS_KB1); const bf16_t* KB2 = (const bf16_t*)(p.ws + WS_KB2);
    int* SELID = (int*)(p.ws + WS_SELID); float* SELG = (float*)(p.ws + WS_SELG);
    unsigned pk = 0u, validmask = 0u;
#pragma unroll
    for (int q = 0; q < 4; ++q) {
        const int target = 4 * c + q; int ci = 0, cj = 0, cnt = 0; bool v = false;
#pragma unroll
        for (int i = 0; i < 16; ++i) { const int nj = 16 / (i + 1); if (target >= cnt && target < cnt + nj) { ci = i; cj = target - cnt; v = true; } cnt += nj; }
        pk |= (unsigned)((ci << 4) | cj) << (8 * q); validmask |= (v ? 1u : 0u) << q;
    }
    for (int tile = blockIdx.x * 8 + wave; tile < T_TOK / 16; tile += gridDim.x * 8) {
        const int tok0 = tile * 16;
        for (int h = 0; h < 8; ++h) {
            __syncthreads();
            int tl = tid; asm volatile("" : "+v"(tl));
#pragma unroll
            for (int it = 0; it < 4; ++it) {
                const int idx = it * NTHREADS + tl, which = idx >> 10, r = (idx & 1023) >> 3, q = idx & 7;
                *(LAS u32x4*)(lds + which * 18432 + r * 144 + q * 16) = *(const u32x4*)((which ? KB2 : KB1) + ((size_t)(h * 128 + r)) * 64 + q * 8);
            }
            bf16x8 a1[2], a2[2];
            {
                const bf16_t* qp = Q + (size_t)(tok0 + c) * 1024 + h * 128 + g * 8;
                a1[0] = *(const bf16x8*)qp; a1[1] = *(const bf16x8*)(qp + 32); a2[0] = *(const bf16x8*)(qp + 64); a2[1] = *(const bf16x8*)(qp + 96);
            }
            __syncthreads();
            f32x4 acc1[8], acc2[8];
#pragma unroll
            for (int nt = 0; nt < 8; ++nt) {
                const LAS unsigned char* kp = lds + (nt * 16 + c) * 144 + g * 16;
                acc1[nt] = (f32x4){0.f, 0.f, 0.f, 0.f}; acc2[nt] = (f32x4){0.f, 0.f, 0.f, 0.f};
                acc1[nt] = MFMA16(a1[0], ld_frag_lds(kp), acc1[nt]); acc1[nt] = MFMA16(a1[1], ld_frag_lds(kp + 64), acc1[nt]);
                acc2[nt] = MFMA16(a2[0], ld_frag_lds(kp + 18432), acc2[nt]); acc2[nt] = MFMA16(a2[1], ld_frag_lds(kp + 18432 + 64), acc2[nt]);
            }
#pragma unroll
            for (int rp = 0; rp < 2; ++rp) {
                const int r0 = 2 * rp, r1 = 2 * rp + 1;
                unsigned sA[8], sB[8], sC[8], sD[8];
#pragma unroll
                for (int nt = 0; nt < 8; ++nt) {
                    const unsigned ix = (unsigned)(127 - (nt * 16 + c));
                    sA[nt] = (ord_key(acc1[nt][r0]) & ~0x7Fu) | ix; sB[nt] = (ord_key(acc2[nt][r0]) & ~0x7Fu) | ix;
                    sC[nt] = (ord_key(acc1[nt][r1]) & ~0x7Fu) | ix; sD[nt] = (ord_key(acc2[nt][r1]) & ~0x7Fu) | ix;
                }
                SORT8(sA); SORT8(sB); SORT8(sC); SORT8(sD);
                unsigned lA, lB, lC, lD;
                top16_row4<8>(sA, sB, sC, sD, c, lA, lB, lC, lD);
                unsigned c0[4], c1[4];
#pragma unroll
                for (int q = 0; q < 4; ++q) {
                    const int ci = (int)((pk >> (8 * q + 4)) & 15u), cj = (int)((pk >> (8 * q)) & 15u);
                    const unsigned ka = (unsigned)__shfl((int)lA, rowbase + ci), kb = (unsigned)__shfl((int)lB, rowbase + cj);
                    const unsigned kc = (unsigned)__shfl((int)lC, rowbase + ci), kd = (unsigned)__shfl((int)lD, rowbase + cj);
                    const float cand0 = key_val(ka & ~0x7Fu) + key_val(kb & ~0x7Fu), cand1 = key_val(kc & ~0x7Fu) + key_val(kd & ~0x7Fu);
                    const bool ok = ((validmask >> q) & 1u) != 0u; const unsigned ix = (unsigned)(63 - (4 * c + q));
                    c0[q] = ok ? ((ord_key(cand0) & ~0x3Fu) | ix) : 0u; c1[q] = ok ? ((ord_key(cand1) & ~0x3Fu) | ix) : 0u;
                }
                SORT4(c0); SORT4(c1);
                unsigned sel0, sel1;
                top16_row2<4>(c0, c1, c, sel0, sel1);
#pragma unroll
                for (int u = 0; u < 2; ++u) {
                    const unsigned sel = u ? sel1 : sel0, list1 = u ? lC : lA, list2 = u ? lD : lB; const int r = u ? r1 : r0;
                    const int slot = 63 - (int)(sel & 63u);
                    const unsigned pkv = (unsigned)__shfl((int)pk, rowbase + (slot >> 2));
                    const int cij = (int)((pkv >> (8 * (slot & 3))) & 0xFFu);
                    const unsigned e1 = (unsigned)__shfl((int)list1, rowbase + (cij >> 4)), e2 = (unsigned)__shfl((int)list2, rowbase + (cij & 15));
                    const int eid = (127 - (int)(e1 & 127u)) * 128 + (127 - (int)(e2 & 127u));
                    const float sv = key_val(sel & ~0x3Fu), mx = key_val(row_max_u32(sel) & ~0x3Fu);
                    const float ev = __expf(sv - mx);
                    const float sum = row_sum_f32(ev);
                    const size_t o = (size_t)(tok0 + 4 * g + r) * 128 + h * 16 + c;
                    SELID[o] = eid; SELG[o] = ev * rcpf_(sum);
                }
            }
        }
    }
}

DI f32x2 pkfma(f32x2 a, f32x2 b, f32x2 c) { return __builtin_elementwise_fma(a, b, c); }
DI void peer_gather(const Params& p, LAS unsigned char* lds) {
    const int tid = threadIdx.x, lane = tid & 63, wave = __builtin_amdgcn_readfirstlane(tid >> 6);
    LAS float* scr = (LAS float*)lds + wave * (16 * 68);
    LAS float* cfl = (LAS float*)(lds + 8 * 16 * 68 * 4) + wave * 128;
    const unsigned char* Ub = p.ws + WS_UB; const unsigned char* Vb = p.ws + WS_VB;
    const float* PSS2 = (const float*)(p.ws + WS_PSS2);
    const int* SELID = (const int*)(p.ws + WS_SELID); const float* SELG = (const float*)(p.ws + WS_SELG);
    const int gw = blockIdx.x * 8 + wave, nw = gridDim.x * 8;
    for (int t = gw; t < T_TOK; t += nw) {
        const int idA = SELID[(size_t)t * 128 + lane], idB = SELID[(size_t)t * 128 + 64 + lane];
        const float gA = SELG[(size_t)t * 128 + lane], gB = SELG[(size_t)t * 128 + 64 + lane];
        const bf16_t* xrow = (const bf16_t*)(p.ws + WS_X1G) + (size_t)t * DM + lane * 32;
        float* orow = p.out + (size_t)t * DM + lane * 32;
        const float pv = lane < 32 ? PSS2[(size_t)t * 32 + lane] : 0.f;
        const float rstd2 = rsqrtf(wave_sum(pv) * (1.f / 2048.f) + EPS);
        f32x2 h2[16];
#pragma unroll
        for (int q = 0; q < 4; ++q) {
            const u32x4 xw = *(const u32x4*)(xrow + q * 8);
            const f32x4 g0 = *(const f32x4*)(p.norm2_g + lane * 32 + q * 8), g1 = *(const f32x4*)(p.norm2_g + lane * 32 + q * 8 + 4);
            h2[4 * q] = (f32x2){bflo(xw.x) * rstd2 * g0[0], bfhi(xw.x) * rstd2 * g0[1]};
            h2[4 * q + 1] = (f32x2){bflo(xw.y) * rstd2 * g0[2], bfhi(xw.y) * rstd2 * g0[3]};
            h2[4 * q + 2] = (f32x2){bflo(xw.z) * rstd2 * g1[0], bfhi(xw.z) * rstd2 * g1[1]};
            h2[4 * q + 3] = (f32x2){bflo(xw.w) * rstd2 * g1[2], bfhi(xw.w) * rstd2 * g1[3]};
        }
        constexpr int NPK = 8;
        u32x4 buf[2][NPK]; unsigned short bsc[2][NPK];
#define PEER_LOAD(TB, st, base) do { const int idv_ = ((base) < 64) ? idA : idB; _Pragma("unroll") for (int e_ = 0; e_ < NPK; ++e_) { \
            const int id_ = __builtin_amdgcn_readlane(idv_, ((base) + e_) & 63); const unsigned char* r_ = (TB) + (size_t)id_ * 1088; \
            buf[st][e_] = *(const u32x4*)(r_ + lane * 16); bsc[st][e_] = *(const unsigned short*)(r_ + 1024 + (lane >> 1) * 2); } } while (0)
#define PEER_DOT(st, slot0) do { _Pragma("unroll") for (int e_ = 0; e_ < NPK; ++e_) { f32x2 a2_ = {0.f, 0.f}; \
            _Pragma("unroll") for (int d_ = 0; d_ < 4; ++d_) { const unsigned w_ = buf[st][e_][d_]; \
                a2_ = pkfma(h2[d_ * 4 + 0], __builtin_amdgcn_cvt_scalef32_pk_f32_fp4(w_, 1.0f, 0), a2_); a2_ = pkfma(h2[d_ * 4 + 1], __builtin_amdgcn_cvt_scalef32_pk_f32_fp4(w_, 1.0f, 1), a2_); \
                a2_ = pkfma(h2[d_ * 4 + 2], __builtin_amdgcn_cvt_scalef32_pk_f32_fp4(w_, 1.0f, 2), a2_); a2_ = pkfma(h2[d_ * 4 + 3], __builtin_amdgcn_cvt_scalef32_pk_f32_fp4(w_, 1.0f, 3), a2_); } \
            scr[((slot0) + e_) * 68 + lane] = (a2_[0] + a2_[1]) * bf2f(bsc[st][e_]); } } while (0)
        PEER_LOAD(Ub, 0, 0);
        for (int b = 0; b < 128 / NPK; b += 2) {
            PEER_LOAD(Ub, 1, (b + 1) * NPK);
            PEER_DOT(0, (b * NPK) & 15);
            if (b + 2 < 128 / NPK) PEER_LOAD(Ub, 0, (b + 2) * NPK);
            PEER_DOT(1, ((b + 1) * NPK) & 15);
            if ((((b + 2) * NPK) & 15) == 0) {
                WAVE_LDS_SYNC();
                float sum = 0.f;
#pragma unroll
                for (int i = 0; i < 4; ++i) { const f32x4 r = *(const LAS f32x4*)(scr + (lane >> 2) * 68 + (lane & 3) * 16 + 4 * i); sum += (r[0] + r[1]) + (r[2] + r[3]); }
                sum += __shfl_xor(sum, 1); sum += __shfl_xor(sum, 2);
                const int k0 = (b + 2) * NPK - 16;
                const int k = k0 + (lane >> 2);
                const float gate = __shfl((k0 < 64) ? gA : gB, k & 63);
                if ((lane & 3) == 0) cfl[k] = gate * gelu_t(sum);
                WAVE_LDS_SYNC();
            }
        }
        f32x2 acc[16];
#pragma unroll
        for (int i = 0; i < 16; ++i) acc[i] = (f32x2){0.f, 0.f};
#define PEER_AXPY(st, base) do { _Pragma("unroll") for (int e_ = 0; e_ < NPK; ++e_) { const float c_ = cfl[(base) + e_] * bf2f(bsc[st][e_]); const f32x2 c2_ = {c_, c_}; \
            _Pragma("unroll") for (int d_ = 0; d_ < 4; ++d_) { const unsigned w_ = buf[st][e_][d_]; \
                acc[d_ * 4 + 0] = pkfma(c2_, __builtin_amdgcn_cvt_scalef32_pk_f32_fp4(w_, 1.0f, 0), acc[d_ * 4 + 0]); acc[d_ * 4 + 1] = pkfma(c2_, __builtin_amdgcn_cvt_scalef32_pk_f32_fp4(w_, 1.0f, 1), acc[d_ * 4 + 1]); \
                acc[d_ * 4 + 2] = pkfma(c2_, __builtin_amdgcn_cvt_scalef32_pk_f32_fp4(w_, 1.0f, 2), acc[d_ * 4 + 2]); acc[d_ * 4 + 3] = pkfma(c2_, __builtin_amdgcn_cvt_scalef32_pk_f32_fp4(w_, 1.0f, 3), acc[d_ * 4 + 3]); } } } while (0)
        PEER_LOAD(Vb, 0, 0);
        for (int b = 0; b < 128 / NPK; b += 2) {
            PEER_LOAD(Vb, 1, (b + 1) * NPK);
            PEER_AXPY(0, b * NPK);
            if (b + 2 < 128 / NPK) PEER_LOAD(Vb, 0, (b + 2) * NPK);
            PEER_AXPY(1, (b + 1) * NPK);
        }
        float ss = 0.f;
#pragma unroll
        for (int q = 0; q < 4; ++q) {
            const u32x4 xw = *(const u32x4*)(xrow + q * 8);
            acc[4 * q] += (f32x2){bflo(xw.x), bfhi(xw.x)}; acc[4 * q + 1] += (f32x2){bflo(xw.y), bfhi(xw.y)};
            acc[4 * q + 2] += (f32x2){bflo(xw.z), bfhi(xw.z)}; acc[4 * q + 3] += (f32x2){bflo(xw.w), bfhi(xw.w)};
#pragma unroll
            for (int i = 0; i < 4; ++i) { const f32x2 a = acc[4 * q + i]; ss += a[0] * a[0] + a[1] * a[1]; }
        }
        const float rstd = rsqrtf(wave_sum(ss) * (1.f / 2048.f) + EPS);
#pragma unroll
        for (int q = 0; q < 8; ++q) {
            const f32x4 g0 = *(const f32x4*)(p.final_g + lane * 32 + q * 4);
            const f32x2 a = acc[2 * q], b = acc[2 * q + 1];
            const f32x4 o0 = {a[0] * rstd * g0[0], a[1] * rstd * g0[1], b[0] * rstd * g0[2], b[1] * rstd * g0[3]};
            *(f32x4*)(orow + q * 4) = o0;
        }
        WAVE_LDS_SYNC();
    }
}

#define XB_TMO      128
#define XB_XCNT(j)  (256  + 64 * (j))
#define XB_XSUB(j)  (1280 + 64 * (j))
#define XB_XGEN(j)  (2304 + 64 * (j))
#define XB_TOP      3328
#define XB_TOPGEN   3392
#define XCD_BAR_WORDS 3456
#define XB_SPIN_CAP (1u << 18)

__device__ __forceinline__ unsigned xb_ld(unsigned* p)              { return __hip_atomic_load(p, __ATOMIC_RELAXED, __HIP_MEMORY_SCOPE_AGENT); }
__device__ __forceinline__ unsigned xb_add(unsigned* p, unsigned v) { return __hip_atomic_fetch_add(p, v, __ATOMIC_RELAXED, __HIP_MEMORY_SCOPE_AGENT); }
__device__ __forceinline__ unsigned xb_xcc_id() { return (unsigned)__builtin_amdgcn_s_getreg((3 << 11) | 20) & 0xFu; }
#define XB_SPIN(cond, bar) do { unsigned _sp = 0; while (cond) { __builtin_amdgcn_s_sleep(1); \
    if ((++_sp & 255u) == 0u) { if (xb_ld(&(bar)[XB_TMO])) break; if (_sp > XB_SPIN_CAP) { atomicAdd(&(bar)[XB_TMO], 1u); break; } } } } while (0)

struct XcdBarrier {
    unsigned* bar; unsigned x;
    volatile LAS unsigned* st;
};

__device__ __forceinline__ XcdBarrier xcd_barrier_post(unsigned* bar, volatile LAS unsigned* st) {
    XcdBarrier b; b.bar = bar; b.x = xb_xcc_id(); b.st = st;
    if (threadIdx.x == 0) (void)xb_add(&bar[XB_XCNT(b.x)], 1u);
    return b;
}
__device__ __forceinline__ void xcd_barrier_complete(unsigned* bar, unsigned x, unsigned& nloc, unsigned& nx) {
    const unsigned G = gridDim.x * gridDim.y * gridDim.z;
    unsigned sum, cnt, mine, sp = 0u;
    for (;;) {
        sum = 0u; cnt = 0u; mine = 0u;
#pragma unroll
        for (unsigned j = 0; j < 16; ++j) { const unsigned c = xb_ld(&bar[XB_XCNT(j)]); sum += c; cnt += (c > 0u) ? 1u : 0u; mine = (j == x) ? c : mine; }
        if (sum == G) break;
        __builtin_amdgcn_s_sleep(1);
        if ((++sp & 255u) == 0u) { if (xb_ld(&bar[XB_TMO])) break; if (sp > XB_SPIN_CAP) { atomicAdd(&bar[XB_TMO], 1u); break; } }
    }
    nloc = mine > 0u ? mine : 1u; nx = cnt > 0u ? cnt : 1u;
}

__device__ __forceinline__ void xcd_barrier(const XcdBarrier& b) {
    asm volatile("s_waitcnt vmcnt(0)" ::: "memory");
    __syncthreads();
    if (threadIdx.x == 0) {
        unsigned* bar = b.bar;
        __builtin_amdgcn_s_waitcnt(0);
        unsigned nloc = b.st[0], nx = b.st[1];
        if (nloc == 0u) { xcd_barrier_complete(bar, b.x, nloc, nx); b.st[0] = nloc; b.st[1] = nx; }
        const unsigned old = xb_add(&bar[XB_XSUB(b.x)], 1u);
        const unsigned gen = old / nloc;
        if (old + 1u == (gen + 1u) * nloc) {
            __builtin_amdgcn_fence(__ATOMIC_RELEASE, "agent");
            asm volatile("s_waitcnt vmcnt(0)" ::: "memory");
            const unsigned og = xb_add(&bar[XB_TOP], 1u);
            const unsigned tg = og / nx;
            if (og + 1u == (tg + 1u) * nx) xb_add(&bar[XB_TOPGEN], 1u);
            else XB_SPIN(xb_ld(&bar[XB_TOPGEN]) == tg, bar);
            __builtin_amdgcn_fence(__ATOMIC_ACQUIRE, "agent");
            xb_add(&bar[XB_XGEN(b.x)], 1u);
            asm volatile("s_waitcnt vmcnt(0)" ::: "memory");
        } else {
            XB_SPIN(xb_ld(&bar[XB_XGEN(b.x)]) == gen, bar);
            __builtin_amdgcn_fence(__ATOMIC_ACQUIRE, "agent");
            asm volatile("s_waitcnt vmcnt(0)" ::: "memory");
        }
    }
    __syncthreads();
}

#ifndef PROBE_DUP
#define PROBE_DUP 0
#endif
#define REP(bit) for (int rep_ = 0; rep_ < (((PROBE_DUP) >> (bit)) & 1) + 1; ++rep_)
#define PH1() { pg8::Gemm g{(const bf16_t*)(p.ws + WS_XN), (const bf16_t*)(p.ws + WS_WINT), T_TOK, NPROJ, DM}; pg8::StaticOrder S; S.init(T_TOK, NPROJ, G, bx); Epi1 E{(bf16_t*)(p.ws + WS_P), (float*)(p.ws + WS_PSSV)}; pg8::gemm_phase<Epi1, pg8::StaticOrder, true, true>(lds, g, S, E); xcd_barrier(xbar); }
#define PH3() { pg8::Gemm g{(const bf16_t*)(p.ws + WS_XN), (const bf16_t*)(p.ws + WS_WOUTT), T_TOK, DM, DM}; pg8::StaticOrder S; S.init(T_TOK, DM, G, bx); Epi2 E{p.x, (bf16_t*)(p.ws + WS_X1G), (float*)(p.ws + WS_PSS2)}; pg8::gemm_phase<Epi2, pg8::StaticOrder, true, true>(lds, g, S, E); xcd_barrier(xbar); }
#define PH4() { pg8::Gemm g{(const bf16_t*)(p.ws + WS_X1G), (const bf16_t*)(p.ws + WS_WQT), T_TOK, 1024, DM}; pg8::StaticOrder S; S.init(T_TOK, 1024, G, bx); Epi3 E{(bf16_t*)(p.ws + WS_Q), (const float*)(p.ws + WS_PSS2)}; pg8::gemm_phase<Epi3, pg8::StaticOrder, true, true>(lds, g, S, E); xcd_barrier(xbar); }
__global__ void __launch_bounds__(NTHREADS, 2) hymba_fwd(Params p) {
    extern __shared__ __attribute__((aligned(16))) unsigned char smem[];
    LAS unsigned char* lds = (LAS unsigned char*)smem;
    cg::grid_group grid = cg::this_grid();
    const int G = gridDim.x, bx = blockIdx.x;
    unsigned* barw = (unsigned*)(p.ws + WS_BAR);
    volatile LAS unsigned* xst = (volatile LAS unsigned*)(lds + LDS_BYTES - 16);
    if (threadIdx.x < 4) xst[threadIdx.x] = 0u;
    if (bx == 0) { for (int i = threadIdx.x; i < XCD_BAR_WORDS; i += NTHREADS) barw[i] = 0u; }
    __syncthreads();
    REP(0) { phase0(p, lds); grid.sync(); }
    const XcdBarrier xbar = xcd_barrier_post(barw, xst);
    PH1()
#if (PROBE_DUP >> 1) & 1
    PH1()
#endif
    REP(2) {
        for (int si = bx; si < 256; si += G) {
            const int b = si >> 6, c = si & 63;
            gmlp_bc(p, lds, b, c);
            for (int h = 0; h < 4; ++h) mlstm_local(p, lds, b, c, h);
        }
        xcd_barrier(xbar);
    }
    REP(3) { phase_scan(p); xcd_barrier(xbar); }
    REP(4) { for (int it = bx; it < 1024; it += G) mlstm_out(p, lds, it >> 8, (it >> 2) & 63, it & 3); xcd_barrier(xbar); }
    PH3()
#if (PROBE_DUP >> 5) & 1
    PH3()
#endif
    PH4()
#if (PROBE_DUP >> 6) & 1
    PH4()
#endif
    REP(7) { peer_select(p, lds); xcd_barrier(xbar); }
    peer_gather(p, lds);
}

extern "C" void kernel_launch(void* const* d_in, const int* in_sizes, int n_in, void* d_out, int out_size, void* d_ws, size_t ws_size, hipStream_t stream) {
    static int grid_blocks = 0;
    if (grid_blocks == 0) {
        if (n_in != 20 || ws_size < WS_END) { fprintf(stderr, "kernel_launch: unexpected n_in %d or ws_size %zu (need %zu)\n", n_in, ws_size, (size_t)WS_END); grid_blocks = -1; return; }
        int dev = 0, cus = 0, per_cu = 0;
        hipGetDevice(&dev);
        hipDeviceGetAttribute(&cus, hipDeviceAttributeMultiprocessorCount, dev);
        hipFuncSetAttribute((const void*)hymba_fwd, hipFuncAttributeMaxDynamicSharedMemorySize, LDS_BYTES);
        hipOccupancyMaxActiveBlocksPerMultiprocessor(&per_cu, (const void*)hymba_fwd, NTHREADS, LDS_BYTES);
        if (per_cu < 1) { fprintf(stderr, "kernel_launch: occupancy query says %d blocks per CU\n", per_cu); per_cu = 1; }
        if (per_cu > 1) per_cu = 1;
        grid_blocks = cus * per_cu;
        (void)hipGetLastError();
    }
    if (grid_blocks < 0) return;
    Params p{};
    p.x = (const float*)d_in[0]; p.norm1_g = (const float*)d_in[1]; p.w_in = (const float*)d_in[2]; p.gm_vnorm_g = (const float*)d_in[3];
    p.w_spatial = (const float*)d_in[4]; p.b_spatial = (const float*)d_in[5]; p.ml_conv_w = (const float*)d_in[6]; p.ml_conv_b = (const float*)d_in[7];
    p.ml_b_i = (const float*)d_in[8]; p.ml_b_f = (const float*)d_in[9]; p.gm_out_g = (const float*)d_in[10]; p.ml_out_g = (const float*)d_in[11];
    p.w_out = (const float*)d_in[12]; p.norm2_g = (const float*)d_in[13]; p.peer_wq = (const float*)d_in[14]; p.peer_k1 = (const float*)d_in[15];
    p.peer_k2 = (const float*)d_in[16]; p.peer_u = (const float*)d_in[17]; p.peer_v = (const float*)d_in[18]; p.final_g = (const float*)d_in[19];
    p.out = (float*)d_out; p.ws = (unsigned char*)d_ws;
    void* args[] = {&p};
    hipError_t e = hipLaunchCooperativeKernel((const void*)hymba_fwd, dim3(grid_blocks), dim3(NTHREADS), args, LDS_BYTES, stream);
    if (e != hipSuccess) fprintf(stderr, "cooperative launch failed: %s (grid %d)\n", hipGetErrorString(e), grid_blocks);
}
```

```cpp
#include <hip/hip_runtime.h>
#include <hip/hip_cooperative_groups.h>
#include <cstdio>
#include <cstdint>
namespace cg = cooperative_groups;
namespace pg8 {
#define PG8_LAS __attribute__((address_space(3)))
typedef unsigned short bf16_t;
typedef short bf16x8 __attribute__((ext_vector_type(8)));
typedef float f32x4 __attribute__((ext_vector_type(4)));
typedef unsigned u32x4 __attribute__((ext_vector_type(4)));
constexpr int BM = 256, BK = 64, HALF = 128, HTB = HALF * BK * 2  , STAGE_BYTES = 8 * HTB, NXCD = 8, WGM = 8;

__host__ __device__ __forceinline__ int lds_byte(int r, int c) { const int st = (r >> 4) * 2 + (c >> 5), rr = r & 15, cc = c & 31, ob = rr * 64 + cc * 2; return st * 1024 + (ob ^ (((ob >> 9) & 1) << 5)); }
__host__ __device__ __forceinline__ void stage_rc(int b, int& R, int& C) { const int st = b / 1024, sb = b % 1024, swz = sb ^ (((sb >> 9) & 1) << 5); R = (st >> 1) * 16 + swz / 64; C = (st & 1) * 32 + (swz % 64) / 2; }
__host__ __device__ __forceinline__ int perm32(int rho) { const int n = rho >> 4, i = rho & 15; return 8 * (i >> 2) + 4 * n + (i & 3); }

struct Unit { int pm, pn; };
struct Gemm { const bf16_t* A; const bf16_t* Bt; int M, N, K; };

struct StaticOrder {
    int nM, nN, nwg, G, c;
    __host__ __device__ void init(int M, int N, int G_, int c_) { nM = M / BM; nN = N / BM; nwg = nM * nN; G = G_; c = c_; }
    __host__ __device__ bool next(int i, Unit& u) const {
        const long L = (long)i * G + c; if (L >= nwg) return false;
        int wgid = (int)L; { const int q = nwg / NXCD, r = nwg % NXCD, xcd = wgid % NXCD, off = wgid / NXCD; wgid = (xcd < r ? xcd * (q + 1) : r * (q + 1) + (xcd - r) * q) + off; }
        const int nig = WGM * nN, gid = wgid / nig, fm = gid * WGM, gsz = (nM - fm) < WGM ? (nM - fm) : WGM;
        u.pm = fm + ((wgid % nig) % gsz); u.pn = (wgid % nig) / gsz; return true;
    }
    __device__ __forceinline__ void a_ready(const Unit&) const {}
    __device__ __forceinline__ void done(const Unit&) const {}
};
__device__ __forceinline__ unsigned cvt_pk_bf16(float lo, float hi) { unsigned r; asm volatile("v_cvt_pk_bf16_f32 %0, %1, %2" : "=v"(r) : "v"(lo), "v"(hi)); return r; }
template <class Epi, class Sched, bool ALIGN_EPI = false, bool SP2 = false>
__device__ __forceinline__ void gemm_phase(PG8_LAS unsigned char* lds, const Gemm g, const Sched& S, const Epi& E) {
    const int tid = threadIdx.x, wid = __builtin_amdgcn_readfirstlane(tid >> 6), lane = tid & 63, wr = wid >> 2, wc = wid & 3, fr = lane & 15, fq = lane >> 4;
    const int K = g.K, nt = K / BK;
    unsigned voffA[2], voffB[2];
#pragma unroll
    for (int i = 0; i < 2; ++i) { int R, C; stage_rc(tid * 16 + i * 8192, R, C); const int Rb = Epi::PERM ? ((R & ~31) + perm32(R & 31)) : R;
        voffA[i] = (unsigned)(R * K + C) * 2u; voffB[i] = (unsigned)(Rb * K + C) * 2u; }
    const size_t kstep = (size_t)(BK * 2);
    const size_t hstep = (size_t)HALF * K * 2;
    const size_t tstep = 2 * hstep;
    const unsigned ldsw = (unsigned)wid * 1024u;
    const int aoff = lds_byte(wr * 64 + fr, fq * 8), boff = lds_byte(wc * 32 + fr, fq * 8);
#define PG8_SA(b, h) (((b) * 2 + (h)) * HTB)
#define PG8_SB(b, h) ((4 + (b) * 2 + (h)) * HTB)
#define PG8_STAGE(bufoff, gbase, voff) do { _Pragma("unroll") for (int _i = 0; _i < 2; ++_i) \
        __builtin_amdgcn_global_load_lds((const unsigned*)((const char*)(gbase) + (voff)[_i]), (PG8_LAS unsigned*)(lds + (bufoff) + ldsw + _i * 8192), 16, 0, 0); } while (0)
#define PG8_LDA(dst, b, h) do { _Pragma("unroll") for (int m = 0; m < 4; ++m) _Pragma("unroll") for (int k = 0; k < 2; ++k) dst[m][k] = *(const PG8_LAS bf16x8*)(lds + PG8_SA(b, h) + aoff + m * 2048 + k * 1024); } while (0)
#define PG8_LDB(dst, b, h) do { _Pragma("unroll") for (int n = 0; n < 2; ++n) _Pragma("unroll") for (int k = 0; k < 2; ++k) dst[n][k] = *(const PG8_LAS bf16x8*)(lds + PG8_SB(b, h) + boff + n * 2048 + k * 1024); } while (0)
#define PG8_MMA(ai, bj, At, Bt) do { __builtin_amdgcn_s_setprio(1); _Pragma("unroll") for (int m = 0; m < 4; ++m) _Pragma("unroll") for (int n = 0; n < 2; ++n) _Pragma("unroll") for (int k = 0; k < 2; ++k) \
        acc[ai][bj][m][n] = __builtin_amdgcn_mfma_f32_16x16x32_bf16(Bt[n][k], At[m][k], acc[ai][bj][m][n], 0, 0, 0); __builtin_amdgcn_s_setprio(0); } while (0)
#define PG8_WAIT_V(n) asm volatile("s_waitcnt vmcnt(" #n ")" ::: "memory")
#define PG8_WAIT_L(n) asm volatile("s_waitcnt lgkmcnt(" #n ")" ::: "memory")
#define PG8_BAR __builtin_amdgcn_s_barrier()
#define PG8_SCHED __builtin_amdgcn_sched_barrier(0)
    Unit cur, nxt; int ui = 0;
    if (!S.next(0, cur)) return;
    f32x4 acc[2][2][4][2];
#pragma unroll
    for (int a = 0; a < 2; ++a)
#pragma unroll
        for (int b = 0; b < 2; ++b)
#pragma unroll
            for (int m = 0; m < 4; ++m)
#pragma unroll
                for (int n = 0; n < 2; ++n) acc[a][b][m][n] = (f32x4){0.f, 0.f, 0.f, 0.f};
    bf16x8 At[4][2], B0[2][2], B1[2][2];
    const char* cA = (const char*)g.A + (size_t)cur.pm * tstep; const char* cB = (const char*)g.Bt + (size_t)cur.pn * tstep;
    S.a_ready(cur);
    if constexpr (SP2) {
        PG8_STAGE(PG8_SB(0, 0), cB, voffB); PG8_STAGE(PG8_SB(0, 1), cB + hstep, voffB); PG8_STAGE(PG8_SA(0, 0), cA, voffA); PG8_STAGE(PG8_SA(0, 1), cA + hstep, voffA);
        if (wr == 1) PG8_BAR;
        PG8_WAIT_V(2); PG8_BAR;
        PG8_STAGE(PG8_SB(1, 0), cB + kstep, voffB); PG8_STAGE(PG8_SA(1, 0), cA + kstep, voffA); PG8_STAGE(PG8_SB(1, 1), cB + hstep + kstep, voffB);
        PG8_WAIT_V(6); PG8_BAR;
    } else {
        PG8_STAGE(PG8_SB(0, 0), cB, voffB); PG8_STAGE(PG8_SA(0, 0), cA, voffA); PG8_STAGE(PG8_SB(0, 1), cB + hstep, voffB); PG8_STAGE(PG8_SA(0, 1), cA + hstep, voffA);
        if (wr == 1) PG8_BAR;
        PG8_WAIT_V(4); PG8_BAR;
        PG8_STAGE(PG8_SB(1, 0), cB + kstep, voffB); PG8_STAGE(PG8_SA(1, 0), cA + kstep, voffA); PG8_STAGE(PG8_SB(1, 1), cB + hstep + kstep, voffB);
        PG8_WAIT_V(6); PG8_BAR;
    }
    for (;;) {
        const bool has_next = S.next(ui + 1, nxt);
        const char* nA = has_next ? (const char*)g.A + (size_t)nxt.pm * tstep : cA; const char* nB = has_next ? (const char*)g.Bt + (size_t)nxt.pn * tstep : cB;
        for (int t = 0; t < nt; t += 2) {
            const bool last = (t == nt - 2);
            const char* a1 = cA + (size_t)(t + 1) * kstep;
            const char* a2 = last ? nA : cA + (size_t)(t + 2) * kstep; const char* b2 = last ? nB : cB + (size_t)(t + 2) * kstep;
            const char* a3 = a2 + kstep; const char* b3 = b2 + kstep;
            if (last && has_next) S.a_ready(nxt);
            if constexpr (SP2) {
            PG8_LDB(B0, 0, 0); PG8_LDB(B1, 0, 1); PG8_SCHED; PG8_LDA(At, 0, 0); PG8_STAGE(PG8_SA(1, 1), a1 + hstep, voffA);
            PG8_WAIT_V(8); PG8_WAIT_L(0); PG8_BAR; PG8_MMA(0, 0, At, B0); PG8_MMA(0, 1, At, B1); PG8_BAR; PG8_SCHED;
            PG8_LDA(At, 0, 1); PG8_STAGE(PG8_SB(0, 0), b2, voffB); PG8_STAGE(PG8_SB(0, 1), b2 + hstep, voffB); PG8_STAGE(PG8_SA(0, 0), a2, voffA);
            PG8_WAIT_V(8); PG8_WAIT_L(0); PG8_BAR; PG8_MMA(1, 0, At, B0); PG8_MMA(1, 1, At, B1); PG8_BAR; PG8_SCHED;
            PG8_LDB(B0, 1, 0); PG8_LDB(B1, 1, 1); PG8_SCHED; PG8_LDA(At, 1, 0); PG8_STAGE(PG8_SA(0, 1), a2 + hstep, voffA);
            PG8_WAIT_V(8); PG8_WAIT_L(0); PG8_BAR; PG8_MMA(0, 0, At, B0); PG8_MMA(0, 1, At, B1); PG8_BAR; PG8_SCHED;
            PG8_LDA(At, 1, 1); PG8_STAGE(PG8_SB(1, 0), b3, voffB); PG8_STAGE(PG8_SB(1, 1), b3 + hstep, voffB); PG8_STAGE(PG8_SA(1, 0), a3, voffA);
            PG8_WAIT_V(8); PG8_WAIT_L(0); PG8_BAR; PG8_MMA(1, 0, At, B0); PG8_MMA(1, 1, At, B1); PG8_BAR; PG8_SCHED;
            } else {
            PG8_LDB(B0, 0, 0); PG8_SCHED; PG8_LDA(At, 0, 0); PG8_STAGE(PG8_SA(1, 1), a1 + hstep, voffA);
            PG8_WAIT_L(8); PG8_BAR; PG8_WAIT_L(0); PG8_MMA(0, 0, At, B0); PG8_BAR; PG8_SCHED;
            PG8_LDB(B1, 0, 1); PG8_STAGE(PG8_SB(0, 0), b2, voffB);
            PG8_BAR; PG8_WAIT_L(0); PG8_MMA(0, 1, At, B1); PG8_BAR;
            PG8_LDA(At, 0, 1); PG8_STAGE(PG8_SA(0, 0), a2, voffA);
            PG8_BAR; PG8_WAIT_L(0); PG8_MMA(1, 0, At, B0); PG8_BAR; PG8_SCHED;
            PG8_STAGE(PG8_SB(0, 1), b2 + hstep, voffB);
            PG8_WAIT_V(6); PG8_BAR; PG8_MMA(1, 1, At, B1); PG8_BAR;
            PG8_LDB(B0, 1, 0); PG8_SCHED; PG8_LDA(At, 1, 0); PG8_STAGE(PG8_SA(0, 1), a2 + hstep, voffA);
            PG8_WAIT_L(8); PG8_BAR; PG8_WAIT_L(0); PG8_MMA(0, 0, At, B0); PG8_BAR; PG8_SCHED;
            PG8_LDB(B1, 1, 1); PG8_STAGE(PG8_SB(1, 0), b3, voffB);
            PG8_BAR; PG8_WAIT_L(0); PG8_MMA(0, 1, At, B1); PG8_BAR;
            PG8_LDA(At, 1, 1); PG8_STAGE(PG8_SA(1, 0), a3, voffA);
            PG8_BAR; PG8_WAIT_L(0); PG8_MMA(1, 0, At, B0); PG8_BAR; PG8_SCHED;
            PG8_STAGE(PG8_SB(1, 1), b3 + hstep, voffB);
            PG8_WAIT_V(6); PG8_BAR; PG8_MMA(1, 1, At, B1); PG8_BAR;
            }
        }
        if constexpr (ALIGN_EPI) { if (wr == 0) PG8_BAR; }
        if constexpr (!Epi::AFTER_DRAIN) { E(acc, cur, wr, wc, fr, fq); S.done(cur); }
        if (!has_next) break;
#pragma unroll
        for (int a = 0; a < 2; ++a)
#pragma unroll
            for (int b = 0; b < 2; ++b)
#pragma unroll
                for (int m = 0; m < 4; ++m)
#pragma unroll
                    for (int n = 0; n < 2; ++n) acc[a][b][m][n] = (f32x4){0.f, 0.f, 0.f, 0.f};
        cur = nxt; cA = nA; cB = nB; ++ui;
        if constexpr (ALIGN_EPI) { if (wr == 1) PG8_BAR; }
    }
    PG8_WAIT_V(0);
    if constexpr (!ALIGN_EPI) { if (wr == 0) PG8_BAR; }
    PG8_BAR;
    if constexpr (Epi::AFTER_DRAIN) { E.fused(acc, cur, wr, wc, fr, fq, lds, wid, lane); S.done(cur); }
#undef PG8_SA
#undef PG8_SB
#undef PG8_STAGE
#undef PG8_LDA
#undef PG8_LDB
#undef PG8_MMA
#undef PG8_WAIT_V
#undef PG8_WAIT_L
#undef PG8_BAR
#undef PG8_SCHED
}
}

#define LAS __attribute__((address_space(3)))
#define DI __device__ __forceinline__
using pg8::bf16_t; using pg8::bf16x8; using pg8::f32x4; using pg8::u32x4; using pg8::cvt_pk_bf16;
typedef unsigned u32x2 __attribute__((ext_vector_type(2)));
typedef float f32x2 __attribute__((ext_vector_type(2)));

constexpr int T_TOK = 32768, DM = 2048, NPROJ = 5120, PROJW = 5128;
constexpr int NTHREADS = 512;
constexpr int LDS_BYTES = 147456;
constexpr float EPS = 1e-6f;

constexpr size_t WS_XN = 0;
constexpr size_t WS_P = 134217728;
constexpr size_t WS_X1G = WS_P;
constexpr size_t WS_Q = WS_P + 134217728;
constexpr size_t WS_WINT = WS_P + 335544320;
constexpr size_t WS_WOUTT = WS_WINT + 20971520;
constexpr size_t WS_WQT = WS_WOUTT + 8388608;
constexpr size_t WS_UB = WS_WQT + 4194304;
constexpr size_t WS_VB = WS_UB + 67108864;
constexpr size_t WS_ST = WS_VB + 67108864;
constexpr size_t WS_CPT = WS_ST + 142606336;
constexpr size_t WS_QC = WS_CPT + 71303168;
constexpr size_t WS_KC = WS_QC + 33554432;
constexpr size_t WS_IG = WS_KC + 33554432;
constexpr size_t WS_LF = WS_IG + 524288;
constexpr size_t WS_PSSV = WS_LF + 524288;
constexpr size_t WS_PSS2 = WS_PSSV + 2097152;
constexpr size_t WS_BEND = WS_PSS2 + 4194304;
constexpr size_t WS_GMAX = WS_BEND + 4096;
constexpr size_t WS_MPREV = WS_GMAX + 4096;
constexpr size_t WS_SELID = WS_MPREV + 4096;
constexpr size_t WS_SELG = WS_SELID + 16777216;
constexpr size_t WS_KB1 = WS_SELG + 16777216;
constexpr size_t WS_KB2 = WS_KB1 + 131072;
constexpr size_t WS_BAR = WS_KB2 + 131072;
constexpr size_t WS_END = WS_BAR + 16384;

struct Params {
    const float *x, *norm1_g, *w_in, *gm_vnorm_g, *w_spatial, *b_spatial, *ml_conv_w, *ml_conv_b, *ml_b_i, *ml_b_f, *gm_out_g, *ml_out_g, *w_out, *norm2_g,
        *peer_wq, *peer_k1, *peer_k2, *peer_u, *peer_v, *final_g;
    float* out;
    unsigned char* ws;
};

template <int CB, int H, int W> DI size_t p_off(int t, int h, int d) { return (size_t)T_TOK * CB + ((size_t)((t >> 7) * H + h) * 128 + (t & 127)) * W + d; }
DI float bf2f(unsigned short h) { return __uint_as_float(((unsigned)h) << 16); }
DI float bflo(unsigned w) { return __uint_as_float(w << 16); }
DI float bfhi(unsigned w) { return __uint_as_float(w & 0xffff0000u); }
DI float rcpf_(float x) { return __builtin_amdgcn_rcpf(x); }
DI float sigmoid_(float x) { return rcpf_(1.f + __expf(-x)); }
DI float gelu_t(float x) { const float z = 1.5957691216057308f * (x + 0.044715f * x * x * x); return x * rcpf_(1.f + __expf(-z)); }
DI float wave_sum(float v) {
#pragma unroll
    for (int o = 32; o; o >>= 1) v += __shfl_xor(v, o);
    return v;
}
DI float wave_max(float v) {
#pragma unroll
    for (int o = 32; o; o >>= 1) v = fmaxf(v, __shfl_xor(v, o));
    return v;
}
DI bf16x8 ld_frag_lds(const LAS unsigned char* p) { return *(const LAS bf16x8*)p; }
#define MFMA16(a, b, c) __builtin_amdgcn_mfma_f32_16x16x32_bf16((a), (b), (c), 0, 0, 0)

struct Epi1 {
    static constexpr bool PERM = true, AFTER_DRAIN = false;
    bf16_t* P; float* pssv;
    DI void operator()(const f32x4 (&acc)[2][2][4][2], const pg8::Unit& u, int wr, int wc, int fr, int fq) const {
        const int row0 = u.pm * 256 + wr * 64 + fr, col0 = u.pn * 256 + wc * 32 + 8 * fq;
        const int mode = u.pn < 8 ? 1 : (u.pn >= 16 ? 2 : 0);
        const bool want_ss = (u.pn >= 4 && u.pn < 8);
#pragma unroll
        for (int ai = 0; ai < 2; ++ai)
#pragma unroll
            for (int m = 0; m < 4; ++m) {
                const int row = row0 + ai * 128 + m * 16;
                const int CB = u.pn < 4 ? 0 : (u.pn < 8 ? 1024 : (u.pn < 10 ? 2048 : (u.pn < 12 ? 2560 : (u.pn < 16 ? 3072 : 4096))));
                const int lw = u.pn < 12 ? 7 : 8, H = u.pn < 8 ? 8 : 4;
                float ss = 0.f;
#pragma unroll
                for (int bj = 0; bj < 2; ++bj) {
                    f32x4 v0 = acc[ai][bj][m][0], v1 = acc[ai][bj][m][1];
                    if (mode == 1) {
#pragma unroll
                        for (int j = 0; j < 4; ++j) { v0[j] = gelu_t(v0[j]); v1[j] = gelu_t(v1[j]); ss += v0[j] * v0[j] + v1[j] * v1[j]; }
                    } else if (mode == 2) {
#pragma unroll
                        for (int j = 0; j < 4; ++j) { v0[j] = sigmoid_(v0[j]); v1[j] = sigmoid_(v1[j]); }
                    }
                    u32x4 w; w.x = cvt_pk_bf16(v0[0], v0[1]); w.y = cvt_pk_bf16(v0[2], v0[3]); w.z = cvt_pk_bf16(v1[0], v1[1]); w.w = cvt_pk_bf16(v1[2], v1[3]);
                    {
                        const int cr = col0 + bj * 128 - CB, hh = cr >> lw, d = cr & ((1 << lw) - 1);
                        *(u32x4*)(P + (size_t)T_TOK * CB + (((size_t)((row >> 7) * H + hh) * 128 + (row & 127)) << lw) + d) = w;
                    }
                }
                if (want_ss) {
                    ss += __shfl_xor(ss, 16); ss += __shfl_xor(ss, 32);
                    if (fq == 0) pssv[(size_t)row * 16 + (u.pn - 4) * 4 + wc] = ss;
                }
            }
    }
};

struct Epi2 {
    static constexpr bool PERM = true, AFTER_DRAIN = false;
    const float* x; bf16_t* x1b; float* pss2;
    DI void operator()(const f32x4 (&acc)[2][2][4][2], const pg8::Unit& u, int wr, int wc, int fr, int fq) const {
        const int row0 = u.pm * 256 + wr * 64 + fr, col0 = u.pn * 256 + wc * 32 + 8 * fq;
#pragma unroll
        for (int ai = 0; ai < 2; ++ai)
#pragma unroll
            for (int m = 0; m < 4; ++m) {
                const int row = row0 + ai * 128 + m * 16;
                float ss = 0.f;
#pragma unroll
                for (int bj = 0; bj < 2; ++bj) {
                    const size_t o = (size_t)row * DM + col0 + bj * 128;
                    const f32x4 v0 = acc[ai][bj][m][0] + *(const f32x4*)(x + o), v1 = acc[ai][bj][m][1] + *(const f32x4*)(x + o + 4);
#pragma unroll
                    for (int j = 0; j < 4; ++j) ss += v0[j] * v0[j] + v1[j] * v1[j];
                    u32x4 w; w.x = cvt_pk_bf16(v0[0], v0[1]); w.y = cvt_pk_bf16(v0[2], v0[3]); w.z = cvt_pk_bf16(v1[0], v1[1]); w.w = cvt_pk_bf16(v1[2], v1[3]);
                    *(u32x4*)(x1b + o) = w;
                }
                ss += __shfl_xor(ss, 16); ss += __shfl_xor(ss, 32);
                if (fq == 0) pss2[(size_t)row * 32 + u.pn * 4 + wc] = ss;
            }
    }
};

struct Epi3 {
    static constexpr bool PERM = true, AFTER_DRAIN = false;
    bf16_t* Q; const float* pss2;
    DI void operator()(const f32x4 (&acc)[2][2][4][2], const pg8::Unit& u, int wr, int wc, int fr, int fq) const {
        const int row0 = u.pm * 256 + wr * 64 + fr, col0 = u.pn * 256 + wc * 32 + 8 * fq;
#pragma unroll
        for (int ai = 0; ai < 2; ++ai)
#pragma unroll
            for (int m = 0; m < 4; ++m) {
                const int row = row0 + ai * 128 + m * 16;
                float ss = 0.f;
#pragma unroll
                for (int i = 0; i < 8; ++i) { const f32x4 t = *(const f32x4*)(pss2 + (size_t)row * 32 + i * 4); ss += (t[0] + t[1]) + (t[2] + t[3]); }
                const float rstd = rsqrtf(ss * (1.f / 2048.f) + EPS);
#pragma unroll
                for (int bj = 0; bj < 2; ++bj) {
                    const f32x4 v0 = acc[ai][bj][m][0] * rstd, v1 = acc[ai][bj][m][1] * rstd;
                    u32x4 w; w.x = cvt_pk_bf16(v0[0], v0[1]); w.y = cvt_pk_bf16(v0[2], v0[3]); w.z = cvt_pk_bf16(v1[0], v1[1]); w.w = cvt_pk_bf16(v1[2], v1[3]);
                    *(u32x4*)(Q + (size_t)row * 1024 + col0 + bj * 128) = w;
                }
            }
    }
};

DI void phase0(const Params& p, LAS unsigned char* lds) {
    const int tid = threadIdx.x, lane = tid & 63, wave = tid >> 6;
    bf16_t* XN = (bf16_t*)(p.ws + WS_XN);
    {
        LAS float* scr = (LAS float*)lds + wave * (64 * 65);
        const int gw = blockIdx.x * 8 + wave, nw = gridDim.x * 8;
        for (int it = gw; it < 4096; it += nw) {
            const float* W; bf16_t* WT; int ldw, kt, nt;
            if (it < 2560) { W = p.w_in; WT = (bf16_t*)(p.ws + WS_WINT); ldw = PROJW; kt = it / 80; nt = it % 80; }
            else if (it < 3584) { const int j = it - 2560; W = p.w_out; WT = (bf16_t*)(p.ws + WS_WOUTT); ldw = 2048; kt = j >> 5; nt = j & 31; }
            else { const int j = it - 3584; W = p.peer_wq; WT = (bf16_t*)(p.ws + WS_WQT); ldw = 1024; kt = j >> 4; nt = j & 15; }
            const int k0 = kt * 64, n0 = nt * 64;
            {
                f32x4 tv[16];
#pragma unroll
                for (int i = 0; i < 16; ++i) tv[i] = *(const f32x4*)(W + (size_t)(k0 + 4 * i + (lane >> 4)) * ldw + n0 + 4 * (lane & 15));
#pragma unroll
                for (int i = 0; i < 16; ++i) {
                    const int r = 4 * i + (lane >> 4);
                    const float gsc = it >= 3584 ? p.norm2_g[k0 + r] : 1.f;
                    LAS float* d = scr + r * 65 + 4 * (lane & 15);
                    d[0] = tv[i][0] * gsc; d[1] = tv[i][1] * gsc; d[2] = tv[i][2] * gsc; d[3] = tv[i][3] * gsc;
                }
            }
            __builtin_amdgcn_fence(__ATOMIC_RELEASE, "wavefront"); __builtin_amdgcn_wave_barrier(); __builtin_amdgcn_fence(__ATOMIC_ACQUIRE, "wavefront");
            const int half = lane >> 5, kk = (lane & 31) * 2;
#pragma unroll 8
            for (int nn = 0; nn < 32; ++nn) {
                const int n = 2 * nn + half; const float a = scr[kk * 65 + n], b = scr[(kk + 1) * 65 + n];
                *(unsigned*)(WT + (size_t)(n0 + n) * 2048 + k0 + kk) = cvt_pk_bf16(a, b);
            }
            __builtin_amdgcn_fence(__ATOMIC_RELEASE, "wavefront"); __builtin_amdgcn_wave_barrier(); __builtin_amdgcn_fence(__ATOMIC_ACQUIRE, "wavefront");
        }
    }
    __syncthreads();
    {
        LAS float* wg = (LAS float*)lds;
        for (int idx = tid; idx < 4096; idx += NTHREADS) {
            const int k = idx >> 1, hf = idx & 1;
            const f32x4 v = *(const f32x4*)(p.w_in + (size_t)k * PROJW + 5120 + hf * 4);
            *(LAS f32x4*)(wg + k * 8 + (k >> 3) * 4 + hf * 4) = v;
        }
        __syncthreads();
        float* IG = (float*)(p.ws + WS_IG); float* LF = (float*)(p.ws + WS_LF);
        for (int row0 = 2 * (blockIdx.x * 8 + wave); row0 < T_TOK; row0 += 2 * gridDim.x * 8) {
            f32x4 xv[2][8];
#pragma unroll
            for (int rr = 0; rr < 2; ++rr) {
                const float* xr = p.x + (size_t)(row0 + rr) * DM;
#pragma unroll
                for (int i = 0; i < 4; ++i) { xv[rr][2 * i] = *(const f32x4*)(xr + i * 512 + lane * 8); xv[rr][2 * i + 1] = *(const f32x4*)(xr + i * 512 + lane * 8 + 4); }
            }
#pragma unroll
            for (int rr = 0; rr < 2; ++rr) {
                const int row = row0 + rr;
                float ss = 0.f;
#pragma unroll
                for (int i = 0; i < 8; ++i) ss += (xv[rr][i][0] * xv[rr][i][0] + xv[rr][i][1] * xv[rr][i][1]) + (xv[rr][i][2] * xv[rr][i][2] + xv[rr][i][3] * xv[rr][i][3]);
                ss = wave_sum(ss);
                const float rstd = rsqrtf(ss * (1.f / 2048.f) + EPS);
                f32x4 ga = {0.f, 0.f, 0.f, 0.f}, gb = {0.f, 0.f, 0.f, 0.f};
#pragma unroll
                for (int i = 0; i < 4; ++i) {
                    const f32x4 g0 = *(const f32x4*)(p.norm1_g + i * 512 + lane * 8), g1 = *(const f32x4*)(p.norm1_g + i * 512 + lane * 8 + 4);
                    const f32x4 h0 = xv[rr][2 * i] * rstd * g0, h1 = xv[rr][2 * i + 1] * rstd * g1;
                    u32x4 w; w.x = cvt_pk_bf16(h0[0], h0[1]); w.y = cvt_pk_bf16(h0[2], h0[3]); w.z = cvt_pk_bf16(h1[0], h1[1]); w.w = cvt_pk_bf16(h1[2], h1[3]);
                    *(u32x4*)(XN + (size_t)row * DM + i * 512 + lane * 8) = w;
                    const LAS float* wb = wg + (i * 512 + lane * 8) * 8 + (i * 64 + lane) * 4;
#pragma unroll
                    for (int e = 0; e < 8; ++e) {
                        const float hv = e < 4 ? h0[e & 3] : h1[e & 3];
                        const f32x4 w0 = *(const LAS f32x4*)(wb + e * 8), w1 = *(const LAS f32x4*)(wb + e * 8 + 4);
                        ga = ga + w0 * hv; gb = gb + w1 * hv;
                    }
                }
                f32x4 m4 = lane < 32 ? ga : gb, s4 = lane < 32 ? gb : ga;
#pragma unroll
                for (int j = 0; j < 4; ++j) m4[j] += __shfl_xor(s4[j], 32);
                const bool up16 = (lane & 16) != 0;
                float m2a = up16 ? m4[2] : m4[0], m2b = up16 ? m4[3] : m4[1];
                const float s2a = up16 ? m4[0] : m4[2], s2b = up16 ? m4[1] : m4[3];
                m2a += __shfl_xor(s2a, 16); m2b += __shfl_xor(s2b, 16);
                const bool up8 = (lane & 8) != 0;
                float m1 = up8 ? m2b : m2a; const float s1 = up8 ? m2a : m2b;
                m1 += __shfl_xor(s1, 8);
                m1 += __shfl_xor(m1, 4); m1 += __shfl_xor(m1, 2); m1 += __shfl_xor(m1, 1);
                const int j = ((lane >> 5) << 2) | (((lane >> 4) & 1) << 1) | ((lane >> 3) & 1);
                if ((lane & 7) == 0) {
                    if (j < 4) IG[(size_t)row * 4 + j] = m1 + p.ml_b_i[j];
                    else { const float z = m1 + p.ml_b_f[j - 4]; LF[(size_t)row * 4 + j - 4] = fminf(z, 0.f) - log1pf(__expf(-fabsf(z))); }
                }
            }
        }
    }
    {
        const size_t nthr = (size_t)gridDim.x * NTHREADS, NQ = (size_t)16384 * 512;
        for (size_t base = (size_t)blockIdx.x * NTHREADS + tid; base < 2 * NQ; base += 16 * nthr) {
            f32x4 v[16];
#pragma unroll
            for (int u = 0; u < 16; ++u) {
                size_t i = base + u * nthr; if (i >= 2 * NQ) i = base;
                const int which = i >= NQ; const size_t j = i - (which ? NQ : 0);
                v[u] = *(const f32x4*)((which ? p.peer_v : p.peer_u) + j * 4);
            }
#pragma unroll
            for (int u = 0; u < 16; ++u) {
                size_t i = base + u * nthr; if (i >= 2 * NQ) i = base;
                const int which = i >= NQ; const size_t j = i - (which ? NQ : 0);
                const int row = (int)(j >> 9), c4 = (int)(j & 511);
                float amax = fmaxf(fmaxf(fabsf(v[u][0]), fabsf(v[u][1])), fmaxf(fabsf(v[u][2]), fabsf(v[u][3])));
                amax = fmaxf(amax, __uint_as_float((unsigned)__builtin_amdgcn_update_dpp(0, (int)__float_as_uint(amax), 0xB1, 0xF, 0xF, true)));
                amax = fmaxf(amax, __uint_as_float((unsigned)__builtin_amdgcn_update_dpp(0, (int)__float_as_uint(amax), 0x4E, 0xF, 0xF, true)));
                amax = fmaxf(amax, __uint_as_float((unsigned)__builtin_amdgcn_update_dpp(0, (int)__float_as_uint(amax), 0x141, 0xF, 0xF, true)));
                amax = fmaxf(amax, __uint_as_float((unsigned)__builtin_amdgcn_update_dpp(0, (int)__float_as_uint(amax), 0x140, 0xF, 0xF, true)));
                const unsigned sb = cvt_pk_bf16(amax * (1.f / 6.f), 0.f) & 0xffffu;
                float sc = bflo(sb); if (sc == 0.f) sc = 1.f;
                const float inv = 1.f / sc;
                unsigned r = 0u;
                r = __builtin_amdgcn_cvt_scalef32_pk_fp4_f32(r, v[u][0] * inv, v[u][1] * inv, 1.0f, 0);
                r = __builtin_amdgcn_cvt_scalef32_pk_fp4_f32(r, v[u][2] * inv, v[u][3] * inv, 1.0f, 1);
                unsigned char* dst = p.ws + (which ? WS_VB : WS_UB) + (size_t)row * 1088;
                *(unsigned short*)(dst + c4 * 2) = (unsigned short)(r & 0xffffu);
                if ((c4 & 15) == 0) *(unsigned short*)(dst + 1024 + (c4 >> 4) * 2) = (unsigned short)(sb == 0u ? 0x3F80u : sb);
            }
        }
    }
    {
        bf16_t* KB1 = (bf16_t*)(p.ws + WS_KB1); bf16_t* KB2 = (bf16_t*)(p.ws + WS_KB2);
        for (int i = blockIdx.x * NTHREADS + tid; i < 65536 / 4; i += gridDim.x * NTHREADS) {
            const f32x4 a = *(const f32x4*)(p.peer_k1 + i * 4), b = *(const f32x4*)(p.peer_k2 + i * 4);
            u32x2 w; w.x = cvt_pk_bf16(a[0], a[1]); w.y = cvt_pk_bf16(a[2], a[3]); *(u32x2*)(KB1 + i * 4) = w;
            w.x = cvt_pk_bf16(b[0], b[1]); w.y = cvt_pk_bf16(b[2], b[3]); *(u32x2*)(KB2 + i * 4) = w;
        }
    }
}

#define WAVE_LDS_SYNC() do { __builtin_amdgcn_fence(__ATOMIC_RELEASE, "wavefront"); __builtin_amdgcn_wave_barrier(); __builtin_amdgcn_fence(__ATOMIC_ACQUIRE, "wavefront"); } while (0)

template <int NG> DI void stage_T_load(const bf16_t* src, int ld, u32x4 (&r0)[NG], u32x4 (&r1)[NG], int wave, int lane) {
#pragma unroll
    for (int i = 0; i < NG; ++i) {
        const int g = wave + 8 * i;
        r0[i] = *(const u32x4*)(src + (size_t)(2 * lane) * ld + g * 8);
        r1[i] = *(const u32x4*)(src + (size_t)(2 * lane + 1) * ld + g * 8);
    }
}
template <int NG> DI void stage_T_store(const u32x4 (&r0)[NG], const u32x4 (&r1)[NG], LAS unsigned char* dst, int wave, int lane) {
#pragma unroll
    for (int i = 0; i < NG; ++i) {
        const int g = wave + 8 * i;
#pragma unroll
        for (int w = 0; w < 4; ++w) {
            const unsigned a = r0[i][w], b = r1[i][w];
            *(LAS unsigned*)(dst + (g * 8 + 2 * w) * 272 + lane * 4) = (a & 0xffffu) | (b << 16);
            *(LAS unsigned*)(dst + (g * 8 + 2 * w + 1) * 272 + lane * 4) = (a >> 16) | (b & 0xffff0000u);
        }
    }
}
template <int NG> DI void stage_T(const bf16_t* src, int ld, LAS unsigned char* dst, int wave, int lane) {
    u32x4 r0[NG], r1[NG];
    stage_T_load<NG>(src, ld, r0, r1, wave, lane);
    stage_T_store<NG>(r0, r1, dst, wave, lane);
}

DI void gmlp_bc(const Params& p, LAS unsigned char* lds, int b, int c) {
    const int tid = threadIdx.x, lane = tid & 63, wave = __builtin_amdgcn_readfirstlane(tid >> 6), fr = lane & 15, fq = lane >> 4;
    const int t0 = b * 8192 + c * 128;
    LAS unsigned char* Wl = lds; LAS unsigned char* GvT = lds + 34816; LAS float* rstdv = (LAS float*)(lds + 69632);
    const bf16_t* P = (const bf16_t*)(p.ws + WS_P); bf16_t* YM = (bf16_t*)(p.ws + WS_XN);
    const float* PSSV = (const float*)(p.ws + WS_PSSV);
    __syncthreads();
    if (tid < 128) {
        float ss = 0.f;
#pragma unroll
        for (int i = 0; i < 4; ++i) { const f32x4 v = *(const f32x4*)(PSSV + (size_t)(t0 + tid) * 16 + i * 4); ss += (v[0] + v[1]) + (v[2] + v[3]); }
        rstdv[tid] = rsqrtf(ss * (1.f / 1024.f) + EPS);
    }
    f32x4 wa[4][2]; u32x4 gr0[2], gr1[2];
#define GMLP_PREFETCH(hh) do { _Pragma("unroll") for (int it = 0; it < 4; ++it) { const int e = (it * NTHREADS + tid) * 8, t = e >> 7, s0 = e & 127; \
            const float* wp = p.w_spatial + ((size_t)((hh) * 128 + t)) * 128 + s0; wa[it][0] = *(const f32x4*)wp; wa[it][1] = *(const f32x4*)(wp + 4); } \
        stage_T_load<2>(P + p_off<1024, 8, 128>(t0, (hh), 0), 128, gr0, gr1, wave, lane); } while (0)
    GMLP_PREFETCH(0);
    for (int h = 0; h < 8; ++h) {
        __syncthreads();
#pragma unroll
        for (int it = 0; it < 4; ++it) {
            const int e = (it * NTHREADS + tid) * 8, t = e >> 7, s0 = e & 127;
            float v[8];
#pragma unroll
            for (int j = 0; j < 8; ++j) { const float a = j < 4 ? wa[it][0][j & 3] : wa[it][1][j & 3]; v[j] = (s0 + j <= t) ? a * rstdv[s0 + j] : 0.f; }
            u32x4 w; w.x = cvt_pk_bf16(v[0], v[1]); w.y = cvt_pk_bf16(v[2], v[3]); w.z = cvt_pk_bf16(v[4], v[5]); w.w = cvt_pk_bf16(v[6], v[7]);
            *(LAS u32x4*)(Wl + t * 272 + s0 * 2) = w;
        }
        stage_T_store<2>(gr0, gr1, GvT, wave, lane);
        __syncthreads();
        if (h + 1 < 8) GMLP_PREFETCH(h + 1);
        f32x4 acc[8];
#pragma unroll
        for (int n = 0; n < 8; ++n) acc[n] = (f32x4){0.f, 0.f, 0.f, 0.f};
        const int kmax = (16 * wave + 15) >> 5;
#pragma unroll
        for (int kk = 0; kk < 4; ++kk) {
            if (kk <= kmax) {
                const bf16x8 bfrag = ld_frag_lds(Wl + (16 * wave + fr) * 272 + (32 * kk + 8 * fq) * 2);
#pragma unroll
                for (int n = 0; n < 8; ++n) { const bf16x8 afrag = ld_frag_lds(GvT + (16 * n + fr) * 272 + (32 * kk + 8 * fq) * 2); acc[n] = MFMA16(afrag, bfrag, acc[n]); }
            }
        }
        const int t = 16 * wave + fr; const size_t grow = (size_t)(t0 + t);
        const float bsp = p.b_spatial[h * 128 + t];
        float ss = 0.f;
#pragma unroll
        for (int n = 0; n < 8; ++n) {
            const int d0 = 16 * n + 4 * fq;
            const u32x2 uw = *(const u32x2*)(P + p_off<0, 8, 128>(t0 + t, h, d0));
            const f32x4 gv = *(const f32x4*)(p.gm_vnorm_g + h * 128 + d0);
            f32x4 y;
            y[0] = bflo(uw.x) * (gv[0] * acc[n][0] + bsp); y[1] = bfhi(uw.x) * (gv[1] * acc[n][1] + bsp);
            y[2] = bflo(uw.y) * (gv[2] * acc[n][2] + bsp); y[3] = bfhi(uw.y) * (gv[3] * acc[n][3] + bsp);
            ss += (y[0] * y[0] + y[1] * y[1]) + (y[2] * y[2] + y[3] * y[3]);
            acc[n] = y;
        }
        ss += __shfl_xor(ss, 16); ss += __shfl_xor(ss, 32);
        const float rstd = rsqrtf(ss * (1.f / 128.f) + EPS);
#pragma unroll
        for (int n = 0; n < 8; ++n) {
            const int d0 = 16 * n + 4 * fq;
            const f32x4 g = *(const f32x4*)(p.gm_out_g + h * 128 + d0);
            const f32x4 o = acc[n] * rstd * g;
            u32x2 w; w.x = cvt_pk_bf16(o[0], o[1]); w.y = cvt_pk_bf16(o[2], o[3]);
            *(u32x2*)(YM + grow * DM + h * 128 + d0) = w;
        }
    }
}

DI void mlstm_local(const Params& p, LAS unsigned char* lds, int b, int c, int h) {
    const int tid = threadIdx.x, lane = tid & 63, wave = __builtin_amdgcn_readfirstlane(tid >> 6), fr = lane & 15, fq = lane >> 4;
    const int bh = b * 4 + h, t0 = b * 8192 + c * 128;
    LAS unsigned char* KT = lds; LAS unsigned char* VT = lds + 34816; LAS float* wsv = (LAS float*)(lds + 108800);
    const bf16_t* P = (const bf16_t*)(p.ws + WS_P);
    bf16_t* QC = (bf16_t*)(p.ws + WS_QC); bf16_t* KC = (bf16_t*)(p.ws + WS_KC);
    const float* IG = (const float*)(p.ws + WS_IG); const float* LF = (const float*)(p.ws + WS_LF);
    LAS float* cwl = (LAS float*)(lds + 109312);
    __syncthreads();
    u32x4 xw[2][5];
#define CONV_LOAD(half) do { _Pragma("unroll") for (int gi = 0; gi < 2; ++gi) { const int g = wave + 8 * (gi + 2 * (half)); const int cgp = (g & 15) * 8; \
        _Pragma("unroll") for (int dj = 0; dj < 5; ++dj) { const int srow = 2 * lane - 3 + dj; xw[gi][dj] = (u32x4){0u, 0u, 0u, 0u}; \
            if (c > 0 || srow >= 0) xw[gi][dj] = *(const u32x4*)(P + ((half) ? p_off<2560, 4, 128>(t0 + srow, h, cgp) : p_off<2048, 4, 128>(t0 + srow, h, cgp))); } } } while (0)
    CONV_LOAD(0);
    for (int idx = tid; idx < 1280; idx += NTHREADS) {
        const int j = idx >> 8, cc = idx & 255, ch = (cc >= 128 ? 512 : 0) + h * 128 + (cc & 127);
        cwl[idx] = j < 4 ? p.ml_conv_w[j * 1024 + ch] : p.ml_conv_b[ch];
    }
    if (wave == 0) {
        const float l0 = LF[(size_t)(t0 + 2 * lane) * 4 + h], l1 = LF[(size_t)(t0 + 2 * lane + 1) * 4 + h];
        const float i0 = IG[(size_t)(t0 + 2 * lane) * 4 + h], i1 = IG[(size_t)(t0 + 2 * lane + 1) * 4 + h];
        float s = l0 + l1;
#pragma unroll
        for (int off = 1; off < 64; off <<= 1) { const float tt = __shfl_up(s, off); if (lane >= off) s += tt; }
        const float b1 = s, b0 = s - l1, bend = __shfl(s, 63);
        const float g0 = bend - b0 + i0, g1 = bend - b1 + i1;
        const float gmax = wave_max(fmaxf(g0, g1));
        wsv[2 * lane] = __expf(g0 - gmax); wsv[2 * lane + 1] = __expf(g1 - gmax);
        if (lane == 0) { ((float*)(p.ws + WS_BEND))[bh * 64 + c] = bend; ((float*)(p.ws + WS_GMAX))[bh * 64 + c] = gmax; }
    }
    __syncthreads();
#pragma unroll
    for (int gi4 = 0; gi4 < 4; ++gi4) {
        const int gi = gi4 & 1;
        if (gi4 == 2) CONV_LOAD(1);
        const int g = wave + 8 * gi4; const bool isk = gi4 >= 2; const int cgp = (g & 15) * 8;
        const int cc0 = (isk ? 128 : 0) + cgp;
        const int s = 2 * lane;
        float y0[8], y1[8];
        {
            const f32x4 cb0 = *(const LAS f32x4*)(cwl + 1024 + cc0), cb1 = *(const LAS f32x4*)(cwl + 1024 + cc0 + 4);
#pragma unroll
            for (int e = 0; e < 8; ++e) { y0[e] = e < 4 ? cb0[e & 3] : cb1[e & 3]; y1[e] = y0[e]; }
#pragma unroll
            for (int j = 0; j < 5; ++j) {
                float xr[8];
#pragma unroll
                for (int q = 0; q < 4; ++q) { xr[2 * q] = bflo(xw[gi][j][q]); xr[2 * q + 1] = bfhi(xw[gi][j][q]); }
                if (j < 4) {
                    const f32x4 w0 = *(const LAS f32x4*)(cwl + j * 256 + cc0), w1 = *(const LAS f32x4*)(cwl + j * 256 + cc0 + 4);
#pragma unroll
                    for (int e = 0; e < 8; ++e) y0[e] += (e < 4 ? w0[e & 3] : w1[e & 3]) * xr[e];
                }
                if (j > 0) {
                    const f32x4 w0 = *(const LAS f32x4*)(cwl + (j - 1) * 256 + cc0), w1 = *(const LAS f32x4*)(cwl + (j - 1) * 256 + cc0 + 4);
#pragma unroll
                    for (int e = 0; e < 8; ++e) y1[e] += (e < 4 ? w0[e & 3] : w1[e & 3]) * xr[e];
                }
            }
        }
        const float sc = isk ? 0.08838834764831845f : 1.f;
#pragma unroll
        for (int e = 0; e < 8; ++e) { y0[e] = y0[e] * sigmoid_(y0[e]) * sc; y1[e] = y1[e] * sigmoid_(y1[e]) * sc; }
        bf16_t* dst = (isk ? KC : QC) + (size_t)(t0 + s) * 512 + h * 128 + cgp;
        u32x4 w; w.x = cvt_pk_bf16(y0[0], y0[1]); w.y = cvt_pk_bf16(y0[2], y0[3]); w.z = cvt_pk_bf16(y0[4], y0[5]); w.w = cvt_pk_bf16(y0[6], y0[7]);
        *(u32x4*)dst = w;
        w.x = cvt_pk_bf16(y1[0], y1[1]); w.y = cvt_pk_bf16(y1[2], y1[3]); w.z = cvt_pk_bf16(y1[4], y1[5]); w.w = cvt_pk_bf16(y1[6], y1[7]);
        *(u32x4*)(dst + 512) = w;
        if (isk) {
            const float w0 = wsv[s], w1 = wsv[s + 1];
#pragma unroll
            for (int e = 0; e < 8; ++e) *(LAS unsigned*)(KT + (cgp + e) * 272 + lane * 4) = cvt_pk_bf16(y0[e] * w0, y1[e] * w1);
        }
    }
    stage_T<4>(P + p_off<3072, 4, 256>(t0, h, 0), 256, VT, wave, lane);
    for (int i = tid; i < 1024; i += NTHREADS) { const int r = i >> 6, w = i & 63; *(LAS unsigned*)(VT + (256 + r) * 272 + w * 4) = 0x3F803F80u; }
    __syncthreads();
    bf16x8 af[4];
#pragma unroll
    for (int kk = 0; kk < 4; ++kk) af[kk] = ld_frag_lds(KT + (16 * wave + fr) * 272 + (32 * kk + 8 * fq) * 2);
    float* ST = (float*)(p.ws + WS_ST) + ((size_t)(bh * 64 + c) * 272) * 128;
#pragma unroll
    for (int n = 0; n < 17; ++n) {
        f32x4 acc = {0.f, 0.f, 0.f, 0.f};
#pragma unroll
        for (int kk = 0; kk < 4; ++kk) { const bf16x8 bfr = ld_frag_lds(VT + (16 * n + fr) * 272 + (32 * kk + 8 * fq) * 2); acc = MFMA16(af[kk], bfr, acc); }
        if (n < 16 || fr == 0) __builtin_nontemporal_store(acc, (f32x4*)(ST + (size_t)(16 * n + fr) * 128 + 16 * wave + 4 * fq));
    }
}

DI void phase_scan(const Params& p) {
    const float* ST = (const float*)(p.ws + WS_ST); bf16_t* CPT = (bf16_t*)(p.ws + WS_CPT);
    const float* BEND = (const float*)(p.ws + WS_BEND); const float* GMAX = (const float*)(p.ws + WS_GMAX); float* MPREV = (float*)(p.ws + WS_MPREV);
    const int gtid = blockIdx.x * NTHREADS + threadIdx.x, nthr = gridDim.x * NTHREADS;
    constexpr int PER = 8224;
    constexpr size_t CST = 272 * 128;
    if (nthr == 16 * 8192) {
        const int bh = gtid >> 13, e4 = gtid & 8191;
        const bool extra = (gtid & 255) == 0;
        const int e42 = 8192 + ((gtid >> 8) & 31);
        const float* src = ST + (size_t)bh * 64 * CST + (size_t)e4 * 4;
        bf16_t* dst = CPT + (size_t)bh * 64 * CST + (size_t)e4 * 4;
        const float* src2 = ST + (size_t)bh * 64 * CST + (size_t)e42 * 4;
        bf16_t* dst2 = CPT + (size_t)bh * 64 * CST + (size_t)e42 * 4;
        f32x4 st = {0.f, 0.f, 0.f, 0.f}, st2 = {0.f, 0.f, 0.f, 0.f}; float m = 0.f;
        for (int c0 = 0; c0 < 64; c0 += 8) {
            f32x4 d[8], d2[8]; float be[8], gm[8];
#pragma unroll
            for (int j = 0; j < 8; ++j) { d[j] = __builtin_nontemporal_load((const f32x4*)(src + (size_t)(c0 + j) * CST)); be[j] = BEND[bh * 64 + c0 + j]; gm[j] = GMAX[bh * 64 + c0 + j]; }
#pragma unroll
            for (int j = 0; j < 8; ++j) d2[j] = extra ? __builtin_nontemporal_load((const f32x4*)(src2 + (size_t)(c0 + j) * CST)) : (f32x4){0.f, 0.f, 0.f, 0.f};
#pragma unroll
            for (int j = 0; j < 8; ++j) {
                const int c = c0 + j;
                const float mn = fmaxf(be[j] + m, gm[j]), a = __expf(be[j] + m - mn), sc = __expf(gm[j] - mn);
                u32x2 w; w.x = cvt_pk_bf16(st[0], st[1]); w.y = cvt_pk_bf16(st[2], st[3]);
                *(u32x2*)(dst + (size_t)c * CST) = w;
                if (extra) { u32x2 w2; w2.x = cvt_pk_bf16(st2[0], st2[1]); w2.y = cvt_pk_bf16(st2[2], st2[3]); *(u32x2*)(dst2 + (size_t)c * CST) = w2; }
                if (e4 == 0) MPREV[bh * 64 + c] = m;
                st = st * a + d[j] * sc; st2 = st2 * a + d2[j] * sc; m = mn;
            }
        }
        return;
    }
    for (int item = gtid; item < 16 * PER; item += nthr) {
        const int bh = item / PER, e4 = item - bh * PER;
        const float* src = ST + (size_t)bh * 64 * CST + (size_t)e4 * 4;
        bf16_t* dst = CPT + (size_t)bh * 64 * CST + (size_t)e4 * 4;
        f32x4 st = {0.f, 0.f, 0.f, 0.f}; float m = 0.f;
        for (int c0 = 0; c0 < 64; c0 += 8) {
            f32x4 d[8]; float be[8], gm[8];
#pragma unroll
            for (int j = 0; j < 8; ++j) { d[j] = __builtin_nontemporal_load((const f32x4*)(src + (size_t)(c0 + j) * CST)); be[j] = BEND[bh * 64 + c0 + j]; gm[j] = GMAX[bh * 64 + c0 + j]; }
#pragma unroll
            for (int j = 0; j < 8; ++j) {
                const int c = c0 + j;
                const float mn = fmaxf(be[j] + m, gm[j]), a = __expf(be[j] + m - mn), sc = __expf(gm[j] - mn);
                u32x2 w; w.x = cvt_pk_bf16(st[0], st[1]); w.y = cvt_pk_bf16(st[2], st[3]);
                *(u32x2*)(dst + (size_t)c * CST) = w;
                if (e4 == 0) MPREV[bh * 64 + c] = m;
                st = st * a + d[j] * sc; m = mn;
            }
        }
    }
}

DI void mlstm_out(const Params& p, LAS unsigned char* lds, int b, int c, int h) {
    const int tid = threadIdx.x, lane = tid & 63, wave = __builtin_amdgcn_readfirstlane(tid >> 6), fr = lane & 15, fq = lane >> 4;
    const int bh = b * 4 + h, t0 = b * 8192 + c * 128;
    LAS unsigned char* Kl = lds; LAS unsigned char* Sl = lds + 34816; LAS unsigned char* VTe = lds + 69632;
    LAS float* av = (LAS float*)(lds + 143616); LAS float* Mv = (LAS float*)(lds + 144128); LAS float* bv = (LAS float*)(lds + 144640);
    const bf16_t* P = (const bf16_t*)(p.ws + WS_P); bf16_t* YM = (bf16_t*)(p.ws + WS_XN);
    const bf16_t* QC = (const bf16_t*)(p.ws + WS_QC); const bf16_t* KC = (const bf16_t*)(p.ws + WS_KC);
    const float* IG = (const float*)(p.ws + WS_IG); const float* LF = (const float*)(p.ws + WS_LF);
    const float mprev = ((const float*)(p.ws + WS_MPREV))[bh * 64 + c];
    __syncthreads();
    if (wave == 0) {
        const float l0 = LF[(size_t)(t0 + 2 * lane) * 4 + h], l1 = LF[(size_t)(t0 + 2 * lane + 1) * 4 + h];
        const float i0 = IG[(size_t)(t0 + 2 * lane) * 4 + h], i1 = IG[(size_t)(t0 + 2 * lane + 1) * 4 + h];
        float s = l0 + l1;
#pragma unroll
        for (int off = 1; off < 64; off <<= 1) { const float tt = __shfl_up(s, off); if (lane >= off) s += tt; }
        const float b1 = s, b0 = s - l1;
        const float a0 = i0 - b0, a1 = i1 - b1;
        float pm = fmaxf(a0, a1);
#pragma unroll
        for (int off = 1; off < 64; off <<= 1) { const float tt = __shfl_up(pm, off); if (lane >= off) pm = fmaxf(pm, tt); }
        float ex = __shfl_up(pm, 1); if (lane == 0) ex = -3.0e38f;
        Mv[2 * lane] = fmaxf(mprev, fmaxf(ex, a0)); Mv[2 * lane + 1] = fmaxf(mprev, pm);
        av[2 * lane] = a0; av[2 * lane + 1] = a1; bv[2 * lane] = b0; bv[2 * lane + 1] = b1;
    }
#pragma unroll
    for (int it = 0; it < 4; ++it) {
        const int e = (it * NTHREADS + tid) * 8, s = e >> 7, d0 = e & 127;
        *(LAS u32x4*)(Kl + s * 272 + d0 * 2) = *(const u32x4*)(KC + (size_t)(t0 + s) * 512 + h * 128 + d0);
    }
    stage_T<4>(P + p_off<3072, 4, 256>(t0, h, 0), 256, VTe, wave, lane);
    for (int i = tid; i < 1024; i += NTHREADS) { const int r = i >> 6, w = i & 63; *(LAS unsigned*)(VTe + (256 + r) * 272 + w * 4) = 0x3F803F80u; }
    bf16x8 qf[4];
#pragma unroll
    for (int kk = 0; kk < 4; ++kk) qf[kk] = *(const bf16x8*)(QC + (size_t)(t0 + 16 * wave + fr) * 512 + h * 128 + 32 * kk + 8 * fq);
    __syncthreads();
    const int t = 16 * wave + fr; const float Mt = Mv[t];
    const int stmax = wave | 1;
    for (int st = 0; st <= stmax; ++st) {
        f32x4 s4 = {0.f, 0.f, 0.f, 0.f};
#pragma unroll
        for (int kk = 0; kk < 4; ++kk) { const bf16x8 kf = ld_frag_lds(Kl + (16 * st + fr) * 272 + (32 * kk + 8 * fq) * 2); s4 = MFMA16(kf, qf[kk], s4); }
#pragma unroll
        for (int r = 0; r < 4; ++r) { const int s = 16 * st + 4 * fq + r; const float w = (s <= t) ? __expf(av[s] - Mt) : 0.f; s4[r] *= w; }
        u32x2 w; w.x = cvt_pk_bf16(s4[0], s4[1]); w.y = cvt_pk_bf16(s4[2], s4[3]);
        *(LAS u32x2*)(Sl + t * 272 + (16 * st + 4 * fq) * 2) = w;
    }
    __syncthreads();
    const bf16_t* cpt = (const bf16_t*)(p.ws + WS_CPT) + ((size_t)(bh * 64 + c) * 272) * 128;
    f32x4 acc[17];
#pragma unroll
    for (int n = 0; n < 17; ++n) acc[n] = (f32x4){0.f, 0.f, 0.f, 0.f};
#pragma unroll
    for (int half = 0; half < 2; ++half) {
        if (half) __syncthreads();
        {
            int tl = tid; asm volatile("" : "+v"(tl));
            const int e = tl * 8, r = e >> 7, d0 = e & 127;
            const bf16_t* cp_ = cpt + (size_t)(128 * half + r) * 128 + d0;
            const u32x4 c0_ = *(const u32x4*)cp_, c1_ = *(const u32x4*)(cp_ + 32 * 128), c2_ = *(const u32x4*)(cp_ + 64 * 128), c3_ = *(const u32x4*)(cp_ + 96 * 128);
            *(LAS u32x4*)(Kl + r * 272 + d0 * 2) = c0_;
            *(LAS u32x4*)(Kl + (r + 32) * 272 + d0 * 2) = c1_;
            *(LAS u32x4*)(Kl + (r + 64) * 272 + d0 * 2) = c2_;
            *(LAS u32x4*)(Kl + (r + 96) * 272 + d0 * 2) = c3_;
        }
        __syncthreads();
#pragma unroll
        for (int n8 = 0; n8 < 8; ++n8) {
#pragma unroll
            for (int kk = 0; kk < 4; ++kk) { const bf16x8 cf = ld_frag_lds(Kl + (16 * n8 + fr) * 272 + (32 * kk + 8 * fq) * 2); acc[8 * half + n8] = MFMA16(cf, qf[kk], acc[8 * half + n8]); }
        }
    }
#pragma unroll
    for (int kk = 0; kk < 4; ++kk) { const bf16x8 cf = *(const bf16x8*)(cpt + (size_t)(256 + fr) * 128 + 32 * kk + 8 * fq); acc[16] = MFMA16(cf, qf[kk], acc[16]); }
    const float ai = __expf(mprev - Mt);
#pragma unroll
    for (int n = 0; n < 17; ++n) acc[n] = acc[n] * ai;
    const int k2max = (16 * wave + 15) >> 5;
#pragma unroll
    for (int kk = 0; kk < 4; ++kk) {
        if (kk <= k2max) {
            const bf16x8 sf = ld_frag_lds(Sl + t * 272 + (32 * kk + 8 * fq) * 2);
#pragma unroll
            for (int n = 0; n < 17; ++n) { const bf16x8 vf = ld_frag_lds(VTe + (16 * n + fr) * 272 + (32 * kk + 8 * fq) * 2); acc[n] = MFMA16(vf, sf, acc[n]); }
        }
    }
    const float den = __shfl(acc[16][0], fr);
    const float mt = bv[t] + Mt;
    const float inv = rcpf_(fmaxf(fabsf(den), __expf(-mt)));
    const size_t grow = (size_t)(t0 + t);
    float ss = 0.f;
#pragma unroll
    for (int n = 0; n < 16; ++n) {
        const int v0 = 16 * n + 4 * fq;
        const u32x2 ow = *(const u32x2*)(P + p_off<4096, 4, 256>(t0 + t, h, v0));
        f32x4 y;
        y[0] = bflo(ow.x) * acc[n][0] * inv; y[1] = bfhi(ow.x) * acc[n][1] * inv; y[2] = bflo(ow.y) * acc[n][2] * inv; y[3] = bfhi(ow.y) * acc[n][3] * inv;
        ss += (y[0] * y[0] + y[1] * y[1]) + (y[2] * y[2] + y[3] * y[3]);
        acc[n] = y;
    }
    ss += __shfl_xor(ss, 16); ss += __shfl_xor(ss, 32);
    const float rstd = rsqrtf(ss * (1.f / 256.f) + EPS);
#pragma unroll
    for (int n = 0; n < 16; ++n) {
        const int v0 = 16 * n + 4 * fq;
        const f32x4 g = *(const f32x4*)(p.ml_out_g + h * 256 + v0);
        const f32x4 o = acc[n] * rstd * g;
        u32x2 w; w.x = cvt_pk_bf16(o[0], o[1]); w.y = cvt_pk_bf16(o[2], o[3]);
        *(u32x2*)(YM + grow * DM + 1024 + h * 256 + v0) = w;
    }
}

DI unsigned ord_key(float f) { const unsigned u = __float_as_uint(f); return (u & 0x80000000u) ? ~u : (u | 0x80000000u); }
DI float key_val(unsigned k) { return (k & 0x80000000u) ? __uint_as_float(k & 0x7fffffffu) : __uint_as_float(~k); }
DI unsigned umax_(unsigned a, unsigned b) { return a > b ? a : b; }
DI unsigned umin_(unsigned a, unsigned b) { return a < b ? a : b; }
#define DPPU(v, ctrl) ((unsigned)__builtin_amdgcn_update_dpp(0, (int)(v), (ctrl), 0xF, 0xF, true))
DI unsigned row_max_u32(unsigned v) {
    v = umax_(v, DPPU(v, 0xB1)); v = umax_(v, DPPU(v, 0x4E)); v = umax_(v, DPPU(v, 0x141)); v = umax_(v, DPPU(v, 0x140)); return v;
}
DI float row_sum_f32(float v) {
    v += __uint_as_float(DPPU(__float_as_uint(v), 0xB1)); v += __uint_as_float(DPPU(__float_as_uint(v), 0x4E));
    v += __uint_as_float(DPPU(__float_as_uint(v), 0x141)); v += __uint_as_float(DPPU(__float_as_uint(v), 0x140)); return v;
}
#define CEX(a, b) do { const unsigned mx_ = umax_(a, b), mn_ = umin_(a, b); a = mx_; b = mn_; } while (0)
template <int N> DI unsigned top16_row(unsigned (&s)[N], int c) {
    unsigned list = 0u;
#pragma unroll 1
    for (int it = 0; it < 16; ++it) {
        const unsigned wm = row_max_u32(s[0]);
        const bool win = (s[0] == wm);
#pragma unroll
        for (int i = 0; i < N - 1; ++i) s[i] = win ? s[i + 1] : s[i];
        s[N - 1] = win ? 0u : s[N - 1];
        list = (c == it) ? wm : list;
    }
    return list;
}

template <int N> DI void top16_row2(unsigned (&s)[N], unsigned (&t)[N], int c, unsigned& l1, unsigned& l2) {
    l1 = 0u; l2 = 0u;
#pragma unroll 1
    for (int it = 0; it < 16; ++it) {
        const unsigned wm1 = row_max_u32(s[0]), wm2 = row_max_u32(t[0]);
        const bool win1 = (s[0] == wm1), win2 = (t[0] == wm2);
#pragma unroll
        for (int i = 0; i < N - 1; ++i) { s[i] = win1 ? s[i + 1] : s[i]; t[i] = win2 ? t[i + 1] : t[i]; }
        s[N - 1] = win1 ? 0u : s[N - 1]; t[N - 1] = win2 ? 0u : t[N - 1];
        l1 = (c == it) ? wm1 : l1; l2 = (c == it) ? wm2 : l2;
    }
}

template <int N> DI void top16_row4(unsigned (&s)[N], unsigned (&t)[N], unsigned (&u)[N], unsigned (&v)[N], int c, unsigned& l1, unsigned& l2, unsigned& l3, unsigned& l4) {
    l1 = 0u; l2 = 0u; l3 = 0u; l4 = 0u;
#pragma unroll 1
    for (int it = 0; it < 16; ++it) {
        const unsigned wm1 = row_max_u32(s[0]), wm2 = row_max_u32(t[0]), wm3 = row_max_u32(u[0]), wm4 = row_max_u32(v[0]);
        const bool win1 = (s[0] == wm1), win2 = (t[0] == wm2), win3 = (u[0] == wm3), win4 = (v[0] == wm4);
#pragma unroll
        for (int i = 0; i < N - 1; ++i) { s[i] = win1 ? s[i + 1] : s[i]; t[i] = win2 ? t[i + 1] : t[i]; u[i] = win3 ? u[i + 1] : u[i]; v[i] = win4 ? v[i + 1] : v[i]; }
        s[N - 1] = win1 ? 0u : s[N - 1]; t[N - 1] = win2 ? 0u : t[N - 1]; u[N - 1] = win3 ? 0u : u[N - 1]; v[N - 1] = win4 ? 0u : v[N - 1];
        l1 = (c == it) ? wm1 : l1; l2 = (c == it) ? wm2 : l2; l3 = (c == it) ? wm3 : l3; l4 = (c == it) ? wm4 : l4;
    }
}
#define SORT8(s) do { CEX(s[0], s[1]); CEX(s[2], s[3]); CEX(s[4], s[5]); CEX(s[6], s[7]); CEX(s[0], s[2]); CEX(s[1], s[3]); CEX(s[4], s[6]); CEX(s[5], s[7]); CEX(s[1], s[2]); CEX(s[5], s[6]); \
    CEX(s[0], s[4]); CEX(s[1], s[5]); CEX(s[2], s[6]); CEX(s[3], s[7]); CEX(s[2], s[4]); CEX(s[3], s[5]); CEX(s[1], s[2]); CEX(s[3], s[4]); CEX(s[5], s[6]); } while (0)
#define SORT4(s) do { CEX(s[0], s[1]); CEX(s[2], s[3]); CEX(s[0], s[2]); CEX(s[1], s[3]); CEX(s[1], s[2]); } while (0)

DI void peer_select(const Params& p, LAS unsigned char* lds) {
    const int tid = threadIdx.x, lane = tid & 63, wave = __builtin_amdgcn_readfirstlane(tid >> 6), c = lane & 15, g = lane >> 4, rowbase = lane & 48;
    const bf16_t* Q = (const bf16_t*)(p.ws + WS_Q); const bf16_t* KB1 = (const bf16_t*)(p.ws + WS_KB1); const bf16_t* KB2 = (const bf16_t*)(p.ws + WS_KB2);
    int* SELID = (int*)(p.ws + WS_SELID); float* SELG = (float*)(p.ws + WS_SELG);
    unsigned pk = 0u, validmask = 0u;
#pragma unroll
    for (int q = 0; q < 4; ++q) {
        const int target = 4 * c + q; int ci = 0, cj = 0, cnt = 0; bool v = false;
#pragma unroll
        for (int i = 0; i < 16; ++i) { const int nj = 16 / (i + 1); if (target >= cnt && target < cnt + nj) { ci = i; cj = target - cnt; v = true; } cnt += nj; }
        pk |= (unsigned)((ci << 4) | cj) << (8 * q); validmask |= (v ? 1u : 0u) << q;
    }
    for (int tile = blockIdx.x * 8 + wave; tile < T_TOK / 16; tile += gridDim.x * 8) {
        const int tok0 = tile * 16;
        for (int h = 0; h < 8; ++h) {
            __syncthreads();
            int tl = tid; asm volatile("" : "+v"(tl));
#pragma unroll
            for (int it = 0; it < 4; ++it) {
                const int idx = it * NTHREADS + tl, which = idx >> 10, r = (idx & 1023) >> 3, q = idx & 7;
                *(LAS u32x4*)(lds + which * 18432 + r * 144 + q * 16) = *(const u32x4*)((which ? KB2 : KB1) + ((size_t)(h * 128 + r)) * 64 + q * 8);
            }
            bf16x8 a1[2], a2[2];
            {
                const bf16_t* qp = Q + (size_t)(tok0 + c) * 1024 + h * 128 + g * 8;
                a1[0] = *(const bf16x8*)qp; a1[1] = *(const bf16x8*)(qp + 32); a2[0] = *(const bf16x8*)(qp + 64); a2[1] = *(const bf16x8*)(qp + 96);
            }
            __syncthreads();
            f32x4 acc1[8], acc2[8];
#pragma unroll
            for (int nt = 0; nt < 8; ++nt) {
                const LAS unsigned char* kp = lds + (nt * 16 + c) * 144 + g * 16;
                acc1[nt] = (f32x4){0.f, 0.f, 0.f, 0.f}; acc2[nt] = (f32x4){0.f, 0.f, 0.f, 0.f};
                acc1[nt] = MFMA16(a1[0], ld_frag_lds(kp), acc1[nt]); acc1[nt] = MFMA16(a1[1], ld_frag_lds(kp + 64), acc1[nt]);
                acc2[nt] = MFMA16(a2[0], ld_frag_lds(kp + 18432), acc2[nt]); acc2[nt] = MFMA16(a2[1], ld_frag_lds(kp + 18432 + 64), acc2[nt]);
            }
#pragma unroll
            for (int rp = 0; rp < 2; ++rp) {
                const int r0 = 2 * rp, r1 = 2 * rp + 1;
                unsigned sA[8], sB[8], sC[8], sD[8];
#pragma unroll
                for (int nt = 0; nt < 8; ++nt) {
                    const unsigned ix = (unsigned)(127 - (nt * 16 + c));
                    sA[nt] = (ord_key(acc1[nt][r0]) & ~0x7Fu) | ix; sB[nt] = (ord_key(acc2[nt][r0]) & ~0x7Fu) | ix;
                    sC[nt] = (ord_key(acc1[nt][r1]) & ~0x7Fu) | ix; sD[nt] = (ord_key(acc2[nt][r1]) & ~0x7Fu) | ix;
                }
                SORT8(sA); SORT8(sB); SORT8(sC); SORT8(sD);
                unsigned lA, lB, lC, lD;
                top16_row4<8>(sA, sB, sC, sD, c, lA, lB, lC, lD);
                unsigned c0[4], c1[4];
#pragma unroll
                for (int q = 0; q < 4; ++q) {
                    const int ci = (int)((pk >> (8 * q + 4)) & 15u), cj = (int)((pk >> (8 * q)) & 15u);
                    const unsigned ka = (unsigned)__shfl((int)lA, rowbase + ci), kb = (unsigned)__shfl((int)lB, rowbase + cj);
                    const unsigned kc = (unsigned)__shfl((int)lC, rowbase + ci), kd = (unsigned)__shfl((int)lD, rowbase + cj);
                    const float cand0 = key_val(ka & ~0x7Fu) + key_val(kb & ~0x7Fu), cand1 = key_val(kc & ~0x7Fu) + key_val(kd & ~0x7Fu);
                    const bool ok = ((validmask >> q) & 1u) != 0u; const unsigned ix = (unsigned)(63 - (4 * c + q));
                    c0[q] = ok ? ((ord_key(cand0) & ~0x3Fu) | ix) : 0u; c1[q] = ok ? ((ord_key(cand1) & ~0x3Fu) | ix) : 0u;
                }
                SORT4(c0); SORT4(c1);
                unsigned sel0, sel1;
                top16_row2<4>(c0, c1, c, sel0, sel1);
#pragma unroll
                for (int u = 0; u < 2; ++u) {
                    const unsigned sel = u ? sel1 : sel0, list1 = u ? lC : lA, list2 = u ? lD : lB; const int r = u ? r1 : r0;
                    const int slot = 63 - (int)(sel & 63u);
                    const unsigned pkv = (unsigned)__shfl((int)pk, rowbase + (slot >> 2));
                    const int cij = (int)((pkv >> (8 * (slot & 3))) & 0xFFu);
                    const unsigned e1 = (unsigned)__shfl((int)list1, rowbase + (cij >> 4)), e2 = (unsigned)__shfl((int)list2, rowbase + (cij & 15));
                    const int eid = (127 - (int)(e1 & 127u)) * 128 + (127 - (int)(e2 & 127u));
                    const float sv = key_val(sel & ~0x3Fu), mx = key_val(row_max_u32(sel) & ~0x3Fu);
                    const float ev = __expf(sv - mx);
                    const float sum = row_sum_f32(ev);
                    const size_t o = (size_t)(tok0 + 4 * g + r) * 128 + h * 16 + c;
                    SELID[o] = eid; SELG[o] = ev * rcpf_(sum);
                }
            }
        }
    }
}

DI f32x2 pkfma(f32x2 a, f32x2 b, f32x2 c) { return __builtin_elementwise_fma(a, b, c); }
DI void peer_gather(const Params& p, LAS unsigned char* lds) {
    const int tid = threadIdx.x, lane = tid & 63, wave = __builtin_amdgcn_readfirstlane(tid >> 6);
    LAS float* scr = (LAS float*)lds + wave * (16 * 68);
    LAS float* cfl = (LAS float*)(lds + 8 * 16 * 68 * 4) + wave * 128;
    const unsigned char* Ub = p.ws + WS_UB; const unsigned char* Vb = p.ws + WS_VB;
    const float* PSS2 = (const float*)(p.ws + WS_PSS2);
    const int* SELID = (const int*)(p.ws + WS_SELID); const float* SELG = (const float*)(p.ws + WS_SELG);
    const int gw = blockIdx.x * 8 + wave, nw = gridDim.x * 8;
    for (int t = gw; t < T_TOK; t += nw) {
        const int idA = SELID[(size_t)t * 128 + lane], idB = SELID[(size_t)t * 128 + 64 + lane];
        const float gA = SELG[(size_t)t * 128 + lane], gB = SELG[(size_t)t * 128 + 64 + lane];
        const bf16_t* xrow = (const bf16_t*)(p.ws + WS_X1G) + (size_t)t * DM + lane * 32;
        float* orow = p.out + (size_t)t * DM + lane * 32;
        const float pv = lane < 32 ? PSS2[(size_t)t * 32 + lane] : 0.f;
        const float rstd2 = rsqrtf(wave_sum(pv) * (1.f / 2048.f) + EPS);
        f32x2 h2[16];
#pragma unroll
        for (int q = 0; q < 4; ++q) {
            const u32x4 xw = *(const u32x4*)(xrow + q * 8);
            const f32x4 g0 = *(const f32x4*)(p.norm2_g + lane * 32 + q * 8), g1 = *(const f32x4*)(p.norm2_g + lane * 32 + q * 8 + 4);
            h2[4 * q] = (f32x2){bflo(xw.x) * rstd2 * g0[0], bfhi(xw.x) * rstd2 * g0[1]};
            h2[4 * q + 1] = (f32x2){bflo(xw.y) * rstd2 * g0[2], bfhi(xw.y) * rstd2 * g0[3]};
            h2[4 * q + 2] = (f32x2){bflo(xw.z) * rstd2 * g1[0], bfhi(xw.z) * rstd2 * g1[1]};
            h2[4 * q + 3] = (f32x2){bflo(xw.w) * rstd2 * g1[2], bfhi(xw.w) * rstd2 * g1[3]};
        }
        constexpr int NPK = 8;
        u32x4 buf[2][NPK]; unsigned short bsc[2][NPK];
#define PEER_LOAD(TB, st, base) do { const int idv_ = ((base) < 64) ? idA : idB; _Pragma("unroll") for (int e_ = 0; e_ < NPK; ++e_) { \
            const int id_ = __builtin_amdgcn_readlane(idv_, ((base) + e_) & 63); const unsigned char* r_ = (TB) + (size_t)id_ * 1088; \
            buf[st][e_] = *(const u32x4*)(r_ + lane * 16); bsc[st][e_] = *(const unsigned short*)(r_ + 1024 + (lane >> 1) * 2); } } while (0)
#define PEER_DOT(st, slot0) do { _Pragma("unroll") for (int e_ = 0; e_ < NPK; ++e_) { f32x2 a2_ = {0.f, 0.f}; \
            _Pragma("unroll") for (int d_ = 0; d_ < 4; ++d_) { const unsigned w_ = buf[st][e_][d_]; \
                a2_ = pkfma(h2[d_ * 4 + 0], __builtin_amdgcn_cvt_scalef32_pk_f32_fp4(w_, 1.0f, 0), a2_); a2_ = pkfma(h2[d_ * 4 + 1], __builtin_amdgcn_cvt_scalef32_pk_f32_fp4(w_, 1.0f, 1), a2_); \
                a2_ = pkfma(h2[d_ * 4 + 2], __builtin_amdgcn_cvt_scalef32_pk_f32_fp4(w_, 1.0f, 2), a2_); a2_ = pkfma(h2[d_ * 4 + 3], __builtin_amdgcn_cvt_scalef32_pk_f32_fp4(w_, 1.0f, 3), a2_); } \
            scr[((slot0) + e_) * 68 + lane] = (a2_[0] + a2_[1]) * bf2f(bsc[st][e_]); } } while (0)
        PEER_LOAD(Ub, 0, 0);
        for (int b = 0; b < 128 / NPK; b += 2) {
            PEER_LOAD(Ub, 1, (b + 1) * NPK);
            PEER_DOT(0, (b * NPK) & 15);
            if (b + 2 < 128 / NPK) PEER_LOAD(Ub, 0, (b + 2) * NPK);
            PEER_DOT(1, ((b + 1) * NPK) & 15);
            if ((((b + 2) * NPK) & 15) == 0) {
                WAVE_LDS_SYNC();
                float sum = 0.f;
#pragma unroll
                for (int i = 0; i < 4; ++i) { const f32x4 r = *(const LAS f32x4*)(scr + (lane >> 2) * 68 + (lane & 3) * 16 + 4 * i); sum += (r[0] + r[1]) + (r[2] + r[3]); }
                sum += __shfl_xor(sum, 1); sum += __shfl_xor(sum, 2);
                const int k0 = (b + 2) * NPK - 16;
                const int k = k0 + (lane >> 2);
                const float gate = __shfl((k0 < 64) ? gA : gB, k & 63);
                if ((lane & 3) == 0) cfl[k] = gate * gelu_t(sum);
                WAVE_LDS_SYNC();
            }
        }
        f32x2 acc[16];
#pragma unroll
        for (int i = 0; i < 16; ++i) acc[i] = (f32x2){0.f, 0.f};
#define PEER_AXPY(st, base) do { _Pragma("unroll") for (int e_ = 0; e_ < NPK; ++e_) { const float c_ = cfl[(base) + e_] * bf2f(bsc[st][e_]); const f32x2 c2_ = {c_, c_}; \
            _Pragma("unroll") for (int d_ = 0; d_ < 4; ++d_) { const unsigned w_ = buf[st][e_][d_]; \
                acc[d_ * 4 + 0] = pkfma(c2_, __builtin_amdgcn_cvt_scalef32_pk_f32_fp4(w_, 1.0f, 0), acc[d_ * 4 + 0]); acc[d_ * 4 + 1] = pkfma(c2_, __builtin_amdgcn_cvt_scalef32_pk_f32_fp4(w_, 1.0f, 1), acc[d_ * 4 + 1]); \
                acc[d_ * 4 + 2] = pkfma(c2_, __builtin_amdgcn_cvt_scalef32_pk_f32_fp4(w_, 1.0f, 2), acc[d_ * 4 + 2]); acc[d_ * 4 + 3] = pkfma(c2_, __builtin_amdgcn_cvt_scalef32_pk_f32_fp4(w_, 1.0f, 3), acc[d_ * 4 + 3]); } } } while (0)
        PEER_LOAD(Vb, 0, 0);
        for (int b = 0; b < 128 / NPK; b += 2) {
            PEER_LOAD(Vb, 1, (b + 1) * NPK);
            PEER_AXPY(0, b * NPK);
            if (b + 2 < 128 / NPK) PEER_LOAD(Vb, 0, (b + 2) * NPK);
            PEER_AXPY(1, (b + 1) * NPK);
        }
        float ss = 0.f;
#pragma unroll
        for (int q = 0; q < 4; ++q) {
            const u32x4 xw = *(const u32x4*)(xrow + q * 8);
            acc[4 * q] += (f32x2){bflo(xw.x), bfhi(xw.x)}; acc[4 * q + 1] += (f32x2){bflo(xw.y), bfhi(xw.y)};
            acc[4 * q + 2] += (f32x2){bflo(xw.z), bfhi(xw.z)}; acc[4 * q + 3] += (f32x2){bflo(xw.w), bfhi(xw.w)};
#pragma unroll
            for (int i = 0; i < 4; ++i) { const f32x2 a = acc[4 * q + i]; ss += a[0] * a[0] + a[1] * a[1]; }
        }
        const float rstd = rsqrtf(wave_sum(ss) * (1.f / 2048.f) + EPS);
#pragma unroll
        for (int q = 0; q < 8; ++q) {
            const f32x4 g0 = *(const f32x4*)(p.final_g + lane * 32 + q * 4);
            const f32x2 a = acc[2 * q], b = acc[2 * q + 1];
            const f32x4 o0 = {a[0] * rstd * g0[0], a[1] * rstd * g0[1], b[0] * rstd * g0[2], b[1] * rstd * g0[3]};
            *(f32x4*)(orow + q * 4) = o0;
        }
        WAVE_LDS_SYNC();
    }
}

#define XB_TMO      128
#define XB_XCNT(j)  (256  + 64 * (j))
#define XB_XSUB(j)  (1280 + 64 * (j))
#define XB_XGEN(j)  (2304 + 64 * (j))
#define XB_TOP      3328
#define XB_TOPGEN   3392
#define XCD_BAR_WORDS 3456
#define XB_SPIN_CAP (1u << 18)

__device__ __forceinline__ unsigned xb_ld(unsigned* p)              { return __hip_atomic_load(p, __ATOMIC_RELAXED, __HIP_MEMORY_SCOPE_AGENT); }
__device__ __forceinline__ unsigned xb_add(unsigned* p, unsigned v) { return __hip_atomic_fetch_add(p, v, __ATOMIC_RELAXED, __HIP_MEMORY_SCOPE_AGENT); }
__device__ __forceinline__ unsigned xb_xcc_id() { return (unsigned)__builtin_amdgcn_s_getreg((3 << 11) | 20) & 0xFu; }
#define XB_SPIN(cond, bar) do { unsigned _sp = 0; while (cond) { __builtin_amdgcn_s_sleep(1); \
    if ((++_sp & 255u) == 0u) { if (xb_ld(&(bar)[XB_TMO])) break; if (_sp > XB_SPIN_CAP) { atomicAdd(&(bar)[XB_TMO], 1u); break; } } } } while (0)

struct XcdBarrier {
    unsigned* bar; unsigned x;
    volatile LAS unsigned* st;
};

__device__ __forceinline__ XcdBarrier xcd_barrier_post(unsigned* bar, volatile LAS unsigned* st) {
    XcdBarrier b; b.bar = bar; b.x = xb_xcc_id(); b.st = st;
    if (threadIdx.x == 0) (void)xb_add(&bar[XB_XCNT(b.x)], 1u);
    return b;
}
__device__ __forceinline__ void xcd_barrier_complete(unsigned* bar, unsigned x, unsigned& nloc, unsigned& nx) {
    const unsigned G = gridDim.x * gridDim.y * gridDim.z;
    unsigned sum, cnt, mine, sp = 0u;
    for (;;) {
        sum = 0u; cnt = 0u; mine = 0u;
#pragma unroll
        for (unsigned j = 0; j < 16; ++j) { const unsigned c = xb_ld(&bar[XB_XCNT(j)]); sum += c; cnt += (c > 0u) ? 1u : 0u; mine = (j == x) ? c : mine; }
        if (sum == G) break;
        __builtin_amdgcn_s_sleep(1);
        if ((++sp & 255u) == 0u) { if (xb_ld(&bar[XB_TMO])) break; if (sp > XB_SPIN_CAP) { atomicAdd(&bar[XB_TMO], 1u); break; } }
    }
    nloc = mine > 0u ? mine : 1u; nx = cnt > 0u ? cnt : 1u;
}

__device__ __forceinline__ void xcd_barrier(const XcdBarrier& b) {
    asm volatile("s_waitcnt vmcnt(0)" ::: "memory");
    __syncthreads();
    if (threadIdx.x == 0) {
        unsigned* bar = b.bar;
        __builtin_amdgcn_s_waitcnt(0);
        unsigned nloc = b.st[0], nx = b.st[1];
        if (nloc == 0u) { xcd_barrier_complete(bar, b.x, nloc, nx); b.st[0] = nloc; b.st[1] = nx; }
        const unsigned old = xb_add(&bar[XB_XSUB(b.x)], 1u);
        const unsigned gen = old / nloc;
        if (old + 1u == (gen + 1u) * nloc) {
            __builtin_amdgcn_fence(__ATOMIC_RELEASE, "agent");
            asm volatile("s_waitcnt vmcnt(0)" ::: "memory");
            const unsigned og = xb_add(&bar[XB_TOP], 1u);
            const unsigned tg = og / nx;
            if (og + 1u == (tg + 1u) * nx) xb_add(&bar[XB_TOPGEN], 1u);
            else XB_SPIN(xb_ld(&bar[XB_TOPGEN]) == tg, bar);
            __builtin_amdgcn_fence(__ATOMIC_ACQUIRE, "agent");
            xb_add(&bar[XB_XGEN(b.x)], 1u);
            asm volatile("s_waitcnt vmcnt(0)" ::: "memory");
        } else {
            XB_SPIN(xb_ld(&bar[XB_XGEN(b.x)]) == gen, bar);
            __builtin_amdgcn_fence(__ATOMIC_ACQUIRE, "agent");
            asm volatile("s_waitcnt vmcnt(0)" ::: "memory");
        }
    }
    __syncthreads();
}

#ifndef PROBE_DUP
#define PROBE_DUP 0
#endif
#define REP(bit) for (int rep_ = 0; rep_ < (((PROBE_DUP) >> (bit)) & 1) + 1; ++rep_)
#define PH1() { pg8::Gemm g{(const bf16_t*)(p.ws + WS_XN), (const bf16_t*)(p.ws + WS_WINT), T_TOK, NPROJ, DM}; pg8::StaticOrder S; S.init(T_TOK, NPROJ, G, bx); Epi1 E{(bf16_t*)(p.ws + WS_P), (float*)(p.ws + WS_PSSV)}; pg8::gemm_phase<Epi1, pg8::StaticOrder, true, true>(lds, g, S, E); xcd_barrier(xbar); }
#define PH3() { pg8::Gemm g{(const bf16_t*)(p.ws + WS_XN), (const bf16_t*)(p.ws + WS_WOUTT), T_TOK, DM, DM}; pg8::StaticOrder S; S.init(T_TOK, DM, G, bx); Epi2 E{p.x, (bf16_t*)(p.ws + WS_X1G), (float*)(p.ws + WS_PSS2)}; pg8::gemm_phase<Epi2, pg8::StaticOrder, true, true>(lds, g, S, E); xcd_barrier(xbar); }
#define PH4() { pg8::Gemm g{(const bf16_t*)(p.ws + WS_X1G), (const bf16_t*)(p.ws + WS_WQT), T_TOK, 1024, DM}; pg8::StaticOrder S; S.init(T_TOK, 1024, G, bx); Epi3 E{(bf16_t*)(p.ws + WS_Q), (const float*)(p.ws + WS_PSS2)}; pg8::gemm_phase<Epi3, pg8::StaticOrder, true, true>(lds, g, S, E); xcd_barrier(xbar); }
__global__ void __launch_bounds__(NTHREADS, 2) hymba_fwd(Params p) {
    extern __shared__ __attribute__((aligned(16))) unsigned char smem[];
    LAS unsigned char* lds = (LAS unsigned char*)smem;
    cg::grid_group grid = cg::this_grid();
    const int G = gridDim.x, bx = blockIdx.x;
    unsigned* barw = (unsigned*)(p.ws + WS_BAR);
    volatile LAS unsigned* xst = (volatile LAS unsigned*)(lds + LDS_BYTES - 16);
    if (threadIdx.x < 4) xst[threadIdx.x] = 0u;
    if (bx == 0) { for (int i = threadIdx.x; i < XCD_BAR_WORDS; i += NTHREADS) barw[i] = 0u; }
    __syncthreads();
    REP(0) { phase0(p, lds); grid.sync(); }
    const XcdBarrier xbar = xcd_barrier_post(barw, xst);
    PH1()
#if (PROBE_DUP >> 1) & 1
    PH1()
#endif
    REP(2) {
        for (int si = bx; si < 256; si += G) {
            const int b = si >> 6, c = si & 63;
            gmlp_bc(p, lds, b, c);
            for (int h = 0; h < 4; ++h) mlstm_local(p, lds, b, c, h);
        }
        xcd_barrier(xbar);
    }
    REP(3) { phase_scan(p); xcd_barrier(xbar); }
    REP(4) { for (int it = bx; it < 1024; it += G) mlstm_out(p, lds, it >> 8, (it >> 2) & 63, it & 3); xcd_barrier(xbar); }
    PH3()
#if (PROBE_DUP >> 5) & 1
    PH3()
#endif
    PH4()
#if (PROBE_DUP >> 6) & 1
    PH4()
#endif
    REP(7) { peer_select(p, lds); xcd_barrier(xbar); }
    peer_gather(p, lds);
}

extern "C" void kernel_launch(void* const* d_in, const int* in_sizes, int n_in, void* d_out, int out_size, void* d_ws, size_t ws_size, hipStream_t stream) {
    static int grid_blocks = 0;
    if (grid_blocks == 0) {
        if (n_in != 20 || ws_size < WS_END) { fprintf(stderr, "kernel_launch: unexpected n_in %d or ws_size %zu (need %zu)\n", n_in, ws_size, (size_t)WS_END); grid_blocks = -1; return; }
        int dev = 0, cus = 0, per_cu = 0;
        hipGetDevice(&dev);
        hipDeviceGetAttribute(&cus, hipDeviceAttributeMultiprocessorCount, dev);
        hipFuncSetAttribute((const void*)hymba_fwd, hipFuncAttributeMaxDynamicSharedMemorySize, LDS_BYTES);
        hipOccupancyMaxActiveBlocksPerMultiprocessor(&per_cu, (const void*)hymba_fwd, NTHREADS, LDS_BYTES);
        if (per_cu < 1) { fprintf(stderr, "kernel_launch: occupancy query says %d blocks per CU\n", per_cu); per_cu = 1; }
        if (per_cu > 1) per_cu = 1;
        grid_blocks = cus * per_cu;
        (void)hipGetLastError();
    }
    if (grid_blocks < 0) return;
    Params p{};
    p.x = (const float*)d_in[0]; p.norm1_g = (const float*)d_in[1]; p.w_in = (const float*)d_in[2]; p.gm_vnorm_g = (const float*)d_in[3];
    p.w_spatial = (const float*)d_in[4]; p.b_spatial = (const float*)d_in[5]; p.ml_conv_w = (const float*)d_in[6]; p.ml_conv_b = (const float*)d_in[7];
    p.ml_b_i = (const float*)d_in[8]; p.ml_b_f = (const float*)d_in[9]; p.gm_out_g = (const float*)d_in[10]; p.ml_out_g = (const float*)d_in[11];
    p.w_out = (const float*)d_in[12]; p.norm2_g = (const float*)d_in[13]; p.peer_wq = (const float*)d_in[14]; p.peer_k1 = (const float*)d_in[15];
    p.peer_k2 = (const float*)d_in[16]; p.peer_u = (const float*)d_in[17]; p.peer_v = (const float*)d_in[18]; p.final_g = (const float*)d_in[19];
    p.out = (float*)d_out; p.ws = (unsigned char*)d_ws;
    void* args[] = {&p};
    hipError_t e = hipLaunchCooperativeKernel((const void*)hymba_fwd, dim3(grid_blocks), dim3(NTHREADS), args, LDS_BYTES, stream);
    if (e != hipSuccess) fprintf(stderr, "cooperative launch failed: %s (grid %d)\n", hipGetErrorString(e), grid_blocks);
}
```

```cpp
#include <hip/hip_runtime.h>
#include <hip/hip_cooperative_groups.h>
#include <cstdio>
#include <cstdint>
namespace cg = cooperative_groups;
namespace pg8 {
#define PG8_LAS __attribute__((address_space(3)))
typedef unsigned short bf16_t;
typedef short bf16x8 __attribute__((ext_vector_type(8)));
typedef float f32x4 __attribute__((ext_vector_type(4)));
typedef unsigned u32x4 __attribute__((ext_vector_type(4)));
constexpr int BM = 256, BK = 64, HALF = 128, HTB = HALF * BK * 2  , STAGE_BYTES = 8 * HTB, NXCD = 8, WGM = 8;

__host__ __device__ __forceinline__ int lds_byte(int r, int c) { const int st = (r >> 4) * 2 + (c >> 5), rr = r & 15, cc = c & 31, ob = rr * 64 + cc * 2; return st * 1024 + (ob ^ (((ob >> 9) & 1) << 5)); }
__host__ __device__ __forceinline__ void stage_rc(int b, int& R, int& C) { const int st = b / 1024, sb = b % 1024, swz = sb ^ (((sb >> 9) & 1) << 5); R = (st >> 1) * 16 + swz / 64; C = (st & 1) * 32 + (swz % 64) / 2; }
__host__ __device__ __forceinline__ int perm32(int rho) { const int n = rho >> 4, i = rho & 15; return 8 * (i >> 2) + 4 * n + (i & 3); }

struct Unit { int pm, pn; };
struct Gemm { const bf16_t* A; const bf16_t* Bt; int M, N, K; };

struct StaticOrder {
    int nM, nN, nwg, G, c;
    __host__ __device__ void init(int M, int N, int G_, int c_) { nM = M / BM; nN = N / BM; nwg = nM * nN; G = G_; c = c_; }
    __host__ __device__ bool next(int i, Unit& u) const {
        const long L = (long)i * G + c; if (L >= nwg) return false;
        int wgid = (int)L; { const int q = nwg / NXCD, r = nwg % NXCD, xcd = wgid % NXCD, off = wgid / NXCD; wgid = (xcd < r ? xcd * (q + 1) : r * (q + 1) + (xcd - r) * q) + off; }
        const int nig = WGM * nN, gid = wgid / nig, fm = gid * WGM, gsz = (nM - fm) < WGM ? (nM - fm) : WGM;
        u.pm = fm + ((wgid % nig) % gsz); u.pn = (wgid % nig) / gsz; return true;
    }
    __device__ __forceinline__ void a_ready(const Unit&) const {}
    __device__ __forceinline__ void done(const Unit&) const {}
};
__device__ __forceinline__ unsigned cvt_pk_bf16(float lo, float hi) { unsigned r; asm volatile("v_cvt_pk_bf16_f32 %0, %1, %2" : "=v"(r) : "v"(lo), "v"(hi)); return r; }
template <class Epi, class Sched, bool ALIGN_EPI = false, bool SP2 = false>
__device__ __forceinline__ void gemm_phase(PG8_LAS unsigned char* lds, const Gemm g, const Sched& S, const Epi& E) {
    const int tid = threadIdx.x, wid = __builtin_amdgcn_readfirstlane(tid >> 6), lane = tid & 63, wr = wid >> 2, wc = wid & 3, fr = lane & 15, fq = lane >> 4;
    const int K = g.K, nt = K / BK;
    unsigned voffA[2], voffB[2];
#pragma unroll
    for (int i = 0; i < 2; ++i) { int R, C; stage_rc(tid * 16 + i * 8192, R, C); const int Rb = Epi::PERM ? ((R & ~31) + perm32(R & 31)) : R;
        voffA[i] = (unsigned)(R * K + C) * 2u; voffB[i] = (unsigned)(Rb * K + C) * 2u; }
    const size_t kstep = (size_t)(BK * 2);
    const size_t hstep = (size_t)HALF * K * 2;
    const size_t tstep = 2 * hstep;
    const unsigned ldsw = (unsigned)wid * 1024u;
    const int aoff = lds_byte(wr * 64 + fr, fq * 8), boff = lds_byte(wc * 32 + fr, fq * 8);
#define PG8_SA(b, h) (((b) * 2 + (h)) * HTB)
#define PG8_SB(b, h) ((4 + (b) * 2 + (h)) * HTB)
#define PG8_STAGE(bufoff, gbase, voff) do { _Pragma("unroll") for (int _i = 0; _i < 2; ++_i) \
        __builtin_amdgcn_global_load_lds((const unsigned*)((const char*)(gbase) + (voff)[_i]), (PG8_LAS unsigned*)(lds + (bufoff) + ldsw + _i * 8192), 16, 0, 0); } while (0)
#define PG8_LDA(dst, b, h) do { _Pragma("unroll") for (int m = 0; m < 4; ++m) _Pragma("unroll") for (int k = 0; k < 2; ++k) dst[m][k] = *(const PG8_LAS bf16x8*)(lds + PG8_SA(b, h) + aoff + m * 2048 + k * 1024); } while (0)
#define PG8_LDB(dst, b, h) do { _Pragma("unroll") for (int n = 0; n < 2; ++n) _Pragma("unroll") for (int k = 0; k < 2; ++k) dst[n][k] = *(const PG8_LAS bf16x8*)(lds + PG8_SB(b, h) + boff + n * 2048 + k * 1024); } while (0)
#define PG8_MMA(ai, bj, At, Bt) do { __builtin_amdgcn_s_setprio(1); _Pragma("unroll") for (int m = 0; m < 4; ++m) _Pragma("unroll") for (int n = 0; n < 2; ++n) _Pragma("unroll") for (int k = 0; k < 2; ++k) \
        acc[ai][bj][m][n] = __builtin_amdgcn_mfma_f32_16x16x32_bf16(Bt[n][k], At[m][k], acc[ai][bj][m][n], 0, 0, 0); __builtin_amdgcn_s_setprio(0); } while (0)
#define PG8_WAIT_V(n) asm volatile("s_waitcnt vmcnt(" #n ")" ::: "memory")
#define PG8_WAIT_L(n) asm volatile("s_waitcnt lgkmcnt(" #n ")" ::: "memory")
#define PG8_BAR __builtin_amdgcn_s_barrier()
#define PG8_SCHED __builtin_amdgcn_sched_barrier(0)
    Unit cur, nxt; int ui = 0;
    if (!S.next(0, cur)) return;
    f32x4 acc[2][2][4][2];
#pragma unroll
    for (int a = 0; a < 2; ++a)
#pragma unroll
        for (int b = 0; b < 2; ++b)
#pragma unroll
            for (int m = 0; m < 4; ++m)
#pragma unroll
                for (int n = 0; n < 2; ++n) acc[a][b][m][n] = (f32x4){0.f, 0.f, 0.f, 0.f};
    bf16x8 At[4][2], B0[2][2], B1[2][2];
    const char* cA = (const char*)g.A + (size_t)cur.pm * tstep; const char* cB = (const char*)g.Bt + (size_t)cur.pn * tstep;
    S.a_ready(cur);
    if constexpr (SP2) {
        PG8_STAGE(PG8_SB(0, 0), cB, voffB); PG8_STAGE(PG8_SB(0, 1), cB + hstep, voffB); PG8_STAGE(PG8_SA(0, 0), cA, voffA); PG8_STAGE(PG8_SA(0, 1), cA + hstep, voffA);
        if (wr == 1) PG8_BAR;
        PG8_WAIT_V(2); PG8_BAR;
        PG8_STAGE(PG8_SB(1, 0), cB + kstep, voffB); PG8_STAGE(PG8_SA(1, 0), cA + kstep, voffA); PG8_STAGE(PG8_SB(1, 1), cB + hstep + kstep, voffB);
        PG8_WAIT_V(6); PG8_BAR;
    } else {
        PG8_STAGE(PG8_SB(0, 0), cB, voffB); PG8_STAGE(PG8_SA(0, 0), cA, voffA); PG8_STAGE(PG8_SB(0, 1), cB + hstep, voffB); PG8_STAGE(PG8_SA(0, 1), cA + hstep, voffA);
        if (wr == 1) PG8_BAR;
        PG8_WAIT_V(4); PG8_BAR;
        PG8_STAGE(PG8_SB(1, 0), cB + kstep, voffB); PG8_STAGE(PG8_SA(1, 0), cA + kstep, voffA); PG8_STAGE(PG8_SB(1, 1), cB + hstep + kstep, voffB);
        PG8_WAIT_V(6); PG8_BAR;
    }
    for (;;) {
        const bool has_next = S.next(ui + 1, nxt);
        const char* nA = has_next ? (const char*)g.A + (size_t)nxt.pm * tstep : cA; const char* nB = has_next ? (const char*)g.Bt + (size_t)nxt.pn * tstep : cB;
        for (int t = 0; t < nt; t += 2) {
            const bool last = (t == nt - 2);
            const char* a1 = cA + (size_t)(t + 1) * kstep;
            const char* a2 = last ? nA : cA + (size_t)(t + 2) * kstep; const char* b2 = last ? nB : cB + (size_t)(t + 2) * kstep;
            const char* a3 = a2 + kstep; const char* b3 = b2 + kstep;
            if (last && has_next) S.a_ready(nxt);
            if constexpr (SP2) {
            PG8_LDB(B0, 0, 0); PG8_LDB(B1, 0, 1); PG8_SCHED; PG8_LDA(At, 0, 0); PG8_STAGE(PG8_SA(1, 1), a1 + hstep, voffA);
            PG8_WAIT_V(8); PG8_WAIT_L(0); PG8_BAR; PG8_MMA(0, 0, At, B0); PG8_MMA(0, 1, At, B1); PG8_BAR; PG8_SCHED;
            PG8_LDA(At, 0, 1); PG8_STAGE(PG8_SB(0, 0), b2, voffB); PG8_STAGE(PG8_SB(0, 1), b2 + hstep, voffB); PG8_STAGE(PG8_SA(0, 0), a2, voffA);
            PG8_WAIT_V(8); PG8_WAIT_L(0); PG8_BAR; PG8_MMA(1, 0, At, B0); PG8_MMA(1, 1, At, B1); PG8_BAR; PG8_SCHED;
            PG8_LDB(B0, 1, 0); PG8_LDB(B1, 1, 1); PG8_SCHED; PG8_LDA(At, 1, 0); PG8_STAGE(PG8_SA(0, 1), a2 + hstep, voffA);
            PG8_WAIT_V(8); PG8_WAIT_L(0); PG8_BAR; PG8_MMA(0, 0, At, B0); PG8_MMA(0, 1, At, B1); PG8_BAR; PG8_SCHED;
            PG8_LDA(At, 1, 1); PG8_STAGE(PG8_SB(1, 0), b3, voffB); PG8_STAGE(PG8_SB(1, 1), b3 + hstep, voffB); PG8_STAGE(PG8_SA(1, 0), a3, voffA);
            PG8_WAIT_V(8); PG8_WAIT_L(0); PG8_BAR; PG8_MMA(1, 0, At, B0); PG8_MMA(1, 1, At, B1); PG8_BAR; PG8_SCHED;
            } else {
            PG8_LDB(B0, 0, 0); PG8_SCHED; PG8_LDA(At, 0, 0); PG8_STAGE(PG8_SA(1, 1), a1 + hstep, voffA);
            PG8_WAIT_L(8); PG8_BAR; PG8_WAIT_L(0); PG8_MMA(0, 0, At, B0); PG8_BAR; PG8_SCHED;
            PG8_LDB(B1, 0, 1); PG8_STAGE(PG8_SB(0, 0), b2, voffB);
            PG8_BAR; PG8_WAIT_L(0); PG8_MMA(0, 1, At, B1); PG8_BAR;
            PG8_LDA(At, 0, 1); PG8_STAGE(PG8_SA(0, 0), a2, voffA);
            PG8_BAR; PG8_WAIT_L(0); PG8_MMA(1, 0, At, B0); PG8_BAR; PG8_SCHED;
            PG8_STAGE(PG8_SB(0, 1), b2 + hstep, voffB);
            PG8_WAIT_V(6); PG8_BAR; PG8_MMA(1, 1, At, B1); PG8_BAR;
            PG8_LDB(B0, 1, 0); PG8_SCHED; PG8_LDA(At, 1, 0); PG8_STAGE(PG8_SA(0, 1), a2 + hstep, voffA);
            PG8_WAIT_L(8); PG8_BAR; PG8_WAIT_L(0); PG8_MMA(0, 0, At, B0); PG8_BAR; PG8_SCHED;
            PG8_LDB(B1, 1, 1); PG8_STAGE(PG8_SB(1, 0), b3, voffB);
            PG8_BAR; PG8_WAIT_L(0); PG8_MMA(0, 1, At, B1); PG8_BAR;
            PG8_LDA(At, 1, 1); PG8_STAGE(PG8_SA(1, 0), a3, voffA);
            PG8_BAR; PG8_WAIT_L(0); PG8_MMA(1, 0, At, B0); PG8_BAR; PG8_SCHED;
            PG8_STAGE(PG8_SB(1, 1), b3 + hstep, voffB);
            PG8_WAIT_V(6); PG8_BAR; PG8_MMA(1, 1, At, B1); PG8_BAR;
            }
        }
        if constexpr (ALIGN_EPI) { if (wr == 0) PG8_BAR; }
        if constexpr (!Epi::AFTER_DRAIN) { E(acc, cur, wr, wc, fr, fq); S.done(cur); }
        if (!has_next) break;
#pragma unroll
        for (int a = 0; a < 2; ++a)
#pragma unroll
            for (int b = 0; b < 2; ++b)
#pragma unroll
                for (int m = 0; m < 4; ++m)
#pragma unroll
                    for (int n = 0; n < 2; ++n) acc[a][b][m][n] = (f32x4){0.f, 0.f, 0.f, 0.f};
        cur = nxt; cA = nA; cB = nB; ++ui;
        if constexpr (ALIGN_EPI) { if (wr == 1) PG8_BAR; }
    }
    PG8_WAIT_V(0);
    if constexpr (!ALIGN_EPI) { if (wr == 0) PG8_BAR; }
    PG8_BAR;
    if constexpr (Epi::AFTER_DRAIN) { E.fused(acc, cur, wr, wc, fr, fq, lds, wid, lane); S.done(cur); }
#undef PG8_SA
#undef PG8_SB
#undef PG8_STAGE
#undef PG8_LDA
#undef PG8_LDB
#undef PG8_MMA
#undef PG8_WAIT_V
#undef PG8_WAIT_L
#undef PG8_BAR
#undef PG8_SCHED
}
}

#define LAS __attribute__((address_space(3)))
#define DI __device__ __forceinline__
using pg8::bf16_t; using pg8::bf16x8; using pg8::f32x4; using pg8::u32x4; using pg8::cvt_pk_bf16;
typedef unsigned u32x2 __attribute__((ext_vector_type(2)));
typedef float f32x2 __attribute__((ext_vector_type(2)));

constexpr int T_TOK = 32768, DM = 2048, NPROJ = 5120, PROJW = 5128;
constexpr int NTHREADS = 512;
constexpr int LDS_BYTES = 147456;
constexpr float EPS = 1e-6f;

constexpr size_t WS_XN = 0;
constexpr size_t WS_P = 134217728;
constexpr size_t WS_X1G = WS_P;
constexpr size_t WS_Q = WS_P + 134217728;
constexpr size_t WS_WINT = WS_P + 335544320;
constexpr size_t WS_WOUTT = WS_WINT + 20971520;
constexpr size_t WS_WQT = WS_WOUTT + 8388608;
constexpr size_t WS_UB = WS_WQT + 4194304;
constexpr size_t WS_VB = WS_UB + 67108864;
constexpr size_t WS_ST = WS_VB + 67108864;
constexpr size_t WS_CPT = WS_ST + 142606336;
constexpr size_t WS_QC = WS_CPT + 71303168;
constexpr size_t WS_KC = WS_QC + 33554432;
constexpr size_t WS_IG = WS_KC + 33554432;
constexpr size_t WS_LF = WS_IG + 524288;
constexpr size_t WS_PSSV = WS_LF + 524288;
constexpr size_t WS_PSS2 = WS_PSSV + 2097152;
constexpr size_t WS_BEND = WS_PSS2 + 4194304;
constexpr size_t WS_GMAX = WS_BEND + 4096;
constexpr size_t WS_MPREV = WS_GMAX + 4096;
constexpr size_t WS_SELID = WS_MPREV + 4096;
constexpr size_t WS_SELG = WS_SELID + 16777216;
constexpr size_t WS_KB1 = WS_SELG + 16777216;
constexpr size_t WS_KB2 = WS_KB1 + 131072;
constexpr size_t WS_BAR = WS_KB2 + 131072;
constexpr size_t WS_END = WS_BAR + 16384;

struct Params {
    const float *x, *norm1_g, *w_in, *gm_vnorm_g, *w_spatial, *b_spatial, *ml_conv_w, *ml_conv_b, *ml_b_i, *ml_b_f, *gm_out_g, *ml_out_g, *w_out, *norm2_g,
        *peer_wq, *peer_k1, *peer_k2, *peer_u, *peer_v, *final_g;
    float* out;
    unsigned char* ws;
};

template <int CB, int H, int W> DI size_t p_off(int t, int h, int d) { return (size_t)T_TOK * CB + ((size_t)((t >> 7) * H + h) * 128 + (t & 127)) * W + d; }
DI float bf2f(unsigned short h) { return __uint_as_float(((unsigned)h) << 16); }
DI float bflo(unsigned w) { return __uint_as_float(w << 16); }
DI float bfhi(unsigned w) { return __uint_as_float(w & 0xffff0000u); }
DI float rcpf_(float x) { return __builtin_amdgcn_rcpf(x); }
DI float sigmoid_(float x) { return rcpf_(1.f + __expf(-x)); }
DI float gelu_t(float x) { const float z = 1.5957691216057308f * (x + 0.044715f * x * x * x); return x * rcpf_(1.f + __expf(-z)); }
DI float wave_sum(float v) {
#pragma unroll
    for (int o = 32; o; o >>= 1) v += __shfl_xor(v, o);
    return v;
}
DI float wave_max(float v) {
#pragma unroll
    for (int o = 32; o; o >>= 1) v = fmaxf(v, __shfl_xor(v, o));
    return v;
}
DI bf16x8 ld_frag_lds(const LAS unsigned char* p) { return *(const LAS bf16x8*)p; }
#define MFMA16(a, b, c) __builtin_amdgcn_mfma_f32_16x16x32_bf16((a), (b), (c), 0, 0, 0)

struct Epi1 {
    static constexpr bool PERM = true, AFTER_DRAIN = false;
    bf16_t* P; float* pssv;
    DI void operator()(const f32x4 (&acc)[2][2][4][2], const pg8::Unit& u, int wr, int wc, int fr, int fq) const {
        const int row0 = u.pm * 256 + wr * 64 + fr, col0 = u.pn * 256 + wc * 32 + 8 * fq;
        const int mode = u.pn < 8 ? 1 : (u.pn >= 16 ? 2 : 0);
        const bool want_ss = (u.pn >= 4 && u.pn < 8);
#pragma unroll
        for (int ai = 0; ai < 2; ++ai)
#pragma unroll
            for (int m = 0; m < 4; ++m) {
                const int row = row0 + ai * 128 + m * 16;
                const int CB = u.pn < 4 ? 0 : (u.pn < 8 ? 1024 : (u.pn < 10 ? 2048 : (u.pn < 12 ? 2560 : (u.pn < 16 ? 3072 : 4096))));
                const int lw = u.pn < 12 ? 7 : 8, H = u.pn < 8 ? 8 : 4;
                float ss = 0.f;
#pragma unroll
                for (int bj = 0; bj < 2; ++bj) {
                    f32x4 v0 = acc[ai][bj][m][0], v1 = acc[ai][bj][m][1];
                    if (mode == 1) {
#pragma unroll
                        for (int j = 0; j < 4; ++j) { v0[j] = gelu_t(v0[j]); v1[j] = gelu_t(v1[j]); ss += v0[j] * v0[j] + v1[j] * v1[j]; }
                    } else if (mode == 2) {
#pragma unroll
                        for (int j = 0; j < 4; ++j) { v0[j] = sigmoid_(v0[j]); v1[j] = sigmoid_(v1[j]); }
                    }
                    u32x4 w; w.x = cvt_pk_bf16(v0[0], v0[1]); w.y = cvt_pk_bf16(v0[2], v0[3]); w.z = cvt_pk_bf16(v1[0], v1[1]); w.w = cvt_pk_bf16(v1[2], v1[3]);
                    {
                        const int cr = col0 + bj * 128 - CB, hh = cr >> lw, d = cr & ((1 << lw) - 1);
                        *(u32x4*)(P + (size_t)T_TOK * CB + (((size_t)((row >> 7) * H + hh) * 128 + (row & 127)) << lw) + d) = w;
                    }
                }
                if (want_ss) {
                    ss += __shfl_xor(ss, 16); ss += __shfl_xor(ss, 32);
                    if (fq == 0) pssv[(size_t)row * 16 + (u.pn - 4) * 4 + wc] = ss;
                }
            }
    }
};

struct Epi2 {
    static constexpr bool PERM = true, AFTER_DRAIN = false;
    const float* x; bf16_t* x1b; float* pss2;
    DI void operator()(const f32x4 (&acc)[2][2][4][2], const pg8::Unit& u, int wr, int wc, int fr, int fq) const {
        const int row0 = u.pm * 256 + wr * 64 + fr, col0 = u.pn * 256 + wc * 32 + 8 * fq;
#pragma unroll
        for (int ai = 0; ai < 2; ++ai)
#pragma unroll
            for (int m = 0; m < 4; ++m) {
                const int row = row0 + ai * 128 + m * 16;
                float ss = 0.f;
#pragma unroll
                for (int bj = 0; bj < 2; ++bj) {
                    const size_t o = (size_t)row * DM + col0 + bj * 128;
                    const f32x4 v0 = acc[ai][bj][m][0] + *(const f32x4*)(x + o), v1 = acc[ai][bj][m][1] + *(const f32x4*)(x + o + 4);
#pragma unroll
                    for (int j = 0; j < 4; ++j) ss += v0[j] * v0[j] + v1[j] * v1[j];
                    u32x4 w; w.x = cvt_pk_bf16(v0[0], v0[1]); w.y = cvt_pk_bf16(v0[2], v0[3]); w.z = cvt_pk_bf16(v1[0], v1[1]); w.w = cvt_pk_bf16(v1[2], v1[3]);
                    *(u32x4*)(x1b + o) = w;
                }
                ss += __shfl_xor(ss, 16); ss += __shfl_xor(ss, 32);
                if (fq == 0) pss2[(size_t)row * 32 + u.pn * 4 + wc] = ss;
            }
    }
};

struct Epi3 {
    static constexpr bool PERM = true, AFTER_DRAIN = false;
    bf16_t* Q; const float* pss2;
    DI void operator()(const f32x4 (&acc)[2][2][4][2], const pg8::Unit& u, int wr, int wc, int fr, int fq) const {
        const int row0 = u.pm * 256 + wr * 64 + fr, col0 = u.pn * 256 + wc * 32 + 8 * fq;
#pragma unroll
        for (int ai = 0; ai < 2; ++ai)
#pragma unroll
            for (int m = 0; m < 4; ++m) {
                const int row = row0 + ai * 128 + m * 16;
                float ss = 0.f;
#pragma unroll
                for (int i = 0; i < 8; ++i) { const f32x4 t = *(const f32x4*)(pss2 + (size_t)row * 32 + i * 4); ss += (t[0] + t[1]) + (t[2] + t[3]); }
                const float rstd = rsqrtf(ss * (1.f / 2048.f) + EPS);
#pragma unroll
                for (int bj = 0; bj < 2; ++bj) {
                    const f32x4 v0 = acc[ai][bj][m][0] * rstd, v1 = acc[ai][bj][m][1] * rstd;
                    u32x4 w; w.x = cvt_pk_bf16(v0[0], v0[1]); w.y = cvt_pk_bf16(v0[2], v0[3]); w.z = cvt_pk_bf16(v1[0], v1[1]); w.w = cvt_pk_bf16(v1[2], v1[3]);
                    *(u32x4*)(Q + (size_t)row * 1024 + col0 + bj * 128) = w;
                }
            }
    }
};

DI void phase0(const Params& p, LAS unsigned char* lds) {
    const int tid = threadIdx.x, lane = tid & 63, wave = tid >> 6;
    bf16_t* XN = (bf16_t*)(p.ws + WS_XN);
    {
        LAS float* scr = (LAS float*)lds + wave * (64 * 65);
        const int gw = blockIdx.x * 8 + wave, nw = gridDim.x * 8;
        for (int it = gw; it < 4096; it += nw) {
            const float* W; bf16_t* WT; int ldw, kt, nt;
            if (it < 2560) { W = p.w_in; WT = (bf16_t*)(p.ws + WS_WINT); ldw = PROJW; kt = it / 80; nt = it % 80; }
            else if (it < 3584) { const int j = it - 2560; W = p.w_out; WT = (bf16_t*)(p.ws + WS_WOUTT); ldw = 2048; kt = j >> 5; nt = j & 31; }
            else { const int j = it - 3584; W = p.peer_wq; WT = (bf16_t*)(p.ws + WS_WQT); ldw = 1024; kt = j >> 4; nt = j & 15; }
            const int k0 = kt * 64, n0 = nt * 64;
            {
                f32x4 tv[16];
#pragma unroll
                for (int i = 0; i < 16; ++i) tv[i] = *(const f32x4*)(W + (size_t)(k0 + 4 * i + (lane >> 4)) * ldw + n0 + 4 * (lane & 15));
#pragma unroll
                for (int i = 0; i < 16; ++i) {
                    const int r = 4 * i + (lane >> 4);
                    const float gsc = it >= 3584 ? p.norm2_g[k0 + r] : 1.f;
                    LAS float* d = scr + r * 65 + 4 * (lane & 15);
                    d[0] = tv[i][0] * gsc; d[1] = tv[i][1] * gsc; d[2] = tv[i][2] * gsc; d[3] = tv[i][3] * gsc;
                }
            }
            __builtin_amdgcn_fence(__ATOMIC_RELEASE, "wavefront"); __builtin_amdgcn_wave_barrier(); __builtin_amdgcn_fence(__ATOMIC_ACQUIRE, "wavefront");
            const int half = lane >> 5, kk = (lane & 31) * 2;
#pragma unroll 8
            for (int nn = 0; nn < 32; ++nn) {
                const int n = 2 * nn + half; const float a = scr[kk * 65 + n], b = scr[(kk + 1) * 65 + n];
                *(unsigned*)(WT + (size_t)(n0 + n) * 2048 + k0 + kk) = cvt_pk_bf16(a, b);
            }
            __builtin_amdgcn_fence(__ATOMIC_RELEASE, "wavefront"); __builtin_amdgcn_wave_barrier(); __builtin_amdgcn_fence(__ATOMIC_ACQUIRE, "wavefront");
        }
    }
    __syncthreads();
    {
        LAS float* wg = (LAS float*)lds;
        for (int idx = tid; idx < 4096; idx += NTHREADS) {
            const int k = idx >> 1, hf = idx & 1;
            const f32x4 v = *(const f32x4*)(p.w_in + (size_t)k * PROJW + 5120 + hf * 4);
            *(LAS f32x4*)(wg + k * 8 + (k >> 3) * 4 + hf * 4) = v;
        }
        __syncthreads();
        float* IG = (float*)(p.ws + WS_IG); float* LF = (float*)(p.ws + WS_LF);
        for (int row0 = 2 * (blockIdx.x * 8 + wave); row0 < T_TOK; row0 += 2 * gridDim.x * 8) {
            f32x4 xv[2][8];
#pragma unroll
            for (int rr = 0; rr < 2; ++rr) {
                const float* xr = p.x + (size_t)(row0 + rr) * DM;
#pragma unroll
                for (int i = 0; i < 4; ++i) { xv[rr][2 * i] = *(const f32x4*)(xr + i * 512 + lane * 8); xv[rr][2 * i + 1] = *(const f32x4*)(xr + i * 512 + lane * 8 + 4); }
            }
#pragma unroll
            for (int rr = 0; rr < 2; ++rr) {
                const int row = row0 + rr;
                float ss = 0.f;
#pragma unroll
                for (int i = 0; i < 8; ++i) ss += (xv[rr][i][0] * xv[rr][i][0] + xv[rr][i][1] * xv[rr][i][1]) + (xv[rr][i][2] * xv[rr][i][2] + xv[rr][i][3] * xv[rr][i][3]);
                ss = wave_sum(ss);
                const float rstd = rsqrtf(ss * (1.f / 2048.f) + EPS);
                f32x4 ga = {0.f, 0.f, 0.f, 0.f}, gb = {0.f, 0.f, 0.f, 0.f};
#pragma unroll
                for (int i = 0; i < 4; ++i) {
                    const f32x4 g0 = *(const f32x4*)(p.norm1_g + i * 512 + lane * 8), g1 = *(const f32x4*)(p.norm1_g + i * 512 + lane * 8 + 4);
                    const f32x4 h0 = xv[rr][2 * i] * rstd * g0, h1 = xv[rr][2 * i + 1] * rstd * g1;
                    u32x4 w; w.x = cvt_pk_bf16(h0[0], h0[1]); w.y = cvt_pk_bf16(h0[2], h0[3]); w.z = cvt_pk_bf16(h1[0], h1[1]); w.w = cvt_pk_bf16(h1[2], h1[3]);
                    *(u32x4*)(XN + (size_t)row * DM + i * 512 + lane * 8) = w;
                    const LAS float* wb = wg + (i * 512 + lane * 8) * 8 + (i * 64 + lane) * 4;
#pragma unroll
                    for (int e = 0; e < 8; ++e) {
                        const float hv = e < 4 ? h0[e & 3] : h1[e & 3];
                        const f32x4 w0 = *(const LAS f32x4*)(wb + e * 8), w1 = *(const LAS f32x4*)(wb + e * 8 + 4);
                        ga = ga + w0 * hv; gb = gb + w1 * hv;
                    }
                }
                f32x4 m4 = lane < 32 ? ga : gb, s4 = lane < 32 ? gb : ga;
#pragma unroll
                for (int j = 0; j < 4; ++j) m4[j] += __shfl_xor(s4[j], 32);
                const bool up16 = (lane & 16) != 0;
                float m2a = up16 ? m4[2] : m4[0], m2b = up16 ? m4[3] : m4[1];
                const float s2a = up16 ? m4[0] : m4[2], s2b = up16 ? m4[1] : m4[3];
                m2a += __shfl_xor(s2a, 16); m2b += __shfl_xor(s2b, 16);
                const bool up8 = (lane & 8) != 0;
                float m1 = up8 ? m2b : m2a; const float s1 = up8 ? m2a : m2b;
                m1 += __shfl_xor(s1, 8);
                m1 += __shfl_xor(m1, 4); m1 += __shfl_xor(m1, 2); m1 += __shfl_xor(m1, 1);
                const int j = ((lane >> 5) << 2) | (((lane >> 4) & 1) << 1) | ((lane >> 3) & 1);
                if ((lane & 7) == 0) {
                    if (j < 4) IG[(size_t)row * 4 + j] = m1 + p.ml_b_i[j];
                    else { const float z = m1 + p.ml_b_f[j - 4]; LF[(size_t)row * 4 + j - 4] = fminf(z, 0.f) - log1pf(__expf(-fabsf(z))); }
                }
            }
        }
    }
    {
        const size_t nthr = (size_t)gridDim.x * NTHREADS, NQ = (size_t)16384 * 512;
        for (size_t base = (size_t)blockIdx.x * NTHREADS + tid; base < 2 * NQ; base += 16 * nthr) {
            f32x4 v[16];
#pragma unroll
            for (int u = 0; u < 16; ++u) {
                size_t i = base + u * nthr; if (i >= 2 * NQ) i = base;
                const int which = i >= NQ; const size_t j = i - (which ? NQ : 0);
                v[u] = *(const f32x4*)((which ? p.peer_v : p.peer_u) + j * 4);
            }
#pragma unroll
            for (int u = 0; u < 16; ++u) {
                size_t i = base + u * nthr; if (i >= 2 * NQ) i = base;
                const int which = i >= NQ; const size_t j = i - (which ? NQ : 0);
                const int row = (int)(j >> 9), c4 = (int)(j & 511);
                float amax = fmaxf(fmaxf(fabsf(v[u][0]), fabsf(v[u][1])), fmaxf(fabsf(v[u][2]), fabsf(v[u][3])));
                amax = fmaxf(amax, __uint_as_float((unsigned)__builtin_amdgcn_update_dpp(0, (int)__float_as_uint(amax), 0xB1, 0xF, 0xF, true)));
                amax = fmaxf(amax, __uint_as_float((unsigned)__builtin_amdgcn_update_dpp(0, (int)__float_as_uint(amax), 0x4E, 0xF, 0xF, true)));
                amax = fmaxf(amax, __uint_as_float((unsigned)__builtin_amdgcn_update_dpp(0, (int)__float_as_uint(amax), 0x141, 0xF, 0xF, true)));
                amax = fmaxf(amax, __uint_as_float((unsigned)__builtin_amdgcn_update_dpp(0, (int)__float_as_uint(amax), 0x140, 0xF, 0xF, true)));
                const unsigned sb = cvt_pk_bf16(amax * (1.f / 6.f), 0.f) & 0xffffu;
                float sc = bflo(sb); if (sc == 0.f) sc = 1.f;
                const float inv = 1.f / sc;
                unsigned r = 0u;
                r = __builtin_amdgcn_cvt_scalef32_pk_fp4_f32(r, v[u][0] * inv, v[u][1] * inv, 1.0f, 0);
                r = __builtin_amdgcn_cvt_scalef32_pk_fp4_f32(r, v[u][2] * inv, v[u][3] * inv, 1.0f, 1);
                unsigned char* dst = p.ws + (which ? WS_VB : WS_UB) + (size_t)row * 1088;
                *(unsigned short*)(dst + c4 * 2) = (unsigned short)(r & 0xffffu);
                if ((c4 & 15) == 0) *(unsigned short*)(dst + 1024 + (c4 >> 4) * 2) = (unsigned short)(sb == 0u ? 0x3F80u : sb);
            }
        }
    }
    {
        bf16_t* KB1 = (bf16_t*)(p.ws + WS_KB1); bf16_t* KB2 = (bf16_t*)(p.ws + WS_KB2);
        for (int i = blockIdx.x * NTHREADS + tid; i < 65536 / 4; i += gridDim.x * NTHREADS) {
            const f32x4 a = *(const f32x4*)(p.peer_k1 + i * 4), b = *(const f32x4*)(p.peer_k2 + i * 4);
            u32x2 w; w.x = cvt_pk_bf16(a[0], a[1]); w.y = cvt_pk_bf16(a[2], a[3]); *(u32x2*)(KB1 + i * 4) = w;
            w.x = cvt_pk_bf16(b[0], b[1]); w.y = cvt_pk_bf16(b[2], b[3]); *(u32x2*)(KB2 + i * 4) = w;
        }
    }
}

#define WAVE_LDS_SYNC() do { __builtin_amdgcn_fence(__ATOMIC_RELEASE, "wavefront"); __builtin_amdgcn_wave_barrier(); __builtin_amdgcn_fence(__ATOMIC_ACQUIRE, "wavefront"); } while (0)

template <int NG> DI void stage_T_load(const bf16_t* src, int ld, u32x4 (&r0)[NG], u32x4 (&r1)[NG], int wave, int lane) {
#pragma unroll
    for (int i = 0; i < NG; ++i) {
        const int g = wave + 8 * i;
        r0[i] = *(const u32x4*)(src + (size_t)(2 * lane) * ld + g * 8);
        r1[i] = *(const u32x4*)(src + (size_t)(2 * lane + 1) * ld + g * 8);
    }
}
template <int NG> DI void stage_T_store(const u32x4 (&r0)[NG], const u32x4 (&r1)[NG], LAS unsigned char* dst, int wave, int lane) {
#pragma unroll
    for (int i = 0; i < NG; ++i) {
        const int g = wave + 8 * i;
#pragma unroll
        for (int w = 0; w < 4; ++w) {
            const unsigned a = r0[i][w], b = r1[i][w];
            *(LAS unsigned*)(dst + (g * 8 + 2 * w) * 272 + lane * 4) = (a & 0xffffu) | (b << 16);
            *(LAS unsigned*)(dst + (g * 8 + 2 * w + 1) * 272 + lane * 4) = (a >> 16) | (b & 0xffff0000u);
        }
    }
}
template <int NG> DI void stage_T(const bf16_t* src, int ld, LAS unsigned char* dst, int wave, int lane) {
    u32x4 r0[NG], r1[NG];
    stage_T_load<NG>(src, ld, r0, r1, wave, lane);
    stage_T_store<NG>(r0, r1, dst, wave, lane);
}

DI void gmlp_bc(const Params& p, LAS unsigned char* lds, int b, int c) {
    const int tid = threadIdx.x, lane = tid & 63, wave = __builtin_amdgcn_readfirstlane(tid >> 6), fr = lane & 15, fq = lane >> 4;
    const int t0 = b * 8192 + c * 128;
    LAS unsigned char* Wl = lds; LAS unsigned char* GvT = lds + 34816; LAS float* rstdv = (LAS float*)(lds + 69632);
    const bf16_t* P = (const bf16_t*)(p.ws + WS_P); bf16_t* YM = (bf16_t*)(p.ws + WS_XN);
    const float* PSSV = (const float*)(p.ws + WS_PSSV);
    __syncthreads();
    if (tid < 128) {
        float ss = 0.f;
#pragma unroll
        for (int i = 0; i < 4; ++i) { const f32x4 v = *(const f32x4*)(PSSV + (size_t)(t0 + tid) * 16 + i * 4); ss += (v[0] + v[1]) + (v[2] + v[3]); }
        rstdv[tid] = rsqrtf(ss * (1.f / 1024.f) + EPS);
    }
    f32x4 wa[4][2]; u32x4 gr0[2], gr1[2];
#define GMLP_PREFETCH(hh) do { _Pragma("unroll") for (int it = 0; it < 4; ++it) { const int e = (it * NTHREADS + tid) * 8, t = e >> 7, s0 = e & 127; \
            const float* wp = p.w_spatial + ((size_t)((hh) * 128 + t)) * 128 + s0; wa[it][0] = *(const f32x4*)wp; wa[it][1] = *(const f32x4*)(wp + 4); } \
        stage_T_load<2>(P + p_off<1024, 8, 128>(t0, (hh), 0), 128, gr0, gr1, wave, lane); } while (0)
    GMLP_PREFETCH(0);
    for (int h = 0; h < 8; ++h) {
        __syncthreads();
#pragma unroll
        for (int it = 0; it < 4; ++it) {
            const int e = (it * NTHREADS + tid) * 8, t = e >> 7, s0 = e & 127;
            float v[8];
#pragma unroll
            for (int j = 0; j < 8; ++j) { const float a = j < 4 ? wa[it][0][j & 3] : wa[it][1][j & 3]; v[j] = (s0 + j <= t) ? a * rstdv[s0 + j] : 0.f; }
            u32x4 w; w.x = cvt_pk_bf16(v[0], v[1]); w.y = cvt_pk_bf16(v[2], v[3]); w.z = cvt_pk_bf16(v[4], v[5]); w.w = cvt_pk_bf16(v[6], v[7]);
            *(LAS u32x4*)(Wl + t * 272 + s0 * 2) = w;
        }
        stage_T_store<2>(gr0, gr1, GvT, wave, lane);
        __syncthreads();
        if (h + 1 < 8) GMLP_PREFETCH(h + 1);
        f32x4 acc[8];
#pragma unroll
        for (int n = 0; n < 8; ++n) acc[n] = (f32x4){0.f, 0.f, 0.f, 0.f};
        const int kmax = (16 * wave + 15) >> 5;
#pragma unroll
        for (int kk = 0; kk < 4; ++kk) {
            if (kk <= kmax) {
                const bf16x8 bfrag = ld_frag_lds(Wl + (16 * wave + fr) * 272 + (32 * kk + 8 * fq) * 2);
#pragma unroll
                for (int n = 0; n < 8; ++n) { const bf16x8 afrag = ld_frag_lds(GvT + (16 * n + fr) * 272 + (32 * kk + 8 * fq) * 2); acc[n] = MFMA16(afrag, bfrag, acc[n]); }
            }
        }
        const int t = 16 * wave + fr; const size_t grow = (size_t)(t0 + t);
        const float bsp = p.b_spatial[h * 128 + t];
        float ss = 0.f;
#pragma unroll
        for (int n = 0; n < 8; ++n) {
            const int d0 = 16 * n + 4 * fq;
            const u32x2 uw = *(const u32x2*)(P + p_off<0, 8, 128>(t0 + t, h, d0));
            const f32x4 gv = *(const f32x4*)(p.gm_vnorm_g + h * 128 + d0);
            f32x4 y;
            y[0] = bflo(uw.x) * (gv[0] * acc[n][0] + bsp); y[1] = bfhi(uw.x) * (gv[1] * acc[n][1] + bsp);
            y[2] = bflo(uw.y) * (gv[2] * acc[n][2] + bsp); y[3] = bfhi(uw.y) * (gv[3] * acc[n][3] + bsp);
            ss += (y[0] * y[0] + y[1] * y[1]) + (y[2] * y[2] + y[3] * y[3]);
            acc[n] = y;
        }
        ss += __shfl_xor(ss, 16); ss += __shfl_xor(ss, 32);
        const float rstd = rsqrtf(ss * (1.f / 128.f) + EPS);
#pragma unroll
        for (int n = 0; n < 8; ++n) {
            const int d0 = 16 * n + 4 * fq;
            const f32x4 g = *(const f32x4*)(p.gm_out_g + h * 128 + d0);
            const f32x4 o = acc[n] * rstd * g;
            u32x2 w; w.x = cvt_pk_bf16(o[0], o[1]); w.y = cvt_pk_bf16(o[2], o[3]);
            *(u32x2*)(YM + grow * DM + h * 128 + d0) = w;
        }
    }
}

DI void mlstm_local(const Params& p, LAS unsigned char* lds, int b, int c, int h) {
    const int tid = threadIdx.x, lane = tid & 63, wave = __builtin_amdgcn_readfirstlane(tid >> 6), fr = lane & 15, fq = lane >> 4;
    const int bh = b * 4 + h, t0 = b * 8192 + c * 128;
    LAS unsigned char* KT = lds; LAS unsigned char* VT = lds + 34816; LAS float* wsv = (LAS float*)(lds + 108800);
    const bf16_t* P = (const bf16_t*)(p.ws + WS_P);
    bf16_t* QC = (bf16_t*)(p.ws + WS_QC); bf16_t* KC = (bf16_t*)(p.ws + WS_KC);
    const float* IG = (const float*)(p.ws + WS_IG); const float* LF = (const float*)(p.ws + WS_LF);
    LAS float* cwl = (LAS float*)(lds + 109312);
    __syncthreads();
    u32x4 xw[2][5];
#define CONV_LOAD(half) do { _Pragma("unroll") for (int gi = 0; gi < 2; ++gi) { const int g = wave + 8 * (gi + 2 * (half)); const int cgp = (g & 15) * 8; \
        _Pragma("unroll") for (int dj = 0; dj < 5; ++dj) { const int srow = 2 * lane - 3 + dj; xw[gi][dj] = (u32x4){0u, 0u, 0u, 0u}; \
            if (c > 0 || srow >= 0) xw[gi][dj] = *(const u32x4*)(P + ((half) ? p_off<2560, 4, 128>(t0 + srow, h, cgp) : p_off<2048, 4, 128>(t0 + srow, h, cgp))); } } } while (0)
    CONV_LOAD(0);
    for (int idx = tid; idx < 1280; idx += NTHREADS) {
        const int j = idx >> 8, cc = idx & 255, ch = (cc >= 128 ? 512 : 0) + h * 128 + (cc & 127);
        cwl[idx] = j < 4 ? p.ml_conv_w[j * 1024 + ch] : p.ml_conv_b[ch];
    }
    if (wave == 0) {
        const float l0 = LF[(size_t)(t0 + 2 * lane) * 4 + h], l1 = LF[(size_t)(t0 + 2 * lane + 1) * 4 + h];
        const float i0 = IG[(size_t)(t0 + 2 * lane) * 4 + h], i1 = IG[(size_t)(t0 + 2 * lane + 1) * 4 + h];
        float s = l0 + l1;
#pragma unroll
        for (int off = 1; off < 64; off <<= 1) { const float tt = __shfl_up(s, off); if (lane >= off) s += tt; }
        const float b1 = s, b0 = s - l1, bend = __shfl(s, 63);
        const float g0 = bend - b0 + i0, g1 = bend - b1 + i1;
        const float gmax = wave_max(fmaxf(g0, g1));
        wsv[2 * lane] = __expf(g0 - gmax); wsv[2 * lane + 1] = __expf(g1 - gmax);
        if (lane == 0) { ((float*)(p.ws + WS_BEND))[bh * 64 + c] = bend; ((float*)(p.ws + WS_GMAX))[bh * 64 + c] = gmax; }
    }
    __syncthreads();
#pragma unroll
    for (int gi4 = 0; gi4 < 4; ++gi4) {
        const int gi = gi4 & 1;
        if (gi4 == 2) CONV_LOAD(1);
        const int g = wave + 8 * gi4; const bool isk = gi4 >= 2; const int cgp = (g & 15) * 8;
        const int cc0 = (isk ? 128 : 0) + cgp;
        const int s = 2 * lane;
        float y0[8], y1[8];
        {
            const f32x4 cb0 = *(const LAS f32x4*)(cwl + 1024 + cc0), cb1 = *(const LAS f32x4*)(cwl + 1024 + cc0 + 4);
#pragma unroll
            for (int e = 0; e < 8; ++e) { y0[e] = e < 4 ? cb0[e & 3] : cb1[e & 3]; y1[e] = y0[e]; }
#pragma unroll
            for (int j = 0; j < 5; ++j) {
                float xr[8];
#pragma unroll
                for (int q = 0; q < 4; ++q) { xr[2 * q] = bflo(xw[gi][j][q]); xr[2 * q + 1] = bfhi(xw[gi][j][q]); }
                if (j < 4) {
                    const f32x4 w0 = *(const LAS f32x4*)(cwl + j * 256 + cc0), w1 = *(const LAS f32x4*)(cwl + j * 256 + cc0 + 4);
#pragma unroll
                    for (int e = 0; e < 8; ++e) y0[e] += (e < 4 ? w0[e & 3] : w1[e & 3]) * xr[e];
                }
                if (j > 0) {
                    const f32x4 w0 = *(const LAS f32x4*)(cwl + (j - 1) * 256 + cc0), w1 = *(const LAS f32x4*)(cwl + (j - 1) * 256 + cc0 + 4);
#pragma unroll
                    for (int e = 0; e < 8; ++e) y1[e] += (e < 4 ? w0[e & 3] : w1[e & 3]) * xr[e];
                }
            }
        }
        const float sc = isk ? 0.08838834764831845f : 1.f;
#pragma unroll
        for (int e = 0; e < 8; ++e) { y0[e] = y0[e] * sigmoid_(y0[e]) * sc; y1[e] = y1[e] * sigmoid_(y1[e]) * sc; }
        bf16_t* dst = (isk ? KC : QC) + (size_t)(t0 + s) * 512 + h * 128 + cgp;
        u32x4 w; w.x = cvt_pk_bf16(y0[0], y0[1]); w.y = cvt_pk_bf16(y0[2], y0[3]); w.z = cvt_pk_bf16(y0[4], y0[5]); w.w = cvt_pk_bf16(y0[6], y0[7]);
        *(u32x4*)dst = w;
        w.x = cvt_pk_bf16(y1[0], y1[1]); w.y = cvt_pk_bf16(y1[2], y1[3]); w.z = cvt_pk_bf16(y1[4], y1[5]); w.w = cvt_pk_bf16(y1[6], y1[7]);
        *(u32x4*)(dst + 512) = w;
        if (isk) {
            const float w0 = wsv[s], w1 = wsv[s + 1];
#pragma unroll
            for (int e = 0; e < 8; ++e) *(LAS unsigned*)(KT + (cgp + e) * 272 + lane * 4) = cvt_pk_bf16(y0[e] * w0, y1[e] * w1);
        }
    }
    stage_T<4>(P + p_off<3072, 4, 256>(t0, h, 0), 256, VT, wave, lane);
    for (int i = tid; i < 1024; i += NTHREADS) { const int r = i >> 6, w = i & 63; *(LAS unsigned*)(VT + (256 + r) * 272 + w * 4) = 0x3F803F80u; }
    __syncthreads();
    bf16x8 af[4];
#pragma unroll
    for (int kk = 0; kk < 4; ++kk) af[kk] = ld_frag_lds(KT + (16 * wave + fr) * 272 + (32 * kk + 8 * fq) * 2);
    float* ST = (float*)(p.ws + WS_ST) + ((size_t)(bh * 64 + c) * 272) * 128;
#pragma unroll
    for (int n = 0; n < 17; ++n) {
        f32x4 acc = {0.f, 0.f, 0.f, 0.f};
#pragma unroll
        for (int kk = 0; kk < 4; ++kk) { const bf16x8 bfr = ld_frag_lds(VT + (16 * n + fr) * 272 + (32 * kk + 8 * fq) * 2); acc = MFMA16(af[kk], bfr, acc); }
        if (n < 16 || fr == 0) __builtin_nontemporal_store(acc, (f32x4*)(ST + (size_t)(16 * n + fr) * 128 + 16 * wave + 4 * fq));
    }
}

DI void phase_scan(const Params& p) {
    const float* ST = (const float*)(p.ws + WS_ST); bf16_t* CPT = (bf16_t*)(p.ws + WS_CPT);
    const float* BEND = (const float*)(p.ws + WS_BEND); const float* GMAX = (const float*)(p.ws + WS_GMAX); float* MPREV = (float*)(p.ws + WS_MPREV);
    const int gtid = blockIdx.x * NTHREADS + threadIdx.x, nthr = gridDim.x * NTHREADS;
    constexpr int PER = 8224;
    constexpr size_t CST = 272 * 128;
    if (nthr == 16 * 8192) {
        const int bh = gtid >> 13, e4 = gtid & 8191;
        const bool extra = (gtid & 255) == 0;
        const int e42 = 8192 + ((gtid >> 8) & 31);
        const float* src = ST + (size_t)bh * 64 * CST + (size_t)e4 * 4;
        bf16_t* dst = CPT + (size_t)bh * 64 * CST + (size_t)e4 * 4;
        const float* src2 = ST + (size_t)bh * 64 * CST + (size_t)e42 * 4;
        bf16_t* dst2 = CPT + (size_t)bh * 64 * CST + (size_t)e42 * 4;
        f32x4 st = {0.f, 0.f, 0.f, 0.f}, st2 = {0.f, 0.f, 0.f, 0.f}; float m = 0.f;
        for (int c0 = 0; c0 < 64; c0 += 8) {
            f32x4 d[8], d2[8]; float be[8], gm[8];
#pragma unroll
            for (int j = 0; j < 8; ++j) { d[j] = __builtin_nontemporal_load((const f32x4*)(src + (size_t)(c0 + j) * CST)); be[j] = BEND[bh * 64 + c0 + j]; gm[j] = GMAX[bh * 64 + c0 + j]; }
#pragma unroll
            for (int j = 0; j < 8; ++j) d2[j] = extra ? __builtin_nontemporal_load((const f32x4*)(src2 + (size_t)(c0 + j) * CST)) : (f32x4){0.f, 0.f, 0.f, 0.f};
#pragma unroll
            for (int j = 0; j < 8; ++j) {
                const int c = c0 + j;
                const float mn = fmaxf(be[j] + m, gm[j]), a = __expf(be[j] + m - mn), sc = __expf(gm[j] - mn);
                u32x2 w; w.x = cvt_pk_bf16(st[0], st[1]); w.y = cvt_pk_bf16(st[2], st[3]);
                *(u32x2*)(dst + (size_t)c * CST) = w;
                if (extra) { u32x2 w2; w2.x = cvt_pk_bf16(st2[0], st2[1]); w2.y = cvt_pk_bf16(st2[2], st2[3]); *(u32x2*)(dst2 + (size_t)c * CST) = w2; }
                if (e4 == 0) MPREV[bh * 64 + c] = m;
                st = st * a + d[j] * sc; st2 = st2 * a + d2[j] * sc; m = mn;
            }
        }
        return;
    }
    for (int item = gtid; item < 16 * PER; item += nthr) {
        const int bh = item / PER, e4 = item - bh * PER;
        const float* src = ST + (size_t)bh * 64 * CST + (size_t)e4 * 4;
        bf16_t* dst = CPT + (size_t)bh * 64 * CST + (size_t)e4 * 4;
        f32x4 st = {0.f, 0.f, 0.f, 0.f}; float m = 0.f;
        for (int c0 = 0; c0 < 64; c0 += 8) {
            f32x4 d[8]; float be[8], gm[8];
#pragma unroll
            for (int j = 0; j < 8; ++j) { d[j] = __builtin_nontemporal_load((const f32x4*)(src + (size_t)(c0 + j) * CST)); be[j] = BEND[bh * 64 + c0 + j]; gm[j] = GMAX[bh * 64 + c0 + j]; }
#pragma unroll
            for (int j = 0; j < 8; ++j) {
                const int c = c0 + j;
                const float mn = fmaxf(be[j] + m, gm[j]), a = __expf(be[j] + m - mn), sc = __expf(gm[j] - mn);
                u32x2 w; w.x = cvt_pk_bf16(st[0], st[1]); w.y = cvt_pk_bf16(st[2], st[3]);
                *(u32x2*)(dst + (size_t)c * CST) = w;
                if (e4 == 0) MPREV[bh * 64 + c] = m;
                st = st * a + d[j] * sc; m = mn;
            }
        }
    }
}

DI void mlstm_out(const Params& p, LAS unsigned char* lds, int b, int c, int h) {
    const int tid = threadIdx.x, lane = tid & 63, wave = __builtin_amdgcn_readfirstlane(tid >> 6), fr = lane & 15, fq = lane >> 4;
    const int bh = b * 4 + h, t0 = b * 8192 + c * 128;
    LAS unsigned char* Kl = lds; LAS unsigned char* Sl = lds + 34816; LAS unsigned char* VTe = lds + 69632;
    LAS float* av = (LAS float*)(lds + 143616); LAS float* Mv = (LAS float*)(lds + 144128); LAS float* bv = (LAS float*)(lds + 144640);
    const bf16_t* P = (const bf16_t*)(p.ws + WS_P); bf16_t* YM = (bf16_t*)(p.ws + WS_XN);
    const bf16_t* QC = (const bf16_t*)(p.ws + WS_QC); const bf16_t* KC = (const bf16_t*)(p.ws + WS_KC);
    const float* IG = (const float*)(p.ws + WS_IG); const float* LF = (const float*)(p.ws + WS_LF);
    const float mprev = ((const float*)(p.ws + WS_MPREV))[bh * 64 + c];
    __syncthreads();
    if (wave == 0) {
        const float l0 = LF[(size_t)(t0 + 2 * lane) * 4 + h], l1 = LF[(size_t)(t0 + 2 * lane + 1) * 4 + h];
        const float i0 = IG[(size_t)(t0 + 2 * lane) * 4 + h], i1 = IG[(size_t)(t0 + 2 * lane + 1) * 4 + h];
        float s = l0 + l1;
#pragma unroll
        for (int off = 1; off < 64; off <<= 1) { const float tt = __shfl_up(s, off); if (lane >= off) s += tt; }
        const float b1 = s, b0 = s - l1;
        const float a0 = i0 - b0, a1 = i1 - b1;
        float pm = fmaxf(a0, a1);
#pragma unroll
        for (int off = 1; off < 64; off <<= 1) { const float tt = __shfl_up(pm, off); if (lane >= off) pm = fmaxf(pm, tt); }
        float ex = __shfl_up(pm, 1); if (lane == 0) ex = -3.0e38f;
        Mv[2 * lane] = fmaxf(mprev, fmaxf(ex, a0)); Mv[2 * lane + 1] = fmaxf(mprev, pm);
        av[2 * lane] = a0; av[2 * lane + 1] = a1; bv[2 * lane] = b0; bv[2 * lane + 1] = b1;
    }
#pragma unroll
    for (int it = 0; it < 4; ++it) {
        const int e = (it * NTHREADS + tid) * 8, s = e >> 7, d0 = e & 127;
        *(LAS u32x4*)(Kl + s * 272 + d0 * 2) = *(const u32x4*)(KC + (size_t)(t0 + s) * 512 + h * 128 + d0);
    }
    stage_T<4>(P + p_off<3072, 4, 256>(t0, h, 0), 256, VTe, wave, lane);
    for (int i = tid; i < 1024; i += NTHREADS) { const int r = i >> 6, w = i & 63; *(LAS unsigned*)(VTe + (256 + r) * 272 + w * 4) = 0x3F803F80u; }
    bf16x8 qf[4];
#pragma unroll
    for (int kk = 0; kk < 4; ++kk) qf[kk] = *(const bf16x8*)(QC + (size_t)(t0 + 16 * wave + fr) * 512 + h * 128 + 32 * kk + 8 * fq);
    __syncthreads();
    const int t = 16 * wave + fr; const float Mt = Mv[t];
    const int stmax = wave | 1;
    for (int st = 0; st <= stmax; ++st) {
        f32x4 s4 = {0.f, 0.f, 0.f, 0.f};
#pragma unroll
        for (int kk = 0; kk < 4; ++kk) { const bf16x8 kf = ld_frag_lds(Kl + (16 * st + fr) * 272 + (32 * kk + 8 * fq) * 2); s4 = MFMA16(kf, qf[kk], s4); }
#pragma unroll
        for (int r = 0; r < 4; ++r) { const int s = 16 * st + 4 * fq + r; const float w = (s <= t) ? __expf(av[s] - Mt) : 0.f; s4[r] *= w; }
        u32x2 w; w.x = cvt_pk_bf16(s4[0], s4[1]); w.y = cvt_pk_bf16(s4[2], s4[3]);
        *(LAS u32x2*)(Sl + t * 272 + (16 * st + 4 * fq) * 2) = w;
    }
    __syncthreads();
    const bf16_t* cpt = (const bf16_t*)(p.ws + WS_CPT) + ((size_t)(bh * 64 + c) * 272) * 128;
    f32x4 acc[17];
#pragma unroll
    for (int n = 0; n < 17; ++n) acc[n] = (f32x4){0.f, 0.f, 0.f, 0.f};
#pragma unroll
    for (int half = 0; half < 2; ++half) {
        if (half) __syncthreads();
#pragma unroll 1
        for (int it = 0; it < 4; it += 2) {
            const int e = (it * NTHREADS + tid) * 8, r = e >> 7, d0 = e & 127;
            const u32x4 c0_ = *(const u32x4*)(cpt + (size_t)(128 * half + r) * 128 + d0), c1_ = *(const u32x4*)(cpt + (size_t)(128 * half + r + 32) * 128 + d0);
            *(LAS u32x4*)(Kl + (r + 32) * 272 + d0 * 2) = c1_;
            *(LAS u32x4*)(Kl + r * 272 + d0 * 2) = c0_;
        }
        __syncthreads();
#pragma unroll
        for (int n8 = 0; n8 < 8; ++n8) {
#pragma unroll
            for (int kk = 0; kk < 4; ++kk) { const bf16x8 cf = ld_frag_lds(Kl + (16 * n8 + fr) * 272 + (32 * kk + 8 * fq) * 2); acc[8 * half + n8] = MFMA16(cf, qf[kk], acc[8 * half + n8]); }
        }
    }
#pragma unroll
    for (int kk = 0; kk < 4; ++kk) { const bf16x8 cf = *(const bf16x8*)(cpt + (size_t)(256 + fr) * 128 + 32 * kk + 8 * fq); acc[16] = MFMA16(cf, qf[kk], acc[16]); }
    const float ai = __expf(mprev - Mt);
#pragma unroll
    for (int n = 0; n < 17; ++n) acc[n] = acc[n] * ai;
    const int k2max = (16 * wave + 15) >> 5;
#pragma unroll
    for (int kk = 0; kk < 4; ++kk) {
        if (kk <= k2max) {
            const bf16x8 sf = ld_frag_lds(Sl + t * 272 + (32 * kk + 8 * fq) * 2);
#pragma unroll
            for (int n = 0; n < 17; ++n) { const bf16x8 vf = ld_frag_lds(VTe + (16 * n + fr) * 272 + (32 * kk + 8 * fq) * 2); acc[n] = MFMA16(vf, sf, acc[n]); }
        }
    }
    const float den = __shfl(acc[16][0], fr);
    const float mt = bv[t] + Mt;
    const float inv = rcpf_(fmaxf(fabsf(den), __expf(-mt)));
    const size_t grow = (size_t)(t0 + t);
    float ss = 0.f;
#pragma unroll
    for (int n = 0; n < 16; ++n) {
        const int v0 = 16 * n + 4 * fq;
        const u32x2 ow = *(const u32x2*)(P + p_off<4096, 4, 256>(t0 + t, h, v0));
        f32x4 y;
        y[0] = bflo(ow.x) * acc[n][0] * inv; y[1] = bfhi(ow.x) * acc[n][1] * inv; y[2] = bflo(ow.y) * acc[n][2] * inv; y[3] = bfhi(ow.y) * acc[n][3] * inv;
        ss += (y[0] * y[0] + y[1] * y[1]) + (y[2] * y[2] + y[3] * y[3]);
        acc[n] = y;
    }
    ss += __shfl_xor(ss, 16); ss += __shfl_xor(ss, 32);
    const float rstd = rsqrtf(ss * (1.f / 256.f) + EPS);
#pragma unroll
    for (int n = 0; n < 16; ++n) {
        const int v0 = 16 * n + 4 * fq;
        const f32x4 g = *(const f32x4*)(p.ml_out_g + h * 256 + v0);
        const f32x4 o = acc[n] * rstd * g;
        u32x2 w; w.x = cvt_pk_bf16(o[0], o[1]); w.y = cvt_pk_bf16(o[2], o[3]);
        *(u32x2*)(YM + grow * DM + 1024 + h * 256 + v0) = w;
    }
}

DI unsigned ord_key(float f) { const unsigned u = __float_as_uint(f); return (u & 0x80000000u) ? ~u : (u | 0x80000000u); }
DI float key_val(unsigned k) { return (k & 0x80000000u) ? __uint_as_float(k & 0x7fffffffu) : __uint_as_float(~k); }
DI unsigned umax_(unsigned a, unsigned b) { return a > b ? a : b; }
DI unsigned umin_(unsigned a, unsigned b) { return a < b ? a : b; }
#define DPPU(v, ctrl) ((unsigned)__builtin_amdgcn_update_dpp(0, (int)(v), (ctrl), 0xF, 0xF, true))
DI unsigned row_max_u32(unsigned v) {
    v = umax_(v, DPPU(v, 0xB1)); v = umax_(v, DPPU(v, 0x4E)); v = umax_(v, DPPU(v, 0x141)); v = umax_(v, DPPU(v, 0x140)); return v;
}
DI float row_sum_f32(float v) {
    v += __uint_as_float(DPPU(__float_as_uint(v), 0xB1)); v += __uint_as_float(DPPU(__float_as_uint(v), 0x4E));
    v += __uint_as_float(DPPU(__float_as_uint(v), 0x141)); v += __uint_as_float(DPPU(__float_as_uint(v), 0x140)); return v;
}
#define CEX(a, b) do { const unsigned mx_ = umax_(a, b), mn_ = umin_(a, b); a = mx_; b = mn_; } while (0)
template <int N> DI unsigned top16_row(unsigned (&s)[N], int c) {
    unsigned list = 0u;
#pragma unroll 1
    for (int it = 0; it < 16; ++it) {
        const unsigned wm = row_max_u32(s[0]);
        const bool win = (s[0] == wm);
#pragma unroll
        for (int i = 0; i < N - 1; ++i) s[i] = win ? s[i + 1] : s[i];
        s[N - 1] = win ? 0u : s[N - 1];
        list = (c == it) ? wm : list;
    }
    return list;
}

template <int N> DI void top16_row2(unsigned (&s)[N], unsigned (&t)[N], int c, unsigned& l1, unsigned& l2) {
    l1 = 0u; l2 = 0u;
#pragma unroll 1
    for (int it = 0; it < 16; ++it) {
        const unsigned wm1 = row_max_u32(s[0]), wm2 = row_max_u32(t[0]);
        const bool win1 = (s[0] == wm1), win2 = (t[0] == wm2);
#pragma unroll
        for (int i = 0; i < N - 1; ++i) { s[i] = win1 ? s[i + 1] : s[i]; t[i] = win2 ? t[i + 1] : t[i]; }
        s[N - 1] = win1 ? 0u : s[N - 1]; t[N - 1] = win2 ? 0u : t[N - 1];
        l1 = (c == it) ? wm1 : l1; l2 = (c == it) ? wm2 : l2;
    }
}

template <int N> DI void top16_row4(unsigned (&s)[N], unsigned (&t)[N], unsigned (&u)[N], unsigned (&v)[N], int c, unsigned& l1, unsigned& l2, unsigned& l3, unsigned& l4) {
    l1 = 0u; l2 = 0u; l3 = 0u; l4 = 0u;
#pragma unroll 1
    for (int it = 0; it < 16; ++it) {
        const unsigned wm1 = row_max_u32(s[0]), wm2 = row_max_u32(t[0]), wm3 = row_max_u32(u[0]), wm4 = row_max_u32(v[0]);
        const bool win1 = (s[0] == wm1), win2 = (t[0] == wm2), win3 = (u[0] == wm3), win4 = (v[0] == wm4);
#pragma unroll
        for (int i = 0; i < N - 1; ++i) { s[i] = win1 ? s[i + 1] : s[i]; t[i] = win2 ? t[i + 1] : t[i]; u[i] = win3 ? u[i + 1] : u[i]; v[i] = win4 ? v[i + 1] : v[i]; }
        s[N - 1] = win1 ? 0u : s[N - 1]; t[N - 1] = win2 ? 0u : t[N - 1]; u[N - 1] = win3 ? 0u : u[N - 1]; v[N - 1] = win4 ? 0u : v[N - 1];
        l1 = (c == it) ? wm1 : l1; l2 = (c == it) ? wm2 : l2; l3 = (c == it) ? wm3 : l3; l4 = (c == it) ? wm4 : l4;
    }
}
#define SORT8(s) do { CEX(s[0], s[1]); CEX(s[2], s[3]); CEX(s[4], s[5]); CEX(s[6], s[7]); CEX(s[0], s[2]); CEX(s[1], s[3]); CEX(s[4], s[6]); CEX(s[5], s[7]); CEX(s[1], s[2]); CEX(s[5], s[6]); \
    CEX(s[0], s[4]); CEX(s[1], s[5]); CEX(s[2], s[6]); CEX(s[3], s[7]); CEX(s[2], s[4]); CEX(s[3], s[5]); CEX(s[1], s[2]); CEX(s[3], s[4]); CEX(s[5], s[6]); } while (0)
#define SORT4(s) do { CEX(s[0], s[1]); CEX(s[2], s[3]); CEX(s[0], s[2]); CEX(s[1], s[3]); CEX(s[1], s[2]); } while (0)

DI void peer_select(const Params& p, LAS unsigned char* lds) {
    const int tid = threadIdx.x, lane = tid & 63, wave = __builtin_amdgcn_readfirstlane(tid >> 6), c = lane & 15, g = lane >> 4, rowbase = lane & 48;
    const bf16_t* Q = (const bf16_t*)(p.ws + WS_Q); const bf16_t* KB1 = (const bf16_t*)(p.ws + WS_KB1); const bf16_t* KB2 = (const bf16_t*)(p.ws + WS_KB2);
    int* SELID = (int*)(p.ws + WS_SELID); float* SELG = (float*)(p.ws + WS_SELG);
    unsigned pk = 0u, validmask = 0u;
#pragma unroll
    for (int q = 0; q < 4; ++q) {
        const int target = 4 * c + q; int ci = 0, cj = 0, cnt = 0; bool v = false;
#pragma unroll
        for (int i = 0; i < 16; ++i) { const int nj = 16 / (i + 1); if (target >= cnt && target < cnt + nj) { ci = i; cj = target - cnt; v = true; } cnt += nj; }
        pk |= (unsigned)((ci << 4) | cj) << (8 * q); validmask |= (v ? 1u : 0u) << q;
    }
    for (int tile = blockIdx.x * 8 + wave; tile < T_TOK / 16; tile += gridDim.x * 8) {
        const int tok0 = tile * 16;
        for (int h = 0; h < 8; ++h) {
            const LAS unsigned char* kbuf = lds + (h & 1) * 36864;
            int tl = tid; asm volatile("" : "+v"(tl));
#pragma unroll
            for (int it = 0; it < 4; ++it) {
                const int idx = it * NTHREADS + tl, which = idx >> 10, r = (idx & 1023) >> 3, q = idx & 7;
                *(LAS u32x4*)(lds + (h & 1) * 36864 + which * 18432 + r * 144 + q * 16) = *(const u32x4*)((which ? KB2 : KB1) + ((size_t)(h * 128 + r)) * 64 + q * 8);
            }
            bf16x8 a1[2], a2[2];
            {
                const bf16_t* qp = Q + (size_t)(tok0 + c) * 1024 + h * 128 + g * 8;
                a1[0] = *(const bf16x8*)qp; a1[1] = *(const bf16x8*)(qp + 32); a2[0] = *(const bf16x8*)(qp + 64); a2[1] = *(const bf16x8*)(qp + 96);
            }
            __syncthreads();
            f32x4 acc1[8], acc2[8];
#pragma unroll
            for (int nt = 0; nt < 8; ++nt) {
                const LAS unsigned char* kp = kbuf + (nt * 16 + c) * 144 + g * 16;
                acc1[nt] = (f32x4){0.f, 0.f, 0.f, 0.f}; acc2[nt] = (f32x4){0.f, 0.f, 0.f, 0.f};
                acc1[nt] = MFMA16(a1[0], ld_frag_lds(kp), acc1[nt]); acc1[nt] = MFMA16(a1[1], ld_frag_lds(kp + 64), acc1[nt]);
                acc2[nt] = MFMA16(a2[0], ld_frag_lds(kp + 18432), acc2[nt]); acc2[nt] = MFMA16(a2[1], ld_frag_lds(kp + 18432 + 64), acc2[nt]);
            }
#pragma unroll
            for (int rp = 0; rp < 2; ++rp) {
                const int r0 = 2 * rp, r1 = 2 * rp + 1;
                unsigned sA[8], sB[8], sC[8], sD[8];
#pragma unroll
                for (int nt = 0; nt < 8; ++nt) {
                    const unsigned ix = (unsigned)(127 - (nt * 16 + c));
                    sA[nt] = (ord_key(acc1[nt][r0]) & ~0x7Fu) | ix; sB[nt] = (ord_key(acc2[nt][r0]) & ~0x7Fu) | ix;
                    sC[nt] = (ord_key(acc1[nt][r1]) & ~0x7Fu) | ix; sD[nt] = (ord_key(acc2[nt][r1]) & ~0x7Fu) | ix;
                }
                SORT8(sA); SORT8(sB); SORT8(sC); SORT8(sD);
                unsigned lA, lB, lC, lD;
                top16_row4<8>(sA, sB, sC, sD, c, lA, lB, lC, lD);
                unsigned c0[4], c1[4];
#pragma unroll
                for (int q = 0; q < 4; ++q) {
                    const int ci = (int)((pk >> (8 * q + 4)) & 15u), cj = (int)((pk >> (8 * q)) & 15u);
                    const unsigned ka = (unsigned)__shfl((int)lA, rowbase + ci), kb = (unsigned)__shfl((int)lB, rowbase + cj);
                    const unsigned kc = (unsigned)__shfl((int)lC, rowbase + ci), kd = (unsigned)__shfl((int)lD, rowbase + cj);
                    const float cand0 = key_val(ka & ~0x7Fu) + key_val(kb & ~0x7Fu), cand1 = key_val(kc & ~0x7Fu) + key_val(kd & ~0x7Fu);
                    const bool ok = ((validmask >> q) & 1u) != 0u; const unsigned ix = (unsigned)(63 - (4 * c + q));
                    c0[q] = ok ? ((ord_key(cand0) & ~0x3Fu) | ix) : 0u; c1[q] = ok ? ((ord_key(cand1) & ~0x3Fu) | ix) : 0u;
                }
                SORT4(c0); SORT4(c1);
                unsigned sel0, sel1;
                top16_row2<4>(c0, c1, c, sel0, sel1);
#pragma unroll
                for (int u = 0; u < 2; ++u) {
                    const unsigned sel = u ? sel1 : sel0, list1 = u ? lC : lA, list2 = u ? lD : lB; const int r = u ? r1 : r0;
                    const int slot = 63 - (int)(sel & 63u);
                    const unsigned pkv = (unsigned)__shfl((int)pk, rowbase + (slot >> 2));
                    const int cij = (int)((pkv >> (8 * (slot & 3))) & 0xFFu);
                    const unsigned e1 = (unsigned)__shfl((int)list1, rowbase + (cij >> 4)), e2 = (unsigned)__shfl((int)list2, rowbase + (cij & 15));
                    const int eid = (127 - (int)(e1 & 127u)) * 128 + (127 - (int)(e2 & 127u));
                    const float sv = key_val(sel & ~0x3Fu), mx = key_val(row_max_u32(sel) & ~0x3Fu);
                    const float ev = __expf(sv - mx);
                    const float sum = row_sum_f32(ev);
                    const size_t o = (size_t)(tok0 + 4 * g + r) * 128 + h * 16 + c;
                    SELID[o] = eid; SELG[o] = ev * rcpf_(sum);
                }
            }
        }
    }
}

DI f32x2 pkfma(f32x2 a, f32x2 b, f32x2 c) { return __builtin_elementwise_fma(a, b, c); }
DI void peer_gather(const Params& p, LAS unsigned char* lds) {
    const int tid = threadIdx.x, lane = tid & 63, wave = __builtin_amdgcn_readfirstlane(tid >> 6);
    LAS float* scr = (LAS float*)lds + wave * (16 * 68);
    LAS float* cfl = (LAS float*)(lds + 8 * 16 * 68 * 4) + wave * 128;
    const unsigned char* Ub = p.ws + WS_UB; const unsigned char* Vb = p.ws + WS_VB;
    const float* PSS2 = (const float*)(p.ws + WS_PSS2);
    const int* SELID = (const int*)(p.ws + WS_SELID); const float* SELG = (const float*)(p.ws + WS_SELG);
    const int gw = blockIdx.x * 8 + wave, nw = gridDim.x * 8;
    for (int t = gw; t < T_TOK; t += nw) {
        const int idA = SELID[(size_t)t * 128 + lane], idB = SELID[(size_t)t * 128 + 64 + lane];
        const float gA = SELG[(size_t)t * 128 + lane], gB = SELG[(size_t)t * 128 + 64 + lane];
        const bf16_t* xrow = (const bf16_t*)(p.ws + WS_X1G) + (size_t)t * DM + lane * 32;
        float* orow = p.out + (size_t)t * DM + lane * 32;
        const float pv = lane < 32 ? PSS2[(size_t)t * 32 + lane] : 0.f;
        const float rstd2 = rsqrtf(wave_sum(pv) * (1.f / 2048.f) + EPS);
        f32x2 h2[16];
#pragma unroll
        for (int q = 0; q < 4; ++q) {
            const u32x4 xw = *(const u32x4*)(xrow + q * 8);
            const f32x4 g0 = *(const f32x4*)(p.norm2_g + lane * 32 + q * 8), g1 = *(const f32x4*)(p.norm2_g + lane * 32 + q * 8 + 4);
            h2[4 * q] = (f32x2){bflo(xw.x) * rstd2 * g0[0], bfhi(xw.x) * rstd2 * g0[1]};
            h2[4 * q + 1] = (f32x2){bflo(xw.y) * rstd2 * g0[2], bfhi(xw.y) * rstd2 * g0[3]};
            h2[4 * q + 2] = (f32x2){bflo(xw.z) * rstd2 * g1[0], bfhi(xw.z) * rstd2 * g1[1]};
            h2[4 * q + 3] = (f32x2){bflo(xw.w) * rstd2 * g1[2], bfhi(xw.w) * rstd2 * g1[3]};
        }
        constexpr int NPK = 8;
        u32x4 buf[2][NPK]; unsigned short bsc[2][NPK];
#define PEER_LOAD(TB, st, base) do { const int idv_ = ((base) < 64) ? idA : idB; _Pragma("unroll") for (int e_ = 0; e_ < NPK; ++e_) { \
            const int id_ = __builtin_amdgcn_readlane(idv_, ((base) + e_) & 63); const unsigned char* r_ = (TB) + (size_t)id_ * 1088; \
            buf[st][e_] = *(const u32x4*)(r_ + lane * 16); bsc[st][e_] = *(const unsigned short*)(r_ + 1024 + (lane >> 1) * 2); } } while (0)
#define PEER_DOT(st, slot0) do { _Pragma("unroll") for (int e_ = 0; e_ < NPK; ++e_) { f32x2 a2_ = {0.f, 0.f}; \
            _Pragma("unroll") for (int d_ = 0; d_ < 4; ++d_) { const unsigned w_ = buf[st][e_][d_]; \
                a2_ = pkfma(h2[d_ * 4 + 0], __builtin_amdgcn_cvt_scalef32_pk_f32_fp4(w_, 1.0f, 0), a2_); a2_ = pkfma(h2[d_ * 4 + 1], __builtin_amdgcn_cvt_scalef32_pk_f32_fp4(w_, 1.0f, 1), a2_); \
                a2_ = pkfma(h2[d_ * 4 + 2], __builtin_amdgcn_cvt_scalef32_pk_f32_fp4(w_, 1.0f, 2), a2_); a2_ = pkfma(h2[d_ * 4 + 3], __builtin_amdgcn_cvt_scalef32_pk_f32_fp4(w_, 1.0f, 3), a2_); } \
            scr[((slot0) + e_) * 68 + lane] = (a2_[0] + a2_[1]) * bf2f(bsc[st][e_]); } } while (0)
        PEER_LOAD(Ub, 0, 0);
        for (int b = 0; b < 128 / NPK; b += 2) {
            PEER_LOAD(Ub, 1, (b + 1) * NPK);
            PEER_DOT(0, (b * NPK) & 15);
            if (b + 2 < 128 / NPK) PEER_LOAD(Ub, 0, (b + 2) * NPK);
            PEER_DOT(1, ((b + 1) * NPK) & 15);
            if ((((b + 2) * NPK) & 15) == 0) {
                WAVE_LDS_SYNC();
                float sum = 0.f;
#pragma unroll
                for (int i = 0; i < 4; ++i) { const f32x4 r = *(const LAS f32x4*)(scr + (lane >> 2) * 68 + (lane & 3) * 16 + 4 * i); sum += (r[0] + r[1]) + (r[2] + r[3]); }
                sum += __shfl_xor(sum, 1); sum += __shfl_xor(sum, 2);
                const int k0 = (b + 2) * NPK - 16;
                const int k = k0 + (lane >> 2);
                const float gate = __shfl((k0 < 64) ? gA : gB, k & 63);
                if ((lane & 3) == 0) cfl[k] = gate * gelu_t(sum);
                WAVE_LDS_SYNC();
            }
        }
        f32x2 acc[16];
#pragma unroll
        for (int i = 0; i < 16; ++i) acc[i] = (f32x2){0.f, 0.f};
#define PEER_AXPY(st, base) do { _Pragma("unroll") for (int e_ = 0; e_ < NPK; ++e_) { const float c_ = cfl[(base) + e_] * bf2f(bsc[st][e_]); const f32x2 c2_ = {c_, c_}; \
            _Pragma("unroll") for (int d_ = 0; d_ < 4; ++d_) { const unsigned w_ = buf[st][e_][d_]; \
                acc[d_ * 4 + 0] = pkfma(c2_, __builtin_amdgcn_cvt_scalef32_pk_f32_fp4(w_, 1.0f, 0), acc[d_ * 4 + 0]); acc[d_ * 4 + 1] = pkfma(c2_, __builtin_amdgcn_cvt_scalef32_pk_f32_fp4(w_, 1.0f, 1), acc[d_ * 4 + 1]); \
                acc[d_ * 4 + 2] = pkfma(c2_, __builtin_amdgcn_cvt_scalef32_pk_f32_fp4(w_, 1.0f, 2), acc[d_ * 4 + 2]); acc[d_ * 4 + 3] = pkfma(c2_, __builtin_amdgcn_cvt_scalef32_pk_f32_fp4(w_, 1.0f, 3), acc[d_ * 4 + 3]); } } } while (0)
        PEER_LOAD(Vb, 0, 0);
        for (int b = 0; b < 128 / NPK; b += 2) {
            PEER_LOAD(Vb, 1, (b + 1) * NPK);
            PEER_AXPY(0, b * NPK);
            if (b + 2 < 128 / NPK) PEER_LOAD(Vb, 0, (b + 2) * NPK);
            PEER_AXPY(1, (b + 1) * NPK);
        }
        float ss = 0.f;
#pragma unroll
        for (int q = 0; q < 4; ++q) {
            const u32x4 xw = *(const u32x4*)(xrow + q * 8);
            acc[4 * q] += (f32x2){bflo(xw.x), bfhi(xw.x)}; acc[4 * q + 1] += (f32x2){bflo(xw.y), bfhi(xw.y)};
            acc[4 * q + 2] += (f32x2){bflo(xw.z), bfhi(xw.z)}; acc[4 * q + 3] += (f32x2){bflo(xw.w), bfhi(xw.w)};
#pragma unroll
            for (int i = 0; i < 4; ++i) { const f32x2 a = acc[4 * q + i]; ss += a[0] * a[0] + a[1] * a[1]; }
        }
        const float rstd = rsqrtf(wave_sum(ss) * (1.f / 2048.f) + EPS);
#pragma unroll
        for (int q = 0; q < 8; ++q) {
            const f32x4 g0 = *(const f32x4*)(p.final_g + lane * 32 + q * 4);
            const f32x2 a = acc[2 * q], b = acc[2 * q + 1];
            const f32x4 o0 = {a[0] * rstd * g0[0], a[1] * rstd * g0[1], b[0] * rstd * g0[2], b[1] * rstd * g0[3]};
            *(f32x4*)(orow + q * 4) = o0;
        }
        WAVE_LDS_SYNC();
    }
}

#define XB_TMO      128
#define XB_XCNT(j)  (256  + 64 * (j))
#define XB_XSUB(j)  (1280 + 64 * (j))
#define XB_XGEN(j)  (2304 + 64 * (j))
#define XB_TOP      3328
#define XB_TOPGEN   3392
#define XCD_BAR_WORDS 3456
#define XB_SPIN_CAP (1u << 18)

__device__ __forceinline__ unsigned xb_ld(unsigned* p)              { return __hip_atomic_load(p, __ATOMIC_RELAXED, __HIP_MEMORY_SCOPE_AGENT); }
__device__ __forceinline__ unsigned xb_add(unsigned* p, unsigned v) { return __hip_atomic_fetch_add(p, v, __ATOMIC_RELAXED, __HIP_MEMORY_SCOPE_AGENT); }
__device__ __forceinline__ unsigned xb_xcc_id() { return (unsigned)__builtin_amdgcn_s_getreg((3 << 11) | 20) & 0xFu; }
#define XB_SPIN(cond, bar) do { unsigned _sp = 0; while (cond) { __builtin_amdgcn_s_sleep(1); \
    if ((++_sp & 255u) == 0u) { if (xb_ld(&(bar)[XB_TMO])) break; if (_sp > XB_SPIN_CAP) { atomicAdd(&(bar)[XB_TMO], 1u); break; } } } } while (0)

struct XcdBarrier {
    unsigned* bar; unsigned x;
    volatile LAS unsigned* st;
};

__device__ __forceinline__ XcdBarrier xcd_barrier_post(unsigned* bar, volatile LAS unsigned* st) {
    XcdBarrier b; b.bar = bar; b.x = xb_xcc_id(); b.st = st;
    if (threadIdx.x == 0) (void)xb_add(&bar[XB_XCNT(b.x)], 1u);
    return b;
}
__device__ __forceinline__ void xcd_barrier_complete(unsigned* bar, unsigned x, unsigned& nloc, unsigned& nx) {
    const unsigned G = gridDim.x * gridDim.y * gridDim.z;
    unsigned sum, cnt, mine, sp = 0u;
    for (;;) {
        sum = 0u; cnt = 0u; mine = 0u;
#pragma unroll
        for (unsigned j = 0; j < 16; ++j) { const unsigned c = xb_ld(&bar[XB_XCNT(j)]); sum += c; cnt += (c > 0u) ? 1u : 0u; mine = (j == x) ? c : mine; }
        if (sum == G) break;
        __builtin_amdgcn_s_sleep(1);
        if ((++sp & 255u) == 0u) { if (xb_ld(&bar[XB_TMO])) break; if (sp > XB_SPIN_CAP) { atomicAdd(&bar[XB_TMO], 1u); break; } }
    }
    nloc = mine > 0u ? mine : 1u; nx = cnt > 0u ? cnt : 1u;
}

__device__ __forceinline__ void xcd_barrier(const XcdBarrier& b) {
    asm volatile("s_waitcnt vmcnt(0)" ::: "memory");
    __syncthreads();
    if (threadIdx.x == 0) {
        unsigned* bar = b.bar;
        __builtin_amdgcn_s_waitcnt(0);
        unsigned nloc = b.st[0], nx = b.st[1];
        if (nloc == 0u) { xcd_barrier_complete(bar, b.x, nloc, nx); b.st[0] = nloc; b.st[1] = nx; }
        const unsigned old = xb_add(&bar[XB_XSUB(b.x)], 1u);
        const unsigned gen = old / nloc;
        if (old + 1u == (gen + 1u) * nloc) {
            __builtin_amdgcn_fence(__ATOMIC_RELEASE, "agent");
            asm volatile("s_waitcnt vmcnt(0)" ::: "memory");
            const unsigned og = xb_add(&bar[XB_TOP], 1u);
            const unsigned tg = og / nx;
            if (og + 1u == (tg + 1u) * nx) xb_add(&bar[XB_TOPGEN], 1u);
            else XB_SPIN(xb_ld(&bar[XB_TOPGEN]) == tg, bar);
            __builtin_amdgcn_fence(__ATOMIC_ACQUIRE, "agent");
            xb_add(&bar[XB_XGEN(b.x)], 1u);
            asm volatile("s_waitcnt vmcnt(0)" ::: "memory");
        } else {
            XB_SPIN(xb_ld(&bar[XB_XGEN(b.x)]) == gen, bar);
            __builtin_amdgcn_fence(__ATOMIC_ACQUIRE, "agent");
            asm volatile("s_waitcnt vmcnt(0)" ::: "memory");
        }
    }
    __syncthreads();
}

#ifndef PROBE_DUP
#define PROBE_DUP 0
#endif
#define REP(bit) for (int rep_ = 0; rep_ < (((PROBE_DUP) >> (bit)) & 1) + 1; ++rep_)
#define PH1() { pg8::Gemm g{(const bf16_t*)(p.ws + WS_XN), (const bf16_t*)(p.ws + WS_WINT), T_TOK, NPROJ, DM}; pg8::StaticOrder S; S.init(T_TOK, NPROJ, G, bx); Epi1 E{(bf16_t*)(p.ws + WS_P), (float*)(p.ws + WS_PSSV)}; pg8::gemm_phase<Epi1, pg8::StaticOrder, true, true>(lds, g, S, E); xcd_barrier(xbar); }
#define PH3() { pg8::Gemm g{(const bf16_t*)(p.ws + WS_XN), (const bf16_t*)(p.ws + WS_WOUTT), T_TOK, DM, DM}; pg8::StaticOrder S; S.init(T_TOK, DM, G, bx); Epi2 E{p.x, (bf16_t*)(p.ws + WS_X1G), (float*)(p.ws + WS_PSS2)}; pg8::gemm_phase<Epi2, pg8::StaticOrder, true, true>(lds, g, S, E); xcd_barrier(xbar); }
#define PH4() { pg8::Gemm g{(const bf16_t*)(p.ws + WS_X1G), (const bf16_t*)(p.ws + WS_WQT), T_TOK, 1024, DM}; pg8::StaticOrder S; S.init(T_TOK, 1024, G, bx); Epi3 E{(bf16_t*)(p.ws + WS_Q), (const float*)(p.ws + WS_PSS2)}; pg8::gemm_phase<Epi3, pg8::StaticOrder, true, true>(lds, g, S, E); xcd_barrier(xbar); }
__global__ void __launch_bounds__(NTHREADS, 2) hymba_fwd(Params p) {
    extern __shared__ __attribute__((aligned(16))) unsigned char smem[];
    LAS unsigned char* lds = (LAS unsigned char*)smem;
    cg::grid_group grid = cg::this_grid();
    const int G = gridDim.x, bx = blockIdx.x;
    unsigned* barw = (unsigned*)(p.ws + WS_BAR);
    volatile LAS unsigned* xst = (volatile LAS unsigned*)(lds + LDS_BYTES - 16);
    if (threadIdx.x < 4) xst[threadIdx.x] = 0u;
    if (bx == 0) { for (int i = threadIdx.x; i < XCD_BAR_WORDS; i += NTHREADS) barw[i] = 0u; }
    __syncthreads();
    REP(0) { phase0(p, lds); grid.sync(); }
    const XcdBarrier xbar = xcd_barrier_post(barw, xst);
    PH1()
#if (PROBE_DUP >> 1) & 1
    PH1()
#endif
    REP(2) {
        for (int si = bx; si < 256; si += G) {
            const int b = si >> 6, c = si & 63;
            gmlp_bc(p, lds, b, c);
            for (int h = 0; h < 4; ++h) mlstm_local(p, lds, b, c, h);
        }
        xcd_barrier(xbar);
    }
    REP(3) { phase_scan(p); xcd_barrier(xbar); }
    REP(4) { for (int it = bx; it < 1024; it += G) mlstm_out(p, lds, it >> 8, (it >> 2) & 63, it & 3); xcd_barrier(xbar); }
    PH3()
#if (PROBE_DUP >> 5) & 1
    PH3()
#endif
    PH4()
#if (PROBE_DUP >> 6) & 1
    PH4()
#endif
    REP(7) { peer_select(p, lds); xcd_barrier(xbar); }
    peer_gather(p, lds);
}

extern "C" void kernel_launch(void* const* d_in, const int* in_sizes, int n_in, void* d_out, int out_size, void* d_ws, size_t ws_size, hipStream_t stream) {
    static int grid_blocks = 0;
    if (grid_blocks == 0) {
        if (n_in != 20 || ws_size < WS_END) { fprintf(stderr, "kernel_launch: unexpected n_in %d or ws_size %zu (need %zu)\n", n_in, ws_size, (size_t)WS_END); grid_blocks = -1; return; }
        int dev = 0, cus = 0, per_cu = 0;
        hipGetDevice(&dev);
        hipDeviceGetAttribute(&cus, hipDeviceAttributeMultiprocessorCount, dev);
        hipFuncSetAttribute((const void*)hymba_fwd, hipFuncAttributeMaxDynamicSharedMemorySize, LDS_BYTES);
        hipOccupancyMaxActiveBlocksPerMultiprocessor(&per_cu, (const void*)hymba_fwd, NTHREADS, LDS_BYTES);
        if (per_cu < 1) { fprintf(stderr, "kernel_launch: occupancy query says %d blocks per CU\n", per_cu); per_cu = 1; }
        if (per_cu > 1) per_cu = 1;
        grid_blocks = cus * per_cu;
        (void)hipGetLastError();
    }
    if (grid_blocks < 0) return;
    Params p{};
    p.x = (const float*)d_in[0]; p.norm1_g = (const float*)d_in[1]; p.w_in = (const float*)d_in[2]; p.gm_vnorm_g = (const float*)d_in[3];
    p.w_spatial = (const float*)d_in[4]; p.b_spatial = (const float*)d_in[5]; p.ml_conv_w = (const float*)d_in[6]; p.ml_conv_b = (const float*)d_in[7];
    p.ml_b_i = (const float*)d_in[8]; p.ml_b_f = (const float*)d_in[9]; p.gm_out_g = (const float*)d_in[10]; p.ml_out_g = (const float*)d_in[11];
    p.w_out = (const float*)d_in[12]; p.norm2_g = (const float*)d_in[13]; p.peer_wq = (const float*)d_in[14]; p.peer_k1 = (const float*)d_in[15];
    p.peer_k2 = (const float*)d_in[16]; p.peer_u = (const float*)d_in[17]; p.peer_v = (const float*)d_in[18]; p.final_g = (const float*)d_in[19];
    p.out = (float*)d_out; p.ws = (unsigned char*)d_ws;
    void* args[] = {&p};
    hipError_t e = hipLaunchCooperativeKernel((const void*)hymba_fwd, dim3(grid_blocks), dim3(NTHREADS), args, LDS_BYTES, stream);
    if (e != hipSuccess) fprintf(stderr, "cooperative launch failed: %s (grid %d)\n", hipGetErrorString(e), grid_blocks);
}
```
